# Optimizing an MI355X kernel written in HIP

```python
import math
import jax
import jax.numpy as jnp
from jax import lax
import numpy as np

D_MODEL = 2048
BATCH = 4
SEQ = 2048
DEPTH = 2

GRID_W = 64
CTX_LEN = 256
EPS = 1e-6
F32 = jnp.float32

ML_HEADS = 4
ML_HD = 128
ML_W = ML_HEADS * ML_HD
ML_CHUNK = 64

SSD_HEADS = 8
SSD_HD = 64
SSD_W = SSD_HEADS * SSD_HD
SSD_GROUPS = 2
SSD_STATE = 128
SSD_CONV = 5
SSD_CONV_CH = SSD_W + 2 * SSD_GROUPS * SSD_STATE
SSD_CHUNK = 64

MLA_HEADS = 4
MLA_NOPE = 128
MLA_ROPE = 64
MLA_QK = MLA_NOPE + MLA_ROPE
MLA_V = 128
MLA_Q_RANK = 448
MLA_KV_RANK = 160
MLA_W = MLA_HEADS * MLA_V
ROPE_THETA = 10000.0
ATT_QBLOCK = 128

NA_HEADS = 4
NA_HD = 128
NA_W = NA_HEADS * NA_HD
NA_KH = 8
NA_KW = 16

MIX_W = ML_W + SSD_W + MLA_W + NA_W

IN_SPLITS = (ML_W, ML_W, ML_W, ML_W, 2 * ML_HEADS, 2 * ML_HEADS,
             SSD_W, SSD_CONV_CH, 2 * SSD_HEADS,
             MLA_Q_RANK, MLA_KV_RANK, MLA_ROPE,
             NA_W, NA_W, NA_W)
D_IN = sum(IN_SPLITS)

FFN_DENSE = 5632
N_EXPERTS = 8
TOP_K = 2
FFN_EXPERT = 7168
MOE_BLOCK = 128

kernel_name = 'hybrid_dit_mlstm_ssd_mla_natten_moe'


def rms_norm(x, g):
    xf = x.astype(F32)
    y = xf * lax.rsqrt(jnp.mean(xf * xf, axis=-1, keepdims=True) + EPS)
    return (y * g.astype(F32)).astype(x.dtype)


def split_cols(p):
    offs = np.cumsum(IN_SPLITS)[:-1].tolist()
    return jnp.split(p, offs, axis=-1)


def axial_rope(n_tok, rot_dim):
    t = jnp.arange(n_tok)
    row = (t // GRID_W).astype(F32)
    col = (t % GRID_W).astype(F32)
    n_freq = rot_dim // 4
    freqs = ROPE_THETA ** (-jnp.arange(n_freq, dtype=F32) / n_freq)
    ang = jnp.concatenate([row[:, None] * freqs, col[:, None] * freqs], axis=-1)
    return jnp.cos(ang), jnp.sin(ang)


def apply_rope(u, cos, sin):
    uf = u.astype(F32)
    half = u.shape[-1] // 2
    u1, u2 = uf[..., :half], uf[..., half:]
    cs, sn = cos[:, None, :], sin[:, None, :]
    return jnp.concatenate([u1 * cs - u2 * sn, u1 * sn + u2 * cs], axis=-1).astype(u.dtype)


def dense_attention(q, k, v, scale):
    s = jnp.einsum('bhqd,bhkd->bhqk', q, k).astype(F32) * scale
    p = jax.nn.softmax(s, axis=-1).astype(v.dtype)
    return jnp.einsum('bhqk,bhkd->bhqd', p, v)


def blocked_attention(q, k, v, scale):
    B, H, T, dk = q.shape
    nb = T // ATT_QBLOCK
    qb = jnp.moveaxis(q.reshape(B, H, nb, ATT_QBLOCK, dk), 2, 0)
    ob = lax.map(lambda qq: dense_attention(qq, k, v, scale), qb)
    return jnp.moveaxis(ob, 0, 2).reshape(B, H, T, v.shape[-1])


def mlstm_chunked(q, k, v, log_i, log_f, state):
    B, H, T, d = q.shape
    L = ML_CHUNK
    nc = T // L

    def chunks(u):
        return jnp.moveaxis(u.reshape(B, H, nc, L, *u.shape[3:]), 2, 0)

    causal = jnp.tril(jnp.ones((L, L), bool))

    def step(carry, inp):
        C, n, m = carry
        qc, kc, vc, ic, fc = inp
        b = jnp.cumsum(fc, axis=-1)
        dmat = jnp.where(causal, b[..., :, None] - b[..., None, :] + ic[..., None, :], -jnp.inf)
        inter = b + m[..., None]
        mt = jnp.maximum(inter, jnp.max(dmat, axis=-1))
        w_intra = jnp.exp(dmat - mt[..., None])
        w_state = jnp.exp(inter - mt)
        s = jnp.einsum('bhtd,bhsd->bhts', qc, kc) * w_intra
        num = jnp.einsum('bhts,bhsd->bhtd', s, vc) + w_state[..., None] * jnp.einsum('bhde,bhte->bhtd', C, qc)
        den = jnp.sum(s, axis=-1) + w_state * jnp.einsum('bhd,bhtd->bht', n, qc)
        h = num / jnp.maximum(jnp.abs(den), jnp.exp(-mt))[..., None]
        bl = b[..., -1]
        g = bl[..., None] - b + ic
        m_new = jnp.maximum(bl + m, jnp.max(g, axis=-1))
        wg = jnp.exp(g - m_new[..., None])
        wc = jnp.exp(bl + m - m_new)
        C_new = wc[..., None, None] * C + jnp.einsum('bhs,bhsd,bhse->bhde', wg, vc, kc)
        n_new = wc[..., None] * n + jnp.einsum('bhs,bhsd->bhd', wg, kc)
        return (C_new, n_new, m_new), h

    state, hs = lax.scan(step, state, (chunks(q), chunks(k), chunks(v), chunks(log_i), chunks(log_f)))
    return state, jnp.moveaxis(hs, 0, 2).reshape(B, H, T, d)


def mlstm_mixer(lat, ctx, i_bias, f_bias, norm_g, with_ctx_out):
    def prep(parts):
        q, k, v, o, ig, fg = parts
        B, T, _ = q.shape
        heads = lambda u: u.astype(F32).reshape(B, T, ML_HEADS, ML_HD).transpose(0, 2, 1, 3)
        gate = lambda u, bias: jnp.transpose(u.astype(F32).reshape(B, T, 2, ML_HEADS) + bias.astype(F32), (2, 0, 3, 1))
        return (heads(q) * ML_HD ** -0.5, heads(k), heads(v), o,
                gate(ig, i_bias), jax.nn.log_sigmoid(gate(fg, f_bias)))

    ql, kl, vl, ol, il, fl = prep(lat)
    qc, kc, vc, oc, ic, fc = prep(ctx)
    B = ql.shape[0]
    zero = (jnp.zeros((B, ML_HEADS, ML_HD, ML_HD), F32), jnp.zeros((B, ML_HEADS, ML_HD), F32),
            jnp.zeros((B, ML_HEADS), F32))
    rev = lambda u: jnp.flip(u, axis=2)
    st_f, hc_f = mlstm_chunked(qc, kc, vc, ic[0], fc[0], zero)
    _, hl_f = mlstm_chunked(ql, kl, vl, il[0], fl[0], st_f)
    st_b, hc_b = mlstm_chunked(rev(qc), rev(kc), rev(vc), rev(ic[1]), rev(fc[1]), zero)
    _, hl_b = mlstm_chunked(rev(ql), rev(kl), rev(vl), rev(il[1]), rev(fl[1]), st_b)

    def finish(h, o):
        B_, H_, T_, d_ = h.shape
        h = rms_norm(h.transpose(0, 2, 1, 3), norm_g.reshape(ML_HEADS, ML_HD))
        out = h * jax.nn.sigmoid(o.astype(F32)).reshape(B_, T_, ML_HEADS, ML_HD)
        return out.reshape(B_, T_, ML_W).astype(o.dtype)

    out_l = finish(hl_f + rev(hl_b), ol)
    out_c = finish(hc_f + rev(hc_b), oc) if with_ctx_out else None
    return out_l, out_c


def ssd_chunked(x, dt, A, Bm, Cm, state):
    B, T, H, P = x.shape
    L = SSD_CHUNK
    nc = T // L

    def chunks(u):
        return jnp.moveaxis(u.reshape(B, nc, L, *u.shape[2:]), 1, 0)

    causal = jnp.tril(jnp.ones((L, L), bool))[None, :, :, None]

    def step(h, inp):
        xc, dtc, bc, cc = inp
        cum = jnp.cumsum(dtc * A, axis=1)
        decay = jnp.exp(jnp.where(causal, cum[:, :, None, :] - cum[:, None, :, :], -jnp.inf))
        w = jnp.einsum('bthn,bshn->btsh', cc, bc) * decay * dtc[:, None, :, :]
        y = (jnp.einsum('btsh,bshp->bthp', w, xc)
             + jnp.einsum('bthn,bhpn->bthp', cc, h) * jnp.exp(cum)[..., None])
        tail = jnp.exp(cum[:, -1:, :] - cum) * dtc
        h_new = h * jnp.exp(cum[:, -1, :])[..., None, None] + jnp.einsum('bsh,bshp,bshn->bhpn', tail, xc, bc)
        return h_new, y

    state, ys = lax.scan(step, state, (chunks(x), chunks(dt), chunks(Bm), chunks(Cm)))
    return state, jnp.moveaxis(ys, 0, 1).reshape(B, T, H, P)


def dwconv_centered(u, w, b):
    K = w.shape[0]
    out = lax.conv_general_dilated(u, w[:, None, :].astype(u.dtype), (1,), [(K // 2, K // 2)],
                                   dimension_numbers=('NWC', 'WIO', 'NWC'), feature_group_count=u.shape[-1])
    return out + b.astype(u.dtype)


def ssd_mixer(lat, ctx, conv_w, conv_b, dt_bias, A_log, D_skip, norm_g, with_ctx_out):
    A = -jnp.exp(A_log.astype(F32))
    rep = SSD_HEADS // SSD_GROUPS

    def prep(parts):
        z, xbc, dtr = parts
        B, T, _ = z.shape
        xbc = jax.nn.silu(dwconv_centered(xbc, conv_w, conv_b)).astype(F32)
        xs, bm, cm = jnp.split(xbc, [SSD_W, SSD_W + SSD_GROUPS * SSD_STATE], axis=-1)
        grp = lambda u: jnp.repeat(u.reshape(B, T, SSD_GROUPS, SSD_STATE), rep, axis=2)
        dt = jax.nn.softplus(dtr.astype(F32).reshape(B, T, 2, SSD_HEADS) + dt_bias.astype(F32))
        return z, xs.reshape(B, T, SSD_HEADS, SSD_HD), grp(bm), grp(cm), dt

    zl, xl, bl, cl, dtl = prep(lat)
    zc, xc, bc, cc, dtc = prep(ctx)
    B = xl.shape[0]
    zero = jnp.zeros((B, SSD_HEADS, SSD_HD, SSD_STATE), F32)
    rev = lambda u: jnp.flip(u, axis=1)
    st_f, yc_f = ssd_chunked(xc, dtc[:, :, 0], A[0], bc, cc, zero)
    _, yl_f = ssd_chunked(xl, dtl[:, :, 0], A[0], bl, cl, st_f)
    st_b, yc_b = ssd_chunked(rev(xc), rev(dtc[:, :, 1]), A[1], rev(bc), rev(cc), zero)
    _, yl_b = ssd_chunked(rev(xl), rev(dtl[:, :, 1]), A[1], rev(bl), rev(cl), st_b)

    def finish(yf, yb, xs, z):
        B_, T_ = z.shape[:2]
        y = yf + rev(yb) + D_skip.astype(F32)[:, None] * xs
        y = y.reshape(B_, T_, SSD_W) * jax.nn.silu(z.astype(F32))
        return rms_norm(y, norm_g).astype(z.dtype)

    out_l = finish(yl_f, yl_b, xl, zl)
    out_c = finish(yc_f, yc_b, xc, zc) if with_ctx_out else None
    return out_l, out_c


def mla_mixer(lat, ctx, q_norm, w_qb, kv_norm, w_kvb, gq, gk, rope, with_ctx_out):
    def prep(parts, rot):
        cq, ckv, kr = parts
        B, T, _ = cq.shape
        q = jnp.dot(rms_norm(cq, q_norm), w_qb).reshape(B, T, MLA_HEADS, MLA_QK)
        kv = jnp.dot(rms_norm(ckv, kv_norm), w_kvb).reshape(B, T, MLA_HEADS, MLA_NOPE + MLA_V)
        k_nope, v = jnp.split(kv, [MLA_NOPE], axis=-1)
        k = jnp.concatenate([k_nope, jnp.broadcast_to(kr[:, :, None, :], (B, T, MLA_HEADS, MLA_ROPE))], axis=-1)
        q = rms_norm(q, gq)
        k = rms_norm(k, gk)
        if rot is not None:
            cos, sin = rot
            q = jnp.concatenate([q[..., :MLA_NOPE], apply_rope(q[..., MLA_NOPE:], cos, sin)], axis=-1)
            k = jnp.concatenate([k[..., :MLA_NOPE], apply_rope(k[..., MLA_NOPE:], cos, sin)], axis=-1)
        t = lambda u: u.transpose(0, 2, 1, 3)
        return t(q), t(k), t(v)

    ql, kl, vl = prep(lat, rope)
    qc, kc, vc = prep(ctx, None)
    scale = MLA_QK ** -0.5
    k_all = jnp.concatenate([kl, kc], axis=2)
    v_all = jnp.concatenate([vl, vc], axis=2)
    merge = lambda o: o.transpose(0, 2, 1, 3).reshape(o.shape[0], o.shape[2], MLA_W)
    out_l = merge(blocked_attention(ql, k_all, v_all, scale))
    out_c = merge(dense_attention(qc, kc, vc, scale)) if with_ctx_out else None
    return out_l, out_c


def na_indices(rows, kh, kw):
    r = jnp.arange(rows)
    cidx = jnp.arange(GRID_W)
    r0 = jnp.clip(r - kh // 2, 0, rows - kh)
    c0 = jnp.clip(cidx - kw // 2, 0, GRID_W - kw)
    key_r = r0[:, None] + jnp.arange(kh)
    key_c = c0[:, None] + jnp.arange(kw)
    idx = key_r[:, None, :, None] * GRID_W + key_c[None, :, None, :]
    dr = key_r - r[:, None] + NA_KH - 1
    dc = key_c - cidx[:, None] + NA_KW - 1
    return idx.reshape(rows, GRID_W, kh * kw), dr, dc


def na_mixer(lat, ctx, gq, gk, rpb, with_ctx_out):
    def prep(parts):
        q, k, v = parts
        B, T, _ = q.shape
        heads = lambda u: u.reshape(B, T, NA_HEADS, NA_HD)
        t = lambda u: u.transpose(0, 2, 1, 3)
        return t(rms_norm(heads(q), gq)), t(rms_norm(heads(k), gk)), t(heads(v))

    ql, kl, vl = prep(lat)
    qc, kc, vc = prep(ctx)
    B, H, T, d = ql.shape
    rows = T // GRID_W
    kh = min(NA_KH, rows)
    nk = kh * NA_KW
    idx, dr, dc = na_indices(rows, kh, NA_KW)
    bias = rpb[:, dr[:, None, :, None], dc[None, :, None, :]]
    bias = bias.reshape(H, rows, GRID_W, nk).transpose(1, 0, 2, 3).astype(F32)
    scale = NA_HD ** -0.5
    q_rows = jnp.moveaxis(ql.reshape(B, H, rows, GRID_W, d), 2, 0)

    def row_step(args):
        q_row, idx_row, b_row = args
        k_nb = kl[:, :, idx_row]
        v_nb = vl[:, :, idx_row]
        s_nb = jnp.einsum('bhwd,bhwkd->bhwk', q_row, k_nb).astype(F32) * scale + b_row
        s_cx = jnp.einsum('bhwd,bhcd->bhwc', q_row, kc).astype(F32) * scale
        p = jax.nn.softmax(jnp.concatenate([s_nb, s_cx], axis=-1), axis=-1).astype(v_nb.dtype)
        return (jnp.einsum('bhwk,bhwkd->bhwd', p[..., :nk], v_nb)
                + jnp.einsum('bhwc,bhcd->bhwd', p[..., nk:], vc))

    o_rows = lax.map(row_step, (q_rows, idx, bias))
    merge = lambda o: o.transpose(0, 2, 1, 3).reshape(o.shape[0], o.shape[2], NA_W)
    out_l = merge(jnp.moveaxis(o_rows, 0, 2).reshape(B, H, T, d))
    out_c = merge(dense_attention(qc, kc, vc, scale)) if with_ctx_out else None
    return out_l, out_c


def swiglu(h, w1, w3, w2):
    return jnp.dot(jax.nn.silu(jnp.dot(h, w1)) * jnp.dot(h, w3), w2)


def moe_swiglu(h, router, w1, w3, w2):
    n_tok, d = h.shape
    n_exp = w1.shape[0]
    logits = jnp.dot(h, router).astype(F32)
    top_v, top_e = lax.top_k(logits, TOP_K)
    gates = jax.nn.softmax(top_v, axis=-1)
    flat_e = top_e.reshape(-1)
    flat_t = jnp.repeat(jnp.arange(n_tok, dtype=jnp.int32), TOP_K)
    flat_g = gates.reshape(-1)
    order = jnp.argsort(flat_e)
    se = flat_e[order]
    counts = jnp.bincount(flat_e, length=n_exp)
    padded = (counts + MOE_BLOCK - 1) // MOE_BLOCK * MOE_BLOCK
    pend = jnp.cumsum(padded)
    pstart = pend - padded
    sstart = jnp.cumsum(counts) - counts
    slot = pstart[se] + jnp.arange(flat_e.shape[0]) - sstart[se]
    n_blk = -(-flat_e.shape[0] // MOE_BLOCK) + n_exp
    n_slot = n_blk * MOE_BLOCK
    slot_tok = jnp.full((n_slot,), n_tok, jnp.int32).at[slot].set(flat_t[order])
    slot_gate = jnp.zeros((n_slot,), F32).at[slot].set(flat_g[order])
    blk_e = jnp.minimum(jnp.searchsorted(pend, jnp.arange(n_blk) * MOE_BLOCK, side='right'), n_exp - 1)
    h_pad = jnp.concatenate([h, jnp.zeros((1, d), h.dtype)], axis=0)
    xb = h_pad[slot_tok].reshape(n_blk, MOE_BLOCK, d)

    def expert_block(args):
        xe, e = args
        return jnp.dot(jax.nn.silu(jnp.dot(xe, w1[e])) * jnp.dot(xe, w3[e]), w2[e])

    yb = lax.map(expert_block, (xb, blk_e)).reshape(n_slot, d)
    out = jax.ops.segment_sum(yb * slot_gate[:, None].astype(yb.dtype), slot_tok, num_segments=n_tok + 1)
    return out[:n_tok]


def setup_inputs(seed: int = 0) -> dict:
    key = jax.random.key(seed)
    ks = iter(jax.random.split(key, 48))
    nrm = lambda shape, s: jax.random.normal(next(ks), shape, F32) * s
    L, D = DEPTH, D_MODEL
    nd, nm = (DEPTH + 1) // 2, DEPTH // 2
    x = nrm((BATCH, SEQ, D), 1.0)
    c = nrm((BATCH, D), 1.0)
    ctx = nrm((BATCH, CTX_LEN, D), 1.0)
    c_ctx = nrm((D,), 1.0)
    mod_w = nrm((L, D, 6 * D), 0.5 * D ** -0.5)
    mod_b = nrm((L, 6 * D), 0.02)
    norm1 = 1.0 + nrm((L, D), 0.05)
    w_in = nrm((L, D, D_IN), D ** -0.5)
    w_out = nrm((L, MIX_W, D), MIX_W ** -0.5)
    ml_i_bias = nrm((L, 2, ML_HEADS), 0.1)
    ml_f_bias = 3.0 + 3.0 * jax.random.uniform(next(ks), (L, 2, ML_HEADS), F32)
    ml_norm = 1.0 + nrm((L, ML_W), 0.05)
    ssd_conv_w = nrm((L, SSD_CONV, SSD_CONV_CH), SSD_CONV ** -0.5)
    ssd_conv_b = nrm((L, SSD_CONV_CH), 0.02)
    dt0 = jnp.exp(jax.random.uniform(next(ks), (L, 2, SSD_HEADS), F32, math.log(1e-3), math.log(1e-1)))
    ssd_dt_bias = dt0 + jnp.log(-jnp.expm1(-dt0))
    ssd_A_log = jnp.log(jax.random.uniform(next(ks), (L, 2, SSD_HEADS), F32, 1.0, 16.0))
    ssd_D = 1.0 + nrm((L, SSD_HEADS), 0.1)
    ssd_norm = 1.0 + nrm((L, SSD_W), 0.05)
    mla_q_norm = 1.0 + nrm((L, MLA_Q_RANK), 0.05)
    mla_w_qb = nrm((L, MLA_Q_RANK, MLA_HEADS * MLA_QK), MLA_Q_RANK ** -0.5)
    mla_kv_norm = 1.0 + nrm((L, MLA_KV_RANK), 0.05)
    mla_w_kvb = nrm((L, MLA_KV_RANK, MLA_HEADS * (MLA_NOPE + MLA_V)), MLA_KV_RANK ** -0.5)
    mla_gq = 1.0 + nrm((L, MLA_QK), 0.05)
    mla_gk = 1.0 + nrm((L, MLA_QK), 0.05)
    na_gq = 1.0 + nrm((L, NA_HD), 0.05)
    na_gk = 1.0 + nrm((L, NA_HD), 0.05)
    na_rpb = nrm((L, NA_HEADS, 2 * NA_KH - 1, 2 * NA_KW - 1), 0.1)
    norm2 = 1.0 + nrm((L, D), 0.05)
    ffn_w1 = nrm((nd, D, FFN_DENSE), D ** -0.5)
    ffn_w3 = nrm((nd, D, FFN_DENSE), D ** -0.5)
    ffn_w2 = nrm((nd, FFN_DENSE, D), FFN_DENSE ** -0.5)
    moe_router = nrm((nm, D, N_EXPERTS), D ** -0.5)
    moe_w1 = nrm((nm, N_EXPERTS, D, FFN_EXPERT), D ** -0.5)
    moe_w3 = nrm((nm, N_EXPERTS, D, FFN_EXPERT), D ** -0.5)
    moe_w2 = nrm((nm, N_EXPERTS, FFN_EXPERT, D), FFN_EXPERT ** -0.5)
    return {'x': x, 'c': c, 'ctx': ctx, 'c_ctx': c_ctx, 'mod_w': mod_w, 'mod_b': mod_b,
            'norm1': norm1, 'w_in': w_in, 'w_out': w_out,
            'ml_i_bias': ml_i_bias, 'ml_f_bias': ml_f_bias, 'ml_norm': ml_norm,
            'ssd_conv_w': ssd_conv_w, 'ssd_conv_b': ssd_conv_b, 'ssd_dt_bias': ssd_dt_bias,
            'ssd_A_log': ssd_A_log, 'ssd_D': ssd_D, 'ssd_norm': ssd_norm,
            'mla_q_norm': mla_q_norm, 'mla_w_qb': mla_w_qb, 'mla_kv_norm': mla_kv_norm,
            'mla_w_kvb': mla_w_kvb, 'mla_gq': mla_gq, 'mla_gk': mla_gk,
            'na_gq': na_gq, 'na_gk': na_gk, 'na_rpb': na_rpb, 'norm2': norm2,
            'ffn_w1': ffn_w1, 'ffn_w3': ffn_w3, 'ffn_w2': ffn_w2,
            'moe_router': moe_router, 'moe_w1': moe_w1, 'moe_w3': moe_w3, 'moe_w2': moe_w2}


def reference(x, c, ctx, c_ctx, mod_w, mod_b, norm1, w_in, w_out,
              ml_i_bias, ml_f_bias, ml_norm,
              ssd_conv_w, ssd_conv_b, ssd_dt_bias, ssd_A_log, ssd_D, ssd_norm,
              mla_q_norm, mla_w_qb, mla_kv_norm, mla_w_kvb, mla_gq, mla_gk,
              na_gq, na_gk, na_rpb, norm2,
              ffn_w1, ffn_w3, ffn_w2, moe_router, moe_w1, moe_w3, moe_w2):
    B, T, D = x.shape
    n_ctx = ctx.shape[1]
    rope = axial_rope(T, MLA_ROPE)
    silu_c = jax.nn.silu(c)
    silu_cc = jax.nn.silu(c_ctx)
    xc = ctx
    for l in range(DEPTH):
        with_ctx = l < DEPTH - 1
        mod = (jnp.dot(silu_c, mod_w[l]) + mod_b[l])[:, None, :]
        modc = (jnp.dot(silu_cc, mod_w[l]) + mod_b[l])[None, None, :]
        sh1, sc1, g1, sh2, sc2, g2 = jnp.split(mod, 6, axis=-1)
        sh1c, sc1c, g1c, sh2c, sc2c, g2c = jnp.split(modc, 6, axis=-1)

        h = rms_norm(x, norm1[l]) * (1.0 + sc1) + sh1
        hc = rms_norm(xc, norm1[l]) * (1.0 + sc1c) + sh1c
        pl = split_cols(jnp.dot(h, w_in[l]))
        pc = split_cols(jnp.dot(hc, w_in[l]))
        ml_l, ml_c = mlstm_mixer(pl[0:6], pc[0:6], ml_i_bias[l], ml_f_bias[l], ml_norm[l], with_ctx)
        ss_l, ss_c = ssd_mixer(pl[6:9], pc[6:9], ssd_conv_w[l], ssd_conv_b[l], ssd_dt_bias[l],
                               ssd_A_log[l], ssd_D[l], ssd_norm[l], with_ctx)
        la_l, la_c = mla_mixer(pl[9:12], pc[9:12], mla_q_norm[l], mla_w_qb[l], mla_kv_norm[l],
                               mla_w_kvb[l], mla_gq[l], mla_gk[l], rope, with_ctx)
        na_l, na_c = na_mixer(pl[12:15], pc[12:15], na_gq[l], na_gk[l], na_rpb[l], with_ctx)
        y = jnp.dot(jnp.concatenate([ml_l, ss_l, la_l, na_l], axis=-1), w_out[l])
        x = x + g1 * y
        if with_ctx:
            yc = jnp.dot(jnp.concatenate([ml_c, ss_c, la_c, na_c], axis=-1), w_out[l])
            xc = xc + g1c * yc

        h2 = rms_norm(x, norm2[l]) * (1.0 + sc2) + sh2
        tokens = h2.reshape(B * T, D)
        if with_ctx:
            h2c = rms_norm(xc, norm2[l]) * (1.0 + sc2c) + sh2c
            tokens = jnp.concatenate([tokens, h2c.reshape(B * n_ctx, D)], axis=0)
        if l % 2 == 0:
            f = swiglu(tokens, ffn_w1[l // 2], ffn_w3[l // 2], ffn_w2[l // 2])
        else:
            f = moe_swiglu(tokens, moe_router[l // 2], moe_w1[l // 2], moe_w3[l // 2], moe_w2[l // 2])
        x = x + g2 * f[:B * T].reshape(B, T, D)
        if with_ctx:
            xc = xc + g2c * f[B * T:].reshape(B, n_ctx, D)
    return x
```

```cpp
#include <hip/hip_runtime.h>
#include <cstdio>
#include <cstdint>

#define DI __device__ __forceinline__
#define LAS __attribute__((address_space(3)))
#define GAS __attribute__((address_space(1)))
typedef unsigned short bf16;
typedef short bf16x8 __attribute__((ext_vector_type(8)));
typedef float f32x4 __attribute__((ext_vector_type(4)));
typedef float f32x2 __attribute__((ext_vector_type(2)));
typedef unsigned u32x4 __attribute__((ext_vector_type(4)));
typedef unsigned u32x2 __attribute__((ext_vector_type(2)));

namespace pg8 {
constexpr int BM = 256, BK = 64, HALF = 128, HTB = HALF * BK * 2, STAGE_BYTES = 8 * HTB, NXCD = 8, WGM = 8;
__host__ __device__ __forceinline__ int lds_byte(int r, int c) { const int st = (r >> 4) * 2 + (c >> 5), rr = r & 15, cc = c & 31, ob = rr * 64 + cc * 2; return st * 1024 + (ob ^ (((ob >> 9) & 1) << 5)); }
__host__ __device__ __forceinline__ void stage_rc(int b, int& R, int& C) { const int st = b / 1024, sb = b % 1024, swz = sb ^ (((sb >> 9) & 1) << 5); R = (st >> 1) * 16 + swz / 64; C = (st & 1) * 32 + (swz % 64) / 2; }
__host__ __device__ __forceinline__ int perm32(int rho) { const int n = rho >> 4, i = rho & 15; return 8 * (i >> 2) + 4 * n + (i & 3); }

struct Unit { int pm, pn, pb; };
struct Gemm { const bf16* A; const bf16* Bt; int K; };

DI int xcd_remap(int L, int nwg) { const int q = nwg / NXCD, r = nwg % NXCD, xcd = L % NXCD, off = L / NXCD; return (xcd < r ? xcd * (q + 1) : r * (q + 1) + (xcd - r) * q) + off; }

struct StaticOrder {
    int nM, nN, nwg, G, c;
    DI void init(int nM_, int nN_, int G_, int c_) { nM = nM_; nN = nN_; nwg = nM * nN; G = G_; c = c_; }
    DI bool next(int i, Unit& u) const {
        const long L = (long)i * G + c; if (L >= nwg) return false;
        const int wgid = xcd_remap((int)L, nwg);
        const int nig = WGM * nN, gid = wgid / nig, fm = gid * WGM, gsz = (nM - fm) < WGM ? (nM - fm) : WGM;
        u.pm = fm + ((wgid % nig) % gsz); u.pn = (wgid % nig) / gsz; u.pb = u.pn; return true;
    }
};

DI unsigned cvt_pk_bf16(float lo, float hi) { unsigned r; asm volatile("v_cvt_pk_bf16_f32 %0, %1, %2" : "=v"(r) : "v"(lo), "v"(hi)); return r; }

template <class Epi, class Sched, bool ALIGN_EPI = true>
DI void gemm_phase(LAS unsigned char* lds, const Gemm g, const Sched& S, const Epi& E) {
    const int tid = threadIdx.x, wid = __builtin_amdgcn_readfirstlane(tid >> 6), lane = tid & 63, wr = wid >> 2, wc = wid & 3, fr = lane & 15, fq = lane >> 4;
    const int K = g.K, nt = K / BK;
    unsigned voffA[2], voffB[2];
#pragma unroll
    for (int i = 0; i < 2; ++i) { int R, C; stage_rc(tid * 16 + i * 8192, R, C); const int Rb = Epi::PERM ? ((R & ~31) + perm32(R & 31)) : R;
        voffA[i] = (unsigned)(R * K + C) * 2u; voffB[i] = (unsigned)(Rb * K + C) * 2u; }
    const size_t kstep = (size_t)(BK * 2);
    const size_t hstep = (size_t)HALF * K * 2;
    const size_t tstep = 2 * hstep;
    const unsigned ldsw = (unsigned)wid * 1024u;
    const int aoff = lds_byte(wr * 64 + fr, fq * 8), boff = lds_byte(wc * 32 + fr, fq * 8);
#define PG8_SA(b, h) (((b) * 2 + (h)) * HTB)
#define PG8_SB(b, h) ((4 + (b) * 2 + (h)) * HTB)
#define PG8_STAGE(bufoff, gbase, voff) do { _Pragma("unroll") for (int _i = 0; _i < 2; ++_i) \
        __builtin_amdgcn_global_load_lds((const unsigned*)((const char*)(gbase) + (voff)[_i]), (LAS unsigned*)(lds + (bufoff) + ldsw + _i * 8192), 16, 0, 0); } while (0)
#define PG8_LDA(dst, b, h) do { _Pragma("unroll") for (int m = 0; m < 4; ++m) _Pragma("unroll") for (int k = 0; k < 2; ++k) dst[m][k] = *(const LAS bf16x8*)(lds + PG8_SA(b, h) + aoff + m * 2048 + k * 1024); } while (0)
#define PG8_LDB(dst, b, h) do { _Pragma("unroll") for (int n = 0; n < 2; ++n) _Pragma("unroll") for (int k = 0; k < 2; ++k) dst[n][k] = *(const LAS bf16x8*)(lds + PG8_SB(b, h) + boff + n * 2048 + k * 1024); } while (0)
#define PG8_MMA(ai, bj, At, Bt) do { __builtin_amdgcn_s_setprio(1); _Pragma("unroll") for (int m = 0; m < 4; ++m) _Pragma("unroll") for (int n = 0; n < 2; ++n) _Pragma("unroll") for (int k = 0; k < 2; ++k) \
        acc[ai][bj][m][n] = __builtin_amdgcn_mfma_f32_16x16x32_bf16(Bt[n][k], At[m][k], acc[ai][bj][m][n], 0, 0, 0); __builtin_amdgcn_s_setprio(0); } while (0)
#define PG8_WAIT_V(n) asm volatile("s_waitcnt vmcnt(" #n ")" ::: "memory")
#define PG8_WAIT_L(n) asm volatile("s_waitcnt lgkmcnt(" #n ")" ::: "memory")
#define PG8_BAR __builtin_amdgcn_s_barrier()
#define PG8_SCHED __builtin_amdgcn_sched_barrier(0)
    Unit cur, nxt; int ui = 0;
    if (!S.next(0, cur)) return;
    f32x4 acc[2][2][4][2];
#pragma unroll
    for (int a = 0; a < 2; ++a)
#pragma unroll
        for (int b = 0; b < 2; ++b)
#pragma unroll
            for (int m = 0; m < 4; ++m)
#pragma unroll
                for (int n = 0; n < 2; ++n) acc[a][b][m][n] = (f32x4){0.f, 0.f, 0.f, 0.f};
    bf16x8 At[4][2], B0[2][2], B1[2][2];
    const char* cA = (const char*)g.A + (size_t)cur.pm * tstep; const char* cB = (const char*)g.Bt + (size_t)cur.pb * tstep;
    {
        PG8_STAGE(PG8_SB(0, 0), cB, voffB); PG8_STAGE(PG8_SB(0, 1), cB + hstep, voffB); PG8_STAGE(PG8_SA(0, 0), cA, voffA); PG8_STAGE(PG8_SA(0, 1), cA + hstep, voffA);
        if (wr == 1) PG8_BAR;
        PG8_WAIT_V(2); PG8_BAR;
        PG8_STAGE(PG8_SB(1, 0), cB + kstep, voffB); PG8_STAGE(PG8_SA(1, 0), cA + kstep, voffA); PG8_STAGE(PG8_SB(1, 1), cB + hstep + kstep, voffB);
        PG8_WAIT_V(6); PG8_BAR;
    }
    for (;;) {
        const bool has_next = S.next(ui + 1, nxt);
        const char* nA = has_next ? (const char*)g.A + (size_t)nxt.pm * tstep : cA; const char* nB = has_next ? (const char*)g.Bt + (size_t)nxt.pb * tstep : cB;
        for (int t = 0; t < nt; t += 2) {
            const bool last = (t == nt - 2);
            const char* a1 = cA + (size_t)(t + 1) * kstep;
            const char* a2 = last ? nA : cA + (size_t)(t + 2) * kstep; const char* b2 = last ? nB : cB + (size_t)(t + 2) * kstep;
            const char* a3 = a2 + kstep; const char* b3 = b2 + kstep;
            PG8_LDB(B0, 0, 0); PG8_LDB(B1, 0, 1); PG8_SCHED; PG8_LDA(At, 0, 0); PG8_STAGE(PG8_SA(1, 1), a1 + hstep, voffA);
            PG8_WAIT_V(8); PG8_WAIT_L(0); PG8_BAR; PG8_MMA(0, 0, At, B0); PG8_MMA(0, 1, At, B1); PG8_BAR; PG8_SCHED;
            PG8_LDA(At, 0, 1); PG8_STAGE(PG8_SB(0, 0), b2, voffB); PG8_STAGE(PG8_SB(0, 1), b2 + hstep, voffB); PG8_STAGE(PG8_SA(0, 0), a2, voffA);
            PG8_WAIT_V(8); PG8_WAIT_L(0); PG8_BAR; PG8_MMA(1, 0, At, B0); PG8_MMA(1, 1, At, B1); PG8_BAR; PG8_SCHED;
            PG8_LDB(B0, 1, 0); PG8_LDB(B1, 1, 1); PG8_SCHED; PG8_LDA(At, 1, 0); PG8_STAGE(PG8_SA(0, 1), a2 + hstep, voffA);
            PG8_WAIT_V(8); PG8_WAIT_L(0); PG8_BAR; PG8_MMA(0, 0, At, B0); PG8_MMA(0, 1, At, B1); PG8_BAR; PG8_SCHED;
            PG8_LDA(At, 1, 1); PG8_STAGE(PG8_SB(1, 0), b3, voffB); PG8_STAGE(PG8_SB(1, 1), b3 + hstep, voffB); PG8_STAGE(PG8_SA(1, 0), a3, voffA);
            PG8_WAIT_V(8); PG8_WAIT_L(0); PG8_BAR; PG8_MMA(1, 0, At, B0); PG8_MMA(1, 1, At, B1); PG8_BAR; PG8_SCHED;
        }
        if constexpr (ALIGN_EPI) { if (wr == 0) PG8_BAR; }
        E(acc, cur, wr, wc, fr, fq);
        if (!has_next) break;
#pragma unroll
        for (int a = 0; a < 2; ++a)
#pragma unroll
            for (int b = 0; b < 2; ++b)
#pragma unroll
                for (int m = 0; m < 4; ++m)
#pragma unroll
                    for (int n = 0; n < 2; ++n) acc[a][b][m][n] = (f32x4){0.f, 0.f, 0.f, 0.f};
        cur = nxt; cA = nA; cB = nB; ++ui;
        if constexpr (ALIGN_EPI) { if (wr == 1) PG8_BAR; }
    }
    PG8_WAIT_V(0);
    if constexpr (!ALIGN_EPI) { if (wr == 0) PG8_BAR; }
    PG8_BAR;
#undef PG8_SA
#undef PG8_SB
#undef PG8_STAGE
#undef PG8_LDA
#undef PG8_LDB
#undef PG8_MMA
#undef PG8_WAIT_V
#undef PG8_WAIT_L
#undef PG8_BAR
#undef PG8_SCHED
}
}
constexpr int D = 2048, NB = 4, TL = 2048, TC = 256, TS = TL + TC  ;
constexpr int MLAT = NB * TL  , MTOK = NB * (TL + TC)  ;
constexpr int DIN = 5824, DINP = 5888, D6 = 6 * D;
constexpr int FF = 5632, FE = 7168, NEXP = 8;
constexpr float EPS = 1e-6f;
constexpr int PC_MLQ = 0, PC_MLK = 512, PC_MLV = 1024, PC_MLO = 1536, PC_IG = 2048, PC_FG = 2056, PC_Z = 2064, PC_XBC = 2576, PC_DT = 3600,
              PC_CQ = 3616, PC_CKV = 4064, PC_KR = 4224, PC_NQ = 4288, PC_NK = 4800, PC_NV = 5312;
constexpr int NCHUNK = 36;
constexpr int MAXMT = 72;

constexpr size_t MiB = 1u << 20;
constexpr size_t WS_CTL = 0, CTL_ZERO_BYTES = 1 * MiB;
constexpr size_t WS_MOD = 1 * MiB;
constexpr size_t WS_WIN = 2 * MiB;
constexpr size_t WS_WOUT = WS_WIN + 46 * MiB;
constexpr size_t WS_WQB = WS_WOUT + 16 * MiB;
constexpr size_t WS_WKVB = WS_WQB + 2 * MiB;
constexpr size_t WS_W13 = WS_WKVB + 1 * MiB;
constexpr size_t WS_W2 = WS_W13 + 44 * MiB;
constexpr size_t WS_MW13 = WS_W2 + 22 * MiB;
constexpr size_t WS_MW2 = WS_MW13 + 448 * MiB;
constexpr size_t WS_HN = WS_MW2 + 224 * MiB;
constexpr size_t WS_A2 = WS_HN + 36 * MiB;
constexpr size_t WS_X = WS_A2 + 36 * MiB;
constexpr size_t WS_BIG = WS_X + 72 * MiB;
constexpr size_t WS_P = WS_BIG;
constexpr size_t WS_CQN = WS_P + 207 * MiB;
constexpr size_t WS_CKVN = WS_CQN + 9 * MiB;
constexpr size_t WS_QRAW = WS_CKVN + 5 * MiB;
constexpr size_t WS_KVRAW = WS_QRAW + 14 * MiB;
constexpr size_t WS_QMLA = WS_KVRAW + 18 * MiB;
constexpr size_t WS_KMLA = WS_QMLA + 14 * MiB;
constexpr size_t WS_VTMLA = WS_KMLA + 14 * MiB;
constexpr size_t WS_QNA = WS_VTMLA + 9 * MiB;
constexpr size_t WS_KNA = WS_QNA + 9 * MiB;
constexpr size_t WS_VTNA = WS_KNA + 9 * MiB;
constexpr size_t WS_XBC = WS_VTNA + 9 * MiB;
constexpr size_t WS_DT = WS_XBC + 18 * MiB;
constexpr size_t WS_GATES = WS_DT + 1 * MiB;
constexpr size_t WS_MLSC = WS_GATES + 1 * MiB;
constexpr size_t WS_SSSC = WS_MLSC + 64 * 1024;
constexpr size_t WS_MLU = WS_MLSC + 1 * MiB;
constexpr size_t WS_MLS = WS_MLU + 73 * MiB;
constexpr size_t WS_SSU = WS_MLS + 37 * MiB;
constexpr size_t WS_SSS = WS_SSU + 72 * MiB;
constexpr size_t WS_HML = WS_SSS + 36 * MiB;
constexpr size_t WS_YSS = WS_HML + 36 * MiB;
constexpr size_t WS_MIXEND = WS_YSS + 36 * MiB;
constexpr size_t WS_G = WS_BIG;
constexpr size_t WS_Y = WS_G + 252 * MiB;
constexpr size_t WS_XG = WS_Y + 144 * MiB;
constexpr size_t WS_TOK = WS_XG + 72 * MiB;
constexpr size_t WS_FFNEND = WS_TOK + 1 * MiB;
constexpr size_t WS_END = (WS_MIXEND > WS_FFNEND ? WS_MIXEND : WS_FFNEND);
static_assert(WS_END < (size_t)1800 * MiB, "workspace budget");
static_assert((size_t)MTOK * DINP * 4 <= 207 * MiB && (size_t)32 * 36 * 129 * 128 * 4 <= 73 * MiB, "sizes");
constexpr int CW_BAR = 4096;
constexpr int CW_MOE = 16384;

constexpr int RING_BYTES = 131072;
constexpr int MISC_OFF = 147456 - 256;
constexpr int LDS_BYTES = 147456;
constexpr int NWAVES = 8, NTHR = 512;

#define RLX_AGENT __ATOMIC_RELAXED, __HIP_MEMORY_SCOPE_AGENT
#define LDS_WAIT() asm volatile("s_waitcnt lgkmcnt(0)" ::: "memory")
#define VM_WAIT() asm volatile("s_waitcnt vmcnt(0)" ::: "memory")
DI unsigned f2bf(float f) { unsigned u = __builtin_bit_cast(unsigned, f); return (u + 0x7fffu + ((u >> 16) & 1u)) >> 16; }
DI unsigned pk2(float lo, float hi) { return f2bf(lo) | (f2bf(hi) << 16); }
DI float bf2f(unsigned b) { return __builtin_bit_cast(float, b << 16); }
DI float wave_sum(float v) {
#pragma unroll
    for (int o = 1; o < 64; o <<= 1) v += __shfl_xor(v, o);
    return v;
}
DI float wave_max(float v) {
#pragma unroll
    for (int o = 1; o < 64; o <<= 1) v = fmaxf(v, __shfl_xor(v, o));
    return v;
}
DI float wave_incl_scan(float v, int lane) {
#pragma unroll
    for (int o = 1; o < 64; o <<= 1) { const float t = __shfl_up(v, o); if (lane >= o) v += t; }
    return v;
}
DI float siluf(float x) { return x / (1.f + __expf(-x)); }
DI float sigmoidf_(float x) { return 1.f / (1.f + __expf(-x)); }
DI float softplusf_(float x) { return fmaxf(x, 0.f) + log1pf(__expf(-fabsf(x))); }
DI float logsigmoidf_(float x) { return fminf(x, 0.f) - log1pf(__expf(-fabsf(x))); }

#define XB_TMO      128
#define XB_XCNT(j)  (256  + 64 * (j))
#define XB_XSUB(j)  (1280 + 64 * (j))
#define XB_XGEN(j)  (2304 + 64 * (j))
#define XB_TOP      3328
#define XB_TOPGEN   3392
#define XCD_BAR_WORDS 3456
#define XB_SPIN_CAP (1u << 22)
DI unsigned xb_ld(unsigned* p)              { return __hip_atomic_load(p, __ATOMIC_RELAXED, __HIP_MEMORY_SCOPE_AGENT); }
DI unsigned xb_add(unsigned* p, unsigned v) { return __hip_atomic_fetch_add(p, v, __ATOMIC_RELAXED, __HIP_MEMORY_SCOPE_AGENT); }
DI unsigned xb_xcc_id() { return (unsigned)__builtin_amdgcn_s_getreg((3 << 11) | 20) & 0xFu; }
#define XB_SPIN(cond, bar) do { unsigned _sp = 0; while (cond) { __builtin_amdgcn_s_sleep(1); \
    if ((++_sp & 255u) == 0u) { if (xb_ld(&(bar)[XB_TMO])) break; if (_sp > XB_SPIN_CAP) { atomicAdd(&(bar)[XB_TMO], 1u); break; } } } } while (0)
struct XcdBarrier { unsigned* bar; unsigned x; volatile LAS unsigned* st; };
DI XcdBarrier xcd_barrier_post(unsigned* bar, volatile LAS unsigned* st) {
    XcdBarrier b; b.bar = bar; b.x = xb_xcc_id(); b.st = st;
    if (threadIdx.x == 0) (void)xb_add(&bar[XB_XCNT(b.x)], 1u);
    return b;
}
DI void xcd_barrier_complete(unsigned* bar, unsigned x, unsigned& nloc, unsigned& nx) {
    const unsigned G = gridDim.x * gridDim.y * gridDim.z;
    unsigned sum, cnt, mine, sp = 0u;
    for (;;) {
        sum = 0u; cnt = 0u; mine = 0u;
#pragma unroll
        for (unsigned j = 0; j < 16; ++j) { const unsigned c = xb_ld(&bar[XB_XCNT(j)]); sum += c; cnt += (c > 0u) ? 1u : 0u; mine = (j == x) ? c : mine; }
        if (sum == G) break;
        __builtin_amdgcn_s_sleep(1);
        if ((++sp & 255u) == 0u) { if (xb_ld(&bar[XB_TMO])) break; if (sp > XB_SPIN_CAP) { atomicAdd(&bar[XB_TMO], 1u); break; } }
    }
    nloc = mine > 0u ? mine : 1u; nx = cnt > 0u ? cnt : 1u;
}
DI void xcd_barrier(const XcdBarrier& b) {
    asm volatile("s_waitcnt vmcnt(0)" ::: "memory");
    __syncthreads();
    if (threadIdx.x == 0) {
        unsigned* bar = b.bar;
        __builtin_amdgcn_s_waitcnt(0);
        unsigned nloc = b.st[0], nx = b.st[1];
        if (nloc == 0u) { xcd_barrier_complete(bar, b.x, nloc, nx); b.st[0] = nloc; b.st[1] = nx; }
        const unsigned old = xb_add(&bar[XB_XSUB(b.x)], 1u);
        const unsigned gen = old / nloc;
        if (old + 1u == (gen + 1u) * nloc) {
            __builtin_amdgcn_fence(__ATOMIC_RELEASE, "agent");
            asm volatile("s_waitcnt vmcnt(0)" ::: "memory");
            const unsigned og = xb_add(&bar[XB_TOP], 1u);
            const unsigned tg = og / nx;
            if (og + 1u == (tg + 1u) * nx) xb_add(&bar[XB_TOPGEN], 1u);
            else XB_SPIN(xb_ld(&bar[XB_TOPGEN]) == tg, bar);
            __builtin_amdgcn_fence(__ATOMIC_ACQUIRE, "agent");
            xb_add(&bar[XB_XGEN(b.x)], 1u);
            asm volatile("s_waitcnt vmcnt(0)" ::: "memory");
        } else {
            XB_SPIN(xb_ld(&bar[XB_XGEN(b.x)]) == gen, bar);
            __builtin_amdgcn_fence(__ATOMIC_ACQUIRE, "agent");
            asm volatile("s_waitcnt vmcnt(0)" ::: "memory");
        }
    }
    __syncthreads();
}

struct Args { const float* in[35]; float* out; unsigned char* ws; int ph_lo, ph_hi; };
struct Frame {
    LAS unsigned char* lds;
    unsigned char* ws;
    const float* in[35];
    float* out;
    int tid, lane, wave, G, bid;
};
#define WSP(T, off) ((T*)(F.ws + (off)))
DI int rowof(int b, int j) { return j < TL ? b * TL + j : MLAT + b * TC + (j - TL); }

template <int K> DI f32x4 mma16(const LAS bf16* A, int lda, const LAS bf16* Bt, int ldb, int lane, f32x4 acc) {
    const int r = lane & 15, q = lane >> 4;
    const LAS bf16* pa = A + r * lda + 8 * q; const LAS bf16* pb = Bt + r * ldb + 8 * q;
#pragma unroll
    for (int k = 0; k < K; k += 32) {
        const bf16x8 a = *(const LAS bf16x8*)(pa + k); const bf16x8 b = *(const LAS bf16x8*)(pb + k);
        acc = __builtin_amdgcn_mfma_f32_16x16x32_bf16(a, b, acc, 0, 0, 0);
    }
    return acc;
}
DI void tr_item(const float* src, size_t ld, int Kv, int Nv, int k0, int n0, bf16* dst, size_t Kd, int dn0, LAS float* scr, int lane) {
    const int nn = 4 * (lane & 15), kq = lane >> 4;
    f32x4 v[16];
#pragma unroll
    for (int i = 0; i < 16; ++i) { const int kk = 4 * i + kq;
        v[i] = (f32x4){0.f, 0.f, 0.f, 0.f};
        if (k0 + kk < Kv && n0 + nn < Nv) v[i] = *(const f32x4*)(src + (size_t)(k0 + kk) * ld + n0 + nn); }
#pragma unroll
    for (int i = 0; i < 16; ++i) { const int kk = 4 * i + kq; LAS float* s = scr + kk * 65 + nn; s[0] = v[i][0]; s[1] = v[i][1]; s[2] = v[i][2]; s[3] = v[i][3]; }
    LDS_WAIT(); asm volatile("" ::: "memory");
    const int c = lane & 7;
#pragma unroll
    for (int j = 0; j < 8; ++j) { const int n = (lane >> 3) + 8 * j; const LAS float* s = scr + (8 * c) * 65 + n;
        u32x4 o; o.x = pk2(s[0 * 65], s[1 * 65]); o.y = pk2(s[2 * 65], s[3 * 65]); o.z = pk2(s[4 * 65], s[5 * 65]); o.w = pk2(s[6 * 65], s[7 * 65]);
        *(u32x4*)(dst + (size_t)(dn0 + n) * Kd + k0 + 8 * c) = o; }
    LDS_WAIT(); asm volatile("" ::: "memory");
}
DI int il_row(int n0, int which) { return (n0 >> 7) * 256 + (n0 & 127) + which * 128; }

DI void p0_prologue(Frame& F) {
    {
        LAS float* sc = (LAS float*)F.lds;
        LAS float* red = (LAS float*)(F.lds + 5 * 2048 * 4);
        bool have = false;
        for (int u = F.bid; u < 2 * 96; u += F.G) {
            if (!have) {
                for (int i = F.tid; i < 5 * 2048; i += NTHR) { const float x = (i < 4 * 2048) ? F.in[1][i] : F.in[3][i - 4 * 2048]; sc[i] = siluf(x); }
                have = true;
            }
            __syncthreads();
            const int l = u / 96, j0 = (u % 96) * 128;
            const float* W = F.in[4] + (size_t)l * D * D6 + j0 + 2 * F.lane;
            f32x2 acc[5];
#pragma unroll
            for (int r = 0; r < 5; ++r) acc[r] = (f32x2){0.f, 0.f};
            const int kb = F.wave * 256;
            for (int k = 0; k < 256; k += 8) {
                f32x2 w[8];
#pragma unroll
                for (int i = 0; i < 8; ++i) w[i] = *(const f32x2*)(W + (size_t)(kb + k + i) * D6);
#pragma unroll
                for (int i = 0; i < 8; ++i)
#pragma unroll
                    for (int r = 0; r < 5; ++r) { const float s = sc[r * 2048 + kb + k + i]; acc[r] += w[i] * s; }
            }
#pragma unroll
            for (int r = 0; r < 5; ++r) { red[(F.wave * 5 + r) * 128 + 2 * F.lane] = acc[r][0]; red[(F.wave * 5 + r) * 128 + 2 * F.lane + 1] = acc[r][1]; }
            __syncthreads();
            for (int i = F.tid; i < 5 * 128; i += NTHR) { const int r = i / 128, j = i % 128; float s = F.in[5][l * D6 + j0 + j];
#pragma unroll
                for (int w = 0; w < 8; ++w) s += red[(w * 5 + r) * 128 + j];
                WSP(float, WS_MOD)[(l * 5 + r) * D6 + j0 + j] = s; }
        }
        __syncthreads();
    }
    LAS float* scr = (LAS float*)(F.lds + F.wave * 16640);
    const int gw = F.bid * NWAVES + F.wave, NGW = F.G * NWAVES;
    constexpr int I_IN = 32 * 92, I_OUT = 32 * 32, I_QB = 8 * 12, I_KVB = 4 * 16, I_F1 = 32 * 88, I_F2 = 88 * 32, I_M1 = 32 * 112, I_M2 = 112 * 32;
    constexpr int NITEMS = 2 * (I_IN + I_OUT + I_QB + I_KVB) + 2 * I_F1 + I_F2 + NEXP * (2 * I_M1 + I_M2);
    for (int it = gw; it < NITEMS; it += NGW) {
        int r = it;
        if (r < NEXP * 2 * I_M1) { const int e = r / (2 * I_M1); r -= e * 2 * I_M1; const int which = r / I_M1; r -= which * I_M1; const int kb = r / 112, nb = r % 112;
            tr_item((which ? F.in[33] : F.in[32]) + (size_t)e * D * FE, FE, D, FE, 64 * kb, 64 * nb, WSP(bf16, WS_MW13) + (size_t)e * 2 * FE * D, D, il_row(64 * nb, which), scr, F.lane); continue; }
        r -= NEXP * 2 * I_M1;
        if (r < NEXP * I_M2) { const int e = r / I_M2; r -= e * I_M2; const int kb = r / 32, nb = r % 32;
            tr_item(F.in[34] + (size_t)e * FE * D, D, FE, D, 64 * kb, 64 * nb, WSP(bf16, WS_MW2) + (size_t)e * D * FE, FE, 64 * nb, scr, F.lane); continue; }
        r -= NEXP * I_M2;
        if (r < 2 * I_IN) { const int l = r / I_IN; r -= l * I_IN; const int kb = r / 92, nb = r % 92;
            tr_item(F.in[7] + (size_t)l * D * DIN, DIN, D, DIN, 64 * kb, 64 * nb, WSP(bf16, WS_WIN) + (size_t)l * DINP * D, D, 64 * nb, scr, F.lane); continue; }
        r -= 2 * I_IN;
        if (r < 2 * I_OUT) { const int l = r / I_OUT; r -= l * I_OUT; const int kb = r / 32, nb = r % 32;
            tr_item(F.in[8] + (size_t)l * D * D, D, D, D, 64 * kb, 64 * nb, WSP(bf16, WS_WOUT) + (size_t)l * D * D, D, 64 * nb, scr, F.lane); continue; }
        r -= 2 * I_OUT;
        if (r < 2 * I_QB) { const int l = r / I_QB; r -= l * I_QB; const int kb = r / 12, nb = r % 12;
            tr_item(F.in[19] + (size_t)l * 448 * 768, 768, 448, 768, 64 * kb, 64 * nb, WSP(bf16, WS_WQB) + (size_t)l * 768 * 512, 512, 64 * nb, scr, F.lane); continue; }
        r -= 2 * I_QB;
        if (r < 2 * I_KVB) { const int l = r / I_KVB; r -= l * I_KVB; const int kb = r / 16, nb = r % 16;
            tr_item(F.in[21] + (size_t)l * 160 * 1024, 1024, 160, 1024, 64 * kb, 64 * nb, WSP(bf16, WS_WKVB) + (size_t)l * 1024 * 256, 256, 64 * nb, scr, F.lane); continue; }
        r -= 2 * I_KVB;
        if (r < 2 * I_F1) { const int which = r / I_F1; r -= which * I_F1; const int kb = r / 88, nb = r % 88;
            tr_item((which ? F.in[29] : F.in[28]), FF, D, FF, 64 * kb, 64 * nb, WSP(bf16, WS_W13), D, il_row(64 * nb, which), scr, F.lane); continue; }
        r -= 2 * I_F1;
        { const int kb = r / 32, nb = r % 32;
            tr_item(F.in[30], D, FF, D, 64 * kb, 64 * nb, WSP(bf16, WS_W2), FF, 64 * nb, scr, F.lane); }
    }
}
template <bool ROUTE>
DI void norm_phase(Frame& F, int l, const float* srcLat, const float* srcCtx, const float* g, int shoff, int nrows) {
    LAS float* rl = (LAS float*)F.lds;
    if (ROUTE) { for (int i = F.tid; i < D * NEXP; i += NTHR) rl[i] = F.in[31][i]; __syncthreads(); }
    const int gw = F.bid * NWAVES + F.wave, NGW = F.G * NWAVES;
    bf16* HN = WSP(bf16, WS_HN);
    for (int row = gw; row < nrows; row += NGW) {
        const float* xr = row < MLAT ? srcLat + (size_t)row * D : srcCtx + (size_t)(row - MLAT) * D;
        const int br = row < MLAT ? row / TL : 4;
        const float* mrow = WSP(float, WS_MOD) + (size_t)(l * 5 + br) * D6 + shoff;
        f32x4 v[8]; float ss = 0.f;
#pragma unroll
        for (int j = 0; j < 8; ++j) { v[j] = *(const f32x4*)(xr + 4 * F.lane + 256 * j); ss += (v[j][0] * v[j][0] + v[j][1] * v[j][1]) + (v[j][2] * v[j][2] + v[j][3] * v[j][3]); }
        const float rstd = 1.0f / sqrtf(wave_sum(ss) * (1.f / D) + EPS);
        float lg[8];
        if (ROUTE) {
#pragma unroll
            for (int e = 0; e < 8; ++e) lg[e] = 0.f; }
#pragma unroll
        for (int j = 0; j < 8; ++j) { const int c = 4 * F.lane + 256 * j;
            const f32x4 gg = *(const f32x4*)(g + c), sh = *(const f32x4*)(mrow + c), sc = *(const f32x4*)(mrow + D + c);
            f32x4 o;
#pragma unroll
            for (int i = 0; i < 4; ++i) o[i] = v[j][i] * rstd * gg[i] * (1.f + sc[i]) + sh[i];
            u32x2 w; w.x = pk2(o[0], o[1]); w.y = pk2(o[2], o[3]);
            *(u32x2*)(HN + (size_t)row * D + c) = w;
            if (ROUTE) {
#pragma unroll
                for (int i = 0; i < 4; ++i) { const f32x4 r0 = *(const LAS f32x4*)(rl + (c + i) * 8), r1 = *(const LAS f32x4*)(rl + (c + i) * 8 + 4);
                    lg[0] += o[i] * r0[0]; lg[1] += o[i] * r0[1]; lg[2] += o[i] * r0[2]; lg[3] += o[i] * r0[3];
                    lg[4] += o[i] * r1[0]; lg[5] += o[i] * r1[1]; lg[6] += o[i] * r1[2]; lg[7] += o[i] * r1[3]; }
                __builtin_amdgcn_sched_barrier(0);
            }
        }
        if (ROUTE) {
#pragma unroll
            for (int e = 0; e < 8; ++e) lg[e] = wave_sum(lg[e]);
            if (F.lane == 0) {
                int e1 = 0; float v1 = lg[0];
#pragma unroll
                for (int e = 1; e < 8; ++e) if (lg[e] > v1) { v1 = lg[e]; e1 = e; }
                int e2 = -1; float v2 = -3.0e38f;
#pragma unroll
                for (int e = 0; e < 8; ++e) if (e != e1 && lg[e] > v2) { v2 = lg[e]; e2 = e; }
                const float g2 = 1.f / (1.f + expf(v1 - v2)), g1 = 1.f - g2;
                unsigned* cnt = WSP(unsigned, WS_CTL) + CW_MOE;
                const unsigned p1 = __hip_atomic_fetch_add(cnt + e1, 1u, RLX_AGENT), p2 = __hip_atomic_fetch_add(cnt + e2, 1u, RLX_AGENT);
                int* tk = WSP(int, WS_TOK) + (size_t)row * 8;
                tk[0] = e1; tk[1] = (int)p1; tk[2] = e2; tk[3] = (int)p2; ((float*)tk)[4] = g1; ((float*)tk)[5] = g2;
            }
        }
    }
}

DI void moe_tables(Frame& F, LAS int* tb, int NT) {
    if (F.tid == 0) {
        const unsigned* cnt = WSP(unsigned, WS_CTL) + CW_MOE; int ts = 0, us = 0;
        for (int e = 0; e < 8; ++e) { const int c = (int)__hip_atomic_load(cnt + e, RLX_AGENT); const int t = (c + 255) >> 8; tb[e] = c; tb[8 + e] = t; tb[16 + e] = ts; tb[32 + e] = us; ts += t; us += t * NT; }
        tb[24] = ts; tb[40] = us;
    }
    __syncthreads();
}
DI void moe_gather_phase(Frame& F) {
    LAS int* tb = (LAS int*)F.lds; moe_tables(F, tb, 1);
    const int gw = F.bid * NWAVES + F.wave, NGW = F.G * NWAVES;
    const bf16* HN = WSP(bf16, WS_HN); bf16* XG = WSP(bf16, WS_XG);
    for (int row = gw; row < MLAT; row += NGW) {
        int* tk = WSP(int, WS_TOK) + (size_t)row * 8;
        const int e1 = tk[0], p1 = tk[1], e2 = tk[2], p2 = tk[3];
        const int s1 = tb[16 + e1] * 256 + p1, s2 = tb[16 + e2] * 256 + p2;
        const u32x4* src = (const u32x4*)(HN + (size_t)row * D) + F.lane;
        u32x4 a[4];
#pragma unroll
        for (int j = 0; j < 4; ++j) a[j] = src[64 * j];
        u32x4* d1 = (u32x4*)(XG + (size_t)s1 * D) + F.lane; u32x4* d2 = (u32x4*)(XG + (size_t)s2 * D) + F.lane;
#pragma unroll
        for (int j = 0; j < 4; ++j) { d1[64 * j] = a[j]; d2[64 * j] = a[j]; }
        if (F.lane == 0) { tk[6] = s1; tk[7] = s2; }
    }
    const int nrow = tb[24] * 256;
    for (int r = gw; r < nrow; r += NGW) {
        const int t = r >> 8; int e = 0;
#pragma unroll
        for (int k = 1; k < 8; ++k) if (t >= tb[16 + k]) e = k;
        const int local = r - tb[16 + e] * 256;
        if (local >= tb[e]) { u32x4* d = (u32x4*)(XG + (size_t)r * D) + F.lane; const u32x4 z = (u32x4){0u, 0u, 0u, 0u};
#pragma unroll
            for (int j = 0; j < 4; ++j) d[64 * j] = z; }
    }
}
DI void moe_combine_phase(Frame& F, int l) {
    const int gw = F.bid * NWAVES + F.wave, NGW = F.G * NWAVES;
    const float* Y = WSP(float, WS_Y); const float* X = WSP(float, WS_X);
    for (int row = gw; row < MLAT; row += NGW) {
        const int* tk = WSP(int, WS_TOK) + (size_t)row * 8;
        const float g1 = ((const float*)tk)[4], g2 = ((const float*)tk)[5]; const int s1 = tk[6], s2 = tk[7];
        const float* mrow = WSP(float, WS_MOD) + (size_t)(l * 5 + row / TL) * D6 + 5 * D;
#pragma unroll
        for (int j = 0; j < 8; ++j) { const int c = 4 * F.lane + 256 * j;
            const f32x4 x = *(const f32x4*)(X + (size_t)row * D + c), y1 = *(const f32x4*)(Y + (size_t)s1 * D + c), y2 = *(const f32x4*)(Y + (size_t)s2 * D + c), gg = *(const f32x4*)(mrow + c);
            *(f32x4*)(F.out + (size_t)row * D + c) = x + gg * (y1 * g1 + y2 * g2); }
    }
}
using pg8::Unit;
struct EpiF32 {
    static constexpr bool PERM = false;
    float* C; int ldc;
    DI void operator()(const f32x4 (&acc)[2][2][4][2], const Unit& u, int wr, int wc, int fr, int fq) const {
        const int row0 = u.pm * 256 + wr * 64 + fr, col0 = u.pn * 256 + wc * 32 + 4 * fq;
#pragma unroll
        for (int ai = 0; ai < 2; ++ai)
#pragma unroll
            for (int m = 0; m < 4; ++m) { float* rowp = C + (size_t)(row0 + ai * 128 + m * 16) * ldc + col0;
#pragma unroll
                for (int bj = 0; bj < 2; ++bj)
#pragma unroll
                    for (int n = 0; n < 2; ++n) *(f32x4*)(rowp + bj * 128 + n * 16) = acc[ai][bj][m][n]; }
    }
};
struct EpiBf16 {
    static constexpr bool PERM = true;
    bf16* O; int ldc;
    DI void operator()(const f32x4 (&acc)[2][2][4][2], const Unit& u, int wr, int wc, int fr, int fq) const {
        const int row0 = u.pm * 256 + wr * 64 + fr, col0 = u.pn * 256 + wc * 32 + 8 * fq;
#pragma unroll
        for (int ai = 0; ai < 2; ++ai)
#pragma unroll
            for (int m = 0; m < 4; ++m) { bf16* rowp = O + (size_t)(row0 + ai * 128 + m * 16) * ldc + col0;
#pragma unroll
                for (int bj = 0; bj < 2; ++bj) { const f32x4 v0 = acc[ai][bj][m][0], v1 = acc[ai][bj][m][1];
                    u32x4 w; w.x = pg8::cvt_pk_bf16(v0[0], v0[1]); w.y = pg8::cvt_pk_bf16(v0[2], v0[3]); w.z = pg8::cvt_pk_bf16(v1[0], v1[1]); w.w = pg8::cvt_pk_bf16(v1[2], v1[3]);
                    *(u32x4*)(rowp + bj * 128) = w; } }
    }
};
struct EpiSwiglu {
    static constexpr bool PERM = true;
    bf16* O; int ldc;
    DI void operator()(const f32x4 (&acc)[2][2][4][2], const Unit& u, int wr, int wc, int fr, int fq) const {
        const int row0 = u.pm * 256 + wr * 64 + fr, col0 = u.pn * 128 + wc * 32 + 8 * fq;
#pragma unroll
        for (int ai = 0; ai < 2; ++ai)
#pragma unroll
            for (int m = 0; m < 4; ++m) { bf16* rowp = O + (size_t)(row0 + ai * 128 + m * 16) * ldc + col0;
                f32x4 v0, v1;
#pragma unroll
                for (int j = 0; j < 4; ++j) { v0[j] = siluf(acc[ai][0][m][0][j]) * acc[ai][1][m][0][j]; v1[j] = siluf(acc[ai][0][m][1][j]) * acc[ai][1][m][1][j]; }
                u32x4 w; w.x = pg8::cvt_pk_bf16(v0[0], v0[1]); w.y = pg8::cvt_pk_bf16(v0[2], v0[3]); w.z = pg8::cvt_pk_bf16(v1[0], v1[1]); w.w = pg8::cvt_pk_bf16(v1[2], v1[3]);
                *(u32x4*)rowp = w; }
    }
};
struct EpiResid {
    static constexpr bool PERM = false;
    const float* baseLat; const float* baseCtx; float* out; const float* mod;
    DI void operator()(const f32x4 (&acc)[2][2][4][2], const Unit& u, int wr, int wc, int fr, int fq) const {
        const int row0 = u.pm * 256 + wr * 64 + fr, col0 = u.pn * 256 + wc * 32 + 4 * fq;
        const int br = (u.pm * 256 < MLAT) ? (u.pm * 256) / TL : 4;
        const float* gate = mod + (size_t)br * D6 + col0;
        f32x4 gv[2][2];
#pragma unroll
        for (int bj = 0; bj < 2; ++bj)
#pragma unroll
            for (int n = 0; n < 2; ++n) gv[bj][n] = *(const f32x4*)(gate + bj * 128 + n * 16);
#pragma unroll
        for (int ai = 0; ai < 2; ++ai)
#pragma unroll
            for (int m = 0; m < 4; ++m) { const int row = row0 + ai * 128 + m * 16;
                const float* bp = (row < MLAT ? baseLat + (size_t)row * D : baseCtx + (size_t)(row - MLAT) * D) + col0; float* op = out + (size_t)row * D + col0;
#pragma unroll
                for (int bj = 0; bj < 2; ++bj)
#pragma unroll
                    for (int n = 0; n < 2; ++n) { const f32x4 b = *(const f32x4*)(bp + bj * 128 + n * 16); *(f32x4*)(op + bj * 128 + n * 16) = b + gv[bj][n] * acc[ai][bj][m][n]; } }
    }
};
struct MoeOrder {
    const LAS int* tb; int NT, G, c;
    DI bool next(int i, Unit& u) const {
        const int nun = tb[40]; const long L = (long)i * G + c; if (L >= nun) return false;
        const int w = pg8::xcd_remap((int)L, nun); int e = 0;
#pragma unroll
        for (int k = 1; k < 8; ++k) if (w >= tb[32 + k]) e = k;
        const int rem = w - tb[32 + e], tiles = tb[8 + e], nt = rem / tiles, mtl = rem - nt * tiles;
        u.pm = tb[16 + e] + mtl; u.pn = nt; u.pb = e * NT + nt; return true;
    }
};
DI int tc_of(int dir, int p) { return dir == 0 ? (p < 4 ? 32 + p : p - 4) : 35 - p; }

DI void m1_prep_unit(Frame& F, int l, int b, int tt) {
    const float* P = WSP(float, WS_P);
    const int j0 = tt * 32, lane = F.lane;
    LAS bf16* vs = (LAS bf16*)F.lds;
    for (int i = F.wave; i < 32; i += 8) {
        const int j = j0 + i, row = rowof(b, j);
        const float* p = P + (size_t)row * DINP;
        {
            float v[7]; float ss = 0.f;
#pragma unroll
            for (int u = 0; u < 7; ++u) { v[u] = p[PC_CQ + lane + 64 * u]; ss += v[u] * v[u]; }
            const float rstd = 1.0f / sqrtf(wave_sum(ss) * (1.f / 448.f) + EPS);
            const float* qn = F.in[18] + l * 448; bf16* o = WSP(bf16, WS_CQN) + (size_t)row * 512;
#pragma unroll
            for (int u = 0; u < 7; ++u) o[lane + 64 * u] = (bf16)f2bf(v[u] * rstd * qn[lane + 64 * u]);
            o[448 + lane] = 0;
        }
        {
            float v[3]; float ss = 0.f;
#pragma unroll
            for (int u = 0; u < 3; ++u) { const int idx = lane + 64 * u; v[u] = idx < 160 ? p[PC_CKV + idx] : 0.f; ss += v[u] * v[u]; }
            const float rstd = 1.0f / sqrtf(wave_sum(ss) * (1.f / 160.f) + EPS);
            const float* kn = F.in[20] + l * 160; bf16* o = WSP(bf16, WS_CKVN) + (size_t)row * 256;
#pragma unroll
            for (int u = 0; u < 3; ++u) { const int idx = lane + 64 * u; o[idx] = idx < 160 ? (bf16)f2bf(v[u] * rstd * kn[idx]) : (bf16)0; }
            o[192 + lane] = 0;
        }
#pragma unroll
        for (int h = 0; h < 4; ++h) {
            {
                const float v0 = p[PC_NQ + h * 128 + lane], v1 = p[PC_NQ + h * 128 + 64 + lane];
                const float rstd = 1.0f / sqrtf(wave_sum(v0 * v0 + v1 * v1) * (1.f / 128.f) + EPS);
                const float* gq = F.in[24] + l * 128; bf16* o = WSP(bf16, WS_QNA) + ((size_t)(b * 4 + h) * TS + j) * 128;
                o[lane] = (bf16)f2bf(v0 * rstd * gq[lane]); o[64 + lane] = (bf16)f2bf(v1 * rstd * gq[64 + lane]);
            }
            {
                const float v0 = p[PC_NK + h * 128 + lane], v1 = p[PC_NK + h * 128 + 64 + lane];
                const float rstd = 1.0f / sqrtf(wave_sum(v0 * v0 + v1 * v1) * (1.f / 128.f) + EPS);
                const float* gk = F.in[25] + l * 128; bf16* o = WSP(bf16, WS_KNA) + ((size_t)(b * 4 + h) * TS + j) * 128;
                o[lane] = (bf16)f2bf(v0 * rstd * gk[lane]); o[64 + lane] = (bf16)f2bf(v1 * rstd * gk[64 + lane]);
            }
        }
#pragma unroll
        for (int u = 0; u < 8; ++u) vs[i * 520 + lane + 64 * u] = (bf16)f2bf(p[PC_NV + lane + 64 * u]);
        if (lane < 8) {
            float* gt = WSP(float, WS_GATES) + (size_t)row * 16;
            gt[lane] = p[PC_IG + lane] + F.in[9][l * 8 + lane];
            gt[8 + lane] = logsigmoidf_(p[PC_FG + lane] + F.in[10][l * 8 + lane]);
        }
        if (lane < 16) WSP(float, WS_DT)[(size_t)row * 16 + lane] = softplusf_(p[PC_DT + lane] + F.in[14][l * 16 + lane]);
    }
    {
        const int ch = 2 * F.tid;
        const int seglo = j0 < TL ? 0 : TL, seghi = j0 < TL ? TL : TS;
        const float* cw = F.in[12] + (size_t)l * 5 * 1024 + ch; const float* cb = F.in[13] + (size_t)l * 1024 + ch;
        f32x2 w[5];
#pragma unroll
        for (int d = 0; d < 5; ++d) w[d] = *(const f32x2*)(cw + d * 1024);
        const f32x2 bias = *(const f32x2*)cb;
        f32x2 x[5];
#pragma unroll
        for (int d = 0; d < 4; ++d) { const int jj = j0 - 2 + d; x[d + 1] = (jj >= seglo && jj < seghi) ? *(const f32x2*)(P + (size_t)rowof(b, jj) * DINP + PC_XBC + ch) : (f32x2){0.f, 0.f}; }
        for (int i = 0; i < 32; ++i) {
#pragma unroll
            for (int d = 0; d < 4; ++d) x[d] = x[d + 1];
            const int jj = j0 + i + 2; x[4] = (jj >= seglo && jj < seghi) ? *(const f32x2*)(P + (size_t)rowof(b, jj) * DINP + PC_XBC + ch) : (f32x2){0.f, 0.f};
            f32x2 a = bias;
#pragma unroll
            for (int d = 0; d < 5; ++d) a += w[d] * x[d];
            *(unsigned*)(WSP(bf16, WS_XBC) + (size_t)rowof(b, j0 + i) * 1024 + ch) = pk2(siluf(a[0]), siluf(a[1]));
        }
    }
    __syncthreads();
    {
        const int t = F.tid; unsigned wv[16];
#pragma unroll
        for (int i = 0; i < 16; ++i) wv[i] = (unsigned)vs[(2 * i) * 520 + t] | ((unsigned)vs[(2 * i + 1) * 520 + t] << 16);
        u32x4* dst = (u32x4*)(WSP(bf16, WS_VTNA) + ((size_t)(b * 4 + (t >> 7)) * 128 + (t & 127)) * TS + j0);
#pragma unroll
        for (int k = 0; k < 4; ++k) dst[k] = (u32x4){wv[4 * k], wv[4 * k + 1], wv[4 * k + 2], wv[4 * k + 3]};
    }
    __syncthreads();
}

DI void ml_a_unit(Frame& F, int seq, int p) {
    const int b = seq >> 3, h = (seq >> 1) & 3, dir = seq & 1, tc = tc_of(dir, p), lane = F.lane;
    const float* P = WSP(float, WS_P);
    LAS bf16* VW = (LAS bf16*)F.lds;
    LAS bf16* KT = (LAS bf16*)(F.lds + 20736);
    LAS float* wgs = (LAS float*)(F.lds + 39168);
    if (F.wave == 0) {
        const int row = rowof(b, tc * 64 + lane);
        const float* gt = WSP(float, WS_GATES) + (size_t)row * 16;
        const float li = gt[dir * 4 + h], lf = gt[8 + dir * 4 + h];
        const float pre = wave_incl_scan(lf, lane), tot = __shfl(pre, 63);
        const float g = dir == 0 ? (tot - pre) + li : (pre - lf) + li;
        const float mloc = wave_max(g);
        wgs[lane] = __expf(g - mloc);
        if (lane == 0) { float* sc = WSP(float, WS_MLSC) + (size_t)(seq * 36 + p) * 4; sc[0] = tot; sc[1] = mloc; }
    }
    __syncthreads();
    for (int idx = F.tid; idx < 64 * 128; idx += NTHR) { const int n = idx >> 7, d = idx & 127;
        const float* pr = P + (size_t)rowof(b, tc * 64 + n) * DINP + h * 128 + d;
        VW[d * 72 + n] = (bf16)f2bf(pr[PC_MLV] * wgs[n]); KT[d * 72 + n] = (bf16)f2bf(pr[PC_MLK]); }
    for (int idx = F.tid; idx < 16 * 64; idx += NTHR) { const int rr = idx >> 6, n = idx & 63; VW[(128 + rr) * 72 + n] = rr == 0 ? (bf16)f2bf(wgs[n]) : (bf16)0; }
    __syncthreads();
    float* U = WSP(float, WS_MLU) + (size_t)(seq * 36 + p) * (129 * 128);
    for (int id = F.wave; id < 72; id += 8) { const int dt = id >> 3, et = id & 7;
        const f32x4 acc = mma16<64>(VW + dt * 16 * 72, 72, KT + et * 16 * 72, 72, lane, (f32x4){0.f, 0.f, 0.f, 0.f});
#pragma unroll
        for (int i = 0; i < 4; ++i) { const int d = dt * 16 + 4 * (lane >> 4) + i; if (d < 129) U[d * 128 + et * 16 + (lane & 15)] = acc[i]; } }
    __syncthreads();
}

DI void ss_a_unit(Frame& F, int l, int b, int dir, int p, int g) {
    const int tc = tc_of(dir, p), lane = F.lane;
    LAS bf16* XT = (LAS bf16*)F.lds;
    LAS bf16* BT = (LAS bf16*)(F.lds + 36864);
    LAS float* tails = (LAS float*)(F.lds + 55296);
    const bf16* XBC = WSP(bf16, WS_XBC);
    if (F.wave < 4) {
        const int h = 4 * g + F.wave, row = rowof(b, tc * 64 + lane);
        const float dt = WSP(float, WS_DT)[(size_t)row * 16 + dir * 8 + h];
        const float A = -__expf(F.in[15][l * 16 + dir * 8 + h]);
        const float a = dt * A, pre = wave_incl_scan(a, lane), tot = __shfl(pre, 63);
        tails[F.wave * 64 + lane] = (dir == 0 ? __expf(tot - pre) : __expf(pre - a)) * dt;
        if (lane == 0) WSP(float, WS_SSSC)[(size_t)((b * 8 + h) * 2 + dir) * 36 + p] = __expf(tot);
    }
    __syncthreads();
    for (int idx = F.tid; idx < 64 * 256; idx += NTHR) { const int n = idx >> 8, c = idx & 255;
        const float x = bf2f(XBC[(size_t)rowof(b, tc * 64 + n) * 1024 + g * 256 + c]);
        XT[c * 72 + n] = (bf16)f2bf(x * tails[(c >> 6) * 64 + n]); }
    for (int idx = F.tid; idx < 64 * 128; idx += NTHR) { const int n = idx >> 7, nn = idx & 127;
        BT[nn * 72 + n] = XBC[(size_t)rowof(b, tc * 64 + n) * 1024 + 512 + g * 128 + nn]; }
    __syncthreads();
    for (int id = F.wave; id < 128; id += 8) { const int hh = id >> 5, rem = id & 31, pt = rem >> 3, nt = rem & 7;
        const f32x4 acc = mma16<64>(XT + (hh * 64 + pt * 16) * 72, 72, BT + nt * 16 * 72, 72, lane, (f32x4){0.f, 0.f, 0.f, 0.f});
        float* U = WSP(float, WS_SSU) + (size_t)(((b * 8 + 4 * g + hh) * 2 + dir) * 36 + p) * 8192;
#pragma unroll
        for (int i = 0; i < 4; ++i) U[(pt * 16 + 4 * (lane >> 4) + i) * 128 + nt * 16 + (lane & 15)] = acc[i]; }
    __syncthreads();
}
DI void ml_scan_unit(Frame& F, int seq, int s4) {
    float* sc = WSP(float, WS_MLSC) + (size_t)seq * 36 * 4;
    const float* U = WSP(float, WS_MLU) + (size_t)seq * 36 * 16512; bf16* S = WSP(bf16, WS_MLS) + (size_t)seq * 36 * 16512;
    float st[9]; float m = 0.f;
#pragma unroll
    for (int k = 0; k < 9; ++k) st[k] = 0.f;
    for (int p = 0; p < 36; ++p) {
        const float bl = sc[p * 4], mloc = sc[p * 4 + 1];
        const float mn = fmaxf(bl + m, mloc), wc = __expf(bl + m - mn), wu = __expf(mloc - mn);
        if (s4 == 0 && F.tid == 0) sc[p * 4 + 2] = m;
#pragma unroll
        for (int k = 0; k < 9; ++k) { const int e = F.tid + 512 * k; if (e < 4128) { const size_t idx = (size_t)p * 16512 + s4 * 4128 + e;
            S[idx] = (bf16)f2bf(st[k]); st[k] = wc * st[k] + wu * U[idx]; } }
        m = mn;
    }
}
DI void ss_scan_unit(Frame& F, int sq, int half) {
    const float* dec = WSP(float, WS_SSSC) + (size_t)sq * 36;
    const float* U = WSP(float, WS_SSU) + (size_t)sq * 36 * 8192; bf16* S = WSP(bf16, WS_SSS) + (size_t)sq * 36 * 8192;
    float st[8];
#pragma unroll
    for (int k = 0; k < 8; ++k) st[k] = 0.f;
    for (int p = 0; p < 36; ++p) {
        const float dc = dec[p];
#pragma unroll
        for (int k = 0; k < 8; ++k) { const size_t idx = (size_t)p * 8192 + half * 4096 + F.tid + 512 * k; S[idx] = (bf16)f2bf(st[k]); st[k] = st[k] * dc + U[idx]; }
    }
}
DI void mla_post_unit(Frame& F, int l, int b, int tt) {
    const float* P = WSP(float, WS_P);
    const bf16* QRAW = WSP(bf16, WS_QRAW); const bf16* KVRAW = WSP(bf16, WS_KVRAW);
    const int j0 = tt * 32, lane = F.lane;
    LAS bf16* vs = (LAS bf16*)F.lds;
    const float* gq = F.in[22] + l * 192; const float* gk = F.in[23] + l * 192;
    for (int i = F.wave; i < 32; i += 8) {
        const int j = j0 + i, row = rowof(b, j); const bool lat = j < TL;
        const int a = lane & 31; const float pos = (float)(a < 16 ? (j >> 6) : (j & 63));
        const float fr = exp2f(-(float)(a & 15) * (13.287712379549449f / 16.f));
        const float ang = pos * fr; const float cs = cosf(ang), sn = sinf(ang);
        const float krv = P[(size_t)row * DINP + PC_KR + lane];
#pragma unroll
        for (int h = 0; h < 4; ++h) {
            {
                const bf16* q = QRAW + (size_t)row * 768 + h * 192;
                const float v0 = bf2f(q[lane]), v1 = bf2f(q[64 + lane]), v2 = bf2f(q[128 + lane]);
                const float rstd = 1.0f / sqrtf(wave_sum(v0 * v0 + v1 * v1 + v2 * v2) * (1.f / 192.f) + EPS);
                const float n0 = v0 * rstd * gq[lane], n1 = v1 * rstd * gq[64 + lane]; float n2 = v2 * rstd * gq[128 + lane];
                const float pr = __shfl_xor(n2, 32);
                if (lat) n2 = lane < 32 ? n2 * cs - pr * sn : pr * sn + n2 * cs;
                bf16* o = WSP(bf16, WS_QMLA) + ((size_t)(b * 4 + h) * TS + j) * 192;
                o[lane] = (bf16)f2bf(n0); o[64 + lane] = (bf16)f2bf(n1); o[128 + lane] = (bf16)f2bf(n2);
            }
            {
                const bf16* kv = KVRAW + (size_t)row * 1024 + h * 256;
                const float v0 = bf2f(kv[lane]), v1 = bf2f(kv[64 + lane]), v2 = krv;
                const float rstd = 1.0f / sqrtf(wave_sum(v0 * v0 + v1 * v1 + v2 * v2) * (1.f / 192.f) + EPS);
                const float n0 = v0 * rstd * gk[lane], n1 = v1 * rstd * gk[64 + lane]; float n2 = v2 * rstd * gk[128 + lane];
                const float pr = __shfl_xor(n2, 32);
                if (lat) n2 = lane < 32 ? n2 * cs - pr * sn : pr * sn + n2 * cs;
                bf16* o = WSP(bf16, WS_KMLA) + ((size_t)(b * 4 + h) * TS + j) * 192;
                o[lane] = (bf16)f2bf(n0); o[64 + lane] = (bf16)f2bf(n1); o[128 + lane] = (bf16)f2bf(n2);
                vs[i * 520 + h * 128 + lane] = kv[128 + lane]; vs[i * 520 + h * 128 + 64 + lane] = kv[192 + lane];
            }
        }
    }
    __syncthreads();
    {
        const int t = F.tid; unsigned wv[16];
#pragma unroll
        for (int i = 0; i < 16; ++i) wv[i] = (unsigned)vs[(2 * i) * 520 + t] | ((unsigned)vs[(2 * i + 1) * 520 + t] << 16);
        u32x4* dst = (u32x4*)(WSP(bf16, WS_VTMLA) + ((size_t)(b * 4 + (t >> 7)) * 128 + (t & 127)) * TS + j0);
#pragma unroll
        for (int k = 0; k < 4; ++k) dst[k] = (u32x4){wv[4 * k], wv[4 * k + 1], wv[4 * k + 2], wv[4 * k + 3]};
    }
    __syncthreads();
}

template <int DK, bool NA>
DI void attn_unit(Frame& F, const bf16* Qg, const bf16* Kg, const bf16* VTg, int nA, int tA0, int nB, int tB0, float scale, bf16* Og, int qrow0, const float* rpb) {
    constexpr int KP = DK + 8, KCH = DK / 8, NKC = 64 * KCH / NTHR;
    LAS bf16* Ks = (LAS bf16*)F.lds;
    LAS bf16* VTs = (LAS bf16*)(F.lds + 64 * KP * 2);
    LAS bf16* Ps = (LAS bf16*)(F.lds + 64 * KP * 2 + 128 * 72 * 2) + F.wave * (16 * 72);
    LAS float* rp = (LAS float*)(F.lds + 64 * KP * 2 + 128 * 72 * 2 + 8 * 16 * 72 * 2);
    const int lane = F.lane, r = lane & 15, q = lane >> 4, tid = F.tid, w = F.wave;
    if (NA) { for (int i = tid; i < 15 * 31; i += NTHR) rp[i] = rpb[i]; }
    bf16x8 qf[DK / 32];
#pragma unroll
    for (int kk = 0; kk < DK / 32; ++kk) qf[kk] = *(const bf16x8*)(Qg + (size_t)(w * 16 + r) * DK + 32 * kk + 8 * q);
    f32x4 o[8]; float mrow[4], lrow[4];
#pragma unroll
    for (int d = 0; d < 8; ++d) o[d] = (f32x4){0.f, 0.f, 0.f, 0.f};
#pragma unroll
    for (int i = 0; i < 4; ++i) { mrow[i] = -1.0e30f; lrow[i] = 0.f; }
    const int ntile = nA + nB;
    u32x4 kreg[NKC], vreg[2];
    const int rq = qrow0 + (w >> 2);
    const int r0 = rq - 4 < 0 ? 0 : (rq - 4 > 24 ? 24 : rq - 4);
#define ATT_LOAD(kt) do { _Pragma("unroll") for (int c = 0; c < NKC; ++c) { const int id = tid + NTHR * c, rr = id / KCH, cc = id % KCH; kreg[c] = *(const u32x4*)(Kg + (size_t)((kt) * 64 + rr) * DK + cc * 8); } \
        _Pragma("unroll") for (int c = 0; c < 2; ++c) { const int id = tid + NTHR * c, dd = id >> 3, cc = id & 7; vreg[c] = *(const u32x4*)(VTg + (size_t)dd * TS + (kt) * 64 + cc * 8); } } while (0)
    ATT_LOAD(nA > 0 ? tA0 : tB0);
    for (int it = 0; it < ntile; ++it) {
        const int kt = it < nA ? tA0 + it : tB0 + (it - nA);
        __syncthreads();
#pragma unroll
        for (int c = 0; c < NKC; ++c) { const int id = tid + NTHR * c, rr = id / KCH, cc = id % KCH; *(LAS u32x4*)(Ks + rr * KP + cc * 8) = kreg[c]; }
#pragma unroll
        for (int c = 0; c < 2; ++c) { const int id = tid + NTHR * c, dd = id >> 3, cc = id & 7; *(LAS u32x4*)(VTs + dd * 72 + cc * 8) = vreg[c]; }
        __syncthreads();
        if (it + 1 < ntile) { const int kn = (it + 1) < nA ? tA0 + it + 1 : tB0 + (it + 1 - nA); ATT_LOAD(kn); }
        const bool nbt = NA && kt < 32;
        if (nbt && (kt < r0 || kt >= r0 + 8)) continue;
        f32x4 s[4];
#pragma unroll
        for (int n = 0; n < 4; ++n) s[n] = (f32x4){0.f, 0.f, 0.f, 0.f};
#pragma unroll
        for (int kk = 0; kk < DK / 32; ++kk)
#pragma unroll
            for (int n = 0; n < 4; ++n) { const bf16x8 kf = *(const LAS bf16x8*)(Ks + (n * 16 + r) * KP + 32 * kk + 8 * q); s[n] = __builtin_amdgcn_mfma_f32_16x16x32_bf16(qf[kk], kf, s[n], 0, 0, 0); }
        float mx[4];
#pragma unroll
        for (int i = 0; i < 4; ++i) mx[i] = -1.0e30f;
#pragma unroll
        for (int n = 0; n < 4; ++n)
#pragma unroll
            for (int i = 0; i < 4; ++i) {
                float v = s[n][i] * scale;
                if (nbt) { const int c = (w & 3) * 16 + 4 * q + i, kc = n * 16 + r; const int c0 = c - 8 < 0 ? 0 : (c - 8 > 48 ? 48 : c - 8);
                    v = (kc >= c0 && kc < c0 + 16) ? v + rp[(kt - rq + 7) * 31 + (kc - c + 15)] : -1.0e30f; }
                s[n][i] = v; mx[i] = fmaxf(mx[i], v);
            }
        float alpha[4], rs[4];
#pragma unroll
        for (int i = 0; i < 4; ++i) {
            float m = mx[i]; m = fmaxf(m, __shfl_xor(m, 1)); m = fmaxf(m, __shfl_xor(m, 2)); m = fmaxf(m, __shfl_xor(m, 4)); m = fmaxf(m, __shfl_xor(m, 8));
            const float mn = fmaxf(mrow[i], m); alpha[i] = __expf(mrow[i] - mn); mrow[i] = mn; rs[i] = 0.f;
        }
#pragma unroll
        for (int n = 0; n < 4; ++n)
#pragma unroll
            for (int i = 0; i < 4; ++i) { const float pv = __expf(s[n][i] - mrow[i]); rs[i] += pv; Ps[(4 * q + i) * 72 + n * 16 + r] = (bf16)f2bf(pv); }
#pragma unroll
        for (int i = 0; i < 4; ++i) {
            float t = rs[i]; t += __shfl_xor(t, 1); t += __shfl_xor(t, 2); t += __shfl_xor(t, 4); t += __shfl_xor(t, 8);
            lrow[i] = lrow[i] * alpha[i] + t;
        }
#pragma unroll
        for (int d = 0; d < 8; ++d)
#pragma unroll
            for (int i = 0; i < 4; ++i) o[d][i] *= alpha[i];
        asm volatile("s_waitcnt lgkmcnt(0)" ::: "memory");
#pragma unroll
        for (int kk = 0; kk < 2; ++kk) { const bf16x8 pf = *(const LAS bf16x8*)(Ps + r * 72 + 32 * kk + 8 * q);
#pragma unroll
            for (int d = 0; d < 8; ++d) { const bf16x8 vf = *(const LAS bf16x8*)(VTs + (d * 16 + r) * 72 + 32 * kk + 8 * q); o[d] = __builtin_amdgcn_mfma_f32_16x16x32_bf16(pf, vf, o[d], 0, 0, 0); } }
    }
#undef ATT_LOAD
#pragma unroll
    for (int i = 0; i < 4; ++i) { const float inv = 1.0f / lrow[i]; bf16* op = Og + (size_t)(w * 16 + 4 * q + i) * D + r;
#pragma unroll
        for (int d = 0; d < 8; ++d) op[d * 16] = (bf16)f2bf(o[d][i] * inv); }
    __syncthreads();
}
DI void ml_c_unit(Frame& F, int seq, int p) {
    const int b = seq >> 3, h = (seq >> 1) & 3, dir = seq & 1, tc = tc_of(dir, p), lane = F.lane, tid = F.tid;
    const float* P = WSP(float, WS_P);
    constexpr float QS = 0.08838834764831845f;
    LAS bf16* Qs = (LAS bf16*)F.lds;
    LAS bf16* Ksm = (LAS bf16*)(F.lds + 17408);
    LAS bf16* VT = (LAS bf16*)(F.lds + 34816);
    LAS bf16* Cx = (LAS bf16*)(F.lds + 55552);
    LAS bf16* SW = (LAS bf16*)(F.lds + 94720);
    LAS float* av = (LAS float*)(F.lds + 103936);
    LAS float* Mt = av + 64;
    LAS float* Bt = av + 128;
    LAS float* den = av + 192;
    const float m_p = WSP(float, WS_MLSC)[(size_t)(seq * 36 + p) * 4 + 2];
    if (F.wave == 0) {
        const int row = rowof(b, tc * 64 + lane);
        const float* gt = WSP(float, WS_GATES) + (size_t)row * 16;
        const float li = gt[dir * 4 + h], lf = gt[8 + dir * 4 + h];
        const float pre = wave_incl_scan(lf, lane), tot = __shfl(pre, 63);
        const float B = dir == 0 ? pre : (tot - pre) + lf;
        const float a = li - B;
        float cm = a;
#pragma unroll
        for (int o = 1; o < 64; o <<= 1) { const float t = dir == 0 ? __shfl_up(cm, o) : __shfl_down(cm, o); const bool ok = dir == 0 ? (lane >= o) : (lane + o < 64); if (ok) cm = fmaxf(cm, t); }
        av[lane] = a; Mt[lane] = fmaxf(m_p, cm); Bt[lane] = B;
    }
    for (int idx = tid; idx < 64 * 128; idx += NTHR) { const int n = idx >> 7, d = idx & 127;
        const float* pr = P + (size_t)rowof(b, tc * 64 + n) * DINP + h * 128 + d;
        Qs[n * 136 + d] = (bf16)f2bf(pr[PC_MLQ]); Ksm[n * 136 + d] = (bf16)f2bf(pr[PC_MLK]); VT[d * 72 + n] = (bf16)f2bf(pr[PC_MLV]); }
    for (int idx = tid; idx < 16 * 64; idx += NTHR) { const int rr = idx >> 6, n = idx & 63; VT[(128 + rr) * 72 + n] = rr == 0 ? (bf16)0x3f80 : (bf16)0; }
    { const bf16* Sg = WSP(bf16, WS_MLS) + (size_t)(seq * 36 + p) * 16512;
      for (int idx = tid; idx < 144 * 16; idx += NTHR) { const int rr = idx >> 4, cc = idx & 15;
          const u32x4 v = rr < 129 ? *(const u32x4*)(Sg + rr * 128 + cc * 8) : (u32x4){0u, 0u, 0u, 0u}; *(LAS u32x4*)(Cx + rr * 136 + cc * 8) = v; } }
    __syncthreads();
    for (int id = F.wave; id < 16; id += 8) { const int tt = id >> 2, st = id & 3;
        const bool skip = dir == 0 ? st > tt : st < tt;
        f32x4 acc = (f32x4){0.f, 0.f, 0.f, 0.f};
        if (!skip) acc = mma16<128>(Qs + tt * 16 * 136, 136, Ksm + st * 16 * 136, 136, lane, acc);
        const int s = st * 16 + (lane & 15); const float as = av[s];
#pragma unroll
        for (int i = 0; i < 4; ++i) { const int t = tt * 16 + 4 * (lane >> 4) + i; const bool ok = !skip && (dir == 0 ? s <= t : s >= t);
            SW[t * 72 + s] = (bf16)f2bf(ok ? acc[i] * QS * __expf(as - Mt[t]) : 0.f); } }
    __syncthreads();
    const int tt = F.wave & 3, d0 = F.wave < 4 ? 0 : 5, nd = F.wave < 4 ? 5 : 4;
    f32x4 val[5];
#pragma unroll
    for (int k = 0; k < 5; ++k) { val[k] = (f32x4){0.f, 0.f, 0.f, 0.f};
        if (k < nd) { const int dt = d0 + k;
            const f32x4 a1 = mma16<64>(SW + tt * 16 * 72, 72, VT + dt * 16 * 72, 72, lane, (f32x4){0.f, 0.f, 0.f, 0.f});
            const f32x4 a2 = mma16<128>(Qs + tt * 16 * 136, 136, Cx + dt * 16 * 136, 136, lane, (f32x4){0.f, 0.f, 0.f, 0.f});
#pragma unroll
            for (int i = 0; i < 4; ++i) { const int t = tt * 16 + 4 * (lane >> 4) + i; val[k][i] = a1[i] + a2[i] * QS * __expf(m_p - Mt[t]); }
            if (dt == 8 && (lane & 15) == 0) {
#pragma unroll
                for (int i = 0; i < 4; ++i) den[tt * 16 + 4 * (lane >> 4) + i] = val[k][i]; } } }
    __syncthreads();
    float* H = WSP(float, WS_HML) + (size_t)dir * MTOK * 512;
#pragma unroll
    for (int k = 0; k < 5; ++k) { const int dt = d0 + k; if (k < nd && dt < 8) {
#pragma unroll
        for (int i = 0; i < 4; ++i) { const int t = tt * 16 + 4 * (lane >> 4) + i;
            const float dn = fmaxf(fabsf(den[t]), __expf(-(Bt[t] + Mt[t])));
            H[(size_t)rowof(b, tc * 64 + t) * 512 + h * 128 + dt * 16 + (lane & 15)] = val[k][i] / dn; } } }
    __syncthreads();
}

DI void ss_c_unit(Frame& F, int l, int sq, int p) {
    const int b = sq >> 4, h = (sq >> 1) & 7, dir = sq & 1, g = h >> 2, tc = tc_of(dir, p), lane = F.lane, tid = F.tid;
    const bf16* XBC = WSP(bf16, WS_XBC);
    LAS bf16* Cm = (LAS bf16*)F.lds;
    LAS bf16* Bm = (LAS bf16*)(F.lds + 17408);
    LAS bf16* XT = (LAS bf16*)(F.lds + 34816);
    LAS bf16* Sx = (LAS bf16*)(F.lds + 44032);
    LAS bf16* W = (LAS bf16*)(F.lds + 61440);
    LAS float* cum = (LAS float*)(F.lds + 70656);
    LAS float* dtv = cum + 64;
    if (F.wave == 0) {
        const int row = rowof(b, tc * 64 + lane);
        const float dt = WSP(float, WS_DT)[(size_t)row * 16 + dir * 8 + h];
        const float A = -__expf(F.in[15][l * 16 + dir * 8 + h]);
        const float a = dt * A, pre = wave_incl_scan(a, lane), tot = __shfl(pre, 63);
        cum[lane] = dir == 0 ? pre : (tot - pre) + a; dtv[lane] = dt;
    }
    for (int idx = tid; idx < 64 * 16; idx += NTHR) { const int n = idx >> 4, cc = idx & 15; const bf16* xr = XBC + (size_t)rowof(b, tc * 64 + n) * 1024;
        *(LAS u32x4*)(Bm + n * 136 + cc * 8) = *(const u32x4*)(xr + 512 + g * 128 + cc * 8);
        *(LAS u32x4*)(Cm + n * 136 + cc * 8) = *(const u32x4*)(xr + 768 + g * 128 + cc * 8); }
    for (int idx = tid; idx < 64 * 64; idx += NTHR) { const int n = idx >> 6, pp = idx & 63; XT[pp * 72 + n] = XBC[(size_t)rowof(b, tc * 64 + n) * 1024 + h * 64 + pp]; }
    { const bf16* Sg = WSP(bf16, WS_SSS) + (size_t)(sq * 36 + p) * 8192;
      for (int idx = tid; idx < 64 * 16; idx += NTHR) { const int rr = idx >> 4, cc = idx & 15; *(LAS u32x4*)(Sx + rr * 136 + cc * 8) = *(const u32x4*)(Sg + rr * 128 + cc * 8); } }
    __syncthreads();
    for (int id = F.wave; id < 16; id += 8) { const int tt = id >> 2, st = id & 3;
        const bool skip = dir == 0 ? st > tt : st < tt;
        f32x4 acc = (f32x4){0.f, 0.f, 0.f, 0.f};
        if (!skip) acc = mma16<128>(Cm + tt * 16 * 136, 136, Bm + st * 16 * 136, 136, lane, acc);
        const int s = st * 16 + (lane & 15); const float cs = cum[s], ds = dtv[s];
#pragma unroll
        for (int i = 0; i < 4; ++i) { const int t = tt * 16 + 4 * (lane >> 4) + i; const bool ok = !skip && (dir == 0 ? s <= t : s >= t);
            W[t * 72 + s] = (bf16)f2bf(ok ? acc[i] * __expf(cum[t] - cs) * ds : 0.f); } }
    __syncthreads();
    float* Y = WSP(float, WS_YSS) + (size_t)dir * MTOK * 512;
    for (int id = F.wave; id < 16; id += 8) { const int tt = id >> 2, pt = id & 3;
        const f32x4 a1 = mma16<64>(W + tt * 16 * 72, 72, XT + pt * 16 * 72, 72, lane, (f32x4){0.f, 0.f, 0.f, 0.f});
        const f32x4 a2 = mma16<128>(Cm + tt * 16 * 136, 136, Sx + pt * 16 * 136, 136, lane, (f32x4){0.f, 0.f, 0.f, 0.f});
#pragma unroll
        for (int i = 0; i < 4; ++i) { const int t = tt * 16 + 4 * (lane >> 4) + i;
            Y[(size_t)rowof(b, tc * 64 + t) * 512 + h * 64 + pt * 16 + (lane & 15)] = a1[i] + a2[i] * __expf(cum[t]); } }
    __syncthreads();
}

DI void m5_finish_phase(Frame& F, int l, int nrows) {
    const int gw = F.bid * NWAVES + F.wave, NGW = F.G * NWAVES, lane = F.lane;
    const float* P = WSP(float, WS_P); const float* H0 = WSP(float, WS_HML); const float* H1 = H0 + (size_t)MTOK * 512;
    const float* Y0 = WSP(float, WS_YSS); const float* Y1 = Y0 + (size_t)MTOK * 512; const bf16* XBC = WSP(bf16, WS_XBC);
    bf16* A2 = WSP(bf16, WS_A2);
    for (int row = gw; row < nrows; row += NGW) {
        const float* p = P + (size_t)row * DINP;
#pragma unroll
        for (int h = 0; h < 4; ++h) {
            const int c0 = h * 128 + lane, c1 = c0 + 64;
            const float v0 = H0[(size_t)row * 512 + c0] + H1[(size_t)row * 512 + c0], v1 = H0[(size_t)row * 512 + c1] + H1[(size_t)row * 512 + c1];
            const float rstd = 1.0f / sqrtf(wave_sum(v0 * v0 + v1 * v1) * (1.f / 128.f) + EPS);
            const float* gn = F.in[11] + l * 512;
            A2[(size_t)row * D + c0] = (bf16)f2bf(v0 * rstd * gn[c0] * sigmoidf_(p[PC_MLO + c0]));
            A2[(size_t)row * D + c1] = (bf16)f2bf(v1 * rstd * gn[c1] * sigmoidf_(p[PC_MLO + c1]));
        }
        float y[8]; float ss = 0.f;
#pragma unroll
        for (int u = 0; u < 8; ++u) { const int c = lane + 64 * u;
            float v = Y0[(size_t)row * 512 + c] + Y1[(size_t)row * 512 + c] + F.in[16][l * 8 + u] * bf2f(XBC[(size_t)row * 1024 + c]);
            v *= siluf(p[PC_Z + c]); y[u] = v; ss += v * v; }
        const float rstd = 1.0f / sqrtf(wave_sum(ss) * (1.f / 512.f) + EPS);
        const float* sn = F.in[17] + l * 512;
#pragma unroll
        for (int u = 0; u < 8; ++u) { const int c = lane + 64 * u; A2[(size_t)row * D + 512 + c] = (bf16)f2bf(y[u] * rstd * sn[c]); }
    }
}
#ifndef ONE_LAUNCH
#define ONE_LAUNCH 1
#endif
#define IN(k) (lo <= (k) && (k) < hi)
#define SEAM(k) do { if (ONE_LAUNCH && hi > (k) + 1) xcd_barrier(bar); } while (0)
template <int l> DI void layer_phases(Frame& F, const XcdBarrier& bar, const int lo, const int hi) {
    LAS int* mtb = (LAS int*)(F.lds + RING_BYTES);
        const int pb = 1 + 16 * l;
        const bool wc = (l == 0);
        const int nrows = wc ? MTOK : MLAT;
        const float* modl = WSP(float, WS_MOD) + (size_t)l * 5 * D6;
        if (IN(pb + 0)) {
            if (l == 0) norm_phase<false>(F, l, F.in[0], F.in[2], F.in[6] + l * D, 0, MTOK);
            else norm_phase<false>(F, l, WSP(float, WS_X), WSP(float, WS_X) + (size_t)MLAT * D, F.in[6] + l * D, 0, MTOK);
            SEAM(pb + 0);
        }
        if (IN(pb + 1)) {
            pg8::Gemm g{WSP(bf16, WS_HN), WSP(bf16, WS_WIN) + (size_t)l * DINP * D, D}; pg8::StaticOrder S; S.init(MTOK / 256, DINP / 256, F.G, F.bid);
            EpiF32 E{WSP(float, WS_P), DINP};
            pg8::gemm_phase<EpiF32, pg8::StaticOrder>(F.lds, g, S, E);
            SEAM(pb + 1);
        }
        if (IN(pb + 2)) {
            for (int u = F.bid; u < NB * 72; u += F.G) m1_prep_unit(F, l, u / 72, u % 72);
            SEAM(pb + 2);
        }
        if (IN(pb + 3)) {
            { pg8::Gemm g{WSP(bf16, WS_CQN), WSP(bf16, WS_WQB) + (size_t)l * 768 * 512, 512}; pg8::StaticOrder S; S.init(MTOK / 256, 3, F.G, F.bid);
              EpiBf16 E{WSP(bf16, WS_QRAW), 768}; pg8::gemm_phase<EpiBf16, pg8::StaticOrder>(F.lds, g, S, E); }
            __syncthreads();
            { pg8::Gemm g{WSP(bf16, WS_CKVN), WSP(bf16, WS_WKVB) + (size_t)l * 1024 * 256, 256}; pg8::StaticOrder S; S.init(MTOK / 256, 4, F.G, (F.bid + 128) % F.G);
              EpiBf16 E{WSP(bf16, WS_KVRAW), 1024}; pg8::gemm_phase<EpiBf16, pg8::StaticOrder>(F.lds, g, S, E); }
            __syncthreads();
            for (int u = F.bid; u < 1152; u += F.G) ml_a_unit(F, u / 36, u % 36);
            for (int v = (F.bid + 128) % F.G; v < 576; v += F.G) ss_a_unit(F, l, v / 144, (v / 72) & 1, (v % 72) >> 1, v & 1);
            SEAM(pb + 3);
        }
        if (IN(pb + 4)) {
            for (int u = F.bid; u < 256; u += F.G) {
                const int bh = u >> 4, qb = u & 15, b = bh >> 2, h = bh & 3;
                const int r0a = 2 * qb - 4 < 0 ? 0 : (2 * qb - 4 > 24 ? 24 : 2 * qb - 4), r0b = 2 * qb - 3 < 0 ? 0 : (2 * qb - 3 > 24 ? 24 : 2 * qb - 3);
                attn_unit<128, true>(F, WSP(bf16, WS_QNA) + ((size_t)bh * TS + qb * 128) * 128, WSP(bf16, WS_KNA) + (size_t)bh * TS * 128, WSP(bf16, WS_VTNA) + (size_t)bh * 128 * TS,
                                     4, 32, r0b + 8 - r0a, r0a, 0.08838834764831845f,
                                     WSP(bf16, WS_A2) + (size_t)(b * TL + qb * 128) * D + 1536 + h * 128, 2 * qb, F.in[26] + (size_t)(l * 4 + h) * 15 * 31);
            }
            if (wc) for (int v = F.bid; v < 32; v += F.G) {
                const int bh2 = v >> 1, qc = v & 1, b2 = bh2 >> 2, h2 = bh2 & 3;
                attn_unit<128, false>(F, WSP(bf16, WS_QNA) + ((size_t)bh2 * TS + TL + qc * 128) * 128, WSP(bf16, WS_KNA) + (size_t)bh2 * TS * 128, WSP(bf16, WS_VTNA) + (size_t)bh2 * 128 * TS,
                                      4, 32, 0, 0, 0.08838834764831845f, WSP(bf16, WS_A2) + (size_t)(MLAT + b2 * TC + qc * 128) * D + 1536 + h2 * 128, 0, nullptr);
            }
            for (int v = (F.bid + 32) % F.G; v < 128; v += F.G) ml_scan_unit(F, v >> 2, v & 3);
            for (int v = (F.bid + 96) % F.G; v < 128; v += F.G) ss_scan_unit(F, v >> 1, v & 1);
            for (int v = F.bid; v < 288; v += F.G) mla_post_unit(F, l, v / 72, v % 72);
            SEAM(pb + 4);
        }
        if (IN(pb + 5)) {
            const int p0 = wc ? 0 : 4, npp = 36 - p0;
            for (int u = F.bid; u < 256; u += F.G) { const int bh = u >> 4, qb = u & 15, b = bh >> 2, h = bh & 3;
                attn_unit<192, false>(F, WSP(bf16, WS_QMLA) + ((size_t)bh * TS + qb * 128) * 192, WSP(bf16, WS_KMLA) + (size_t)bh * TS * 192, WSP(bf16, WS_VTMLA) + (size_t)bh * 128 * TS,
                                      36, 0, 0, 0, 0.07216878364870322f, WSP(bf16, WS_A2) + (size_t)(b * TL + qb * 128) * D + 1024 + h * 128, 0, nullptr); }
            if (wc) for (int v = F.bid; v < 32; v += F.G) { const int bh = v >> 1, qc = v & 1, b = bh >> 2, h = bh & 3;
                attn_unit<192, false>(F, WSP(bf16, WS_QMLA) + ((size_t)bh * TS + TL + qc * 128) * 192, WSP(bf16, WS_KMLA) + (size_t)bh * TS * 192, WSP(bf16, WS_VTMLA) + (size_t)bh * 128 * TS,
                                      4, 32, 0, 0, 0.07216878364870322f, WSP(bf16, WS_A2) + (size_t)(MLAT + b * TC + qc * 128) * D + 1024 + h * 128, 0, nullptr); }
            for (int v = (F.bid + 32) % F.G; v < 32 * npp; v += F.G) ml_c_unit(F, v / npp, p0 + v % npp);
            for (int v = (F.bid + 160) % F.G; v < 64 * npp; v += F.G) ss_c_unit(F, l, v / npp, p0 + v % npp);
            SEAM(pb + 5);
        }
        if (IN(pb + 6)) { m5_finish_phase(F, l, nrows); SEAM(pb + 6); }
        if (IN(pb + 7)) {
            pg8::Gemm g{WSP(bf16, WS_A2), WSP(bf16, WS_WOUT) + (size_t)l * D * D, D}; pg8::StaticOrder S; S.init(nrows / 256, D / 256, F.G, F.bid);
            EpiResid E{l == 0 ? F.in[0] : WSP(float, WS_X), l == 0 ? F.in[2] : WSP(float, WS_X) + (size_t)MLAT * D, WSP(float, WS_X), modl + 2 * D};
            pg8::gemm_phase<EpiResid, pg8::StaticOrder>(F.lds, g, S, E);
            SEAM(pb + 7);
        }
        if (IN(pb + 8)) {
            if (l == 0) norm_phase<false>(F, l, WSP(float, WS_X), WSP(float, WS_X) + (size_t)MLAT * D, F.in[27] + l * D, 3 * D, nrows);
            else norm_phase<true>(F, l, WSP(float, WS_X), WSP(float, WS_X) + (size_t)MLAT * D, F.in[27] + l * D, 3 * D, nrows);
            SEAM(pb + 8);
        }
        if (l == 0) {
            if (IN(pb + 10)) {
                pg8::Gemm g{WSP(bf16, WS_HN), WSP(bf16, WS_W13), D}; pg8::StaticOrder S; S.init(MTOK / 256, 2 * FF / 256, F.G, F.bid);
                EpiSwiglu E{WSP(bf16, WS_G), FF}; pg8::gemm_phase<EpiSwiglu, pg8::StaticOrder>(F.lds, g, S, E);
                SEAM(pb + 10);
            }
            if (IN(pb + 11)) {
                pg8::Gemm g{WSP(bf16, WS_G), WSP(bf16, WS_W2), FF}; pg8::StaticOrder S; S.init(MTOK / 256, D / 256, F.G, F.bid);
                EpiResid E{WSP(float, WS_X), WSP(float, WS_X) + (size_t)MLAT * D, WSP(float, WS_X), modl + 5 * D};
                pg8::gemm_phase<EpiResid, pg8::StaticOrder>(F.lds, g, S, E);
                SEAM(pb + 11);
            }
        } else {
            if (IN(pb + 9)) { moe_gather_phase(F); SEAM(pb + 9); }
            if (IN(pb + 10)) {
                __syncthreads(); moe_tables(F, mtb, 2 * FE / 256);
                pg8::Gemm g{WSP(bf16, WS_XG), WSP(bf16, WS_MW13), D}; MoeOrder S{mtb, 2 * FE / 256, F.G, F.bid};
                EpiSwiglu E{WSP(bf16, WS_G), FE}; pg8::gemm_phase<EpiSwiglu, MoeOrder>(F.lds, g, S, E);
                SEAM(pb + 10);
            }
            if (IN(pb + 11)) {
                __syncthreads(); moe_tables(F, mtb, D / 256);
                pg8::Gemm g{WSP(bf16, WS_G), WSP(bf16, WS_MW2), FE}; MoeOrder S{mtb, D / 256, F.G, F.bid};
                EpiF32 E{WSP(float, WS_Y), D}; pg8::gemm_phase<EpiF32, MoeOrder>(F.lds, g, S, E);
                SEAM(pb + 11);
            }
            if (IN(pb + 12)) { moe_combine_phase(F, l); }
        }
}
__global__ void __launch_bounds__(NTHR, 2) fwd_kernel(Args args) {
    extern __shared__ __attribute__((aligned(16))) unsigned char lds[];
    Frame F;
    F.lds = (LAS unsigned char*)lds; F.ws = args.ws; F.out = args.out;
#pragma unroll
    for (int i = 0; i < 35; ++i) F.in[i] = args.in[i];
    F.tid = threadIdx.x; F.lane = F.tid & 63; F.wave = __builtin_amdgcn_readfirstlane(F.tid >> 6); F.G = gridDim.x; F.bid = blockIdx.x;
    volatile LAS unsigned* MISC = (volatile LAS unsigned*)(F.lds + MISC_OFF);
    if (F.tid < 64) MISC[F.tid] = 0u;
    __syncthreads();
    XcdBarrier bar; bar.bar = WSP(unsigned, WS_CTL) + CW_BAR; bar.x = 0; bar.st = nullptr;
    if (ONE_LAUNCH) bar = xcd_barrier_post(WSP(unsigned, WS_CTL) + CW_BAR, MISC + 8);
    const int lo = args.ph_lo, hi = args.ph_hi;

    if (IN(0)) { p0_prologue(F); SEAM(0); }

    layer_phases<0>(F, bar, lo, hi);
    layer_phases<1>(F, bar, lo, hi);
#undef IN
#undef SEAM
}

extern "C" void kernel_launch(void* const* d_in, const int* in_sizes, int n_in, void* d_out, int out_size, void* d_ws, size_t ws_size, hipStream_t stream) {
    static int grid = 0;
    if (grid == 0) {
        if (n_in != 35 || out_size != MLAT * D || ws_size < WS_END) { fprintf(stderr, "kernel_launch: unexpected shapes (n_in %d out %d ws %zu need %zu)\n", n_in, out_size, ws_size, (size_t)WS_END); grid = -1; return; }
        int dev = 0, cus = 0, per_cu = 0;
        if (hipGetDevice(&dev) != hipSuccess || hipDeviceGetAttribute(&cus, hipDeviceAttributeMultiprocessorCount, dev) != hipSuccess) { grid = -1; return; }
        if (hipFuncSetAttribute((const void*)fwd_kernel, hipFuncAttributeMaxDynamicSharedMemorySize, LDS_BYTES) != hipSuccess) { fprintf(stderr, "kernel_launch: hipFuncSetAttribute failed\n"); grid = -1; return; }
        if (hipOccupancyMaxActiveBlocksPerMultiprocessor(&per_cu, (const void*)fwd_kernel, NTHR, LDS_BYTES) != hipSuccess || per_cu < 1) { fprintf(stderr, "kernel_launch: occupancy query says %d\n", per_cu); }
        (void)hipGetLastError();
        grid = cus;
    }
    if (grid < 0) return;
    (void)hipMemsetAsync((char*)d_ws + WS_CTL, 0, CTL_ZERO_BYTES, stream);
    Args a{};
    for (int i = 0; i < 35; ++i) a.in[i] = (const float*)d_in[i];
    a.out = (float*)d_out; a.ws = (unsigned char*)d_ws;
#if ONE_LAUNCH
    a.ph_lo = 0; a.ph_hi = 64;
    hipLaunchKernelGGL(fwd_kernel, dim3(grid), dim3(NTHR), LDS_BYTES, stream, a);
#else
    static const int phases[] = {0, 1, 2, 3, 4, 5, 6, 7, 8, 9, 11, 12, 17, 18, 19, 20, 21, 22, 23, 24, 25, 26, 27, 28, 29};
    for (int k = 0; k < (int)(sizeof(phases) / sizeof(phases[0])); ++k) {
        a.ph_lo = phases[k]; a.ph_hi = phases[k] + 1;
        hipLaunchKernelGGL(fwd_kernel, dim3(grid), dim3(NTHR), LDS_BYTES, stream, a);
    }
#endif
}
```

```cpp
#define PROBE_MASK (0ull)
#define ONE_LAUNCH 1
#define UNIT_REP 0
#include <hip/hip_runtime.h>
#include <cstdio>
#include <cstdint>

#define DI __device__ __forceinline__
#define LAS __attribute__((address_space(3)))
#define GAS __attribute__((address_space(1)))
typedef unsigned short bf16;
typedef short bf16x8 __attribute__((ext_vector_type(8)));
typedef float f32x4 __attribute__((ext_vector_type(4)));
typedef float f32x2 __attribute__((ext_vector_type(2)));
typedef unsigned u32x4 __attribute__((ext_vector_type(4)));
typedef unsigned u32x2 __attribute__((ext_vector_type(2)));

namespace pg8 {
constexpr int BM = 256, BK = 64, HALF = 128, HTB = HALF * BK * 2, STAGE_BYTES = 8 * HTB, NXCD = 8, WGM = 8;
__host__ __device__ __forceinline__ int lds_byte(int r, int c) { const int st = (r >> 4) * 2 + (c >> 5), rr = r & 15, cc = c & 31, ob = rr * 64 + cc * 2; return st * 1024 + (ob ^ (((ob >> 9) & 1) << 5)); }
__host__ __device__ __forceinline__ void stage_rc(int b, int& R, int& C) { const int st = b / 1024, sb = b % 1024, swz = sb ^ (((sb >> 9) & 1) << 5); R = (st >> 1) * 16 + swz / 64; C = (st & 1) * 32 + (swz % 64) / 2; }
__host__ __device__ __forceinline__ int perm32(int rho) { const int n = rho >> 4, i = rho & 15; return 8 * (i >> 2) + 4 * n + (i & 3); }

struct Unit { int pm, pn, pb; };
struct Gemm { const bf16* A; const bf16* Bt; int K; };

DI int xcd_remap(int L, int nwg) { const int q = nwg / NXCD, r = nwg % NXCD, xcd = L % NXCD, off = L / NXCD; return (xcd < r ? xcd * (q + 1) : r * (q + 1) + (xcd - r) * q) + off; }

struct StaticOrder {
    int nM, nN, nwg, G, c;
    DI void init(int nM_, int nN_, int G_, int c_) { nM = nM_; nN = nN_; nwg = nM * nN; G = G_; c = c_; }
    DI bool next(int i, Unit& u) const {
        const long L = (long)i * G + c; if (L >= nwg) return false;
        const int wgid = xcd_remap((int)L, nwg);
        const int nig = WGM * nN, gid = wgid / nig, fm = gid * WGM, gsz = (nM - fm) < WGM ? (nM - fm) : WGM;
        u.pm = fm + ((wgid % nig) % gsz); u.pn = (wgid % nig) / gsz; u.pb = u.pn; return true;
    }
};

DI unsigned cvt_pk_bf16(float lo, float hi) { unsigned r; asm volatile("v_cvt_pk_bf16_f32 %0, %1, %2" : "=v"(r) : "v"(lo), "v"(hi)); return r; }

template <class Epi, class Sched, bool ALIGN_EPI = true>
DI void gemm_phase(LAS unsigned char* lds, const Gemm g, const Sched& S, const Epi& E) {
    const int tid = threadIdx.x, wid = __builtin_amdgcn_readfirstlane(tid >> 6), lane = tid & 63, wr = wid >> 2, wc = wid & 3, fr = lane & 15, fq = lane >> 4;
    const int K = g.K, nt = K / BK;
    unsigned voffA[2], voffB[2];
#pragma unroll
    for (int i = 0; i < 2; ++i) { int R, C; stage_rc(tid * 16 + i * 8192, R, C); const int Rb = Epi::PERM ? ((R & ~31) + perm32(R & 31)) : R;
        voffA[i] = (unsigned)(R * K + C) * 2u; voffB[i] = (unsigned)(Rb * K + C) * 2u; }
    const size_t kstep = (size_t)(BK * 2);
    const size_t hstep = (size_t)HALF * K * 2;
    const size_t tstep = 2 * hstep;
    const unsigned ldsw = (unsigned)wid * 1024u;
    const int aoff = lds_byte(wr * 64 + fr, fq * 8), boff = lds_byte(wc * 32 + fr, fq * 8);
#define PG8_SA(b, h) (((b) * 2 + (h)) * HTB)
#define PG8_SB(b, h) ((4 + (b) * 2 + (h)) * HTB)
#define PG8_STAGE(bufoff, gbase, voff) do { _Pragma("unroll") for (int _i = 0; _i < 2; ++_i) \
        __builtin_amdgcn_global_load_lds((const unsigned*)((const char*)(gbase) + (voff)[_i]), (LAS unsigned*)(lds + (bufoff) + ldsw + _i * 8192), 16, 0, 0); } while (0)
#define PG8_LDA(dst, b, h) do { _Pragma("unroll") for (int m = 0; m < 4; ++m) _Pragma("unroll") for (int k = 0; k < 2; ++k) dst[m][k] = *(const LAS bf16x8*)(lds + PG8_SA(b, h) + aoff + m * 2048 + k * 1024); } while (0)
#define PG8_LDB(dst, b, h) do { _Pragma("unroll") for (int n = 0; n < 2; ++n) _Pragma("unroll") for (int k = 0; k < 2; ++k) dst[n][k] = *(const LAS bf16x8*)(lds + PG8_SB(b, h) + boff + n * 2048 + k * 1024); } while (0)
#define PG8_MMA(ai, bj, At, Bt) do { __builtin_amdgcn_s_setprio(1); _Pragma("unroll") for (int m = 0; m < 4; ++m) _Pragma("unroll") for (int n = 0; n < 2; ++n) _Pragma("unroll") for (int k = 0; k < 2; ++k) \
        acc[ai][bj][m][n] = __builtin_amdgcn_mfma_f32_16x16x32_bf16(Bt[n][k], At[m][k], acc[ai][bj][m][n], 0, 0, 0); __builtin_amdgcn_s_setprio(0); } while (0)
#define PG8_WAIT_V(n) asm volatile("s_waitcnt vmcnt(" #n ")" ::: "memory")
#define PG8_WAIT_L(n) asm volatile("s_waitcnt lgkmcnt(" #n ")" ::: "memory")
#define PG8_BAR __builtin_amdgcn_s_barrier()
#define PG8_SCHED __builtin_amdgcn_sched_barrier(0)
    Unit cur, nxt; int ui = 0;
    if (!S.next(0, cur)) return;
    f32x4 acc[2][2][4][2];
#pragma unroll
    for (int a = 0; a < 2; ++a)
#pragma unroll
        for (int b = 0; b < 2; ++b)
#pragma unroll
            for (int m = 0; m < 4; ++m)
#pragma unroll
                for (int n = 0; n < 2; ++n) acc[a][b][m][n] = (f32x4){0.f, 0.f, 0.f, 0.f};
    bf16x8 At[4][2], B0[2][2], B1[2][2];
    const char* cA = (const char*)g.A + (size_t)cur.pm * tstep; const char* cB = (const char*)g.Bt + (size_t)cur.pb * tstep;
    {
        PG8_STAGE(PG8_SB(0, 0), cB, voffB); PG8_STAGE(PG8_SB(0, 1), cB + hstep, voffB); PG8_STAGE(PG8_SA(0, 0), cA, voffA); PG8_STAGE(PG8_SA(0, 1), cA + hstep, voffA);
        if (wr == 1) PG8_BAR;
        PG8_WAIT_V(2); PG8_BAR;
        PG8_STAGE(PG8_SB(1, 0), cB + kstep, voffB); PG8_STAGE(PG8_SA(1, 0), cA + kstep, voffA); PG8_STAGE(PG8_SB(1, 1), cB + hstep + kstep, voffB);
        PG8_WAIT_V(6); PG8_BAR;
    }
    for (;;) {
        const bool has_next = S.next(ui + 1, nxt);
        const char* nA = has_next ? (const char*)g.A + (size_t)nxt.pm * tstep : cA; const char* nB = has_next ? (const char*)g.Bt + (size_t)nxt.pb * tstep : cB;
        for (int t = 0; t < nt; t += 2) {
            const bool last = (t == nt - 2);
            const char* a1 = cA + (size_t)(t + 1) * kstep;
            const char* a2 = last ? nA : cA + (size_t)(t + 2) * kstep; const char* b2 = last ? nB : cB + (size_t)(t + 2) * kstep;
            const char* a3 = a2 + kstep; const char* b3 = b2 + kstep;
            PG8_LDB(B0, 0, 0); PG8_LDB(B1, 0, 1); PG8_SCHED; PG8_LDA(At, 0, 0); PG8_STAGE(PG8_SA(1, 1), a1 + hstep, voffA);
            PG8_WAIT_V(8); PG8_WAIT_L(0); PG8_BAR; PG8_MMA(0, 0, At, B0); PG8_MMA(0, 1, At, B1); PG8_BAR; PG8_SCHED;
            PG8_LDA(At, 0, 1); PG8_STAGE(PG8_SB(0, 0), b2, voffB); PG8_STAGE(PG8_SB(0, 1), b2 + hstep, voffB); PG8_STAGE(PG8_SA(0, 0), a2, voffA);
            PG8_WAIT_V(8); PG8_WAIT_L(0); PG8_BAR; PG8_MMA(1, 0, At, B0); PG8_MMA(1, 1, At, B1); PG8_BAR; PG8_SCHED;
            PG8_LDB(B0, 1, 0); PG8_LDB(B1, 1, 1); PG8_SCHED; PG8_LDA(At, 1, 0); PG8_STAGE(PG8_SA(0, 1), a2 + hstep, voffA);
            PG8_WAIT_V(8); PG8_WAIT_L(0); PG8_BAR; PG8_MMA(0, 0, At, B0); PG8_MMA(0, 1, At, B1); PG8_BAR; PG8_SCHED;
            PG8_LDA(At, 1, 1); PG8_STAGE(PG8_SB(1, 0), b3, voffB); PG8_STAGE(PG8_SB(1, 1), b3 + hstep, voffB); PG8_STAGE(PG8_SA(1, 0), a3, voffA);
            PG8_WAIT_V(8); PG8_WAIT_L(0); PG8_BAR; PG8_MMA(1, 0, At, B0); PG8_MMA(1, 1, At, B1); PG8_BAR; PG8_SCHED;
        }
        if constexpr (ALIGN_EPI) { if (wr == 0) PG8_BAR; }
        E(acc, cur, wr, wc, fr, fq);
        if (!has_next) break;
#pragma unroll
        for (int a = 0; a < 2; ++a)
#pragma unroll
            for (int b = 0; b < 2; ++b)
#pragma unroll
                for (int m = 0; m < 4; ++m)
#pragma unroll
                    for (int n = 0; n < 2; ++n) acc[a][b][m][n] = (f32x4){0.f, 0.f, 0.f, 0.f};
        cur = nxt; cA = nA; cB = nB; ++ui;
        if constexpr (ALIGN_EPI) { if (wr == 1) PG8_BAR; }
    }
    PG8_WAIT_V(0);
    if constexpr (!ALIGN_EPI) { if (wr == 0) PG8_BAR; }
    PG8_BAR;
#undef PG8_SA
#undef PG8_SB
#undef PG8_STAGE
#undef PG8_LDA
#undef PG8_LDB
#undef PG8_MMA
#undef PG8_WAIT_V
#undef PG8_WAIT_L
#undef PG8_BAR
#undef PG8_SCHED
}
}
constexpr int D = 2048, NB = 4, TL = 2048, TC = 256, TS = TL + TC  ;
constexpr int MLAT = NB * TL  , MTOK = NB * (TL + TC)  ;
constexpr int DIN = 5824, DINP = 5888, D6 = 6 * D;
constexpr int FF = 5632, FE = 7168, NEXP = 8;
constexpr float EPS = 1e-6f;
constexpr int PC_MLQ = 0, PC_MLK = 512, PC_MLV = 1024, PC_MLO = 1536, PC_IG = 2048, PC_FG = 2056, PC_Z = 2064, PC_XBC = 2576, PC_DT = 3600,
              PC_CQ = 3616, PC_CKV = 4064, PC_KR = 4224, PC_NQ = 4288, PC_NK = 4800, PC_NV = 5312;
constexpr int NCHUNK = 36;
constexpr int MAXMT = 72;

constexpr size_t MiB = 1u << 20;
constexpr size_t WS_CTL = 0, CTL_ZERO_BYTES = 1 * MiB;
constexpr size_t WS_MOD = 1 * MiB;
constexpr size_t WS_WIN = 2 * MiB;
constexpr size_t WS_WOUT = WS_WIN + 46 * MiB;
constexpr size_t WS_WQB = WS_WOUT + 16 * MiB;
constexpr size_t WS_WKVB = WS_WQB + 2 * MiB;
constexpr size_t WS_W13 = WS_WKVB + 1 * MiB;
constexpr size_t WS_W2 = WS_W13 + 44 * MiB;
constexpr size_t WS_MW13 = WS_W2 + 22 * MiB;
constexpr size_t WS_MW2 = WS_MW13 + 448 * MiB;
constexpr size_t WS_HN = WS_MW2 + 224 * MiB;
constexpr size_t WS_A2 = WS_HN + 36 * MiB;
constexpr size_t WS_X = WS_A2 + 36 * MiB;
constexpr size_t WS_BIG = WS_X + 72 * MiB;
constexpr size_t WS_P = WS_BIG;
constexpr size_t WS_CQN = WS_P + 207 * MiB;
constexpr size_t WS_CKVN = WS_CQN + 9 * MiB;
constexpr size_t WS_QRAW = WS_CKVN + 5 * MiB;
constexpr size_t WS_KVRAW = WS_QRAW + 14 * MiB;
constexpr size_t WS_QMLA = WS_KVRAW + 18 * MiB;
constexpr size_t WS_KMLA = WS_QMLA + 14 * MiB;
constexpr size_t WS_VTMLA = WS_KMLA + 14 * MiB;
constexpr size_t WS_QNA = WS_VTMLA + 9 * MiB;
constexpr size_t WS_KNA = WS_QNA + 9 * MiB;
constexpr size_t WS_VTNA = WS_KNA + 9 * MiB;
constexpr size_t WS_XBC = WS_VTNA + 9 * MiB;
constexpr size_t WS_DT = WS_XBC + 18 * MiB;
constexpr size_t WS_GATES = WS_DT + 1 * MiB;
constexpr size_t WS_MLSC = WS_GATES + 1 * MiB;
constexpr size_t WS_SSSC = WS_MLSC + 64 * 1024;
constexpr size_t WS_MLU = WS_MLSC + 1 * MiB;
constexpr size_t WS_MLS = WS_MLU + 73 * MiB;
constexpr size_t WS_SSU = WS_MLS + 37 * MiB;
constexpr size_t WS_SSS = WS_SSU + 72 * MiB;
constexpr size_t WS_HML = WS_SSS + 36 * MiB;
constexpr size_t WS_YSS = WS_HML + 36 * MiB;
constexpr size_t WS_MIXEND = WS_YSS + 36 * MiB;
constexpr size_t WS_G = WS_BIG;
constexpr size_t WS_Y = WS_G + 252 * MiB;
constexpr size_t WS_XG = WS_Y + 144 * MiB;
constexpr size_t WS_TOK = WS_XG + 72 * MiB;
constexpr size_t WS_FFNEND = WS_TOK + 1 * MiB;
constexpr size_t WS_END = (WS_MIXEND > WS_FFNEND ? WS_MIXEND : WS_FFNEND);
static_assert(WS_END < (size_t)1800 * MiB, "workspace budget");
static_assert((size_t)MTOK * DINP * 4 <= 207 * MiB && (size_t)32 * 36 * 129 * 128 * 4 <= 73 * MiB, "sizes");
constexpr int CW_BAR = 4096;
constexpr int CW_MOE = 16384;

constexpr int RING_BYTES = 131072;
constexpr int MISC_OFF = 147456 - 256;
constexpr int LDS_BYTES = 147456;
constexpr int NWAVES = 8, NTHR = 512;

#define RLX_AGENT __ATOMIC_RELAXED, __HIP_MEMORY_SCOPE_AGENT
#define LDS_WAIT() asm volatile("s_waitcnt lgkmcnt(0)" ::: "memory")
#define VM_WAIT() asm volatile("s_waitcnt vmcnt(0)" ::: "memory")
DI unsigned f2bf(float f) { unsigned u = __builtin_bit_cast(unsigned, f); return (u + 0x7fffu + ((u >> 16) & 1u)) >> 16; }
DI unsigned pk2(float lo, float hi) { return f2bf(lo) | (f2bf(hi) << 16); }
DI float bf2f(unsigned b) { return __builtin_bit_cast(float, b << 16); }
DI float wave_sum(float v) {
#pragma unroll
    for (int o = 1; o < 64; o <<= 1) v += __shfl_xor(v, o);
    return v;
}
DI float wave_max(float v) {
#pragma unroll
    for (int o = 1; o < 64; o <<= 1) v = fmaxf(v, __shfl_xor(v, o));
    return v;
}
DI float wave_incl_scan(float v, int lane) {
#pragma unroll
    for (int o = 1; o < 64; o <<= 1) { const float t = __shfl_up(v, o); if (lane >= o) v += t; }
    return v;
}
DI float siluf(float x) { return x / (1.f + __expf(-x)); }
DI float sigmoidf_(float x) { return 1.f / (1.f + __expf(-x)); }
DI float softplusf_(float x) { return fmaxf(x, 0.f) + log1pf(__expf(-fabsf(x))); }
DI float logsigmoidf_(float x) { return fminf(x, 0.f) - log1pf(__expf(-fabsf(x))); }

#define XB_TMO      128
#define XB_XCNT(j)  (256  + 64 * (j))
#define XB_XSUB(j)  (1280 + 64 * (j))
#define XB_XGEN(j)  (2304 + 64 * (j))
#define XB_TOP      3328
#define XB_TOPGEN   3392
#define XCD_BAR_WORDS 3456
#define XB_SPIN_CAP (1u << 22)
DI unsigned xb_ld(unsigned* p)              { return __hip_atomic_load(p, __ATOMIC_RELAXED, __HIP_MEMORY_SCOPE_AGENT); }
DI unsigned xb_add(unsigned* p, unsigned v) { return __hip_atomic_fetch_add(p, v, __ATOMIC_RELAXED, __HIP_MEMORY_SCOPE_AGENT); }
DI unsigned xb_xcc_id() { return (unsigned)__builtin_amdgcn_s_getreg((3 << 11) | 20) & 0xFu; }
#define XB_SPIN(cond, bar) do { unsigned _sp = 0; while (cond) { __builtin_amdgcn_s_sleep(1); \
    if ((++_sp & 255u) == 0u) { if (xb_ld(&(bar)[XB_TMO])) break; if (_sp > XB_SPIN_CAP) { atomicAdd(&(bar)[XB_TMO], 1u); break; } } } } while (0)
struct XcdBarrier { unsigned* bar; unsigned x; volatile LAS unsigned* st; };
DI XcdBarrier xcd_barrier_post(unsigned* bar, volatile LAS unsigned* st) {
    XcdBarrier b; b.bar = bar; b.x = xb_xcc_id(); b.st = st;
    if (threadIdx.x == 0) (void)xb_add(&bar[XB_XCNT(b.x)], 1u);
    return b;
}
DI void xcd_barrier_complete(unsigned* bar, unsigned x, unsigned& nloc, unsigned& nx) {
    const unsigned G = gridDim.x * gridDim.y * gridDim.z;
    unsigned sum, cnt, mine, sp = 0u;
    for (;;) {
        sum = 0u; cnt = 0u; mine = 0u;
#pragma unroll
        for (unsigned j = 0; j < 16; ++j) { const unsigned c = xb_ld(&bar[XB_XCNT(j)]); sum += c; cnt += (c > 0u) ? 1u : 0u; mine = (j == x) ? c : mine; }
        if (sum == G) break;
        __builtin_amdgcn_s_sleep(1);
        if ((++sp & 255u) == 0u) { if (xb_ld(&bar[XB_TMO])) break; if (sp > XB_SPIN_CAP) { atomicAdd(&bar[XB_TMO], 1u); break; } }
    }
    nloc = mine > 0u ? mine : 1u; nx = cnt > 0u ? cnt : 1u;
}
DI void xcd_barrier(const XcdBarrier& b) {
    asm volatile("s_waitcnt vmcnt(0)" ::: "memory");
    __syncthreads();
    if (threadIdx.x == 0) {
        unsigned* bar = b.bar;
        __builtin_amdgcn_s_waitcnt(0);
        unsigned nloc = b.st[0], nx = b.st[1];
        if (nloc == 0u) { xcd_barrier_complete(bar, b.x, nloc, nx); b.st[0] = nloc; b.st[1] = nx; }
        const unsigned old = xb_add(&bar[XB_XSUB(b.x)], 1u);
        const unsigned gen = old / nloc;
        if (old + 1u == (gen + 1u) * nloc) {
            __builtin_amdgcn_fence(__ATOMIC_RELEASE, "agent");
            asm volatile("s_waitcnt vmcnt(0)" ::: "memory");
            const unsigned og = xb_add(&bar[XB_TOP], 1u);
            const unsigned tg = og / nx;
            if (og + 1u == (tg + 1u) * nx) xb_add(&bar[XB_TOPGEN], 1u);
            else XB_SPIN(xb_ld(&bar[XB_TOPGEN]) == tg, bar);
            __builtin_amdgcn_fence(__ATOMIC_ACQUIRE, "agent");
            xb_add(&bar[XB_XGEN(b.x)], 1u);
            asm volatile("s_waitcnt vmcnt(0)" ::: "memory");
        } else {
            XB_SPIN(xb_ld(&bar[XB_XGEN(b.x)]) == gen, bar);
            __builtin_amdgcn_fence(__ATOMIC_ACQUIRE, "agent");
            asm volatile("s_waitcnt vmcnt(0)" ::: "memory");
        }
    }
    __syncthreads();
}

struct Args { const float* in[35]; float* out; unsigned char* ws; int ph_lo, ph_hi, rep, pad; };
struct Frame {
    LAS unsigned char* lds;
    unsigned char* ws;
    const float* in[35];
    float* out;
    int tid, lane, wave, G, bid, rep;
};
#define WSP(T, off) ((T*)(F.ws + (off)))
DI int rowof(int b, int j) { return j < TL ? b * TL + j : MLAT + b * TC + (j - TL); }

template <int K> DI f32x4 mma16(const LAS bf16* A, int lda, const LAS bf16* Bt, int ldb, int lane, f32x4 acc) {
    const int r = lane & 15, q = lane >> 4;
    const LAS bf16* pa = A + r * lda + 8 * q; const LAS bf16* pb = Bt + r * ldb + 8 * q;
#pragma unroll
    for (int k = 0; k < K; k += 32) {
        const bf16x8 a = *(const LAS bf16x8*)(pa + k); const bf16x8 b = *(const LAS bf16x8*)(pb + k);
        acc = __builtin_amdgcn_mfma_f32_16x16x32_bf16(a, b, acc, 0, 0, 0);
    }
    return acc;
}
DI void tr_item(const float* src, size_t ld, int Kv, int Nv, int k0, int n0, bf16* dst, size_t Kd, int dn0, LAS float* scr, int lane) {
    const int nn = 4 * (lane & 15), kq = lane >> 4;
    f32x4 v[16];
#pragma unroll
    for (int i = 0; i < 16; ++i) { const int kk = 4 * i + kq;
        v[i] = (f32x4){0.f, 0.f, 0.f, 0.f};
        if (k0 + kk < Kv && n0 + nn < Nv) v[i] = *(const f32x4*)(src + (size_t)(k0 + kk) * ld + n0 + nn); }
#pragma unroll
    for (int i = 0; i < 16; ++i) { const int kk = 4 * i + kq; LAS float* s = scr + kk * 65 + nn; s[0] = v[i][0]; s[1] = v[i][1]; s[2] = v[i][2]; s[3] = v[i][3]; }
    LDS_WAIT(); asm volatile("" ::: "memory");
    const int c = lane & 7;
#pragma unroll
    for (int j = 0; j < 8; ++j) { const int n = (lane >> 3) + 8 * j; const LAS float* s = scr + (8 * c) * 65 + n;
        u32x4 o; o.x = pk2(s[0 * 65], s[1 * 65]); o.y = pk2(s[2 * 65], s[3 * 65]); o.z = pk2(s[4 * 65], s[5 * 65]); o.w = pk2(s[6 * 65], s[7 * 65]);
        *(u32x4*)(dst + (size_t)(dn0 + n) * Kd + k0 + 8 * c) = o; }
    LDS_WAIT(); asm volatile("" ::: "memory");
}
DI int il_row(int n0, int which) { return (n0 >> 7) * 256 + (n0 & 127) + which * 128; }

DI void p0_prologue(Frame& F) {
    {
        LAS float* sc = (LAS float*)F.lds;
        LAS float* red = (LAS float*)(F.lds + 5 * 2048 * 4);
        bool have = false;
        for (int u = F.bid; u < 2 * 96; u += F.G) {
            if (!have) {
                for (int i = F.tid; i < 5 * 2048; i += NTHR) { const float x = (i < 4 * 2048) ? F.in[1][i] : F.in[3][i - 4 * 2048]; sc[i] = siluf(x); }
                have = true;
            }
            __syncthreads();
            const int l = u / 96, j0 = (u % 96) * 128;
            const float* W = F.in[4] + (size_t)l * D * D6 + j0 + 2 * F.lane;
            f32x2 acc[5];
#pragma unroll
            for (int r = 0; r < 5; ++r) acc[r] = (f32x2){0.f, 0.f};
            const int kb = F.wave * 256;
            for (int k = 0; k < 256; k += 8) {
                f32x2 w[8];
#pragma unroll
                for (int i = 0; i < 8; ++i) w[i] = *(const f32x2*)(W + (size_t)(kb + k + i) * D6);
#pragma unroll
                for (int i = 0; i < 8; ++i)
#pragma unroll
                    for (int r = 0; r < 5; ++r) { const float s = sc[r * 2048 + kb + k + i]; acc[r] += w[i] * s; }
            }
#pragma unroll
            for (int r = 0; r < 5; ++r) { red[(F.wave * 5 + r) * 128 + 2 * F.lane] = acc[r][0]; red[(F.wave * 5 + r) * 128 + 2 * F.lane + 1] = acc[r][1]; }
            __syncthreads();
            for (int i = F.tid; i < 5 * 128; i += NTHR) { const int r = i / 128, j = i % 128; float s = F.in[5][l * D6 + j0 + j];
#pragma unroll
                for (int w = 0; w < 8; ++w) s += red[(w * 5 + r) * 128 + j];
                WSP(float, WS_MOD)[(l * 5 + r) * D6 + j0 + j] = s; }
        }
        __syncthreads();
    }
    LAS float* scr = (LAS float*)(F.lds + F.wave * 16640);
    const int gw = F.bid * NWAVES + F.wave, NGW = F.G * NWAVES;
    constexpr int I_IN = 32 * 92, I_OUT = 32 * 32, I_QB = 8 * 12, I_KVB = 4 * 16, I_F1 = 32 * 88, I_F2 = 88 * 32, I_M1 = 32 * 112, I_M2 = 112 * 32;
    constexpr int NITEMS = 2 * (I_IN + I_OUT + I_QB + I_KVB) + 2 * I_F1 + I_F2 + NEXP * (2 * I_M1 + I_M2);
    for (int it = gw; it < NITEMS; it += NGW) {
        int r = it;
        if (r < NEXP * 2 * I_M1) { const int e = r / (2 * I_M1); r -= e * 2 * I_M1; const int which = r / I_M1; r -= which * I_M1; const int kb = r / 112, nb = r % 112;
            tr_item((which ? F.in[33] : F.in[32]) + (size_t)e * D * FE, FE, D, FE, 64 * kb, 64 * nb, WSP(bf16, WS_MW13) + (size_t)e * 2 * FE * D, D, il_row(64 * nb, which), scr, F.lane); continue; }
        r -= NEXP * 2 * I_M1;
        if (r < NEXP * I_M2) { const int e = r / I_M2; r -= e * I_M2; const int kb = r / 32, nb = r % 32;
            tr_item(F.in[34] + (size_t)e * FE * D, D, FE, D, 64 * kb, 64 * nb, WSP(bf16, WS_MW2) + (size_t)e * D * FE, FE, 64 * nb, scr, F.lane); continue; }
        r -= NEXP * I_M2;
        if (r < 2 * I_IN) { const int l = r / I_IN; r -= l * I_IN; const int kb = r / 92, nb = r % 92;
            tr_item(F.in[7] + (size_t)l * D * DIN, DIN, D, DIN, 64 * kb, 64 * nb, WSP(bf16, WS_WIN) + (size_t)l * DINP * D, D, 64 * nb, scr, F.lane); continue; }
        r -= 2 * I_IN;
        if (r < 2 * I_OUT) { const int l = r / I_OUT; r -= l * I_OUT; const int kb = r / 32, nb = r % 32;
            tr_item(F.in[8] + (size_t)l * D * D, D, D, D, 64 * kb, 64 * nb, WSP(bf16, WS_WOUT) + (size_t)l * D * D, D, 64 * nb, scr, F.lane); continue; }
        r -= 2 * I_OUT;
        if (r < 2 * I_QB) { const int l = r / I_QB; r -= l * I_QB; const int kb = r / 12, nb = r % 12;
            tr_item(F.in[19] + (size_t)l * 448 * 768, 768, 448, 768, 64 * kb, 64 * nb, WSP(bf16, WS_WQB) + (size_t)l * 768 * 512, 512, 64 * nb, scr, F.lane); continue; }
        r -= 2 * I_QB;
        if (r < 2 * I_KVB) { const int l = r / I_KVB; r -= l * I_KVB; const int kb = r / 16, nb = r % 16;
            tr_item(F.in[21] + (size_t)l * 160 * 1024, 1024, 160, 1024, 64 * kb, 64 * nb, WSP(bf16, WS_WKVB) + (size_t)l * 1024 * 256, 256, 64 * nb, scr, F.lane); continue; }
        r -= 2 * I_KVB;
        if (r < 2 * I_F1) { const int which = r / I_F1; r -= which * I_F1; const int kb = r / 88, nb = r % 88;
            tr_item((which ? F.in[29] : F.in[28]), FF, D, FF, 64 * kb, 64 * nb, WSP(bf16, WS_W13), D, il_row(64 * nb, which), scr, F.lane); continue; }
        r -= 2 * I_F1;
        { const int kb = r / 32, nb = r % 32;
            tr_item(F.in[30], D, FF, D, 64 * kb, 64 * nb, WSP(bf16, WS_W2), FF, 64 * nb, scr, F.lane); }
    }
}
template <bool ROUTE>
DI void norm_phase(Frame& F, int l, const float* srcLat, const float* srcCtx, const float* g, int shoff, int nrows) {
    LAS float* rl = (LAS float*)F.lds;
    if (ROUTE) { for (int i = F.tid; i < D * NEXP; i += NTHR) rl[i] = F.in[31][i]; __syncthreads(); }
    const int gw = F.bid * NWAVES + F.wave, NGW = F.G * NWAVES;
    bf16* HN = WSP(bf16, WS_HN);
    for (int row = gw; row < nrows; row += NGW) {
        const float* xr = row < MLAT ? srcLat + (size_t)row * D : srcCtx + (size_t)(row - MLAT) * D;
        const int br = row < MLAT ? row / TL : 4;
        const float* mrow = WSP(float, WS_MOD) + (size_t)(l * 5 + br) * D6 + shoff;
        f32x4 v[8]; float ss = 0.f;
#pragma unroll
        for (int j = 0; j < 8; ++j) { v[j] = *(const f32x4*)(xr + 4 * F.lane + 256 * j); ss += (v[j][0] * v[j][0] + v[j][1] * v[j][1]) + (v[j][2] * v[j][2] + v[j][3] * v[j][3]); }
        const float rstd = 1.0f / sqrtf(wave_sum(ss) * (1.f / D) + EPS);
        float lg[8];
        if (ROUTE) {
#pragma unroll
            for (int e = 0; e < 8; ++e) lg[e] = 0.f; }
#pragma unroll
        for (int j = 0; j < 8; ++j) { const int c = 4 * F.lane + 256 * j;
            const f32x4 gg = *(const f32x4*)(g + c), sh = *(const f32x4*)(mrow + c), sc = *(const f32x4*)(mrow + D + c);
            f32x4 o;
#pragma unroll
            for (int i = 0; i < 4; ++i) o[i] = v[j][i] * rstd * gg[i] * (1.f + sc[i]) + sh[i];
            u32x2 w; w.x = pk2(o[0], o[1]); w.y = pk2(o[2], o[3]);
            *(u32x2*)(HN + (size_t)row * D + c) = w;
            if (ROUTE) {
#pragma unroll
                for (int i = 0; i < 4; ++i) { const f32x4 r0 = *(const LAS f32x4*)(rl + (c + i) * 8), r1 = *(const LAS f32x4*)(rl + (c + i) * 8 + 4);
                    lg[0] += o[i] * r0[0]; lg[1] += o[i] * r0[1]; lg[2] += o[i] * r0[2]; lg[3] += o[i] * r0[3];
                    lg[4] += o[i] * r1[0]; lg[5] += o[i] * r1[1]; lg[6] += o[i] * r1[2]; lg[7] += o[i] * r1[3]; }
                __builtin_amdgcn_sched_barrier(0);
            }
        }
        if (ROUTE) {
#pragma unroll
            for (int e = 0; e < 8; ++e) lg[e] = wave_sum(lg[e]);
            if (F.lane == 0) {
                int e1 = 0; float v1 = lg[0];
#pragma unroll
                for (int e = 1; e < 8; ++e) if (lg[e] > v1) { v1 = lg[e]; e1 = e; }
                int e2 = -1; float v2 = -3.0e38f;
#pragma unroll
                for (int e = 0; e < 8; ++e) if (e != e1 && lg[e] > v2) { v2 = lg[e]; e2 = e; }
                const float g2 = 1.f / (1.f + expf(v1 - v2)), g1 = 1.f - g2;
                unsigned* cnt = WSP(unsigned, WS_CTL) + CW_MOE;
                const unsigned p1 = __hip_atomic_fetch_add(cnt + e1, 1u, RLX_AGENT), p2 = __hip_atomic_fetch_add(cnt + e2, 1u, RLX_AGENT);
                int* tk = WSP(int, WS_TOK) + (size_t)row * 8;
                tk[0] = e1; tk[1] = (int)p1; tk[2] = e2; tk[3] = (int)p2; ((float*)tk)[4] = g1; ((float*)tk)[5] = g2;
            }
        }
    }
}

DI void moe_tables(Frame& F, LAS int* tb, int NT) {
    if (F.tid == 0) {
        const unsigned* cnt = WSP(unsigned, WS_CTL) + CW_MOE; int ts = 0, us = 0;
        for (int e = 0; e < 8; ++e) { const int c = (int)__hip_atomic_load(cnt + e, RLX_AGENT); const int t = (c + 255) >> 8; tb[e] = c; tb[8 + e] = t; tb[16 + e] = ts; tb[32 + e] = us; ts += t; us += t * NT; }
        tb[24] = ts; tb[40] = us;
    }
    __syncthreads();
}
DI void moe_gather_phase(Frame& F) {
    LAS int* tb = (LAS int*)F.lds; moe_tables(F, tb, 1);
    const int gw = F.bid * NWAVES + F.wave, NGW = F.G * NWAVES;
    const bf16* HN = WSP(bf16, WS_HN); bf16* XG = WSP(bf16, WS_XG);
    for (int row = gw; row < MLAT; row += NGW) {
        int* tk = WSP(int, WS_TOK) + (size_t)row * 8;
        const int e1 = tk[0], p1 = tk[1], e2 = tk[2], p2 = tk[3];
        const int s1 = tb[16 + e1] * 256 + p1, s2 = tb[16 + e2] * 256 + p2;
        const u32x4* src = (const u32x4*)(HN + (size_t)row * D) + F.lane;
        u32x4 a[4];
#pragma unroll
        for (int j = 0; j < 4; ++j) a[j] = src[64 * j];
        u32x4* d1 = (u32x4*)(XG + (size_t)s1 * D) + F.lane; u32x4* d2 = (u32x4*)(XG + (size_t)s2 * D) + F.lane;
#pragma unroll
        for (int j = 0; j < 4; ++j) { d1[64 * j] = a[j]; d2[64 * j] = a[j]; }
        if (F.lane == 0) { tk[6] = s1; tk[7] = s2; }
    }
    const int nrow = tb[24] * 256;
    for (int r = gw; r < nrow; r += NGW) {
        const int t = r >> 8; int e = 0;
#pragma unroll
        for (int k = 1; k < 8; ++k) if (t >= tb[16 + k]) e = k;
        const int local = r - tb[16 + e] * 256;
        if (local >= tb[e]) { u32x4* d = (u32x4*)(XG + (size_t)r * D) + F.lane; const u32x4 z = (u32x4){0u, 0u, 0u, 0u};
#pragma unroll
            for (int j = 0; j < 4; ++j) d[64 * j] = z; }
    }
}
DI void moe_combine_phase(Frame& F, int l) {
    const int gw = F.bid * NWAVES + F.wave, NGW = F.G * NWAVES;
    const float* Y = WSP(float, WS_Y); const float* X = WSP(float, WS_X);
    for (int row = gw; row < MLAT; row += NGW) {
        const int* tk = WSP(int, WS_TOK) + (size_t)row * 8;
        const float g1 = ((const float*)tk)[4], g2 = ((const float*)tk)[5]; const int s1 = tk[6], s2 = tk[7];
        const float* mrow = WSP(float, WS_MOD) + (size_t)(l * 5 + row / TL) * D6 + 5 * D;
#pragma unroll
        for (int j = 0; j < 8; ++j) { const int c = 4 * F.lane + 256 * j;
            const f32x4 x = *(const f32x4*)(X + (size_t)row * D + c), y1 = *(const f32x4*)(Y + (size_t)s1 * D + c), y2 = *(const f32x4*)(Y + (size_t)s2 * D + c), gg = *(const f32x4*)(mrow + c);
            *(f32x4*)(F.out + (size_t)row * D + c) = x + gg * (y1 * g1 + y2 * g2); }
    }
}
using pg8::Unit;
struct EpiF32 {
    static constexpr bool PERM = false;
    float* C; int ldc;
    DI void operator()(const f32x4 (&acc)[2][2][4][2], const Unit& u, int wr, int wc, int fr, int fq) const {
        const int row0 = u.pm * 256 + wr * 64 + fr, col0 = u.pn * 256 + wc * 32 + 4 * fq;
#pragma unroll
        for (int ai = 0; ai < 2; ++ai)
#pragma unroll
            for (int m = 0; m < 4; ++m) { float* rowp = C + (size_t)(row0 + ai * 128 + m * 16) * ldc + col0;
#pragma unroll
                for (int bj = 0; bj < 2; ++bj)
#pragma unroll
                    for (int n = 0; n < 2; ++n) *(f32x4*)(rowp + bj * 128 + n * 16) = acc[ai][bj][m][n]; }
    }
};
struct EpiBf16 {
    static constexpr bool PERM = true;
    bf16* O; int ldc;
    DI void operator()(const f32x4 (&acc)[2][2][4][2], const Unit& u, int wr, int wc, int fr, int fq) const {
        const int row0 = u.pm * 256 + wr * 64 + fr, col0 = u.pn * 256 + wc * 32 + 8 * fq;
#pragma unroll
        for (int ai = 0; ai < 2; ++ai)
#pragma unroll
            for (int m = 0; m < 4; ++m) { bf16* rowp = O + (size_t)(row0 + ai * 128 + m * 16) * ldc + col0;
#pragma unroll
                for (int bj = 0; bj < 2; ++bj) { const f32x4 v0 = acc[ai][bj][m][0], v1 = acc[ai][bj][m][1];
                    u32x4 w; w.x = pg8::cvt_pk_bf16(v0[0], v0[1]); w.y = pg8::cvt_pk_bf16(v0[2], v0[3]); w.z = pg8::cvt_pk_bf16(v1[0], v1[1]); w.w = pg8::cvt_pk_bf16(v1[2], v1[3]);
                    *(u32x4*)(rowp + bj * 128) = w; } }
    }
};
struct EpiSwiglu {
    static constexpr bool PERM = true;
    bf16* O; int ldc;
    DI void operator()(const f32x4 (&acc)[2][2][4][2], const Unit& u, int wr, int wc, int fr, int fq) const {
        const int row0 = u.pm * 256 + wr * 64 + fr, col0 = u.pn * 128 + wc * 32 + 8 * fq;
#pragma unroll
        for (int ai = 0; ai < 2; ++ai)
#pragma unroll
            for (int m = 0; m < 4; ++m) { bf16* rowp = O + (size_t)(row0 + ai * 128 + m * 16) * ldc + col0;
                f32x4 v0, v1;
#pragma unroll
                for (int j = 0; j < 4; ++j) { v0[j] = siluf(acc[ai][0][m][0][j]) * acc[ai][1][m][0][j]; v1[j] = siluf(acc[ai][0][m][1][j]) * acc[ai][1][m][1][j]; }
                u32x4 w; w.x = pg8::cvt_pk_bf16(v0[0], v0[1]); w.y = pg8::cvt_pk_bf16(v0[2], v0[3]); w.z = pg8::cvt_pk_bf16(v1[0], v1[1]); w.w = pg8::cvt_pk_bf16(v1[2], v1[3]);
                *(u32x4*)rowp = w; }
    }
};
struct EpiResid {
    static constexpr bool PERM = false;
    const float* baseLat; const float* baseCtx; float* out; const float* mod;
    DI void operator()(const f32x4 (&acc)[2][2][4][2], const Unit& u, int wr, int wc, int fr, int fq) const {
        const int row0 = u.pm * 256 + wr * 64 + fr, col0 = u.pn * 256 + wc * 32 + 4 * fq;
        const int br = (u.pm * 256 < MLAT) ? (u.pm * 256) / TL : 4;
        const float* gate = mod + (size_t)br * D6 + col0;
        f32x4 gv[2][2];
#pragma unroll
        for (int bj = 0; bj < 2; ++bj)
#pragma unroll
            for (int n = 0; n < 2; ++n) gv[bj][n] = *(const f32x4*)(gate + bj * 128 + n * 16);
#pragma unroll
        for (int ai = 0; ai < 2; ++ai)
#pragma unroll
            for (int m = 0; m < 4; ++m) { const int row = row0 + ai * 128 + m * 16;
                const float* bp = (row < MLAT ? baseLat + (size_t)row * D : baseCtx + (size_t)(row - MLAT) * D) + col0; float* op = out + (size_t)row * D + col0;
#pragma unroll
                for (int bj = 0; bj < 2; ++bj)
#pragma unroll
                    for (int n = 0; n < 2; ++n) { const f32x4 b = *(const f32x4*)(bp + bj * 128 + n * 16); *(f32x4*)(op + bj * 128 + n * 16) = b + gv[bj][n] * acc[ai][bj][m][n]; } }
    }
};
struct MoeOrder {
    const LAS int* tb; int NT, G, c;
    DI bool next(int i, Unit& u) const {
        const int nun = tb[40]; const long L = (long)i * G + c; if (L >= nun) return false;
        const int w = pg8::xcd_remap((int)L, nun); int e = 0;
#pragma unroll
        for (int k = 1; k < 8; ++k) if (w >= tb[32 + k]) e = k;
        const int rem = w - tb[32 + e], tiles = tb[8 + e], nt = rem / tiles, mtl = rem - nt * tiles;
        u.pm = tb[16 + e] + mtl; u.pn = nt; u.pb = e * NT + nt; return true;
    }
};
DI int tc_of(int dir, int p) { return dir == 0 ? (p < 4 ? 32 + p : p - 4) : 35 - p; }

DI void m1_prep_unit(Frame& F, int l, int b, int tt) {
    const float* P = WSP(float, WS_P);
    const int j0 = tt * 32, lane = F.lane;
    LAS bf16* vs = (LAS bf16*)F.lds;
    for (int i = F.wave; i < 32; i += 8) {
        const int j = j0 + i, row = rowof(b, j);
        const float* p = P + (size_t)row * DINP;
        float cq[7], ckv[3], nq[4][2], nk[4][2], nv[8];
#pragma unroll
        for (int u = 0; u < 7; ++u) cq[u] = p[PC_CQ + lane + 64 * u];
#pragma unroll
        for (int u = 0; u < 3; ++u) { const int idx = lane + 64 * u; ckv[u] = idx < 160 ? p[PC_CKV + idx] : 0.f; }
#pragma unroll
        for (int h = 0; h < 4; ++h) { nq[h][0] = p[PC_NQ + h * 128 + lane]; nq[h][1] = p[PC_NQ + h * 128 + 64 + lane]; nk[h][0] = p[PC_NK + h * 128 + lane]; nk[h][1] = p[PC_NK + h * 128 + 64 + lane]; }
#pragma unroll
        for (int u = 0; u < 8; ++u) nv[u] = p[PC_NV + lane + 64 * u];
        const float gi = lane < 8 ? p[PC_IG + lane] : 0.f, gf = lane < 8 ? p[PC_FG + lane] : 0.f, gd = lane < 16 ? p[PC_DT + lane] : 0.f;
        {
            float ss = 0.f;
#pragma unroll
            for (int u = 0; u < 7; ++u) ss += cq[u] * cq[u];
            const float rstd = 1.0f / sqrtf(wave_sum(ss) * (1.f / 448.f) + EPS);
            const float* qn = F.in[18] + l * 448; bf16* o = WSP(bf16, WS_CQN) + (size_t)row * 512;
#pragma unroll
            for (int u = 0; u < 7; ++u) o[lane + 64 * u] = (bf16)f2bf(cq[u] * rstd * qn[lane + 64 * u]);
            o[448 + lane] = 0;
        }
        {
            float ss = 0.f;
#pragma unroll
            for (int u = 0; u < 3; ++u) ss += ckv[u] * ckv[u];
            const float rstd = 1.0f / sqrtf(wave_sum(ss) * (1.f / 160.f) + EPS);
            const float* kn = F.in[20] + l * 160; bf16* o = WSP(bf16, WS_CKVN) + (size_t)row * 256;
#pragma unroll
            for (int u = 0; u < 3; ++u) { const int idx = lane + 64 * u; o[idx] = idx < 160 ? (bf16)f2bf(ckv[u] * rstd * kn[idx]) : (bf16)0; }
            o[192 + lane] = 0;
        }
        const float* gq = F.in[24] + l * 128; const float* gk = F.in[25] + l * 128;
#pragma unroll
        for (int h = 0; h < 4; ++h) {
            const float rq = 1.0f / sqrtf(wave_sum(nq[h][0] * nq[h][0] + nq[h][1] * nq[h][1]) * (1.f / 128.f) + EPS);
            const float rk = 1.0f / sqrtf(wave_sum(nk[h][0] * nk[h][0] + nk[h][1] * nk[h][1]) * (1.f / 128.f) + EPS);
            bf16* oq = WSP(bf16, WS_QNA) + ((size_t)(b * 4 + h) * TS + j) * 128; bf16* ok = WSP(bf16, WS_KNA) + ((size_t)(b * 4 + h) * TS + j) * 128;
            oq[lane] = (bf16)f2bf(nq[h][0] * rq * gq[lane]); oq[64 + lane] = (bf16)f2bf(nq[h][1] * rq * gq[64 + lane]);
            ok[lane] = (bf16)f2bf(nk[h][0] * rk * gk[lane]); ok[64 + lane] = (bf16)f2bf(nk[h][1] * rk * gk[64 + lane]);
        }
#pragma unroll
        for (int u = 0; u < 8; ++u) vs[i * 520 + lane + 64 * u] = (bf16)f2bf(nv[u]);
        if (lane < 8) {
            float* gt = WSP(float, WS_GATES) + (size_t)row * 16;
            gt[lane] = gi + F.in[9][l * 8 + lane];
            gt[8 + lane] = logsigmoidf_(gf + F.in[10][l * 8 + lane]);
        }
        if (lane < 16) WSP(float, WS_DT)[(size_t)row * 16 + lane] = softplusf_(gd + F.in[14][l * 16 + lane]);
    }
    {
        const int ch = 2 * F.tid;
        const int seglo = j0 < TL ? 0 : TL, seghi = j0 < TL ? TL : TS;
        const float* cw = F.in[12] + (size_t)l * 5 * 1024 + ch; const float* cb = F.in[13] + (size_t)l * 1024 + ch;
        f32x2 w[5];
#pragma unroll
        for (int d = 0; d < 5; ++d) w[d] = *(const f32x2*)(cw + d * 1024);
        const f32x2 bias = *(const f32x2*)cb;
        f32x2 xin[36];
#pragma unroll
        for (int d = 0; d < 36; ++d) { const int jj = j0 - 2 + d; xin[d] = (jj >= seglo && jj < seghi) ? *(const f32x2*)(P + (size_t)rowof(b, jj) * DINP + PC_XBC + ch) : (f32x2){0.f, 0.f}; }
#pragma unroll
        for (int i = 0; i < 32; ++i) {
            f32x2 a = bias;
#pragma unroll
            for (int d = 0; d < 5; ++d) a += w[d] * xin[i + d];
            *(unsigned*)(WSP(bf16, WS_XBC) + (size_t)rowof(b, j0 + i) * 1024 + ch) = pk2(siluf(a[0]), siluf(a[1]));
        }
    }
    __syncthreads();
    {
        const int t = F.tid; unsigned wv[16];
#pragma unroll
        for (int i = 0; i < 16; ++i) wv[i] = (unsigned)vs[(2 * i) * 520 + t] | ((unsigned)vs[(2 * i + 1) * 520 + t] << 16);
        u32x4* dst = (u32x4*)(WSP(bf16, WS_VTNA) + ((size_t)(b * 4 + (t >> 7)) * 128 + (t & 127)) * TS + j0);
#pragma unroll
        for (int k = 0; k < 4; ++k) dst[k] = (u32x4){wv[4 * k], wv[4 * k + 1], wv[4 * k + 2], wv[4 * k + 3]};
    }
    __syncthreads();
}

DI void ml_a_unit(Frame& F, int seq, int p) {
    const int b = seq >> 3, h = (seq >> 1) & 3, dir = seq & 1, tc = tc_of(dir, p), lane = F.lane;
    const float* P = WSP(float, WS_P);
    LAS bf16* VW = (LAS bf16*)F.lds;
    LAS bf16* KT = (LAS bf16*)(F.lds + 20736);
    LAS float* wgs = (LAS float*)(F.lds + 39168);
    if (F.wave == 0) {
        const int row = rowof(b, tc * 64 + lane);
        const float* gt = WSP(float, WS_GATES) + (size_t)row * 16;
        const float li = gt[dir * 4 + h], lf = gt[8 + dir * 4 + h];
        const float pre = wave_incl_scan(lf, lane), tot = __shfl(pre, 63);
        const float g = dir == 0 ? (tot - pre) + li : (pre - lf) + li;
        const float mloc = wave_max(g);
        wgs[lane] = __expf(g - mloc);
        if (lane == 0) { float* sc = WSP(float, WS_MLSC) + (size_t)(seq * 36 + p) * 4; sc[0] = tot; sc[1] = mloc; }
    }
    {
        float vv[16], kk[16];
#pragma unroll
        for (int it = 0; it < 16; ++it) { const int idx = F.tid + NTHR * it, n = idx >> 7, d = idx & 127;
            const float* pr = P + (size_t)rowof(b, tc * 64 + n) * DINP + h * 128 + d; vv[it] = pr[PC_MLV]; kk[it] = pr[PC_MLK]; }
        __syncthreads();
#pragma unroll
        for (int it = 0; it < 16; ++it) { const int idx = F.tid + NTHR * it, n = idx >> 7, d = idx & 127;
            VW[d * 72 + n] = (bf16)f2bf(vv[it] * wgs[n]); KT[d * 72 + n] = (bf16)f2bf(kk[it]); }
    }
    for (int idx = F.tid; idx < 16 * 64; idx += NTHR) { const int rr = idx >> 6, n = idx & 63; VW[(128 + rr) * 72 + n] = rr == 0 ? (bf16)f2bf(wgs[n]) : (bf16)0; }
    __syncthreads();
    float* U = WSP(float, WS_MLU) + (size_t)(seq * 36 + p) * (129 * 128);
    for (int id = F.wave; id < 72; id += 8) { const int dt = id >> 3, et = id & 7;
        const f32x4 acc = mma16<64>(VW + dt * 16 * 72, 72, KT + et * 16 * 72, 72, lane, (f32x4){0.f, 0.f, 0.f, 0.f});
#pragma unroll
        for (int i = 0; i < 4; ++i) { const int d = dt * 16 + 4 * (lane >> 4) + i; if (d < 129) U[d * 128 + et * 16 + (lane & 15)] = acc[i]; } }
    __syncthreads();
}

DI void ss_a_unit(Frame& F, int l, int b, int dir, int p, int g) {
    const int tc = tc_of(dir, p), lane = F.lane;
    LAS bf16* XT = (LAS bf16*)F.lds;
    LAS bf16* BT = (LAS bf16*)(F.lds + 36864);
    LAS float* tails = (LAS float*)(F.lds + 55296);
    const bf16* XBC = WSP(bf16, WS_XBC);
    if (F.wave < 4) {
        const int h = 4 * g + F.wave, row = rowof(b, tc * 64 + lane);
        const float dt = WSP(float, WS_DT)[(size_t)row * 16 + dir * 8 + h];
        const float A = -__expf(F.in[15][l * 16 + dir * 8 + h]);
        const float a = dt * A, pre = wave_incl_scan(a, lane), tot = __shfl(pre, 63);
        tails[F.wave * 64 + lane] = (dir == 0 ? __expf(tot - pre) : __expf(pre - a)) * dt;
        if (lane == 0) WSP(float, WS_SSSC)[(size_t)((b * 8 + h) * 2 + dir) * 36 + p] = __expf(tot);
    }
    {
        bf16 xv[32], bv[16];
#pragma unroll
        for (int it = 0; it < 32; ++it) { const int idx = F.tid + NTHR * it, n = idx >> 8, c = idx & 255; xv[it] = XBC[(size_t)rowof(b, tc * 64 + n) * 1024 + g * 256 + c]; }
#pragma unroll
        for (int it = 0; it < 16; ++it) { const int idx = F.tid + NTHR * it, n = idx >> 7, nn = idx & 127; bv[it] = XBC[(size_t)rowof(b, tc * 64 + n) * 1024 + 512 + g * 128 + nn]; }
        __syncthreads();
#pragma unroll
        for (int it = 0; it < 32; ++it) { const int idx = F.tid + NTHR * it, n = idx >> 8, c = idx & 255; XT[c * 72 + n] = (bf16)f2bf(bf2f(xv[it]) * tails[(c >> 6) * 64 + n]); }
#pragma unroll
        for (int it = 0; it < 16; ++it) { const int idx = F.tid + NTHR * it, n = idx >> 7, nn = idx & 127; BT[nn * 72 + n] = bv[it]; }
    }
    __syncthreads();
    for (int id = F.wave; id < 128; id += 8) { const int hh = id >> 5, rem = id & 31, pt = rem >> 3, nt = rem & 7;
        const f32x4 acc = mma16<64>(XT + (hh * 64 + pt * 16) * 72, 72, BT + nt * 16 * 72, 72, lane, (f32x4){0.f, 0.f, 0.f, 0.f});
        float* U = WSP(float, WS_SSU) + (size_t)(((b * 8 + 4 * g + hh) * 2 + dir) * 36 + p) * 8192;
#pragma unroll
        for (int i = 0; i < 4; ++i) U[(pt * 16 + 4 * (lane >> 4) + i) * 128 + nt * 16 + (lane & 15)] = acc[i]; }
    __syncthreads();
}
DI void ml_scan_unit(Frame& F, int seq, int s4) {
    float* sc = WSP(float, WS_MLSC) + (size_t)seq * 36 * 4;
    const float* U = WSP(float, WS_MLU) + (size_t)seq * 36 * 16512 + s4 * 4128 + F.tid; bf16* S = WSP(bf16, WS_MLS) + (size_t)seq * 36 * 16512 + s4 * 4128 + F.tid;
    float st[9]; float m = 0.f;
#pragma unroll
    for (int k = 0; k < 9; ++k) st[k] = 0.f;
    for (int pg = 0; pg < 36; pg += 6) {
        float u[6][9];
#pragma unroll
        for (int pp = 0; pp < 6; ++pp)
#pragma unroll
            for (int k = 0; k < 9; ++k) u[pp][k] = (F.tid + 512 * k < 4128) ? U[(size_t)(pg + pp) * 16512 + 512 * k] : 0.f;
#pragma unroll
        for (int pp = 0; pp < 6; ++pp) { const int p = pg + pp;
            const float bl = sc[p * 4], mloc = sc[p * 4 + 1];
            const float mn = fmaxf(bl + m, mloc), wc = __expf(bl + m - mn), wu = __expf(mloc - mn);
            if (s4 == 0 && F.tid == 0) sc[p * 4 + 2] = m;
#pragma unroll
            for (int k = 0; k < 9; ++k) { if (F.tid + 512 * k < 4128) S[(size_t)p * 16512 + 512 * k] = (bf16)f2bf(st[k]); st[k] = wc * st[k] + wu * u[pp][k]; }
            m = mn; }
    }
}
DI void ss_scan_unit(Frame& F, int sq, int half) {
    const float* dec = WSP(float, WS_SSSC) + (size_t)sq * 36;
    const float* U = WSP(float, WS_SSU) + (size_t)sq * 36 * 8192 + half * 4096 + F.tid; bf16* S = WSP(bf16, WS_SSS) + (size_t)sq * 36 * 8192 + half * 4096 + F.tid;
    float st[8];
#pragma unroll
    for (int k = 0; k < 8; ++k) st[k] = 0.f;
    for (int pg = 0; pg < 36; pg += 6) {
        float u[6][8];
#pragma unroll
        for (int pp = 0; pp < 6; ++pp)
#pragma unroll
            for (int k = 0; k < 8; ++k) u[pp][k] = U[(size_t)(pg + pp) * 8192 + 512 * k];
#pragma unroll
        for (int pp = 0; pp < 6; ++pp) { const int p = pg + pp; const float dc = dec[p];
#pragma unroll
            for (int k = 0; k < 8; ++k) { S[(size_t)p * 8192 + 512 * k] = (bf16)f2bf(st[k]); st[k] = st[k] * dc + u[pp][k]; } }
    }
}
DI void mla_post_unit(Frame& F, int l, int b, int tt) {
    const float* P = WSP(float, WS_P);
    const bf16* QRAW = WSP(bf16, WS_QRAW); const bf16* KVRAW = WSP(bf16, WS_KVRAW);
    const int j0 = tt * 32, lane = F.lane;
    LAS bf16* vs = (LAS bf16*)F.lds;
    const float* gq = F.in[22] + l * 192; const float* gk = F.in[23] + l * 192;
    for (int i = F.wave; i < 32; i += 8) {
        const int j = j0 + i, row = rowof(b, j); const bool lat = j < TL;
        const int a = lane & 31; const float pos = (float)(a < 16 ? (j >> 6) : (j & 63));
        const float fr = exp2f(-(float)(a & 15) * (13.287712379549449f / 16.f));
        const float ang = pos * fr; const float cs = cosf(ang), sn = sinf(ang);
        const float krv = P[(size_t)row * DINP + PC_KR + lane];
        float qv[4][3], kk[4][2]; bf16 vv[4][2];
#pragma unroll
        for (int h = 0; h < 4; ++h) { const bf16* q = QRAW + (size_t)row * 768 + h * 192; const bf16* kv = KVRAW + (size_t)row * 1024 + h * 256;
            qv[h][0] = bf2f(q[lane]); qv[h][1] = bf2f(q[64 + lane]); qv[h][2] = bf2f(q[128 + lane]);
            kk[h][0] = bf2f(kv[lane]); kk[h][1] = bf2f(kv[64 + lane]); vv[h][0] = kv[128 + lane]; vv[h][1] = kv[192 + lane]; }
#pragma unroll
        for (int h = 0; h < 4; ++h) {
            {
                const float v0 = qv[h][0], v1 = qv[h][1], v2 = qv[h][2];
                const float rstd = 1.0f / sqrtf(wave_sum(v0 * v0 + v1 * v1 + v2 * v2) * (1.f / 192.f) + EPS);
                const float n0 = v0 * rstd * gq[lane], n1 = v1 * rstd * gq[64 + lane]; float n2 = v2 * rstd * gq[128 + lane];
                const float pr = __shfl_xor(n2, 32);
                if (lat) n2 = lane < 32 ? n2 * cs - pr * sn : pr * sn + n2 * cs;
                bf16* o = WSP(bf16, WS_QMLA) + ((size_t)(b * 4 + h) * TS + j) * 192;
                o[lane] = (bf16)f2bf(n0); o[64 + lane] = (bf16)f2bf(n1); o[128 + lane] = (bf16)f2bf(n2);
            }
            {
                const float v0 = kk[h][0], v1 = kk[h][1], v2 = krv;
                const float rstd = 1.0f / sqrtf(wave_sum(v0 * v0 + v1 * v1 + v2 * v2) * (1.f / 192.f) + EPS);
                const float n0 = v0 * rstd * gk[lane], n1 = v1 * rstd * gk[64 + lane]; float n2 = v2 * rstd * gk[128 + lane];
                const float pr = __shfl_xor(n2, 32);
                if (lat) n2 = lane < 32 ? n2 * cs - pr * sn : pr * sn + n2 * cs;
                bf16* o = WSP(bf16, WS_KMLA) + ((size_t)(b * 4 + h) * TS + j) * 192;
                o[lane] = (bf16)f2bf(n0); o[64 + lane] = (bf16)f2bf(n1); o[128 + lane] = (bf16)f2bf(n2);
                vs[i * 520 + h * 128 + lane] = vv[h][0]; vs[i * 520 + h * 128 + 64 + lane] = vv[h][1];
            }
        }
    }
    __syncthreads();
    {
        const int t = F.tid; unsigned wv[16];
#pragma unroll
        for (int i = 0; i < 16; ++i) wv[i] = (unsigned)vs[(2 * i) * 520 + t] | ((unsigned)vs[(2 * i + 1) * 520 + t] << 16);
        u32x4* dst = (u32x4*)(WSP(bf16, WS_VTMLA) + ((size_t)(b * 4 + (t >> 7)) * 128 + (t & 127)) * TS + j0);
#pragma unroll
        for (int k = 0; k < 4; ++k) dst[k] = (u32x4){wv[4 * k], wv[4 * k + 1], wv[4 * k + 2], wv[4 * k + 3]};
    }
    __syncthreads();
}

template <int DK, bool NA>
DI void attn_unit(Frame& F, const bf16* Qg, const bf16* Kg, const bf16* VTg, int nA, int tA0, int nB, int tB0, float scale, bf16* Og, int qrow0, const float* rpb) {
    constexpr int KP = DK + 8, KCH = DK / 8, NKC = 64 * KCH / NTHR;
    LAS bf16* Ks = (LAS bf16*)F.lds;
    LAS bf16* VTs = (LAS bf16*)(F.lds + 64 * KP * 2);
    LAS bf16* Ps = (LAS bf16*)(F.lds + 64 * KP * 2 + 128 * 72 * 2) + F.wave * (16 * 72);
    LAS float* rp = (LAS float*)(F.lds + 64 * KP * 2 + 128 * 72 * 2 + 8 * 16 * 72 * 2);
    const int lane = F.lane, r = lane & 15, q = lane >> 4, tid = F.tid, w = F.wave;
    if (NA) { for (int i = tid; i < 15 * 31; i += NTHR) rp[i] = rpb[i]; }
    bf16x8 qf[DK / 32];
#pragma unroll
    for (int kk = 0; kk < DK / 32; ++kk) qf[kk] = *(const bf16x8*)(Qg + (size_t)(w * 16 + r) * DK + 32 * kk + 8 * q);
    f32x4 o[8]; float mrow[4], lrow[4];
#pragma unroll
    for (int d = 0; d < 8; ++d) o[d] = (f32x4){0.f, 0.f, 0.f, 0.f};
#pragma unroll
    for (int i = 0; i < 4; ++i) { mrow[i] = -1.0e30f; lrow[i] = 0.f; }
    const int ntile = nA + nB;
    u32x4 kreg[NKC], vreg[2];
    const int rq = qrow0 + (w >> 2);
    const int r0 = rq - 4 < 0 ? 0 : (rq - 4 > 24 ? 24 : rq - 4);
#define ATT_LOAD(kt) do { _Pragma("unroll") for (int c = 0; c < NKC; ++c) { const int id = tid + NTHR * c, rr = id / KCH, cc = id % KCH; kreg[c] = *(const u32x4*)(Kg + (size_t)((kt) * 64 + rr) * DK + cc * 8); } \
        _Pragma("unroll") for (int c = 0; c < 2; ++c) { const int id = tid + NTHR * c, dd = id >> 3, cc = id & 7; vreg[c] = *(const u32x4*)(VTg + (size_t)dd * TS + (kt) * 64 + cc * 8); } } while (0)
    ATT_LOAD(nA > 0 ? tA0 : tB0);
    for (int it = 0; it < ntile; ++it) {
        const int kt = it < nA ? tA0 + it : tB0 + (it - nA);
        __syncthreads();
#pragma unroll
        for (int c = 0; c < NKC; ++c) { const int id = tid + NTHR * c, rr = id / KCH, cc = id % KCH; *(LAS u32x4*)(Ks + rr * KP + cc * 8) = kreg[c]; }
#pragma unroll
        for (int c = 0; c < 2; ++c) { const int id = tid + NTHR * c, dd = id >> 3, cc = id & 7; *(LAS u32x4*)(VTs + dd * 72 + cc * 8) = vreg[c]; }
        __syncthreads();
        if (it + 1 < ntile) { const int kn = (it + 1) < nA ? tA0 + it + 1 : tB0 + (it + 1 - nA); ATT_LOAD(kn); }
        const bool nbt = NA && kt < 32;
        if (nbt && (kt < r0 || kt >= r0 + 8)) continue;
        f32x4 s[4];
#pragma unroll
        for (int n = 0; n < 4; ++n) s[n] = (f32x4){0.f, 0.f, 0.f, 0.f};
#pragma unroll
        for (int kk = 0; kk < DK / 32; ++kk)
#pragma unroll
            for (int n = 0; n < 4; ++n) { const bf16x8 kf = *(const LAS bf16x8*)(Ks + (n * 16 + r) * KP + 32 * kk + 8 * q); s[n] = __builtin_amdgcn_mfma_f32_16x16x32_bf16(qf[kk], kf, s[n], 0, 0, 0); }
        float mx[4];
#pragma unroll
        for (int i = 0; i < 4; ++i) mx[i] = -1.0e30f;
#pragma unroll
        for (int n = 0; n < 4; ++n)
#pragma unroll
            for (int i = 0; i < 4; ++i) {
                float v = s[n][i] * scale;
                if (nbt) { const int c = (w & 3) * 16 + 4 * q + i, kc = n * 16 + r; const int c0 = c - 8 < 0 ? 0 : (c - 8 > 48 ? 48 : c - 8);
                    v = (kc >= c0 && kc < c0 + 16) ? v + rp[(kt - rq + 7) * 31 + (kc - c + 15)] : -1.0e30f; }
                s[n][i] = v; mx[i] = fmaxf(mx[i], v);
            }
        float alpha[4], rs[4];
#pragma unroll
        for (int i = 0; i < 4; ++i) {
            float m = mx[i]; m = fmaxf(m, __shfl_xor(m, 1)); m = fmaxf(m, __shfl_xor(m, 2)); m = fmaxf(m, __shfl_xor(m, 4)); m = fmaxf(m, __shfl_xor(m, 8));
            const float mn = fmaxf(mrow[i], m); alpha[i] = __expf(mrow[i] - mn); mrow[i] = mn; rs[i] = 0.f;
        }
#pragma unroll
        for (int n = 0; n < 4; ++n)
#pragma unroll
            for (int i = 0; i < 4; ++i) { const float pv = __expf(s[n][i] - mrow[i]); rs[i] += pv; Ps[(4 * q + i) * 72 + n * 16 + r] = (bf16)f2bf(pv); }
#pragma unroll
        for (int i = 0; i < 4; ++i) {
            float t = rs[i]; t += __shfl_xor(t, 1); t += __shfl_xor(t, 2); t += __shfl_xor(t, 4); t += __shfl_xor(t, 8);
            lrow[i] = lrow[i] * alpha[i] + t;
        }
#pragma unroll
        for (int d = 0; d < 8; ++d)
#pragma unroll
            for (int i = 0; i < 4; ++i) o[d][i] *= alpha[i];
        asm volatile("s_waitcnt lgkmcnt(0)" ::: "memory");
#pragma unroll
        for (int kk = 0; kk < 2; ++kk) { const bf16x8 pf = *(const LAS bf16x8*)(Ps + r * 72 + 32 * kk + 8 * q);
#pragma unroll
            for (int d = 0; d < 8; ++d) { const bf16x8 vf = *(const LAS bf16x8*)(VTs + (d * 16 + r) * 72 + 32 * kk + 8 * q); o[d] = __builtin_amdgcn_mfma_f32_16x16x32_bf16(pf, vf, o[d], 0, 0, 0); } }
    }
#undef ATT_LOAD
#pragma unroll
    for (int i = 0; i < 4; ++i) { const float inv = 1.0f / lrow[i]; bf16* op = Og + (size_t)(w * 16 + 4 * q + i) * D + r;
#pragma unroll
        for (int d = 0; d < 8; ++d) op[d * 16] = (bf16)f2bf(o[d][i] * inv); }
    __syncthreads();
}
DI void ml_c_unit(Frame& F, int seq, int p) {
    const int b = seq >> 3, h = (seq >> 1) & 3, dir = seq & 1, tc = tc_of(dir, p), lane = F.lane, tid = F.tid;
    const float* P = WSP(float, WS_P);
    constexpr float QS = 0.08838834764831845f;
    LAS bf16* Qs = (LAS bf16*)F.lds;
    LAS bf16* Ksm = (LAS bf16*)(F.lds + 17408);
    LAS bf16* VT = (LAS bf16*)(F.lds + 34816);
    LAS bf16* Cx = (LAS bf16*)(F.lds + 55552);
    LAS bf16* SW = (LAS bf16*)(F.lds + 94720);
    LAS float* av = (LAS float*)(F.lds + 103936);
    LAS float* Mt = av + 64;
    LAS float* Bt = av + 128;
    LAS float* den = av + 192;
    const float m_p = WSP(float, WS_MLSC)[(size_t)(seq * 36 + p) * 4 + 2];
    if (F.wave == 0) {
        const int row = rowof(b, tc * 64 + lane);
        const float* gt = WSP(float, WS_GATES) + (size_t)row * 16;
        const float li = gt[dir * 4 + h], lf = gt[8 + dir * 4 + h];
        const float pre = wave_incl_scan(lf, lane), tot = __shfl(pre, 63);
        const float B = dir == 0 ? pre : (tot - pre) + lf;
        const float a = li - B;
        float cm = a;
#pragma unroll
        for (int o = 1; o < 64; o <<= 1) { const float t = dir == 0 ? __shfl_up(cm, o) : __shfl_down(cm, o); const bool ok = dir == 0 ? (lane >= o) : (lane + o < 64); if (ok) cm = fmaxf(cm, t); }
        av[lane] = a; Mt[lane] = fmaxf(m_p, cm); Bt[lane] = B;
    }
    {
        float qq[16], kk[16], vv[16]; u32x4 cx[5];
        const bf16* Sg = WSP(bf16, WS_MLS) + (size_t)(seq * 36 + p) * 16512;
#pragma unroll
        for (int it = 0; it < 16; ++it) { const int idx = tid + NTHR * it, n = idx >> 7, d = idx & 127;
            const float* pr = P + (size_t)rowof(b, tc * 64 + n) * DINP + h * 128 + d; qq[it] = pr[PC_MLQ]; kk[it] = pr[PC_MLK]; vv[it] = pr[PC_MLV]; }
#pragma unroll
        for (int it = 0; it < 5; ++it) { const int idx = tid + NTHR * it, rr = idx >> 4, cc = idx & 15; cx[it] = (idx < 144 * 16 && rr < 129) ? *(const u32x4*)(Sg + rr * 128 + cc * 8) : (u32x4){0u, 0u, 0u, 0u}; }
#pragma unroll
        for (int it = 0; it < 16; ++it) { const int idx = tid + NTHR * it, n = idx >> 7, d = idx & 127;
            Qs[n * 136 + d] = (bf16)f2bf(qq[it]); Ksm[n * 136 + d] = (bf16)f2bf(kk[it]); VT[d * 72 + n] = (bf16)f2bf(vv[it]); }
#pragma unroll
        for (int it = 0; it < 5; ++it) { const int idx = tid + NTHR * it, rr = idx >> 4, cc = idx & 15; if (idx < 144 * 16) *(LAS u32x4*)(Cx + rr * 136 + cc * 8) = cx[it]; }
    }
    for (int idx = tid; idx < 16 * 64; idx += NTHR) { const int rr = idx >> 6, n = idx & 63; VT[(128 + rr) * 72 + n] = rr == 0 ? (bf16)0x3f80 : (bf16)0; }
    __syncthreads();
    for (int id = F.wave; id < 16; id += 8) { const int tt = id >> 2, st = id & 3;
        const bool skip = dir == 0 ? st > tt : st < tt;
        f32x4 acc = (f32x4){0.f, 0.f, 0.f, 0.f};
        if (!skip) acc = mma16<128>(Qs + tt * 16 * 136, 136, Ksm + st * 16 * 136, 136, lane, acc);
        const int s = st * 16 + (lane & 15); const float as = av[s];
#pragma unroll
        for (int i = 0; i < 4; ++i) { const int t = tt * 16 + 4 * (lane >> 4) + i; const bool ok = !skip && (dir == 0 ? s <= t : s >= t);
            SW[t * 72 + s] = (bf16)f2bf(ok ? acc[i] * QS * __expf(as - Mt[t]) : 0.f); } }
    __syncthreads();
    const int tt = F.wave & 3, d0 = F.wave < 4 ? 0 : 5, nd = F.wave < 4 ? 5 : 4;
    f32x4 val[5];
#pragma unroll
    for (int k = 0; k < 5; ++k) { val[k] = (f32x4){0.f, 0.f, 0.f, 0.f};
        if (k < nd) { const int dt = d0 + k;
            const f32x4 a1 = mma16<64>(SW + tt * 16 * 72, 72, VT + dt * 16 * 72, 72, lane, (f32x4){0.f, 0.f, 0.f, 0.f});
            const f32x4 a2 = mma16<128>(Qs + tt * 16 * 136, 136, Cx + dt * 16 * 136, 136, lane, (f32x4){0.f, 0.f, 0.f, 0.f});
#pragma unroll
            for (int i = 0; i < 4; ++i) { const int t = tt * 16 + 4 * (lane >> 4) + i; val[k][i] = a1[i] + a2[i] * QS * __expf(m_p - Mt[t]); }
            if (dt == 8 && (lane & 15) == 0) {
#pragma unroll
                for (int i = 0; i < 4; ++i) den[tt * 16 + 4 * (lane >> 4) + i] = val[k][i]; } } }
    __syncthreads();
    float* H = WSP(float, WS_HML) + (size_t)dir * MTOK * 512;
#pragma unroll
    for (int k = 0; k < 5; ++k) { const int dt = d0 + k; if (k < nd && dt < 8) {
#pragma unroll
        for (int i = 0; i < 4; ++i) { const int t = tt * 16 + 4 * (lane >> 4) + i;
            const float dn = fmaxf(fabsf(den[t]), __expf(-(Bt[t] + Mt[t])));
            H[(size_t)rowof(b, tc * 64 + t) * 512 + h * 128 + dt * 16 + (lane & 15)] = val[k][i] / dn; } } }
    __syncthreads();
}

DI void ss_c_unit(Frame& F, int l, int sq, int p) {
    const int b = sq >> 4, h = (sq >> 1) & 7, dir = sq & 1, g = h >> 2, tc = tc_of(dir, p), lane = F.lane, tid = F.tid;
    const bf16* XBC = WSP(bf16, WS_XBC);
    LAS bf16* Cm = (LAS bf16*)F.lds;
    LAS bf16* Bm = (LAS bf16*)(F.lds + 17408);
    LAS bf16* XT = (LAS bf16*)(F.lds + 34816);
    LAS bf16* Sx = (LAS bf16*)(F.lds + 44032);
    LAS bf16* W = (LAS bf16*)(F.lds + 61440);
    LAS float* cum = (LAS float*)(F.lds + 70656);
    LAS float* dtv = cum + 64;
    if (F.wave == 0) {
        const int row = rowof(b, tc * 64 + lane);
        const float dt = WSP(float, WS_DT)[(size_t)row * 16 + dir * 8 + h];
        const float A = -__expf(F.in[15][l * 16 + dir * 8 + h]);
        const float a = dt * A, pre = wave_incl_scan(a, lane), tot = __shfl(pre, 63);
        cum[lane] = dir == 0 ? pre : (tot - pre) + a; dtv[lane] = dt;
    }
    {
        u32x4 bb[2], cc_[2], sx[2]; bf16 xx[8];
        const bf16* Sg = WSP(bf16, WS_SSS) + (size_t)(sq * 36 + p) * 8192;
#pragma unroll
        for (int it = 0; it < 2; ++it) { const int idx = tid + NTHR * it, n = idx >> 4, cc = idx & 15; const bf16* xr = XBC + (size_t)rowof(b, tc * 64 + n) * 1024;
            bb[it] = *(const u32x4*)(xr + 512 + g * 128 + cc * 8); cc_[it] = *(const u32x4*)(xr + 768 + g * 128 + cc * 8); sx[it] = *(const u32x4*)(Sg + n * 128 + cc * 8); }
#pragma unroll
        for (int it = 0; it < 8; ++it) { const int idx = tid + NTHR * it, n = idx >> 6, pp = idx & 63; xx[it] = XBC[(size_t)rowof(b, tc * 64 + n) * 1024 + h * 64 + pp]; }
#pragma unroll
        for (int it = 0; it < 2; ++it) { const int idx = tid + NTHR * it, n = idx >> 4, cc = idx & 15;
            *(LAS u32x4*)(Bm + n * 136 + cc * 8) = bb[it]; *(LAS u32x4*)(Cm + n * 136 + cc * 8) = cc_[it]; *(LAS u32x4*)(Sx + n * 136 + cc * 8) = sx[it]; }
#pragma unroll
        for (int it = 0; it < 8; ++it) { const int idx = tid + NTHR * it, n = idx >> 6, pp = idx & 63; XT[pp * 72 + n] = xx[it]; }
    }
    __syncthreads();
    for (int id = F.wave; id < 16; id += 8) { const int tt = id >> 2, st = id & 3;
        const bool skip = dir == 0 ? st > tt : st < tt;
        f32x4 acc = (f32x4){0.f, 0.f, 0.f, 0.f};
        if (!skip) acc = mma16<128>(Cm + tt * 16 * 136, 136, Bm + st * 16 * 136, 136, lane, acc);
        const int s = st * 16 + (lane & 15); const float cs = cum[s], ds = dtv[s];
#pragma unroll
        for (int i = 0; i < 4; ++i) { const int t = tt * 16 + 4 * (lane >> 4) + i; const bool ok = !skip && (dir == 0 ? s <= t : s >= t);
            W[t * 72 + s] = (bf16)f2bf(ok ? acc[i] * __expf(cum[t] - cs) * ds : 0.f); } }
    __syncthreads();
    float* Y = WSP(float, WS_YSS) + (size_t)dir * MTOK * 512;
    for (int id = F.wave; id < 16; id += 8) { const int tt = id >> 2, pt = id & 3;
        const f32x4 a1 = mma16<64>(W + tt * 16 * 72, 72, XT + pt * 16 * 72, 72, lane, (f32x4){0.f, 0.f, 0.f, 0.f});
        const f32x4 a2 = mma16<128>(Cm + tt * 16 * 136, 136, Sx + pt * 16 * 136, 136, lane, (f32x4){0.f, 0.f, 0.f, 0.f});
#pragma unroll
        for (int i = 0; i < 4; ++i) { const int t = tt * 16 + 4 * (lane >> 4) + i;
            Y[(size_t)rowof(b, tc * 64 + t) * 512 + h * 64 + pt * 16 + (lane & 15)] = a1[i] + a2[i] * __expf(cum[t]); } }
    __syncthreads();
}

DI void m5_finish_phase(Frame& F, int l, int nrows) {
    const int gw = F.bid * NWAVES + F.wave, NGW = F.G * NWAVES, lane = F.lane;
    const float* P = WSP(float, WS_P); const float* H0 = WSP(float, WS_HML); const float* H1 = H0 + (size_t)MTOK * 512;
    const float* Y0 = WSP(float, WS_YSS); const float* Y1 = Y0 + (size_t)MTOK * 512; const bf16* XBC = WSP(bf16, WS_XBC);
    bf16* A2 = WSP(bf16, WS_A2);
    for (int row = gw; row < nrows; row += NGW) {
        const float* p = P + (size_t)row * DINP;
#pragma unroll
        for (int h = 0; h < 4; ++h) {
            const int c0 = h * 128 + lane, c1 = c0 + 64;
            const float v0 = H0[(size_t)row * 512 + c0] + H1[(size_t)row * 512 + c0], v1 = H0[(size_t)row * 512 + c1] + H1[(size_t)row * 512 + c1];
            const float rstd = 1.0f / sqrtf(wave_sum(v0 * v0 + v1 * v1) * (1.f / 128.f) + EPS);
            const float* gn = F.in[11] + l * 512;
            A2[(size_t)row * D + c0] = (bf16)f2bf(v0 * rstd * gn[c0] * sigmoidf_(p[PC_MLO + c0]));
            A2[(size_t)row * D + c1] = (bf16)f2bf(v1 * rstd * gn[c1] * sigmoidf_(p[PC_MLO + c1]));
        }
        float y[8]; float ss = 0.f;
#pragma unroll
        for (int u = 0; u < 8; ++u) { const int c = lane + 64 * u;
            float v = Y0[(size_t)row * 512 + c] + Y1[(size_t)row * 512 + c] + F.in[16][l * 8 + u] * bf2f(XBC[(size_t)row * 1024 + c]);
            v *= siluf(p[PC_Z + c]); y[u] = v; ss += v * v; }
        const float rstd = 1.0f / sqrtf(wave_sum(ss) * (1.f / 512.f) + EPS);
        const float* sn = F.in[17] + l * 512;
#pragma unroll
        for (int u = 0; u < 8; ++u) { const int c = lane + 64 * u; A2[(size_t)row * D + 512 + c] = (bf16)f2bf(y[u] * rstd * sn[c]); }
    }
}
#ifndef PROBE_MASK
#define PROBE_MASK 0ull
#endif
#define NREP(k) ((((unsigned long long)(PROBE_MASK) >> (k)) & 1ull) ? 2 : 1)
#ifndef UNIT_REP
#define UNIT_REP 0
#endif
#define UREP(i) for (int rp_ = 0; rp_ <= ((F.rep >> (i)) & 1); ++rp_)
#ifndef ONE_LAUNCH
#define ONE_LAUNCH 1
#endif
#define IN(k) (lo <= (k) && (k) < hi)
#define SEAM(k) do { if (ONE_LAUNCH && hi > (k) + 1) xcd_barrier(bar); } while (0)
template <int l> DI void layer_phases(Frame& F, const XcdBarrier& bar, const int lo, const int hi) {
    LAS int* mtb = (LAS int*)(F.lds + RING_BYTES);
        const int pb = 1 + 16 * l;
        const bool wc = (l == 0);
        const int nrows = wc ? MTOK : MLAT;
        const float* modl = WSP(float, WS_MOD) + (size_t)l * 5 * D6;
        if (IN(pb + 0)) {
            if (l == 0) norm_phase<false>(F, l, F.in[0], F.in[2], F.in[6] + l * D, 0, MTOK);
            else norm_phase<false>(F, l, WSP(float, WS_X), WSP(float, WS_X) + (size_t)MLAT * D, F.in[6] + l * D, 0, MTOK);
            SEAM(pb + 0);
        }
        if (IN(pb + 1)) {
            pg8::Gemm g{WSP(bf16, WS_HN), WSP(bf16, WS_WIN) + (size_t)l * DINP * D, D}; pg8::StaticOrder S; S.init(MTOK / 256, DINP / 256, F.G, F.bid);
            EpiF32 E{WSP(float, WS_P), DINP};
            pg8::gemm_phase<EpiF32, pg8::StaticOrder>(F.lds, g, S, E);
            SEAM(pb + 1);
        }
        if (IN(pb + 2)) {
            for (int u = F.bid; u < NB * 72; u += F.G) m1_prep_unit(F, l, u / 72, u % 72);
            SEAM(pb + 2);
        }
        if (IN(pb + 3)) {
            { pg8::Gemm g{WSP(bf16, WS_CQN), WSP(bf16, WS_WQB) + (size_t)l * 768 * 512, 512}; pg8::StaticOrder S; S.init(MTOK / 256, 3, F.G, F.bid);
              EpiBf16 E{WSP(bf16, WS_QRAW), 768}; pg8::gemm_phase<EpiBf16, pg8::StaticOrder>(F.lds, g, S, E); }
            __syncthreads();
            { pg8::Gemm g{WSP(bf16, WS_CKVN), WSP(bf16, WS_WKVB) + (size_t)l * 1024 * 256, 256}; pg8::StaticOrder S; S.init(MTOK / 256, 4, F.G, (F.bid + 128) % F.G);
              EpiBf16 E{WSP(bf16, WS_KVRAW), 1024}; pg8::gemm_phase<EpiBf16, pg8::StaticOrder>(F.lds, g, S, E); }
            __syncthreads();
            UREP(2) for (int u = F.bid; u < 1152; u += F.G) ml_a_unit(F, u / 36, u % 36);
            UREP(3) for (int v = (F.bid + 128) % F.G; v < 576; v += F.G) ss_a_unit(F, l, v / 144, (v / 72) & 1, (v % 72) >> 1, v & 1);
            SEAM(pb + 3);
        }
        if (IN(pb + 4)) {
            UREP(4) for (int u = F.bid; u < 256; u += F.G) {
                const int bh = u >> 4, qb = u & 15, b = bh >> 2, h = bh & 3;
                const int r0a = 2 * qb - 4 < 0 ? 0 : (2 * qb - 4 > 24 ? 24 : 2 * qb - 4), r0b = 2 * qb - 3 < 0 ? 0 : (2 * qb - 3 > 24 ? 24 : 2 * qb - 3);
                attn_unit<128, true>(F, WSP(bf16, WS_QNA) + ((size_t)bh * TS + qb * 128) * 128, WSP(bf16, WS_KNA) + (size_t)bh * TS * 128, WSP(bf16, WS_VTNA) + (size_t)bh * 128 * TS,
                                     4, 32, r0b + 8 - r0a, r0a, 0.08838834764831845f,
                                     WSP(bf16, WS_A2) + (size_t)(b * TL + qb * 128) * D + 1536 + h * 128, 2 * qb, F.in[26] + (size_t)(l * 4 + h) * 15 * 31);
            }
            if (wc) UREP(5) for (int v = F.bid; v < 32; v += F.G) {
                const int bh2 = v >> 1, qc = v & 1, b2 = bh2 >> 2, h2 = bh2 & 3;
                attn_unit<128, false>(F, WSP(bf16, WS_QNA) + ((size_t)bh2 * TS + TL + qc * 128) * 128, WSP(bf16, WS_KNA) + (size_t)bh2 * TS * 128, WSP(bf16, WS_VTNA) + (size_t)bh2 * 128 * TS,
                                      4, 32, 0, 0, 0.08838834764831845f, WSP(bf16, WS_A2) + (size_t)(MLAT + b2 * TC + qc * 128) * D + 1536 + h2 * 128, 0, nullptr);
            }
            UREP(6) for (int v = (F.bid + 32) % F.G; v < 128; v += F.G) ml_scan_unit(F, v >> 2, v & 3);
            UREP(7) for (int v = (F.bid + 96) % F.G; v < 128; v += F.G) ss_scan_unit(F, v >> 1, v & 1);
            UREP(8) for (int v = F.bid; v < 288; v += F.G) mla_post_unit(F, l, v / 72, v % 72);
            SEAM(pb + 4);
        }
        if (IN(pb + 5)) {
            const int p0 = wc ? 0 : 4, npp = 36 - p0;
            UREP(9) for (int u = F.bid; u < 256; u += F.G) { const int bh = u >> 4, qb = u & 15, b = bh >> 2, h = bh & 3;
                attn_unit<192, false>(F, WSP(bf16, WS_QMLA) + ((size_t)bh * TS + qb * 128) * 192, WSP(bf16, WS_KMLA) + (size_t)bh * TS * 192, WSP(bf16, WS_VTMLA) + (size_t)bh * 128 * TS,
                                      36, 0, 0, 0, 0.07216878364870322f, WSP(bf16, WS_A2) + (size_t)(b * TL + qb * 128) * D + 1024 + h * 128, 0, nullptr); }
            if (wc) UREP(10) for (int v = F.bid; v < 32; v += F.G) { const int bh = v >> 1, qc = v & 1, b = bh >> 2, h = bh & 3;
                attn_unit<192, false>(F, WSP(bf16, WS_QMLA) + ((size_t)bh * TS + TL + qc * 128) * 192, WSP(bf16, WS_KMLA) + (size_t)bh * TS * 192, WSP(bf16, WS_VTMLA) + (size_t)bh * 128 * TS,
                                      4, 32, 0, 0, 0.07216878364870322f, WSP(bf16, WS_A2) + (size_t)(MLAT + b * TC + qc * 128) * D + 1024 + h * 128, 0, nullptr); }
            UREP(11) for (int v = (F.bid + 32) % F.G; v < 32 * npp; v += F.G) ml_c_unit(F, v / npp, p0 + v % npp);
            UREP(12) for (int v = (F.bid + 160) % F.G; v < 64 * npp; v += F.G) ss_c_unit(F, l, v / npp, p0 + v % npp);
            SEAM(pb + 5);
        }
        if (IN(pb + 6)) { m5_finish_phase(F, l, nrows); SEAM(pb + 6); }
        if (IN(pb + 7)) {
            pg8::Gemm g{WSP(bf16, WS_A2), WSP(bf16, WS_WOUT) + (size_t)l * D * D, D}; pg8::StaticOrder S; S.init(nrows / 256, D / 256, F.G, F.bid);
            EpiResid E{l == 0 ? F.in[0] : WSP(float, WS_X), l == 0 ? F.in[2] : WSP(float, WS_X) + (size_t)MLAT * D, WSP(float, WS_X), modl + 2 * D};
            pg8::gemm_phase<EpiResid, pg8::StaticOrder>(F.lds, g, S, E);
            SEAM(pb + 7);
        }
        if (IN(pb + 8)) {
            if (l == 0) norm_phase<false>(F, l, WSP(float, WS_X), WSP(float, WS_X) + (size_t)MLAT * D, F.in[27] + l * D, 3 * D, nrows);
            else norm_phase<true>(F, l, WSP(float, WS_X), WSP(float, WS_X) + (size_t)MLAT * D, F.in[27] + l * D, 3 * D, nrows);
            SEAM(pb + 8);
        }
        if (l == 0) {
            if (IN(pb + 10)) {
                pg8::Gemm g{WSP(bf16, WS_HN), WSP(bf16, WS_W13), D}; pg8::StaticOrder S; S.init(MTOK / 256, 2 * FF / 256, F.G, F.bid);
                EpiSwiglu E{WSP(bf16, WS_G), FF}; pg8::gemm_phase<EpiSwiglu, pg8::StaticOrder>(F.lds, g, S, E);
                SEAM(pb + 10);
            }
            if (IN(pb + 11)) {
                pg8::Gemm g{WSP(bf16, WS_G), WSP(bf16, WS_W2), FF}; pg8::StaticOrder S; S.init(MTOK / 256, D / 256, F.G, F.bid);
                EpiResid E{WSP(float, WS_X), WSP(float, WS_X) + (size_t)MLAT * D, WSP(float, WS_X), modl + 5 * D};
                pg8::gemm_phase<EpiResid, pg8::StaticOrder>(F.lds, g, S, E);
                SEAM(pb + 11);
            }
        } else {
            if (IN(pb + 9)) { moe_gather_phase(F); SEAM(pb + 9); }
            if (IN(pb + 10)) {
                __syncthreads(); moe_tables(F, mtb, 2 * FE / 256);
                pg8::Gemm g{WSP(bf16, WS_XG), WSP(bf16, WS_MW13), D}; MoeOrder S{mtb, 2 * FE / 256, F.G, F.bid};
                EpiSwiglu E{WSP(bf16, WS_G), FE}; pg8::gemm_phase<EpiSwiglu, MoeOrder>(F.lds, g, S, E);
                SEAM(pb + 10);
            }
            if (IN(pb + 11)) {
                __syncthreads(); moe_tables(F, mtb, D / 256);
                pg8::Gemm g{WSP(bf16, WS_G), WSP(bf16, WS_MW2), FE}; MoeOrder S{mtb, D / 256, F.G, F.bid};
                EpiF32 E{WSP(float, WS_Y), D}; pg8::gemm_phase<EpiF32, MoeOrder>(F.lds, g, S, E);
                SEAM(pb + 11);
            }
            if (IN(pb + 12)) { moe_combine_phase(F, l); }
        }
}
__global__ void __launch_bounds__(NTHR, 2) fwd_kernel(Args args) {
    extern __shared__ __attribute__((aligned(16))) unsigned char lds[];
    Frame F;
    F.lds = (LAS unsigned char*)lds; F.ws = args.ws; F.out = args.out;
#pragma unroll
    for (int i = 0; i < 35; ++i) F.in[i] = args.in[i];
    F.tid = threadIdx.x; F.lane = F.tid & 63; F.wave = __builtin_amdgcn_readfirstlane(F.tid >> 6); F.G = gridDim.x; F.bid = blockIdx.x; F.rep = args.rep;
    volatile LAS unsigned* MISC = (volatile LAS unsigned*)(F.lds + MISC_OFF);
    if (F.tid < 64) MISC[F.tid] = 0u;
    __syncthreads();
    XcdBarrier bar; bar.bar = WSP(unsigned, WS_CTL) + CW_BAR; bar.x = 0; bar.st = nullptr;
    if (ONE_LAUNCH) bar = xcd_barrier_post(WSP(unsigned, WS_CTL) + CW_BAR, MISC + 8);
    const int lo = args.ph_lo, hi = args.ph_hi;

    if (IN(0)) { p0_prologue(F); SEAM(0); }

    layer_phases<0>(F, bar, lo, hi);
    layer_phases<1>(F, bar, lo, hi);
#undef IN
#undef SEAM
}

extern "C" void kernel_launch(void* const* d_in, const int* in_sizes, int n_in, void* d_out, int out_size, void* d_ws, size_t ws_size, hipStream_t stream) {
    static int grid = 0;
    if (grid == 0) {
        if (n_in != 35 || out_size != MLAT * D || ws_size < WS_END) { fprintf(stderr, "kernel_launch: unexpected shapes (n_in %d out %d ws %zu need %zu)\n", n_in, out_size, ws_size, (size_t)WS_END); grid = -1; return; }
        int dev = 0, cus = 0, per_cu = 0;
        if (hipGetDevice(&dev) != hipSuccess || hipDeviceGetAttribute(&cus, hipDeviceAttributeMultiprocessorCount, dev) != hipSuccess) { grid = -1; return; }
        if (hipFuncSetAttribute((const void*)fwd_kernel, hipFuncAttributeMaxDynamicSharedMemorySize, LDS_BYTES) != hipSuccess) { fprintf(stderr, "kernel_launch: hipFuncSetAttribute failed\n"); grid = -1; return; }
        if (hipOccupancyMaxActiveBlocksPerMultiprocessor(&per_cu, (const void*)fwd_kernel, NTHR, LDS_BYTES) != hipSuccess || per_cu < 1) { fprintf(stderr, "kernel_launch: occupancy query says %d\n", per_cu); }
        (void)hipGetLastError();
        grid = cus;
    }
    if (grid < 0) return;
    (void)hipMemsetAsync((char*)d_ws + WS_CTL, 0, CTL_ZERO_BYTES, stream);
    Args a{};
    for (int i = 0; i < 35; ++i) a.in[i] = (const float*)d_in[i];
    a.out = (float*)d_out; a.ws = (unsigned char*)d_ws; a.rep = UNIT_REP;
#if ONE_LAUNCH
    a.ph_lo = 0; a.ph_hi = 64;
    hipLaunchKernelGGL(fwd_kernel, dim3(grid), dim3(NTHR), LDS_BYTES, stream, a);
#else
    static const int phases[] = {0, 1, 2, 3, 4, 5, 6, 7, 8, 9, 11, 12, 17, 18, 19, 20, 21, 22, 23, 24, 25, 26, 27, 28, 29};
    for (int k = 0; k < (int)(sizeof(phases) / sizeof(phases[0])); ++k) {
        a.ph_lo = phases[k]; a.ph_hi = phases[k] + 1;
        for (int rp = 0; rp < NREP(phases[k]); ++rp) hipLaunchKernelGGL(fwd_kernel, dim3(grid), dim3(NTHR), LDS_BYTES, stream, a);
    }
#endif
}
```

```cpp
#define NCV_P 48
#define NCV_OUT 96
#define NCV_UP 24
#define NCV_DOWN 96
#define FILL_MASK 0x7fffffffull
#define PROBE_MASK (0ull)
#define ONE_LAUNCH 1
#define UNIT_REP 0
#include <hip/hip_runtime.h>
#include <cstdio>
#include <cstdint>

#define DI __device__ __forceinline__
#define LAS __attribute__((address_space(3)))
#define GAS __attribute__((address_space(1)))
typedef unsigned short bf16;
typedef short bf16x8 __attribute__((ext_vector_type(8)));
typedef float f32x4 __attribute__((ext_vector_type(4)));
typedef float f32x2 __attribute__((ext_vector_type(2)));
typedef unsigned u32x4 __attribute__((ext_vector_type(4)));
typedef unsigned u32x2 __attribute__((ext_vector_type(2)));

namespace pg8 {
constexpr int BM = 256, BK = 64, HALF = 128, HTB = HALF * BK * 2, STAGE_BYTES = 8 * HTB, NXCD = 8, WGM = 8;
__host__ __device__ __forceinline__ int lds_byte(int r, int c) { const int st = (r >> 4) * 2 + (c >> 5), rr = r & 15, cc = c & 31, ob = rr * 64 + cc * 2; return st * 1024 + (ob ^ (((ob >> 9) & 1) << 5)); }
__host__ __device__ __forceinline__ void stage_rc(int b, int& R, int& C) { const int st = b / 1024, sb = b % 1024, swz = sb ^ (((sb >> 9) & 1) << 5); R = (st >> 1) * 16 + swz / 64; C = (st & 1) * 32 + (swz % 64) / 2; }
__host__ __device__ __forceinline__ int perm32(int rho) { const int n = rho >> 4, i = rho & 15; return 8 * (i >> 2) + 4 * n + (i & 3); }

struct Unit { int pm, pn, pb; };
struct Gemm { const bf16* A; const bf16* Bt; int K; };

DI int xcd_remap(int L, int nwg) { const int q = nwg / NXCD, r = nwg % NXCD, xcd = L % NXCD, off = L / NXCD; return (xcd < r ? xcd * (q + 1) : r * (q + 1) + (xcd - r) * q) + off; }

struct StaticOrder {
    int nM, nN, nwg, G, c;
    DI void init(int nM_, int nN_, int G_, int c_) { nM = nM_; nN = nN_; nwg = nM * nN; G = G_; c = c_; }
    DI bool next(int i, Unit& u) const {
        const long L = (long)i * G + c; if (L >= nwg) return false;
        const int wgid = xcd_remap((int)L, nwg);
        const int nig = WGM * nN, gid = wgid / nig, fm = gid * WGM, gsz = (nM - fm) < WGM ? (nM - fm) : WGM;
        u.pm = fm + ((wgid % nig) % gsz); u.pn = (wgid % nig) / gsz; u.pb = u.pn; return true;
    }
};

DI unsigned cvt_pk_bf16(float lo, float hi) { unsigned r; asm volatile("v_cvt_pk_bf16_f32 %0, %1, %2" : "=v"(r) : "v"(lo), "v"(hi)); return r; }

template <class Epi, class Sched, bool ALIGN_EPI = true>
DI void gemm_phase(LAS unsigned char* lds, const Gemm g, const Sched& S, const Epi& E) {
    const int tid = threadIdx.x, wid = __builtin_amdgcn_readfirstlane(tid >> 6), lane = tid & 63, wr = wid >> 2, wc = wid & 3, fr = lane & 15, fq = lane >> 4;
    const int K = g.K, nt = K / BK;
    unsigned voffA[2], voffB[2];
#pragma unroll
    for (int i = 0; i < 2; ++i) { int R, C; stage_rc(tid * 16 + i * 8192, R, C); const int Rb = Epi::PERM ? ((R & ~31) + perm32(R & 31)) : R;
        voffA[i] = (unsigned)(R * K + C) * 2u; voffB[i] = (unsigned)(Rb * K + C) * 2u; }
    const size_t kstep = (size_t)(BK * 2);
    const size_t hstep = (size_t)HALF * K * 2;
    const size_t tstep = 2 * hstep;
    const unsigned ldsw = (unsigned)wid * 1024u;
    const int aoff = lds_byte(wr * 64 + fr, fq * 8), boff = lds_byte(wc * 32 + fr, fq * 8);
#define PG8_SA(b, h) (((b) * 2 + (h)) * HTB)
#define PG8_SB(b, h) ((4 + (b) * 2 + (h)) * HTB)
#define PG8_STAGE(bufoff, gbase, voff) do { _Pragma("unroll") for (int _i = 0; _i < 2; ++_i) \
        __builtin_amdgcn_global_load_lds((const unsigned*)((const char*)(gbase) + (voff)[_i]), (LAS unsigned*)(lds + (bufoff) + ldsw + _i * 8192), 16, 0, 0); } while (0)
#define PG8_LDA(dst, b, h) do { _Pragma("unroll") for (int m = 0; m < 4; ++m) _Pragma("unroll") for (int k = 0; k < 2; ++k) dst[m][k] = *(const LAS bf16x8*)(lds + PG8_SA(b, h) + aoff + m * 2048 + k * 1024); } while (0)
#define PG8_LDB(dst, b, h) do { _Pragma("unroll") for (int n = 0; n < 2; ++n) _Pragma("unroll") for (int k = 0; k < 2; ++k) dst[n][k] = *(const LAS bf16x8*)(lds + PG8_SB(b, h) + boff + n * 2048 + k * 1024); } while (0)
#define PG8_MMA(ai, bj, At, Bt) do { __builtin_amdgcn_s_setprio(1); _Pragma("unroll") for (int m = 0; m < 4; ++m) _Pragma("unroll") for (int n = 0; n < 2; ++n) _Pragma("unroll") for (int k = 0; k < 2; ++k) \
        acc[ai][bj][m][n] = __builtin_amdgcn_mfma_f32_16x16x32_bf16(Bt[n][k], At[m][k], acc[ai][bj][m][n], 0, 0, 0); __builtin_amdgcn_s_setprio(0); } while (0)
#define PG8_WAIT_V(n) asm volatile("s_waitcnt vmcnt(" #n ")" ::: "memory")
#define PG8_WAIT_L(n) asm volatile("s_waitcnt lgkmcnt(" #n ")" ::: "memory")
#define PG8_BAR __builtin_amdgcn_s_barrier()
#define PG8_SCHED __builtin_amdgcn_sched_barrier(0)
    Unit cur, nxt; int ui = 0;
    if (!S.next(0, cur)) return;
    f32x4 acc[2][2][4][2];
#pragma unroll
    for (int a = 0; a < 2; ++a)
#pragma unroll
        for (int b = 0; b < 2; ++b)
#pragma unroll
            for (int m = 0; m < 4; ++m)
#pragma unroll
                for (int n = 0; n < 2; ++n) acc[a][b][m][n] = (f32x4){0.f, 0.f, 0.f, 0.f};
    bf16x8 At[4][2], B0[2][2], B1[2][2];
    const char* cA = (const char*)g.A + (size_t)cur.pm * tstep; const char* cB = (const char*)g.Bt + (size_t)cur.pb * tstep;
    {
        PG8_STAGE(PG8_SB(0, 0), cB, voffB); PG8_STAGE(PG8_SB(0, 1), cB + hstep, voffB); PG8_STAGE(PG8_SA(0, 0), cA, voffA); PG8_STAGE(PG8_SA(0, 1), cA + hstep, voffA);
        if (wr == 1) PG8_BAR;
        PG8_WAIT_V(2); PG8_BAR;
        PG8_STAGE(PG8_SB(1, 0), cB + kstep, voffB); PG8_STAGE(PG8_SA(1, 0), cA + kstep, voffA); PG8_STAGE(PG8_SB(1, 1), cB + hstep + kstep, voffB);
        PG8_WAIT_V(6); PG8_BAR;
    }
    for (;;) {
        const bool has_next = S.next(ui + 1, nxt);
        const char* nA = has_next ? (const char*)g.A + (size_t)nxt.pm * tstep : cA; const char* nB = has_next ? (const char*)g.Bt + (size_t)nxt.pb * tstep : cB;
        for (int t = 0; t < nt; t += 2) {
            const bool last = (t == nt - 2);
            const char* a1 = cA + (size_t)(t + 1) * kstep;
            const char* a2 = last ? nA : cA + (size_t)(t + 2) * kstep; const char* b2 = last ? nB : cB + (size_t)(t + 2) * kstep;
            const char* a3 = a2 + kstep; const char* b3 = b2 + kstep;
            PG8_LDB(B0, 0, 0); PG8_LDB(B1, 0, 1); PG8_SCHED; PG8_LDA(At, 0, 0); PG8_STAGE(PG8_SA(1, 1), a1 + hstep, voffA);
            PG8_WAIT_V(8); PG8_WAIT_L(0); PG8_BAR; PG8_MMA(0, 0, At, B0); PG8_MMA(0, 1, At, B1); PG8_BAR; PG8_SCHED;
            PG8_LDA(At, 0, 1); PG8_STAGE(PG8_SB(0, 0), b2, voffB); PG8_STAGE(PG8_SB(0, 1), b2 + hstep, voffB); PG8_STAGE(PG8_SA(0, 0), a2, voffA);
            PG8_WAIT_V(8); PG8_WAIT_L(0); PG8_BAR; PG8_MMA(1, 0, At, B0); PG8_MMA(1, 1, At, B1); PG8_BAR; PG8_SCHED;
            PG8_LDB(B0, 1, 0); PG8_LDB(B1, 1, 1); PG8_SCHED; PG8_LDA(At, 1, 0); PG8_STAGE(PG8_SA(0, 1), a2 + hstep, voffA);
            PG8_WAIT_V(8); PG8_WAIT_L(0); PG8_BAR; PG8_MMA(0, 0, At, B0); PG8_MMA(0, 1, At, B1); PG8_BAR; PG8_SCHED;
            PG8_LDA(At, 1, 1); PG8_STAGE(PG8_SB(1, 0), b3, voffB); PG8_STAGE(PG8_SB(1, 1), b3 + hstep, voffB); PG8_STAGE(PG8_SA(1, 0), a3, voffA);
            PG8_WAIT_V(8); PG8_WAIT_L(0); PG8_BAR; PG8_MMA(1, 0, At, B0); PG8_MMA(1, 1, At, B1); PG8_BAR; PG8_SCHED;
        }
        if constexpr (ALIGN_EPI) { if (wr == 0) PG8_BAR; }
        E(acc, cur, wr, wc, fr, fq);
        if (!has_next) break;
#pragma unroll
        for (int a = 0; a < 2; ++a)
#pragma unroll
            for (int b = 0; b < 2; ++b)
#pragma unroll
                for (int m = 0; m < 4; ++m)
#pragma unroll
                    for (int n = 0; n < 2; ++n) acc[a][b][m][n] = (f32x4){0.f, 0.f, 0.f, 0.f};
        cur = nxt; cA = nA; cB = nB; ++ui;
        if constexpr (ALIGN_EPI) { if (wr == 1) PG8_BAR; }
    }
    PG8_WAIT_V(0);
    if constexpr (!ALIGN_EPI) { if (wr == 0) PG8_BAR; }
    PG8_BAR;
#undef PG8_SA
#undef PG8_SB
#undef PG8_STAGE
#undef PG8_LDA
#undef PG8_LDB
#undef PG8_MMA
#undef PG8_WAIT_V
#undef PG8_WAIT_L
#undef PG8_BAR
#undef PG8_SCHED
}
}
constexpr int D = 2048, NB = 4, TL = 2048, TC = 256, TS = TL + TC  ;
constexpr int MLAT = NB * TL  , MTOK = NB * (TL + TC)  ;
constexpr int DIN = 5824, DINP = 5888, D6 = 6 * D;
constexpr int FF = 5632, FE = 7168, NEXP = 8;
constexpr float EPS = 1e-6f;
constexpr int PC_MLQ = 0, PC_MLK = 512, PC_MLV = 1024, PC_MLO = 1536, PC_IG = 2048, PC_FG = 2056, PC_Z = 2064, PC_XBC = 2576, PC_DT = 3600,
              PC_CQ = 3616, PC_CKV = 4064, PC_KR = 4224, PC_NQ = 4288, PC_NK = 4800, PC_NV = 5312;
constexpr int NCHUNK = 36;
constexpr int MAXMT = 72;

constexpr size_t MiB = 1u << 20;
constexpr size_t WS_CTL = 0, CTL_ZERO_BYTES = 1 * MiB;
constexpr size_t WS_MOD = 1 * MiB;
constexpr size_t WS_WIN = 2 * MiB;
constexpr size_t WS_WOUT = WS_WIN + 46 * MiB;
constexpr size_t WS_WQB = WS_WOUT + 16 * MiB;
constexpr size_t WS_WKVB = WS_WQB + 2 * MiB;
constexpr size_t WS_W13 = WS_WKVB + 1 * MiB;
constexpr size_t WS_W2 = WS_W13 + 44 * MiB;
constexpr size_t WS_MW13 = WS_W2 + 22 * MiB;
constexpr size_t WS_MW2 = WS_MW13 + 448 * MiB;
constexpr size_t WS_HN = WS_MW2 + 224 * MiB;
constexpr size_t WS_A2 = WS_HN + 36 * MiB;
constexpr size_t WS_X = WS_A2 + 36 * MiB;
constexpr size_t WS_BIG = WS_X + 72 * MiB;
constexpr size_t WS_P = WS_BIG;
constexpr size_t WS_CQN = WS_P + 207 * MiB;
constexpr size_t WS_CKVN = WS_CQN + 9 * MiB;
constexpr size_t WS_QRAW = WS_CKVN + 5 * MiB;
constexpr size_t WS_KVRAW = WS_QRAW + 14 * MiB;
constexpr size_t WS_QMLA = WS_KVRAW + 18 * MiB;
constexpr size_t WS_KMLA = WS_QMLA + 14 * MiB;
constexpr size_t WS_VTMLA = WS_KMLA + 14 * MiB;
constexpr size_t WS_QNA = WS_VTMLA + 9 * MiB;
constexpr size_t WS_KNA = WS_QNA + 9 * MiB;
constexpr size_t WS_VTNA = WS_KNA + 9 * MiB;
constexpr size_t WS_XBC = WS_VTNA + 9 * MiB;
constexpr size_t WS_DT = WS_XBC + 18 * MiB;
constexpr size_t WS_GATES = WS_DT + 1 * MiB;
constexpr size_t WS_MLSC = WS_GATES + 1 * MiB;
constexpr size_t WS_SSSC = WS_MLSC + 64 * 1024;
constexpr size_t WS_MLU = WS_MLSC + 1 * MiB;
constexpr size_t WS_MLS = WS_MLU + 73 * MiB;
constexpr size_t WS_SSU = WS_MLS + 37 * MiB;
constexpr size_t WS_SSS = WS_SSU + 72 * MiB;
constexpr size_t WS_HML = WS_SSS + 36 * MiB;
constexpr size_t WS_YSS = WS_HML + 36 * MiB;
constexpr size_t WS_MIXEND = WS_YSS + 36 * MiB;
constexpr size_t WS_G = WS_BIG;
constexpr size_t WS_Y = WS_G + 252 * MiB;
constexpr size_t WS_XG = WS_Y + 144 * MiB;
constexpr size_t WS_TOK = WS_XG + 72 * MiB;
constexpr size_t WS_FFNEND = WS_TOK + 1 * MiB;
constexpr size_t WS_END = (WS_MIXEND > WS_FFNEND ? WS_MIXEND : WS_FFNEND);
static_assert(WS_END < (size_t)1800 * MiB, "workspace budget");
static_assert((size_t)MTOK * DINP * 4 <= 207 * MiB && (size_t)32 * 36 * 129 * 128 * 4 <= 73 * MiB, "sizes");
constexpr int CW_BAR = 4096;
constexpr int CW_MOE = 16384;
constexpr int CW_QH = 20480;
constexpr int CW_ARR = 32768;

constexpr int RING_BYTES = 131072;
constexpr int MISC_OFF = 147456 - 256;
constexpr int LDS_BYTES = 147456;
constexpr int NWAVES = 8, NTHR = 512;

#define RLX_AGENT __ATOMIC_RELAXED, __HIP_MEMORY_SCOPE_AGENT
#define LDS_WAIT() asm volatile("s_waitcnt lgkmcnt(0)" ::: "memory")
#define VM_WAIT() asm volatile("s_waitcnt vmcnt(0)" ::: "memory")
DI unsigned f2bf(float f) { unsigned u = __builtin_bit_cast(unsigned, f); return (u + 0x7fffu + ((u >> 16) & 1u)) >> 16; }
DI unsigned pk2(float lo, float hi) { return f2bf(lo) | (f2bf(hi) << 16); }
DI float bf2f(unsigned b) { return __builtin_bit_cast(float, b << 16); }
DI float wave_sum(float v) {
#pragma unroll
    for (int o = 1; o < 64; o <<= 1) v += __shfl_xor(v, o);
    return v;
}
DI float wave_max(float v) {
#pragma unroll
    for (int o = 1; o < 64; o <<= 1) v = fmaxf(v, __shfl_xor(v, o));
    return v;
}
DI float wave_incl_scan(float v, int lane) {
#pragma unroll
    for (int o = 1; o < 64; o <<= 1) { const float t = __shfl_up(v, o); if (lane >= o) v += t; }
    return v;
}
DI float siluf(float x) { return x / (1.f + __expf(-x)); }
DI float sigmoidf_(float x) { return 1.f / (1.f + __expf(-x)); }
DI float softplusf_(float x) { return fmaxf(x, 0.f) + log1pf(__expf(-fabsf(x))); }
DI float logsigmoidf_(float x) { return fminf(x, 0.f) - log1pf(__expf(-fabsf(x))); }

#define XB_TMO      128
#define XB_XCNT(j)  (256  + 64 * (j))
#define XB_XSUB(j)  (1280 + 64 * (j))
#define XB_XGEN(j)  (2304 + 64 * (j))
#define XB_TOP      3328
#define XB_TOPGEN   3392
#define XCD_BAR_WORDS 3456
#define XB_SPIN_CAP (1u << 22)
DI unsigned xb_ld(unsigned* p)              { return __hip_atomic_load(p, __ATOMIC_RELAXED, __HIP_MEMORY_SCOPE_AGENT); }
DI unsigned xb_add(unsigned* p, unsigned v) { return __hip_atomic_fetch_add(p, v, __ATOMIC_RELAXED, __HIP_MEMORY_SCOPE_AGENT); }
DI unsigned xb_xcc_id() { return (unsigned)__builtin_amdgcn_s_getreg((3 << 11) | 20) & 0xFu; }
#define XB_SPIN(cond, bar) do { unsigned _sp = 0; while (cond) { __builtin_amdgcn_s_sleep(1); \
    if ((++_sp & 255u) == 0u) { if (xb_ld(&(bar)[XB_TMO])) break; if (_sp > XB_SPIN_CAP) { atomicAdd(&(bar)[XB_TMO], 1u); break; } } } } while (0)
struct XcdBarrier { unsigned* bar; unsigned x; volatile LAS unsigned* st; };
DI XcdBarrier xcd_barrier_post(unsigned* bar, volatile LAS unsigned* st) {
    XcdBarrier b; b.bar = bar; b.x = xb_xcc_id(); b.st = st;
    if (threadIdx.x == 0) (void)xb_add(&bar[XB_XCNT(b.x)], 1u);
    return b;
}
DI void xcd_barrier_complete(unsigned* bar, unsigned x, unsigned& nloc, unsigned& nx) {
    const unsigned G = gridDim.x * gridDim.y * gridDim.z;
    unsigned sum, cnt, mine, sp = 0u;
    for (;;) {
        sum = 0u; cnt = 0u; mine = 0u;
#pragma unroll
        for (unsigned j = 0; j < 16; ++j) { const unsigned c = xb_ld(&bar[XB_XCNT(j)]); sum += c; cnt += (c > 0u) ? 1u : 0u; mine = (j == x) ? c : mine; }
        if (sum == G) break;
        __builtin_amdgcn_s_sleep(1);
        if ((++sp & 255u) == 0u) { if (xb_ld(&bar[XB_TMO])) break; if (sp > XB_SPIN_CAP) { atomicAdd(&bar[XB_TMO], 1u); break; } }
    }
    nloc = mine > 0u ? mine : 1u; nx = cnt > 0u ? cnt : 1u;
}
DI void xcd_barrier(const XcdBarrier& b) {
    asm volatile("s_waitcnt vmcnt(0)" ::: "memory");
    __syncthreads();
    if (threadIdx.x == 0) {
        unsigned* bar = b.bar;
        __builtin_amdgcn_s_waitcnt(0);
        unsigned nloc = b.st[0], nx = b.st[1];
        if (nloc == 0u) { xcd_barrier_complete(bar, b.x, nloc, nx); b.st[0] = nloc; b.st[1] = nx; }
        const unsigned old = xb_add(&bar[XB_XSUB(b.x)], 1u);
        const unsigned gen = old / nloc;
        if (old + 1u == (gen + 1u) * nloc) {
            __builtin_amdgcn_fence(__ATOMIC_RELEASE, "agent");
            asm volatile("s_waitcnt vmcnt(0)" ::: "memory");
            const unsigned og = xb_add(&bar[XB_TOP], 1u);
            const unsigned tg = og / nx;
            if (og + 1u == (tg + 1u) * nx) xb_add(&bar[XB_TOPGEN], 1u);
            else XB_SPIN(xb_ld(&bar[XB_TOPGEN]) == tg, bar);
            __builtin_amdgcn_fence(__ATOMIC_ACQUIRE, "agent");
            xb_add(&bar[XB_XGEN(b.x)], 1u);
            asm volatile("s_waitcnt vmcnt(0)" ::: "memory");
        } else {
            XB_SPIN(xb_ld(&bar[XB_XGEN(b.x)]) == gen, bar);
            __builtin_amdgcn_fence(__ATOMIC_ACQUIRE, "agent");
            asm volatile("s_waitcnt vmcnt(0)" ::: "memory");
        }
    }
    __syncthreads();
}

struct Args { const float* in[35]; float* out; unsigned char* ws; int ph_lo, ph_hi, rep, pad; };
struct Frame {
    LAS unsigned char* lds;
    unsigned char* ws;
    const float* in[35];
    float* out;
    int tid, lane, wave, G, bid, rep;
};
#define WSP(T, off) ((T*)(F.ws + (off)))
DI int rowof(int b, int j) { return j < TL ? b * TL + j : MLAT + b * TC + (j - TL); }

template <int K> DI f32x4 mma16(const LAS bf16* A, int lda, const LAS bf16* Bt, int ldb, int lane, f32x4 acc) {
    const int r = lane & 15, q = lane >> 4;
    const LAS bf16* pa = A + r * lda + 8 * q; const LAS bf16* pb = Bt + r * ldb + 8 * q;
#pragma unroll
    for (int k = 0; k < K; k += 32) {
        const bf16x8 a = *(const LAS bf16x8*)(pa + k); const bf16x8 b = *(const LAS bf16x8*)(pb + k);
        acc = __builtin_amdgcn_mfma_f32_16x16x32_bf16(a, b, acc, 0, 0, 0);
    }
    return acc;
}
struct CvDesc { const float* src; bf16* dst; size_t ld, Kd; int Kv, Nv, k0, n0, dn0; };
DI void tr_load(const CvDesc& d, f32x4 (&v)[16], int lane) {
    const int nn = 4 * (lane & 15), kq = lane >> 4;
#pragma unroll
    for (int i = 0; i < 16; ++i) { const int kk = 4 * i + kq;
        v[i] = (f32x4){0.f, 0.f, 0.f, 0.f};
        if (d.k0 + kk < d.Kv && d.n0 + nn < d.Nv) v[i] = __builtin_nontemporal_load((const f32x4*)(d.src + (size_t)(d.k0 + kk) * d.ld + d.n0 + nn)); }
}
DI void tr_lds(const f32x4 (&v)[16], LAS float* scr, int lane) {
    const int nn = 4 * (lane & 15), kq = lane >> 4;
#pragma unroll
    for (int i = 0; i < 16; ++i) { const int kk = 4 * i + kq; LAS float* s = scr + kk * 65 + nn; s[0] = v[i][0]; s[1] = v[i][1]; s[2] = v[i][2]; s[3] = v[i][3]; }
    LDS_WAIT(); asm volatile("" ::: "memory");
}
DI void tr_out(const CvDesc& d, LAS float* scr, int lane) {
    const int c = lane & 7;
#pragma unroll
    for (int j = 0; j < 8; ++j) { const int n = (lane >> 3) + 8 * j; const LAS float* s = scr + (8 * c) * 65 + n;
        u32x4 o; o.x = pk2(s[0 * 65], s[1 * 65]); o.y = pk2(s[2 * 65], s[3 * 65]); o.z = pk2(s[4 * 65], s[5 * 65]); o.w = pk2(s[6 * 65], s[7 * 65]);
        *(u32x4*)(d.dst + (size_t)(d.dn0 + n) * d.Kd + d.k0 + 8 * c) = o; }
    LDS_WAIT(); asm volatile("" ::: "memory");
}
DI int il_row(int n0, int which) { return (n0 >> 7) * 256 + (n0 & 127) + which * 128; }

constexpr int I_IN = 32 * 92, I_OUT = 32 * 32, I_QB = 8 * 12, I_KVB = 4 * 16, I_F1 = 32 * 88, I_F2 = 88 * 32, I_M1 = 32 * 112, I_M2 = 112 * 32;
constexpr int I_L = I_IN + I_OUT + I_QB + I_KVB;
constexpr int CV_NE = I_L + 2 * I_F1 + I_F2, CV_NQ1 = CV_NE + I_L, CV_NALL = CV_NQ1 + NEXP * (2 * I_M1 + I_M2);
DI CvDesc conv_decode(Frame& F, int it) {
    int r = it;
    if (r >= CV_NQ1) { r -= CV_NQ1;
        if (r < NEXP * 2 * I_M1) { const int e = r / (2 * I_M1); r -= e * 2 * I_M1; const int which = r / I_M1; r -= which * I_M1; const int kb = r / 112, nb = r % 112;
            return CvDesc{(which ? F.in[33] : F.in[32]) + (size_t)e * D * FE, WSP(bf16, WS_MW13) + (size_t)e * 2 * FE * D, (size_t)(FE), (size_t)(D), D, FE, 64 * kb, 64 * nb, il_row(64 * nb, which)}; }
        r -= NEXP * 2 * I_M1;
        { const int e = r / I_M2; r -= e * I_M2; const int kb = r / 32, nb = r % 32;
            return CvDesc{F.in[34] + (size_t)e * FE * D, WSP(bf16, WS_MW2) + (size_t)e * D * FE, (size_t)(D), (size_t)(FE), FE, D, 64 * kb, 64 * nb, 64 * nb}; }
    }
    int l = 0;
    if (r >= CV_NE) { r -= CV_NE; l = 1; }
    else if (r >= I_L) { r -= I_L;
        if (r < 2 * I_F1) { const int which = r / I_F1; r -= which * I_F1; const int kb = r / 88, nb = r % 88;
            return CvDesc{(which ? F.in[29] : F.in[28]), WSP(bf16, WS_W13), (size_t)(FF), (size_t)(D), D, FF, 64 * kb, 64 * nb, il_row(64 * nb, which)}; }
        r -= 2 * I_F1;
        { const int kb = r / 32, nb = r % 32; return CvDesc{F.in[30], WSP(bf16, WS_W2), (size_t)(D), (size_t)(FF), FF, D, 64 * kb, 64 * nb, 64 * nb}; }
    }
    if (r < I_IN) { const int kb = r / 92, nb = r % 92;
        return CvDesc{F.in[7] + (size_t)l * D * DIN, WSP(bf16, WS_WIN) + (size_t)l * DINP * D, (size_t)(DIN), (size_t)(D), D, DIN, 64 * kb, 64 * nb, 64 * nb}; }
    r -= I_IN;
    if (r < I_OUT) { const int kb = r / 32, nb = r % 32;
        return CvDesc{F.in[8] + (size_t)l * D * D, WSP(bf16, WS_WOUT) + (size_t)l * D * D, (size_t)(D), (size_t)(D), D, D, 64 * kb, 64 * nb, 64 * nb}; }
    r -= I_OUT;
    if (r < I_QB) { const int kb = r / 12, nb = r % 12;
        return CvDesc{F.in[19] + (size_t)l * 448 * 768, WSP(bf16, WS_WQB) + (size_t)l * 768 * 512, (size_t)(768), (size_t)(512), 448, 768, 64 * kb, 64 * nb, 64 * nb}; }
    r -= I_QB;
    { const int kb = r / 16, nb = r % 16;
        return CvDesc{F.in[21] + (size_t)l * 160 * 1024, WSP(bf16, WS_WKVB) + (size_t)l * 1024 * 256, (size_t)(1024), (size_t)(256), 160, 1024, 64 * kb, 64 * nb, 64 * nb}; }
}

DI void conv_item(Frame& F, int it, LAS float* scr) { const CvDesc d = conv_decode(F, it); f32x4 v[16]; tr_load(d, v, F.lane); tr_lds(v, scr, F.lane); tr_out(d, scr, F.lane); }
DI void conv_items(Frame& F, int it0, int n, LAS float* scr) {
    if (it0 >= CV_NALL) return;
    if (it0 + n > CV_NALL) n = CV_NALL - it0;
    CvDesc d = conv_decode(F, it0); f32x4 v[16]; tr_load(d, v, F.lane);
    for (int k = 0; k < n; ++k) {
        tr_lds(v, scr, F.lane);
        CvDesc dn = d;
        if (k + 1 < n) { dn = conv_decode(F, it0 + k + 1); tr_load(dn, v, F.lane); }
        tr_out(d, scr, F.lane);
        d = dn;
    }
}
DI void p0_prologue(Frame& F) {
    {
        LAS float* sc = (LAS float*)F.lds;
        LAS float* red = (LAS float*)(F.lds + 5 * 2048 * 4);
        bool have = false;
        for (int u = F.bid; u < 2 * 96; u += F.G) {
            if (!have) {
                for (int i = F.tid; i < 5 * 2048; i += NTHR) { const float x = (i < 4 * 2048) ? F.in[1][i] : F.in[3][i - 4 * 2048]; sc[i] = siluf(x); }
                have = true;
            }
            __syncthreads();
            const int l = u / 96, j0 = (u % 96) * 128;
            const float* W = F.in[4] + (size_t)l * D * D6 + j0 + 2 * F.lane;
            f32x2 acc[5];
#pragma unroll
            for (int r = 0; r < 5; ++r) acc[r] = (f32x2){0.f, 0.f};
            const int kb = F.wave * 256;
            for (int k = 0; k < 256; k += 8) {
                f32x2 w[8];
#pragma unroll
                for (int i = 0; i < 8; ++i) w[i] = *(const f32x2*)(W + (size_t)(kb + k + i) * D6);
#pragma unroll
                for (int i = 0; i < 8; ++i)
#pragma unroll
                    for (int r = 0; r < 5; ++r) { const float s = sc[r * 2048 + kb + k + i]; acc[r] += w[i] * s; }
            }
#pragma unroll
            for (int r = 0; r < 5; ++r) { red[(F.wave * 5 + r) * 128 + 2 * F.lane] = acc[r][0]; red[(F.wave * 5 + r) * 128 + 2 * F.lane + 1] = acc[r][1]; }
            __syncthreads();
            for (int i = F.tid; i < 5 * 128; i += NTHR) { const int r = i / 128, j = i % 128; float s = F.in[5][l * D6 + j0 + j];
#pragma unroll
                for (int w = 0; w < 8; ++w) s += red[(w * 5 + r) * 128 + j];
                WSP(float, WS_MOD)[(l * 5 + r) * D6 + j0 + j] = s; }
        }
        __syncthreads();
    }
    LAS float* scr = (LAS float*)(F.lds + F.wave * 16640);
    const int gw = F.bid * NWAVES + F.wave, NGW = F.G * NWAVES;
    for (int it = gw; it < CV_NE; it += NGW) conv_item(F, it, scr);
}

constexpr int CV_NDEF = CV_NALL - CV_NE;
DI void conv_fill(Frame& F, int phase, bool work) {
    LAS float* scr = (LAS float*)(F.lds + F.wave * 16640);
    volatile LAS int* bc = (volatile LAS int*)(F.lds + MISC_OFF) + 16;
    unsigned* ctl = WSP(unsigned, WS_CTL);
    __syncthreads();
    if (F.tid == 0) __hip_atomic_fetch_add(ctl + CW_ARR + 64 * phase, 1u, RLX_AGENT);
    if (!work) return;
    for (;;) {
        if (F.tid == 0) {
            int base = -1;
            if (__hip_atomic_load(ctl + CW_ARR + 64 * phase, RLX_AGENT) < (unsigned)F.G) { base = (int)__hip_atomic_fetch_add(ctl + CW_QH, 32u, RLX_AGENT); if (base >= CV_NDEF) base = -1; }
            bc[0] = base;
        }
        __syncthreads();
        const int base = bc[0];
        __syncthreads();
        if (base < 0) break;
        conv_items(F, CV_NE + base + F.wave * 4, 4, scr);
    }
}
DI void conv_drain(Frame& F, int upto) {
    LAS float* scr = (LAS float*)(F.lds + F.wave * 16640);
    volatile LAS int* bc = (volatile LAS int*)(F.lds + MISC_OFF) + 16;
    unsigned* ctl = WSP(unsigned, WS_CTL);
    __syncthreads();
    for (;;) {
        if (F.tid == 0) {
            int base = -1;
            if ((int)__hip_atomic_load(ctl + CW_QH, RLX_AGENT) < upto) { base = (int)__hip_atomic_fetch_add(ctl + CW_QH, 64u, RLX_AGENT); if (base >= CV_NDEF) base = -1; }
            bc[0] = base;
        }
        __syncthreads();
        const int base = bc[0];
        __syncthreads();
        if (base < 0) break;
        conv_items(F, CV_NE + base + F.wave * 8, 8, scr);
    }
}
template <bool ROUTE>
DI void norm_phase(Frame& F, int l, const float* srcLat, const float* srcCtx, const float* g, int shoff, int nrows) {
    LAS float* rl = (LAS float*)F.lds;
    if (ROUTE) { for (int i = F.tid; i < D * NEXP; i += NTHR) rl[i] = F.in[31][i]; __syncthreads(); }
    const int gw = F.bid * NWAVES + F.wave, NGW = F.G * NWAVES;
    bf16* HN = WSP(bf16, WS_HN);
    for (int row = gw; row < nrows; row += NGW) {
        const float* xr = row < MLAT ? srcLat + (size_t)row * D : srcCtx + (size_t)(row - MLAT) * D;
        const int br = row < MLAT ? row / TL : 4;
        const float* mrow = WSP(float, WS_MOD) + (size_t)(l * 5 + br) * D6 + shoff;
        f32x4 v[8]; float ss = 0.f;
#pragma unroll
        for (int j = 0; j < 8; ++j) { v[j] = *(const f32x4*)(xr + 4 * F.lane + 256 * j); ss += (v[j][0] * v[j][0] + v[j][1] * v[j][1]) + (v[j][2] * v[j][2] + v[j][3] * v[j][3]); }
        const float rstd = 1.0f / sqrtf(wave_sum(ss) * (1.f / D) + EPS);
        float lg[8];
        if (ROUTE) {
#pragma unroll
            for (int e = 0; e < 8; ++e) lg[e] = 0.f; }
#pragma unroll
        for (int j = 0; j < 8; ++j) { const int c = 4 * F.lane + 256 * j;
            const f32x4 gg = *(const f32x4*)(g + c), sh = *(const f32x4*)(mrow + c), sc = *(const f32x4*)(mrow + D + c);
            f32x4 o;
#pragma unroll
            for (int i = 0; i < 4; ++i) o[i] = v[j][i] * rstd * gg[i] * (1.f + sc[i]) + sh[i];
            u32x2 w; w.x = pk2(o[0], o[1]); w.y = pk2(o[2], o[3]);
            *(u32x2*)(HN + (size_t)row * D + c) = w;
            if (ROUTE) {
#pragma unroll
                for (int i = 0; i < 4; ++i) { const f32x4 r0 = *(const LAS f32x4*)(rl + (c + i) * 8), r1 = *(const LAS f32x4*)(rl + (c + i) * 8 + 4);
                    lg[0] += o[i] * r0[0]; lg[1] += o[i] * r0[1]; lg[2] += o[i] * r0[2]; lg[3] += o[i] * r0[3];
                    lg[4] += o[i] * r1[0]; lg[5] += o[i] * r1[1]; lg[6] += o[i] * r1[2]; lg[7] += o[i] * r1[3]; }
                __builtin_amdgcn_sched_barrier(0);
            }
        }
        if (ROUTE) {
#pragma unroll
            for (int e = 0; e < 8; ++e) lg[e] = wave_sum(lg[e]);
            if (F.lane == 0) {
                int e1 = 0; float v1 = lg[0];
#pragma unroll
                for (int e = 1; e < 8; ++e) if (lg[e] > v1) { v1 = lg[e]; e1 = e; }
                int e2 = -1; float v2 = -3.0e38f;
#pragma unroll
                for (int e = 0; e < 8; ++e) if (e != e1 && lg[e] > v2) { v2 = lg[e]; e2 = e; }
                const float g2 = 1.f / (1.f + expf(v1 - v2)), g1 = 1.f - g2;
                unsigned* cnt = WSP(unsigned, WS_CTL) + CW_MOE;
                const unsigned p1 = __hip_atomic_fetch_add(cnt + e1, 1u, RLX_AGENT), p2 = __hip_atomic_fetch_add(cnt + e2, 1u, RLX_AGENT);
                int* tk = WSP(int, WS_TOK) + (size_t)row * 8;
                tk[0] = e1; tk[1] = (int)p1; tk[2] = e2; tk[3] = (int)p2; ((float*)tk)[4] = g1; ((float*)tk)[5] = g2;
            }
        }
    }
}

DI void moe_tables(Frame& F, LAS int* tb, int NT) {
    if (F.tid == 0) {
        const unsigned* cnt = WSP(unsigned, WS_CTL) + CW_MOE; int ts = 0, us = 0;
        for (int e = 0; e < 8; ++e) { const int c = (int)__hip_atomic_load(cnt + e, RLX_AGENT); const int t = (c + 255) >> 8; tb[e] = c; tb[8 + e] = t; tb[16 + e] = ts; tb[32 + e] = us; ts += t; us += t * NT; }
        tb[24] = ts; tb[40] = us;
    }
    __syncthreads();
}
DI void moe_gather_phase(Frame& F) {
    LAS int* tb = (LAS int*)F.lds; moe_tables(F, tb, 1);
    const int gw = F.bid * NWAVES + F.wave, NGW = F.G * NWAVES;
    const bf16* HN = WSP(bf16, WS_HN); bf16* XG = WSP(bf16, WS_XG);
    for (int row = gw; row < MLAT; row += NGW) {
        int* tk = WSP(int, WS_TOK) + (size_t)row * 8;
        const int e1 = tk[0], p1 = tk[1], e2 = tk[2], p2 = tk[3];
        const int s1 = tb[16 + e1] * 256 + p1, s2 = tb[16 + e2] * 256 + p2;
        const u32x4* src = (const u32x4*)(HN + (size_t)row * D) + F.lane;
        u32x4 a[4];
#pragma unroll
        for (int j = 0; j < 4; ++j) a[j] = src[64 * j];
        u32x4* d1 = (u32x4*)(XG + (size_t)s1 * D) + F.lane; u32x4* d2 = (u32x4*)(XG + (size_t)s2 * D) + F.lane;
#pragma unroll
        for (int j = 0; j < 4; ++j) { d1[64 * j] = a[j]; d2[64 * j] = a[j]; }
        if (F.lane == 0) { tk[6] = s1; tk[7] = s2; }
    }
    const int nrow = tb[24] * 256;
    for (int r = gw; r < nrow; r += NGW) {
        const int t = r >> 8; int e = 0;
#pragma unroll
        for (int k = 1; k < 8; ++k) if (t >= tb[16 + k]) e = k;
        const int local = r - tb[16 + e] * 256;
        if (local >= tb[e]) { u32x4* d = (u32x4*)(XG + (size_t)r * D) + F.lane; const u32x4 z = (u32x4){0u, 0u, 0u, 0u};
#pragma unroll
            for (int j = 0; j < 4; ++j) d[64 * j] = z; }
    }
}
DI void moe_combine_phase(Frame& F, int l) {
    const int gw = F.bid * NWAVES + F.wave, NGW = F.G * NWAVES;
    const float* Y = WSP(float, WS_Y); const float* X = WSP(float, WS_X);
    for (int row = gw; row < MLAT; row += NGW) {
        const int* tk = WSP(int, WS_TOK) + (size_t)row * 8;
        const float g1 = ((const float*)tk)[4], g2 = ((const float*)tk)[5]; const int s1 = tk[6], s2 = tk[7];
        const float* mrow = WSP(float, WS_MOD) + (size_t)(l * 5 + row / TL) * D6 + 5 * D;
        f32x4 xv[8], y1[8], y2[8];
#pragma unroll
        for (int j = 0; j < 8; ++j) { const int c = 4 * F.lane + 256 * j;
            xv[j] = *(const f32x4*)(X + (size_t)row * D + c); y1[j] = *(const f32x4*)(Y + (size_t)s1 * D + c); y2[j] = *(const f32x4*)(Y + (size_t)s2 * D + c); }
#pragma unroll
        for (int j = 0; j < 8; ++j) { const int c = 4 * F.lane + 256 * j; const f32x4 gg = *(const f32x4*)(mrow + c);
            *(f32x4*)(F.out + (size_t)row * D + c) = xv[j] + gg * (y1[j] * g1 + y2[j] * g2); }
    }
}
using pg8::Unit;
struct EpiF32 {
    static constexpr bool PERM = false;
    float* C; int ldc;
    DI void operator()(const f32x4 (&acc)[2][2][4][2], const Unit& u, int wr, int wc, int fr, int fq) const {
        const int row0 = u.pm * 256 + wr * 64 + fr, col0 = u.pn * 256 + wc * 32 + 4 * fq;
#pragma unroll
        for (int ai = 0; ai < 2; ++ai)
#pragma unroll
            for (int m = 0; m < 4; ++m) { float* rowp = C + (size_t)(row0 + ai * 128 + m * 16) * ldc + col0;
#pragma unroll
                for (int bj = 0; bj < 2; ++bj)
#pragma unroll
                    for (int n = 0; n < 2; ++n) *(f32x4*)(rowp + bj * 128 + n * 16) = acc[ai][bj][m][n]; }
    }
};
struct EpiBf16 {
    static constexpr bool PERM = true;
    bf16* O; int ldc;
    DI void operator()(const f32x4 (&acc)[2][2][4][2], const Unit& u, int wr, int wc, int fr, int fq) const {
        const int row0 = u.pm * 256 + wr * 64 + fr, col0 = u.pn * 256 + wc * 32 + 8 * fq;
#pragma unroll
        for (int ai = 0; ai < 2; ++ai)
#pragma unroll
            for (int m = 0; m < 4; ++m) { bf16* rowp = O + (size_t)(row0 + ai * 128 + m * 16) * ldc + col0;
#pragma unroll
                for (int bj = 0; bj < 2; ++bj) { const f32x4 v0 = acc[ai][bj][m][0], v1 = acc[ai][bj][m][1];
                    u32x4 w; w.x = pg8::cvt_pk_bf16(v0[0], v0[1]); w.y = pg8::cvt_pk_bf16(v0[2], v0[3]); w.z = pg8::cvt_pk_bf16(v1[0], v1[1]); w.w = pg8::cvt_pk_bf16(v1[2], v1[3]);
                    *(u32x4*)(rowp + bj * 128) = w; } }
    }
};
struct EpiSwiglu {
    static constexpr bool PERM = true;
    bf16* O; int ldc;
    DI void operator()(const f32x4 (&acc)[2][2][4][2], const Unit& u, int wr, int wc, int fr, int fq) const {
        const int row0 = u.pm * 256 + wr * 64 + fr, col0 = u.pn * 128 + wc * 32 + 8 * fq;
#pragma unroll
        for (int ai = 0; ai < 2; ++ai)
#pragma unroll
            for (int m = 0; m < 4; ++m) { bf16* rowp = O + (size_t)(row0 + ai * 128 + m * 16) * ldc + col0;
                f32x4 v0, v1;
#pragma unroll
                for (int j = 0; j < 4; ++j) { v0[j] = siluf(acc[ai][0][m][0][j]) * acc[ai][1][m][0][j]; v1[j] = siluf(acc[ai][0][m][1][j]) * acc[ai][1][m][1][j]; }
                u32x4 w; w.x = pg8::cvt_pk_bf16(v0[0], v0[1]); w.y = pg8::cvt_pk_bf16(v0[2], v0[3]); w.z = pg8::cvt_pk_bf16(v1[0], v1[1]); w.w = pg8::cvt_pk_bf16(v1[2], v1[3]);
                *(u32x4*)rowp = w; }
    }
};
struct EpiResid {
    static constexpr bool PERM = false;
    const float* baseLat; const float* baseCtx; float* out; const float* mod;
    DI void operator()(const f32x4 (&acc)[2][2][4][2], const Unit& u, int wr, int wc, int fr, int fq) const {
        const int row0 = u.pm * 256 + wr * 64 + fr, col0 = u.pn * 256 + wc * 32 + 4 * fq;
        const int br = (u.pm * 256 < MLAT) ? (u.pm * 256) / TL : 4;
        const float* gate = mod + (size_t)br * D6 + col0;
        f32x4 gv[2][2];
#pragma unroll
        for (int bj = 0; bj < 2; ++bj)
#pragma unroll
            for (int n = 0; n < 2; ++n) gv[bj][n] = *(const f32x4*)(gate + bj * 128 + n * 16);
#pragma unroll
        for (int ai = 0; ai < 2; ++ai)
#pragma unroll
            for (int m = 0; m < 4; ++m) { const int row = row0 + ai * 128 + m * 16;
                const float* bp = (row < MLAT ? baseLat + (size_t)row * D : baseCtx + (size_t)(row - MLAT) * D) + col0; float* op = out + (size_t)row * D + col0;
#pragma unroll
                for (int bj = 0; bj < 2; ++bj)
#pragma unroll
                    for (int n = 0; n < 2; ++n) { const f32x4 b = *(const f32x4*)(bp + bj * 128 + n * 16); *(f32x4*)(op + bj * 128 + n * 16) = b + gv[bj][n] * acc[ai][bj][m][n]; } }
    }
};
struct MoeOrder {
    const LAS int* tb; int NT, G, c;
    DI bool next(int i, Unit& u) const {
        const int nun = tb[40]; const long L = (long)i * G + c; if (L >= nun) return false;
        const int w = pg8::xcd_remap((int)L, nun); int e = 0;
#pragma unroll
        for (int k = 1; k < 8; ++k) if (w >= tb[32 + k]) e = k;
        const int rem = w - tb[32 + e], tiles = tb[8 + e], nt = rem / tiles, mtl = rem - nt * tiles;
        u.pm = tb[16 + e] + mtl; u.pn = nt; u.pb = e * NT + nt; return true;
    }
};
DI int tc_of(int dir, int p) { return dir == 0 ? (p < 4 ? 32 + p : p - 4) : 35 - p; }

DI void m1_prep_unit(Frame& F, int l, int b, int tt) {
    const float* P = WSP(float, WS_P);
    const int j0 = tt * 32, lane = F.lane;
    LAS bf16* vs = (LAS bf16*)F.lds;
    for (int i = F.wave; i < 32; i += 8) {
        const int j = j0 + i, row = rowof(b, j);
        const float* p = P + (size_t)row * DINP;
        float cq[7], ckv[3], nq[4][2], nk[4][2], nv[8];
#pragma unroll
        for (int u = 0; u < 7; ++u) cq[u] = p[PC_CQ + lane + 64 * u];
#pragma unroll
        for (int u = 0; u < 3; ++u) { const int idx = lane + 64 * u; ckv[u] = idx < 160 ? p[PC_CKV + idx] : 0.f; }
#pragma unroll
        for (int h = 0; h < 4; ++h) { nq[h][0] = p[PC_NQ + h * 128 + lane]; nq[h][1] = p[PC_NQ + h * 128 + 64 + lane]; nk[h][0] = p[PC_NK + h * 128 + lane]; nk[h][1] = p[PC_NK + h * 128 + 64 + lane]; }
#pragma unroll
        for (int u = 0; u < 8; ++u) nv[u] = p[PC_NV + lane + 64 * u];
        const float gi = lane < 8 ? p[PC_IG + lane] : 0.f, gf = lane < 8 ? p[PC_FG + lane] : 0.f, gd = lane < 16 ? p[PC_DT + lane] : 0.f;
        {
            float ss = 0.f;
#pragma unroll
            for (int u = 0; u < 7; ++u) ss += cq[u] * cq[u];
            const float rstd = 1.0f / sqrtf(wave_sum(ss) * (1.f / 448.f) + EPS);
            const float* qn = F.in[18] + l * 448; bf16* o = WSP(bf16, WS_CQN) + (size_t)row * 512;
#pragma unroll
            for (int u = 0; u < 7; ++u) o[lane + 64 * u] = (bf16)f2bf(cq[u] * rstd * qn[lane + 64 * u]);
            o[448 + lane] = 0;
        }
        {
            float ss = 0.f;
#pragma unroll
            for (int u = 0; u < 3; ++u) ss += ckv[u] * ckv[u];
            const float rstd = 1.0f / sqrtf(wave_sum(ss) * (1.f / 160.f) + EPS);
            const float* kn = F.in[20] + l * 160; bf16* o = WSP(bf16, WS_CKVN) + (size_t)row * 256;
#pragma unroll
            for (int u = 0; u < 3; ++u) { const int idx = lane + 64 * u; o[idx] = idx < 160 ? (bf16)f2bf(ckv[u] * rstd * kn[idx]) : (bf16)0; }
            o[192 + lane] = 0;
        }
        const float* gq = F.in[24] + l * 128; const float* gk = F.in[25] + l * 128;
#pragma unroll
        for (int h = 0; h < 4; ++h) {
            const float rq = 1.0f / sqrtf(wave_sum(nq[h][0] * nq[h][0] + nq[h][1] * nq[h][1]) * (1.f / 128.f) + EPS);
            const float rk = 1.0f / sqrtf(wave_sum(nk[h][0] * nk[h][0] + nk[h][1] * nk[h][1]) * (1.f / 128.f) + EPS);
            bf16* oq = WSP(bf16, WS_QNA) + ((size_t)(b * 4 + h) * TS + j) * 128; bf16* ok = WSP(bf16, WS_KNA) + ((size_t)(b * 4 + h) * TS + j) * 128;
            oq[lane] = (bf16)f2bf(nq[h][0] * rq * gq[lane]); oq[64 + lane] = (bf16)f2bf(nq[h][1] * rq * gq[64 + lane]);
            ok[lane] = (bf16)f2bf(nk[h][0] * rk * gk[lane]); ok[64 + lane] = (bf16)f2bf(nk[h][1] * rk * gk[64 + lane]);
        }
#pragma unroll
        for (int u = 0; u < 8; ++u) vs[i * 520 + lane + 64 * u] = (bf16)f2bf(nv[u]);
        if (lane < 8) {
            float* gt = WSP(float, WS_GATES) + (size_t)row * 16;
            gt[lane] = gi + F.in[9][l * 8 + lane];
            gt[8 + lane] = logsigmoidf_(gf + F.in[10][l * 8 + lane]);
        }
        if (lane < 16) WSP(float, WS_DT)[(size_t)row * 16 + lane] = softplusf_(gd + F.in[14][l * 16 + lane]);
    }
    {
        const int ch = 2 * F.tid;
        const int seglo = j0 < TL ? 0 : TL, seghi = j0 < TL ? TL : TS;
        const float* cw = F.in[12] + (size_t)l * 5 * 1024 + ch; const float* cb = F.in[13] + (size_t)l * 1024 + ch;
        f32x2 w[5];
#pragma unroll
        for (int d = 0; d < 5; ++d) w[d] = *(const f32x2*)(cw + d * 1024);
        const f32x2 bias = *(const f32x2*)cb;
        f32x2 xin[36];
#pragma unroll
        for (int d = 0; d < 36; ++d) { const int jj = j0 - 2 + d; xin[d] = (jj >= seglo && jj < seghi) ? *(const f32x2*)(P + (size_t)rowof(b, jj) * DINP + PC_XBC + ch) : (f32x2){0.f, 0.f}; }
#pragma unroll
        for (int i = 0; i < 32; ++i) {
            f32x2 a = bias;
#pragma unroll
            for (int d = 0; d < 5; ++d) a += w[d] * xin[i + d];
            *(unsigned*)(WSP(bf16, WS_XBC) + (size_t)rowof(b, j0 + i) * 1024 + ch) = pk2(siluf(a[0]), siluf(a[1]));
        }
    }
    __syncthreads();
    {
        const int t = F.tid; unsigned wv[16];
#pragma unroll
        for (int i = 0; i < 16; ++i) wv[i] = (unsigned)vs[(2 * i) * 520 + t] | ((unsigned)vs[(2 * i + 1) * 520 + t] << 16);
        u32x4* dst = (u32x4*)(WSP(bf16, WS_VTNA) + ((size_t)(b * 4 + (t >> 7)) * 128 + (t & 127)) * TS + j0);
#pragma unroll
        for (int k = 0; k < 4; ++k) dst[k] = (u32x4){wv[4 * k], wv[4 * k + 1], wv[4 * k + 2], wv[4 * k + 3]};
    }
    __syncthreads();
}

DI void ml_a_unit(Frame& F, int seq, int p) {
    const int b = seq >> 3, h = (seq >> 1) & 3, dir = seq & 1, tc = tc_of(dir, p), lane = F.lane;
    const float* P = WSP(float, WS_P);
    LAS bf16* VW = (LAS bf16*)F.lds;
    LAS bf16* KT = (LAS bf16*)(F.lds + 20736);
    LAS float* wgs = (LAS float*)(F.lds + 39168);
    if (F.wave == 0) {
        const int row = rowof(b, tc * 64 + lane);
        const float* gt = WSP(float, WS_GATES) + (size_t)row * 16;
        const float li = gt[dir * 4 + h], lf = gt[8 + dir * 4 + h];
        const float pre = wave_incl_scan(lf, lane), tot = __shfl(pre, 63);
        const float g = dir == 0 ? (tot - pre) + li : (pre - lf) + li;
        const float mloc = wave_max(g);
        wgs[lane] = __expf(g - mloc);
        if (lane == 0) { float* sc = WSP(float, WS_MLSC) + (size_t)(seq * 36 + p) * 4; sc[0] = tot; sc[1] = mloc; }
    }
    {
        float vv[16], kk[16];
#pragma unroll
        for (int it = 0; it < 16; ++it) { const int idx = F.tid + NTHR * it, n = idx >> 7, d = idx & 127;
            const float* pr = P + (size_t)rowof(b, tc * 64 + n) * DINP + h * 128 + d; vv[it] = pr[PC_MLV]; kk[it] = pr[PC_MLK]; }
        __syncthreads();
#pragma unroll
        for (int it = 0; it < 16; ++it) { const int idx = F.tid + NTHR * it, n = idx >> 7, d = idx & 127;
            VW[d * 72 + n] = (bf16)f2bf(vv[it] * wgs[n]); KT[d * 72 + n] = (bf16)f2bf(kk[it]); }
    }
    for (int idx = F.tid; idx < 16 * 64; idx += NTHR) { const int rr = idx >> 6, n = idx & 63; VW[(128 + rr) * 72 + n] = rr == 0 ? (bf16)f2bf(wgs[n]) : (bf16)0; }
    __syncthreads();
    float* U = WSP(float, WS_MLU) + (size_t)(seq * 36 + p) * (129 * 128);
    for (int id = F.wave; id < 72; id += 8) { const int dt = id >> 3, et = id & 7;
        const f32x4 acc = mma16<64>(VW + dt * 16 * 72, 72, KT + et * 16 * 72, 72, lane, (f32x4){0.f, 0.f, 0.f, 0.f});
#pragma unroll
        for (int i = 0; i < 4; ++i) { const int d = dt * 16 + 4 * (lane >> 4) + i; if (d < 129) U[d * 128 + et * 16 + (lane & 15)] = acc[i]; } }
    __syncthreads();
}

DI void ss_a_unit(Frame& F, int l, int b, int dir, int p, int g) {
    const int tc = tc_of(dir, p), lane = F.lane;
    LAS bf16* XT = (LAS bf16*)F.lds;
    LAS bf16* BT = (LAS bf16*)(F.lds + 36864);
    LAS float* tails = (LAS float*)(F.lds + 55296);
    const bf16* XBC = WSP(bf16, WS_XBC);
    if (F.wave < 4) {
        const int h = 4 * g + F.wave, row = rowof(b, tc * 64 + lane);
        const float dt = WSP(float, WS_DT)[(size_t)row * 16 + dir * 8 + h];
        const float A = -__expf(F.in[15][l * 16 + dir * 8 + h]);
        const float a = dt * A, pre = wave_incl_scan(a, lane), tot = __shfl(pre, 63);
        tails[F.wave * 64 + lane] = (dir == 0 ? __expf(tot - pre) : __expf(pre - a)) * dt;
        if (lane == 0) WSP(float, WS_SSSC)[(size_t)((b * 8 + h) * 2 + dir) * 36 + p] = __expf(tot);
    }
    {
        bf16 xv[32], bv[16];
#pragma unroll
        for (int it = 0; it < 32; ++it) { const int idx = F.tid + NTHR * it, n = idx >> 8, c = idx & 255; xv[it] = XBC[(size_t)rowof(b, tc * 64 + n) * 1024 + g * 256 + c]; }
#pragma unroll
        for (int it = 0; it < 16; ++it) { const int idx = F.tid + NTHR * it, n = idx >> 7, nn = idx & 127; bv[it] = XBC[(size_t)rowof(b, tc * 64 + n) * 1024 + 512 + g * 128 + nn]; }
        __syncthreads();
#pragma unroll
        for (int it = 0; it < 32; ++it) { const int idx = F.tid + NTHR * it, n = idx >> 8, c = idx & 255; XT[c * 72 + n] = (bf16)f2bf(bf2f(xv[it]) * tails[(c >> 6) * 64 + n]); }
#pragma unroll
        for (int it = 0; it < 16; ++it) { const int idx = F.tid + NTHR * it, n = idx >> 7, nn = idx & 127; BT[nn * 72 + n] = bv[it]; }
    }
    __syncthreads();
    for (int id = F.wave; id < 128; id += 8) { const int hh = id >> 5, rem = id & 31, pt = rem >> 3, nt = rem & 7;
        const f32x4 acc = mma16<64>(XT + (hh * 64 + pt * 16) * 72, 72, BT + nt * 16 * 72, 72, lane, (f32x4){0.f, 0.f, 0.f, 0.f});
        float* U = WSP(float, WS_SSU) + (size_t)(((b * 8 + 4 * g + hh) * 2 + dir) * 36 + p) * 8192;
#pragma unroll
        for (int i = 0; i < 4; ++i) U[(pt * 16 + 4 * (lane >> 4) + i) * 128 + nt * 16 + (lane & 15)] = acc[i]; }
    __syncthreads();
}
DI void ml_scan_unit(Frame& F, int seq, int s4) {
    float* sc = WSP(float, WS_MLSC) + (size_t)seq * 36 * 4;
    const float* U = WSP(float, WS_MLU) + (size_t)seq * 36 * 16512 + s4 * 4128 + F.tid; bf16* S = WSP(bf16, WS_MLS) + (size_t)seq * 36 * 16512 + s4 * 4128 + F.tid;
    float st[9]; float m = 0.f;
#pragma unroll
    for (int k = 0; k < 9; ++k) st[k] = 0.f;
    for (int pg = 0; pg < 36; pg += 6) {
        float u[6][9];
#pragma unroll
        for (int pp = 0; pp < 6; ++pp)
#pragma unroll
            for (int k = 0; k < 9; ++k) u[pp][k] = (F.tid + 512 * k < 4128) ? U[(size_t)(pg + pp) * 16512 + 512 * k] : 0.f;
#pragma unroll
        for (int pp = 0; pp < 6; ++pp) { const int p = pg + pp;
            const float bl = sc[p * 4], mloc = sc[p * 4 + 1];
            const float mn = fmaxf(bl + m, mloc), wc = __expf(bl + m - mn), wu = __expf(mloc - mn);
            if (s4 == 0 && F.tid == 0) sc[p * 4 + 2] = m;
#pragma unroll
            for (int k = 0; k < 9; ++k) { if (F.tid + 512 * k < 4128) S[(size_t)p * 16512 + 512 * k] = (bf16)f2bf(st[k]); st[k] = wc * st[k] + wu * u[pp][k]; }
            m = mn; }
    }
}
DI void ss_scan_unit(Frame& F, int sq, int half) {
    const float* dec = WSP(float, WS_SSSC) + (size_t)sq * 36;
    const float* U = WSP(float, WS_SSU) + (size_t)sq * 36 * 8192 + half * 4096 + F.tid; bf16* S = WSP(bf16, WS_SSS) + (size_t)sq * 36 * 8192 + half * 4096 + F.tid;
    float st[8];
#pragma unroll
    for (int k = 0; k < 8; ++k) st[k] = 0.f;
    for (int pg = 0; pg < 36; pg += 6) {
        float u[6][8];
#pragma unroll
        for (int pp = 0; pp < 6; ++pp)
#pragma unroll
            for (int k = 0; k < 8; ++k) u[pp][k] = U[(size_t)(pg + pp) * 8192 + 512 * k];
#pragma unroll
        for (int pp = 0; pp < 6; ++pp) { const int p = pg + pp; const float dc = dec[p];
#pragma unroll
            for (int k = 0; k < 8; ++k) { S[(size_t)p * 8192 + 512 * k] = (bf16)f2bf(st[k]); st[k] = st[k] * dc + u[pp][k]; } }
    }
}
DI void mla_post_unit(Frame& F, int l, int b, int tt) {
    const float* P = WSP(float, WS_P);
    const bf16* QRAW = WSP(bf16, WS_QRAW); const bf16* KVRAW = WSP(bf16, WS_KVRAW);
    const int j0 = tt * 32, lane = F.lane;
    LAS bf16* vs = (LAS bf16*)F.lds;
    const float* gq = F.in[22] + l * 192; const float* gk = F.in[23] + l * 192;
    for (int i = F.wave; i < 32; i += 8) {
        const int j = j0 + i, row = rowof(b, j); const bool lat = j < TL;
        const int a = lane & 31; const float pos = (float)(a < 16 ? (j >> 6) : (j & 63));
        const float fr = exp2f(-(float)(a & 15) * (13.287712379549449f / 16.f));
        const float ang = pos * fr; const float cs = cosf(ang), sn = sinf(ang);
        const float krv = P[(size_t)row * DINP + PC_KR + lane];
        float qv[4][3], kk[4][2]; bf16 vv[4][2];
#pragma unroll
        for (int h = 0; h < 4; ++h) { const bf16* q = QRAW + (size_t)row * 768 + h * 192; const bf16* kv = KVRAW + (size_t)row * 1024 + h * 256;
            qv[h][0] = bf2f(q[lane]); qv[h][1] = bf2f(q[64 + lane]); qv[h][2] = bf2f(q[128 + lane]);
            kk[h][0] = bf2f(kv[lane]); kk[h][1] = bf2f(kv[64 + lane]); vv[h][0] = kv[128 + lane]; vv[h][1] = kv[192 + lane]; }
#pragma unroll
        for (int h = 0; h < 4; ++h) {
            {
                const float v0 = qv[h][0], v1 = qv[h][1], v2 = qv[h][2];
                const float rstd = 1.0f / sqrtf(wave_sum(v0 * v0 + v1 * v1 + v2 * v2) * (1.f / 192.f) + EPS);
                const float n0 = v0 * rstd * gq[lane], n1 = v1 * rstd * gq[64 + lane]; float n2 = v2 * rstd * gq[128 + lane];
                const float pr = __shfl_xor(n2, 32);
                if (lat) n2 = lane < 32 ? n2 * cs - pr * sn : pr * sn + n2 * cs;
                bf16* o = WSP(bf16, WS_QMLA) + ((size_t)(b * 4 + h) * TS + j) * 192;
                o[lane] = (bf16)f2bf(n0); o[64 + lane] = (bf16)f2bf(n1); o[128 + lane] = (bf16)f2bf(n2);
            }
            {
                const float v0 = kk[h][0], v1 = kk[h][1], v2 = krv;
                const float rstd = 1.0f / sqrtf(wave_sum(v0 * v0 + v1 * v1 + v2 * v2) * (1.f / 192.f) + EPS);
                const float n0 = v0 * rstd * gk[lane], n1 = v1 * rstd * gk[64 + lane]; float n2 = v2 * rstd * gk[128 + lane];
                const float pr = __shfl_xor(n2, 32);
                if (lat) n2 = lane < 32 ? n2 * cs - pr * sn : pr * sn + n2 * cs;
                bf16* o = WSP(bf16, WS_KMLA) + ((size_t)(b * 4 + h) * TS + j) * 192;
                o[lane] = (bf16)f2bf(n0); o[64 + lane] = (bf16)f2bf(n1); o[128 + lane] = (bf16)f2bf(n2);
                vs[i * 520 + h * 128 + lane] = vv[h][0]; vs[i * 520 + h * 128 + 64 + lane] = vv[h][1];
            }
        }
    }
    __syncthreads();
    {
        const int t = F.tid; unsigned wv[16];
#pragma unroll
        for (int i = 0; i < 16; ++i) wv[i] = (unsigned)vs[(2 * i) * 520 + t] | ((unsigned)vs[(2 * i + 1) * 520 + t] << 16);
        u32x4* dst = (u32x4*)(WSP(bf16, WS_VTMLA) + ((size_t)(b * 4 + (t >> 7)) * 128 + (t & 127)) * TS + j0);
#pragma unroll
        for (int k = 0; k < 4; ++k) dst[k] = (u32x4){wv[4 * k], wv[4 * k + 1], wv[4 * k + 2], wv[4 * k + 3]};
    }
    __syncthreads();
}

template <int DK, bool NA>
DI void attn_unit(Frame& F, const bf16* Qg, const bf16* Kg, const bf16* VTg, int nA, int tA0, int nB, int tB0, float scale, bf16* Og, int qrow0, const float* rpb) {
    constexpr int KP = DK + 8, KCH = DK / 8, NKC = 64 * KCH / NTHR;
    LAS bf16* Ks = (LAS bf16*)F.lds;
    LAS bf16* VTs = (LAS bf16*)(F.lds + 64 * KP * 2);
    LAS bf16* Ps = (LAS bf16*)(F.lds + 64 * KP * 2 + 128 * 72 * 2) + F.wave * (16 * 72);
    LAS float* rp = (LAS float*)(F.lds + 64 * KP * 2 + 128 * 72 * 2 + 8 * 16 * 72 * 2);
    const int lane = F.lane, r = lane & 15, q = lane >> 4, tid = F.tid, w = F.wave;
    if (NA) { for (int i = tid; i < 15 * 31; i += NTHR) rp[i] = rpb[i]; }
    bf16x8 qf[DK / 32];
#pragma unroll
    for (int kk = 0; kk < DK / 32; ++kk) qf[kk] = *(const bf16x8*)(Qg + (size_t)(w * 16 + r) * DK + 32 * kk + 8 * q);
    f32x4 o[8]; float mrow[4], lrow[4];
#pragma unroll
    for (int d = 0; d < 8; ++d) o[d] = (f32x4){0.f, 0.f, 0.f, 0.f};
#pragma unroll
    for (int i = 0; i < 4; ++i) { mrow[i] = -1.0e30f; lrow[i] = 0.f; }
    const int ntile = nA + nB;
    u32x4 kreg[NKC], vreg[2];
    const int rq = qrow0 + (w >> 2);
    const int r0 = rq - 4 < 0 ? 0 : (rq - 4 > 24 ? 24 : rq - 4);
#define ATT_LOAD(kt) do { _Pragma("unroll") for (int c = 0; c < NKC; ++c) { const int id = tid + NTHR * c, rr = id / KCH, cc = id % KCH; kreg[c] = *(const u32x4*)(Kg + (size_t)((kt) * 64 + rr) * DK + cc * 8); } \
        _Pragma("unroll") for (int c = 0; c < 2; ++c) { const int id = tid + NTHR * c, dd = id >> 3, cc = id & 7; vreg[c] = *(const u32x4*)(VTg + (size_t)dd * TS + (kt) * 64 + cc * 8); } } while (0)
    ATT_LOAD(nA > 0 ? tA0 : tB0);
    for (int it = 0; it < ntile; ++it) {
        const int kt = it < nA ? tA0 + it : tB0 + (it - nA);
        __syncthreads();
#pragma unroll
        for (int c = 0; c < NKC; ++c) { const int id = tid + NTHR * c, rr = id / KCH, cc = id % KCH; *(LAS u32x4*)(Ks + rr * KP + cc * 8) = kreg[c]; }
#pragma unroll
        for (int c = 0; c < 2; ++c) { const int id = tid + NTHR * c, dd = id >> 3, cc = id & 7; *(LAS u32x4*)(VTs + dd * 72 + cc * 8) = vreg[c]; }
        __syncthreads();
        if (it + 1 < ntile) { const int kn = (it + 1) < nA ? tA0 + it + 1 : tB0 + (it + 1 - nA); ATT_LOAD(kn); }
        const bool nbt = NA && kt < 32;
        if (nbt && (kt < r0 || kt >= r0 + 8)) continue;
        f32x4 s[4];
#pragma unroll
        for (int n = 0; n < 4; ++n) s[n] = (f32x4){0.f, 0.f, 0.f, 0.f};
#pragma unroll
        for (int kk = 0; kk < DK / 32; ++kk)
#pragma unroll
            for (int n = 0; n < 4; ++n) { const bf16x8 kf = *(const LAS bf16x8*)(Ks + (n * 16 + r) * KP + 32 * kk + 8 * q); s[n] = __builtin_amdgcn_mfma_f32_16x16x32_bf16(qf[kk], kf, s[n], 0, 0, 0); }
        float mx[4];
#pragma unroll
        for (int i = 0; i < 4; ++i) mx[i] = -1.0e30f;
#pragma unroll
        for (int n = 0; n < 4; ++n)
#pragma unroll
            for (int i = 0; i < 4; ++i) {
                float v = s[n][i] * scale;
                if (nbt) { const int c = (w & 3) * 16 + 4 * q + i, kc = n * 16 + r; const int c0 = c - 8 < 0 ? 0 : (c - 8 > 48 ? 48 : c - 8);
                    v = (kc >= c0 && kc < c0 + 16) ? v + rp[(kt - rq + 7) * 31 + (kc - c + 15)] : -1.0e30f; }
                s[n][i] = v; mx[i] = fmaxf(mx[i], v);
            }
        float alpha[4], rs[4];
#pragma unroll
        for (int i = 0; i < 4; ++i) {
            float m = mx[i]; m = fmaxf(m, __shfl_xor(m, 1)); m = fmaxf(m, __shfl_xor(m, 2)); m = fmaxf(m, __shfl_xor(m, 4)); m = fmaxf(m, __shfl_xor(m, 8));
            const float mn = fmaxf(mrow[i], m); alpha[i] = __expf(mrow[i] - mn); mrow[i] = mn; rs[i] = 0.f;
        }
#pragma unroll
        for (int n = 0; n < 4; ++n)
#pragma unroll
            for (int i = 0; i < 4; ++i) { const float pv = __expf(s[n][i] - mrow[i]); rs[i] += pv; Ps[(4 * q + i) * 72 + n * 16 + r] = (bf16)f2bf(pv); }
#pragma unroll
        for (int i = 0; i < 4; ++i) {
            float t = rs[i]; t += __shfl_xor(t, 1); t += __shfl_xor(t, 2); t += __shfl_xor(t, 4); t += __shfl_xor(t, 8);
            lrow[i] = lrow[i] * alpha[i] + t;
        }
#pragma unroll
        for (int d = 0; d < 8; ++d)
#pragma unroll
            for (int i = 0; i < 4; ++i) o[d][i] *= alpha[i];
        asm volatile("s_waitcnt lgkmcnt(0)" ::: "memory");
#pragma unroll
        for (int kk = 0; kk < 2; ++kk) { const bf16x8 pf = *(const LAS bf16x8*)(Ps + r * 72 + 32 * kk + 8 * q);
#pragma unroll
            for (int d = 0; d < 8; ++d) { const bf16x8 vf = *(const LAS bf16x8*)(VTs + (d * 16 + r) * 72 + 32 * kk + 8 * q); o[d] = __builtin_amdgcn_mfma_f32_16x16x32_bf16(pf, vf, o[d], 0, 0, 0); } }
    }
#undef ATT_LOAD
#pragma unroll
    for (int i = 0; i < 4; ++i) { const float inv = 1.0f / lrow[i]; bf16* op = Og + (size_t)(w * 16 + 4 * q + i) * D + r;
#pragma unroll
        for (int d = 0; d < 8; ++d) op[d * 16] = (bf16)f2bf(o[d][i] * inv); }
    __syncthreads();
}
DI void ml_c_unit(Frame& F, int seq, int p) {
    const int b = seq >> 3, h = (seq >> 1) & 3, dir = seq & 1, tc = tc_of(dir, p), lane = F.lane, tid = F.tid;
    const float* P = WSP(float, WS_P);
    constexpr float QS = 0.08838834764831845f;
    LAS bf16* Qs = (LAS bf16*)F.lds;
    LAS bf16* Ksm = (LAS bf16*)(F.lds + 17408);
    LAS bf16* VT = (LAS bf16*)(F.lds + 34816);
    LAS bf16* Cx = (LAS bf16*)(F.lds + 55552);
    LAS bf16* SW = (LAS bf16*)(F.lds + 94720);
    LAS float* av = (LAS float*)(F.lds + 103936);
    LAS float* Mt = av + 64;
    LAS float* Bt = av + 128;
    LAS float* den = av + 192;
    const float m_p = WSP(float, WS_MLSC)[(size_t)(seq * 36 + p) * 4 + 2];
    if (F.wave == 0) {
        const int row = rowof(b, tc * 64 + lane);
        const float* gt = WSP(float, WS_GATES) + (size_t)row * 16;
        const float li = gt[dir * 4 + h], lf = gt[8 + dir * 4 + h];
        const float pre = wave_incl_scan(lf, lane), tot = __shfl(pre, 63);
        const float B = dir == 0 ? pre : (tot - pre) + lf;
        const float a = li - B;
        float cm = a;
#pragma unroll
        for (int o = 1; o < 64; o <<= 1) { const float t = dir == 0 ? __shfl_up(cm, o) : __shfl_down(cm, o); const bool ok = dir == 0 ? (lane >= o) : (lane + o < 64); if (ok) cm = fmaxf(cm, t); }
        av[lane] = a; Mt[lane] = fmaxf(m_p, cm); Bt[lane] = B;
    }
    {
        float qq[16], kk[16], vv[16]; u32x4 cx[5];
        const bf16* Sg = WSP(bf16, WS_MLS) + (size_t)(seq * 36 + p) * 16512;
#pragma unroll
        for (int it = 0; it < 16; ++it) { const int idx = tid + NTHR * it, n = idx >> 7, d = idx & 127;
            const float* pr = P + (size_t)rowof(b, tc * 64 + n) * DINP + h * 128 + d; qq[it] = pr[PC_MLQ]; kk[it] = pr[PC_MLK]; vv[it] = pr[PC_MLV]; }
#pragma unroll
        for (int it = 0; it < 5; ++it) { const int idx = tid + NTHR * it, rr = idx >> 4, cc = idx & 15; cx[it] = (idx < 144 * 16 && rr < 129) ? *(const u32x4*)(Sg + rr * 128 + cc * 8) : (u32x4){0u, 0u, 0u, 0u}; }
#pragma unroll
        for (int it = 0; it < 16; ++it) { const int idx = tid + NTHR * it, n = idx >> 7, d = idx & 127;
            Qs[n * 136 + d] = (bf16)f2bf(qq[it]); Ksm[n * 136 + d] = (bf16)f2bf(kk[it]); VT[d * 72 + n] = (bf16)f2bf(vv[it]); }
#pragma unroll
        for (int it = 0; it < 5; ++it) { const int idx = tid + NTHR * it, rr = idx >> 4, cc = idx & 15; if (idx < 144 * 16) *(LAS u32x4*)(Cx + rr * 136 + cc * 8) = cx[it]; }
    }
    for (int idx = tid; idx < 16 * 64; idx += NTHR) { const int rr = idx >> 6, n = idx & 63; VT[(128 + rr) * 72 + n] = rr == 0 ? (bf16)0x3f80 : (bf16)0; }
    __syncthreads();
    for (int id = F.wave; id < 16; id += 8) { const int tt = id >> 2, st = id & 3;
        const bool skip = dir == 0 ? st > tt : st < tt;
        f32x4 acc = (f32x4){0.f, 0.f, 0.f, 0.f};
        if (!skip) acc = mma16<128>(Qs + tt * 16 * 136, 136, Ksm + st * 16 * 136, 136, lane, acc);
        const int s = st * 16 + (lane & 15); const float as = av[s];
#pragma unroll
        for (int i = 0; i < 4; ++i) { const int t = tt * 16 + 4 * (lane >> 4) + i; const bool ok = !skip && (dir == 0 ? s <= t : s >= t);
            SW[t * 72 + s] = (bf16)f2bf(ok ? acc[i] * QS * __expf(as - Mt[t]) : 0.f); } }
    __syncthreads();
    const int tt = F.wave & 3, d0 = F.wave < 4 ? 0 : 5, nd = F.wave < 4 ? 5 : 4;
    f32x4 val[5];
#pragma unroll
    for (int k = 0; k < 5; ++k) { val[k] = (f32x4){0.f, 0.f, 0.f, 0.f};
        if (k < nd) { const int dt = d0 + k;
            const f32x4 a1 = mma16<64>(SW + tt * 16 * 72, 72, VT + dt * 16 * 72, 72, lane, (f32x4){0.f, 0.f, 0.f, 0.f});
            const f32x4 a2 = mma16<128>(Qs + tt * 16 * 136, 136, Cx + dt * 16 * 136, 136, lane, (f32x4){0.f, 0.f, 0.f, 0.f});
#pragma unroll
            for (int i = 0; i < 4; ++i) { const int t = tt * 16 + 4 * (lane >> 4) + i; val[k][i] = a1[i] + a2[i] * QS * __expf(m_p - Mt[t]); }
            if (dt == 8 && (lane & 15) == 0) {
#pragma unroll
                for (int i = 0; i < 4; ++i) den[tt * 16 + 4 * (lane >> 4) + i] = val[k][i]; } } }
    __syncthreads();
    float* H = WSP(float, WS_HML) + (size_t)dir * MTOK * 512;
#pragma unroll
    for (int k = 0; k < 5; ++k) { const int dt = d0 + k; if (k < nd && dt < 8) {
#pragma unroll
        for (int i = 0; i < 4; ++i) { const int t = tt * 16 + 4 * (lane >> 4) + i;
            const float dn = fmaxf(fabsf(den[t]), __expf(-(Bt[t] + Mt[t])));
            H[(size_t)rowof(b, tc * 64 + t) * 512 + h * 128 + dt * 16 + (lane & 15)] = val[k][i] / dn; } } }
    __syncthreads();
}

DI void ss_c_unit(Frame& F, int l, int sq, int p) {
    const int b = sq >> 4, h = (sq >> 1) & 7, dir = sq & 1, g = h >> 2, tc = tc_of(dir, p), lane = F.lane, tid = F.tid;
    const bf16* XBC = WSP(bf16, WS_XBC);
    LAS bf16* Cm = (LAS bf16*)F.lds;
    LAS bf16* Bm = (LAS bf16*)(F.lds + 17408);
    LAS bf16* XT = (LAS bf16*)(F.lds + 34816);
    LAS bf16* Sx = (LAS bf16*)(F.lds + 44032);
    LAS bf16* W = (LAS bf16*)(F.lds + 61440);
    LAS float* cum = (LAS float*)(F.lds + 70656);
    LAS float* dtv = cum + 64;
    if (F.wave == 0) {
        const int row = rowof(b, tc * 64 + lane);
        const float dt = WSP(float, WS_DT)[(size_t)row * 16 + dir * 8 + h];
        const float A = -__expf(F.in[15][l * 16 + dir * 8 + h]);
        const float a = dt * A, pre = wave_incl_scan(a, lane), tot = __shfl(pre, 63);
        cum[lane] = dir == 0 ? pre : (tot - pre) + a; dtv[lane] = dt;
    }
    {
        u32x4 bb[2], cc_[2], sx[2]; bf16 xx[8];
        const bf16* Sg = WSP(bf16, WS_SSS) + (size_t)(sq * 36 + p) * 8192;
#pragma unroll
        for (int it = 0; it < 2; ++it) { const int idx = tid + NTHR * it, n = idx >> 4, cc = idx & 15; const bf16* xr = XBC + (size_t)rowof(b, tc * 64 + n) * 1024;
            bb[it] = *(const u32x4*)(xr + 512 + g * 128 + cc * 8); cc_[it] = *(const u32x4*)(xr + 768 + g * 128 + cc * 8); sx[it] = *(const u32x4*)(Sg + n * 128 + cc * 8); }
#pragma unroll
        for (int it = 0; it < 8; ++it) { const int idx = tid + NTHR * it, n = idx >> 6, pp = idx & 63; xx[it] = XBC[(size_t)rowof(b, tc * 64 + n) * 1024 + h * 64 + pp]; }
#pragma unroll
        for (int it = 0; it < 2; ++it) { const int idx = tid + NTHR * it, n = idx >> 4, cc = idx & 15;
            *(LAS u32x4*)(Bm + n * 136 + cc * 8) = bb[it]; *(LAS u32x4*)(Cm + n * 136 + cc * 8) = cc_[it]; *(LAS u32x4*)(Sx + n * 136 + cc * 8) = sx[it]; }
#pragma unroll
        for (int it = 0; it < 8; ++it) { const int idx = tid + NTHR * it, n = idx >> 6, pp = idx & 63; XT[pp * 72 + n] = xx[it]; }
    }
    __syncthreads();
    for (int id = F.wave; id < 16; id += 8) { const int tt = id >> 2, st = id & 3;
        const bool skip = dir == 0 ? st > tt : st < tt;
        f32x4 acc = (f32x4){0.f, 0.f, 0.f, 0.f};
        if (!skip) acc = mma16<128>(Cm + tt * 16 * 136, 136, Bm + st * 16 * 136, 136, lane, acc);
        const int s = st * 16 + (lane & 15); const float cs = cum[s], ds = dtv[s];
#pragma unroll
        for (int i = 0; i < 4; ++i) { const int t = tt * 16 + 4 * (lane >> 4) + i; const bool ok = !skip && (dir == 0 ? s <= t : s >= t);
            W[t * 72 + s] = (bf16)f2bf(ok ? acc[i] * __expf(cum[t] - cs) * ds : 0.f); } }
    __syncthreads();
    float* Y = WSP(float, WS_YSS) + (size_t)dir * MTOK * 512;
    for (int id = F.wave; id < 16; id += 8) { const int tt = id >> 2, pt = id & 3;
        const f32x4 a1 = mma16<64>(W + tt * 16 * 72, 72, XT + pt * 16 * 72, 72, lane, (f32x4){0.f, 0.f, 0.f, 0.f});
        const f32x4 a2 = mma16<128>(Cm + tt * 16 * 136, 136, Sx + pt * 16 * 136, 136, lane, (f32x4){0.f, 0.f, 0.f, 0.f});
#pragma unroll
        for (int i = 0; i < 4; ++i) { const int t = tt * 16 + 4 * (lane >> 4) + i;
            Y[(size_t)rowof(b, tc * 64 + t) * 512 + h * 64 + pt * 16 + (lane & 15)] = a1[i] + a2[i] * __expf(cum[t]); } }
    __syncthreads();
}

DI void m5_finish_phase(Frame& F, int l, int nrows) {
    const int gw = F.bid * NWAVES + F.wave, NGW = F.G * NWAVES, lane = F.lane;
    const float* P = WSP(float, WS_P); const float* H0 = WSP(float, WS_HML); const float* H1 = H0 + (size_t)MTOK * 512;
    const float* Y0 = WSP(float, WS_YSS); const float* Y1 = Y0 + (size_t)MTOK * 512; const bf16* XBC = WSP(bf16, WS_XBC);
    bf16* A2 = WSP(bf16, WS_A2);
    for (int row = gw; row < nrows; row += NGW) {
        const float* p = P + (size_t)row * DINP;
        float hv[8], ov[8], yv[8], zv[8]; bf16 xv[8];
#pragma unroll
        for (int u = 0; u < 8; ++u) { const int c = lane + 64 * u;
            hv[u] = H0[(size_t)row * 512 + c] + H1[(size_t)row * 512 + c]; ov[u] = p[PC_MLO + c];
            yv[u] = Y0[(size_t)row * 512 + c] + Y1[(size_t)row * 512 + c]; zv[u] = p[PC_Z + c]; xv[u] = XBC[(size_t)row * 1024 + c]; }
        const float* gn = F.in[11] + l * 512; const float* sn = F.in[17] + l * 512;
#pragma unroll
        for (int h = 0; h < 4; ++h) {
            const float v0 = hv[2 * h], v1 = hv[2 * h + 1]; const int c0 = h * 128 + lane, c1 = c0 + 64;
            const float rstd = 1.0f / sqrtf(wave_sum(v0 * v0 + v1 * v1) * (1.f / 128.f) + EPS);
            A2[(size_t)row * D + c0] = (bf16)f2bf(v0 * rstd * gn[c0] * sigmoidf_(ov[2 * h]));
            A2[(size_t)row * D + c1] = (bf16)f2bf(v1 * rstd * gn[c1] * sigmoidf_(ov[2 * h + 1]));
        }
        float y[8]; float ss = 0.f;
#pragma unroll
        for (int u = 0; u < 8; ++u) { float v = yv[u] + F.in[16][l * 8 + u] * bf2f(xv[u]); v *= siluf(zv[u]); y[u] = v; ss += v * v; }
        const float rstd = 1.0f / sqrtf(wave_sum(ss) * (1.f / 512.f) + EPS);
#pragma unroll
        for (int u = 0; u < 8; ++u) { const int c = lane + 64 * u; A2[(size_t)row * D + 512 + c] = (bf16)f2bf(y[u] * rstd * sn[c]); }
    }
}
#ifndef PROBE_MASK
#define PROBE_MASK 0ull
#endif
#define NREP(k) ((((unsigned long long)(PROBE_MASK) >> (k)) & 1ull) ? 2 : 1)
#ifndef UNIT_REP
#define UNIT_REP 0
#endif
#define UREP(i) for (int rp_ = 0; rp_ <= ((F.rep >> (i)) & 1); ++rp_)
#ifndef ONE_LAUNCH
#define ONE_LAUNCH 1
#endif
#define IN(k) (lo <= (k) && (k) < hi)
#define SEAM(k) do { if (ONE_LAUNCH && hi > (k) + 1) xcd_barrier(bar); } while (0)
#ifndef FILL_MASK
#define FILL_MASK 0x7fffffffull
#endif
#define FILL(k, work) do { if (ONE_LAUNCH) conv_fill(F, (k), (work)); } while (0)
#ifndef NCV_P
#define NCV_P 48
#define NCV_OUT 112
#define NCV_UP 24
#define NCV_DOWN 112
#endif
template <int l> DI void layer_phases(Frame& F, const XcdBarrier& bar, const int lo, const int hi) {
    LAS int* mtb = (LAS int*)(F.lds + RING_BYTES);
        const int pb = 1 + 16 * l;
        const bool wc = (l == 0);
        const int nrows = wc ? MTOK : MLAT;
        const float* modl = WSP(float, WS_MOD) + (size_t)l * 5 * D6;
        if (IN(pb + 0)) {
            if (l == 0) norm_phase<false>(F, l, F.in[0], F.in[2], F.in[6] + l * D, 0, MTOK);
            else norm_phase<false>(F, l, WSP(float, WS_X), WSP(float, WS_X) + (size_t)MLAT * D, F.in[6] + l * D, 0, MTOK);
            if (l == 1) conv_drain(F, CV_NQ1 - CV_NE); SEAM(pb + 0);
        }
        if (IN(pb + 1)) {
            const int ncv = ONE_LAUNCH ? NCV_P : 0, gw_ = F.G - ncv;
            if (F.bid < gw_) { pg8::Gemm g{WSP(bf16, WS_HN), WSP(bf16, WS_WIN) + (size_t)l * DINP * D, D}; pg8::StaticOrder S; S.init(MTOK / 256, DINP / 256, gw_, F.bid);
                EpiF32 E{WSP(float, WS_P), DINP};
                pg8::gemm_phase<EpiF32, pg8::StaticOrder>(F.lds, g, S, E); }
            FILL(pb + 1, F.bid >= gw_);
            SEAM(pb + 1);
        }
        if (IN(pb + 2)) {
            for (int u = F.bid; u < NB * 72; u += F.G) m1_prep_unit(F, l, u / 72, u % 72);
            SEAM(pb + 2);
        }
        if (IN(pb + 3)) {
            { pg8::Gemm g{WSP(bf16, WS_CQN), WSP(bf16, WS_WQB) + (size_t)l * 768 * 512, 512}; pg8::StaticOrder S; S.init(MTOK / 256, 3, F.G, F.bid);
              EpiBf16 E{WSP(bf16, WS_QRAW), 768}; pg8::gemm_phase<EpiBf16, pg8::StaticOrder>(F.lds, g, S, E); }
            __syncthreads();
            { pg8::Gemm g{WSP(bf16, WS_CKVN), WSP(bf16, WS_WKVB) + (size_t)l * 1024 * 256, 256}; pg8::StaticOrder S; S.init(MTOK / 256, 4, F.G, (F.bid + 128) % F.G);
              EpiBf16 E{WSP(bf16, WS_KVRAW), 1024}; pg8::gemm_phase<EpiBf16, pg8::StaticOrder>(F.lds, g, S, E); }
            __syncthreads();
            UREP(2) for (int u = F.bid; u < 1152; u += F.G) ml_a_unit(F, u / 36, u % 36);
            UREP(3) for (int v = (F.bid + 128) % F.G; v < 576; v += F.G) ss_a_unit(F, l, v / 144, (v / 72) & 1, (v % 72) >> 1, v & 1);
            SEAM(pb + 3);
        }
        if (IN(pb + 4)) {
            UREP(4) for (int u = F.bid; u < 256; u += F.G) {
                const int bh = u >> 4, qb = u & 15, b = bh >> 2, h = bh & 3;
                const int r0a = 2 * qb - 4 < 0 ? 0 : (2 * qb - 4 > 24 ? 24 : 2 * qb - 4), r0b = 2 * qb - 3 < 0 ? 0 : (2 * qb - 3 > 24 ? 24 : 2 * qb - 3);
                attn_unit<128, true>(F, WSP(bf16, WS_QNA) + ((size_t)bh * TS + qb * 128) * 128, WSP(bf16, WS_KNA) + (size_t)bh * TS * 128, WSP(bf16, WS_VTNA) + (size_t)bh * 128 * TS,
                                     4, 32, r0b + 8 - r0a, r0a, 0.08838834764831845f,
                                     WSP(bf16, WS_A2) + (size_t)(b * TL + qb * 128) * D + 1536 + h * 128, 2 * qb, F.in[26] + (size_t)(l * 4 + h) * 15 * 31);
            }
            if (wc) UREP(5) for (int v = F.bid; v < 32; v += F.G) {
                const int bh2 = v >> 1, qc = v & 1, b2 = bh2 >> 2, h2 = bh2 & 3;
                attn_unit<128, false>(F, WSP(bf16, WS_QNA) + ((size_t)bh2 * TS + TL + qc * 128) * 128, WSP(bf16, WS_KNA) + (size_t)bh2 * TS * 128, WSP(bf16, WS_VTNA) + (size_t)bh2 * 128 * TS,
                                      4, 32, 0, 0, 0.08838834764831845f, WSP(bf16, WS_A2) + (size_t)(MLAT + b2 * TC + qc * 128) * D + 1536 + h2 * 128, 0, nullptr);
            }
            UREP(6) for (int v = (F.bid + 32) % F.G; v < 128; v += F.G) ml_scan_unit(F, v >> 2, v & 3);
            UREP(7) for (int v = (F.bid + 96) % F.G; v < 128; v += F.G) ss_scan_unit(F, v >> 1, v & 1);
            UREP(8) for (int v = F.bid; v < 288; v += F.G) mla_post_unit(F, l, v / 72, v % 72);
            SEAM(pb + 4);
        }
        if (IN(pb + 5)) {
            const int p0 = wc ? 0 : 4, npp = 36 - p0;
            UREP(9) for (int u = F.bid; u < 256; u += F.G) { const int bh = u >> 4, qb = u & 15, b = bh >> 2, h = bh & 3;
                attn_unit<192, false>(F, WSP(bf16, WS_QMLA) + ((size_t)bh * TS + qb * 128) * 192, WSP(bf16, WS_KMLA) + (size_t)bh * TS * 192, WSP(bf16, WS_VTMLA) + (size_t)bh * 128 * TS,
                                      36, 0, 0, 0, 0.07216878364870322f, WSP(bf16, WS_A2) + (size_t)(b * TL + qb * 128) * D + 1024 + h * 128, 0, nullptr); }
            if (wc) UREP(10) for (int v = F.bid; v < 32; v += F.G) { const int bh = v >> 1, qc = v & 1, b = bh >> 2, h = bh & 3;
                attn_unit<192, false>(F, WSP(bf16, WS_QMLA) + ((size_t)bh * TS + TL + qc * 128) * 192, WSP(bf16, WS_KMLA) + (size_t)bh * TS * 192, WSP(bf16, WS_VTMLA) + (size_t)bh * 128 * TS,
                                      4, 32, 0, 0, 0.07216878364870322f, WSP(bf16, WS_A2) + (size_t)(MLAT + b * TC + qc * 128) * D + 1024 + h * 128, 0, nullptr); }
            UREP(11) for (int v = (F.bid + 32) % F.G; v < 32 * npp; v += F.G) ml_c_unit(F, v / npp, p0 + v % npp);
            UREP(12) for (int v = (F.bid + 160) % F.G; v < 64 * npp; v += F.G) ss_c_unit(F, l, v / npp, p0 + v % npp);
            SEAM(pb + 5);
        }
        if (IN(pb + 6)) { m5_finish_phase(F, l, nrows); SEAM(pb + 6); }
        if (IN(pb + 7)) {
            const int ncv = (ONE_LAUNCH && l == 0) ? NCV_OUT : 0, gw_ = F.G - ncv;
            if (F.bid < gw_) { pg8::Gemm g{WSP(bf16, WS_A2), WSP(bf16, WS_WOUT) + (size_t)l * D * D, D}; pg8::StaticOrder S; S.init(nrows / 256, D / 256, gw_, F.bid);
                EpiResid E{l == 0 ? F.in[0] : WSP(float, WS_X), l == 0 ? F.in[2] : WSP(float, WS_X) + (size_t)MLAT * D, WSP(float, WS_X), modl + 2 * D};
                pg8::gemm_phase<EpiResid, pg8::StaticOrder>(F.lds, g, S, E); }
            FILL(pb + 7, F.bid >= gw_);
            SEAM(pb + 7);
        }
        if (IN(pb + 8)) {
            if (l == 0) norm_phase<false>(F, l, WSP(float, WS_X), WSP(float, WS_X) + (size_t)MLAT * D, F.in[27] + l * D, 3 * D, nrows);
            else norm_phase<true>(F, l, WSP(float, WS_X), WSP(float, WS_X) + (size_t)MLAT * D, F.in[27] + l * D, 3 * D, nrows);
            SEAM(pb + 8);
        }
        if (l == 0) {
            if (IN(pb + 10)) {
                const int ncv = ONE_LAUNCH ? NCV_UP : 0, gw_ = F.G - ncv;
                if (F.bid < gw_) { pg8::Gemm g{WSP(bf16, WS_HN), WSP(bf16, WS_W13), D}; pg8::StaticOrder S; S.init(MTOK / 256, 2 * FF / 256, gw_, F.bid);
                    EpiSwiglu E{WSP(bf16, WS_G), FF}; pg8::gemm_phase<EpiSwiglu, pg8::StaticOrder>(F.lds, g, S, E); }
                FILL(pb + 10, F.bid >= gw_);
                SEAM(pb + 10);
            }
            if (IN(pb + 11)) {
                const int ncv = ONE_LAUNCH ? NCV_DOWN : 0, gw_ = F.G - ncv;
                if (F.bid < gw_) { pg8::Gemm g{WSP(bf16, WS_G), WSP(bf16, WS_W2), FF}; pg8::StaticOrder S; S.init(MTOK / 256, D / 256, gw_, F.bid);
                    EpiResid E{WSP(float, WS_X), WSP(float, WS_X) + (size_t)MLAT * D, WSP(float, WS_X), modl + 5 * D};
                    pg8::gemm_phase<EpiResid, pg8::StaticOrder>(F.lds, g, S, E); }
                FILL(pb + 11, F.bid >= gw_);
                SEAM(pb + 11);
            }
        } else {
            if (IN(pb + 9)) { moe_gather_phase(F); conv_drain(F, CV_NDEF); SEAM(pb + 9); }
            if (IN(pb + 10)) {
                __syncthreads(); moe_tables(F, mtb, 2 * FE / 256);
                pg8::Gemm g{WSP(bf16, WS_XG), WSP(bf16, WS_MW13), D}; MoeOrder S{mtb, 2 * FE / 256, F.G, F.bid};
                EpiSwiglu E{WSP(bf16, WS_G), FE}; pg8::gemm_phase<EpiSwiglu, MoeOrder>(F.lds, g, S, E);
                SEAM(pb + 10);
            }
            if (IN(pb + 11)) {
                __syncthreads(); moe_tables(F, mtb, D / 256);
                pg8::Gemm g{WSP(bf16, WS_G), WSP(bf16, WS_MW2), FE}; MoeOrder S{mtb, D / 256, F.G, F.bid};
                EpiF32 E{WSP(float, WS_Y), D}; pg8::gemm_phase<EpiF32, MoeOrder>(F.lds, g, S, E);
                SEAM(pb + 11);
            }
            if (IN(pb + 12)) { moe_combine_phase(F, l); }
        }
}
__global__ void __launch_bounds__(NTHR, 2) fwd_kernel(Args args) {
    extern __shared__ __attribute__((aligned(16))) unsigned char lds[];
    Frame F;
    F.lds = (LAS unsigned char*)lds; F.ws = args.ws; F.out = args.out;
#pragma unroll
    for (int i = 0; i < 35; ++i) F.in[i] = args.in[i];
    F.tid = threadIdx.x; F.lane = F.tid & 63; F.wave = __builtin_amdgcn_readfirstlane(F.tid >> 6); F.G = gridDim.x; F.bid = blockIdx.x; F.rep = args.rep;
    volatile LAS unsigned* MISC = (volatile LAS unsigned*)(F.lds + MISC_OFF);
    if (F.tid < 64) MISC[F.tid] = 0u;
    __syncthreads();
    XcdBarrier bar; bar.bar = WSP(unsigned, WS_CTL) + CW_BAR; bar.x = 0; bar.st = nullptr;
    if (ONE_LAUNCH) bar = xcd_barrier_post(WSP(unsigned, WS_CTL) + CW_BAR, MISC + 8);
    const int lo = args.ph_lo, hi = args.ph_hi;

    if (IN(0)) { p0_prologue(F); SEAM(0); }

    layer_phases<0>(F, bar, lo, hi);
    layer_phases<1>(F, bar, lo, hi);
#undef IN
#undef SEAM
}

extern "C" void kernel_launch(void* const* d_in, const int* in_sizes, int n_in, void* d_out, int out_size, void* d_ws, size_t ws_size, hipStream_t stream) {
    static int grid = 0;
    if (grid == 0) {
        if (n_in != 35 || out_size != MLAT * D || ws_size < WS_END) { fprintf(stderr, "kernel_launch: unexpected shapes (n_in %d out %d ws %zu need %zu)\n", n_in, out_size, ws_size, (size_t)WS_END); grid = -1; return; }
        int dev = 0, cus = 0, per_cu = 0;
        if (hipGetDevice(&dev) != hipSuccess || hipDeviceGetAttribute(&cus, hipDeviceAttributeMultiprocessorCount, dev) != hipSuccess) { grid = -1; return; }
        if (hipFuncSetAttribute((const void*)fwd_kernel, hipFuncAttributeMaxDynamicSharedMemorySize, LDS_BYTES) != hipSuccess) { fprintf(stderr, "kernel_launch: hipFuncSetAttribute failed\n"); grid = -1; return; }
        if (hipOccupancyMaxActiveBlocksPerMultiprocessor(&per_cu, (const void*)fwd_kernel, NTHR, LDS_BYTES) != hipSuccess || per_cu < 1) { fprintf(stderr, "kernel_launch: occupancy query says %d\n", per_cu); }
        (void)hipGetLastError();
        grid = cus;
    }
    if (grid < 0) return;
    (void)hipMemsetAsync((char*)d_ws + WS_CTL, 0, CTL_ZERO_BYTES, stream);
    Args a{};
    for (int i = 0; i < 35; ++i) a.in[i] = (const float*)d_in[i];
    a.out = (float*)d_out; a.ws = (unsigned char*)d_ws; a.rep = UNIT_REP;
#if ONE_LAUNCH
    a.ph_lo = 0; a.ph_hi = 64;
    hipLaunchKernelGGL(fwd_kernel, dim3(grid), dim3(NTHR), LDS_BYTES, stream, a);
#else
    static const int phases[] = {0, 1, 2, 3, 4, 5, 6, 7, 8, 9, 11, 12, 17, 18, 19, 20, 21, 22, 23, 24, 25, 26, 27, 28, 29};
    for (int k = 0; k < (int)(sizeof(phases) / sizeof(phases[0])); ++k) {
        a.ph_lo = phases[k]; a.ph_hi = phases[k] + 1;
        for (int rp = 0; rp < NREP(phases[k]); ++rp) hipLaunchKernelGGL(fwd_kernel, dim3(grid), dim3(NTHR), LDS_BYTES, stream, a);
    }
#endif
}
```

```cpp
#define NCV_P 48
#define NCV_OUT 96
#define NCV_UP 24
#define NCV_DOWN 96
#define FILL_MASK 0x7fffffffull
#define PROBE_MASK (0ull)
#define ONE_LAUNCH 1
#define UNIT_REP 0
#include <hip/hip_runtime.h>
#include <cstdio>
#include <cstdint>

#define DI __device__ __forceinline__
#define LAS __attribute__((address_space(3)))
#define GAS __attribute__((address_space(1)))
typedef unsigned short bf16;
typedef short bf16x8 __attribute__((ext_vector_type(8)));
typedef float f32x4 __attribute__((ext_vector_type(4)));
typedef float f32x2 __attribute__((ext_vector_type(2)));
typedef unsigned u32x4 __attribute__((ext_vector_type(4)));
typedef unsigned u32x2 __attribute__((ext_vector_type(2)));

namespace pg8 {
constexpr int BM = 256, BK = 64, HALF = 128, HTB = HALF * BK * 2, STAGE_BYTES = 8 * HTB, NXCD = 8, WGM = 8;
__host__ __device__ __forceinline__ int lds_byte(int r, int c) { const int st = (r >> 4) * 2 + (c >> 5), rr = r & 15, cc = c & 31, ob = rr * 64 + cc * 2; return st * 1024 + (ob ^ (((ob >> 9) & 1) << 5)); }
__host__ __device__ __forceinline__ void stage_rc(int b, int& R, int& C) { const int st = b / 1024, sb = b % 1024, swz = sb ^ (((sb >> 9) & 1) << 5); R = (st >> 1) * 16 + swz / 64; C = (st & 1) * 32 + (swz % 64) / 2; }
__host__ __device__ __forceinline__ int perm32(int rho) { const int n = rho >> 4, i = rho & 15; return 8 * (i >> 2) + 4 * n + (i & 3); }

struct Unit { int pm, pn, pb, koff, aux; };
struct Gemm { const bf16* A; const bf16* Bt; int K, ld; };

DI int xcd_remap(int L, int nwg) { const int q = nwg / NXCD, r = nwg % NXCD, xcd = L % NXCD, off = L / NXCD; return (xcd < r ? xcd * (q + 1) : r * (q + 1) + (xcd - r) * q) + off; }

struct StaticOrder {
    int nM, nN, nwg, G, c;
    DI void init(int nM_, int nN_, int G_, int c_) { nM = nM_; nN = nN_; nwg = nM * nN; G = G_; c = c_; }
    DI bool next(int i, Unit& u) const {
        const long L = (long)i * G + c; if (L >= nwg) return false;
        const int wgid = xcd_remap((int)L, nwg);
        const int nig = WGM * nN, gid = wgid / nig, fm = gid * WGM, gsz = (nM - fm) < WGM ? (nM - fm) : WGM;
        u.pm = fm + ((wgid % nig) % gsz); u.pn = (wgid % nig) / gsz; u.pb = u.pn; u.koff = 0; u.aux = 0; return true;
    }
};

DI unsigned cvt_pk_bf16(float lo, float hi) { unsigned r; asm volatile("v_cvt_pk_bf16_f32 %0, %1, %2" : "=v"(r) : "v"(lo), "v"(hi)); return r; }

template <class Epi, class Sched, bool ALIGN_EPI = true>
DI void gemm_phase(LAS unsigned char* lds, const Gemm g, const Sched& S, const Epi& E) {
    const int tid = threadIdx.x, wid = __builtin_amdgcn_readfirstlane(tid >> 6), lane = tid & 63, wr = wid >> 2, wc = wid & 3, fr = lane & 15, fq = lane >> 4;
    const int K = g.K, nt = K / BK;
    unsigned voffA[2], voffB[2];
#pragma unroll
    for (int i = 0; i < 2; ++i) { int R, C; stage_rc(tid * 16 + i * 8192, R, C); const int Rb = Epi::PERM ? ((R & ~31) + perm32(R & 31)) : R;
        voffA[i] = (unsigned)(R * g.ld + C) * 2u; voffB[i] = (unsigned)(Rb * g.ld + C) * 2u; }
    const size_t kstep = (size_t)(BK * 2);
    const size_t hstep = (size_t)HALF * g.ld * 2;
    const size_t tstep = 2 * hstep;
    const unsigned ldsw = (unsigned)wid * 1024u;
    const int aoff = lds_byte(wr * 64 + fr, fq * 8), boff = lds_byte(wc * 32 + fr, fq * 8);
#define PG8_SA(b, h) (((b) * 2 + (h)) * HTB)
#define PG8_SB(b, h) ((4 + (b) * 2 + (h)) * HTB)
#define PG8_STAGE(bufoff, gbase, voff) do { _Pragma("unroll") for (int _i = 0; _i < 2; ++_i) \
        __builtin_amdgcn_global_load_lds((const unsigned*)((const char*)(gbase) + (voff)[_i]), (LAS unsigned*)(lds + (bufoff) + ldsw + _i * 8192), 16, 0, 0); } while (0)
#define PG8_LDA(dst, b, h) do { _Pragma("unroll") for (int m = 0; m < 4; ++m) _Pragma("unroll") for (int k = 0; k < 2; ++k) dst[m][k] = *(const LAS bf16x8*)(lds + PG8_SA(b, h) + aoff + m * 2048 + k * 1024); } while (0)
#define PG8_LDB(dst, b, h) do { _Pragma("unroll") for (int n = 0; n < 2; ++n) _Pragma("unroll") for (int k = 0; k < 2; ++k) dst[n][k] = *(const LAS bf16x8*)(lds + PG8_SB(b, h) + boff + n * 2048 + k * 1024); } while (0)
#define PG8_MMA(ai, bj, At, Bt) do { __builtin_amdgcn_s_setprio(1); _Pragma("unroll") for (int m = 0; m < 4; ++m) _Pragma("unroll") for (int n = 0; n < 2; ++n) _Pragma("unroll") for (int k = 0; k < 2; ++k) \
        acc[ai][bj][m][n] = __builtin_amdgcn_mfma_f32_16x16x32_bf16(Bt[n][k], At[m][k], acc[ai][bj][m][n], 0, 0, 0); __builtin_amdgcn_s_setprio(0); } while (0)
#define PG8_WAIT_V(n) asm volatile("s_waitcnt vmcnt(" #n ")" ::: "memory")
#define PG8_WAIT_L(n) asm volatile("s_waitcnt lgkmcnt(" #n ")" ::: "memory")
#define PG8_BAR __builtin_amdgcn_s_barrier()
#define PG8_SCHED __builtin_amdgcn_sched_barrier(0)
    Unit cur, nxt; int ui = 0;
    if (!S.next(0, cur)) return;
    f32x4 acc[2][2][4][2];
#pragma unroll
    for (int a = 0; a < 2; ++a)
#pragma unroll
        for (int b = 0; b < 2; ++b)
#pragma unroll
            for (int m = 0; m < 4; ++m)
#pragma unroll
                for (int n = 0; n < 2; ++n) acc[a][b][m][n] = (f32x4){0.f, 0.f, 0.f, 0.f};
    bf16x8 At[4][2], B0[2][2], B1[2][2];
    const char* cA = (const char*)g.A + (size_t)cur.pm * tstep + (size_t)cur.koff * 2; const char* cB = (const char*)g.Bt + (size_t)cur.pb * tstep + (size_t)cur.koff * 2;
    {
        PG8_STAGE(PG8_SB(0, 0), cB, voffB); PG8_STAGE(PG8_SB(0, 1), cB + hstep, voffB); PG8_STAGE(PG8_SA(0, 0), cA, voffA); PG8_STAGE(PG8_SA(0, 1), cA + hstep, voffA);
        if (wr == 1) PG8_BAR;
        PG8_WAIT_V(2); PG8_BAR;
        PG8_STAGE(PG8_SB(1, 0), cB + kstep, voffB); PG8_STAGE(PG8_SA(1, 0), cA + kstep, voffA); PG8_STAGE(PG8_SB(1, 1), cB + hstep + kstep, voffB);
        PG8_WAIT_V(6); PG8_BAR;
    }
    for (;;) {
        const bool has_next = S.next(ui + 1, nxt);
        const char* nA = has_next ? (const char*)g.A + (size_t)nxt.pm * tstep + (size_t)nxt.koff * 2 : cA; const char* nB = has_next ? (const char*)g.Bt + (size_t)nxt.pb * tstep + (size_t)nxt.koff * 2 : cB;
        for (int t = 0; t < nt; t += 2) {
            const bool last = (t == nt - 2);
            const char* a1 = cA + (size_t)(t + 1) * kstep;
            const char* a2 = last ? nA : cA + (size_t)(t + 2) * kstep; const char* b2 = last ? nB : cB + (size_t)(t + 2) * kstep;
            const char* a3 = a2 + kstep; const char* b3 = b2 + kstep;
            PG8_LDB(B0, 0, 0); PG8_LDB(B1, 0, 1); PG8_SCHED; PG8_LDA(At, 0, 0); PG8_STAGE(PG8_SA(1, 1), a1 + hstep, voffA);
            PG8_WAIT_V(8); PG8_WAIT_L(0); PG8_BAR; PG8_MMA(0, 0, At, B0); PG8_MMA(0, 1, At, B1); PG8_BAR; PG8_SCHED;
            PG8_LDA(At, 0, 1); PG8_STAGE(PG8_SB(0, 0), b2, voffB); PG8_STAGE(PG8_SB(0, 1), b2 + hstep, voffB); PG8_STAGE(PG8_SA(0, 0), a2, voffA);
            PG8_WAIT_V(8); PG8_WAIT_L(0); PG8_BAR; PG8_MMA(1, 0, At, B0); PG8_MMA(1, 1, At, B1); PG8_BAR; PG8_SCHED;
            PG8_LDB(B0, 1, 0); PG8_LDB(B1, 1, 1); PG8_SCHED; PG8_LDA(At, 1, 0); PG8_STAGE(PG8_SA(0, 1), a2 + hstep, voffA);
            PG8_WAIT_V(8); PG8_WAIT_L(0); PG8_BAR; PG8_MMA(0, 0, At, B0); PG8_MMA(0, 1, At, B1); PG8_BAR; PG8_SCHED;
            PG8_LDA(At, 1, 1); PG8_STAGE(PG8_SB(1, 0), b3, voffB); PG8_STAGE(PG8_SB(1, 1), b3 + hstep, voffB); PG8_STAGE(PG8_SA(1, 0), a3, voffA);
            PG8_WAIT_V(8); PG8_WAIT_L(0); PG8_BAR; PG8_MMA(1, 0, At, B0); PG8_MMA(1, 1, At, B1); PG8_BAR; PG8_SCHED;
        }
        if constexpr (ALIGN_EPI) { if (wr == 0) PG8_BAR; }
        E(acc, cur, wr, wc, fr, fq);
        if (!has_next) break;
#pragma unroll
        for (int a = 0; a < 2; ++a)
#pragma unroll
            for (int b = 0; b < 2; ++b)
#pragma unroll
                for (int m = 0; m < 4; ++m)
#pragma unroll
                    for (int n = 0; n < 2; ++n) acc[a][b][m][n] = (f32x4){0.f, 0.f, 0.f, 0.f};
        cur = nxt; cA = nA; cB = nB; ++ui;
        if constexpr (ALIGN_EPI) { if (wr == 1) PG8_BAR; }
    }
    PG8_WAIT_V(0);
    if constexpr (!ALIGN_EPI) { if (wr == 0) PG8_BAR; }
    PG8_BAR;
#undef PG8_SA
#undef PG8_SB
#undef PG8_STAGE
#undef PG8_LDA
#undef PG8_LDB
#undef PG8_MMA
#undef PG8_WAIT_V
#undef PG8_WAIT_L
#undef PG8_BAR
#undef PG8_SCHED
}
}
constexpr int D = 2048, NB = 4, TL = 2048, TC = 256, TS = TL + TC  ;
constexpr int MLAT = NB * TL  , MTOK = NB * (TL + TC)  ;
constexpr int DIN = 5824, DINP = 5888, D6 = 6 * D;
constexpr int FF = 5632, FE = 7168, NEXP = 8;
constexpr float EPS = 1e-6f;
constexpr int PC_MLQ = 0, PC_MLK = 512, PC_MLV = 1024, PC_MLO = 1536, PC_IG = 2048, PC_FG = 2056, PC_Z = 2064, PC_XBC = 2576, PC_DT = 3600,
              PC_CQ = 3616, PC_CKV = 4064, PC_KR = 4224, PC_NQ = 4288, PC_NK = 4800, PC_NV = 5312;
constexpr int NCHUNK = 36;
constexpr int MAXMT = 72;

constexpr size_t MiB = 1u << 20;
constexpr size_t WS_CTL = 0, CTL_ZERO_BYTES = 1 * MiB;
constexpr size_t WS_MOD = 1 * MiB;
constexpr size_t WS_WIN = 2 * MiB;
constexpr size_t WS_WOUT = WS_WIN + 46 * MiB;
constexpr size_t WS_WQB = WS_WOUT + 16 * MiB;
constexpr size_t WS_WKVB = WS_WQB + 2 * MiB;
constexpr size_t WS_W13 = WS_WKVB + 1 * MiB;
constexpr size_t WS_W2 = WS_W13 + 44 * MiB;
constexpr size_t WS_MW13 = WS_W2 + 22 * MiB;
constexpr size_t WS_MW2 = WS_MW13 + 448 * MiB;
constexpr size_t WS_HN = WS_MW2 + 224 * MiB;
constexpr size_t WS_A2 = WS_HN + 36 * MiB;
constexpr size_t WS_X = WS_A2 + 36 * MiB;
constexpr size_t WS_BIG = WS_X + 72 * MiB;
constexpr size_t WS_P = WS_BIG;
constexpr size_t WS_CQN = WS_P + 207 * MiB;
constexpr size_t WS_CKVN = WS_CQN + 9 * MiB;
constexpr size_t WS_QRAW = WS_CKVN + 5 * MiB;
constexpr size_t WS_KVRAW = WS_QRAW + 14 * MiB;
constexpr size_t WS_QMLA = WS_KVRAW + 18 * MiB;
constexpr size_t WS_KMLA = WS_QMLA + 14 * MiB;
constexpr size_t WS_VTMLA = WS_KMLA + 14 * MiB;
constexpr size_t WS_QNA = WS_VTMLA + 9 * MiB;
constexpr size_t WS_KNA = WS_QNA + 9 * MiB;
constexpr size_t WS_VTNA = WS_KNA + 9 * MiB;
constexpr size_t WS_XBC = WS_VTNA + 9 * MiB;
constexpr size_t WS_DT = WS_XBC + 18 * MiB;
constexpr size_t WS_GATES = WS_DT + 1 * MiB;
constexpr size_t WS_MLSC = WS_GATES + 1 * MiB;
constexpr size_t WS_SSSC = WS_MLSC + 64 * 1024;
constexpr size_t WS_MLU = WS_MLSC + 1 * MiB;
constexpr size_t WS_MLS = WS_MLU + 73 * MiB;
constexpr size_t WS_SSU = WS_MLS + 37 * MiB;
constexpr size_t WS_SSS = WS_SSU + 72 * MiB;
constexpr size_t WS_HML = WS_SSS + 36 * MiB;
constexpr size_t WS_YSS = WS_HML + 36 * MiB;
constexpr size_t WS_MIXEND = WS_YSS + 36 * MiB;
constexpr size_t WS_G = WS_BIG;
constexpr size_t WS_Y = WS_G + 252 * MiB;
constexpr size_t WS_XG = WS_Y + 144 * MiB;
constexpr size_t WS_TOK = WS_XG + 72 * MiB;
constexpr size_t WS_PART = WS_TOK + 1 * MiB;
constexpr size_t WS_FFNEND = WS_PART + 64 * MiB;
constexpr size_t WS_END = (WS_MIXEND > WS_FFNEND ? WS_MIXEND : WS_FFNEND);
static_assert(WS_END < (size_t)1800 * MiB, "workspace budget");
static_assert((size_t)MTOK * DINP * 4 <= 207 * MiB && (size_t)32 * 36 * 129 * 128 * 4 <= 73 * MiB, "sizes");
constexpr int CW_BAR = 4096;
constexpr int CW_MOE = 16384;
constexpr int CW_QH = 20480;
constexpr int CW_ARR = 32768;

constexpr int RING_BYTES = 131072;
constexpr int MISC_OFF = 147456 - 256;
constexpr int LDS_BYTES = 147456;
constexpr int NWAVES = 8, NTHR = 512;

#define RLX_AGENT __ATOMIC_RELAXED, __HIP_MEMORY_SCOPE_AGENT
#define LDS_WAIT() asm volatile("s_waitcnt lgkmcnt(0)" ::: "memory")
#define VM_WAIT() asm volatile("s_waitcnt vmcnt(0)" ::: "memory")
DI unsigned f2bf(float f) { unsigned u = __builtin_bit_cast(unsigned, f); return (u + 0x7fffu + ((u >> 16) & 1u)) >> 16; }
DI unsigned pk2(float lo, float hi) { return f2bf(lo) | (f2bf(hi) << 16); }
DI float bf2f(unsigned b) { return __builtin_bit_cast(float, b << 16); }
DI float wave_sum(float v) {
#pragma unroll
    for (int o = 1; o < 64; o <<= 1) v += __shfl_xor(v, o);
    return v;
}
DI float wave_max(float v) {
#pragma unroll
    for (int o = 1; o < 64; o <<= 1) v = fmaxf(v, __shfl_xor(v, o));
    return v;
}
DI float wave_incl_scan(float v, int lane) {
#pragma unroll
    for (int o = 1; o < 64; o <<= 1) { const float t = __shfl_up(v, o); if (lane >= o) v += t; }
    return v;
}
DI float siluf(float x) { return x / (1.f + __expf(-x)); }
DI float sigmoidf_(float x) { return 1.f / (1.f + __expf(-x)); }
DI float softplusf_(float x) { return fmaxf(x, 0.f) + log1pf(__expf(-fabsf(x))); }
DI float logsigmoidf_(float x) { return fminf(x, 0.f) - log1pf(__expf(-fabsf(x))); }

#define XB_TMO      128
#define XB_XCNT(j)  (256  + 64 * (j))
#define XB_XSUB(j)  (1280 + 64 * (j))
#define XB_XGEN(j)  (2304 + 64 * (j))
#define XB_TOP      3328
#define XB_TOPGEN   3392
#define XCD_BAR_WORDS 3456
#define XB_SPIN_CAP (1u << 22)
DI unsigned xb_ld(unsigned* p)              { return __hip_atomic_load(p, __ATOMIC_RELAXED, __HIP_MEMORY_SCOPE_AGENT); }
DI unsigned xb_add(unsigned* p, unsigned v) { return __hip_atomic_fetch_add(p, v, __ATOMIC_RELAXED, __HIP_MEMORY_SCOPE_AGENT); }
DI unsigned xb_xcc_id() { return (unsigned)__builtin_amdgcn_s_getreg((3 << 11) | 20) & 0xFu; }
#define XB_SPIN(cond, bar) do { unsigned _sp = 0; while (cond) { __builtin_amdgcn_s_sleep(1); \
    if ((++_sp & 255u) == 0u) { if (xb_ld(&(bar)[XB_TMO])) break; if (_sp > XB_SPIN_CAP) { atomicAdd(&(bar)[XB_TMO], 1u); break; } } } } while (0)
struct XcdBarrier { unsigned* bar; unsigned x; volatile LAS unsigned* st; };
DI XcdBarrier xcd_barrier_post(unsigned* bar, volatile LAS unsigned* st) {
    XcdBarrier b; b.bar = bar; b.x = xb_xcc_id(); b.st = st;
    if (threadIdx.x == 0) (void)xb_add(&bar[XB_XCNT(b.x)], 1u);
    return b;
}
DI void xcd_barrier_complete(unsigned* bar, unsigned x, unsigned& nloc, unsigned& nx) {
    const unsigned G = gridDim.x * gridDim.y * gridDim.z;
    unsigned sum, cnt, mine, sp = 0u;
    for (;;) {
        sum = 0u; cnt = 0u; mine = 0u;
#pragma unroll
        for (unsigned j = 0; j < 16; ++j) { const unsigned c = xb_ld(&bar[XB_XCNT(j)]); sum += c; cnt += (c > 0u) ? 1u : 0u; mine = (j == x) ? c : mine; }
        if (sum == G) break;
        __builtin_amdgcn_s_sleep(1);
        if ((++sp & 255u) == 0u) { if (xb_ld(&bar[XB_TMO])) break; if (sp > XB_SPIN_CAP) { atomicAdd(&bar[XB_TMO], 1u); break; } }
    }
    nloc = mine > 0u ? mine : 1u; nx = cnt > 0u ? cnt : 1u;
}
DI void xcd_barrier(const XcdBarrier& b) {
    asm volatile("s_waitcnt vmcnt(0)" ::: "memory");
    __syncthreads();
    if (threadIdx.x == 0) {
        unsigned* bar = b.bar;
        __builtin_amdgcn_s_waitcnt(0);
        unsigned nloc = b.st[0], nx = b.st[1];
        if (nloc == 0u) { xcd_barrier_complete(bar, b.x, nloc, nx); b.st[0] = nloc; b.st[1] = nx; }
        const unsigned old = xb_add(&bar[XB_XSUB(b.x)], 1u);
        const unsigned gen = old / nloc;
        if (old + 1u == (gen + 1u) * nloc) {
            __builtin_amdgcn_fence(__ATOMIC_RELEASE, "agent");
            asm volatile("s_waitcnt vmcnt(0)" ::: "memory");
            const unsigned og = xb_add(&bar[XB_TOP], 1u);
            const unsigned tg = og / nx;
            if (og + 1u == (tg + 1u) * nx) xb_add(&bar[XB_TOPGEN], 1u);
            else XB_SPIN(xb_ld(&bar[XB_TOPGEN]) == tg, bar);
            __builtin_amdgcn_fence(__ATOMIC_ACQUIRE, "agent");
            xb_add(&bar[XB_XGEN(b.x)], 1u);
            asm volatile("s_waitcnt vmcnt(0)" ::: "memory");
        } else {
            XB_SPIN(xb_ld(&bar[XB_XGEN(b.x)]) == gen, bar);
            __builtin_amdgcn_fence(__ATOMIC_ACQUIRE, "agent");
            asm volatile("s_waitcnt vmcnt(0)" ::: "memory");
        }
    }
    __syncthreads();
}

struct Args { const float* in[35]; float* out; unsigned char* ws; int ph_lo, ph_hi, rep, pad; };
struct Frame {
    LAS unsigned char* lds;
    unsigned char* ws;
    const float* in[35];
    float* out;
    int tid, lane, wave, G, bid, rep;
};
#define WSP(T, off) ((T*)(F.ws + (off)))
DI int rowof(int b, int j) { return j < TL ? b * TL + j : MLAT + b * TC + (j - TL); }

template <int K> DI f32x4 mma16(const LAS bf16* A, int lda, const LAS bf16* Bt, int ldb, int lane, f32x4 acc) {
    const int r = lane & 15, q = lane >> 4;
    const LAS bf16* pa = A + r * lda + 8 * q; const LAS bf16* pb = Bt + r * ldb + 8 * q;
#pragma unroll
    for (int k = 0; k < K; k += 32) {
        const bf16x8 a = *(const LAS bf16x8*)(pa + k); const bf16x8 b = *(const LAS bf16x8*)(pb + k);
        acc = __builtin_amdgcn_mfma_f32_16x16x32_bf16(a, b, acc, 0, 0, 0);
    }
    return acc;
}
struct CvDesc { const float* src; bf16* dst; size_t ld, Kd; int Kv, Nv, k0, n0, dn0; };
DI void tr_load(const CvDesc& d, f32x4 (&v)[16], int lane) {
    const int nn = 4 * (lane & 15), kq = lane >> 4;
#pragma unroll
    for (int i = 0; i < 16; ++i) { const int kk = 4 * i + kq;
        v[i] = (f32x4){0.f, 0.f, 0.f, 0.f};
        if (d.k0 + kk < d.Kv && d.n0 + nn < d.Nv) v[i] = __builtin_nontemporal_load((const f32x4*)(d.src + (size_t)(d.k0 + kk) * d.ld + d.n0 + nn)); }
}
DI void tr_lds(const f32x4 (&v)[16], LAS float* scr, int lane) {
    const int nn = 4 * (lane & 15), kq = lane >> 4;
#pragma unroll
    for (int i = 0; i < 16; ++i) { const int kk = 4 * i + kq; LAS float* s = scr + kk * 65 + nn; s[0] = v[i][0]; s[1] = v[i][1]; s[2] = v[i][2]; s[3] = v[i][3]; }
    LDS_WAIT(); asm volatile("" ::: "memory");
}
DI void tr_out(const CvDesc& d, LAS float* scr, int lane) {
    const int c = lane & 7;
#pragma unroll
    for (int j = 0; j < 8; ++j) { const int n = (lane >> 3) + 8 * j; const LAS float* s = scr + (8 * c) * 65 + n;
        u32x4 o; o.x = pk2(s[0 * 65], s[1 * 65]); o.y = pk2(s[2 * 65], s[3 * 65]); o.z = pk2(s[4 * 65], s[5 * 65]); o.w = pk2(s[6 * 65], s[7 * 65]);
        *(u32x4*)(d.dst + (size_t)(d.dn0 + n) * d.Kd + d.k0 + 8 * c) = o; }
    LDS_WAIT(); asm volatile("" ::: "memory");
}
DI int il_row(int n0, int which) { return (n0 >> 7) * 256 + (n0 & 127) + which * 128; }

constexpr int I_IN = 32 * 92, I_OUT = 32 * 32, I_QB = 8 * 12, I_KVB = 4 * 16, I_F1 = 32 * 88, I_F2 = 88 * 32, I_M1 = 32 * 112, I_M2 = 112 * 32;
constexpr int I_L = I_IN + I_OUT + I_QB + I_KVB;
constexpr int CV_NE = I_L + 2 * I_F1 + I_F2, CV_NQ1 = CV_NE + I_L, CV_NALL = CV_NQ1 + NEXP * (2 * I_M1 + I_M2);
DI CvDesc conv_decode(Frame& F, int it) {
    int r = it;
    if (r >= CV_NQ1) { r -= CV_NQ1;
        if (r < NEXP * 2 * I_M1) { const int e = r / (2 * I_M1); r -= e * 2 * I_M1; const int which = r / I_M1; r -= which * I_M1; const int kb = r / 112, nb = r % 112;
            return CvDesc{(which ? F.in[33] : F.in[32]) + (size_t)e * D * FE, WSP(bf16, WS_MW13) + (size_t)e * 2 * FE * D, (size_t)(FE), (size_t)(D), D, FE, 64 * kb, 64 * nb, il_row(64 * nb, which)}; }
        r -= NEXP * 2 * I_M1;
        { const int e = r / I_M2; r -= e * I_M2; const int kb = r / 32, nb = r % 32;
            return CvDesc{F.in[34] + (size_t)e * FE * D, WSP(bf16, WS_MW2) + (size_t)e * D * FE, (size_t)(D), (size_t)(FE), FE, D, 64 * kb, 64 * nb, 64 * nb}; }
    }
    int l = 0;
    if (r >= CV_NE) { r -= CV_NE; l = 1; }
    else if (r >= I_L) { r -= I_L;
        if (r < 2 * I_F1) { const int which = r / I_F1; r -= which * I_F1; const int kb = r / 88, nb = r % 88;
            return CvDesc{(which ? F.in[29] : F.in[28]), WSP(bf16, WS_W13), (size_t)(FF), (size_t)(D), D, FF, 64 * kb, 64 * nb, il_row(64 * nb, which)}; }
        r -= 2 * I_F1;
        { const int kb = r / 32, nb = r % 32; return CvDesc{F.in[30], WSP(bf16, WS_W2), (size_t)(D), (size_t)(FF), FF, D, 64 * kb, 64 * nb, 64 * nb}; }
    }
    if (r < I_IN) { const int kb = r / 92, nb = r % 92;
        return CvDesc{F.in[7] + (size_t)l * D * DIN, WSP(bf16, WS_WIN) + (size_t)l * DINP * D, (size_t)(DIN), (size_t)(D), D, DIN, 64 * kb, 64 * nb, 64 * nb}; }
    r -= I_IN;
    if (r < I_OUT) { const int kb = r / 32, nb = r % 32;
        return CvDesc{F.in[8] + (size_t)l * D * D, WSP(bf16, WS_WOUT) + (size_t)l * D * D, (size_t)(D), (size_t)(D), D, D, 64 * kb, 64 * nb, 64 * nb}; }
    r -= I_OUT;
    if (r < I_QB) { const int kb = r / 12, nb = r % 12;
        return CvDesc{F.in[19] + (size_t)l * 448 * 768, WSP(bf16, WS_WQB) + (size_t)l * 768 * 512, (size_t)(768), (size_t)(512), 448, 768, 64 * kb, 64 * nb, 64 * nb}; }
    r -= I_QB;
    { const int kb = r / 16, nb = r % 16;
        return CvDesc{F.in[21] + (size_t)l * 160 * 1024, WSP(bf16, WS_WKVB) + (size_t)l * 1024 * 256, (size_t)(1024), (size_t)(256), 160, 1024, 64 * kb, 64 * nb, 64 * nb}; }
}

DI void conv_item(Frame& F, int it, LAS float* scr) { const CvDesc d = conv_decode(F, it); f32x4 v[16]; tr_load(d, v, F.lane); tr_lds(v, scr, F.lane); tr_out(d, scr, F.lane); }
DI void conv_items(Frame& F, int it0, int n, LAS float* scr) {
    if (it0 >= CV_NALL) return;
    if (it0 + n > CV_NALL) n = CV_NALL - it0;
    CvDesc d = conv_decode(F, it0); f32x4 v[16]; tr_load(d, v, F.lane);
    for (int k = 0; k < n; ++k) {
        tr_lds(v, scr, F.lane);
        CvDesc dn = d;
        if (k + 1 < n) { dn = conv_decode(F, it0 + k + 1); tr_load(dn, v, F.lane); }
        tr_out(d, scr, F.lane);
        d = dn;
    }
}
DI void p0_prologue(Frame& F) {
    {
        LAS float* sc = (LAS float*)F.lds;
        LAS float* red = (LAS float*)(F.lds + 5 * 2048 * 4);
        bool have = false;
        for (int u = F.bid; u < 2 * 96; u += F.G) {
            if (!have) {
                for (int i = F.tid; i < 5 * 2048; i += NTHR) { const float x = (i < 4 * 2048) ? F.in[1][i] : F.in[3][i - 4 * 2048]; sc[i] = siluf(x); }
                have = true;
            }
            __syncthreads();
            const int l = u / 96, j0 = (u % 96) * 128;
            const float* W = F.in[4] + (size_t)l * D * D6 + j0 + 2 * F.lane;
            f32x2 acc[5];
#pragma unroll
            for (int r = 0; r < 5; ++r) acc[r] = (f32x2){0.f, 0.f};
            const int kb = F.wave * 256;
            for (int k = 0; k < 256; k += 8) {
                f32x2 w[8];
#pragma unroll
                for (int i = 0; i < 8; ++i) w[i] = *(const f32x2*)(W + (size_t)(kb + k + i) * D6);
#pragma unroll
                for (int i = 0; i < 8; ++i)
#pragma unroll
                    for (int r = 0; r < 5; ++r) { const float s = sc[r * 2048 + kb + k + i]; acc[r] += w[i] * s; }
            }
#pragma unroll
            for (int r = 0; r < 5; ++r) { red[(F.wave * 5 + r) * 128 + 2 * F.lane] = acc[r][0]; red[(F.wave * 5 + r) * 128 + 2 * F.lane + 1] = acc[r][1]; }
            __syncthreads();
            for (int i = F.tid; i < 5 * 128; i += NTHR) { const int r = i / 128, j = i % 128; float s = F.in[5][l * D6 + j0 + j];
#pragma unroll
                for (int w = 0; w < 8; ++w) s += red[(w * 5 + r) * 128 + j];
                WSP(float, WS_MOD)[(l * 5 + r) * D6 + j0 + j] = s; }
        }
        __syncthreads();
    }
    LAS float* scr = (LAS float*)(F.lds + F.wave * 16640);
    const int gw = F.bid * NWAVES + F.wave, NGW = F.G * NWAVES;
    for (int it = gw; it < CV_NE; it += NGW) conv_item(F, it, scr);
}

constexpr int CV_NDEF = CV_NALL - CV_NE;
DI void conv_fill(Frame& F, int phase, bool work) {
    LAS float* scr = (LAS float*)(F.lds + F.wave * 16640);
    volatile LAS int* bc = (volatile LAS int*)(F.lds + MISC_OFF) + 16;
    unsigned* ctl = WSP(unsigned, WS_CTL);
    __syncthreads();
    if (F.tid == 0) __hip_atomic_fetch_add(ctl + CW_ARR + 64 * phase, 1u, RLX_AGENT);
    if (!work) return;
    for (;;) {
        if (F.tid == 0) {
            int base = -1;
            if (__hip_atomic_load(ctl + CW_ARR + 64 * phase, RLX_AGENT) < (unsigned)F.G) { base = (int)__hip_atomic_fetch_add(ctl + CW_QH, 32u, RLX_AGENT); if (base >= CV_NDEF) base = -1; }
            bc[0] = base;
        }
        __syncthreads();
        const int base = bc[0];
        __syncthreads();
        if (base < 0) break;
        conv_items(F, CV_NE + base + F.wave * 4, 4, scr);
    }
}
DI void conv_drain(Frame& F, int upto) {
    LAS float* scr = (LAS float*)(F.lds + F.wave * 16640);
    volatile LAS int* bc = (volatile LAS int*)(F.lds + MISC_OFF) + 16;
    unsigned* ctl = WSP(unsigned, WS_CTL);
    __syncthreads();
    for (;;) {
        if (F.tid == 0) {
            int base = -1;
            if ((int)__hip_atomic_load(ctl + CW_QH, RLX_AGENT) < upto) { base = (int)__hip_atomic_fetch_add(ctl + CW_QH, 64u, RLX_AGENT); if (base >= CV_NDEF) base = -1; }
            bc[0] = base;
        }
        __syncthreads();
        const int base = bc[0];
        __syncthreads();
        if (base < 0) break;
        conv_items(F, CV_NE + base + F.wave * 8, 8, scr);
    }
}
template <bool ROUTE>
DI void norm_phase(Frame& F, int l, const float* srcLat, const float* srcCtx, const float* g, int shoff, int nrows) {
    LAS float* rl = (LAS float*)F.lds;
    if (ROUTE) { for (int i = F.tid; i < D * NEXP; i += NTHR) rl[i] = F.in[31][i]; __syncthreads(); }
    const int gw = F.bid * NWAVES + F.wave, NGW = F.G * NWAVES;
    bf16* HN = WSP(bf16, WS_HN);
    for (int row = gw; row < nrows; row += NGW) {
        const float* xr = row < MLAT ? srcLat + (size_t)row * D : srcCtx + (size_t)(row - MLAT) * D;
        const int br = row < MLAT ? row / TL : 4;
        const float* mrow = WSP(float, WS_MOD) + (size_t)(l * 5 + br) * D6 + shoff;
        f32x4 v[8]; float ss = 0.f;
#pragma unroll
        for (int j = 0; j < 8; ++j) { v[j] = *(const f32x4*)(xr + 4 * F.lane + 256 * j); ss += (v[j][0] * v[j][0] + v[j][1] * v[j][1]) + (v[j][2] * v[j][2] + v[j][3] * v[j][3]); }
        const float rstd = 1.0f / sqrtf(wave_sum(ss) * (1.f / D) + EPS);
        float lg[8];
        if (ROUTE) {
#pragma unroll
            for (int e = 0; e < 8; ++e) lg[e] = 0.f; }
#pragma unroll
        for (int j = 0; j < 8; ++j) { const int c = 4 * F.lane + 256 * j;
            const f32x4 gg = *(const f32x4*)(g + c), sh = *(const f32x4*)(mrow + c), sc = *(const f32x4*)(mrow + D + c);
            f32x4 o;
#pragma unroll
            for (int i = 0; i < 4; ++i) o[i] = v[j][i] * rstd * gg[i] * (1.f + sc[i]) + sh[i];
            u32x2 w; w.x = pk2(o[0], o[1]); w.y = pk2(o[2], o[3]);
            *(u32x2*)(HN + (size_t)row * D + c) = w;
            if (ROUTE) {
#pragma unroll
                for (int i = 0; i < 4; ++i) { const f32x4 r0 = *(const LAS f32x4*)(rl + (c + i) * 8), r1 = *(const LAS f32x4*)(rl + (c + i) * 8 + 4);
                    lg[0] += o[i] * r0[0]; lg[1] += o[i] * r0[1]; lg[2] += o[i] * r0[2]; lg[3] += o[i] * r0[3];
                    lg[4] += o[i] * r1[0]; lg[5] += o[i] * r1[1]; lg[6] += o[i] * r1[2]; lg[7] += o[i] * r1[3]; }
                __builtin_amdgcn_sched_barrier(0);
            }
        }
        if (ROUTE) {
#pragma unroll
            for (int e = 0; e < 8; ++e) lg[e] = wave_sum(lg[e]);
            if (F.lane == 0) {
                int e1 = 0; float v1 = lg[0];
#pragma unroll
                for (int e = 1; e < 8; ++e) if (lg[e] > v1) { v1 = lg[e]; e1 = e; }
                int e2 = -1; float v2 = -3.0e38f;
#pragma unroll
                for (int e = 0; e < 8; ++e) if (e != e1 && lg[e] > v2) { v2 = lg[e]; e2 = e; }
                const float g2 = 1.f / (1.f + expf(v1 - v2)), g1 = 1.f - g2;
                unsigned* cnt = WSP(unsigned, WS_CTL) + CW_MOE;
                const unsigned p1 = __hip_atomic_fetch_add(cnt + e1, 1u, RLX_AGENT), p2 = __hip_atomic_fetch_add(cnt + e2, 1u, RLX_AGENT);
                int* tk = WSP(int, WS_TOK) + (size_t)row * 8;
                tk[0] = e1; tk[1] = (int)p1; tk[2] = e2; tk[3] = (int)p2; ((float*)tk)[4] = g1; ((float*)tk)[5] = g2;
            }
        }
    }
}

DI void moe_tables(Frame& F, LAS int* tb, int NT) {
    if (F.tid == 0) {
        const unsigned* cnt = WSP(unsigned, WS_CTL) + CW_MOE; int ts = 0, us = 0;
        for (int e = 0; e < 8; ++e) { const int c = (int)__hip_atomic_load(cnt + e, RLX_AGENT); const int t = (c + 255) >> 8; tb[e] = c; tb[8 + e] = t; tb[16 + e] = ts; tb[32 + e] = us; ts += t; us += t * NT; }
        tb[24] = ts; tb[40] = us;
    }
    __syncthreads();
}
DI void moe_gather_phase(Frame& F) {
    LAS int* tb = (LAS int*)F.lds; moe_tables(F, tb, 1);
    const int gw = F.bid * NWAVES + F.wave, NGW = F.G * NWAVES;
    const bf16* HN = WSP(bf16, WS_HN); bf16* XG = WSP(bf16, WS_XG);
    for (int row = gw; row < MLAT; row += NGW) {
        int* tk = WSP(int, WS_TOK) + (size_t)row * 8;
        const int e1 = tk[0], p1 = tk[1], e2 = tk[2], p2 = tk[3];
        const int s1 = tb[16 + e1] * 256 + p1, s2 = tb[16 + e2] * 256 + p2;
        const u32x4* src = (const u32x4*)(HN + (size_t)row * D) + F.lane;
        u32x4 a[4];
#pragma unroll
        for (int j = 0; j < 4; ++j) a[j] = src[64 * j];
        u32x4* d1 = (u32x4*)(XG + (size_t)s1 * D) + F.lane; u32x4* d2 = (u32x4*)(XG + (size_t)s2 * D) + F.lane;
#pragma unroll
        for (int j = 0; j < 4; ++j) { d1[64 * j] = a[j]; d2[64 * j] = a[j]; }
        if (F.lane == 0) { tk[6] = s1; tk[7] = s2; }
    }
    const int nrow = tb[24] * 256;
    for (int r = gw; r < nrow; r += NGW) {
        const int t = r >> 8; int e = 0;
#pragma unroll
        for (int k = 1; k < 8; ++k) if (t >= tb[16 + k]) e = k;
        const int local = r - tb[16 + e] * 256;
        if (local >= tb[e]) { u32x4* d = (u32x4*)(XG + (size_t)r * D) + F.lane; const u32x4 z = (u32x4){0u, 0u, 0u, 0u};
#pragma unroll
            for (int j = 0; j < 4; ++j) d[64 * j] = z; }
    }
}
DI void moe_combine_phase(Frame& F, int l) {
    const int gw = F.bid * NWAVES + F.wave, NGW = F.G * NWAVES;
    const float* Y = WSP(float, WS_Y); const float* X = WSP(float, WS_X);
    for (int row = gw; row < MLAT; row += NGW) {
        const int* tk = WSP(int, WS_TOK) + (size_t)row * 8;
        const float g1 = ((const float*)tk)[4], g2 = ((const float*)tk)[5]; const int s1 = tk[6], s2 = tk[7];
        const float* mrow = WSP(float, WS_MOD) + (size_t)(l * 5 + row / TL) * D6 + 5 * D;
        f32x4 xv[8], y1[8], y2[8];
#pragma unroll
        for (int j = 0; j < 8; ++j) { const int c = 4 * F.lane + 256 * j;
            xv[j] = *(const f32x4*)(X + (size_t)row * D + c); y1[j] = *(const f32x4*)(Y + (size_t)s1 * D + c); y2[j] = *(const f32x4*)(Y + (size_t)s2 * D + c); }
#pragma unroll
        for (int j = 0; j < 8; ++j) { const int c = 4 * F.lane + 256 * j; const f32x4 gg = *(const f32x4*)(mrow + c);
            *(f32x4*)(F.out + (size_t)row * D + c) = xv[j] + gg * (y1[j] * g1 + y2[j] * g2); }
    }
}
using pg8::Unit;
struct EpiF32 {
    static constexpr bool PERM = false;
    float* C; int ldc;
    DI void operator()(const f32x4 (&acc)[2][2][4][2], const Unit& u, int wr, int wc, int fr, int fq) const {
        const int row0 = u.pm * 256 + wr * 64 + fr, col0 = u.pn * 256 + wc * 32 + 4 * fq;
#pragma unroll
        for (int ai = 0; ai < 2; ++ai)
#pragma unroll
            for (int m = 0; m < 4; ++m) { float* rowp = C + (size_t)(row0 + ai * 128 + m * 16) * ldc + col0;
#pragma unroll
                for (int bj = 0; bj < 2; ++bj)
#pragma unroll
                    for (int n = 0; n < 2; ++n) *(f32x4*)(rowp + bj * 128 + n * 16) = acc[ai][bj][m][n]; }
    }
};
struct EpiBf16 {
    static constexpr bool PERM = true;
    bf16* O; int ldc;
    DI void operator()(const f32x4 (&acc)[2][2][4][2], const Unit& u, int wr, int wc, int fr, int fq) const {
        const int row0 = u.pm * 256 + wr * 64 + fr, col0 = u.pn * 256 + wc * 32 + 8 * fq;
#pragma unroll
        for (int ai = 0; ai < 2; ++ai)
#pragma unroll
            for (int m = 0; m < 4; ++m) { bf16* rowp = O + (size_t)(row0 + ai * 128 + m * 16) * ldc + col0;
#pragma unroll
                for (int bj = 0; bj < 2; ++bj) { const f32x4 v0 = acc[ai][bj][m][0], v1 = acc[ai][bj][m][1];
                    u32x4 w; w.x = pg8::cvt_pk_bf16(v0[0], v0[1]); w.y = pg8::cvt_pk_bf16(v0[2], v0[3]); w.z = pg8::cvt_pk_bf16(v1[0], v1[1]); w.w = pg8::cvt_pk_bf16(v1[2], v1[3]);
                    *(u32x4*)(rowp + bj * 128) = w; } }
    }
};
struct EpiSwiglu {
    static constexpr bool PERM = true;
    bf16* O; int ldc;
    DI void operator()(const f32x4 (&acc)[2][2][4][2], const Unit& u, int wr, int wc, int fr, int fq) const {
        const int row0 = u.pm * 256 + wr * 64 + fr, col0 = u.pn * 128 + wc * 32 + 8 * fq;
#pragma unroll
        for (int ai = 0; ai < 2; ++ai)
#pragma unroll
            for (int m = 0; m < 4; ++m) { bf16* rowp = O + (size_t)(row0 + ai * 128 + m * 16) * ldc + col0;
                f32x4 v0, v1;
#pragma unroll
                for (int j = 0; j < 4; ++j) { v0[j] = siluf(acc[ai][0][m][0][j]) * acc[ai][1][m][0][j]; v1[j] = siluf(acc[ai][0][m][1][j]) * acc[ai][1][m][1][j]; }
                u32x4 w; w.x = pg8::cvt_pk_bf16(v0[0], v0[1]); w.y = pg8::cvt_pk_bf16(v0[2], v0[3]); w.z = pg8::cvt_pk_bf16(v1[0], v1[1]); w.w = pg8::cvt_pk_bf16(v1[2], v1[3]);
                *(u32x4*)rowp = w; }
    }
};
struct EpiResid {
    static constexpr bool PERM = false;
    const float* baseLat; const float* baseCtx; float* out; const float* mod;
    DI void operator()(const f32x4 (&acc)[2][2][4][2], const Unit& u, int wr, int wc, int fr, int fq) const {
        const int row0 = u.pm * 256 + wr * 64 + fr, col0 = u.pn * 256 + wc * 32 + 4 * fq;
        const int br = (u.pm * 256 < MLAT) ? (u.pm * 256) / TL : 4;
        const float* gate = mod + (size_t)br * D6 + col0;
        f32x4 gv[2][2];
#pragma unroll
        for (int bj = 0; bj < 2; ++bj)
#pragma unroll
            for (int n = 0; n < 2; ++n) gv[bj][n] = *(const f32x4*)(gate + bj * 128 + n * 16);
#pragma unroll
        for (int ai = 0; ai < 2; ++ai)
#pragma unroll
            for (int m = 0; m < 4; ++m) { const int row = row0 + ai * 128 + m * 16;
                const float* bp = (row < MLAT ? baseLat + (size_t)row * D : baseCtx + (size_t)(row - MLAT) * D) + col0; float* op = out + (size_t)row * D + col0;
#pragma unroll
                for (int bj = 0; bj < 2; ++bj)
#pragma unroll
                    for (int n = 0; n < 2; ++n) { const f32x4 b = *(const f32x4*)(bp + bj * 128 + n * 16); *(f32x4*)(op + bj * 128 + n * 16) = b + gv[bj][n] * acc[ai][bj][m][n]; } }
    }
};
struct MoeOrder {
    const LAS int* tb; int NT, G, c, L0, nT, S, KS;
    DI bool next(int i, Unit& u) const {
        const long T = (long)i * G + c; if (T >= nT) return false;
        const int nun = tb[40], L = L0 + (int)T / S, sl = (int)T % S;
        const int w = pg8::xcd_remap(L, nun); int e = 0;
#pragma unroll
        for (int k = 1; k < 8; ++k) if (w >= tb[32 + k]) e = k;
        const int rem = w - tb[32 + e], tiles = tb[8 + e], nt = rem / tiles, mtl = rem - nt * tiles;
        u.pm = tb[16 + e] + mtl; u.pn = nt; u.pb = e * NT + nt; u.koff = sl * KS; u.aux = (int)T; return true;
    }
};
struct EpiPart {
    static constexpr bool PERM = false;
    float* part;
    DI void operator()(const f32x4 (&acc)[2][2][4][2], const Unit& u, int wr, int wc, int fr, int fq) const {
        f32x4* p = (f32x4*)part + (size_t)u.aux * (32 * NTHR) + threadIdx.x;
#pragma unroll
        for (int ai = 0; ai < 2; ++ai)
#pragma unroll
            for (int bj = 0; bj < 2; ++bj)
#pragma unroll
                for (int m = 0; m < 4; ++m)
#pragma unroll
                    for (int n = 0; n < 2; ++n) p[(size_t)(((ai * 2 + bj) * 4 + m) * 2 + n) * NTHR] = acc[ai][bj][m][n];
    }
};
template <int S> DI void splitk_reduce_f32(const float* part, int t, int cg, const Unit& u, float* C, int ldc) {
    const int tid = threadIdx.x, wid = tid >> 6, lane = tid & 63, wr = wid >> 2, wc = wid & 3, fr = lane & 15, fq = lane >> 4;
    f32x4 v[4][S];
#pragma unroll
    for (int k = 0; k < 4; ++k)
#pragma unroll
        for (int s = 0; s < S; ++s) v[k][s] = *((const f32x4*)part + ((size_t)(t * S + s) * 32 + (cg * 4 + k)) * NTHR + tid);
#pragma unroll
    for (int k = 0; k < 4; ++k) { const int ch = cg * 4 + k, n = ch & 1, m = (ch >> 1) & 3, bj = (ch >> 3) & 1, ai = ch >> 4;
        f32x4 a = v[k][0];
#pragma unroll
        for (int s = 1; s < S; ++s) a += v[k][s];
        *(f32x4*)(C + (size_t)(u.pm * 256 + ai * 128 + wr * 64 + m * 16 + fr) * ldc + u.pn * 256 + bj * 128 + wc * 32 + n * 16 + 4 * fq) = a; }
}
DI int tc_of(int dir, int p) { return dir == 0 ? (p < 4 ? 32 + p : p - 4) : 35 - p; }

DI void m1_prep_unit(Frame& F, int l, int b, int tt) {
    const float* P = WSP(float, WS_P);
    const int j0 = tt * 32, lane = F.lane;
    LAS bf16* vs = (LAS bf16*)F.lds;
    for (int i = F.wave; i < 32; i += 8) {
        const int j = j0 + i, row = rowof(b, j);
        const float* p = P + (size_t)row * DINP;
        float cq[7], ckv[3], nq[4][2], nk[4][2], nv[8];
#pragma unroll
        for (int u = 0; u < 7; ++u) cq[u] = p[PC_CQ + lane + 64 * u];
#pragma unroll
        for (int u = 0; u < 3; ++u) { const int idx = lane + 64 * u; ckv[u] = idx < 160 ? p[PC_CKV + idx] : 0.f; }
#pragma unroll
        for (int h = 0; h < 4; ++h) { nq[h][0] = p[PC_NQ + h * 128 + lane]; nq[h][1] = p[PC_NQ + h * 128 + 64 + lane]; nk[h][0] = p[PC_NK + h * 128 + lane]; nk[h][1] = p[PC_NK + h * 128 + 64 + lane]; }
#pragma unroll
        for (int u = 0; u < 8; ++u) nv[u] = p[PC_NV + lane + 64 * u];
        const float gi = lane < 8 ? p[PC_IG + lane] : 0.f, gf = lane < 8 ? p[PC_FG + lane] : 0.f, gd = lane < 16 ? p[PC_DT + lane] : 0.f;
        {
            float ss = 0.f;
#pragma unroll
            for (int u = 0; u < 7; ++u) ss += cq[u] * cq[u];
            const float rstd = 1.0f / sqrtf(wave_sum(ss) * (1.f / 448.f) + EPS);
            const float* qn = F.in[18] + l * 448; bf16* o = WSP(bf16, WS_CQN) + (size_t)row * 512;
#pragma unroll
            for (int u = 0; u < 7; ++u) o[lane + 64 * u] = (bf16)f2bf(cq[u] * rstd * qn[lane + 64 * u]);
            o[448 + lane] = 0;
        }
        {
            float ss = 0.f;
#pragma unroll
            for (int u = 0; u < 3; ++u) ss += ckv[u] * ckv[u];
            const float rstd = 1.0f / sqrtf(wave_sum(ss) * (1.f / 160.f) + EPS);
            const float* kn = F.in[20] + l * 160; bf16* o = WSP(bf16, WS_CKVN) + (size_t)row * 256;
#pragma unroll
            for (int u = 0; u < 3; ++u) { const int idx = lane + 64 * u; o[idx] = idx < 160 ? (bf16)f2bf(ckv[u] * rstd * kn[idx]) : (bf16)0; }
            o[192 + lane] = 0;
        }
        const float* gq = F.in[24] + l * 128; const float* gk = F.in[25] + l * 128;
#pragma unroll
        for (int h = 0; h < 4; ++h) {
            const float rq = 1.0f / sqrtf(wave_sum(nq[h][0] * nq[h][0] + nq[h][1] * nq[h][1]) * (1.f / 128.f) + EPS);
            const float rk = 1.0f / sqrtf(wave_sum(nk[h][0] * nk[h][0] + nk[h][1] * nk[h][1]) * (1.f / 128.f) + EPS);
            bf16* oq = WSP(bf16, WS_QNA) + ((size_t)(b * 4 + h) * TS + j) * 128; bf16* ok = WSP(bf16, WS_KNA) + ((size_t)(b * 4 + h) * TS + j) * 128;
            oq[lane] = (bf16)f2bf(nq[h][0] * rq * gq[lane]); oq[64 + lane] = (bf16)f2bf(nq[h][1] * rq * gq[64 + lane]);
            ok[lane] = (bf16)f2bf(nk[h][0] * rk * gk[lane]); ok[64 + lane] = (bf16)f2bf(nk[h][1] * rk * gk[64 + lane]);
        }
#pragma unroll
        for (int u = 0; u < 8; ++u) vs[i * 520 + lane + 64 * u] = (bf16)f2bf(nv[u]);
        if (lane < 8) {
            float* gt = WSP(float, WS_GATES) + (size_t)row * 16;
            gt[lane] = gi + F.in[9][l * 8 + lane];
            gt[8 + lane] = logsigmoidf_(gf + F.in[10][l * 8 + lane]);
        }
        if (lane < 16) WSP(float, WS_DT)[(size_t)row * 16 + lane] = softplusf_(gd + F.in[14][l * 16 + lane]);
    }
    {
        const int ch = 2 * F.tid;
        const int seglo = j0 < TL ? 0 : TL, seghi = j0 < TL ? TL : TS;
        const float* cw = F.in[12] + (size_t)l * 5 * 1024 + ch; const float* cb = F.in[13] + (size_t)l * 1024 + ch;
        f32x2 w[5];
#pragma unroll
        for (int d = 0; d < 5; ++d) w[d] = *(const f32x2*)(cw + d * 1024);
        const f32x2 bias = *(const f32x2*)cb;
        f32x2 xin[36];
#pragma unroll
        for (int d = 0; d < 36; ++d) { const int jj = j0 - 2 + d; xin[d] = (jj >= seglo && jj < seghi) ? *(const f32x2*)(P + (size_t)rowof(b, jj) * DINP + PC_XBC + ch) : (f32x2){0.f, 0.f}; }
#pragma unroll
        for (int i = 0; i < 32; ++i) {
            f32x2 a = bias;
#pragma unroll
            for (int d = 0; d < 5; ++d) a += w[d] * xin[i + d];
            *(unsigned*)(WSP(bf16, WS_XBC) + (size_t)rowof(b, j0 + i) * 1024 + ch) = pk2(siluf(a[0]), siluf(a[1]));
        }
    }
    __syncthreads();
    {
        const int t = F.tid; unsigned wv[16];
#pragma unroll
        for (int i = 0; i < 16; ++i) wv[i] = (unsigned)vs[(2 * i) * 520 + t] | ((unsigned)vs[(2 * i + 1) * 520 + t] << 16);
        u32x4* dst = (u32x4*)(WSP(bf16, WS_VTNA) + ((size_t)(b * 4 + (t >> 7)) * 128 + (t & 127)) * TS + j0);
#pragma unroll
        for (int k = 0; k < 4; ++k) dst[k] = (u32x4){wv[4 * k], wv[4 * k + 1], wv[4 * k + 2], wv[4 * k + 3]};
    }
    __syncthreads();
}

DI void ml_a_unit(Frame& F, int seq, int p) {
    const int b = seq >> 3, h = (seq >> 1) & 3, dir = seq & 1, tc = tc_of(dir, p), lane = F.lane;
    const float* P = WSP(float, WS_P);
    LAS bf16* VW = (LAS bf16*)F.lds;
    LAS bf16* KT = (LAS bf16*)(F.lds + 20736);
    LAS float* wgs = (LAS float*)(F.lds + 39168);
    if (F.wave == 0) {
        const int row = rowof(b, tc * 64 + lane);
        const float* gt = WSP(float, WS_GATES) + (size_t)row * 16;
        const float li = gt[dir * 4 + h], lf = gt[8 + dir * 4 + h];
        const float pre = wave_incl_scan(lf, lane), tot = __shfl(pre, 63);
        const float g = dir == 0 ? (tot - pre) + li : (pre - lf) + li;
        const float mloc = wave_max(g);
        wgs[lane] = __expf(g - mloc);
        if (lane == 0) { float* sc = WSP(float, WS_MLSC) + (size_t)(seq * 36 + p) * 4; sc[0] = tot; sc[1] = mloc; }
    }
    {
        float vv[16], kk[16];
#pragma unroll
        for (int it = 0; it < 16; ++it) { const int idx = F.tid + NTHR * it, n = idx >> 7, d = idx & 127;
            const float* pr = P + (size_t)rowof(b, tc * 64 + n) * DINP + h * 128 + d; vv[it] = pr[PC_MLV]; kk[it] = pr[PC_MLK]; }
        __syncthreads();
#pragma unroll
        for (int it = 0; it < 16; ++it) { const int idx = F.tid + NTHR * it, n = idx >> 7, d = idx & 127;
            VW[d * 72 + n] = (bf16)f2bf(vv[it] * wgs[n]); KT[d * 72 + n] = (bf16)f2bf(kk[it]); }
    }
    for (int idx = F.tid; idx < 16 * 64; idx += NTHR) { const int rr = idx >> 6, n = idx & 63; VW[(128 + rr) * 72 + n] = rr == 0 ? (bf16)f2bf(wgs[n]) : (bf16)0; }
    __syncthreads();
    float* U = WSP(float, WS_MLU) + (size_t)(seq * 36 + p) * (129 * 128);
    for (int id = F.wave; id < 72; id += 8) { const int dt = id >> 3, et = id & 7;
        const f32x4 acc = mma16<64>(VW + dt * 16 * 72, 72, KT + et * 16 * 72, 72, lane, (f32x4){0.f, 0.f, 0.f, 0.f});
#pragma unroll
        for (int i = 0; i < 4; ++i) { const int d = dt * 16 + 4 * (lane >> 4) + i; if (d < 129) U[d * 128 + et * 16 + (lane & 15)] = acc[i]; } }
    __syncthreads();
}

DI void ss_a_unit(Frame& F, int l, int b, int dir, int p, int g) {
    const int tc = tc_of(dir, p), lane = F.lane;
    LAS bf16* XT = (LAS bf16*)F.lds;
    LAS bf16* BT = (LAS bf16*)(F.lds + 36864);
    LAS float* tails = (LAS float*)(F.lds + 55296);
    const bf16* XBC = WSP(bf16, WS_XBC);
    if (F.wave < 4) {
        const int h = 4 * g + F.wave, row = rowof(b, tc * 64 + lane);
        const float dt = WSP(float, WS_DT)[(size_t)row * 16 + dir * 8 + h];
        const float A = -__expf(F.in[15][l * 16 + dir * 8 + h]);
        const float a = dt * A, pre = wave_incl_scan(a, lane), tot = __shfl(pre, 63);
        tails[F.wave * 64 + lane] = (dir == 0 ? __expf(tot - pre) : __expf(pre - a)) * dt;
        if (lane == 0) WSP(float, WS_SSSC)[(size_t)((b * 8 + h) * 2 + dir) * 36 + p] = __expf(tot);
    }
    {
        bf16 xv[32], bv[16];
#pragma unroll
        for (int it = 0; it < 32; ++it) { const int idx = F.tid + NTHR * it, n = idx >> 8, c = idx & 255; xv[it] = XBC[(size_t)rowof(b, tc * 64 + n) * 1024 + g * 256 + c]; }
#pragma unroll
        for (int it = 0; it < 16; ++it) { const int idx = F.tid + NTHR * it, n = idx >> 7, nn = idx & 127; bv[it] = XBC[(size_t)rowof(b, tc * 64 + n) * 1024 + 512 + g * 128 + nn]; }
        __syncthreads();
#pragma unroll
        for (int it = 0; it < 32; ++it) { const int idx = F.tid + NTHR * it, n = idx >> 8, c = idx & 255; XT[c * 72 + n] = (bf16)f2bf(bf2f(xv[it]) * tails[(c >> 6) * 64 + n]); }
#pragma unroll
        for (int it = 0; it < 16; ++it) { const int idx = F.tid + NTHR * it, n = idx >> 7, nn = idx & 127; BT[nn * 72 + n] = bv[it]; }
    }
    __syncthreads();
    for (int id = F.wave; id < 128; id += 8) { const int hh = id >> 5, rem = id & 31, pt = rem >> 3, nt = rem & 7;
        const f32x4 acc = mma16<64>(XT + (hh * 64 + pt * 16) * 72, 72, BT + nt * 16 * 72, 72, lane, (f32x4){0.f, 0.f, 0.f, 0.f});
        float* U = WSP(float, WS_SSU) + (size_t)(((b * 8 + 4 * g + hh) * 2 + dir) * 36 + p) * 8192;
#pragma unroll
        for (int i = 0; i < 4; ++i) U[(pt * 16 + 4 * (lane >> 4) + i) * 128 + nt * 16 + (lane & 15)] = acc[i]; }
    __syncthreads();
}
DI void ml_scan_unit(Frame& F, int seq, int s4) {
    float* sc = WSP(float, WS_MLSC) + (size_t)seq * 36 * 4;
    const float* U = WSP(float, WS_MLU) + (size_t)seq * 36 * 16512 + s4 * 4128 + F.tid; bf16* S = WSP(bf16, WS_MLS) + (size_t)seq * 36 * 16512 + s4 * 4128 + F.tid;
    float st[9]; float m = 0.f;
#pragma unroll
    for (int k = 0; k < 9; ++k) st[k] = 0.f;
    for (int pg = 0; pg < 36; pg += 12) {
        float u[12][9];
#pragma unroll
        for (int pp = 0; pp < 12; ++pp)
#pragma unroll
            for (int k = 0; k < 9; ++k) u[pp][k] = (F.tid + 512 * k < 4128) ? U[(size_t)(pg + pp) * 16512 + 512 * k] : 0.f;
#pragma unroll
        for (int pp = 0; pp < 12; ++pp) { const int p = pg + pp;
            const float bl = sc[p * 4], mloc = sc[p * 4 + 1];
            const float mn = fmaxf(bl + m, mloc), wc = __expf(bl + m - mn), wu = __expf(mloc - mn);
            if (s4 == 0 && F.tid == 0) sc[p * 4 + 2] = m;
#pragma unroll
            for (int k = 0; k < 9; ++k) { if (F.tid + 512 * k < 4128) S[(size_t)p * 16512 + 512 * k] = (bf16)f2bf(st[k]); st[k] = wc * st[k] + wu * u[pp][k]; }
            m = mn; }
    }
}
DI void ss_scan_unit(Frame& F, int sq, int half) {
    const float* dec = WSP(float, WS_SSSC) + (size_t)sq * 36;
    const float* U = WSP(float, WS_SSU) + (size_t)sq * 36 * 8192 + half * 4096 + F.tid; bf16* S = WSP(bf16, WS_SSS) + (size_t)sq * 36 * 8192 + half * 4096 + F.tid;
    float st[8];
#pragma unroll
    for (int k = 0; k < 8; ++k) st[k] = 0.f;
    for (int pg = 0; pg < 36; pg += 12) {
        float u[12][8];
#pragma unroll
        for (int pp = 0; pp < 12; ++pp)
#pragma unroll
            for (int k = 0; k < 8; ++k) u[pp][k] = U[(size_t)(pg + pp) * 8192 + 512 * k];
#pragma unroll
        for (int pp = 0; pp < 12; ++pp) { const int p = pg + pp; const float dc = dec[p];
#pragma unroll
            for (int k = 0; k < 8; ++k) { S[(size_t)p * 8192 + 512 * k] = (bf16)f2bf(st[k]); st[k] = st[k] * dc + u[pp][k]; } }
    }
}
DI void mla_post_unit(Frame& F, int l, int b, int tt) {
    const float* P = WSP(float, WS_P);
    const bf16* QRAW = WSP(bf16, WS_QRAW); const bf16* KVRAW = WSP(bf16, WS_KVRAW);
    const int j0 = tt * 32, lane = F.lane;
    LAS bf16* vs = (LAS bf16*)F.lds;
    const float* gq = F.in[22] + l * 192; const float* gk = F.in[23] + l * 192;
    for (int i = F.wave; i < 32; i += 8) {
        const int j = j0 + i, row = rowof(b, j); const bool lat = j < TL;
        const int a = lane & 31; const float pos = (float)(a < 16 ? (j >> 6) : (j & 63));
        const float fr = exp2f(-(float)(a & 15) * (13.287712379549449f / 16.f));
        const float ang = pos * fr; const float cs = __cosf(ang), sn = __sinf(ang);
        const float krv = P[(size_t)row * DINP + PC_KR + lane];
        float qv[4][3], kk[4][2]; bf16 vv[4][2];
#pragma unroll
        for (int h = 0; h < 4; ++h) { const bf16* q = QRAW + (size_t)row * 768 + h * 192; const bf16* kv = KVRAW + (size_t)row * 1024 + h * 256;
            qv[h][0] = bf2f(q[lane]); qv[h][1] = bf2f(q[64 + lane]); qv[h][2] = bf2f(q[128 + lane]);
            kk[h][0] = bf2f(kv[lane]); kk[h][1] = bf2f(kv[64 + lane]); vv[h][0] = kv[128 + lane]; vv[h][1] = kv[192 + lane]; }
#pragma unroll
        for (int h = 0; h < 4; ++h) {
            {
                const float v0 = qv[h][0], v1 = qv[h][1], v2 = qv[h][2];
                const float rstd = 1.0f / sqrtf(wave_sum(v0 * v0 + v1 * v1 + v2 * v2) * (1.f / 192.f) + EPS);
                const float n0 = v0 * rstd * gq[lane], n1 = v1 * rstd * gq[64 + lane]; float n2 = v2 * rstd * gq[128 + lane];
                const float pr = __shfl_xor(n2, 32);
                if (lat) n2 = lane < 32 ? n2 * cs - pr * sn : pr * sn + n2 * cs;
                bf16* o = WSP(bf16, WS_QMLA) + ((size_t)(b * 4 + h) * TS + j) * 192;
                o[lane] = (bf16)f2bf(n0); o[64 + lane] = (bf16)f2bf(n1); o[128 + lane] = (bf16)f2bf(n2);
            }
            {
                const float v0 = kk[h][0], v1 = kk[h][1], v2 = krv;
                const float rstd = 1.0f / sqrtf(wave_sum(v0 * v0 + v1 * v1 + v2 * v2) * (1.f / 192.f) + EPS);
                const float n0 = v0 * rstd * gk[lane], n1 = v1 * rstd * gk[64 + lane]; float n2 = v2 * rstd * gk[128 + lane];
                const float pr = __shfl_xor(n2, 32);
                if (lat) n2 = lane < 32 ? n2 * cs - pr * sn : pr * sn + n2 * cs;
                bf16* o = WSP(bf16, WS_KMLA) + ((size_t)(b * 4 + h) * TS + j) * 192;
                o[lane] = (bf16)f2bf(n0); o[64 + lane] = (bf16)f2bf(n1); o[128 + lane] = (bf16)f2bf(n2);
                vs[i * 520 + h * 128 + lane] = vv[h][0]; vs[i * 520 + h * 128 + 64 + lane] = vv[h][1];
            }
        }
    }
    __syncthreads();
    {
        const int t = F.tid; unsigned wv[16];
#pragma unroll
        for (int i = 0; i < 16; ++i) wv[i] = (unsigned)vs[(2 * i) * 520 + t] | ((unsigned)vs[(2 * i + 1) * 520 + t] << 16);
        u32x4* dst = (u32x4*)(WSP(bf16, WS_VTMLA) + ((size_t)(b * 4 + (t >> 7)) * 128 + (t & 127)) * TS + j0);
#pragma unroll
        for (int k = 0; k < 4; ++k) dst[k] = (u32x4){wv[4 * k], wv[4 * k + 1], wv[4 * k + 2], wv[4 * k + 3]};
    }
    __syncthreads();
}

template <int DK, bool NA>
DI void attn_unit(Frame& F, const bf16* Qg, const bf16* Kg, const bf16* VTg, int nA, int tA0, int nB, int tB0, float scale, bf16* Og, int qrow0, const float* rpb) {
    constexpr int KP = DK + 8, KCH = DK / 8, NKC = 64 * KCH / NTHR;
    LAS bf16* Ks = (LAS bf16*)F.lds;
    LAS bf16* VTs = (LAS bf16*)(F.lds + 64 * KP * 2);
    LAS bf16* Ps = (LAS bf16*)(F.lds + 64 * KP * 2 + 128 * 72 * 2) + F.wave * (16 * 72);
    LAS float* rp = (LAS float*)(F.lds + 64 * KP * 2 + 128 * 72 * 2 + 8 * 16 * 72 * 2);
    const int lane = F.lane, r = lane & 15, q = lane >> 4, tid = F.tid, w = F.wave;
    if (NA) { for (int i = tid; i < 15 * 31; i += NTHR) rp[i] = rpb[i]; }
    bf16x8 qf[DK / 32];
#pragma unroll
    for (int kk = 0; kk < DK / 32; ++kk) qf[kk] = *(const bf16x8*)(Qg + (size_t)(w * 16 + r) * DK + 32 * kk + 8 * q);
    f32x4 o[8]; float mrow[4], lrow[4];
#pragma unroll
    for (int d = 0; d < 8; ++d) o[d] = (f32x4){0.f, 0.f, 0.f, 0.f};
#pragma unroll
    for (int i = 0; i < 4; ++i) { mrow[i] = -1.0e30f; lrow[i] = 0.f; }
    const int ntile = nA + nB;
    u32x4 kreg[NKC], vreg[2];
    const int rq = qrow0 + (w >> 2);
    const int r0 = rq - 4 < 0 ? 0 : (rq - 4 > 24 ? 24 : rq - 4);
#define ATT_LOAD(kt) do { _Pragma("unroll") for (int c = 0; c < NKC; ++c) { const int id = tid + NTHR * c, rr = id / KCH, cc = id % KCH; kreg[c] = *(const u32x4*)(Kg + (size_t)((kt) * 64 + rr) * DK + cc * 8); } \
        _Pragma("unroll") for (int c = 0; c < 2; ++c) { const int id = tid + NTHR * c, dd = id >> 3, cc = id & 7; vreg[c] = *(const u32x4*)(VTg + (size_t)dd * TS + (kt) * 64 + cc * 8); } } while (0)
    ATT_LOAD(nA > 0 ? tA0 : tB0);
    for (int it = 0; it < ntile; ++it) {
        const int kt = it < nA ? tA0 + it : tB0 + (it - nA);
        __syncthreads();
#pragma unroll
        for (int c = 0; c < NKC; ++c) { const int id = tid + NTHR * c, rr = id / KCH, cc = id % KCH; *(LAS u32x4*)(Ks + rr * KP + cc * 8) = kreg[c]; }
#pragma unroll
        for (int c = 0; c < 2; ++c) { const int id = tid + NTHR * c, dd = id >> 3, cc = id & 7; *(LAS u32x4*)(VTs + dd * 72 + cc * 8) = vreg[c]; }
        __syncthreads();
        if (it + 1 < ntile) { const int kn = (it + 1) < nA ? tA0 + it + 1 : tB0 + (it + 1 - nA); ATT_LOAD(kn); }
        const bool nbt = NA && kt < 32;
        if (nbt && (kt < r0 || kt >= r0 + 8)) continue;
        f32x4 s[4];
#pragma unroll
        for (int n = 0; n < 4; ++n) s[n] = (f32x4){0.f, 0.f, 0.f, 0.f};
#pragma unroll
        for (int kk = 0; kk < DK / 32; ++kk)
#pragma unroll
            for (int n = 0; n < 4; ++n) { const bf16x8 kf = *(const LAS bf16x8*)(Ks + (n * 16 + r) * KP + 32 * kk + 8 * q); s[n] = __builtin_amdgcn_mfma_f32_16x16x32_bf16(qf[kk], kf, s[n], 0, 0, 0); }
        float mx[4];
#pragma unroll
        for (int i = 0; i < 4; ++i) mx[i] = -1.0e30f;
#pragma unroll
        for (int n = 0; n < 4; ++n)
#pragma unroll
            for (int i = 0; i < 4; ++i) {
                float v = s[n][i] * scale;
                if (nbt) { const int c = (w & 3) * 16 + 4 * q + i, kc = n * 16 + r; const int c0 = c - 8 < 0 ? 0 : (c - 8 > 48 ? 48 : c - 8);
                    v = (kc >= c0 && kc < c0 + 16) ? v + rp[(kt - rq + 7) * 31 + (kc - c + 15)] : -1.0e30f; }
                s[n][i] = v; mx[i] = fmaxf(mx[i], v);
            }
        float alpha[4], rs[4];
#pragma unroll
        for (int i = 0; i < 4; ++i) {
            float m = mx[i]; m = fmaxf(m, __shfl_xor(m, 1)); m = fmaxf(m, __shfl_xor(m, 2)); m = fmaxf(m, __shfl_xor(m, 4)); m = fmaxf(m, __shfl_xor(m, 8));
            const float mn = fmaxf(mrow[i], m); alpha[i] = __expf(mrow[i] - mn); mrow[i] = mn; rs[i] = 0.f;
        }
#pragma unroll
        for (int n = 0; n < 4; ++n)
#pragma unroll
            for (int i = 0; i < 4; ++i) { const float pv = __expf(s[n][i] - mrow[i]); rs[i] += pv; Ps[(4 * q + i) * 72 + n * 16 + r] = (bf16)f2bf(pv); }
#pragma unroll
        for (int i = 0; i < 4; ++i) {
            float t = rs[i]; t += __shfl_xor(t, 1); t += __shfl_xor(t, 2); t += __shfl_xor(t, 4); t += __shfl_xor(t, 8);
            lrow[i] = lrow[i] * alpha[i] + t;
        }
#pragma unroll
        for (int d = 0; d < 8; ++d)
#pragma unroll
            for (int i = 0; i < 4; ++i) o[d][i] *= alpha[i];
        asm volatile("s_waitcnt lgkmcnt(0)" ::: "memory");
#pragma unroll
        for (int kk = 0; kk < 2; ++kk) { const bf16x8 pf = *(const LAS bf16x8*)(Ps + r * 72 + 32 * kk + 8 * q);
#pragma unroll
            for (int d = 0; d < 8; ++d) { const bf16x8 vf = *(const LAS bf16x8*)(VTs + (d * 16 + r) * 72 + 32 * kk + 8 * q); o[d] = __builtin_amdgcn_mfma_f32_16x16x32_bf16(pf, vf, o[d], 0, 0, 0); } }
    }
#undef ATT_LOAD
#pragma unroll
    for (int i = 0; i < 4; ++i) { const float inv = 1.0f / lrow[i]; bf16* op = Og + (size_t)(w * 16 + 4 * q + i) * D + r;
#pragma unroll
        for (int d = 0; d < 8; ++d) op[d * 16] = (bf16)f2bf(o[d][i] * inv); }
    __syncthreads();
}
DI void ml_c_unit(Frame& F, int seq, int p) {
    const int b = seq >> 3, h = (seq >> 1) & 3, dir = seq & 1, tc = tc_of(dir, p), lane = F.lane, tid = F.tid;
    const float* P = WSP(float, WS_P);
    constexpr float QS = 0.08838834764831845f;
    LAS bf16* Qs = (LAS bf16*)F.lds;
    LAS bf16* Ksm = (LAS bf16*)(F.lds + 17408);
    LAS bf16* VT = (LAS bf16*)(F.lds + 34816);
    LAS bf16* Cx = (LAS bf16*)(F.lds + 55552);
    LAS bf16* SW = (LAS bf16*)(F.lds + 94720);
    LAS float* av = (LAS float*)(F.lds + 103936);
    LAS float* Mt = av + 64;
    LAS float* Bt = av + 128;
    LAS float* den = av + 192;
    const float m_p = WSP(float, WS_MLSC)[(size_t)(seq * 36 + p) * 4 + 2];
    if (F.wave == 0) {
        const int row = rowof(b, tc * 64 + lane);
        const float* gt = WSP(float, WS_GATES) + (size_t)row * 16;
        const float li = gt[dir * 4 + h], lf = gt[8 + dir * 4 + h];
        const float pre = wave_incl_scan(lf, lane), tot = __shfl(pre, 63);
        const float B = dir == 0 ? pre : (tot - pre) + lf;
        const float a = li - B;
        float cm = a;
#pragma unroll
        for (int o = 1; o < 64; o <<= 1) { const float t = dir == 0 ? __shfl_up(cm, o) : __shfl_down(cm, o); const bool ok = dir == 0 ? (lane >= o) : (lane + o < 64); if (ok) cm = fmaxf(cm, t); }
        av[lane] = a; Mt[lane] = fmaxf(m_p, cm); Bt[lane] = B;
    }
    {
        float qq[16], kk[16], vv[16]; u32x4 cx[5];
        const bf16* Sg = WSP(bf16, WS_MLS) + (size_t)(seq * 36 + p) * 16512;
#pragma unroll
        for (int it = 0; it < 16; ++it) { const int idx = tid + NTHR * it, n = idx >> 7, d = idx & 127;
            const float* pr = P + (size_t)rowof(b, tc * 64 + n) * DINP + h * 128 + d; qq[it] = pr[PC_MLQ]; kk[it] = pr[PC_MLK]; vv[it] = pr[PC_MLV]; }
#pragma unroll
        for (int it = 0; it < 5; ++it) { const int idx = tid + NTHR * it, rr = idx >> 4, cc = idx & 15; cx[it] = (idx < 144 * 16 && rr < 129) ? *(const u32x4*)(Sg + rr * 128 + cc * 8) : (u32x4){0u, 0u, 0u, 0u}; }
#pragma unroll
        for (int it = 0; it < 16; ++it) { const int idx = tid + NTHR * it, n = idx >> 7, d = idx & 127;
            Qs[n * 136 + d] = (bf16)f2bf(qq[it]); Ksm[n * 136 + d] = (bf16)f2bf(kk[it]); VT[d * 72 + n] = (bf16)f2bf(vv[it]); }
#pragma unroll
        for (int it = 0; it < 5; ++it) { const int idx = tid + NTHR * it, rr = idx >> 4, cc = idx & 15; if (idx < 144 * 16) *(LAS u32x4*)(Cx + rr * 136 + cc * 8) = cx[it]; }
    }
    for (int idx = tid; idx < 16 * 64; idx += NTHR) { const int rr = idx >> 6, n = idx & 63; VT[(128 + rr) * 72 + n] = rr == 0 ? (bf16)0x3f80 : (bf16)0; }
    __syncthreads();
    for (int id = F.wave; id < 16; id += 8) { const int tt = id >> 2, st = id & 3;
        const bool skip = dir == 0 ? st > tt : st < tt;
        f32x4 acc = (f32x4){0.f, 0.f, 0.f, 0.f};
        if (!skip) acc = mma16<128>(Qs + tt * 16 * 136, 136, Ksm + st * 16 * 136, 136, lane, acc);
        const int s = st * 16 + (lane & 15); const float as = av[s];
#pragma unroll
        for (int i = 0; i < 4; ++i) { const int t = tt * 16 + 4 * (lane >> 4) + i; const bool ok = !skip && (dir == 0 ? s <= t : s >= t);
            SW[t * 72 + s] = (bf16)f2bf(ok ? acc[i] * QS * __expf(as - Mt[t]) : 0.f); } }
    __syncthreads();
    const int tt = F.wave & 3, d0 = F.wave < 4 ? 0 : 5, nd = F.wave < 4 ? 5 : 4;
    f32x4 val[5];
#pragma unroll
    for (int k = 0; k < 5; ++k) { val[k] = (f32x4){0.f, 0.f, 0.f, 0.f};
        if (k < nd) { const int dt = d0 + k;
            const f32x4 a1 = mma16<64>(SW + tt * 16 * 72, 72, VT + dt * 16 * 72, 72, lane, (f32x4){0.f, 0.f, 0.f, 0.f});
            const f32x4 a2 = mma16<128>(Qs + tt * 16 * 136, 136, Cx + dt * 16 * 136, 136, lane, (f32x4){0.f, 0.f, 0.f, 0.f});
#pragma unroll
            for (int i = 0; i < 4; ++i) { const int t = tt * 16 + 4 * (lane >> 4) + i; val[k][i] = a1[i] + a2[i] * QS * __expf(m_p - Mt[t]); }
            if (dt == 8 && (lane & 15) == 0) {
#pragma unroll
                for (int i = 0; i < 4; ++i) den[tt * 16 + 4 * (lane >> 4) + i] = val[k][i]; } } }
    __syncthreads();
    float* H = WSP(float, WS_HML) + (size_t)dir * MTOK * 512;
#pragma unroll
    for (int k = 0; k < 5; ++k) { const int dt = d0 + k; if (k < nd && dt < 8) {
#pragma unroll
        for (int i = 0; i < 4; ++i) { const int t = tt * 16 + 4 * (lane >> 4) + i;
            const float dn = fmaxf(fabsf(den[t]), __expf(-(Bt[t] + Mt[t])));
            H[(size_t)rowof(b, tc * 64 + t) * 512 + h * 128 + dt * 16 + (lane & 15)] = val[k][i] / dn; } } }
    __syncthreads();
}

DI void ss_c_unit(Frame& F, int l, int sq, int p) {
    const int b = sq >> 4, h = (sq >> 1) & 7, dir = sq & 1, g = h >> 2, tc = tc_of(dir, p), lane = F.lane, tid = F.tid;
    const bf16* XBC = WSP(bf16, WS_XBC);
    LAS bf16* Cm = (LAS bf16*)F.lds;
    LAS bf16* Bm = (LAS bf16*)(F.lds + 17408);
    LAS bf16* XT = (LAS bf16*)(F.lds + 34816);
    LAS bf16* Sx = (LAS bf16*)(F.lds + 44032);
    LAS bf16* W = (LAS bf16*)(F.lds + 61440);
    LAS float* cum = (LAS float*)(F.lds + 70656);
    LAS float* dtv = cum + 64;
    if (F.wave == 0) {
        const int row = rowof(b, tc * 64 + lane);
        const float dt = WSP(float, WS_DT)[(size_t)row * 16 + dir * 8 + h];
        const float A = -__expf(F.in[15][l * 16 + dir * 8 + h]);
        const float a = dt * A, pre = wave_incl_scan(a, lane), tot = __shfl(pre, 63);
        cum[lane] = dir == 0 ? pre : (tot - pre) + a; dtv[lane] = dt;
    }
    {
        u32x4 bb[2], cc_[2], sx[2]; bf16 xx[8];
        const bf16* Sg = WSP(bf16, WS_SSS) + (size_t)(sq * 36 + p) * 8192;
#pragma unroll
        for (int it = 0; it < 2; ++it) { const int idx = tid + NTHR * it, n = idx >> 4, cc = idx & 15; const bf16* xr = XBC + (size_t)rowof(b, tc * 64 + n) * 1024;
            bb[it] = *(const u32x4*)(xr + 512 + g * 128 + cc * 8); cc_[it] = *(const u32x4*)(xr + 768 + g * 128 + cc * 8); sx[it] = *(const u32x4*)(Sg + n * 128 + cc * 8); }
#pragma unroll
        for (int it = 0; it < 8; ++it) { const int idx = tid + NTHR * it, n = idx >> 6, pp = idx & 63; xx[it] = XBC[(size_t)rowof(b, tc * 64 + n) * 1024 + h * 64 + pp]; }
#pragma unroll
        for (int it = 0; it < 2; ++it) { const int idx = tid + NTHR * it, n = idx >> 4, cc = idx & 15;
            *(LAS u32x4*)(Bm + n * 136 + cc * 8) = bb[it]; *(LAS u32x4*)(Cm + n * 136 + cc * 8) = cc_[it]; *(LAS u32x4*)(Sx + n * 136 + cc * 8) = sx[it]; }
#pragma unroll
        for (int it = 0; it < 8; ++it) { const int idx = tid + NTHR * it, n = idx >> 6, pp = idx & 63; XT[pp * 72 + n] = xx[it]; }
    }
    __syncthreads();
    for (int id = F.wave; id < 16; id += 8) { const int tt = id >> 2, st = id & 3;
        const bool skip = dir == 0 ? st > tt : st < tt;
        f32x4 acc = (f32x4){0.f, 0.f, 0.f, 0.f};
        if (!skip) acc = mma16<128>(Cm + tt * 16 * 136, 136, Bm + st * 16 * 136, 136, lane, acc);
        const int s = st * 16 + (lane & 15); const float cs = cum[s], ds = dtv[s];
#pragma unroll
        for (int i = 0; i < 4; ++i) { const int t = tt * 16 + 4 * (lane >> 4) + i; const bool ok = !skip && (dir == 0 ? s <= t : s >= t);
            W[t * 72 + s] = (bf16)f2bf(ok ? acc[i] * __expf(cum[t] - cs) * ds : 0.f); } }
    __syncthreads();
    float* Y = WSP(float, WS_YSS) + (size_t)dir * MTOK * 512;
    for (int id = F.wave; id < 16; id += 8) { const int tt = id >> 2, pt = id & 3;
        const f32x4 a1 = mma16<64>(W + tt * 16 * 72, 72, XT + pt * 16 * 72, 72, lane, (f32x4){0.f, 0.f, 0.f, 0.f});
        const f32x4 a2 = mma16<128>(Cm + tt * 16 * 136, 136, Sx + pt * 16 * 136, 136, lane, (f32x4){0.f, 0.f, 0.f, 0.f});
#pragma unroll
        for (int i = 0; i < 4; ++i) { const int t = tt * 16 + 4 * (lane >> 4) + i;
            Y[(size_t)rowof(b, tc * 64 + t) * 512 + h * 64 + pt * 16 + (lane & 15)] = a1[i] + a2[i] * __expf(cum[t]); } }
    __syncthreads();
}

DI void m5_finish_phase(Frame& F, int l, int nrows) {
    const int gw = F.bid * NWAVES + F.wave, NGW = F.G * NWAVES, lane = F.lane;
    const float* P = WSP(float, WS_P); const float* H0 = WSP(float, WS_HML); const float* H1 = H0 + (size_t)MTOK * 512;
    const float* Y0 = WSP(float, WS_YSS); const float* Y1 = Y0 + (size_t)MTOK * 512; const bf16* XBC = WSP(bf16, WS_XBC);
    bf16* A2 = WSP(bf16, WS_A2);
    for (int row = gw; row < nrows; row += NGW) {
        const float* p = P + (size_t)row * DINP;
        float hv[8], ov[8], yv[8], zv[8]; bf16 xv[8];
#pragma unroll
        for (int u = 0; u < 8; ++u) { const int c = lane + 64 * u;
            hv[u] = H0[(size_t)row * 512 + c] + H1[(size_t)row * 512 + c]; ov[u] = p[PC_MLO + c];
            yv[u] = Y0[(size_t)row * 512 + c] + Y1[(size_t)row * 512 + c]; zv[u] = p[PC_Z + c]; xv[u] = XBC[(size_t)row * 1024 + c]; }
        const float* gn = F.in[11] + l * 512; const float* sn = F.in[17] + l * 512;
#pragma unroll
        for (int h = 0; h < 4; ++h) {
            const float v0 = hv[2 * h], v1 = hv[2 * h + 1]; const int c0 = h * 128 + lane, c1 = c0 + 64;
            const float rstd = 1.0f / sqrtf(wave_sum(v0 * v0 + v1 * v1) * (1.f / 128.f) + EPS);
            A2[(size_t)row * D + c0] = (bf16)f2bf(v0 * rstd * gn[c0] * sigmoidf_(ov[2 * h]));
            A2[(size_t)row * D + c1] = (bf16)f2bf(v1 * rstd * gn[c1] * sigmoidf_(ov[2 * h + 1]));
        }
        float y[8]; float ss = 0.f;
#pragma unroll
        for (int u = 0; u < 8; ++u) { float v = yv[u] + F.in[16][l * 8 + u] * bf2f(xv[u]); v *= siluf(zv[u]); y[u] = v; ss += v * v; }
        const float rstd = 1.0f / sqrtf(wave_sum(ss) * (1.f / 512.f) + EPS);
#pragma unroll
        for (int u = 0; u < 8; ++u) { const int c = lane + 64 * u; A2[(size_t)row * D + 512 + c] = (bf16)f2bf(y[u] * rstd * sn[c]); }
    }
}
#ifndef PROBE_MASK
#define PROBE_MASK 0ull
#endif
#define NREP(k) ((((unsigned long long)(PROBE_MASK) >> (k)) & 1ull) ? 2 : 1)
#ifndef UNIT_REP
#define UNIT_REP 0
#endif
#define UREP(i) for (int rp_ = 0; rp_ <= ((F.rep >> (i)) & 1); ++rp_)
#ifndef ONE_LAUNCH
#define ONE_LAUNCH 1
#endif
#define IN(k) (lo <= (k) && (k) < hi)
#define SEAM(k) do { if (ONE_LAUNCH && hi > (k) + 1) xcd_barrier(bar); } while (0)
#ifndef FILL_MASK
#define FILL_MASK 0x7fffffffull
#endif
#define FILL(k, work) do { if (ONE_LAUNCH) conv_fill(F, (k), (work)); } while (0)
#ifndef NCV_P
#define NCV_P 48
#define NCV_OUT 112
#define NCV_UP 24
#define NCV_DOWN 112
#endif
template <int l> DI void layer_phases(Frame& F, const XcdBarrier& bar, const int lo, const int hi) {
    LAS int* mtb = (LAS int*)(F.lds + RING_BYTES);
        const int pb = 1 + 16 * l;
        const bool wc = (l == 0);
        const int nrows = wc ? MTOK : MLAT;
        const float* modl = WSP(float, WS_MOD) + (size_t)l * 5 * D6;
        if (IN(pb + 0)) {
            if (l == 0) norm_phase<false>(F, l, F.in[0], F.in[2], F.in[6] + l * D, 0, MTOK);
            else norm_phase<false>(F, l, WSP(float, WS_X), WSP(float, WS_X) + (size_t)MLAT * D, F.in[6] + l * D, 0, MTOK);
            if (l == 1) conv_drain(F, CV_NQ1 - CV_NE); SEAM(pb + 0);
        }
        if (IN(pb + 1)) {
            const int ncv = ONE_LAUNCH ? NCV_P : 0, gw_ = F.G - ncv;
            if (F.bid < gw_) { pg8::Gemm g{WSP(bf16, WS_HN), WSP(bf16, WS_WIN) + (size_t)l * DINP * D, D, D}; pg8::StaticOrder S; S.init(MTOK / 256, DINP / 256, gw_, F.bid);
                EpiF32 E{WSP(float, WS_P), DINP};
                pg8::gemm_phase<EpiF32, pg8::StaticOrder>(F.lds, g, S, E); }
            FILL(pb + 1, F.bid >= gw_);
            SEAM(pb + 1);
        }
        if (IN(pb + 2)) {
            for (int u = F.bid; u < NB * 72; u += F.G) m1_prep_unit(F, l, u / 72, u % 72);
            SEAM(pb + 2);
        }
        if (IN(pb + 3)) {
            { pg8::Gemm g{WSP(bf16, WS_CQN), WSP(bf16, WS_WQB) + (size_t)l * 768 * 512, 512, 512}; pg8::StaticOrder S; S.init(MTOK / 256, 3, F.G, F.bid);
              EpiBf16 E{WSP(bf16, WS_QRAW), 768}; pg8::gemm_phase<EpiBf16, pg8::StaticOrder>(F.lds, g, S, E); }
            __syncthreads();
            { pg8::Gemm g{WSP(bf16, WS_CKVN), WSP(bf16, WS_WKVB) + (size_t)l * 1024 * 256, 256, 256}; pg8::StaticOrder S; S.init(MTOK / 256, 4, F.G, (F.bid + 128) % F.G);
              EpiBf16 E{WSP(bf16, WS_KVRAW), 1024}; pg8::gemm_phase<EpiBf16, pg8::StaticOrder>(F.lds, g, S, E); }
            __syncthreads();
            UREP(2) for (int u = F.bid; u < 1152; u += F.G) ml_a_unit(F, u / 36, u % 36);
            UREP(3) for (int v = (F.bid + 128) % F.G; v < 576; v += F.G) ss_a_unit(F, l, v / 144, (v / 72) & 1, (v % 72) >> 1, v & 1);
            SEAM(pb + 3);
        }
        if (IN(pb + 4)) {
            UREP(4) for (int u = F.bid; u < 256; u += F.G) {
                const int bh = u >> 4, qb = u & 15, b = bh >> 2, h = bh & 3;
                const int r0a = 2 * qb - 4 < 0 ? 0 : (2 * qb - 4 > 24 ? 24 : 2 * qb - 4), r0b = 2 * qb - 3 < 0 ? 0 : (2 * qb - 3 > 24 ? 24 : 2 * qb - 3);
                attn_unit<128, true>(F, WSP(bf16, WS_QNA) + ((size_t)bh * TS + qb * 128) * 128, WSP(bf16, WS_KNA) + (size_t)bh * TS * 128, WSP(bf16, WS_VTNA) + (size_t)bh * 128 * TS,
                                     4, 32, r0b + 8 - r0a, r0a, 0.08838834764831845f,
                                     WSP(bf16, WS_A2) + (size_t)(b * TL + qb * 128) * D + 1536 + h * 128, 2 * qb, F.in[26] + (size_t)(l * 4 + h) * 15 * 31);
            }
            if (wc) UREP(5) for (int v = F.bid; v < 32; v += F.G) {
                const int bh2 = v >> 1, qc = v & 1, b2 = bh2 >> 2, h2 = bh2 & 3;
                attn_unit<128, false>(F, WSP(bf16, WS_QNA) + ((size_t)bh2 * TS + TL + qc * 128) * 128, WSP(bf16, WS_KNA) + (size_t)bh2 * TS * 128, WSP(bf16, WS_VTNA) + (size_t)bh2 * 128 * TS,
                                      4, 32, 0, 0, 0.08838834764831845f, WSP(bf16, WS_A2) + (size_t)(MLAT + b2 * TC + qc * 128) * D + 1536 + h2 * 128, 0, nullptr);
            }
            UREP(6) for (int v = (F.bid + 32) % F.G; v < 128; v += F.G) ml_scan_unit(F, v >> 2, v & 3);
            UREP(7) for (int v = (F.bid + 96) % F.G; v < 128; v += F.G) ss_scan_unit(F, v >> 1, v & 1);
            UREP(8) for (int v = F.bid; v < 288; v += F.G) mla_post_unit(F, l, v / 72, v % 72);
            SEAM(pb + 4);
        }
        if (IN(pb + 5)) {
            const int p0 = wc ? 0 : 4, npp = 36 - p0;
            UREP(9) for (int u = F.bid; u < 256; u += F.G) { const int bh = u >> 4, qb = u & 15, b = bh >> 2, h = bh & 3;
                attn_unit<192, false>(F, WSP(bf16, WS_QMLA) + ((size_t)bh * TS + qb * 128) * 192, WSP(bf16, WS_KMLA) + (size_t)bh * TS * 192, WSP(bf16, WS_VTMLA) + (size_t)bh * 128 * TS,
                                      36, 0, 0, 0, 0.07216878364870322f, WSP(bf16, WS_A2) + (size_t)(b * TL + qb * 128) * D + 1024 + h * 128, 0, nullptr); }
            if (wc) UREP(10) for (int v = F.bid; v < 32; v += F.G) { const int bh = v >> 1, qc = v & 1, b = bh >> 2, h = bh & 3;
                attn_unit<192, false>(F, WSP(bf16, WS_QMLA) + ((size_t)bh * TS + TL + qc * 128) * 192, WSP(bf16, WS_KMLA) + (size_t)bh * TS * 192, WSP(bf16, WS_VTMLA) + (size_t)bh * 128 * TS,
                                      4, 32, 0, 0, 0.07216878364870322f, WSP(bf16, WS_A2) + (size_t)(MLAT + b * TC + qc * 128) * D + 1024 + h * 128, 0, nullptr); }
            UREP(11) for (int v = (F.bid + 32) % F.G; v < 32 * npp; v += F.G) ml_c_unit(F, v / npp, p0 + v % npp);
            UREP(12) for (int v = (F.bid + 160) % F.G; v < 64 * npp; v += F.G) ss_c_unit(F, l, v / npp, p0 + v % npp);
            SEAM(pb + 5);
        }
        if (IN(pb + 6)) { m5_finish_phase(F, l, nrows); SEAM(pb + 6); }
        if (IN(pb + 7)) {
            const int ncv = (ONE_LAUNCH && l == 0) ? NCV_OUT : 0, gw_ = F.G - ncv;
            if (F.bid < gw_) { pg8::Gemm g{WSP(bf16, WS_A2), WSP(bf16, WS_WOUT) + (size_t)l * D * D, D, D}; pg8::StaticOrder S; S.init(nrows / 256, D / 256, gw_, F.bid);
                EpiResid E{l == 0 ? F.in[0] : WSP(float, WS_X), l == 0 ? F.in[2] : WSP(float, WS_X) + (size_t)MLAT * D, WSP(float, WS_X), modl + 2 * D};
                pg8::gemm_phase<EpiResid, pg8::StaticOrder>(F.lds, g, S, E); }
            FILL(pb + 7, F.bid >= gw_);
            SEAM(pb + 7);
        }
        if (IN(pb + 8)) {
            if (l == 0) norm_phase<false>(F, l, WSP(float, WS_X), WSP(float, WS_X) + (size_t)MLAT * D, F.in[27] + l * D, 3 * D, nrows);
            else norm_phase<true>(F, l, WSP(float, WS_X), WSP(float, WS_X) + (size_t)MLAT * D, F.in[27] + l * D, 3 * D, nrows);
            SEAM(pb + 8);
        }
        if (l == 0) {
            if (IN(pb + 10)) {
                const int ncv = ONE_LAUNCH ? NCV_UP : 0, gw_ = F.G - ncv;
                if (F.bid < gw_) { pg8::Gemm g{WSP(bf16, WS_HN), WSP(bf16, WS_W13), D, D}; pg8::StaticOrder S; S.init(MTOK / 256, 2 * FF / 256, gw_, F.bid);
                    EpiSwiglu E{WSP(bf16, WS_G), FF}; pg8::gemm_phase<EpiSwiglu, pg8::StaticOrder>(F.lds, g, S, E); }
                FILL(pb + 10, F.bid >= gw_);
                SEAM(pb + 10);
            }
            if (IN(pb + 11)) {
                const int ncv = ONE_LAUNCH ? NCV_DOWN : 0, gw_ = F.G - ncv;
                if (F.bid < gw_) { pg8::Gemm g{WSP(bf16, WS_G), WSP(bf16, WS_W2), FF, FF}; pg8::StaticOrder S; S.init(MTOK / 256, D / 256, gw_, F.bid);
                    EpiResid E{WSP(float, WS_X), WSP(float, WS_X) + (size_t)MLAT * D, WSP(float, WS_X), modl + 5 * D};
                    pg8::gemm_phase<EpiResid, pg8::StaticOrder>(F.lds, g, S, E); }
                FILL(pb + 11, F.bid >= gw_);
                SEAM(pb + 11);
            }
        } else {
            if (IN(pb + 9)) { moe_gather_phase(F); conv_drain(F, CV_NDEF); SEAM(pb + 9); }
            if (IN(pb + 10)) {
                __syncthreads(); moe_tables(F, mtb, 2 * FE / 256);
                pg8::Gemm g{WSP(bf16, WS_XG), WSP(bf16, WS_MW13), D, D}; MoeOrder S{mtb, 2 * FE / 256, F.G, F.bid, 0, mtb[40], 1, 0};
                EpiSwiglu E{WSP(bf16, WS_G), FE}; pg8::gemm_phase<EpiSwiglu, MoeOrder>(F.lds, g, S, E);
                SEAM(pb + 10);
            }
            if (IN(pb + 11)) {
                __syncthreads(); moe_tables(F, mtb, D / 256);
                const int nun = mtb[40], nfull0 = (nun / F.G) * F.G, nt0 = nun - nfull0;
                const int SK = nt0 == 0 ? 1 : (nt0 <= 32 ? 8 : (nt0 <= 64 ? 4 : (nt0 <= 128 ? 2 : 1)));
                const int nfull = SK == 1 ? nun : nfull0, ntail = nun - nfull;
                { pg8::Gemm g{WSP(bf16, WS_G), WSP(bf16, WS_MW2), FE, FE}; MoeOrder S{mtb, D / 256, F.G, F.bid, 0, nfull, 1, 0};
                  EpiF32 E{WSP(float, WS_Y), D}; pg8::gemm_phase<EpiF32, MoeOrder>(F.lds, g, S, E); }
                if (ntail > 0) { __syncthreads();
                  pg8::Gemm g{WSP(bf16, WS_G), WSP(bf16, WS_MW2), FE / SK, FE}; MoeOrder S{mtb, D / 256, F.G, F.bid, nfull, ntail * SK, SK, FE / SK};
                  EpiPart E{WSP(float, WS_PART)}; pg8::gemm_phase<EpiPart, MoeOrder>(F.lds, g, S, E); }
                SEAM(pb + 11);
            }
            if (IN(pb + 12)) {
                __syncthreads(); moe_tables(F, mtb, D / 256);
                const int nun = mtb[40], nfull0 = (nun / F.G) * F.G, nt0 = nun - nfull0;
                const int SK = nt0 == 0 ? 1 : (nt0 <= 32 ? 8 : (nt0 <= 64 ? 4 : (nt0 <= 128 ? 2 : 1)));
                const int nfull = SK == 1 ? nun : nfull0, ntail = nun - nfull;
                for (int it = F.bid; it < ntail * 8; it += F.G) { const int t = it >> 3, cg = it & 7;
                    MoeOrder S{mtb, D / 256, 1, 0, nfull + t, 1, 1, 0}; pg8::Unit u; S.next(0, u);
                    if (SK == 8) splitk_reduce_f32<8>(WSP(float, WS_PART), t, cg, u, WSP(float, WS_Y), D);
                    else if (SK == 4) splitk_reduce_f32<4>(WSP(float, WS_PART), t, cg, u, WSP(float, WS_Y), D);
                    else splitk_reduce_f32<2>(WSP(float, WS_PART), t, cg, u, WSP(float, WS_Y), D); }
                SEAM(pb + 12);
            }
            if (IN(pb + 13)) { moe_combine_phase(F, l); }
        }
}
__global__ void __launch_bounds__(NTHR, 2) fwd_kernel(Args args) {
    extern __shared__ __attribute__((aligned(16))) unsigned char lds[];
    Frame F;
    F.lds = (LAS unsigned char*)lds; F.ws = args.ws; F.out = args.out;
#pragma unroll
    for (int i = 0; i < 35; ++i) F.in[i] = args.in[i];
    F.tid = threadIdx.x; F.lane = F.tid & 63; F.wave = __builtin_amdgcn_readfirstlane(F.tid >> 6); F.G = gridDim.x; F.bid = blockIdx.x; F.rep = args.rep;
    volatile LAS unsigned* MISC = (volatile LAS unsigned*)(F.lds + MISC_OFF);
    if (F.tid < 64) MISC[F.tid] = 0u;
    __syncthreads();
    XcdBarrier bar; bar.bar = WSP(unsigned, WS_CTL) + CW_BAR; bar.x = 0; bar.st = nullptr;
    if (ONE_LAUNCH) bar = xcd_barrier_post(WSP(unsigned, WS_CTL) + CW_BAR, MISC + 8);
    const int lo = args.ph_lo, hi = args.ph_hi;

    if (IN(0)) { p0_prologue(F); SEAM(0); }

    layer_phases<0>(F, bar, lo, hi);
    layer_phases<1>(F, bar, lo, hi);
#undef IN
#undef SEAM
}

extern "C" void kernel_launch(void* const* d_in, const int* in_sizes, int n_in, void* d_out, int out_size, void* d_ws, size_t ws_size, hipStream_t stream) {
    static int grid = 0;
    if (grid == 0) {
        if (n_in != 35 || out_size != MLAT * D || ws_size < WS_END) { fprintf(stderr, "kernel_launch: unexpected shapes (n_in %d out %d ws %zu need %zu)\n", n_in, out_size, ws_size, (size_t)WS_END); grid = -1; return; }
        int dev = 0, cus = 0, per_cu = 0;
        if (hipGetDevice(&dev) != hipSuccess || hipDeviceGetAttribute(&cus, hipDeviceAttributeMultiprocessorCount, dev) != hipSuccess) { grid = -1; return; }
        if (hipFuncSetAttribute((const void*)fwd_kernel, hipFuncAttributeMaxDynamicSharedMemorySize, LDS_BYTES) != hipSuccess) { fprintf(stderr, "kernel_launch: hipFuncSetAttribute failed\n"); grid = -1; return; }
        if (hipOccupancyMaxActiveBlocksPerMultiprocessor(&per_cu, (const void*)fwd_kernel, NTHR, LDS_BYTES) != hipSuccess || per_cu < 1) { fprintf(stderr, "kernel_launch: occupancy query says %d\n", per_cu); }
        (void)hipGetLastError();
        grid = cus;
    }
    if (grid < 0) return;
    (void)hipMemsetAsync((char*)d_ws + WS_CTL, 0, CTL_ZERO_BYTES, stream);
    Args a{};
    for (int i = 0; i < 35; ++i) a.in[i] = (const float*)d_in[i];
    a.out = (float*)d_out; a.ws = (unsigned char*)d_ws; a.rep = UNIT_REP;
#if ONE_LAUNCH
    a.ph_lo = 0; a.ph_hi = 64;
    hipLaunchKernelGGL(fwd_kernel, dim3(grid), dim3(NTHR), LDS_BYTES, stream, a);
#else
    static const int phases[] = {0, 1, 2, 3, 4, 5, 6, 7, 8, 9, 11, 12, 17, 18, 19, 20, 21, 22, 23, 24, 25, 26, 27, 28, 29, 30};
    for (int k = 0; k < (int)(sizeof(phases) / sizeof(phases[0])); ++k) {
        a.ph_lo = phases[k]; a.ph_hi = phases[k] + 1;
        for (int rp = 0; rp < NREP(phases[k]); ++rp) hipLaunchKernelGGL(fwd_kernel, dim3(grid), dim3(NTHR), LDS_BYTES, stream, a);
    }
#endif
}
```

```cpp
#define NCV_P 48
#define NCV_OUT 96
#define NCV_UP 24
#define NCV_DOWN 96
#define FILL_MASK 0x7fffffffull
#define PROBE_MASK (0ull)
#define ONE_LAUNCH 1
#define UNIT_REP 0
#include <hip/hip_runtime.h>
#include <cstdio>
#include <cstdint>

#define DI __device__ __forceinline__
#define LAS __attribute__((address_space(3)))
#define GAS __attribute__((address_space(1)))
typedef unsigned short bf16;
typedef short bf16x8 __attribute__((ext_vector_type(8)));
typedef float f32x4 __attribute__((ext_vector_type(4)));
typedef float f32x2 __attribute__((ext_vector_type(2)));
typedef unsigned u32x4 __attribute__((ext_vector_type(4)));
typedef unsigned u32x2 __attribute__((ext_vector_type(2)));

namespace pg8 {
constexpr int BM = 256, BK = 64, HALF = 128, HTB = HALF * BK * 2, STAGE_BYTES = 8 * HTB, NXCD = 8, WGM = 8;
__host__ __device__ __forceinline__ int lds_byte(int r, int c) { const int st = (r >> 4) * 2 + (c >> 5), rr = r & 15, cc = c & 31, ob = rr * 64 + cc * 2; return st * 1024 + (ob ^ (((ob >> 9) & 1) << 5)); }
__host__ __device__ __forceinline__ void stage_rc(int b, int& R, int& C) { const int st = b / 1024, sb = b % 1024, swz = sb ^ (((sb >> 9) & 1) << 5); R = (st >> 1) * 16 + swz / 64; C = (st & 1) * 32 + (swz % 64) / 2; }
__host__ __device__ __forceinline__ int perm32(int rho) { const int n = rho >> 4, i = rho & 15; return 8 * (i >> 2) + 4 * n + (i & 3); }

struct Unit { int pm, pn, pb, koff, aux; };
struct Gemm { const bf16* A; const bf16* Bt; int K, ld; };

DI int xcd_remap(int L, int nwg) { const int q = nwg / NXCD, r = nwg % NXCD, xcd = L % NXCD, off = L / NXCD; return (xcd < r ? xcd * (q + 1) : r * (q + 1) + (xcd - r) * q) + off; }

struct StaticOrder {
    int nM, nN, nwg, G, c;
    DI void init(int nM_, int nN_, int G_, int c_) { nM = nM_; nN = nN_; nwg = nM * nN; G = G_; c = c_; }
    DI bool next(int i, Unit& u) const {
        const long L = (long)i * G + c; if (L >= nwg) return false;
        const int wgid = xcd_remap((int)L, nwg);
        const int nig = WGM * nN, gid = wgid / nig, fm = gid * WGM, gsz = (nM - fm) < WGM ? (nM - fm) : WGM;
        u.pm = fm + ((wgid % nig) % gsz); u.pn = (wgid % nig) / gsz; u.pb = u.pn; u.koff = 0; u.aux = 0; return true;
    }
};

DI unsigned cvt_pk_bf16(float lo, float hi) { unsigned r; asm volatile("v_cvt_pk_bf16_f32 %0, %1, %2" : "=v"(r) : "v"(lo), "v"(hi)); return r; }

template <class Epi, class Sched, bool ALIGN_EPI = true>
DI void gemm_phase(LAS unsigned char* lds, const Gemm g, const Sched& S, const Epi& E) {
    const int tid = threadIdx.x, wid = __builtin_amdgcn_readfirstlane(tid >> 6), lane = tid & 63, wr = wid >> 2, wc = wid & 3, fr = lane & 15, fq = lane >> 4;
    const int K = g.K, nt = K / BK;
    unsigned voffA[2], voffB[2];
#pragma unroll
    for (int i = 0; i < 2; ++i) { int R, C; stage_rc(tid * 16 + i * 8192, R, C); const int Rb = Epi::PERM ? ((R & ~31) + perm32(R & 31)) : R;
        voffA[i] = (unsigned)(R * g.ld + C) * 2u; voffB[i] = (unsigned)(Rb * g.ld + C) * 2u; }
    const size_t kstep = (size_t)(BK * 2);
    const size_t hstep = (size_t)HALF * g.ld * 2;
    const size_t tstep = 2 * hstep;
    const unsigned ldsw = (unsigned)wid * 1024u;
    const int aoff = lds_byte(wr * 64 + fr, fq * 8), boff = lds_byte(wc * 32 + fr, fq * 8);
#define PG8_SA(b, h) (((b) * 2 + (h)) * HTB)
#define PG8_SB(b, h) ((4 + (b) * 2 + (h)) * HTB)
#define PG8_STAGE(bufoff, gbase, voff) do { _Pragma("unroll") for (int _i = 0; _i < 2; ++_i) \
        __builtin_amdgcn_global_load_lds((const unsigned*)((const char*)(gbase) + (voff)[_i]), (LAS unsigned*)(lds + (bufoff) + ldsw + _i * 8192), 16, 0, 0); } while (0)
#define PG8_LDA(dst, b, h) do { _Pragma("unroll") for (int m = 0; m < 4; ++m) _Pragma("unroll") for (int k = 0; k < 2; ++k) dst[m][k] = *(const LAS bf16x8*)(lds + PG8_SA(b, h) + aoff + m * 2048 + k * 1024); } while (0)
#define PG8_LDB(dst, b, h) do { _Pragma("unroll") for (int n = 0; n < 2; ++n) _Pragma("unroll") for (int k = 0; k < 2; ++k) dst[n][k] = *(const LAS bf16x8*)(lds + PG8_SB(b, h) + boff + n * 2048 + k * 1024); } while (0)
#define PG8_MMA(ai, bj, At, Bt) do { __builtin_amdgcn_s_setprio(1); _Pragma("unroll") for (int m = 0; m < 4; ++m) _Pragma("unroll") for (int n = 0; n < 2; ++n) _Pragma("unroll") for (int k = 0; k < 2; ++k) \
        acc[ai][bj][m][n] = __builtin_amdgcn_mfma_f32_16x16x32_bf16(Bt[n][k], At[m][k], acc[ai][bj][m][n], 0, 0, 0); __builtin_amdgcn_s_setprio(0); } while (0)
#define PG8_WAIT_V(n) asm volatile("s_waitcnt vmcnt(" #n ")" ::: "memory")
#define PG8_WAIT_L(n) asm volatile("s_waitcnt lgkmcnt(" #n ")" ::: "memory")
#define PG8_BAR __builtin_amdgcn_s_barrier()
#define PG8_SCHED __builtin_amdgcn_sched_barrier(0)
    Unit cur, nxt; int ui = 0;
    if (!S.next(0, cur)) return;
    f32x4 acc[2][2][4][2];
#pragma unroll
    for (int a = 0; a < 2; ++a)
#pragma unroll
        for (int b = 0; b < 2; ++b)
#pragma unroll
            for (int m = 0; m < 4; ++m)
#pragma unroll
                for (int n = 0; n < 2; ++n) acc[a][b][m][n] = (f32x4){0.f, 0.f, 0.f, 0.f};
    bf16x8 At[4][2], B0[2][2], B1[2][2];
    const char* cA = (const char*)g.A + (size_t)cur.pm * tstep + (size_t)cur.koff * 2; const char* cB = (const char*)g.Bt + (size_t)cur.pb * tstep + (size_t)cur.koff * 2;
    {
        PG8_STAGE(PG8_SB(0, 0), cB, voffB); PG8_STAGE(PG8_SB(0, 1), cB + hstep, voffB); PG8_STAGE(PG8_SA(0, 0), cA, voffA); PG8_STAGE(PG8_SA(0, 1), cA + hstep, voffA);
        if (wr == 1) PG8_BAR;
        PG8_WAIT_V(2); PG8_BAR;
        PG8_STAGE(PG8_SB(1, 0), cB + kstep, voffB); PG8_STAGE(PG8_SA(1, 0), cA + kstep, voffA); PG8_STAGE(PG8_SB(1, 1), cB + hstep + kstep, voffB);
        PG8_WAIT_V(6); PG8_BAR;
    }
    for (;;) {
        const bool has_next = S.next(ui + 1, nxt);
        const char* nA = has_next ? (const char*)g.A + (size_t)nxt.pm * tstep + (size_t)nxt.koff * 2 : cA; const char* nB = has_next ? (const char*)g.Bt + (size_t)nxt.pb * tstep + (size_t)nxt.koff * 2 : cB;
        for (int t = 0; t < nt; t += 2) {
            const bool last = (t == nt - 2);
            const char* a1 = cA + (size_t)(t + 1) * kstep;
            const char* a2 = last ? nA : cA + (size_t)(t + 2) * kstep; const char* b2 = last ? nB : cB + (size_t)(t + 2) * kstep;
            const char* a3 = a2 + kstep; const char* b3 = b2 + kstep;
            PG8_LDB(B0, 0, 0); PG8_LDB(B1, 0, 1); PG8_SCHED; PG8_LDA(At, 0, 0); PG8_STAGE(PG8_SA(1, 1), a1 + hstep, voffA);
            PG8_WAIT_V(8); PG8_WAIT_L(0); PG8_BAR; PG8_MMA(0, 0, At, B0); PG8_MMA(0, 1, At, B1); PG8_BAR; PG8_SCHED;
            PG8_LDA(At, 0, 1); PG8_STAGE(PG8_SB(0, 0), b2, voffB); PG8_STAGE(PG8_SB(0, 1), b2 + hstep, voffB); PG8_STAGE(PG8_SA(0, 0), a2, voffA);
            PG8_WAIT_V(8); PG8_WAIT_L(0); PG8_BAR; PG8_MMA(1, 0, At, B0); PG8_MMA(1, 1, At, B1); PG8_BAR; PG8_SCHED;
            PG8_LDB(B0, 1, 0); PG8_LDB(B1, 1, 1); PG8_SCHED; PG8_LDA(At, 1, 0); PG8_STAGE(PG8_SA(0, 1), a2 + hstep, voffA);
            PG8_WAIT_V(8); PG8_WAIT_L(0); PG8_BAR; PG8_MMA(0, 0, At, B0); PG8_MMA(0, 1, At, B1); PG8_BAR; PG8_SCHED;
            PG8_LDA(At, 1, 1); PG8_STAGE(PG8_SB(1, 0), b3, voffB); PG8_STAGE(PG8_SB(1, 1), b3 + hstep, voffB); PG8_STAGE(PG8_SA(1, 0), a3, voffA);
            PG8_WAIT_V(8); PG8_WAIT_L(0); PG8_BAR; PG8_MMA(1, 0, At, B0); PG8_MMA(1, 1, At, B1); PG8_BAR; PG8_SCHED;
        }
        if constexpr (ALIGN_EPI) { if (wr == 0) PG8_BAR; }
        E(acc, cur, wr, wc, fr, fq);
        if (!has_next) break;
#pragma unroll
        for (int a = 0; a < 2; ++a)
#pragma unroll
            for (int b = 0; b < 2; ++b)
#pragma unroll
                for (int m = 0; m < 4; ++m)
#pragma unroll
                    for (int n = 0; n < 2; ++n) acc[a][b][m][n] = (f32x4){0.f, 0.f, 0.f, 0.f};
        cur = nxt; cA = nA; cB = nB; ++ui;
        if constexpr (ALIGN_EPI) { if (wr == 1) PG8_BAR; }
    }
    PG8_WAIT_V(0);
    if constexpr (!ALIGN_EPI) { if (wr == 0) PG8_BAR; }
    PG8_BAR;
#undef PG8_SA
#undef PG8_SB
#undef PG8_STAGE
#undef PG8_LDA
#undef PG8_LDB
#undef PG8_MMA
#undef PG8_WAIT_V
#undef PG8_WAIT_L
#undef PG8_BAR
#undef PG8_SCHED
}
}
constexpr int D = 2048, NB = 4, TL = 2048, TC = 256, TS = TL + TC  ;
constexpr int MLAT = NB * TL  , MTOK = NB * (TL + TC)  ;
constexpr int DIN = 5824, DINP = 5888, D6 = 6 * D;
constexpr int FF = 5632, FE = 7168, NEXP = 8;
constexpr float EPS = 1e-6f;
constexpr int PC_MLQ = 0, PC_MLK = 512, PC_MLV = 1024, PC_MLO = 1536, PC_IG = 2048, PC_FG = 2056, PC_Z = 2064, PC_XBC = 2576, PC_DT = 3600,
              PC_CQ = 3616, PC_CKV = 4064, PC_KR = 4224, PC_NQ = 4288, PC_NK = 4800, PC_NV = 5312;
constexpr int NCHUNK = 36;
constexpr int MAXMT = 72;

constexpr size_t MiB = 1u << 20;
constexpr size_t WS_CTL = 0, CTL_ZERO_BYTES = 1 * MiB;
constexpr size_t WS_MOD = 1 * MiB;
constexpr size_t WS_WIN = 2 * MiB;
constexpr size_t WS_WOUT = WS_WIN + 46 * MiB;
constexpr size_t WS_WQB = WS_WOUT + 16 * MiB;
constexpr size_t WS_WKVB = WS_WQB + 2 * MiB;
constexpr size_t WS_W13 = WS_WKVB + 1 * MiB;
constexpr size_t WS_W2 = WS_W13 + 44 * MiB;
constexpr size_t WS_MW13 = WS_W2 + 22 * MiB;
constexpr size_t WS_MW2 = WS_MW13 + 448 * MiB;
constexpr size_t WS_HN = WS_MW2 + 224 * MiB;
constexpr size_t WS_A2 = WS_HN + 36 * MiB;
constexpr size_t WS_X = WS_A2 + 36 * MiB;
constexpr size_t WS_BIG = WS_X + 72 * MiB;
constexpr size_t WS_P = WS_BIG;
constexpr size_t WS_CQN = WS_P + 207 * MiB;
constexpr size_t WS_CKVN = WS_CQN + 9 * MiB;
constexpr size_t WS_QRAW = WS_CKVN + 5 * MiB;
constexpr size_t WS_KVRAW = WS_QRAW + 14 * MiB;
constexpr size_t WS_QMLA = WS_KVRAW + 18 * MiB;
constexpr size_t WS_KMLA = WS_QMLA + 14 * MiB;
constexpr size_t WS_VTMLA = WS_KMLA + 14 * MiB;
constexpr size_t WS_QNA = WS_VTMLA + 9 * MiB;
constexpr size_t WS_KNA = WS_QNA + 9 * MiB;
constexpr size_t WS_VTNA = WS_KNA + 9 * MiB;
constexpr size_t WS_XBC = WS_VTNA + 9 * MiB;
constexpr size_t WS_DT = WS_XBC + 18 * MiB;
constexpr size_t WS_GATES = WS_DT + 1 * MiB;
constexpr size_t WS_MLSC = WS_GATES + 1 * MiB;
constexpr size_t WS_SSSC = WS_MLSC + 64 * 1024;
constexpr size_t WS_MLU = WS_MLSC + 1 * MiB;
constexpr size_t WS_MLS = WS_MLU + 73 * MiB;
constexpr size_t WS_SSU = WS_MLS + 37 * MiB;
constexpr size_t WS_SSS = WS_SSU + 72 * MiB;
constexpr size_t WS_HML = WS_SSS + 36 * MiB;
constexpr size_t WS_YSS = WS_HML + 36 * MiB;
constexpr size_t WS_MIXEND = WS_YSS + 36 * MiB;
constexpr size_t WS_G = WS_BIG;
constexpr size_t WS_Y = WS_G + 252 * MiB;
constexpr size_t WS_XG = WS_Y + 144 * MiB;
constexpr size_t WS_TOK = WS_XG + 72 * MiB;
constexpr size_t WS_PART = WS_TOK + 1 * MiB;
constexpr size_t WS_FFNEND = WS_PART + 64 * MiB;
constexpr size_t WS_END = (WS_MIXEND > WS_FFNEND ? WS_MIXEND : WS_FFNEND);
static_assert(WS_END < (size_t)1800 * MiB, "workspace budget");
static_assert((size_t)MTOK * DINP * 4 <= 207 * MiB && (size_t)32 * 36 * 129 * 128 * 4 <= 73 * MiB, "sizes");
constexpr int CW_BAR = 4096;
constexpr int CW_MOE = 16384;
constexpr int CW_QH = 20480;
constexpr int CW_ARR = 32768;

constexpr int RING_BYTES = 131072;
constexpr int MISC_OFF = 147456 - 256;
constexpr int LDS_BYTES = 147456;
constexpr int NWAVES = 8, NTHR = 512;

#define RLX_AGENT __ATOMIC_RELAXED, __HIP_MEMORY_SCOPE_AGENT
#define LDS_WAIT() asm volatile("s_waitcnt lgkmcnt(0)" ::: "memory")
#define VM_WAIT() asm volatile("s_waitcnt vmcnt(0)" ::: "memory")
DI unsigned f2bf(float f) { unsigned u = __builtin_bit_cast(unsigned, f); return (u + 0x7fffu + ((u >> 16) & 1u)) >> 16; }
DI unsigned pk2(float lo, float hi) { return f2bf(lo) | (f2bf(hi) << 16); }
DI float bf2f(unsigned b) { return __builtin_bit_cast(float, b << 16); }
DI float wave_sum(float v) {
#pragma unroll
    for (int o = 1; o < 64; o <<= 1) v += __shfl_xor(v, o);
    return v;
}
DI float wave_max(float v) {
#pragma unroll
    for (int o = 1; o < 64; o <<= 1) v = fmaxf(v, __shfl_xor(v, o));
    return v;
}
DI float wave_incl_scan(float v, int lane) {
#pragma unroll
    for (int o = 1; o < 64; o <<= 1) { const float t = __shfl_up(v, o); if (lane >= o) v += t; }
    return v;
}
DI float siluf(float x) { return x / (1.f + __expf(-x)); }
DI float sigmoidf_(float x) { return 1.f / (1.f + __expf(-x)); }
DI float softplusf_(float x) { return fmaxf(x, 0.f) + log1pf(__expf(-fabsf(x))); }
DI float logsigmoidf_(float x) { return fminf(x, 0.f) - log1pf(__expf(-fabsf(x))); }

#define XB_TMO      128
#define XB_XCNT(j)  (256  + 64 * (j))
#define XB_XSUB(j)  (1280 + 64 * (j))
#define XB_XGEN(j)  (2304 + 64 * (j))
#define XB_TOP      3328
#define XB_TOPGEN   3392
#define XCD_BAR_WORDS 3456
#define XB_SPIN_CAP (1u << 22)
DI unsigned xb_ld(unsigned* p)              { return __hip_atomic_load(p, __ATOMIC_RELAXED, __HIP_MEMORY_SCOPE_AGENT); }
DI unsigned xb_add(unsigned* p, unsigned v) { return __hip_atomic_fetch_add(p, v, __ATOMIC_RELAXED, __HIP_MEMORY_SCOPE_AGENT); }
DI unsigned xb_xcc_id() { return (unsigned)__builtin_amdgcn_s_getreg((3 << 11) | 20) & 0xFu; }
#define XB_SPIN(cond, bar) do { unsigned _sp = 0; while (cond) { __builtin_amdgcn_s_sleep(1); \
    if ((++_sp & 255u) == 0u) { if (xb_ld(&(bar)[XB_TMO])) break; if (_sp > XB_SPIN_CAP) { atomicAdd(&(bar)[XB_TMO], 1u); break; } } } } while (0)
struct XcdBarrier { unsigned* bar; unsigned x; volatile LAS unsigned* st; };
DI XcdBarrier xcd_barrier_post(unsigned* bar, volatile LAS unsigned* st) {
    XcdBarrier b; b.bar = bar; b.x = xb_xcc_id(); b.st = st;
    if (threadIdx.x == 0) (void)xb_add(&bar[XB_XCNT(b.x)], 1u);
    return b;
}
DI void xcd_barrier_complete(unsigned* bar, unsigned x, unsigned& nloc, unsigned& nx) {
    const unsigned G = gridDim.x * gridDim.y * gridDim.z;
    unsigned sum, cnt, mine, sp = 0u;
    for (;;) {
        sum = 0u; cnt = 0u; mine = 0u;
#pragma unroll
        for (unsigned j = 0; j < 16; ++j) { const unsigned c = xb_ld(&bar[XB_XCNT(j)]); sum += c; cnt += (c > 0u) ? 1u : 0u; mine = (j == x) ? c : mine; }
        if (sum == G) break;
        __builtin_amdgcn_s_sleep(1);
        if ((++sp & 255u) == 0u) { if (xb_ld(&bar[XB_TMO])) break; if (sp > XB_SPIN_CAP) { atomicAdd(&bar[XB_TMO], 1u); break; } }
    }
    nloc = mine > 0u ? mine : 1u; nx = cnt > 0u ? cnt : 1u;
}
DI void xcd_barrier(const XcdBarrier& b) {
    asm volatile("s_waitcnt vmcnt(0)" ::: "memory");
    __syncthreads();
    if (threadIdx.x == 0) {
        unsigned* bar = b.bar;
        __builtin_amdgcn_s_waitcnt(0);
        unsigned nloc = b.st[0], nx = b.st[1];
        if (nloc == 0u) { xcd_barrier_complete(bar, b.x, nloc, nx); b.st[0] = nloc; b.st[1] = nx; }
        const unsigned old = xb_add(&bar[XB_XSUB(b.x)], 1u);
        const unsigned gen = old / nloc;
        if (old + 1u == (gen + 1u) * nloc) {
            __builtin_amdgcn_fence(__ATOMIC_RELEASE, "agent");
            asm volatile("s_waitcnt vmcnt(0)" ::: "memory");
            const unsigned og = xb_add(&bar[XB_TOP], 1u);
            const unsigned tg = og / nx;
            if (og + 1u == (tg + 1u) * nx) xb_add(&bar[XB_TOPGEN], 1u);
            else XB_SPIN(xb_ld(&bar[XB_TOPGEN]) == tg, bar);
            __builtin_amdgcn_fence(__ATOMIC_ACQUIRE, "agent");
            xb_add(&bar[XB_XGEN(b.x)], 1u);
            asm volatile("s_waitcnt vmcnt(0)" ::: "memory");
        } else {
            XB_SPIN(xb_ld(&bar[XB_XGEN(b.x)]) == gen, bar);
            __builtin_amdgcn_fence(__ATOMIC_ACQUIRE, "agent");
            asm volatile("s_waitcnt vmcnt(0)" ::: "memory");
        }
    }
    __syncthreads();
}

struct Args { const float* in[35]; float* out; unsigned char* ws; int ph_lo, ph_hi, rep, pad; };
struct Frame {
    LAS unsigned char* lds;
    unsigned char* ws;
    const float* in[35];
    float* out;
    int tid, lane, wave, G, bid, rep;
};
#define WSP(T, off) ((T*)(F.ws + (off)))
DI int rowof(int b, int j) { return j < TL ? b * TL + j : MLAT + b * TC + (j - TL); }

template <int K> DI f32x4 mma16(const LAS bf16* A, int lda, const LAS bf16* Bt, int ldb, int lane, f32x4 acc) {
    const int r = lane & 15, q = lane >> 4;
    const LAS bf16* pa = A + r * lda + 8 * q; const LAS bf16* pb = Bt + r * ldb + 8 * q;
#pragma unroll
    for (int k = 0; k < K; k += 32) {
        const bf16x8 a = *(const LAS bf16x8*)(pa + k); const bf16x8 b = *(const LAS bf16x8*)(pb + k);
        acc = __builtin_amdgcn_mfma_f32_16x16x32_bf16(a, b, acc, 0, 0, 0);
    }
    return acc;
}
struct CvDesc { const float* src; bf16* dst; size_t ld, Kd; int Kv, Nv, k0, n0, dn0; };
DI void tr_load(const CvDesc& d, f32x4 (&v)[16], int lane) {
    const int nn = 4 * (lane & 15), kq = lane >> 4;
#pragma unroll
    for (int i = 0; i < 16; ++i) { const int kk = 4 * i + kq;
        v[i] = (f32x4){0.f, 0.f, 0.f, 0.f};
        if (d.k0 + kk < d.Kv && d.n0 + nn < d.Nv) v[i] = __builtin_nontemporal_load((const f32x4*)(d.src + (size_t)(d.k0 + kk) * d.ld + d.n0 + nn)); }
}
DI void tr_lds(const f32x4 (&v)[16], LAS float* scr, int lane) {
    const int nn = 4 * (lane & 15), kq = lane >> 4;
#pragma unroll
    for (int i = 0; i < 16; ++i) { const int kk = 4 * i + kq; LAS float* s = scr + kk * 65 + nn; s[0] = v[i][0]; s[1] = v[i][1]; s[2] = v[i][2]; s[3] = v[i][3]; }
    LDS_WAIT(); asm volatile("" ::: "memory");
}
DI void tr_out(const CvDesc& d, LAS float* scr, int lane) {
    const int c = lane & 7;
#pragma unroll
    for (int j = 0; j < 8; ++j) { const int n = (lane >> 3) + 8 * j; const LAS float* s = scr + (8 * c) * 65 + n;
        u32x4 o; o.x = pk2(s[0 * 65], s[1 * 65]); o.y = pk2(s[2 * 65], s[3 * 65]); o.z = pk2(s[4 * 65], s[5 * 65]); o.w = pk2(s[6 * 65], s[7 * 65]);
        *(u32x4*)(d.dst + (size_t)(d.dn0 + n) * d.Kd + d.k0 + 8 * c) = o; }
    LDS_WAIT(); asm volatile("" ::: "memory");
}
DI int il_row(int n0, int which) { return (n0 >> 7) * 256 + (n0 & 127) + which * 128; }

constexpr int I_IN = 32 * 92, I_OUT = 32 * 32, I_QB = 8 * 12, I_KVB = 4 * 16, I_F1 = 32 * 88, I_F2 = 88 * 32, I_M1 = 32 * 112, I_M2 = 112 * 32;
constexpr int I_L = I_IN + I_OUT + I_QB + I_KVB;
constexpr int CV_NE = I_L + 2 * I_F1 + I_F2, CV_NQ1 = CV_NE + I_L, CV_NALL = CV_NQ1 + NEXP * (2 * I_M1 + I_M2);
DI CvDesc conv_decode(Frame& F, int it) {
    int r = it;
    if (r >= CV_NQ1) { r -= CV_NQ1;
        if (r < NEXP * 2 * I_M1) { const int e = r / (2 * I_M1); r -= e * 2 * I_M1; const int which = r / I_M1; r -= which * I_M1; const int kb = r / 112, nb = r % 112;
            return CvDesc{(which ? F.in[33] : F.in[32]) + (size_t)e * D * FE, WSP(bf16, WS_MW13) + (size_t)e * 2 * FE * D, (size_t)(FE), (size_t)(D), D, FE, 64 * kb, 64 * nb, il_row(64 * nb, which)}; }
        r -= NEXP * 2 * I_M1;
        { const int e = r / I_M2; r -= e * I_M2; const int kb = r / 32, nb = r % 32;
            return CvDesc{F.in[34] + (size_t)e * FE * D, WSP(bf16, WS_MW2) + (size_t)e * D * FE, (size_t)(D), (size_t)(FE), FE, D, 64 * kb, 64 * nb, 64 * nb}; }
    }
    int l = 0;
    if (r >= CV_NE) { r -= CV_NE; l = 1; }
    else if (r >= I_L) { r -= I_L;
        if (r < 2 * I_F1) { const int which = r / I_F1; r -= which * I_F1; const int kb = r / 88, nb = r % 88;
            return CvDesc{(which ? F.in[29] : F.in[28]), WSP(bf16, WS_W13), (size_t)(FF), (size_t)(D), D, FF, 64 * kb, 64 * nb, il_row(64 * nb, which)}; }
        r -= 2 * I_F1;
        { const int kb = r / 32, nb = r % 32; return CvDesc{F.in[30], WSP(bf16, WS_W2), (size_t)(D), (size_t)(FF), FF, D, 64 * kb, 64 * nb, 64 * nb}; }
    }
    if (r < I_IN) { const int kb = r / 92, nb = r % 92;
        return CvDesc{F.in[7] + (size_t)l * D * DIN, WSP(bf16, WS_WIN) + (size_t)l * DINP * D, (size_t)(DIN), (size_t)(D), D, DIN, 64 * kb, 64 * nb, 64 * nb}; }
    r -= I_IN;
    if (r < I_OUT) { const int kb = r / 32, nb = r % 32;
        return CvDesc{F.in[8] + (size_t)l * D * D, WSP(bf16, WS_WOUT) + (size_t)l * D * D, (size_t)(D), (size_t)(D), D, D, 64 * kb, 64 * nb, 64 * nb}; }
    r -= I_OUT;
    if (r < I_QB) { const int kb = r / 12, nb = r % 12;
        return CvDesc{F.in[19] + (size_t)l * 448 * 768, WSP(bf16, WS_WQB) + (size_t)l * 768 * 512, (size_t)(768), (size_t)(512), 448, 768, 64 * kb, 64 * nb, 64 * nb}; }
    r -= I_QB;
    { const int kb = r / 16, nb = r % 16;
        return CvDesc{F.in[21] + (size_t)l * 160 * 1024, WSP(bf16, WS_WKVB) + (size_t)l * 1024 * 256, (size_t)(1024), (size_t)(256), 160, 1024, 64 * kb, 64 * nb, 64 * nb}; }
}

DI void conv_item(Frame& F, int it, LAS float* scr) { const CvDesc d = conv_decode(F, it); f32x4 v[16]; tr_load(d, v, F.lane); tr_lds(v, scr, F.lane); tr_out(d, scr, F.lane); }
DI void conv_items(Frame& F, int it0, int n, LAS float* scr) {
    if (it0 >= CV_NALL) return;
    if (it0 + n > CV_NALL) n = CV_NALL - it0;
    CvDesc d = conv_decode(F, it0); f32x4 v[16]; tr_load(d, v, F.lane);
    for (int k = 0; k < n; ++k) {
        tr_lds(v, scr, F.lane);
        CvDesc dn = d;
        if (k + 1 < n) { dn = conv_decode(F, it0 + k + 1); tr_load(dn, v, F.lane); }
        tr_out(d, scr, F.lane);
        d = dn;
    }
}
DI void p0_prologue(Frame& F) {
    {
        LAS float* sc = (LAS float*)F.lds;
        LAS float* red = (LAS float*)(F.lds + 5 * 2048 * 4);
        bool have = false;
        for (int u = F.bid; u < 2 * 96; u += F.G) {
            if (!have) {
                for (int i = F.tid; i < 5 * 2048; i += NTHR) { const float x = (i < 4 * 2048) ? F.in[1][i] : F.in[3][i - 4 * 2048]; sc[i] = siluf(x); }
                have = true;
            }
            __syncthreads();
            const int l = u / 96, j0 = (u % 96) * 128;
            const float* W = F.in[4] + (size_t)l * D * D6 + j0 + 2 * F.lane;
            f32x2 acc[5];
#pragma unroll
            for (int r = 0; r < 5; ++r) acc[r] = (f32x2){0.f, 0.f};
            const int kb = F.wave * 256;
            for (int k = 0; k < 256; k += 8) {
                f32x2 w[8];
#pragma unroll
                for (int i = 0; i < 8; ++i) w[i] = *(const f32x2*)(W + (size_t)(kb + k + i) * D6);
#pragma unroll
                for (int i = 0; i < 8; ++i)
#pragma unroll
                    for (int r = 0; r < 5; ++r) { const float s = sc[r * 2048 + kb + k + i]; acc[r] += w[i] * s; }
            }
#pragma unroll
            for (int r = 0; r < 5; ++r) { red[(F.wave * 5 + r) * 128 + 2 * F.lane] = acc[r][0]; red[(F.wave * 5 + r) * 128 + 2 * F.lane + 1] = acc[r][1]; }
            __syncthreads();
            for (int i = F.tid; i < 5 * 128; i += NTHR) { const int r = i / 128, j = i % 128; float s = F.in[5][l * D6 + j0 + j];
#pragma unroll
                for (int w = 0; w < 8; ++w) s += red[(w * 5 + r) * 128 + j];
                WSP(float, WS_MOD)[(l * 5 + r) * D6 + j0 + j] = s; }
        }
        __syncthreads();
    }
    LAS float* scr = (LAS float*)(F.lds + F.wave * 16640);
    const int gw = F.bid * NWAVES + F.wave, NGW = F.G * NWAVES;
    for (int it = gw; it < CV_NE; it += NGW) conv_item(F, it, scr);
}

constexpr int CV_NDEF = CV_NALL - CV_NE;
DI void conv_fill(Frame& F, int phase, bool work) {
    LAS float* scr = (LAS float*)(F.lds + F.wave * 16640);
    volatile LAS int* bc = (volatile LAS int*)(F.lds + MISC_OFF) + 16;
    unsigned* ctl = WSP(unsigned, WS_CTL);
    __syncthreads();
    if (F.tid == 0) __hip_atomic_fetch_add(ctl + CW_ARR + 64 * phase, 1u, RLX_AGENT);
    if (!work) return;
    for (;;) {
        if (F.tid == 0) {
            int base = -1;
            if (__hip_atomic_load(ctl + CW_ARR + 64 * phase, RLX_AGENT) < (unsigned)F.G) { base = (int)__hip_atomic_fetch_add(ctl + CW_QH, 32u, RLX_AGENT); if (base >= CV_NDEF) base = -1; }
            bc[0] = base;
        }
        __syncthreads();
        const int base = bc[0];
        __syncthreads();
        if (base < 0) break;
        conv_items(F, CV_NE + base + F.wave * 4, 4, scr);
    }
}
DI void conv_drain(Frame& F, int upto) {
    LAS float* scr = (LAS float*)(F.lds + F.wave * 16640);
    volatile LAS int* bc = (volatile LAS int*)(F.lds + MISC_OFF) + 16;
    unsigned* ctl = WSP(unsigned, WS_CTL);
    __syncthreads();
    for (;;) {
        if (F.tid == 0) {
            int base = -1;
            if ((int)__hip_atomic_load(ctl + CW_QH, RLX_AGENT) < upto) { base = (int)__hip_atomic_fetch_add(ctl + CW_QH, 64u, RLX_AGENT); if (base >= CV_NDEF) base = -1; }
            bc[0] = base;
        }
        __syncthreads();
        const int base = bc[0];
        __syncthreads();
        if (base < 0) break;
        conv_items(F, CV_NE + base + F.wave * 8, 8, scr);
    }
}
template <bool ROUTE>
DI void norm_phase(Frame& F, int l, const float* srcLat, const float* srcCtx, const float* g, int shoff, int nrows) {
    LAS float* rl = (LAS float*)F.lds;
    if (ROUTE) { for (int i = F.tid; i < D * NEXP; i += NTHR) rl[i] = F.in[31][i]; __syncthreads(); }
    const int gw = F.bid * NWAVES + F.wave, NGW = F.G * NWAVES;
    bf16* HN = WSP(bf16, WS_HN);
    for (int row = gw; row < nrows; row += NGW) {
        const float* xr = row < MLAT ? srcLat + (size_t)row * D : srcCtx + (size_t)(row - MLAT) * D;
        const int br = row < MLAT ? row / TL : 4;
        const float* mrow = WSP(float, WS_MOD) + (size_t)(l * 5 + br) * D6 + shoff;
        f32x4 v[8]; float ss = 0.f;
#pragma unroll
        for (int j = 0; j < 8; ++j) { v[j] = *(const f32x4*)(xr + 4 * F.lane + 256 * j); ss += (v[j][0] * v[j][0] + v[j][1] * v[j][1]) + (v[j][2] * v[j][2] + v[j][3] * v[j][3]); }
        const float rstd = 1.0f / sqrtf(wave_sum(ss) * (1.f / D) + EPS);
        float lg[8];
        if (ROUTE) {
#pragma unroll
            for (int e = 0; e < 8; ++e) lg[e] = 0.f; }
#pragma unroll
        for (int j = 0; j < 8; ++j) { const int c = 4 * F.lane + 256 * j;
            const f32x4 gg = *(const f32x4*)(g + c), sh = *(const f32x4*)(mrow + c), sc = *(const f32x4*)(mrow + D + c);
            f32x4 o;
#pragma unroll
            for (int i = 0; i < 4; ++i) o[i] = v[j][i] * rstd * gg[i] * (1.f + sc[i]) + sh[i];
            u32x2 w; w.x = pk2(o[0], o[1]); w.y = pk2(o[2], o[3]);
            *(u32x2*)(HN + (size_t)row * D + c) = w;
            if (ROUTE) {
#pragma unroll
                for (int i = 0; i < 4; ++i) { const f32x4 r0 = *(const LAS f32x4*)(rl + (c + i) * 8), r1 = *(const LAS f32x4*)(rl + (c + i) * 8 + 4);
                    lg[0] += o[i] * r0[0]; lg[1] += o[i] * r0[1]; lg[2] += o[i] * r0[2]; lg[3] += o[i] * r0[3];
                    lg[4] += o[i] * r1[0]; lg[5] += o[i] * r1[1]; lg[6] += o[i] * r1[2]; lg[7] += o[i] * r1[3]; }
                __builtin_amdgcn_sched_barrier(0);
            }
        }
        if (ROUTE) {
#pragma unroll
            for (int e = 0; e < 8; ++e) lg[e] = wave_sum(lg[e]);
            if (F.lane == 0) {
                int e1 = 0; float v1 = lg[0];
#pragma unroll
                for (int e = 1; e < 8; ++e) if (lg[e] > v1) { v1 = lg[e]; e1 = e; }
                int e2 = -1; float v2 = -3.0e38f;
#pragma unroll
                for (int e = 0; e < 8; ++e) if (e != e1 && lg[e] > v2) { v2 = lg[e]; e2 = e; }
                const float g2 = 1.f / (1.f + expf(v1 - v2)), g1 = 1.f - g2;
                unsigned* cnt = WSP(unsigned, WS_CTL) + CW_MOE;
                const unsigned p1 = __hip_atomic_fetch_add(cnt + e1, 1u, RLX_AGENT), p2 = __hip_atomic_fetch_add(cnt + e2, 1u, RLX_AGENT);
                int* tk = WSP(int, WS_TOK) + (size_t)row * 8;
                tk[0] = e1; tk[1] = (int)p1; tk[2] = e2; tk[3] = (int)p2; ((float*)tk)[4] = g1; ((float*)tk)[5] = g2;
            }
        }
    }
}

DI void moe_tables(Frame& F, LAS int* tb, int NT) {
    if (F.tid == 0) {
        const unsigned* cnt = WSP(unsigned, WS_CTL) + CW_MOE; int ts = 0, us = 0;
        for (int e = 0; e < 8; ++e) { const int c = (int)__hip_atomic_load(cnt + e, RLX_AGENT); const int t = (c + 255) >> 8; tb[e] = c; tb[8 + e] = t; tb[16 + e] = ts; tb[32 + e] = us; ts += t; us += t * NT; }
        tb[24] = ts; tb[40] = us;
    }
    __syncthreads();
}
DI void moe_gather_phase(Frame& F) {
    LAS int* tb = (LAS int*)F.lds; moe_tables(F, tb, 1);
    const int gw = F.bid * NWAVES + F.wave, NGW = F.G * NWAVES;
    const bf16* HN = WSP(bf16, WS_HN); bf16* XG = WSP(bf16, WS_XG);
    for (int row = gw; row < MLAT; row += NGW) {
        int* tk = WSP(int, WS_TOK) + (size_t)row * 8;
        const int e1 = tk[0], p1 = tk[1], e2 = tk[2], p2 = tk[3];
        const int s1 = tb[16 + e1] * 256 + p1, s2 = tb[16 + e2] * 256 + p2;
        const u32x4* src = (const u32x4*)(HN + (size_t)row * D) + F.lane;
        u32x4 a[4];
#pragma unroll
        for (int j = 0; j < 4; ++j) a[j] = src[64 * j];
        u32x4* d1 = (u32x4*)(XG + (size_t)s1 * D) + F.lane; u32x4* d2 = (u32x4*)(XG + (size_t)s2 * D) + F.lane;
#pragma unroll
        for (int j = 0; j < 4; ++j) { d1[64 * j] = a[j]; d2[64 * j] = a[j]; }
        if (F.lane == 0) { tk[6] = s1; tk[7] = s2; }
    }
    const int nrow = tb[24] * 256;
    for (int r = gw; r < nrow; r += NGW) {
        const int t = r >> 8; int e = 0;
#pragma unroll
        for (int k = 1; k < 8; ++k) if (t >= tb[16 + k]) e = k;
        const int local = r - tb[16 + e] * 256;
        if (local >= tb[e]) { u32x4* d = (u32x4*)(XG + (size_t)r * D) + F.lane; const u32x4 z = (u32x4){0u, 0u, 0u, 0u};
#pragma unroll
            for (int j = 0; j < 4; ++j) d[64 * j] = z; }
    }
}
DI void moe_combine_phase(Frame& F, int l) {
    const int gw = F.bid * NWAVES + F.wave, NGW = F.G * NWAVES;
    const float* Y = WSP(float, WS_Y); const float* X = WSP(float, WS_X);
    for (int row = gw; row < MLAT; row += NGW) {
        const int* tk = WSP(int, WS_TOK) + (size_t)row * 8;
        const float g1 = ((const float*)tk)[4], g2 = ((const float*)tk)[5]; const int s1 = tk[6], s2 = tk[7];
        const float* mrow = WSP(float, WS_MOD) + (size_t)(l * 5 + row / TL) * D6 + 5 * D;
        f32x4 xv[8], y1[8], y2[8];
#pragma unroll
        for (int j = 0; j < 8; ++j) { const int c = 4 * F.lane + 256 * j;
            xv[j] = *(const f32x4*)(X + (size_t)row * D + c); y1[j] = *(const f32x4*)(Y + (size_t)s1 * D + c); y2[j] = *(const f32x4*)(Y + (size_t)s2 * D + c); }
#pragma unroll
        for (int j = 0; j < 8; ++j) { const int c = 4 * F.lane + 256 * j; const f32x4 gg = *(const f32x4*)(mrow + c);
            *(f32x4*)(F.out + (size_t)row * D + c) = xv[j] + gg * (y1[j] * g1 + y2[j] * g2); }
    }
}
using pg8::Unit;
struct EpiF32 {
    static constexpr bool PERM = false;
    float* C; int ldc;
    DI void operator()(const f32x4 (&acc)[2][2][4][2], const Unit& u, int wr, int wc, int fr, int fq) const {
        const int row0 = u.pm * 256 + wr * 64 + fr, col0 = u.pn * 256 + wc * 32 + 4 * fq;
#pragma unroll
        for (int ai = 0; ai < 2; ++ai)
#pragma unroll
            for (int m = 0; m < 4; ++m) { float* rowp = C + (size_t)(row0 + ai * 128 + m * 16) * ldc + col0;
#pragma unroll
                for (int bj = 0; bj < 2; ++bj)
#pragma unroll
                    for (int n = 0; n < 2; ++n) *(f32x4*)(rowp + bj * 128 + n * 16) = acc[ai][bj][m][n]; }
    }
};
struct EpiBf16 {
    static constexpr bool PERM = true;
    bf16* O; int ldc;
    DI void operator()(const f32x4 (&acc)[2][2][4][2], const Unit& u, int wr, int wc, int fr, int fq) const {
        const int row0 = u.pm * 256 + wr * 64 + fr, col0 = u.pn * 256 + wc * 32 + 8 * fq;
#pragma unroll
        for (int ai = 0; ai < 2; ++ai)
#pragma unroll
            for (int m = 0; m < 4; ++m) { bf16* rowp = O + (size_t)(row0 + ai * 128 + m * 16) * ldc + col0;
#pragma unroll
                for (int bj = 0; bj < 2; ++bj) { const f32x4 v0 = acc[ai][bj][m][0], v1 = acc[ai][bj][m][1];
                    u32x4 w; w.x = pg8::cvt_pk_bf16(v0[0], v0[1]); w.y = pg8::cvt_pk_bf16(v0[2], v0[3]); w.z = pg8::cvt_pk_bf16(v1[0], v1[1]); w.w = pg8::cvt_pk_bf16(v1[2], v1[3]);
                    *(u32x4*)(rowp + bj * 128) = w; } }
    }
};
struct EpiSwiglu {
    static constexpr bool PERM = true;
    bf16* O; int ldc;
    DI void operator()(const f32x4 (&acc)[2][2][4][2], const Unit& u, int wr, int wc, int fr, int fq) const {
        const int row0 = u.pm * 256 + wr * 64 + fr, col0 = u.pn * 128 + wc * 32 + 8 * fq;
#pragma unroll
        for (int ai = 0; ai < 2; ++ai)
#pragma unroll
            for (int m = 0; m < 4; ++m) { bf16* rowp = O + (size_t)(row0 + ai * 128 + m * 16) * ldc + col0;
                f32x4 v0, v1;
#pragma unroll
                for (int j = 0; j < 4; ++j) { v0[j] = siluf(acc[ai][0][m][0][j]) * acc[ai][1][m][0][j]; v1[j] = siluf(acc[ai][0][m][1][j]) * acc[ai][1][m][1][j]; }
                u32x4 w; w.x = pg8::cvt_pk_bf16(v0[0], v0[1]); w.y = pg8::cvt_pk_bf16(v0[2], v0[3]); w.z = pg8::cvt_pk_bf16(v1[0], v1[1]); w.w = pg8::cvt_pk_bf16(v1[2], v1[3]);
                *(u32x4*)rowp = w; }
    }
};
struct EpiResid {
    static constexpr bool PERM = false;
    const float* baseLat; const float* baseCtx; float* out; const float* mod;
    DI void operator()(const f32x4 (&acc)[2][2][4][2], const Unit& u, int wr, int wc, int fr, int fq) const {
        const int row0 = u.pm * 256 + wr * 64 + fr, col0 = u.pn * 256 + wc * 32 + 4 * fq;
        const int br = (u.pm * 256 < MLAT) ? (u.pm * 256) / TL : 4;
        const float* gate = mod + (size_t)br * D6 + col0;
        f32x4 gv[2][2];
#pragma unroll
        for (int bj = 0; bj < 2; ++bj)
#pragma unroll
            for (int n = 0; n < 2; ++n) gv[bj][n] = *(const f32x4*)(gate + bj * 128 + n * 16);
#pragma unroll
        for (int ai = 0; ai < 2; ++ai)
#pragma unroll
            for (int m = 0; m < 4; ++m) { const int row = row0 + ai * 128 + m * 16;
                const float* bp = (row < MLAT ? baseLat + (size_t)row * D : baseCtx + (size_t)(row - MLAT) * D) + col0; float* op = out + (size_t)row * D + col0;
#pragma unroll
                for (int bj = 0; bj < 2; ++bj)
#pragma unroll
                    for (int n = 0; n < 2; ++n) { const f32x4 b = *(const f32x4*)(bp + bj * 128 + n * 16); *(f32x4*)(op + bj * 128 + n * 16) = b + gv[bj][n] * acc[ai][bj][m][n]; } }
    }
};
struct MoeOrder {
    const LAS int* tb; int NT, G, c, L0, nT, S, KS;
    DI bool next(int i, Unit& u) const {
        const long T = (long)i * G + c; if (T >= nT) return false;
        const int nun = tb[40], L = L0 + (int)T / S, sl = (int)T % S;
        const int w = pg8::xcd_remap(L, nun); int e = 0;
#pragma unroll
        for (int k = 1; k < 8; ++k) if (w >= tb[32 + k]) e = k;
        const int rem = w - tb[32 + e], tiles = tb[8 + e], nt = rem / tiles, mtl = rem - nt * tiles;
        u.pm = tb[16 + e] + mtl; u.pn = nt; u.pb = e * NT + nt; u.koff = sl * KS; u.aux = (int)T; return true;
    }
};
struct EpiPart {
    static constexpr bool PERM = false;
    float* part;
    DI void operator()(const f32x4 (&acc)[2][2][4][2], const Unit& u, int wr, int wc, int fr, int fq) const {
        f32x4* p = (f32x4*)part + (size_t)u.aux * (32 * NTHR) + threadIdx.x;
#pragma unroll
        for (int ai = 0; ai < 2; ++ai)
#pragma unroll
            for (int bj = 0; bj < 2; ++bj)
#pragma unroll
                for (int m = 0; m < 4; ++m)
#pragma unroll
                    for (int n = 0; n < 2; ++n) p[(size_t)(((ai * 2 + bj) * 4 + m) * 2 + n) * NTHR] = acc[ai][bj][m][n];
    }
};
template <int S> DI void splitk_reduce_f32(const float* part, int t, int cg, const Unit& u, float* C, int ldc) {
    const int tid = threadIdx.x, wid = tid >> 6, lane = tid & 63, wr = wid >> 2, wc = wid & 3, fr = lane & 15, fq = lane >> 4;
    f32x4 v[4][S];
#pragma unroll
    for (int k = 0; k < 4; ++k)
#pragma unroll
        for (int s = 0; s < S; ++s) v[k][s] = *((const f32x4*)part + ((size_t)(t * S + s) * 32 + (cg * 4 + k)) * NTHR + tid);
#pragma unroll
    for (int k = 0; k < 4; ++k) { const int ch = cg * 4 + k, n = ch & 1, m = (ch >> 1) & 3, bj = (ch >> 3) & 1, ai = ch >> 4;
        f32x4 a = v[k][0];
#pragma unroll
        for (int s = 1; s < S; ++s) a += v[k][s];
        *(f32x4*)(C + (size_t)(u.pm * 256 + ai * 128 + wr * 64 + m * 16 + fr) * ldc + u.pn * 256 + bj * 128 + wc * 32 + n * 16 + 4 * fq) = a; }
}
DI int tc_of(int dir, int p) { return dir == 0 ? (p < 4 ? 32 + p : p - 4) : 35 - p; }

DI void m1_prep_unit(Frame& F, int l, int b, int tt) {
    const float* P = WSP(float, WS_P);
    const int j0 = tt * 32, lane = F.lane;
    LAS bf16* vs = (LAS bf16*)F.lds;
    for (int i = F.wave; i < 32; i += 8) {
        const int j = j0 + i, row = rowof(b, j);
        const float* p = P + (size_t)row * DINP;
        float cq[7], ckv[3], nq[4][2], nk[4][2], nv[8];
#pragma unroll
        for (int u = 0; u < 7; ++u) cq[u] = p[PC_CQ + lane + 64 * u];
#pragma unroll
        for (int u = 0; u < 3; ++u) { const int idx = lane + 64 * u; ckv[u] = idx < 160 ? p[PC_CKV + idx] : 0.f; }
#pragma unroll
        for (int h = 0; h < 4; ++h) { nq[h][0] = p[PC_NQ + h * 128 + lane]; nq[h][1] = p[PC_NQ + h * 128 + 64 + lane]; nk[h][0] = p[PC_NK + h * 128 + lane]; nk[h][1] = p[PC_NK + h * 128 + 64 + lane]; }
#pragma unroll
        for (int u = 0; u < 8; ++u) nv[u] = p[PC_NV + lane + 64 * u];
        const float gi = lane < 8 ? p[PC_IG + lane] : 0.f, gf = lane < 8 ? p[PC_FG + lane] : 0.f, gd = lane < 16 ? p[PC_DT + lane] : 0.f;
        {
            float ss = 0.f;
#pragma unroll
            for (int u = 0; u < 7; ++u) ss += cq[u] * cq[u];
            const float rstd = 1.0f / sqrtf(wave_sum(ss) * (1.f / 448.f) + EPS);
            const float* qn = F.in[18] + l * 448; bf16* o = WSP(bf16, WS_CQN) + (size_t)row * 512;
#pragma unroll
            for (int u = 0; u < 7; ++u) o[lane + 64 * u] = (bf16)f2bf(cq[u] * rstd * qn[lane + 64 * u]);
            o[448 + lane] = 0;
        }
        {
            float ss = 0.f;
#pragma unroll
            for (int u = 0; u < 3; ++u) ss += ckv[u] * ckv[u];
            const float rstd = 1.0f / sqrtf(wave_sum(ss) * (1.f / 160.f) + EPS);
            const float* kn = F.in[20] + l * 160; bf16* o = WSP(bf16, WS_CKVN) + (size_t)row * 256;
#pragma unroll
            for (int u = 0; u < 3; ++u) { const int idx = lane + 64 * u; o[idx] = idx < 160 ? (bf16)f2bf(ckv[u] * rstd * kn[idx]) : (bf16)0; }
            o[192 + lane] = 0;
        }
        const float* gq = F.in[24] + l * 128; const float* gk = F.in[25] + l * 128;
#pragma unroll
        for (int h = 0; h < 4; ++h) {
            const float rq = 1.0f / sqrtf(wave_sum(nq[h][0] * nq[h][0] + nq[h][1] * nq[h][1]) * (1.f / 128.f) + EPS);
            const float rk = 1.0f / sqrtf(wave_sum(nk[h][0] * nk[h][0] + nk[h][1] * nk[h][1]) * (1.f / 128.f) + EPS);
            bf16* oq = WSP(bf16, WS_QNA) + ((size_t)(b * 4 + h) * TS + j) * 128; bf16* ok = WSP(bf16, WS_KNA) + ((size_t)(b * 4 + h) * TS + j) * 128;
            oq[lane] = (bf16)f2bf(nq[h][0] * rq * gq[lane]); oq[64 + lane] = (bf16)f2bf(nq[h][1] * rq * gq[64 + lane]);
            ok[lane] = (bf16)f2bf(nk[h][0] * rk * gk[lane]); ok[64 + lane] = (bf16)f2bf(nk[h][1] * rk * gk[64 + lane]);
        }
#pragma unroll
        for (int u = 0; u < 8; ++u) vs[i * 520 + lane + 64 * u] = (bf16)f2bf(nv[u]);
        if (lane < 8) {
            float* gt = WSP(float, WS_GATES) + (size_t)row * 16;
            gt[lane] = gi + F.in[9][l * 8 + lane];
            gt[8 + lane] = logsigmoidf_(gf + F.in[10][l * 8 + lane]);
        }
        if (lane < 16) WSP(float, WS_DT)[(size_t)row * 16 + lane] = softplusf_(gd + F.in[14][l * 16 + lane]);
    }
    {
        const int ch = 2 * F.tid;
        const int seglo = j0 < TL ? 0 : TL, seghi = j0 < TL ? TL : TS;
        const float* cw = F.in[12] + (size_t)l * 5 * 1024 + ch; const float* cb = F.in[13] + (size_t)l * 1024 + ch;
        f32x2 w[5];
#pragma unroll
        for (int d = 0; d < 5; ++d) w[d] = *(const f32x2*)(cw + d * 1024);
        const f32x2 bias = *(const f32x2*)cb;
        f32x2 xin[36];
#pragma unroll
        for (int d = 0; d < 36; ++d) { const int jj = j0 - 2 + d; xin[d] = (jj >= seglo && jj < seghi) ? *(const f32x2*)(P + (size_t)rowof(b, jj) * DINP + PC_XBC + ch) : (f32x2){0.f, 0.f}; }
#pragma unroll
        for (int i = 0; i < 32; ++i) {
            f32x2 a = bias;
#pragma unroll
            for (int d = 0; d < 5; ++d) a += w[d] * xin[i + d];
            *(unsigned*)(WSP(bf16, WS_XBC) + (size_t)rowof(b, j0 + i) * 1024 + ch) = pk2(siluf(a[0]), siluf(a[1]));
        }
    }
    __syncthreads();
    {
        const int t = F.tid; unsigned wv[16];
#pragma unroll
        for (int i = 0; i < 16; ++i) wv[i] = (unsigned)vs[(2 * i) * 520 + t] | ((unsigned)vs[(2 * i + 1) * 520 + t] << 16);
        u32x4* dst = (u32x4*)(WSP(bf16, WS_VTNA) + ((size_t)(b * 4 + (t >> 7)) * 128 + (t & 127)) * TS + j0);
#pragma unroll
        for (int k = 0; k < 4; ++k) dst[k] = (u32x4){wv[4 * k], wv[4 * k + 1], wv[4 * k + 2], wv[4 * k + 3]};
    }
    __syncthreads();
}

DI void ml_a_unit(Frame& F, int seq, int p) {
    const int b = seq >> 3, h = (seq >> 1) & 3, dir = seq & 1, tc = tc_of(dir, p), lane = F.lane;
    const float* P = WSP(float, WS_P);
    LAS bf16* VW = (LAS bf16*)F.lds;
    LAS bf16* KT = (LAS bf16*)(F.lds + 20736);
    LAS float* wgs = (LAS float*)(F.lds + 39168);
    if (F.wave == 0) {
        const int row = rowof(b, tc * 64 + lane);
        const float* gt = WSP(float, WS_GATES) + (size_t)row * 16;
        const float li = gt[dir * 4 + h], lf = gt[8 + dir * 4 + h];
        const float pre = wave_incl_scan(lf, lane), tot = __shfl(pre, 63);
        const float g = dir == 0 ? (tot - pre) + li : (pre - lf) + li;
        const float mloc = wave_max(g);
        wgs[lane] = __expf(g - mloc);
        if (lane == 0) { float* sc = WSP(float, WS_MLSC) + (size_t)(seq * 36 + p) * 4; sc[0] = tot; sc[1] = mloc; }
    }
    {
        float vv[16], kk[16];
#pragma unroll
        for (int it = 0; it < 16; ++it) { const int idx = F.tid + NTHR * it, n = idx >> 7, d = idx & 127;
            const float* pr = P + (size_t)rowof(b, tc * 64 + n) * DINP + h * 128 + d; vv[it] = pr[PC_MLV]; kk[it] = pr[PC_MLK]; }
        __syncthreads();
#pragma unroll
        for (int it = 0; it < 16; ++it) { const int idx = F.tid + NTHR * it, n = idx >> 7, d = idx & 127;
            VW[d * 72 + n] = (bf16)f2bf(vv[it] * wgs[n]); KT[d * 72 + n] = (bf16)f2bf(kk[it]); }
    }
    for (int idx = F.tid; idx < 16 * 64; idx += NTHR) { const int rr = idx >> 6, n = idx & 63; VW[(128 + rr) * 72 + n] = rr == 0 ? (bf16)f2bf(wgs[n]) : (bf16)0; }
    __syncthreads();
    float* U = WSP(float, WS_MLU) + (size_t)(seq * 36 + p) * (129 * 128);
    for (int id = F.wave; id < 72; id += 8) { const int dt = id >> 3, et = id & 7;
        const f32x4 acc = mma16<64>(VW + dt * 16 * 72, 72, KT + et * 16 * 72, 72, lane, (f32x4){0.f, 0.f, 0.f, 0.f});
#pragma unroll
        for (int i = 0; i < 4; ++i) { const int d = dt * 16 + 4 * (lane >> 4) + i; if (d < 129) U[d * 128 + et * 16 + (lane & 15)] = acc[i]; } }
    __syncthreads();
}

DI void ss_a_unit(Frame& F, int l, int b, int dir, int p, int g) {
    const int tc = tc_of(dir, p), lane = F.lane;
    LAS bf16* XT = (LAS bf16*)F.lds;
    LAS bf16* BT = (LAS bf16*)(F.lds + 36864);
    LAS float* tails = (LAS float*)(F.lds + 55296);
    const bf16* XBC = WSP(bf16, WS_XBC);
    if (F.wave < 4) {
        const int h = 4 * g + F.wave, row = rowof(b, tc * 64 + lane);
        const float dt = WSP(float, WS_DT)[(size_t)row * 16 + dir * 8 + h];
        const float A = -__expf(F.in[15][l * 16 + dir * 8 + h]);
        const float a = dt * A, pre = wave_incl_scan(a, lane), tot = __shfl(pre, 63);
        tails[F.wave * 64 + lane] = (dir == 0 ? __expf(tot - pre) : __expf(pre - a)) * dt;
        if (lane == 0) WSP(float, WS_SSSC)[(size_t)((b * 8 + h) * 2 + dir) * 36 + p] = __expf(tot);
    }
    {
        bf16 xv[32], bv[16];
#pragma unroll
        for (int it = 0; it < 32; ++it) { const int idx = F.tid + NTHR * it, n = idx >> 8, c = idx & 255; xv[it] = XBC[(size_t)rowof(b, tc * 64 + n) * 1024 + g * 256 + c]; }
#pragma unroll
        for (int it = 0; it < 16; ++it) { const int idx = F.tid + NTHR * it, n = idx >> 7, nn = idx & 127; bv[it] = XBC[(size_t)rowof(b, tc * 64 + n) * 1024 + 512 + g * 128 + nn]; }
        __syncthreads();
#pragma unroll
        for (int it = 0; it < 32; ++it) { const int idx = F.tid + NTHR * it, n = idx >> 8, c = idx & 255; XT[c * 72 + n] = (bf16)f2bf(bf2f(xv[it]) * tails[(c >> 6) * 64 + n]); }
#pragma unroll
        for (int it = 0; it < 16; ++it) { const int idx = F.tid + NTHR * it, n = idx >> 7, nn = idx & 127; BT[nn * 72 + n] = bv[it]; }
    }
    __syncthreads();
    for (int id = F.wave; id < 128; id += 8) { const int hh = id >> 5, rem = id & 31, pt = rem >> 3, nt = rem & 7;
        const f32x4 acc = mma16<64>(XT + (hh * 64 + pt * 16) * 72, 72, BT + nt * 16 * 72, 72, lane, (f32x4){0.f, 0.f, 0.f, 0.f});
        float* U = WSP(float, WS_SSU) + (size_t)(((b * 8 + 4 * g + hh) * 2 + dir) * 36 + p) * 8192;
#pragma unroll
        for (int i = 0; i < 4; ++i) U[(pt * 16 + 4 * (lane >> 4) + i) * 128 + nt * 16 + (lane & 15)] = acc[i]; }
    __syncthreads();
}
DI void ml_scan_unit(Frame& F, int seq, int s4) {
    float* sc = WSP(float, WS_MLSC) + (size_t)seq * 36 * 4;
    const float* U = WSP(float, WS_MLU) + (size_t)seq * 36 * 16512 + s4 * 4128 + F.tid; bf16* S = WSP(bf16, WS_MLS) + (size_t)seq * 36 * 16512 + s4 * 4128 + F.tid;
    float st[9]; float m = 0.f;
#pragma unroll
    for (int k = 0; k < 9; ++k) st[k] = 0.f;
    for (int pg = 0; pg < 36; pg += 12) {
        float u[12][9];
#pragma unroll
        for (int pp = 0; pp < 12; ++pp)
#pragma unroll
            for (int k = 0; k < 9; ++k) u[pp][k] = (F.tid + 512 * k < 4128) ? U[(size_t)(pg + pp) * 16512 + 512 * k] : 0.f;
#pragma unroll
        for (int pp = 0; pp < 12; ++pp) { const int p = pg + pp;
            const float bl = sc[p * 4], mloc = sc[p * 4 + 1];
            const float mn = fmaxf(bl + m, mloc), wc = __expf(bl + m - mn), wu = __expf(mloc - mn);
            if (s4 == 0 && F.tid == 0) sc[p * 4 + 2] = m;
#pragma unroll
            for (int k = 0; k < 9; ++k) { if (F.tid + 512 * k < 4128) S[(size_t)p * 16512 + 512 * k] = (bf16)f2bf(st[k]); st[k] = wc * st[k] + wu * u[pp][k]; }
            m = mn; }
    }
}
DI void ss_scan_unit(Frame& F, int sq, int half) {
    const float* dec = WSP(float, WS_SSSC) + (size_t)sq * 36;
    const float* U = WSP(float, WS_SSU) + (size_t)sq * 36 * 8192 + half * 4096 + F.tid; bf16* S = WSP(bf16, WS_SSS) + (size_t)sq * 36 * 8192 + half * 4096 + F.tid;
    float st[8];
#pragma unroll
    for (int k = 0; k < 8; ++k) st[k] = 0.f;
    for (int pg = 0; pg < 36; pg += 12) {
        float u[12][8];
#pragma unroll
        for (int pp = 0; pp < 12; ++pp)
#pragma unroll
            for (int k = 0; k < 8; ++k) u[pp][k] = U[(size_t)(pg + pp) * 8192 + 512 * k];
#pragma unroll
        for (int pp = 0; pp < 12; ++pp) { const int p = pg + pp; const float dc = dec[p];
#pragma unroll
            for (int k = 0; k < 8; ++k) { S[(size_t)p * 8192 + 512 * k] = (bf16)f2bf(st[k]); st[k] = st[k] * dc + u[pp][k]; } }
    }
}
DI void mla_post_unit(Frame& F, int l, int b, int tt) {
    const float* P = WSP(float, WS_P);
    const bf16* QRAW = WSP(bf16, WS_QRAW); const bf16* KVRAW = WSP(bf16, WS_KVRAW);
    const int j0 = tt * 32, lane = F.lane;
    LAS bf16* vs = (LAS bf16*)F.lds;
    const float* gq = F.in[22] + l * 192; const float* gk = F.in[23] + l * 192;
    for (int i = F.wave; i < 32; i += 8) {
        const int j = j0 + i, row = rowof(b, j); const bool lat = j < TL;
        const int a = lane & 31; const float pos = (float)(a < 16 ? (j >> 6) : (j & 63));
        const float fr = exp2f(-(float)(a & 15) * (13.287712379549449f / 16.f));
        const float ang = pos * fr; const float cs = __cosf(ang), sn = __sinf(ang);
        const float krv = P[(size_t)row * DINP + PC_KR + lane];
        float qv[4][3], kk[4][2]; bf16 vv[4][2];
#pragma unroll
        for (int h = 0; h < 4; ++h) { const bf16* q = QRAW + (size_t)row * 768 + h * 192; const bf16* kv = KVRAW + (size_t)row * 1024 + h * 256;
            qv[h][0] = bf2f(q[lane]); qv[h][1] = bf2f(q[64 + lane]); qv[h][2] = bf2f(q[128 + lane]);
            kk[h][0] = bf2f(kv[lane]); kk[h][1] = bf2f(kv[64 + lane]); vv[h][0] = kv[128 + lane]; vv[h][1] = kv[192 + lane]; }
#pragma unroll
        for (int h = 0; h < 4; ++h) {
            {
                const float v0 = qv[h][0], v1 = qv[h][1], v2 = qv[h][2];
                const float rstd = 1.0f / sqrtf(wave_sum(v0 * v0 + v1 * v1 + v2 * v2) * (1.f / 192.f) + EPS);
                const float n0 = v0 * rstd * gq[lane], n1 = v1 * rstd * gq[64 + lane]; float n2 = v2 * rstd * gq[128 + lane];
                const float pr = __shfl_xor(n2, 32);
                if (lat) n2 = lane < 32 ? n2 * cs - pr * sn : pr * sn + n2 * cs;
                bf16* o = WSP(bf16, WS_QMLA) + ((size_t)(b * 4 + h) * TS + j) * 192;
                o[lane] = (bf16)f2bf(n0); o[64 + lane] = (bf16)f2bf(n1); o[128 + lane] = (bf16)f2bf(n2);
            }
            {
                const float v0 = kk[h][0], v1 = kk[h][1], v2 = krv;
                const float rstd = 1.0f / sqrtf(wave_sum(v0 * v0 + v1 * v1 + v2 * v2) * (1.f / 192.f) + EPS);
                const float n0 = v0 * rstd * gk[lane], n1 = v1 * rstd * gk[64 + lane]; float n2 = v2 * rstd * gk[128 + lane];
                const float pr = __shfl_xor(n2, 32);
                if (lat) n2 = lane < 32 ? n2 * cs - pr * sn : pr * sn + n2 * cs;
                bf16* o = WSP(bf16, WS_KMLA) + ((size_t)(b * 4 + h) * TS + j) * 192;
                o[lane] = (bf16)f2bf(n0); o[64 + lane] = (bf16)f2bf(n1); o[128 + lane] = (bf16)f2bf(n2);
                vs[i * 520 + h * 128 + lane] = vv[h][0]; vs[i * 520 + h * 128 + 64 + lane] = vv[h][1];
            }
        }
    }
    __syncthreads();
    {
        const int t = F.tid; unsigned wv[16];
#pragma unroll
        for (int i = 0; i < 16; ++i) wv[i] = (unsigned)vs[(2 * i) * 520 + t] | ((unsigned)vs[(2 * i + 1) * 520 + t] << 16);
        u32x4* dst = (u32x4*)(WSP(bf16, WS_VTMLA) + ((size_t)(b * 4 + (t >> 7)) * 128 + (t & 127)) * TS + j0);
#pragma unroll
        for (int k = 0; k < 4; ++k) dst[k] = (u32x4){wv[4 * k], wv[4 * k + 1], wv[4 * k + 2], wv[4 * k + 3]};
    }
    __syncthreads();
}

template <int DK, bool NA>
DI void attn_unit(Frame& F, const bf16* Qg, const bf16* Kg, const bf16* VTg, int nA, int tA0, int nB, int tB0, float scale, bf16* Og, int qrow0, const float* rpb) {
    constexpr int KP = DK + 8, KCH = DK / 8, NKC = 64 * KCH / NTHR;
    LAS bf16* Ks = (LAS bf16*)F.lds;
    LAS bf16* VTs = (LAS bf16*)(F.lds + 64 * KP * 2);
    LAS bf16* Ps = (LAS bf16*)(F.lds + 64 * KP * 2 + 128 * 72 * 2) + F.wave * (16 * 72);
    LAS float* rp = (LAS float*)(F.lds + 64 * KP * 2 + 128 * 72 * 2 + 8 * 16 * 72 * 2);
    const int lane = F.lane, r = lane & 15, q = lane >> 4, tid = F.tid, w = F.wave;
    if (NA) { for (int i = tid; i < 15 * 31; i += NTHR) rp[i] = rpb[i]; }
    bf16x8 qf[DK / 32];
#pragma unroll
    for (int kk = 0; kk < DK / 32; ++kk) qf[kk] = *(const bf16x8*)(Qg + (size_t)(w * 16 + r) * DK + 32 * kk + 8 * q);
    f32x4 o[8]; float mrow[4], lrow[4];
#pragma unroll
    for (int d = 0; d < 8; ++d) o[d] = (f32x4){0.f, 0.f, 0.f, 0.f};
#pragma unroll
    for (int i = 0; i < 4; ++i) { mrow[i] = -1.0e30f; lrow[i] = 0.f; }
    const int ntile = nA + nB;
    u32x4 kreg[NKC], vreg[2];
    const int rq = qrow0 + (w >> 2);
    const int r0 = rq - 4 < 0 ? 0 : (rq - 4 > 24 ? 24 : rq - 4);
#define ATT_LOAD(kt) do { _Pragma("unroll") for (int c = 0; c < NKC; ++c) { const int id = tid + NTHR * c, rr = id / KCH, cc = id % KCH; kreg[c] = *(const u32x4*)(Kg + (size_t)((kt) * 64 + rr) * DK + cc * 8); } \
        _Pragma("unroll") for (int c = 0; c < 2; ++c) { const int id = tid + NTHR * c, dd = id >> 3, cc = id & 7; vreg[c] = *(const u32x4*)(VTg + (size_t)dd * TS + (kt) * 64 + cc * 8); } } while (0)
    ATT_LOAD(nA > 0 ? tA0 : tB0);
    for (int it = 0; it < ntile; ++it) {
        const int kt = it < nA ? tA0 + it : tB0 + (it - nA);
        __syncthreads();
#pragma unroll
        for (int c = 0; c < NKC; ++c) { const int id = tid + NTHR * c, rr = id / KCH, cc = id % KCH; *(LAS u32x4*)(Ks + rr * KP + cc * 8) = kreg[c]; }
#pragma unroll
        for (int c = 0; c < 2; ++c) { const int id = tid + NTHR * c, dd = id >> 3, cc = id & 7; *(LAS u32x4*)(VTs + dd * 72 + cc * 8) = vreg[c]; }
        __syncthreads();
        if (it + 1 < ntile) { const int kn = (it + 1) < nA ? tA0 + it + 1 : tB0 + (it + 1 - nA); ATT_LOAD(kn); }
        const bool nbt = NA && kt < 32;
        if (nbt && (kt < r0 || kt >= r0 + 8)) continue;
        f32x4 s[4];
#pragma unroll
        for (int n = 0; n < 4; ++n) s[n] = (f32x4){0.f, 0.f, 0.f, 0.f};
#pragma unroll
        for (int kk = 0; kk < DK / 32; ++kk)
#pragma unroll
            for (int n = 0; n < 4; ++n) { const bf16x8 kf = *(const LAS bf16x8*)(Ks + (n * 16 + r) * KP + 32 * kk + 8 * q); s[n] = __builtin_amdgcn_mfma_f32_16x16x32_bf16(qf[kk], kf, s[n], 0, 0, 0); }
        float mx[4];
#pragma unroll
        for (int i = 0; i < 4; ++i) mx[i] = -1.0e30f;
#pragma unroll
        for (int n = 0; n < 4; ++n)
#pragma unroll
            for (int i = 0; i < 4; ++i) {
                float v = s[n][i] * scale;
                if (nbt) { const int c = (w & 3) * 16 + 4 * q + i, kc = n * 16 + r; const int c0 = c - 8 < 0 ? 0 : (c - 8 > 48 ? 48 : c - 8);
                    v = (kc >= c0 && kc < c0 + 16) ? v + rp[(kt - rq + 7) * 31 + (kc - c + 15)] : -1.0e30f; }
                s[n][i] = v; mx[i] = fmaxf(mx[i], v);
            }
        float alpha[4], rs[4];
#pragma unroll
        for (int i = 0; i < 4; ++i) {
            float m = mx[i]; m = fmaxf(m, __shfl_xor(m, 1)); m = fmaxf(m, __shfl_xor(m, 2)); m = fmaxf(m, __shfl_xor(m, 4)); m = fmaxf(m, __shfl_xor(m, 8));
            const float mn = fmaxf(mrow[i], m); alpha[i] = __expf(mrow[i] - mn); mrow[i] = mn; rs[i] = 0.f;
        }
#pragma unroll
        for (int n = 0; n < 4; ++n)
#pragma unroll
            for (int i = 0; i < 4; ++i) { const float pv = __expf(s[n][i] - mrow[i]); rs[i] += pv; Ps[(4 * q + i) * 72 + n * 16 + r] = (bf16)f2bf(pv); }
#pragma unroll
        for (int i = 0; i < 4; ++i) {
            float t = rs[i]; t += __shfl_xor(t, 1); t += __shfl_xor(t, 2); t += __shfl_xor(t, 4); t += __shfl_xor(t, 8);
            lrow[i] = lrow[i] * alpha[i] + t;
        }
#pragma unroll
        for (int d = 0; d < 8; ++d)
#pragma unroll
            for (int i = 0; i < 4; ++i) o[d][i] *= alpha[i];
        asm volatile("s_waitcnt lgkmcnt(0)" ::: "memory");
#pragma unroll
        for (int kk = 0; kk < 2; ++kk) { const bf16x8 pf = *(const LAS bf16x8*)(Ps + r * 72 + 32 * kk + 8 * q);
#pragma unroll
            for (int d = 0; d < 8; ++d) { const bf16x8 vf = *(const LAS bf16x8*)(VTs + (d * 16 + r) * 72 + 32 * kk + 8 * q); o[d] = __builtin_amdgcn_mfma_f32_16x16x32_bf16(pf, vf, o[d], 0, 0, 0); } }
    }
#undef ATT_LOAD
#pragma unroll
    for (int i = 0; i < 4; ++i) { const float inv = 1.0f / lrow[i]; bf16* op = Og + (size_t)(w * 16 + 4 * q + i) * D + r;
#pragma unroll
        for (int d = 0; d < 8; ++d) op[d * 16] = (bf16)f2bf(o[d][i] * inv); }
    __syncthreads();
}
typedef float f32x16 __attribute__((ext_vector_type(16)));
typedef short s16x4 __attribute__((ext_vector_type(4)));
template <int DK, bool NA>
DI void attn_unit2(Frame& F, const bf16* Qg, const bf16* Kg, const bf16* VTg, int nA, int tA0, int nB, int tB0, float sc2, bf16* Og, int qrow0, const float* rpb) {
    constexpr int KP = DK + 8, KCH = DK / 8, NKC = 64 * KCH / NTHR, NKK = DK / 16;
    constexpr int KTB = 64 * KP * 2, VTB = 128 * 72 * 2, BUFB = KTB + VTB;
    const int lane = F.lane, l32 = lane & 31, h = lane >> 5, tid = F.tid, w = F.wave, g = w & 3, kp = w >> 2;
    LAS float* rp = (LAS float*)(F.lds + 2 * BUFB);
    if (NA) { for (int i = tid; i < 15 * 31; i += NTHR) rp[i] = rpb[i] * 1.4426950408889634f; }
    bf16x8 qf[NKK];
#pragma unroll
    for (int kk = 0; kk < NKK; ++kk) qf[kk] = *(const bf16x8*)(Qg + (size_t)(32 * g + l32) * DK + 16 * kk + 8 * h);
    f32x16 o[4]; float mrun = -1.0e30f, lrun = 0.f;
#pragma unroll
    for (int d = 0; d < 4; ++d)
#pragma unroll
        for (int i = 0; i < 16; ++i) o[d][i] = 0.f;
    const int ntile = nA + nB;
    const int rq = qrow0 + (g >> 1), r0 = rq - 4 < 0 ? 0 : (rq - 4 > 24 ? 24 : rq - 4);
    const int cq = 32 * (g & 1) + l32, c0 = cq - 8 < 0 ? 0 : (cq - 8 > 48 ? 48 : cq - 8);
    u32x4 kreg[NKC], vreg[2];
#define ATT2_TILE(it) ((it) < nA ? tA0 + (it) : tB0 + ((it) - nA))
#define ATT2_LOAD(it) do { const int kt_ = ATT2_TILE(it); \
        _Pragma("unroll") for (int c = 0; c < NKC; ++c) { const int id = tid + NTHR * c, rr = id / KCH, cc = id % KCH; kreg[c] = *(const u32x4*)(Kg + (size_t)(kt_ * 64 + rr) * DK + cc * 8); } \
        _Pragma("unroll") for (int c = 0; c < 2; ++c) { const int id = tid + NTHR * c, dd = id >> 3, cc = id & 7; vreg[c] = *(const u32x4*)(VTg + (size_t)dd * TS + kt_ * 64 + cc * 8); } } while (0)
#define ATT2_STORE(b) do { \
        _Pragma("unroll") for (int c = 0; c < NKC; ++c) { const int id = tid + NTHR * c, rr = id / KCH, cc = id % KCH; *(LAS u32x4*)(F.lds + (b) * BUFB + (rr * KP + cc * 8) * 2) = kreg[c]; } \
        _Pragma("unroll") for (int c = 0; c < 2; ++c) { const int id = tid + NTHR * c, dd = id >> 3, cc = id & 7; *(LAS u32x4*)(F.lds + (b) * BUFB + KTB + (dd * 72 + cc * 8) * 2) = vreg[c]; } } while (0)
    ATT2_LOAD(0); ATT2_STORE(0);
    __syncthreads();
    for (int st = 0; st < ntile; ++st) {
        if (st + 1 < ntile) ATT2_LOAD(st + 1);
        const int kt = ATT2_TILE(st);
        const bool nbt = NA && kt < 32;
        if (!(nbt && (kt < r0 || kt >= r0 + 8))) {
            const LAS bf16* Ks = (const LAS bf16*)(F.lds + (st & 1) * BUFB) + (kp * 32 + l32) * KP + 8 * h;
            const LAS bf16* VTs = (const LAS bf16*)(F.lds + (st & 1) * BUFB + KTB) + l32 * 72 + kp * 32 + 4 * h;
            f32x16 s;
#pragma unroll
            for (int i = 0; i < 16; ++i) s[i] = 0.f;
#pragma unroll
            for (int kk = 0; kk < NKK; ++kk) { const bf16x8 kf = *(const LAS bf16x8*)(Ks + 16 * kk); s = __builtin_amdgcn_mfma_f32_32x32x16_bf16(kf, qf[kk], s, 0, 0, 0); }
            float mx = -1.0e30f;
#pragma unroll
            for (int i = 0; i < 16; ++i) {
                float v = s[i] * sc2;
                if (nbt) { const int kc = kp * 32 + 8 * (i >> 2) + 4 * h + (i & 3); v = (kc >= c0 && kc < c0 + 16) ? v + rp[(kt - rq + 7) * 31 + (kc - cq + 15)] : -1.0e30f; }
                s[i] = v; mx = fmaxf(mx, v);
            }
            mx = fmaxf(mx, __shfl_xor(mx, 32));
            const float mn = fmaxf(mrun, mx), alpha = __builtin_amdgcn_exp2f(mrun - mn); mrun = mn;
            float rs = 0.f;
#pragma unroll
            for (int i = 0; i < 16; ++i) { const float pv = __builtin_amdgcn_exp2f(s[i] - mn); s[i] = pv; rs += pv; }
            rs += __shfl_xor(rs, 32);
            lrun = lrun * alpha + rs;
#pragma unroll
            for (int d = 0; d < 4; ++d)
#pragma unroll
                for (int i = 0; i < 16; ++i) o[d][i] *= alpha;
#pragma unroll
            for (int sp = 0; sp < 2; ++sp) {
                u32x4 pw; pw.x = pg8::cvt_pk_bf16(s[8 * sp + 0], s[8 * sp + 1]); pw.y = pg8::cvt_pk_bf16(s[8 * sp + 2], s[8 * sp + 3]);
                pw.z = pg8::cvt_pk_bf16(s[8 * sp + 4], s[8 * sp + 5]); pw.w = pg8::cvt_pk_bf16(s[8 * sp + 6], s[8 * sp + 7]);
                const bf16x8 pf = __builtin_bit_cast(bf16x8, pw);
#pragma unroll
                for (int d = 0; d < 4; ++d) { const LAS bf16* vp = VTs + d * 32 * 72 + 16 * sp;
                    const u32x2 lo = *(const LAS u32x2*)vp, hi = *(const LAS u32x2*)(vp + 8);
                    const u32x4 vv = (u32x4){lo.x, lo.y, hi.x, hi.y};
                    o[d] = __builtin_amdgcn_mfma_f32_32x32x16_bf16(__builtin_bit_cast(bf16x8, vv), pf, o[d], 0, 0, 0); }
            }
        }
        if (st + 1 < ntile) ATT2_STORE((st + 1) & 1);
        __syncthreads();
    }
#undef ATT2_LOAD
#undef ATT2_STORE
#undef ATT2_TILE
    LAS float* ob = (LAS float*)F.lds + g * (66 * 64);
    if (kp == 1) {
#pragma unroll
        for (int d = 0; d < 4; ++d)
#pragma unroll
            for (int i = 0; i < 16; ++i) ob[(d * 16 + i) * 64 + lane] = o[d][i];
        ob[64 * 64 + lane] = mrun; ob[65 * 64 + lane] = lrun;
    }
    __syncthreads();
    if (kp == 0) {
        const float m1 = ob[64 * 64 + lane], l1 = ob[65 * 64 + lane];
        const float mf = fmaxf(mrun, m1), a0 = __builtin_amdgcn_exp2f(mrun - mf), a1 = __builtin_amdgcn_exp2f(m1 - mf);
        const float inv = 1.0f / (lrun * a0 + l1 * a1);
        bf16* op = Og + (size_t)(32 * g + l32) * D + 4 * h;
#pragma unroll
        for (int d = 0; d < 4; ++d)
#pragma unroll
            for (int i4 = 0; i4 < 4; ++i4) {
                float r[4];
#pragma unroll
                for (int j = 0; j < 4; ++j) r[j] = (o[d][4 * i4 + j] * a0 + ob[(d * 16 + 4 * i4 + j) * 64 + lane] * a1) * inv;
                u32x2 wv; wv.x = pk2(r[0], r[1]); wv.y = pk2(r[2], r[3]);
                *(u32x2*)(op + d * 32 + 8 * i4) = wv;
            }
    }
    __syncthreads();
}
DI void ml_c_unit(Frame& F, int seq, int p) {
    const int b = seq >> 3, h = (seq >> 1) & 3, dir = seq & 1, tc = tc_of(dir, p), lane = F.lane, tid = F.tid;
    const float* P = WSP(float, WS_P);
    constexpr float QS = 0.08838834764831845f;
    LAS bf16* Qs = (LAS bf16*)F.lds;
    LAS bf16* Ksm = (LAS bf16*)(F.lds + 17408);
    LAS bf16* VT = (LAS bf16*)(F.lds + 34816);
    LAS bf16* Cx = (LAS bf16*)(F.lds + 55552);
    LAS bf16* SW = (LAS bf16*)(F.lds + 94720);
    LAS float* av = (LAS float*)(F.lds + 103936);
    LAS float* Mt = av + 64;
    LAS float* Bt = av + 128;
    LAS float* den = av + 192;
    const float m_p = WSP(float, WS_MLSC)[(size_t)(seq * 36 + p) * 4 + 2];
    if (F.wave == 0) {
        const int row = rowof(b, tc * 64 + lane);
        const float* gt = WSP(float, WS_GATES) + (size_t)row * 16;
        const float li = gt[dir * 4 + h], lf = gt[8 + dir * 4 + h];
        const float pre = wave_incl_scan(lf, lane), tot = __shfl(pre, 63);
        const float B = dir == 0 ? pre : (tot - pre) + lf;
        const float a = li - B;
        float cm = a;
#pragma unroll
        for (int o = 1; o < 64; o <<= 1) { const float t = dir == 0 ? __shfl_up(cm, o) : __shfl_down(cm, o); const bool ok = dir == 0 ? (lane >= o) : (lane + o < 64); if (ok) cm = fmaxf(cm, t); }
        av[lane] = a; Mt[lane] = fmaxf(m_p, cm); Bt[lane] = B;
    }
    {
        float qq[16], kk[16], vv[16]; u32x4 cx[5];
        const bf16* Sg = WSP(bf16, WS_MLS) + (size_t)(seq * 36 + p) * 16512;
#pragma unroll
        for (int it = 0; it < 16; ++it) { const int idx = tid + NTHR * it, n = idx >> 7, d = idx & 127;
            const float* pr = P + (size_t)rowof(b, tc * 64 + n) * DINP + h * 128 + d; qq[it] = pr[PC_MLQ]; kk[it] = pr[PC_MLK]; vv[it] = pr[PC_MLV]; }
#pragma unroll
        for (int it = 0; it < 5; ++it) { const int idx = tid + NTHR * it, rr = idx >> 4, cc = idx & 15; cx[it] = (idx < 144 * 16 && rr < 129) ? *(const u32x4*)(Sg + rr * 128 + cc * 8) : (u32x4){0u, 0u, 0u, 0u}; }
#pragma unroll
        for (int it = 0; it < 16; ++it) { const int idx = tid + NTHR * it, n = idx >> 7, d = idx & 127;
            Qs[n * 136 + d] = (bf16)f2bf(qq[it]); Ksm[n * 136 + d] = (bf16)f2bf(kk[it]); VT[d * 72 + n] = (bf16)f2bf(vv[it]); }
#pragma unroll
        for (int it = 0; it < 5; ++it) { const int idx = tid + NTHR * it, rr = idx >> 4, cc = idx & 15; if (idx < 144 * 16) *(LAS u32x4*)(Cx + rr * 136 + cc * 8) = cx[it]; }
    }
    for (int idx = tid; idx < 16 * 64; idx += NTHR) { const int rr = idx >> 6, n = idx & 63; VT[(128 + rr) * 72 + n] = rr == 0 ? (bf16)0x3f80 : (bf16)0; }
    __syncthreads();
    for (int id = F.wave; id < 16; id += 8) { const int tt = id >> 2, st = id & 3;
        const bool skip = dir == 0 ? st > tt : st < tt;
        f32x4 acc = (f32x4){0.f, 0.f, 0.f, 0.f};
        if (!skip) acc = mma16<128>(Qs + tt * 16 * 136, 136, Ksm + st * 16 * 136, 136, lane, acc);
        const int s = st * 16 + (lane & 15); const float as = av[s];
#pragma unroll
        for (int i = 0; i < 4; ++i) { const int t = tt * 16 + 4 * (lane >> 4) + i; const bool ok = !skip && (dir == 0 ? s <= t : s >= t);
            SW[t * 72 + s] = (bf16)f2bf(ok ? acc[i] * QS * __expf(as - Mt[t]) : 0.f); } }
    __syncthreads();
    const int tt = F.wave & 3, d0 = F.wave < 4 ? 0 : 5, nd = F.wave < 4 ? 5 : 4;
    f32x4 val[5];
#pragma unroll
    for (int k = 0; k < 5; ++k) { val[k] = (f32x4){0.f, 0.f, 0.f, 0.f};
        if (k < nd) { const int dt = d0 + k;
            const f32x4 a1 = mma16<64>(SW + tt * 16 * 72, 72, VT + dt * 16 * 72, 72, lane, (f32x4){0.f, 0.f, 0.f, 0.f});
            const f32x4 a2 = mma16<128>(Qs + tt * 16 * 136, 136, Cx + dt * 16 * 136, 136, lane, (f32x4){0.f, 0.f, 0.f, 0.f});
#pragma unroll
            for (int i = 0; i < 4; ++i) { const int t = tt * 16 + 4 * (lane >> 4) + i; val[k][i] = a1[i] + a2[i] * QS * __expf(m_p - Mt[t]); }
            if (dt == 8 && (lane & 15) == 0) {
#pragma unroll
                for (int i = 0; i < 4; ++i) den[tt * 16 + 4 * (lane >> 4) + i] = val[k][i]; } } }
    __syncthreads();
    float* H = WSP(float, WS_HML) + (size_t)dir * MTOK * 512;
#pragma unroll
    for (int k = 0; k < 5; ++k) { const int dt = d0 + k; if (k < nd && dt < 8) {
#pragma unroll
        for (int i = 0; i < 4; ++i) { const int t = tt * 16 + 4 * (lane >> 4) + i;
            const float dn = fmaxf(fabsf(den[t]), __expf(-(Bt[t] + Mt[t])));
            H[(size_t)rowof(b, tc * 64 + t) * 512 + h * 128 + dt * 16 + (lane & 15)] = val[k][i] / dn; } } }
    __syncthreads();
}

DI void ss_c_unit(Frame& F, int l, int sq, int p) {
    const int b = sq >> 4, h = (sq >> 1) & 7, dir = sq & 1, g = h >> 2, tc = tc_of(dir, p), lane = F.lane, tid = F.tid;
    const bf16* XBC = WSP(bf16, WS_XBC);
    LAS bf16* Cm = (LAS bf16*)F.lds;
    LAS bf16* Bm = (LAS bf16*)(F.lds + 17408);
    LAS bf16* XT = (LAS bf16*)(F.lds + 34816);
    LAS bf16* Sx = (LAS bf16*)(F.lds + 44032);
    LAS bf16* W = (LAS bf16*)(F.lds + 61440);
    LAS float* cum = (LAS float*)(F.lds + 70656);
    LAS float* dtv = cum + 64;
    if (F.wave == 0) {
        const int row = rowof(b, tc * 64 + lane);
        const float dt = WSP(float, WS_DT)[(size_t)row * 16 + dir * 8 + h];
        const float A = -__expf(F.in[15][l * 16 + dir * 8 + h]);
        const float a = dt * A, pre = wave_incl_scan(a, lane), tot = __shfl(pre, 63);
        cum[lane] = dir == 0 ? pre : (tot - pre) + a; dtv[lane] = dt;
    }
    {
        u32x4 bb[2], cc_[2], sx[2]; bf16 xx[8];
        const bf16* Sg = WSP(bf16, WS_SSS) + (size_t)(sq * 36 + p) * 8192;
#pragma unroll
        for (int it = 0; it < 2; ++it) { const int idx = tid + NTHR * it, n = idx >> 4, cc = idx & 15; const bf16* xr = XBC + (size_t)rowof(b, tc * 64 + n) * 1024;
            bb[it] = *(const u32x4*)(xr + 512 + g * 128 + cc * 8); cc_[it] = *(const u32x4*)(xr + 768 + g * 128 + cc * 8); sx[it] = *(const u32x4*)(Sg + n * 128 + cc * 8); }
#pragma unroll
        for (int it = 0; it < 8; ++it) { const int idx = tid + NTHR * it, n = idx >> 6, pp = idx & 63; xx[it] = XBC[(size_t)rowof(b, tc * 64 + n) * 1024 + h * 64 + pp]; }
#pragma unroll
        for (int it = 0; it < 2; ++it) { const int idx = tid + NTHR * it, n = idx >> 4, cc = idx & 15;
            *(LAS u32x4*)(Bm + n * 136 + cc * 8) = bb[it]; *(LAS u32x4*)(Cm + n * 136 + cc * 8) = cc_[it]; *(LAS u32x4*)(Sx + n * 136 + cc * 8) = sx[it]; }
#pragma unroll
        for (int it = 0; it < 8; ++it) { const int idx = tid + NTHR * it, n = idx >> 6, pp = idx & 63; XT[pp * 72 + n] = xx[it]; }
    }
    __syncthreads();
    for (int id = F.wave; id < 16; id += 8) { const int tt = id >> 2, st = id & 3;
        const bool skip = dir == 0 ? st > tt : st < tt;
        f32x4 acc = (f32x4){0.f, 0.f, 0.f, 0.f};
        if (!skip) acc = mma16<128>(Cm + tt * 16 * 136, 136, Bm + st * 16 * 136, 136, lane, acc);
        const int s = st * 16 + (lane & 15); const float cs = cum[s], ds = dtv[s];
#pragma unroll
        for (int i = 0; i < 4; ++i) { const int t = tt * 16 + 4 * (lane >> 4) + i; const bool ok = !skip && (dir == 0 ? s <= t : s >= t);
            W[t * 72 + s] = (bf16)f2bf(ok ? acc[i] * __expf(cum[t] - cs) * ds : 0.f); } }
    __syncthreads();
    float* Y = WSP(float, WS_YSS) + (size_t)dir * MTOK * 512;
    for (int id = F.wave; id < 16; id += 8) { const int tt = id >> 2, pt = id & 3;
        const f32x4 a1 = mma16<64>(W + tt * 16 * 72, 72, XT + pt * 16 * 72, 72, lane, (f32x4){0.f, 0.f, 0.f, 0.f});
        const f32x4 a2 = mma16<128>(Cm + tt * 16 * 136, 136, Sx + pt * 16 * 136, 136, lane, (f32x4){0.f, 0.f, 0.f, 0.f});
#pragma unroll
        for (int i = 0; i < 4; ++i) { const int t = tt * 16 + 4 * (lane >> 4) + i;
            Y[(size_t)rowof(b, tc * 64 + t) * 512 + h * 64 + pt * 16 + (lane & 15)] = a1[i] + a2[i] * __expf(cum[t]); } }
    __syncthreads();
}

DI void m5_finish_phase(Frame& F, int l, int nrows) {
    const int gw = F.bid * NWAVES + F.wave, NGW = F.G * NWAVES, lane = F.lane;
    const float* P = WSP(float, WS_P); const float* H0 = WSP(float, WS_HML); const float* H1 = H0 + (size_t)MTOK * 512;
    const float* Y0 = WSP(float, WS_YSS); const float* Y1 = Y0 + (size_t)MTOK * 512; const bf16* XBC = WSP(bf16, WS_XBC);
    bf16* A2 = WSP(bf16, WS_A2);
    for (int row = gw; row < nrows; row += NGW) {
        const float* p = P + (size_t)row * DINP;
        float hv[8], ov[8], yv[8], zv[8]; bf16 xv[8];
#pragma unroll
        for (int u = 0; u < 8; ++u) { const int c = lane + 64 * u;
            hv[u] = H0[(size_t)row * 512 + c] + H1[(size_t)row * 512 + c]; ov[u] = p[PC_MLO + c];
            yv[u] = Y0[(size_t)row * 512 + c] + Y1[(size_t)row * 512 + c]; zv[u] = p[PC_Z + c]; xv[u] = XBC[(size_t)row * 1024 + c]; }
        const float* gn = F.in[11] + l * 512; const float* sn = F.in[17] + l * 512;
#pragma unroll
        for (int h = 0; h < 4; ++h) {
            const float v0 = hv[2 * h], v1 = hv[2 * h + 1]; const int c0 = h * 128 + lane, c1 = c0 + 64;
            const float rstd = 1.0f / sqrtf(wave_sum(v0 * v0 + v1 * v1) * (1.f / 128.f) + EPS);
            A2[(size_t)row * D + c0] = (bf16)f2bf(v0 * rstd * gn[c0] * sigmoidf_(ov[2 * h]));
            A2[(size_t)row * D + c1] = (bf16)f2bf(v1 * rstd * gn[c1] * sigmoidf_(ov[2 * h + 1]));
        }
        float y[8]; float ss = 0.f;
#pragma unroll
        for (int u = 0; u < 8; ++u) { float v = yv[u] + F.in[16][l * 8 + u] * bf2f(xv[u]); v *= siluf(zv[u]); y[u] = v; ss += v * v; }
        const float rstd = 1.0f / sqrtf(wave_sum(ss) * (1.f / 512.f) + EPS);
#pragma unroll
        for (int u = 0; u < 8; ++u) { const int c = lane + 64 * u; A2[(size_t)row * D + 512 + c] = (bf16)f2bf(y[u] * rstd * sn[c]); }
    }
}
#ifndef PROBE_MASK
#define PROBE_MASK 0ull
#endif
#define NREP(k) ((((unsigned long long)(PROBE_MASK) >> (k)) & 1ull) ? 2 : 1)
#ifndef UNIT_REP
#define UNIT_REP 0
#endif
#define UREP(i) for (int rp_ = 0; rp_ <= ((F.rep >> (i)) & 1); ++rp_)
#ifndef ONE_LAUNCH
#define ONE_LAUNCH 1
#endif
#define IN(k) (lo <= (k) && (k) < hi)
#define SEAM(k) do { if (ONE_LAUNCH && hi > (k) + 1) xcd_barrier(bar); } while (0)
#ifndef FILL_MASK
#define FILL_MASK 0x7fffffffull
#endif
#define FILL(k, work) do { if (ONE_LAUNCH) conv_fill(F, (k), (work)); } while (0)
#ifndef NCV_P
#define NCV_P 48
#define NCV_OUT 112
#define NCV_UP 24
#define NCV_DOWN 112
#endif
template <int l> DI void layer_phases(Frame& F, const XcdBarrier& bar, const int lo, const int hi) {
    LAS int* mtb = (LAS int*)(F.lds + RING_BYTES);
        const int pb = 1 + 16 * l;
        const bool wc = (l == 0);
        const int nrows = wc ? MTOK : MLAT;
        const float* modl = WSP(float, WS_MOD) + (size_t)l * 5 * D6;
        if (IN(pb + 0)) {
            if (l == 0) norm_phase<false>(F, l, F.in[0], F.in[2], F.in[6] + l * D, 0, MTOK);
            else norm_phase<false>(F, l, WSP(float, WS_X), WSP(float, WS_X) + (size_t)MLAT * D, F.in[6] + l * D, 0, MTOK);
            if (l == 1) conv_drain(F, CV_NQ1 - CV_NE); SEAM(pb + 0);
        }
        if (IN(pb + 1)) {
            const int ncv = ONE_LAUNCH ? NCV_P : 0, gw_ = F.G - ncv;
            if (F.bid < gw_) { pg8::Gemm g{WSP(bf16, WS_HN), WSP(bf16, WS_WIN) + (size_t)l * DINP * D, D, D}; pg8::StaticOrder S; S.init(MTOK / 256, DINP / 256, gw_, F.bid);
                EpiF32 E{WSP(float, WS_P), DINP};
                pg8::gemm_phase<EpiF32, pg8::StaticOrder>(F.lds, g, S, E); }
            FILL(pb + 1, F.bid >= gw_);
            SEAM(pb + 1);
        }
        if (IN(pb + 2)) {
            for (int u = F.bid; u < NB * 72; u += F.G) m1_prep_unit(F, l, u / 72, u % 72);
            SEAM(pb + 2);
        }
        if (IN(pb + 3)) {
            { pg8::Gemm g{WSP(bf16, WS_CQN), WSP(bf16, WS_WQB) + (size_t)l * 768 * 512, 512, 512}; pg8::StaticOrder S; S.init(MTOK / 256, 3, F.G, F.bid);
              EpiBf16 E{WSP(bf16, WS_QRAW), 768}; pg8::gemm_phase<EpiBf16, pg8::StaticOrder>(F.lds, g, S, E); }
            __syncthreads();
            { pg8::Gemm g{WSP(bf16, WS_CKVN), WSP(bf16, WS_WKVB) + (size_t)l * 1024 * 256, 256, 256}; pg8::StaticOrder S; S.init(MTOK / 256, 4, F.G, (F.bid + 128) % F.G);
              EpiBf16 E{WSP(bf16, WS_KVRAW), 1024}; pg8::gemm_phase<EpiBf16, pg8::StaticOrder>(F.lds, g, S, E); }
            __syncthreads();
            UREP(2) for (int u = F.bid; u < 1152; u += F.G) ml_a_unit(F, u / 36, u % 36);
            UREP(3) for (int v = (F.bid + 128) % F.G; v < 576; v += F.G) ss_a_unit(F, l, v / 144, (v / 72) & 1, (v % 72) >> 1, v & 1);
            SEAM(pb + 3);
        }
        if (IN(pb + 4)) {
            UREP(4) for (int u = F.bid; u < 256; u += F.G) {
                const int bh = u >> 4, qb = u & 15, b = bh >> 2, h = bh & 3;
                const int r0a = 2 * qb - 4 < 0 ? 0 : (2 * qb - 4 > 24 ? 24 : 2 * qb - 4), r0b = 2 * qb - 3 < 0 ? 0 : (2 * qb - 3 > 24 ? 24 : 2 * qb - 3);
                attn_unit2<128, true>(F, WSP(bf16, WS_QNA) + ((size_t)bh * TS + qb * 128) * 128, WSP(bf16, WS_KNA) + (size_t)bh * TS * 128, WSP(bf16, WS_VTNA) + (size_t)bh * 128 * TS,
                                     4, 32, r0b + 8 - r0a, r0a, 0.12751743082459868f,
                                     WSP(bf16, WS_A2) + (size_t)(b * TL + qb * 128) * D + 1536 + h * 128, 2 * qb, F.in[26] + (size_t)(l * 4 + h) * 15 * 31);
            }
            if (wc) UREP(5) for (int v = F.bid; v < 32; v += F.G) {
                const int bh2 = v >> 1, qc = v & 1, b2 = bh2 >> 2, h2 = bh2 & 3;
                attn_unit2<128, false>(F, WSP(bf16, WS_QNA) + ((size_t)bh2 * TS + TL + qc * 128) * 128, WSP(bf16, WS_KNA) + (size_t)bh2 * TS * 128, WSP(bf16, WS_VTNA) + (size_t)bh2 * 128 * TS,
                                      4, 32, 0, 0, 0.12751743082459868f, WSP(bf16, WS_A2) + (size_t)(MLAT + b2 * TC + qc * 128) * D + 1536 + h2 * 128, 0, nullptr);
            }
            UREP(6) for (int v = (F.bid + 32) % F.G; v < 128; v += F.G) ml_scan_unit(F, v >> 2, v & 3);
            UREP(7) for (int v = (F.bid + 96) % F.G; v < 128; v += F.G) ss_scan_unit(F, v >> 1, v & 1);
            UREP(8) for (int v = F.bid; v < 288; v += F.G) mla_post_unit(F, l, v / 72, v % 72);
            SEAM(pb + 4);
        }
        if (IN(pb + 5)) {
            const int p0 = wc ? 0 : 4, npp = 36 - p0;
            UREP(9) for (int u = F.bid; u < 256; u += F.G) { const int bh = u >> 4, qb = u & 15, b = bh >> 2, h = bh & 3;
                attn_unit2<192, false>(F, WSP(bf16, WS_QMLA) + ((size_t)bh * TS + qb * 128) * 192, WSP(bf16, WS_KMLA) + (size_t)bh * TS * 192, WSP(bf16, WS_VTMLA) + (size_t)bh * 128 * TS,
                                      36, 0, 0, 0, 0.10411754627862817f, WSP(bf16, WS_A2) + (size_t)(b * TL + qb * 128) * D + 1024 + h * 128, 0, nullptr); }
            if (wc) UREP(10) for (int v = F.bid; v < 32; v += F.G) { const int bh = v >> 1, qc = v & 1, b = bh >> 2, h = bh & 3;
                attn_unit2<192, false>(F, WSP(bf16, WS_QMLA) + ((size_t)bh * TS + TL + qc * 128) * 192, WSP(bf16, WS_KMLA) + (size_t)bh * TS * 192, WSP(bf16, WS_VTMLA) + (size_t)bh * 128 * TS,
                                      4, 32, 0, 0, 0.10411754627862817f, WSP(bf16, WS_A2) + (size_t)(MLAT + b * TC + qc * 128) * D + 1024 + h * 128, 0, nullptr); }
            UREP(11) for (int v = (F.bid + 32) % F.G; v < 32 * npp; v += F.G) ml_c_unit(F, v / npp, p0 + v % npp);
            UREP(12) for (int v = (F.bid + 160) % F.G; v < 64 * npp; v += F.G) ss_c_unit(F, l, v / npp, p0 + v % npp);
            SEAM(pb + 5);
        }
        if (IN(pb + 6)) { m5_finish_phase(F, l, nrows); SEAM(pb + 6); }
        if (IN(pb + 7)) {
            const int ncv = (ONE_LAUNCH && l == 0) ? NCV_OUT : 0, gw_ = F.G - ncv;
            if (F.bid < gw_) { pg8::Gemm g{WSP(bf16, WS_A2), WSP(bf16, WS_WOUT) + (size_t)l * D * D, D, D}; pg8::StaticOrder S; S.init(nrows / 256, D / 256, gw_, F.bid);
                EpiResid E{l == 0 ? F.in[0] : WSP(float, WS_X), l == 0 ? F.in[2] : WSP(float, WS_X) + (size_t)MLAT * D, WSP(float, WS_X), modl + 2 * D};
                pg8::gemm_phase<EpiResid, pg8::StaticOrder>(F.lds, g, S, E); }
            FILL(pb + 7, F.bid >= gw_);
            SEAM(pb + 7);
        }
        if (IN(pb + 8)) {
            if (l == 0) norm_phase<false>(F, l, WSP(float, WS_X), WSP(float, WS_X) + (size_t)MLAT * D, F.in[27] + l * D, 3 * D, nrows);
            else norm_phase<true>(F, l, WSP(float, WS_X), WSP(float, WS_X) + (size_t)MLAT * D, F.in[27] + l * D, 3 * D, nrows);
            SEAM(pb + 8);
        }
        if (l == 0) {
            if (IN(pb + 10)) {
                const int ncv = ONE_LAUNCH ? NCV_UP : 0, gw_ = F.G - ncv;
                if (F.bid < gw_) { pg8::Gemm g{WSP(bf16, WS_HN), WSP(bf16, WS_W13), D, D}; pg8::StaticOrder S; S.init(MTOK / 256, 2 * FF / 256, gw_, F.bid);
                    EpiSwiglu E{WSP(bf16, WS_G), FF}; pg8::gemm_phase<EpiSwiglu, pg8::StaticOrder>(F.lds, g, S, E); }
                FILL(pb + 10, F.bid >= gw_);
                SEAM(pb + 10);
            }
            if (IN(pb + 11)) {
                const int ncv = ONE_LAUNCH ? NCV_DOWN : 0, gw_ = F.G - ncv;
                if (F.bid < gw_) { pg8::Gemm g{WSP(bf16, WS_G), WSP(bf16, WS_W2), FF, FF}; pg8::StaticOrder S; S.init(MTOK / 256, D / 256, gw_, F.bid);
                    EpiResid E{WSP(float, WS_X), WSP(float, WS_X) + (size_t)MLAT * D, WSP(float, WS_X), modl + 5 * D};
                    pg8::gemm_phase<EpiResid, pg8::StaticOrder>(F.lds, g, S, E); }
                FILL(pb + 11, F.bid >= gw_);
                SEAM(pb + 11);
            }
        } else {
            if (IN(pb + 9)) { moe_gather_phase(F); conv_drain(F, CV_NDEF); SEAM(pb + 9); }
            if (IN(pb + 10)) {
                __syncthreads(); moe_tables(F, mtb, 2 * FE / 256);
                pg8::Gemm g{WSP(bf16, WS_XG), WSP(bf16, WS_MW13), D, D}; MoeOrder S{mtb, 2 * FE / 256, F.G, F.bid, 0, mtb[40], 1, 0};
                EpiSwiglu E{WSP(bf16, WS_G), FE}; pg8::gemm_phase<EpiSwiglu, MoeOrder>(F.lds, g, S, E);
                SEAM(pb + 10);
            }
            if (IN(pb + 11)) {
                __syncthreads(); moe_tables(F, mtb, D / 256);
                const int nun = mtb[40], nfull0 = (nun / F.G) * F.G, nt0 = nun - nfull0;
                const int SK = nt0 == 0 ? 1 : (nt0 <= 32 ? 8 : (nt0 <= 64 ? 4 : (nt0 <= 128 ? 2 : 1)));
                const int nfull = SK == 1 ? nun : nfull0, ntail = nun - nfull;
                { pg8::Gemm g{WSP(bf16, WS_G), WSP(bf16, WS_MW2), FE, FE}; MoeOrder S{mtb, D / 256, F.G, F.bid, 0, nfull, 1, 0};
                  EpiF32 E{WSP(float, WS_Y), D}; pg8::gemm_phase<EpiF32, MoeOrder>(F.lds, g, S, E); }
                if (ntail > 0) { __syncthreads();
                  pg8::Gemm g{WSP(bf16, WS_G), WSP(bf16, WS_MW2), FE / SK, FE}; MoeOrder S{mtb, D / 256, F.G, F.bid, nfull, ntail * SK, SK, FE / SK};
                  EpiPart E{WSP(float, WS_PART)}; pg8::gemm_phase<EpiPart, MoeOrder>(F.lds, g, S, E); }
                SEAM(pb + 11);
            }
            if (IN(pb + 12)) {
                __syncthreads(); moe_tables(F, mtb, D / 256);
                const int nun = mtb[40], nfull0 = (nun / F.G) * F.G, nt0 = nun - nfull0;
                const int SK = nt0 == 0 ? 1 : (nt0 <= 32 ? 8 : (nt0 <= 64 ? 4 : (nt0 <= 128 ? 2 : 1)));
                const int nfull = SK == 1 ? nun : nfull0, ntail = nun - nfull;
                for (int it = F.bid; it < ntail * 8; it += F.G) { const int t = it >> 3, cg = it & 7;
                    MoeOrder S{mtb, D / 256, 1, 0, nfull + t, 1, 1, 0}; pg8::Unit u; S.next(0, u);
                    if (SK == 8) splitk_reduce_f32<8>(WSP(float, WS_PART), t, cg, u, WSP(float, WS_Y), D);
                    else if (SK == 4) splitk_reduce_f32<4>(WSP(float, WS_PART), t, cg, u, WSP(float, WS_Y), D);
                    else splitk_reduce_f32<2>(WSP(float, WS_PART), t, cg, u, WSP(float, WS_Y), D); }
                SEAM(pb + 12);
            }
            if (IN(pb + 13)) { moe_combine_phase(F, l); }
        }
}
__global__ void __launch_bounds__(NTHR, 2) fwd_kernel(Args args) {
    extern __shared__ __attribute__((aligned(16))) unsigned char lds[];
    Frame F;
    F.lds = (LAS unsigned char*)lds; F.ws = args.ws; F.out = args.out;
#pragma unroll
    for (int i = 0; i < 35; ++i) F.in[i] = args.in[i];
    F.tid = threadIdx.x; F.lane = F.tid & 63; F.wave = __builtin_amdgcn_readfirstlane(F.tid >> 6); F.G = gridDim.x; F.bid = blockIdx.x; F.rep = args.rep;
    volatile LAS unsigned* MISC = (volatile LAS unsigned*)(F.lds + MISC_OFF);
    if (F.tid < 64) MISC[F.tid] = 0u;
    __syncthreads();
    XcdBarrier bar; bar.bar = WSP(unsigned, WS_CTL) + CW_BAR; bar.x = 0; bar.st = nullptr;
    if (ONE_LAUNCH) bar = xcd_barrier_post(WSP(unsigned, WS_CTL) + CW_BAR, MISC + 8);
    const int lo = args.ph_lo, hi = args.ph_hi;

    if (IN(0)) { p0_prologue(F); SEAM(0); }

    layer_phases<0>(F, bar, lo, hi);
    layer_phases<1>(F, bar, lo, hi);
#undef IN
#undef SEAM
}

extern "C" void kernel_launch(void* const* d_in, const int* in_sizes, int n_in, void* d_out, int out_size, void* d_ws, size_t ws_size, hipStream_t stream) {
    static int grid = 0;
    if (grid == 0) {
        if (n_in != 35 || out_size != MLAT * D || ws_size < WS_END) { fprintf(stderr, "kernel_launch: unexpected shapes (n_in %d out %d ws %zu need %zu)\n", n_in, out_size, ws_size, (size_t)WS_END); grid = -1; return; }
        int dev = 0, cus = 0, per_cu = 0;
        if (hipGetDevice(&dev) != hipSuccess || hipDeviceGetAttribute(&cus, hipDeviceAttributeMultiprocessorCount, dev) != hipSuccess) { grid = -1; return; }
        if (hipFuncSetAttribute((const void*)fwd_kernel, hipFuncAttributeMaxDynamicSharedMemorySize, LDS_BYTES) != hipSuccess) { fprintf(stderr, "kernel_launch: hipFuncSetAttribute failed\n"); grid = -1; return; }
        if (hipOccupancyMaxActiveBlocksPerMultiprocessor(&per_cu, (const void*)fwd_kernel, NTHR, LDS_BYTES) != hipSuccess || per_cu < 1) { fprintf(stderr, "kernel_launch: occupancy query says %d\n", per_cu); }
        (void)hipGetLastError();
        grid = cus;
    }
    if (grid < 0) return;
    (void)hipMemsetAsync((char*)d_ws + WS_CTL, 0, CTL_ZERO_BYTES, stream);
    Args a{};
    for (int i = 0; i < 35; ++i) a.in[i] = (const float*)d_in[i];
    a.out = (float*)d_out; a.ws = (unsigned char*)d_ws; a.rep = UNIT_REP;
#if ONE_LAUNCH
    a.ph_lo = 0; a.ph_hi = 64;
    hipLaunchKernelGGL(fwd_kernel, dim3(grid), dim3(NTHR), LDS_BYTES, stream, a);
#else
    static const int phases[] = {0, 1, 2, 3, 4, 5, 6, 7, 8, 9, 11, 12, 17, 18, 19, 20, 21, 22, 23, 24, 25, 26, 27, 28, 29, 30};
    for (int k = 0; k < (int)(sizeof(phases) / sizeof(phases[0])); ++k) {
        a.ph_lo = phases[k]; a.ph_hi = phases[k] + 1;
        for (int rp = 0; rp < NREP(phases[k]); ++rp) hipLaunchKernelGGL(fwd_kernel, dim3(grid), dim3(NTHR), LDS_BYTES, stream, a);
    }
#endif
}
```

```cpp
#define NCV_P 48
#define NCV_OUT 96
#define NCV_UP 24
#define NCV_DOWN 96
#define FILL_MASK 0x7fffffffull
#define PROBE_MASK (0ull)
#define ONE_LAUNCH 1
#define UNIT_REP 0
#include <hip/hip_runtime.h>
#include <cstdio>
#include <cstdint>

#define DI __device__ __forceinline__
#define LAS __attribute__((address_space(3)))
#define GAS __attribute__((address_space(1)))
typedef unsigned short bf16;
typedef short bf16x8 __attribute__((ext_vector_type(8)));
typedef float f32x4 __attribute__((ext_vector_type(4)));
typedef float f32x2 __attribute__((ext_vector_type(2)));
typedef unsigned u32x4 __attribute__((ext_vector_type(4)));
typedef unsigned u32x2 __attribute__((ext_vector_type(2)));

namespace pg8 {
constexpr int BM = 256, BK = 64, HALF = 128, HTB = HALF * BK * 2, STAGE_BYTES = 8 * HTB, NXCD = 8, WGM = 8;
__host__ __device__ __forceinline__ int lds_byte(int r, int c) { const int st = (r >> 4) * 2 + (c >> 5), rr = r & 15, cc = c & 31, ob = rr * 64 + cc * 2; return st * 1024 + (ob ^ (((ob >> 9) & 1) << 5)); }
__host__ __device__ __forceinline__ void stage_rc(int b, int& R, int& C) { const int st = b / 1024, sb = b % 1024, swz = sb ^ (((sb >> 9) & 1) << 5); R = (st >> 1) * 16 + swz / 64; C = (st & 1) * 32 + (swz % 64) / 2; }
__host__ __device__ __forceinline__ int perm32(int rho) { const int n = rho >> 4, i = rho & 15; return 8 * (i >> 2) + 4 * n + (i & 3); }

struct Unit { int pm, pn, pb, koff, aux; };
struct Gemm { const bf16* A; const bf16* Bt; int K, ld; };

DI int xcd_remap(int L, int nwg) { const int q = nwg / NXCD, r = nwg % NXCD, xcd = L % NXCD, off = L / NXCD; return (xcd < r ? xcd * (q + 1) : r * (q + 1) + (xcd - r) * q) + off; }

struct StaticOrder {
    int nM, nN, nwg, G, c;
    DI void init(int nM_, int nN_, int G_, int c_) { nM = nM_; nN = nN_; nwg = nM * nN; G = G_; c = c_; }
    DI bool next(int i, Unit& u) const {
        const long L = (long)i * G + c; if (L >= nwg) return false;
        const int wgid = xcd_remap((int)L, nwg);
        const int nig = WGM * nN, gid = wgid / nig, fm = gid * WGM, gsz = (nM - fm) < WGM ? (nM - fm) : WGM;
        u.pm = fm + ((wgid % nig) % gsz); u.pn = (wgid % nig) / gsz; u.pb = u.pn; u.koff = 0; u.aux = 0; return true;
    }
};

DI unsigned cvt_pk_bf16(float lo, float hi) { unsigned r; asm volatile("v_cvt_pk_bf16_f32 %0, %1, %2" : "=v"(r) : "v"(lo), "v"(hi)); return r; }

template <class Epi, class Sched, bool ALIGN_EPI = true>
DI void gemm_phase(LAS unsigned char* lds, const Gemm g, const Sched& S, const Epi& E) {
    const int tid = threadIdx.x, wid = __builtin_amdgcn_readfirstlane(tid >> 6), lane = tid & 63, wr = wid >> 2, wc = wid & 3, fr = lane & 15, fq = lane >> 4;
    const int K = g.K, nt = K / BK;
    unsigned voffA[2], voffB[2];
#pragma unroll
    for (int i = 0; i < 2; ++i) { int R, C; stage_rc(tid * 16 + i * 8192, R, C); const int Rb = Epi::PERM ? ((R & ~31) + perm32(R & 31)) : R;
        voffA[i] = (unsigned)(R * g.ld + C) * 2u; voffB[i] = (unsigned)(Rb * g.ld + C) * 2u; }
    const size_t kstep = (size_t)(BK * 2);
    const size_t hstep = (size_t)HALF * g.ld * 2;
    const size_t tstep = 2 * hstep;
    const unsigned ldsw = (unsigned)wid * 1024u;
    const int aoff = lds_byte(wr * 64 + fr, fq * 8), boff = lds_byte(wc * 32 + fr, fq * 8);
#define PG8_SA(b, h) (((b) * 2 + (h)) * HTB)
#define PG8_SB(b, h) ((4 + (b) * 2 + (h)) * HTB)
#define PG8_STAGE(bufoff, gbase, voff) do { _Pragma("unroll") for (int _i = 0; _i < 2; ++_i) \
        __builtin_amdgcn_global_load_lds((const unsigned*)((const char*)(gbase) + (voff)[_i]), (LAS unsigned*)(lds + (bufoff) + ldsw + _i * 8192), 16, 0, 0); } while (0)
#define PG8_LDA(dst, b, h) do { _Pragma("unroll") for (int m = 0; m < 4; ++m) _Pragma("unroll") for (int k = 0; k < 2; ++k) dst[m][k] = *(const LAS bf16x8*)(lds + PG8_SA(b, h) + aoff + m * 2048 + k * 1024); } while (0)
#define PG8_LDB(dst, b, h) do { _Pragma("unroll") for (int n = 0; n < 2; ++n) _Pragma("unroll") for (int k = 0; k < 2; ++k) dst[n][k] = *(const LAS bf16x8*)(lds + PG8_SB(b, h) + boff + n * 2048 + k * 1024); } while (0)
#define PG8_MMA(ai, bj, At, Bt) do { __builtin_amdgcn_s_setprio(1); _Pragma("unroll") for (int m = 0; m < 4; ++m) _Pragma("unroll") for (int n = 0; n < 2; ++n) _Pragma("unroll") for (int k = 0; k < 2; ++k) \
        acc[ai][bj][m][n] = __builtin_amdgcn_mfma_f32_16x16x32_bf16(Bt[n][k], At[m][k], acc[ai][bj][m][n], 0, 0, 0); __builtin_amdgcn_s_setprio(0); } while (0)
#define PG8_WAIT_V(n) asm volatile("s_waitcnt vmcnt(" #n ")" ::: "memory")
#define PG8_WAIT_L(n) asm volatile("s_waitcnt lgkmcnt(" #n ")" ::: "memory")
#define PG8_BAR __builtin_amdgcn_s_barrier()
#define PG8_SCHED __builtin_amdgcn_sched_barrier(0)
    Unit cur, nxt; int ui = 0;
    if (!S.next(0, cur)) return;
    f32x4 acc[2][2][4][2];
#pragma unroll
    for (int a = 0; a < 2; ++a)
#pragma unroll
        for (int b = 0; b < 2; ++b)
#pragma unroll
            for (int m = 0; m < 4; ++m)
#pragma unroll
                for (int n = 0; n < 2; ++n) acc[a][b][m][n] = (f32x4){0.f, 0.f, 0.f, 0.f};
    bf16x8 At[4][2], B0[2][2], B1[2][2];
    const char* cA = (const char*)g.A + (size_t)cur.pm * tstep + (size_t)cur.koff * 2; const char* cB = (const char*)g.Bt + (size_t)cur.pb * tstep + (size_t)cur.koff * 2;
    {
        PG8_STAGE(PG8_SB(0, 0), cB, voffB); PG8_STAGE(PG8_SB(0, 1), cB + hstep, voffB); PG8_STAGE(PG8_SA(0, 0), cA, voffA); PG8_STAGE(PG8_SA(0, 1), cA + hstep, voffA);
        if (wr == 1) PG8_BAR;
        PG8_WAIT_V(2); PG8_BAR;
        PG8_STAGE(PG8_SB(1, 0), cB + kstep, voffB); PG8_STAGE(PG8_SA(1, 0), cA + kstep, voffA); PG8_STAGE(PG8_SB(1, 1), cB + hstep + kstep, voffB);
        PG8_WAIT_V(6); PG8_BAR;
    }
    for (;;) {
        const bool has_next = S.next(ui + 1, nxt);
        const char* nA = has_next ? (const char*)g.A + (size_t)nxt.pm * tstep + (size_t)nxt.koff * 2 : cA; const char* nB = has_next ? (const char*)g.Bt + (size_t)nxt.pb * tstep + (size_t)nxt.koff * 2 : cB;
        for (int t = 0; t < nt; t += 2) {
            const bool last = (t == nt - 2);
            const char* a1 = cA + (size_t)(t + 1) * kstep;
            const char* a2 = last ? nA : cA + (size_t)(t + 2) * kstep; const char* b2 = last ? nB : cB + (size_t)(t + 2) * kstep;
            const char* a3 = a2 + kstep; const char* b3 = b2 + kstep;
            PG8_LDB(B0, 0, 0); PG8_LDB(B1, 0, 1); PG8_SCHED; PG8_LDA(At, 0, 0); PG8_STAGE(PG8_SA(1, 1), a1 + hstep, voffA);
            PG8_WAIT_V(8); PG8_WAIT_L(0); PG8_BAR; PG8_MMA(0, 0, At, B0); PG8_MMA(0, 1, At, B1); PG8_BAR; PG8_SCHED;
            PG8_LDA(At, 0, 1); PG8_STAGE(PG8_SB(0, 0), b2, voffB); PG8_STAGE(PG8_SB(0, 1), b2 + hstep, voffB); PG8_STAGE(PG8_SA(0, 0), a2, voffA);
            PG8_WAIT_V(8); PG8_WAIT_L(0); PG8_BAR; PG8_MMA(1, 0, At, B0); PG8_MMA(1, 1, At, B1); PG8_BAR; PG8_SCHED;
            PG8_LDB(B0, 1, 0); PG8_LDB(B1, 1, 1); PG8_SCHED; PG8_LDA(At, 1, 0); PG8_STAGE(PG8_SA(0, 1), a2 + hstep, voffA);
            PG8_WAIT_V(8); PG8_WAIT_L(0); PG8_BAR; PG8_MMA(0, 0, At, B0); PG8_MMA(0, 1, At, B1); PG8_BAR; PG8_SCHED;
            PG8_LDA(At, 1, 1); PG8_STAGE(PG8_SB(1, 0), b3, voffB); PG8_STAGE(PG8_SB(1, 1), b3 + hstep, voffB); PG8_STAGE(PG8_SA(1, 0), a3, voffA);
            PG8_WAIT_V(8); PG8_WAIT_L(0); PG8_BAR; PG8_MMA(1, 0, At, B0); PG8_MMA(1, 1, At, B1); PG8_BAR; PG8_SCHED;
        }
        if constexpr (ALIGN_EPI) { if (wr == 0) PG8_BAR; }
        E(acc, cur, wr, wc, fr, fq);
        if (!has_next) break;
#pragma unroll
        for (int a = 0; a < 2; ++a)
#pragma unroll
            for (int b = 0; b < 2; ++b)
#pragma unroll
                for (int m = 0; m < 4; ++m)
#pragma unroll
                    for (int n = 0; n < 2; ++n) acc[a][b][m][n] = (f32x4){0.f, 0.f, 0.f, 0.f};
        cur = nxt; cA = nA; cB = nB; ++ui;
        if constexpr (ALIGN_EPI) { if (wr == 1) PG8_BAR; }
    }
    PG8_WAIT_V(0);
    if constexpr (!ALIGN_EPI) { if (wr == 0) PG8_BAR; }
    PG8_BAR;
#undef PG8_SA
#undef PG8_SB
#undef PG8_STAGE
#undef PG8_LDA
#undef PG8_LDB
#undef PG8_MMA
#undef PG8_WAIT_V
#undef PG8_WAIT_L
#undef PG8_BAR
#undef PG8_SCHED
}
}
constexpr int D = 2048, NB = 4, TL = 2048, TC = 256, TS = TL + TC  ;
constexpr int MLAT = NB * TL  , MTOK = NB * (TL + TC)  ;
constexpr int DIN = 5824, DINP = 5888, D6 = 6 * D;
constexpr int FF = 5632, FE = 7168, NEXP = 8;
constexpr float EPS = 1e-6f;
constexpr int PC_MLQ = 0, PC_MLK = 512, PC_MLV = 1024, PC_MLO = 1536, PC_IG = 2048, PC_FG = 2056, PC_Z = 2064, PC_XBC = 2576, PC_DT = 3600,
              PC_CQ = 3616, PC_CKV = 4064, PC_KR = 4224, PC_NQ = 4288, PC_NK = 4800, PC_NV = 5312;
constexpr int NCHUNK = 36;
constexpr int MAXMT = 72;

constexpr size_t MiB = 1u << 20;
constexpr size_t WS_CTL = 0, CTL_ZERO_BYTES = 1 * MiB;
constexpr size_t WS_MOD = 1 * MiB;
constexpr size_t WS_WIN = 2 * MiB;
constexpr size_t WS_WOUT = WS_WIN + 46 * MiB;
constexpr size_t WS_WQB = WS_WOUT + 16 * MiB;
constexpr size_t WS_WKVB = WS_WQB + 2 * MiB;
constexpr size_t WS_W13 = WS_WKVB + 1 * MiB;
constexpr size_t WS_W2 = WS_W13 + 44 * MiB;
constexpr size_t WS_MW13 = WS_W2 + 22 * MiB;
constexpr size_t WS_MW2 = WS_MW13 + 448 * MiB;
constexpr size_t WS_HN = WS_MW2 + 224 * MiB;
constexpr size_t WS_A2 = WS_HN + 36 * MiB;
constexpr size_t WS_X = WS_A2 + 36 * MiB;
constexpr size_t WS_BIG = WS_X + 72 * MiB;
constexpr size_t WS_P = WS_BIG;
constexpr size_t WS_GRAW = WS_BIG + 104 * MiB;
constexpr size_t WS_CQN = WS_P + 207 * MiB;
constexpr size_t WS_CKVN = WS_CQN + 9 * MiB;
constexpr size_t WS_QRAW = WS_CKVN + 5 * MiB;
constexpr size_t WS_KVRAW = WS_QRAW + 14 * MiB;
constexpr size_t WS_QMLA = WS_KVRAW + 18 * MiB;
constexpr size_t WS_KMLA = WS_QMLA + 14 * MiB;
constexpr size_t WS_VTMLA = WS_KMLA + 14 * MiB;
constexpr size_t WS_QNA = WS_VTMLA + 9 * MiB;
constexpr size_t WS_KNA = WS_QNA + 9 * MiB;
constexpr size_t WS_VTNA = WS_KNA + 9 * MiB;
constexpr size_t WS_XBC = WS_VTNA + 9 * MiB;
constexpr size_t WS_DT = WS_XBC + 18 * MiB;
constexpr size_t WS_GATES = WS_DT + 1 * MiB;
constexpr size_t WS_MLSC = WS_GATES + 1 * MiB;
constexpr size_t WS_SSSC = WS_MLSC + 64 * 1024;
constexpr size_t WS_MLU = WS_MLSC + 1 * MiB;
constexpr size_t WS_MLS = WS_MLU + 73 * MiB;
constexpr size_t WS_SSU = WS_MLS + 37 * MiB;
constexpr size_t WS_SSS = WS_SSU + 72 * MiB;
constexpr size_t WS_HML = WS_SSS + 36 * MiB;
constexpr size_t WS_YSS = WS_HML + 36 * MiB;
constexpr size_t WS_MIXEND = WS_YSS + 36 * MiB;
constexpr size_t WS_G = WS_BIG;
constexpr size_t WS_Y = WS_G + 252 * MiB;
constexpr size_t WS_XG = WS_Y + 144 * MiB;
constexpr size_t WS_TOK = WS_XG + 72 * MiB;
constexpr size_t WS_PART = WS_TOK + 1 * MiB;
constexpr size_t WS_FFNEND = WS_PART + 64 * MiB;
constexpr size_t WS_END = (WS_MIXEND > WS_FFNEND ? WS_MIXEND : WS_FFNEND);
static_assert(WS_END < (size_t)1800 * MiB, "workspace budget");
static_assert((size_t)MTOK * DINP * 4 <= 207 * MiB && (size_t)32 * 36 * 129 * 128 * 4 <= 73 * MiB, "sizes");
constexpr int CW_BAR = 4096;
constexpr int CW_MOE = 16384;
constexpr int CW_QH = 20480;
constexpr int CW_ARR = 32768;

constexpr int RING_BYTES = 131072;
constexpr int MISC_OFF = 147456 - 256;
constexpr int LDS_BYTES = 147456;
constexpr int NWAVES = 8, NTHR = 512;

#define RLX_AGENT __ATOMIC_RELAXED, __HIP_MEMORY_SCOPE_AGENT
#define LDS_WAIT() asm volatile("s_waitcnt lgkmcnt(0)" ::: "memory")
#define VM_WAIT() asm volatile("s_waitcnt vmcnt(0)" ::: "memory")
DI unsigned f2bf(float f) { unsigned u = __builtin_bit_cast(unsigned, f); return (u + 0x7fffu + ((u >> 16) & 1u)) >> 16; }
DI unsigned pk2(float lo, float hi) { return f2bf(lo) | (f2bf(hi) << 16); }
DI float bf2f(unsigned b) { return __builtin_bit_cast(float, b << 16); }
DI float wave_sum(float v) {
#pragma unroll
    for (int o = 1; o < 64; o <<= 1) v += __shfl_xor(v, o);
    return v;
}
DI float wave_max(float v) {
#pragma unroll
    for (int o = 1; o < 64; o <<= 1) v = fmaxf(v, __shfl_xor(v, o));
    return v;
}
DI float wave_incl_scan(float v, int lane) {
#pragma unroll
    for (int o = 1; o < 64; o <<= 1) { const float t = __shfl_up(v, o); if (lane >= o) v += t; }
    return v;
}
DI float siluf(float x) { return x / (1.f + __expf(-x)); }
DI float sigmoidf_(float x) { return 1.f / (1.f + __expf(-x)); }
DI float softplusf_(float x) { return fmaxf(x, 0.f) + log1pf(__expf(-fabsf(x))); }
DI float logsigmoidf_(float x) { return fminf(x, 0.f) - log1pf(__expf(-fabsf(x))); }

#define XB_TMO      128
#define XB_XCNT(j)  (256  + 64 * (j))
#define XB_XSUB(j)  (1280 + 64 * (j))
#define XB_XGEN(j)  (2304 + 64 * (j))
#define XB_TOP      3328
#define XB_TOPGEN   3392
#define XCD_BAR_WORDS 3456
#define XB_SPIN_CAP (1u << 22)
DI unsigned xb_ld(unsigned* p)              { return __hip_atomic_load(p, __ATOMIC_RELAXED, __HIP_MEMORY_SCOPE_AGENT); }
DI unsigned xb_add(unsigned* p, unsigned v) { return __hip_atomic_fetch_add(p, v, __ATOMIC_RELAXED, __HIP_MEMORY_SCOPE_AGENT); }
DI unsigned xb_xcc_id() { return (unsigned)__builtin_amdgcn_s_getreg((3 << 11) | 20) & 0xFu; }
#define XB_SPIN(cond, bar) do { unsigned _sp = 0; while (cond) { __builtin_amdgcn_s_sleep(1); \
    if ((++_sp & 255u) == 0u) { if (xb_ld(&(bar)[XB_TMO])) break; if (_sp > XB_SPIN_CAP) { atomicAdd(&(bar)[XB_TMO], 1u); break; } } } } while (0)
struct XcdBarrier { unsigned* bar; unsigned x; volatile LAS unsigned* st; };
DI XcdBarrier xcd_barrier_post(unsigned* bar, volatile LAS unsigned* st) {
    XcdBarrier b; b.bar = bar; b.x = xb_xcc_id(); b.st = st;
    if (threadIdx.x == 0) (void)xb_add(&bar[XB_XCNT(b.x)], 1u);
    return b;
}
DI void xcd_barrier_complete(unsigned* bar, unsigned x, unsigned& nloc, unsigned& nx) {
    const unsigned G = gridDim.x * gridDim.y * gridDim.z;
    unsigned sum, cnt, mine, sp = 0u;
    for (;;) {
        sum = 0u; cnt = 0u; mine = 0u;
#pragma unroll
        for (unsigned j = 0; j < 16; ++j) { const unsigned c = xb_ld(&bar[XB_XCNT(j)]); sum += c; cnt += (c > 0u) ? 1u : 0u; mine = (j == x) ? c : mine; }
        if (sum == G) break;
        __builtin_amdgcn_s_sleep(1);
        if ((++sp & 255u) == 0u) { if (xb_ld(&bar[XB_TMO])) break; if (sp > XB_SPIN_CAP) { atomicAdd(&bar[XB_TMO], 1u); break; } }
    }
    nloc = mine > 0u ? mine : 1u; nx = cnt > 0u ? cnt : 1u;
}
DI void xcd_barrier(const XcdBarrier& b) {
    asm volatile("s_waitcnt vmcnt(0)" ::: "memory");
    __syncthreads();
    if (threadIdx.x == 0) {
        unsigned* bar = b.bar;
        __builtin_amdgcn_s_waitcnt(0);
        unsigned nloc = b.st[0], nx = b.st[1];
        if (nloc == 0u) { xcd_barrier_complete(bar, b.x, nloc, nx); b.st[0] = nloc; b.st[1] = nx; }
        const unsigned old = xb_add(&bar[XB_XSUB(b.x)], 1u);
        const unsigned gen = old / nloc;
        if (old + 1u == (gen + 1u) * nloc) {
            __builtin_amdgcn_fence(__ATOMIC_RELEASE, "agent");
            asm volatile("s_waitcnt vmcnt(0)" ::: "memory");
            const unsigned og = xb_add(&bar[XB_TOP], 1u);
            const unsigned tg = og / nx;
            if (og + 1u == (tg + 1u) * nx) xb_add(&bar[XB_TOPGEN], 1u);
            else XB_SPIN(xb_ld(&bar[XB_TOPGEN]) == tg, bar);
            __builtin_amdgcn_fence(__ATOMIC_ACQUIRE, "agent");
            xb_add(&bar[XB_XGEN(b.x)], 1u);
            asm volatile("s_waitcnt vmcnt(0)" ::: "memory");
        } else {
            XB_SPIN(xb_ld(&bar[XB_XGEN(b.x)]) == gen, bar);
            __builtin_amdgcn_fence(__ATOMIC_ACQUIRE, "agent");
            asm volatile("s_waitcnt vmcnt(0)" ::: "memory");
        }
    }
    __syncthreads();
}

struct Args { const float* in[35]; float* out; unsigned char* ws; int ph_lo, ph_hi, rep, pad; };
struct Frame {
    LAS unsigned char* lds;
    unsigned char* ws;
    const float* in[35];
    float* out;
    int tid, lane, wave, G, bid, rep;
};
#define WSP(T, off) ((T*)(F.ws + (off)))
DI int rowof(int b, int j) { return j < TL ? b * TL + j : MLAT + b * TC + (j - TL); }

template <int K> DI f32x4 mma16(const LAS bf16* A, int lda, const LAS bf16* Bt, int ldb, int lane, f32x4 acc) {
    const int r = lane & 15, q = lane >> 4;
    const LAS bf16* pa = A + r * lda + 8 * q; const LAS bf16* pb = Bt + r * ldb + 8 * q;
#pragma unroll
    for (int k = 0; k < K; k += 32) {
        const bf16x8 a = *(const LAS bf16x8*)(pa + k); const bf16x8 b = *(const LAS bf16x8*)(pb + k);
        acc = __builtin_amdgcn_mfma_f32_16x16x32_bf16(a, b, acc, 0, 0, 0);
    }
    return acc;
}
struct CvDesc { const float* src; bf16* dst; size_t ld, Kd; int Kv, Nv, k0, n0, dn0; };
DI void tr_load(const CvDesc& d, f32x4 (&v)[16], int lane) {
    const int nn = 4 * (lane & 15), kq = lane >> 4;
#pragma unroll
    for (int i = 0; i < 16; ++i) { const int kk = 4 * i + kq;
        v[i] = (f32x4){0.f, 0.f, 0.f, 0.f};
        if (d.k0 + kk < d.Kv && d.n0 + nn < d.Nv) v[i] = __builtin_nontemporal_load((const f32x4*)(d.src + (size_t)(d.k0 + kk) * d.ld + d.n0 + nn)); }
}
DI void tr_lds(const f32x4 (&v)[16], LAS float* scr, int lane) {
    const int nn = 4 * (lane & 15), kq = lane >> 4;
#pragma unroll
    for (int i = 0; i < 16; ++i) { const int kk = 4 * i + kq; LAS float* s = scr + kk * 65 + nn; s[0] = v[i][0]; s[1] = v[i][1]; s[2] = v[i][2]; s[3] = v[i][3]; }
    LDS_WAIT(); asm volatile("" ::: "memory");
}
DI void tr_out(const CvDesc& d, LAS float* scr, int lane) {
    const int c = lane & 7;
#pragma unroll
    for (int j = 0; j < 8; ++j) { const int n = (lane >> 3) + 8 * j; const LAS float* s = scr + (8 * c) * 65 + n;
        u32x4 o; o.x = pk2(s[0 * 65], s[1 * 65]); o.y = pk2(s[2 * 65], s[3 * 65]); o.z = pk2(s[4 * 65], s[5 * 65]); o.w = pk2(s[6 * 65], s[7 * 65]);
        *(u32x4*)(d.dst + (size_t)(d.dn0 + n) * d.Kd + d.k0 + 8 * c) = o; }
    LDS_WAIT(); asm volatile("" ::: "memory");
}
DI int il_row(int n0, int which) { return (n0 >> 7) * 256 + (n0 & 127) + which * 128; }

constexpr int I_IN = 32 * 92, I_OUT = 32 * 32, I_QB = 8 * 12, I_KVB = 4 * 16, I_F1 = 32 * 88, I_F2 = 88 * 32, I_M1 = 32 * 112, I_M2 = 112 * 32;
constexpr int I_L = I_IN + I_OUT + I_QB + I_KVB;
constexpr int CV_NE = I_L + 2 * I_F1 + I_F2, CV_NQ1 = CV_NE + I_L, CV_NALL = CV_NQ1 + NEXP * (2 * I_M1 + I_M2);
DI CvDesc conv_decode(Frame& F, int it) {
    int r = it;
    if (r >= CV_NQ1) { r -= CV_NQ1;
        if (r < NEXP * 2 * I_M1) { const int e = r / (2 * I_M1); r -= e * 2 * I_M1; const int which = r / I_M1; r -= which * I_M1; const int kb = r / 112, nb = r % 112;
            return CvDesc{(which ? F.in[33] : F.in[32]) + (size_t)e * D * FE, WSP(bf16, WS_MW13) + (size_t)e * 2 * FE * D, (size_t)(FE), (size_t)(D), D, FE, 64 * kb, 64 * nb, il_row(64 * nb, which)}; }
        r -= NEXP * 2 * I_M1;
        { const int e = r / I_M2; r -= e * I_M2; const int kb = r / 32, nb = r % 32;
            return CvDesc{F.in[34] + (size_t)e * FE * D, WSP(bf16, WS_MW2) + (size_t)e * D * FE, (size_t)(D), (size_t)(FE), FE, D, 64 * kb, 64 * nb, 64 * nb}; }
    }
    int l = 0;
    if (r >= CV_NE) { r -= CV_NE; l = 1; }
    else if (r >= I_L) { r -= I_L;
        if (r < 2 * I_F1) { const int which = r / I_F1; r -= which * I_F1; const int kb = r / 88, nb = r % 88;
            return CvDesc{(which ? F.in[29] : F.in[28]), WSP(bf16, WS_W13), (size_t)(FF), (size_t)(D), D, FF, 64 * kb, 64 * nb, il_row(64 * nb, which)}; }
        r -= 2 * I_F1;
        { const int kb = r / 32, nb = r % 32; return CvDesc{F.in[30], WSP(bf16, WS_W2), (size_t)(D), (size_t)(FF), FF, D, 64 * kb, 64 * nb, 64 * nb}; }
    }
    if (r < I_IN) { const int kb = r / 92, nb = r % 92;
        return CvDesc{F.in[7] + (size_t)l * D * DIN, WSP(bf16, WS_WIN) + (size_t)l * DINP * D, (size_t)(DIN), (size_t)(D), D, DIN, 64 * kb, 64 * nb, 64 * nb}; }
    r -= I_IN;
    if (r < I_OUT) { const int kb = r / 32, nb = r % 32;
        return CvDesc{F.in[8] + (size_t)l * D * D, WSP(bf16, WS_WOUT) + (size_t)l * D * D, (size_t)(D), (size_t)(D), D, D, 64 * kb, 64 * nb, 64 * nb}; }
    r -= I_OUT;
    if (r < I_QB) { const int kb = r / 12, nb = r % 12;
        return CvDesc{F.in[19] + (size_t)l * 448 * 768, WSP(bf16, WS_WQB) + (size_t)l * 768 * 512, (size_t)(768), (size_t)(512), 448, 768, 64 * kb, 64 * nb, 64 * nb}; }
    r -= I_QB;
    { const int kb = r / 16, nb = r % 16;
        return CvDesc{F.in[21] + (size_t)l * 160 * 1024, WSP(bf16, WS_WKVB) + (size_t)l * 1024 * 256, (size_t)(1024), (size_t)(256), 160, 1024, 64 * kb, 64 * nb, 64 * nb}; }
}

DI void conv_item(Frame& F, int it, LAS float* scr) { const CvDesc d = conv_decode(F, it); f32x4 v[16]; tr_load(d, v, F.lane); tr_lds(v, scr, F.lane); tr_out(d, scr, F.lane); }
DI void conv_items(Frame& F, int it0, int n, LAS float* scr) {
    if (it0 >= CV_NALL) return;
    if (it0 + n > CV_NALL) n = CV_NALL - it0;
    CvDesc d = conv_decode(F, it0); f32x4 v[16]; tr_load(d, v, F.lane);
    for (int k = 0; k < n; ++k) {
        tr_lds(v, scr, F.lane);
        CvDesc dn = d;
        if (k + 1 < n) { dn = conv_decode(F, it0 + k + 1); tr_load(dn, v, F.lane); }
        tr_out(d, scr, F.lane);
        d = dn;
    }
}
DI void p0_prologue(Frame& F) {
    {
        LAS float* sc = (LAS float*)F.lds;
        LAS float* red = (LAS float*)(F.lds + 5 * 2048 * 4);
        bool have = false;
        for (int u = F.bid; u < 2 * 96; u += F.G) {
            if (!have) {
                for (int i = F.tid; i < 5 * 2048; i += NTHR) { const float x = (i < 4 * 2048) ? F.in[1][i] : F.in[3][i - 4 * 2048]; sc[i] = siluf(x); }
                have = true;
            }
            __syncthreads();
            const int l = u / 96, j0 = (u % 96) * 128;
            const float* W = F.in[4] + (size_t)l * D * D6 + j0 + 2 * F.lane;
            f32x2 acc[5];
#pragma unroll
            for (int r = 0; r < 5; ++r) acc[r] = (f32x2){0.f, 0.f};
            const int kb = F.wave * 256;
            for (int k = 0; k < 256; k += 8) {
                f32x2 w[8];
#pragma unroll
                for (int i = 0; i < 8; ++i) w[i] = *(const f32x2*)(W + (size_t)(kb + k + i) * D6);
#pragma unroll
                for (int i = 0; i < 8; ++i)
#pragma unroll
                    for (int r = 0; r < 5; ++r) { const float s = sc[r * 2048 + kb + k + i]; acc[r] += w[i] * s; }
            }
#pragma unroll
            for (int r = 0; r < 5; ++r) { red[(F.wave * 5 + r) * 128 + 2 * F.lane] = acc[r][0]; red[(F.wave * 5 + r) * 128 + 2 * F.lane + 1] = acc[r][1]; }
            __syncthreads();
            for (int i = F.tid; i < 5 * 128; i += NTHR) { const int r = i / 128, j = i % 128; float s = F.in[5][l * D6 + j0 + j];
#pragma unroll
                for (int w = 0; w < 8; ++w) s += red[(w * 5 + r) * 128 + j];
                WSP(float, WS_MOD)[(l * 5 + r) * D6 + j0 + j] = s; }
        }
        __syncthreads();
    }
    LAS float* scr = (LAS float*)(F.lds + F.wave * 16640);
    const int gw = F.bid * NWAVES + F.wave, NGW = F.G * NWAVES;
    for (int it = gw; it < I_L; it += NGW) conv_item(F, it, scr);
}

constexpr int CV_EAGER = I_L;
constexpr int CV_NDEF = CV_NALL - CV_EAGER;
DI void conv_fill(Frame& F, int phase, bool work) {
    LAS float* scr = (LAS float*)(F.lds + F.wave * 16640);
    volatile LAS int* bc = (volatile LAS int*)(F.lds + MISC_OFF) + 16;
    unsigned* ctl = WSP(unsigned, WS_CTL);
    __syncthreads();
    if (F.tid == 0) __hip_atomic_fetch_add(ctl + CW_ARR + 64 * phase, 1u, RLX_AGENT);
    if (!work) return;
    for (;;) {
        if (F.tid == 0) {
            int base = -1;
            if (__hip_atomic_load(ctl + CW_ARR + 64 * phase, RLX_AGENT) < (unsigned)F.G) { base = (int)__hip_atomic_fetch_add(ctl + CW_QH, 32u, RLX_AGENT); if (base >= CV_NDEF) base = -1; }
            bc[0] = base;
        }
        __syncthreads();
        const int base = bc[0];
        __syncthreads();
        if (base < 0) break;
        conv_items(F, CV_EAGER + base + F.wave * 4, 4, scr);
    }
}
DI void conv_drain(Frame& F, int upto) {
    LAS float* scr = (LAS float*)(F.lds + F.wave * 16640);
    volatile LAS int* bc = (volatile LAS int*)(F.lds + MISC_OFF) + 16;
    unsigned* ctl = WSP(unsigned, WS_CTL);
    __syncthreads();
    for (;;) {
        if (F.tid == 0) {
            int base = -1;
            if ((int)__hip_atomic_load(ctl + CW_QH, RLX_AGENT) < upto) { base = (int)__hip_atomic_fetch_add(ctl + CW_QH, 64u, RLX_AGENT); if (base >= CV_NDEF) base = -1; }
            bc[0] = base;
        }
        __syncthreads();
        const int base = bc[0];
        __syncthreads();
        if (base < 0) break;
        conv_items(F, CV_EAGER + base + F.wave * 8, 8, scr);
    }
}
template <bool ROUTE>
DI void norm_phase(Frame& F, int l, const float* srcLat, const float* srcCtx, const float* g, int shoff, int nrows) {
    LAS float* rl = (LAS float*)F.lds;
    if (ROUTE) { for (int i = F.tid; i < D * NEXP; i += NTHR) rl[i] = F.in[31][i]; __syncthreads(); }
    const int gw = F.bid * NWAVES + F.wave, NGW = F.G * NWAVES;
    bf16* HN = WSP(bf16, WS_HN);
    for (int row = gw; row < nrows; row += NGW) {
        const float* xr = row < MLAT ? srcLat + (size_t)row * D : srcCtx + (size_t)(row - MLAT) * D;
        const int br = row < MLAT ? row / TL : 4;
        const float* mrow = WSP(float, WS_MOD) + (size_t)(l * 5 + br) * D6 + shoff;
        f32x4 v[8]; float ss = 0.f;
#pragma unroll
        for (int j = 0; j < 8; ++j) { v[j] = *(const f32x4*)(xr + 4 * F.lane + 256 * j); ss += (v[j][0] * v[j][0] + v[j][1] * v[j][1]) + (v[j][2] * v[j][2] + v[j][3] * v[j][3]); }
        const float rstd = 1.0f / sqrtf(wave_sum(ss) * (1.f / D) + EPS);
        float lg[8];
        if (ROUTE) {
#pragma unroll
            for (int e = 0; e < 8; ++e) lg[e] = 0.f; }
#pragma unroll
        for (int j = 0; j < 8; ++j) { const int c = 4 * F.lane + 256 * j;
            const f32x4 gg = *(const f32x4*)(g + c), sh = *(const f32x4*)(mrow + c), sc = *(const f32x4*)(mrow + D + c);
            f32x4 o;
#pragma unroll
            for (int i = 0; i < 4; ++i) o[i] = v[j][i] * rstd * gg[i] * (1.f + sc[i]) + sh[i];
            u32x2 w; w.x = pk2(o[0], o[1]); w.y = pk2(o[2], o[3]);
            *(u32x2*)(HN + (size_t)row * D + c) = w;
            if (ROUTE) {
#pragma unroll
                for (int i = 0; i < 4; ++i) { const f32x4 r0 = *(const LAS f32x4*)(rl + (c + i) * 8), r1 = *(const LAS f32x4*)(rl + (c + i) * 8 + 4);
                    lg[0] += o[i] * r0[0]; lg[1] += o[i] * r0[1]; lg[2] += o[i] * r0[2]; lg[3] += o[i] * r0[3];
                    lg[4] += o[i] * r1[0]; lg[5] += o[i] * r1[1]; lg[6] += o[i] * r1[2]; lg[7] += o[i] * r1[3]; }
                __builtin_amdgcn_sched_barrier(0);
            }
        }
        if (ROUTE) {
#pragma unroll
            for (int e = 0; e < 8; ++e) lg[e] = wave_sum(lg[e]);
            if (F.lane == 0) {
                int e1 = 0; float v1 = lg[0];
#pragma unroll
                for (int e = 1; e < 8; ++e) if (lg[e] > v1) { v1 = lg[e]; e1 = e; }
                int e2 = -1; float v2 = -3.0e38f;
#pragma unroll
                for (int e = 0; e < 8; ++e) if (e != e1 && lg[e] > v2) { v2 = lg[e]; e2 = e; }
                const float g2 = 1.f / (1.f + expf(v1 - v2)), g1 = 1.f - g2;
                unsigned* cnt = WSP(unsigned, WS_CTL) + CW_MOE;
                const unsigned p1 = __hip_atomic_fetch_add(cnt + e1, 1u, RLX_AGENT), p2 = __hip_atomic_fetch_add(cnt + e2, 1u, RLX_AGENT);
                int* tk = WSP(int, WS_TOK) + (size_t)row * 8;
                tk[0] = e1; tk[1] = (int)p1; tk[2] = e2; tk[3] = (int)p2; ((float*)tk)[4] = g1; ((float*)tk)[5] = g2;
            }
        }
    }
}

DI void moe_tables(Frame& F, LAS int* tb, int NT) {
    if (F.tid == 0) {
        const unsigned* cnt = WSP(unsigned, WS_CTL) + CW_MOE; int ts = 0, us = 0;
        for (int e = 0; e < 8; ++e) { const int c = (int)__hip_atomic_load(cnt + e, RLX_AGENT); const int t = (c + 255) >> 8; tb[e] = c; tb[8 + e] = t; tb[16 + e] = ts; tb[32 + e] = us; ts += t; us += t * NT; }
        tb[24] = ts; tb[40] = us;
    }
    __syncthreads();
}
DI void moe_gather_phase(Frame& F) {
    LAS int* tb = (LAS int*)F.lds; moe_tables(F, tb, 1);
    const int gw = F.bid * NWAVES + F.wave, NGW = F.G * NWAVES;
    const bf16* HN = WSP(bf16, WS_HN); bf16* XG = WSP(bf16, WS_XG);
    for (int row = gw; row < MLAT; row += NGW) {
        int* tk = WSP(int, WS_TOK) + (size_t)row * 8;
        const int e1 = tk[0], p1 = tk[1], e2 = tk[2], p2 = tk[3];
        const int s1 = tb[16 + e1] * 256 + p1, s2 = tb[16 + e2] * 256 + p2;
        const u32x4* src = (const u32x4*)(HN + (size_t)row * D) + F.lane;
        u32x4 a[4];
#pragma unroll
        for (int j = 0; j < 4; ++j) a[j] = src[64 * j];
        u32x4* d1 = (u32x4*)(XG + (size_t)s1 * D) + F.lane; u32x4* d2 = (u32x4*)(XG + (size_t)s2 * D) + F.lane;
#pragma unroll
        for (int j = 0; j < 4; ++j) { d1[64 * j] = a[j]; d2[64 * j] = a[j]; }
        if (F.lane == 0) { tk[6] = s1; tk[7] = s2; }
    }
    const int nrow = tb[24] * 256;
    for (int r = gw; r < nrow; r += NGW) {
        const int t = r >> 8; int e = 0;
#pragma unroll
        for (int k = 1; k < 8; ++k) if (t >= tb[16 + k]) e = k;
        const int local = r - tb[16 + e] * 256;
        if (local >= tb[e]) { u32x4* d = (u32x4*)(XG + (size_t)r * D) + F.lane; const u32x4 z = (u32x4){0u, 0u, 0u, 0u};
#pragma unroll
            for (int j = 0; j < 4; ++j) d[64 * j] = z; }
    }
}
DI void moe_combine_phase(Frame& F, int l) {
    const int gw = F.bid * NWAVES + F.wave, NGW = F.G * NWAVES;
    const float* Y = WSP(float, WS_Y); const float* X = WSP(float, WS_X);
    for (int row = gw; row < MLAT; row += NGW) {
        const int* tk = WSP(int, WS_TOK) + (size_t)row * 8;
        const float g1 = ((const float*)tk)[4], g2 = ((const float*)tk)[5]; const int s1 = tk[6], s2 = tk[7];
        const float* mrow = WSP(float, WS_MOD) + (size_t)(l * 5 + row / TL) * D6 + 5 * D;
        f32x4 xv[8], y1[8], y2[8];
#pragma unroll
        for (int j = 0; j < 8; ++j) { const int c = 4 * F.lane + 256 * j;
            xv[j] = *(const f32x4*)(X + (size_t)row * D + c); y1[j] = *(const f32x4*)(Y + (size_t)s1 * D + c); y2[j] = *(const f32x4*)(Y + (size_t)s2 * D + c); }
#pragma unroll
        for (int j = 0; j < 8; ++j) { const int c = 4 * F.lane + 256 * j; const f32x4 gg = *(const f32x4*)(mrow + c);
            *(f32x4*)(F.out + (size_t)row * D + c) = xv[j] + gg * (y1[j] * g1 + y2[j] * g2); }
    }
}
using pg8::Unit;
struct EpiF32 {
    static constexpr bool PERM = false;
    float* C; int ldc;
    DI void operator()(const f32x4 (&acc)[2][2][4][2], const Unit& u, int wr, int wc, int fr, int fq) const {
        const int row0 = u.pm * 256 + wr * 64 + fr, col0 = u.pn * 256 + wc * 32 + 4 * fq;
#pragma unroll
        for (int ai = 0; ai < 2; ++ai)
#pragma unroll
            for (int m = 0; m < 4; ++m) { float* rowp = C + (size_t)(row0 + ai * 128 + m * 16) * ldc + col0;
#pragma unroll
                for (int bj = 0; bj < 2; ++bj)
#pragma unroll
                    for (int n = 0; n < 2; ++n) *(f32x4*)(rowp + bj * 128 + n * 16) = acc[ai][bj][m][n]; }
    }
};
struct EpiBf16 {
    static constexpr bool PERM = true;
    bf16* O; int ldc;
    DI void operator()(const f32x4 (&acc)[2][2][4][2], const Unit& u, int wr, int wc, int fr, int fq) const {
        const int row0 = u.pm * 256 + wr * 64 + fr, col0 = u.pn * 256 + wc * 32 + 8 * fq;
#pragma unroll
        for (int ai = 0; ai < 2; ++ai)
#pragma unroll
            for (int m = 0; m < 4; ++m) { bf16* rowp = O + (size_t)(row0 + ai * 128 + m * 16) * ldc + col0;
#pragma unroll
                for (int bj = 0; bj < 2; ++bj) { const f32x4 v0 = acc[ai][bj][m][0], v1 = acc[ai][bj][m][1];
                    u32x4 w; w.x = pg8::cvt_pk_bf16(v0[0], v0[1]); w.y = pg8::cvt_pk_bf16(v0[2], v0[3]); w.z = pg8::cvt_pk_bf16(v1[0], v1[1]); w.w = pg8::cvt_pk_bf16(v1[2], v1[3]);
                    *(u32x4*)(rowp + bj * 128) = w; } }
    }
};
struct EpiP {
    static constexpr bool PERM = true;
    bf16* O; float* graw;
    DI void operator()(const f32x4 (&acc)[2][2][4][2], const Unit& u, int wr, int wc, int fr, int fq) const {
        const int row0 = u.pm * 256 + wr * 64 + fr, col0 = u.pn * 256 + wc * 32 + 8 * fq;
#pragma unroll
        for (int ai = 0; ai < 2; ++ai)
#pragma unroll
            for (int m = 0; m < 4; ++m) { bf16* rowp = O + (size_t)(row0 + ai * 128 + m * 16) * DINP + col0;
#pragma unroll
                for (int bj = 0; bj < 2; ++bj) { const f32x4 v0 = acc[ai][bj][m][0], v1 = acc[ai][bj][m][1];
                    u32x4 w; w.x = pg8::cvt_pk_bf16(v0[0], v0[1]); w.y = pg8::cvt_pk_bf16(v0[2], v0[3]); w.z = pg8::cvt_pk_bf16(v1[0], v1[1]); w.w = pg8::cvt_pk_bf16(v1[2], v1[3]);
                    *(u32x4*)(rowp + bj * 128) = w; } }
        const bool gsel = (u.pn == 8 && wc == 0 && fq < 2), dsel = (u.pn == 14 && wc == 0 && fq >= 2);
        if (gsel || dsel) { const int off = gsel ? 8 * fq : 16 + 8 * (fq - 2);
#pragma unroll
            for (int ai = 0; ai < 2; ++ai)
#pragma unroll
                for (int m = 0; m < 4; ++m) { float* gp = graw + (size_t)(row0 + ai * 128 + m * 16) * 32 + off;
                    *(f32x4*)gp = acc[ai][0][m][0]; *(f32x4*)(gp + 4) = acc[ai][0][m][1]; } }
    }
};
struct EpiSwiglu {
    static constexpr bool PERM = true;
    bf16* O; int ldc;
    DI void operator()(const f32x4 (&acc)[2][2][4][2], const Unit& u, int wr, int wc, int fr, int fq) const {
        const int row0 = u.pm * 256 + wr * 64 + fr, col0 = u.pn * 128 + wc * 32 + 8 * fq;
#pragma unroll
        for (int ai = 0; ai < 2; ++ai)
#pragma unroll
            for (int m = 0; m < 4; ++m) { bf16* rowp = O + (size_t)(row0 + ai * 128 + m * 16) * ldc + col0;
                f32x4 v0, v1;
#pragma unroll
                for (int j = 0; j < 4; ++j) { v0[j] = siluf(acc[ai][0][m][0][j]) * acc[ai][1][m][0][j]; v1[j] = siluf(acc[ai][0][m][1][j]) * acc[ai][1][m][1][j]; }
                u32x4 w; w.x = pg8::cvt_pk_bf16(v0[0], v0[1]); w.y = pg8::cvt_pk_bf16(v0[2], v0[3]); w.z = pg8::cvt_pk_bf16(v1[0], v1[1]); w.w = pg8::cvt_pk_bf16(v1[2], v1[3]);
                *(u32x4*)rowp = w; }
    }
};
struct EpiResid {
    static constexpr bool PERM = false;
    const float* baseLat; const float* baseCtx; float* out; const float* mod;
    DI void operator()(const f32x4 (&acc)[2][2][4][2], const Unit& u, int wr, int wc, int fr, int fq) const {
        const int row0 = u.pm * 256 + wr * 64 + fr, col0 = u.pn * 256 + wc * 32 + 4 * fq;
        const int br = (u.pm * 256 < MLAT) ? (u.pm * 256) / TL : 4;
        const float* gate = mod + (size_t)br * D6 + col0;
        f32x4 gv[2][2];
#pragma unroll
        for (int bj = 0; bj < 2; ++bj)
#pragma unroll
            for (int n = 0; n < 2; ++n) gv[bj][n] = *(const f32x4*)(gate + bj * 128 + n * 16);
#pragma unroll
        for (int ai = 0; ai < 2; ++ai)
#pragma unroll
            for (int m = 0; m < 4; ++m) { const int row = row0 + ai * 128 + m * 16;
                const float* bp = (row < MLAT ? baseLat + (size_t)row * D : baseCtx + (size_t)(row - MLAT) * D) + col0; float* op = out + (size_t)row * D + col0;
#pragma unroll
                for (int bj = 0; bj < 2; ++bj)
#pragma unroll
                    for (int n = 0; n < 2; ++n) { const f32x4 b = *(const f32x4*)(bp + bj * 128 + n * 16); *(f32x4*)(op + bj * 128 + n * 16) = b + gv[bj][n] * acc[ai][bj][m][n]; } }
    }
};
struct MoeOrder {
    const LAS int* tb; int NT, G, c, L0, nT, S, KS;
    DI bool next(int i, Unit& u) const {
        const long T = (long)i * G + c; if (T >= nT) return false;
        const int nun = tb[40], L = L0 + (int)T / S, sl = (int)T % S;
        const int w = pg8::xcd_remap(L, nun); int e = 0;
#pragma unroll
        for (int k = 1; k < 8; ++k) if (w >= tb[32 + k]) e = k;
        const int rem = w - tb[32 + e], tiles = tb[8 + e], nt = rem / tiles, mtl = rem - nt * tiles;
        u.pm = tb[16 + e] + mtl; u.pn = nt; u.pb = e * NT + nt; u.koff = sl * KS; u.aux = (int)T; return true;
    }
};
struct EpiPart {
    static constexpr bool PERM = false;
    float* part;
    DI void operator()(const f32x4 (&acc)[2][2][4][2], const Unit& u, int wr, int wc, int fr, int fq) const {
        f32x4* p = (f32x4*)part + (size_t)u.aux * (32 * NTHR) + threadIdx.x;
#pragma unroll
        for (int ai = 0; ai < 2; ++ai)
#pragma unroll
            for (int bj = 0; bj < 2; ++bj)
#pragma unroll
                for (int m = 0; m < 4; ++m)
#pragma unroll
                    for (int n = 0; n < 2; ++n) p[(size_t)(((ai * 2 + bj) * 4 + m) * 2 + n) * NTHR] = acc[ai][bj][m][n];
    }
};
template <int S> DI void splitk_reduce_f32(const float* part, int t, int cg, const Unit& u, float* C, int ldc) {
    const int tid = threadIdx.x, wid = tid >> 6, lane = tid & 63, wr = wid >> 2, wc = wid & 3, fr = lane & 15, fq = lane >> 4;
    f32x4 v[4][S];
#pragma unroll
    for (int k = 0; k < 4; ++k)
#pragma unroll
        for (int s = 0; s < S; ++s) v[k][s] = *((const f32x4*)part + ((size_t)(t * S + s) * 32 + (cg * 4 + k)) * NTHR + tid);
#pragma unroll
    for (int k = 0; k < 4; ++k) { const int ch = cg * 4 + k, n = ch & 1, m = (ch >> 1) & 3, bj = (ch >> 3) & 1, ai = ch >> 4;
        f32x4 a = v[k][0];
#pragma unroll
        for (int s = 1; s < S; ++s) a += v[k][s];
        *(f32x4*)(C + (size_t)(u.pm * 256 + ai * 128 + wr * 64 + m * 16 + fr) * ldc + u.pn * 256 + bj * 128 + wc * 32 + n * 16 + 4 * fq) = a; }
}
DI int tc_of(int dir, int p) { return dir == 0 ? (p < 4 ? 32 + p : p - 4) : 35 - p; }

DI void m1_prep_unit(Frame& F, int l, int b, int tt) {
    const bf16* P = WSP(bf16, WS_P); const float* GR = WSP(float, WS_GRAW);
    const int j0 = tt * 32, lane = F.lane;
    LAS bf16* vs = (LAS bf16*)F.lds;
    for (int i = F.wave; i < 32; i += 8) {
        const int j = j0 + i, row = rowof(b, j);
        const bf16* p = P + (size_t)row * DINP; const float* gr = GR + (size_t)row * 32;
        float cq[7], ckv[3], nq[4][2], nk[4][2]; bf16 nv[8];
#pragma unroll
        for (int u = 0; u < 7; ++u) cq[u] = bf2f(p[PC_CQ + lane + 64 * u]);
#pragma unroll
        for (int u = 0; u < 3; ++u) { const int idx = lane + 64 * u; ckv[u] = idx < 160 ? bf2f(p[PC_CKV + idx]) : 0.f; }
#pragma unroll
        for (int h = 0; h < 4; ++h) { nq[h][0] = bf2f(p[PC_NQ + h * 128 + lane]); nq[h][1] = bf2f(p[PC_NQ + h * 128 + 64 + lane]); nk[h][0] = bf2f(p[PC_NK + h * 128 + lane]); nk[h][1] = bf2f(p[PC_NK + h * 128 + 64 + lane]); }
#pragma unroll
        for (int u = 0; u < 8; ++u) nv[u] = p[PC_NV + lane + 64 * u];
        const float gi = lane < 8 ? gr[lane] : 0.f, gf = lane < 8 ? gr[8 + lane] : 0.f, gd = lane < 16 ? gr[16 + lane] : 0.f;
        {
            float ss = 0.f;
#pragma unroll
            for (int u = 0; u < 7; ++u) ss += cq[u] * cq[u];
            const float rstd = 1.0f / sqrtf(wave_sum(ss) * (1.f / 448.f) + EPS);
            const float* qn = F.in[18] + l * 448; bf16* o = WSP(bf16, WS_CQN) + (size_t)row * 512;
#pragma unroll
            for (int u = 0; u < 7; ++u) o[lane + 64 * u] = (bf16)f2bf(cq[u] * rstd * qn[lane + 64 * u]);
            o[448 + lane] = 0;
        }
        {
            float ss = 0.f;
#pragma unroll
            for (int u = 0; u < 3; ++u) ss += ckv[u] * ckv[u];
            const float rstd = 1.0f / sqrtf(wave_sum(ss) * (1.f / 160.f) + EPS);
            const float* kn = F.in[20] + l * 160; bf16* o = WSP(bf16, WS_CKVN) + (size_t)row * 256;
#pragma unroll
            for (int u = 0; u < 3; ++u) { const int idx = lane + 64 * u; o[idx] = idx < 160 ? (bf16)f2bf(ckv[u] * rstd * kn[idx]) : (bf16)0; }
            o[192 + lane] = 0;
        }
        const float* gq = F.in[24] + l * 128; const float* gk = F.in[25] + l * 128;
#pragma unroll
        for (int h = 0; h < 4; ++h) {
            const float rq = 1.0f / sqrtf(wave_sum(nq[h][0] * nq[h][0] + nq[h][1] * nq[h][1]) * (1.f / 128.f) + EPS);
            const float rk = 1.0f / sqrtf(wave_sum(nk[h][0] * nk[h][0] + nk[h][1] * nk[h][1]) * (1.f / 128.f) + EPS);
            bf16* oq = WSP(bf16, WS_QNA) + ((size_t)(b * 4 + h) * TS + j) * 128; bf16* ok = WSP(bf16, WS_KNA) + ((size_t)(b * 4 + h) * TS + j) * 128;
            oq[lane] = (bf16)f2bf(nq[h][0] * rq * gq[lane]); oq[64 + lane] = (bf16)f2bf(nq[h][1] * rq * gq[64 + lane]);
            ok[lane] = (bf16)f2bf(nk[h][0] * rk * gk[lane]); ok[64 + lane] = (bf16)f2bf(nk[h][1] * rk * gk[64 + lane]);
        }
#pragma unroll
        for (int u = 0; u < 8; ++u) vs[i * 520 + lane + 64 * u] = nv[u];
        if (lane < 8) {
            float* gt = WSP(float, WS_GATES) + (size_t)row * 16;
            gt[lane] = gi + F.in[9][l * 8 + lane];
            gt[8 + lane] = logsigmoidf_(gf + F.in[10][l * 8 + lane]);
        }
        if (lane < 16) WSP(float, WS_DT)[(size_t)row * 16 + lane] = softplusf_(gd + F.in[14][l * 16 + lane]);
    }
    {
        const int ch = 2 * F.tid;
        const int seglo = j0 < TL ? 0 : TL, seghi = j0 < TL ? TL : TS;
        const float* cw = F.in[12] + (size_t)l * 5 * 1024 + ch; const float* cb = F.in[13] + (size_t)l * 1024 + ch;
        f32x2 w[5];
#pragma unroll
        for (int d = 0; d < 5; ++d) w[d] = *(const f32x2*)(cw + d * 1024);
        const f32x2 bias = *(const f32x2*)cb;
        f32x2 xin[36];
#pragma unroll
        for (int d = 0; d < 36; ++d) { const int jj = j0 - 2 + d; unsigned xw = 0u; if (jj >= seglo && jj < seghi) xw = *(const unsigned*)(P + (size_t)rowof(b, jj) * DINP + PC_XBC + ch); xin[d] = (f32x2){bf2f(xw & 0xffffu), bf2f(xw >> 16)}; }
#pragma unroll
        for (int i = 0; i < 32; ++i) {
            f32x2 a = bias;
#pragma unroll
            for (int d = 0; d < 5; ++d) a += w[d] * xin[i + d];
            *(unsigned*)(WSP(bf16, WS_XBC) + (size_t)rowof(b, j0 + i) * 1024 + ch) = pk2(siluf(a[0]), siluf(a[1]));
        }
    }
    __syncthreads();
    {
        const int t = F.tid; unsigned wv[16];
#pragma unroll
        for (int i = 0; i < 16; ++i) wv[i] = (unsigned)vs[(2 * i) * 520 + t] | ((unsigned)vs[(2 * i + 1) * 520 + t] << 16);
        u32x4* dst = (u32x4*)(WSP(bf16, WS_VTNA) + ((size_t)(b * 4 + (t >> 7)) * 128 + (t & 127)) * TS + j0);
#pragma unroll
        for (int k = 0; k < 4; ++k) dst[k] = (u32x4){wv[4 * k], wv[4 * k + 1], wv[4 * k + 2], wv[4 * k + 3]};
    }
    __syncthreads();
}

DI void ml_a_unit(Frame& F, int seq, int p) {
    const int b = seq >> 3, h = (seq >> 1) & 3, dir = seq & 1, tc = tc_of(dir, p), lane = F.lane;
    const bf16* P = WSP(bf16, WS_P);
    LAS bf16* VW = (LAS bf16*)F.lds;
    LAS bf16* KT = (LAS bf16*)(F.lds + 20736);
    LAS float* wgs = (LAS float*)(F.lds + 39168);
    if (F.wave == 0) {
        const int row = rowof(b, tc * 64 + lane);
        const float* gt = WSP(float, WS_GATES) + (size_t)row * 16;
        const float li = gt[dir * 4 + h], lf = gt[8 + dir * 4 + h];
        const float pre = wave_incl_scan(lf, lane), tot = __shfl(pre, 63);
        const float g = dir == 0 ? (tot - pre) + li : (pre - lf) + li;
        const float mloc = wave_max(g);
        wgs[lane] = __expf(g - mloc);
        if (lane == 0) { float* sc = WSP(float, WS_MLSC) + (size_t)(seq * 36 + p) * 4; sc[0] = tot; sc[1] = mloc; }
    }
    {
        float vv[16], kk[16];
#pragma unroll
        for (int it = 0; it < 16; ++it) { const int idx = F.tid + NTHR * it, n = idx >> 7, d = idx & 127;
            const bf16* pr = P + (size_t)rowof(b, tc * 64 + n) * DINP + h * 128 + d; vv[it] = bf2f(pr[PC_MLV]); kk[it] = bf2f(pr[PC_MLK]); }
        __syncthreads();
#pragma unroll
        for (int it = 0; it < 16; ++it) { const int idx = F.tid + NTHR * it, n = idx >> 7, d = idx & 127;
            VW[d * 72 + n] = (bf16)f2bf(vv[it] * wgs[n]); KT[d * 72 + n] = (bf16)f2bf(kk[it]); }
    }
    for (int idx = F.tid; idx < 16 * 64; idx += NTHR) { const int rr = idx >> 6, n = idx & 63; VW[(128 + rr) * 72 + n] = rr == 0 ? (bf16)f2bf(wgs[n]) : (bf16)0; }
    __syncthreads();
    float* U = WSP(float, WS_MLU) + (size_t)(seq * 36 + p) * (129 * 128);
    for (int id = F.wave; id < 72; id += 8) { const int dt = id >> 3, et = id & 7;
        const f32x4 acc = mma16<64>(VW + dt * 16 * 72, 72, KT + et * 16 * 72, 72, lane, (f32x4){0.f, 0.f, 0.f, 0.f});
#pragma unroll
        for (int i = 0; i < 4; ++i) { const int d = dt * 16 + 4 * (lane >> 4) + i; if (d < 129) U[d * 128 + et * 16 + (lane & 15)] = acc[i]; } }
    __syncthreads();
}

DI void ss_a_unit(Frame& F, int l, int b, int dir, int p, int g) {
    const int tc = tc_of(dir, p), lane = F.lane;
    LAS bf16* XT = (LAS bf16*)F.lds;
    LAS bf16* BT = (LAS bf16*)(F.lds + 36864);
    LAS float* tails = (LAS float*)(F.lds + 55296);
    const bf16* XBC = WSP(bf16, WS_XBC);
    if (F.wave < 4) {
        const int h = 4 * g + F.wave, row = rowof(b, tc * 64 + lane);
        const float dt = WSP(float, WS_DT)[(size_t)row * 16 + dir * 8 + h];
        const float A = -__expf(F.in[15][l * 16 + dir * 8 + h]);
        const float a = dt * A, pre = wave_incl_scan(a, lane), tot = __shfl(pre, 63);
        tails[F.wave * 64 + lane] = (dir == 0 ? __expf(tot - pre) : __expf(pre - a)) * dt;
        if (lane == 0) WSP(float, WS_SSSC)[(size_t)((b * 8 + h) * 2 + dir) * 36 + p] = __expf(tot);
    }
    {
        bf16 xv[32], bv[16];
#pragma unroll
        for (int it = 0; it < 32; ++it) { const int idx = F.tid + NTHR * it, n = idx >> 8, c = idx & 255; xv[it] = XBC[(size_t)rowof(b, tc * 64 + n) * 1024 + g * 256 + c]; }
#pragma unroll
        for (int it = 0; it < 16; ++it) { const int idx = F.tid + NTHR * it, n = idx >> 7, nn = idx & 127; bv[it] = XBC[(size_t)rowof(b, tc * 64 + n) * 1024 + 512 + g * 128 + nn]; }
        __syncthreads();
#pragma unroll
        for (int it = 0; it < 32; ++it) { const int idx = F.tid + NTHR * it, n = idx >> 8, c = idx & 255; XT[c * 72 + n] = (bf16)f2bf(bf2f(xv[it]) * tails[(c >> 6) * 64 + n]); }
#pragma unroll
        for (int it = 0; it < 16; ++it) { const int idx = F.tid + NTHR * it, n = idx >> 7, nn = idx & 127; BT[nn * 72 + n] = bv[it]; }
    }
    __syncthreads();
    for (int id = F.wave; id < 128; id += 8) { const int hh = id >> 5, rem = id & 31, pt = rem >> 3, nt = rem & 7;
        const f32x4 acc = mma16<64>(XT + (hh * 64 + pt * 16) * 72, 72, BT + nt * 16 * 72, 72, lane, (f32x4){0.f, 0.f, 0.f, 0.f});
        float* U = WSP(float, WS_SSU) + (size_t)(((b * 8 + 4 * g + hh) * 2 + dir) * 36 + p) * 8192;
#pragma unroll
        for (int i = 0; i < 4; ++i) U[(pt * 16 + 4 * (lane >> 4) + i) * 128 + nt * 16 + (lane & 15)] = acc[i]; }
    __syncthreads();
}
DI void ml_scan_unit(Frame& F, int seq, int s4) {
    float* sc = WSP(float, WS_MLSC) + (size_t)seq * 36 * 4;
    const float* U = WSP(float, WS_MLU) + (size_t)seq * 36 * 16512 + s4 * 4128 + F.tid; bf16* S = WSP(bf16, WS_MLS) + (size_t)seq * 36 * 16512 + s4 * 4128 + F.tid;
    float st[9]; float m = 0.f;
#pragma unroll
    for (int k = 0; k < 9; ++k) st[k] = 0.f;
    for (int pg = 0; pg < 36; pg += 12) {
        float u[12][9];
#pragma unroll
        for (int pp = 0; pp < 12; ++pp)
#pragma unroll
            for (int k = 0; k < 9; ++k) u[pp][k] = (F.tid + 512 * k < 4128) ? U[(size_t)(pg + pp) * 16512 + 512 * k] : 0.f;
#pragma unroll
        for (int pp = 0; pp < 12; ++pp) { const int p = pg + pp;
            const float bl = sc[p * 4], mloc = sc[p * 4 + 1];
            const float mn = fmaxf(bl + m, mloc), wc = __expf(bl + m - mn), wu = __expf(mloc - mn);
            if (s4 == 0 && F.tid == 0) sc[p * 4 + 2] = m;
#pragma unroll
            for (int k = 0; k < 9; ++k) { if (F.tid + 512 * k < 4128) S[(size_t)p * 16512 + 512 * k] = (bf16)f2bf(st[k]); st[k] = wc * st[k] + wu * u[pp][k]; }
            m = mn; }
    }
}
DI void ss_scan_unit(Frame& F, int sq, int half) {
    const float* dec = WSP(float, WS_SSSC) + (size_t)sq * 36;
    const float* U = WSP(float, WS_SSU) + (size_t)sq * 36 * 8192 + half * 4096 + F.tid; bf16* S = WSP(bf16, WS_SSS) + (size_t)sq * 36 * 8192 + half * 4096 + F.tid;
    float st[8];
#pragma unroll
    for (int k = 0; k < 8; ++k) st[k] = 0.f;
    for (int pg = 0; pg < 36; pg += 12) {
        float u[12][8];
#pragma unroll
        for (int pp = 0; pp < 12; ++pp)
#pragma unroll
            for (int k = 0; k < 8; ++k) u[pp][k] = U[(size_t)(pg + pp) * 8192 + 512 * k];
#pragma unroll
        for (int pp = 0; pp < 12; ++pp) { const int p = pg + pp; const float dc = dec[p];
#pragma unroll
            for (int k = 0; k < 8; ++k) { S[(size_t)p * 8192 + 512 * k] = (bf16)f2bf(st[k]); st[k] = st[k] * dc + u[pp][k]; } }
    }
}
DI void mla_post_unit(Frame& F, int l, int b, int tt) {
    const bf16* P = WSP(bf16, WS_P);
    const bf16* QRAW = WSP(bf16, WS_QRAW); const bf16* KVRAW = WSP(bf16, WS_KVRAW);
    const int j0 = tt * 32, lane = F.lane;
    LAS bf16* vs = (LAS bf16*)F.lds;
    const float* gq = F.in[22] + l * 192; const float* gk = F.in[23] + l * 192;
    float qv[4][4][3], kk[4][4][2], krv[4]; bf16 vv[4][4][2];
#pragma unroll
    for (int it = 0; it < 4; ++it) {
        const int row = rowof(b, j0 + F.wave + 8 * it);
        krv[it] = bf2f(P[(size_t)row * DINP + PC_KR + lane]);
#pragma unroll
        for (int h = 0; h < 4; ++h) { const bf16* q = QRAW + (size_t)row * 768 + h * 192; const bf16* kv = KVRAW + (size_t)row * 1024 + h * 256;
            qv[it][h][0] = bf2f(q[lane]); qv[it][h][1] = bf2f(q[64 + lane]); qv[it][h][2] = bf2f(q[128 + lane]);
            kk[it][h][0] = bf2f(kv[lane]); kk[it][h][1] = bf2f(kv[64 + lane]); vv[it][h][0] = kv[128 + lane]; vv[it][h][1] = kv[192 + lane]; }
    }
    const float gq0 = gq[lane], gq1 = gq[64 + lane], gq2 = gq[128 + lane], gk0 = gk[lane], gk1 = gk[64 + lane], gk2 = gk[128 + lane];
    const int a = lane & 31;
    const float fr = exp2f(-(float)(a & 15) * (13.287712379549449f / 16.f));
#pragma unroll
    for (int it = 0; it < 4; ++it) {
        const int i = F.wave + 8 * it, j = j0 + i; const bool lat = j < TL;
        const float pos = (float)(a < 16 ? (j >> 6) : (j & 63));
        const float ang = pos * fr; const float cs = __cosf(ang), sn = __sinf(ang);
#pragma unroll
        for (int h = 0; h < 4; ++h) {
            {
                const float v0 = qv[it][h][0], v1 = qv[it][h][1], v2 = qv[it][h][2];
                const float rstd = 1.0f / sqrtf(wave_sum(v0 * v0 + v1 * v1 + v2 * v2) * (1.f / 192.f) + EPS);
                const float n0 = v0 * rstd * gq0, n1 = v1 * rstd * gq1; float n2 = v2 * rstd * gq2;
                const float pr = __shfl_xor(n2, 32);
                if (lat) n2 = lane < 32 ? n2 * cs - pr * sn : pr * sn + n2 * cs;
                bf16* o = WSP(bf16, WS_QMLA) + ((size_t)(b * 4 + h) * TS + j) * 192;
                o[lane] = (bf16)f2bf(n0); o[64 + lane] = (bf16)f2bf(n1); o[128 + lane] = (bf16)f2bf(n2);
            }
            {
                const float v0 = kk[it][h][0], v1 = kk[it][h][1], v2 = krv[it];
                const float rstd = 1.0f / sqrtf(wave_sum(v0 * v0 + v1 * v1 + v2 * v2) * (1.f / 192.f) + EPS);
                const float n0 = v0 * rstd * gk0, n1 = v1 * rstd * gk1; float n2 = v2 * rstd * gk2;
                const float pr = __shfl_xor(n2, 32);
                if (lat) n2 = lane < 32 ? n2 * cs - pr * sn : pr * sn + n2 * cs;
                bf16* o = WSP(bf16, WS_KMLA) + ((size_t)(b * 4 + h) * TS + j) * 192;
                o[lane] = (bf16)f2bf(n0); o[64 + lane] = (bf16)f2bf(n1); o[128 + lane] = (bf16)f2bf(n2);
                vs[i * 520 + h * 128 + lane] = vv[it][h][0]; vs[i * 520 + h * 128 + 64 + lane] = vv[it][h][1];
            }
        }
    }
    __syncthreads();
    {
        const int t = F.tid; unsigned wv[16];
#pragma unroll
        for (int i = 0; i < 16; ++i) wv[i] = (unsigned)vs[(2 * i) * 520 + t] | ((unsigned)vs[(2 * i + 1) * 520 + t] << 16);
        u32x4* dst = (u32x4*)(WSP(bf16, WS_VTMLA) + ((size_t)(b * 4 + (t >> 7)) * 128 + (t & 127)) * TS + j0);
#pragma unroll
        for (int k = 0; k < 4; ++k) dst[k] = (u32x4){wv[4 * k], wv[4 * k + 1], wv[4 * k + 2], wv[4 * k + 3]};
    }
    __syncthreads();
}

template <int DK, bool NA>
DI void attn_unit(Frame& F, const bf16* Qg, const bf16* Kg, const bf16* VTg, int nA, int tA0, int nB, int tB0, float scale, bf16* Og, int qrow0, const float* rpb) {
    constexpr int KP = DK + 8, KCH = DK / 8, NKC = 64 * KCH / NTHR;
    LAS bf16* Ks = (LAS bf16*)F.lds;
    LAS bf16* VTs = (LAS bf16*)(F.lds + 64 * KP * 2);
    LAS bf16* Ps = (LAS bf16*)(F.lds + 64 * KP * 2 + 128 * 72 * 2) + F.wave * (16 * 72);
    LAS float* rp = (LAS float*)(F.lds + 64 * KP * 2 + 128 * 72 * 2 + 8 * 16 * 72 * 2);
    const int lane = F.lane, r = lane & 15, q = lane >> 4, tid = F.tid, w = F.wave;
    if (NA) { for (int i = tid; i < 15 * 31; i += NTHR) rp[i] = rpb[i]; }
    bf16x8 qf[DK / 32];
#pragma unroll
    for (int kk = 0; kk < DK / 32; ++kk) qf[kk] = *(const bf16x8*)(Qg + (size_t)(w * 16 + r) * DK + 32 * kk + 8 * q);
    f32x4 o[8]; float mrow[4], lrow[4];
#pragma unroll
    for (int d = 0; d < 8; ++d) o[d] = (f32x4){0.f, 0.f, 0.f, 0.f};
#pragma unroll
    for (int i = 0; i < 4; ++i) { mrow[i] = -1.0e30f; lrow[i] = 0.f; }
    const int ntile = nA + nB;
    u32x4 kreg[NKC], vreg[2];
    const int rq = qrow0 + (w >> 2);
    const int r0 = rq - 4 < 0 ? 0 : (rq - 4 > 24 ? 24 : rq - 4);
#define ATT_LOAD(kt) do { _Pragma("unroll") for (int c = 0; c < NKC; ++c) { const int id = tid + NTHR * c, rr = id / KCH, cc = id % KCH; kreg[c] = *(const u32x4*)(Kg + (size_t)((kt) * 64 + rr) * DK + cc * 8); } \
        _Pragma("unroll") for (int c = 0; c < 2; ++c) { const int id = tid + NTHR * c, dd = id >> 3, cc = id & 7; vreg[c] = *(const u32x4*)(VTg + (size_t)dd * TS + (kt) * 64 + cc * 8); } } while (0)
    ATT_LOAD(nA > 0 ? tA0 : tB0);
    for (int it = 0; it < ntile; ++it) {
        const int kt = it < nA ? tA0 + it : tB0 + (it - nA);
        __syncthreads();
#pragma unroll
        for (int c = 0; c < NKC; ++c) { const int id = tid + NTHR * c, rr = id / KCH, cc = id % KCH; *(LAS u32x4*)(Ks + rr * KP + cc * 8) = kreg[c]; }
#pragma unroll
        for (int c = 0; c < 2; ++c) { const int id = tid + NTHR * c, dd = id >> 3, cc = id & 7; *(LAS u32x4*)(VTs + dd * 72 + cc * 8) = vreg[c]; }
        __syncthreads();
        if (it + 1 < ntile) { const int kn = (it + 1) < nA ? tA0 + it + 1 : tB0 + (it + 1 - nA); ATT_LOAD(kn); }
        const bool nbt = NA && kt < 32;
        if (nbt && (kt < r0 || kt >= r0 + 8)) continue;
        f32x4 s[4];
#pragma unroll
        for (int n = 0; n < 4; ++n) s[n] = (f32x4){0.f, 0.f, 0.f, 0.f};
#pragma unroll
        for (int kk = 0; kk < DK / 32; ++kk)
#pragma unroll
            for (int n = 0; n < 4; ++n) { const bf16x8 kf = *(const LAS bf16x8*)(Ks + (n * 16 + r) * KP + 32 * kk + 8 * q); s[n] = __builtin_amdgcn_mfma_f32_16x16x32_bf16(qf[kk], kf, s[n], 0, 0, 0); }
        float mx[4];
#pragma unroll
        for (int i = 0; i < 4; ++i) mx[i] = -1.0e30f;
#pragma unroll
        for (int n = 0; n < 4; ++n)
#pragma unroll
            for (int i = 0; i < 4; ++i) {
                float v = s[n][i] * scale;
                if (nbt) { const int c = (w & 3) * 16 + 4 * q + i, kc = n * 16 + r; const int c0 = c - 8 < 0 ? 0 : (c - 8 > 48 ? 48 : c - 8);
                    v = (kc >= c0 && kc < c0 + 16) ? v + rp[(kt - rq + 7) * 31 + (kc - c + 15)] : -1.0e30f; }
                s[n][i] = v; mx[i] = fmaxf(mx[i], v);
            }
        float alpha[4], rs[4];
#pragma unroll
        for (int i = 0; i < 4; ++i) {
            float m = mx[i]; m = fmaxf(m, __shfl_xor(m, 1)); m = fmaxf(m, __shfl_xor(m, 2)); m = fmaxf(m, __shfl_xor(m, 4)); m = fmaxf(m, __shfl_xor(m, 8));
            const float mn = fmaxf(mrow[i], m); alpha[i] = __expf(mrow[i] - mn); mrow[i] = mn; rs[i] = 0.f;
        }
#pragma unroll
        for (int n = 0; n < 4; ++n)
#pragma unroll
            for (int i = 0; i < 4; ++i) { const float pv = __expf(s[n][i] - mrow[i]); rs[i] += pv; Ps[(4 * q + i) * 72 + n * 16 + r] = (bf16)f2bf(pv); }
#pragma unroll
        for (int i = 0; i < 4; ++i) {
            float t = rs[i]; t += __shfl_xor(t, 1); t += __shfl_xor(t, 2); t += __shfl_xor(t, 4); t += __shfl_xor(t, 8);
            lrow[i] = lrow[i] * alpha[i] + t;
        }
#pragma unroll
        for (int d = 0; d < 8; ++d)
#pragma unroll
            for (int i = 0; i < 4; ++i) o[d][i] *= alpha[i];
        asm volatile("s_waitcnt lgkmcnt(0)" ::: "memory");
#pragma unroll
        for (int kk = 0; kk < 2; ++kk) { const bf16x8 pf = *(const LAS bf16x8*)(Ps + r * 72 + 32 * kk + 8 * q);
#pragma unroll
            for (int d = 0; d < 8; ++d) { const bf16x8 vf = *(const LAS bf16x8*)(VTs + (d * 16 + r) * 72 + 32 * kk + 8 * q); o[d] = __builtin_amdgcn_mfma_f32_16x16x32_bf16(pf, vf, o[d], 0, 0, 0); } }
    }
#undef ATT_LOAD
#pragma unroll
    for (int i = 0; i < 4; ++i) { const float inv = 1.0f / lrow[i]; bf16* op = Og + (size_t)(w * 16 + 4 * q + i) * D + r;
#pragma unroll
        for (int d = 0; d < 8; ++d) op[d * 16] = (bf16)f2bf(o[d][i] * inv); }
    __syncthreads();
}
typedef float f32x16 __attribute__((ext_vector_type(16)));
typedef short s16x4 __attribute__((ext_vector_type(4)));
template <int DK, bool NA>
DI void attn_unit2(Frame& F, const bf16* Qg, const bf16* Kg, const bf16* VTg, int nA, int tA0, int nB, int tB0, float sc2, bf16* Og, int qrow0, const float* rpb) {
    constexpr int KP = DK + 8, KCH = DK / 8, NKC = 64 * KCH / NTHR, NKK = DK / 16;
    constexpr int KTB = 64 * KP * 2, VTB = 128 * 72 * 2, BUFB = KTB + VTB;
    const int lane = F.lane, l32 = lane & 31, h = lane >> 5, tid = F.tid, w = F.wave, g = w & 3, kp = w >> 2;
    LAS float* rp = (LAS float*)(F.lds + 2 * BUFB);
    if (NA) { for (int i = tid; i < 15 * 31; i += NTHR) rp[i] = rpb[i] * 1.4426950408889634f; }
    bf16x8 qf[NKK];
#pragma unroll
    for (int kk = 0; kk < NKK; ++kk) qf[kk] = *(const bf16x8*)(Qg + (size_t)(32 * g + l32) * DK + 16 * kk + 8 * h);
    f32x16 o[4]; float mrun = -1.0e30f, lrun = 0.f;
#pragma unroll
    for (int d = 0; d < 4; ++d)
#pragma unroll
        for (int i = 0; i < 16; ++i) o[d][i] = 0.f;
    const int ntile = nA + nB;
    const int rq = qrow0 + (g >> 1), r0 = rq - 4 < 0 ? 0 : (rq - 4 > 24 ? 24 : rq - 4);
    const int cq = 32 * (g & 1) + l32, c0 = cq - 8 < 0 ? 0 : (cq - 8 > 48 ? 48 : cq - 8);
    u32x4 kreg[NKC], vreg[2];
#define ATT2_TILE(it) ((it) < nA ? tA0 + (it) : tB0 + ((it) - nA))
#define ATT2_LOAD(it) do { const int kt_ = ATT2_TILE(it); \
        _Pragma("unroll") for (int c = 0; c < NKC; ++c) { const int id = tid + NTHR * c, rr = id / KCH, cc = id % KCH; kreg[c] = *(const u32x4*)(Kg + (size_t)(kt_ * 64 + rr) * DK + cc * 8); } \
        _Pragma("unroll") for (int c = 0; c < 2; ++c) { const int id = tid + NTHR * c, dd = id >> 3, cc = id & 7; vreg[c] = *(const u32x4*)(VTg + (size_t)dd * TS + kt_ * 64 + cc * 8); } } while (0)
#define ATT2_STORE(b) do { \
        _Pragma("unroll") for (int c = 0; c < NKC; ++c) { const int id = tid + NTHR * c, rr = id / KCH, cc = id % KCH; *(LAS u32x4*)(F.lds + (b) * BUFB + (rr * KP + cc * 8) * 2) = kreg[c]; } \
        _Pragma("unroll") for (int c = 0; c < 2; ++c) { const int id = tid + NTHR * c, dd = id >> 3, cc = id & 7; *(LAS u32x4*)(F.lds + (b) * BUFB + KTB + (dd * 72 + cc * 8) * 2) = vreg[c]; } } while (0)
    ATT2_LOAD(0); ATT2_STORE(0);
    __syncthreads();
    for (int st = 0; st < ntile; ++st) {
        if (st + 1 < ntile) ATT2_LOAD(st + 1);
        const int kt = ATT2_TILE(st);
        const bool nbt = NA && kt < 32;
        if (!(nbt && (kt < r0 || kt >= r0 + 8))) {
            const LAS bf16* Ks = (const LAS bf16*)(F.lds + (st & 1) * BUFB) + (kp * 32 + l32) * KP + 8 * h;
            const LAS bf16* VTs = (const LAS bf16*)(F.lds + (st & 1) * BUFB + KTB) + l32 * 72 + kp * 32 + 4 * h;
            f32x16 s;
#pragma unroll
            for (int i = 0; i < 16; ++i) s[i] = 0.f;
#pragma unroll
            for (int kk = 0; kk < NKK; ++kk) { const bf16x8 kf = *(const LAS bf16x8*)(Ks + 16 * kk); s = __builtin_amdgcn_mfma_f32_32x32x16_bf16(kf, qf[kk], s, 0, 0, 0); }
            float mx = -1.0e30f;
#pragma unroll
            for (int i = 0; i < 16; ++i) {
                float v = s[i] * sc2;
                if (nbt) { const int kc = kp * 32 + 8 * (i >> 2) + 4 * h + (i & 3); v = (kc >= c0 && kc < c0 + 16) ? v + rp[(kt - rq + 7) * 31 + (kc - cq + 15)] : -1.0e30f; }
                s[i] = v; mx = fmaxf(mx, v);
            }
            mx = fmaxf(mx, __shfl_xor(mx, 32));
            const float mn = fmaxf(mrun, mx), alpha = __builtin_amdgcn_exp2f(mrun - mn); mrun = mn;
            float rs = 0.f;
#pragma unroll
            for (int i = 0; i < 16; ++i) { const float pv = __builtin_amdgcn_exp2f(s[i] - mn); s[i] = pv; rs += pv; }
            rs += __shfl_xor(rs, 32);
            lrun = lrun * alpha + rs;
            if (__any(alpha != 1.0f)) {
#pragma unroll
                for (int d = 0; d < 4; ++d)
#pragma unroll
                    for (int i = 0; i < 16; ++i) o[d][i] *= alpha;
            }
#pragma unroll
            for (int sp = 0; sp < 2; ++sp) {
                u32x4 pw; pw.x = pg8::cvt_pk_bf16(s[8 * sp + 0], s[8 * sp + 1]); pw.y = pg8::cvt_pk_bf16(s[8 * sp + 2], s[8 * sp + 3]);
                pw.z = pg8::cvt_pk_bf16(s[8 * sp + 4], s[8 * sp + 5]); pw.w = pg8::cvt_pk_bf16(s[8 * sp + 6], s[8 * sp + 7]);
                const bf16x8 pf = __builtin_bit_cast(bf16x8, pw);
#pragma unroll
                for (int d = 0; d < 4; ++d) { const LAS bf16* vp = VTs + d * 32 * 72 + 16 * sp;
                    const u32x2 lo = *(const LAS u32x2*)vp, hi = *(const LAS u32x2*)(vp + 8);
                    const u32x4 vv = (u32x4){lo.x, lo.y, hi.x, hi.y};
                    o[d] = __builtin_amdgcn_mfma_f32_32x32x16_bf16(__builtin_bit_cast(bf16x8, vv), pf, o[d], 0, 0, 0); }
            }
        }
        if (st + 1 < ntile) ATT2_STORE((st + 1) & 1);
        __syncthreads();
    }
#undef ATT2_LOAD
#undef ATT2_STORE
#undef ATT2_TILE
    LAS float* ob = (LAS float*)F.lds + g * (66 * 64);
    if (kp == 1) {
#pragma unroll
        for (int d = 0; d < 4; ++d)
#pragma unroll
            for (int i = 0; i < 16; ++i) ob[(d * 16 + i) * 64 + lane] = o[d][i];
        ob[64 * 64 + lane] = mrun; ob[65 * 64 + lane] = lrun;
    }
    __syncthreads();
    if (kp == 0) {
        const float m1 = ob[64 * 64 + lane], l1 = ob[65 * 64 + lane];
        const float mf = fmaxf(mrun, m1), a0 = __builtin_amdgcn_exp2f(mrun - mf), a1 = __builtin_amdgcn_exp2f(m1 - mf);
        const float inv = 1.0f / (lrun * a0 + l1 * a1);
        bf16* op = Og + (size_t)(32 * g + l32) * D + 4 * h;
#pragma unroll
        for (int d = 0; d < 4; ++d)
#pragma unroll
            for (int i4 = 0; i4 < 4; ++i4) {
                float r[4];
#pragma unroll
                for (int j = 0; j < 4; ++j) r[j] = (o[d][4 * i4 + j] * a0 + ob[(d * 16 + 4 * i4 + j) * 64 + lane] * a1) * inv;
                u32x2 wv; wv.x = pk2(r[0], r[1]); wv.y = pk2(r[2], r[3]);
                *(u32x2*)(op + d * 32 + 8 * i4) = wv;
            }
    }
    __syncthreads();
}
DI void ml_c_unit(Frame& F, int seq, int p) {
    const int b = seq >> 3, h = (seq >> 1) & 3, dir = seq & 1, tc = tc_of(dir, p), lane = F.lane, tid = F.tid;
    const bf16* P = WSP(bf16, WS_P);
    constexpr float QS = 0.08838834764831845f;
    LAS bf16* Qs = (LAS bf16*)F.lds;
    LAS bf16* Ksm = (LAS bf16*)(F.lds + 17408);
    LAS bf16* VT = (LAS bf16*)(F.lds + 34816);
    LAS bf16* Cx = (LAS bf16*)(F.lds + 55552);
    LAS bf16* SW = (LAS bf16*)(F.lds + 94720);
    LAS float* av = (LAS float*)(F.lds + 103936);
    LAS float* Mt = av + 64;
    LAS float* Bt = av + 128;
    LAS float* den = av + 192;
    const float m_p = WSP(float, WS_MLSC)[(size_t)(seq * 36 + p) * 4 + 2];
    if (F.wave == 0) {
        const int row = rowof(b, tc * 64 + lane);
        const float* gt = WSP(float, WS_GATES) + (size_t)row * 16;
        const float li = gt[dir * 4 + h], lf = gt[8 + dir * 4 + h];
        const float pre = wave_incl_scan(lf, lane), tot = __shfl(pre, 63);
        const float B = dir == 0 ? pre : (tot - pre) + lf;
        const float a = li - B;
        float cm = a;
#pragma unroll
        for (int o = 1; o < 64; o <<= 1) { const float t = dir == 0 ? __shfl_up(cm, o) : __shfl_down(cm, o); const bool ok = dir == 0 ? (lane >= o) : (lane + o < 64); if (ok) cm = fmaxf(cm, t); }
        av[lane] = a; Mt[lane] = fmaxf(m_p, cm); Bt[lane] = B;
    }
    {
        u32x4 qv[2], kv[2]; bf16 vv[16]; u32x4 cx[5];
        const bf16* Sg = WSP(bf16, WS_MLS) + (size_t)(seq * 36 + p) * 16512;
#pragma unroll
        for (int it = 0; it < 2; ++it) { const int idx = tid + NTHR * it, n = idx >> 4, cc = idx & 15;
            const bf16* pr = P + (size_t)rowof(b, tc * 64 + n) * DINP + h * 128 + cc * 8; qv[it] = *(const u32x4*)(pr + PC_MLQ); kv[it] = *(const u32x4*)(pr + PC_MLK); }
#pragma unroll
        for (int it = 0; it < 16; ++it) { const int idx = tid + NTHR * it, n = idx >> 7, d = idx & 127; vv[it] = P[(size_t)rowof(b, tc * 64 + n) * DINP + PC_MLV + h * 128 + d]; }
#pragma unroll
        for (int it = 0; it < 5; ++it) { const int idx = tid + NTHR * it, rr = idx >> 4, cc = idx & 15; cx[it] = (idx < 144 * 16 && rr < 129) ? *(const u32x4*)(Sg + rr * 128 + cc * 8) : (u32x4){0u, 0u, 0u, 0u}; }
#pragma unroll
        for (int it = 0; it < 2; ++it) { const int idx = tid + NTHR * it, n = idx >> 4, cc = idx & 15; *(LAS u32x4*)(Qs + n * 136 + cc * 8) = qv[it]; *(LAS u32x4*)(Ksm + n * 136 + cc * 8) = kv[it]; }
#pragma unroll
        for (int it = 0; it < 16; ++it) { const int idx = tid + NTHR * it, n = idx >> 7, d = idx & 127; VT[d * 72 + n] = vv[it]; }
#pragma unroll
        for (int it = 0; it < 5; ++it) { const int idx = tid + NTHR * it, rr = idx >> 4, cc = idx & 15; if (idx < 144 * 16) *(LAS u32x4*)(Cx + rr * 136 + cc * 8) = cx[it]; }
    }
    for (int idx = tid; idx < 16 * 64; idx += NTHR) { const int rr = idx >> 6, n = idx & 63; VT[(128 + rr) * 72 + n] = rr == 0 ? (bf16)0x3f80 : (bf16)0; }
    __syncthreads();
    for (int id = F.wave; id < 16; id += 8) { const int tt = id >> 2, st = id & 3;
        const bool skip = dir == 0 ? st > tt : st < tt;
        f32x4 acc = (f32x4){0.f, 0.f, 0.f, 0.f};
        if (!skip) acc = mma16<128>(Qs + tt * 16 * 136, 136, Ksm + st * 16 * 136, 136, lane, acc);
        const int s = st * 16 + (lane & 15); const float as = av[s];
#pragma unroll
        for (int i = 0; i < 4; ++i) { const int t = tt * 16 + 4 * (lane >> 4) + i; const bool ok = !skip && (dir == 0 ? s <= t : s >= t);
            SW[t * 72 + s] = (bf16)f2bf(ok ? acc[i] * QS * __expf(as - Mt[t]) : 0.f); } }
    __syncthreads();
    const int tt = F.wave & 3, d0 = F.wave < 4 ? 0 : 5, nd = F.wave < 4 ? 5 : 4;
    f32x4 val[5];
#pragma unroll
    for (int k = 0; k < 5; ++k) { val[k] = (f32x4){0.f, 0.f, 0.f, 0.f};
        if (k < nd) { const int dt = d0 + k;
            const f32x4 a1 = mma16<64>(SW + tt * 16 * 72, 72, VT + dt * 16 * 72, 72, lane, (f32x4){0.f, 0.f, 0.f, 0.f});
            const f32x4 a2 = mma16<128>(Qs + tt * 16 * 136, 136, Cx + dt * 16 * 136, 136, lane, (f32x4){0.f, 0.f, 0.f, 0.f});
#pragma unroll
            for (int i = 0; i < 4; ++i) { const int t = tt * 16 + 4 * (lane >> 4) + i; val[k][i] = a1[i] + a2[i] * QS * __expf(m_p - Mt[t]); }
            if (dt == 8 && (lane & 15) == 0) {
#pragma unroll
                for (int i = 0; i < 4; ++i) den[tt * 16 + 4 * (lane >> 4) + i] = val[k][i]; } } }
    __syncthreads();
    float* H = WSP(float, WS_HML) + (size_t)dir * MTOK * 512;
#pragma unroll
    for (int k = 0; k < 5; ++k) { const int dt = d0 + k; if (k < nd && dt < 8) {
#pragma unroll
        for (int i = 0; i < 4; ++i) { const int t = tt * 16 + 4 * (lane >> 4) + i;
            const float dn = fmaxf(fabsf(den[t]), __expf(-(Bt[t] + Mt[t])));
            H[(size_t)rowof(b, tc * 64 + t) * 512 + h * 128 + dt * 16 + (lane & 15)] = val[k][i] / dn; } } }
    __syncthreads();
}

DI void ss_c_unit(Frame& F, int l, int sq, int p) {
    const int b = sq >> 4, h = (sq >> 1) & 7, dir = sq & 1, g = h >> 2, tc = tc_of(dir, p), lane = F.lane, tid = F.tid;
    const bf16* XBC = WSP(bf16, WS_XBC);
    LAS bf16* Cm = (LAS bf16*)F.lds;
    LAS bf16* Bm = (LAS bf16*)(F.lds + 17408);
    LAS bf16* XT = (LAS bf16*)(F.lds + 34816);
    LAS bf16* Sx = (LAS bf16*)(F.lds + 44032);
    LAS bf16* W = (LAS bf16*)(F.lds + 61440);
    LAS float* cum = (LAS float*)(F.lds + 70656);
    LAS float* dtv = cum + 64;
    if (F.wave == 0) {
        const int row = rowof(b, tc * 64 + lane);
        const float dt = WSP(float, WS_DT)[(size_t)row * 16 + dir * 8 + h];
        const float A = -__expf(F.in[15][l * 16 + dir * 8 + h]);
        const float a = dt * A, pre = wave_incl_scan(a, lane), tot = __shfl(pre, 63);
        cum[lane] = dir == 0 ? pre : (tot - pre) + a; dtv[lane] = dt;
    }
    {
        u32x4 bb[2], cc_[2], sx[2]; bf16 xx[8];
        const bf16* Sg = WSP(bf16, WS_SSS) + (size_t)(sq * 36 + p) * 8192;
#pragma unroll
        for (int it = 0; it < 2; ++it) { const int idx = tid + NTHR * it, n = idx >> 4, cc = idx & 15; const bf16* xr = XBC + (size_t)rowof(b, tc * 64 + n) * 1024;
            bb[it] = *(const u32x4*)(xr + 512 + g * 128 + cc * 8); cc_[it] = *(const u32x4*)(xr + 768 + g * 128 + cc * 8); sx[it] = *(const u32x4*)(Sg + n * 128 + cc * 8); }
#pragma unroll
        for (int it = 0; it < 8; ++it) { const int idx = tid + NTHR * it, n = idx >> 6, pp = idx & 63; xx[it] = XBC[(size_t)rowof(b, tc * 64 + n) * 1024 + h * 64 + pp]; }
#pragma unroll
        for (int it = 0; it < 2; ++it) { const int idx = tid + NTHR * it, n = idx >> 4, cc = idx & 15;
            *(LAS u32x4*)(Bm + n * 136 + cc * 8) = bb[it]; *(LAS u32x4*)(Cm + n * 136 + cc * 8) = cc_[it]; *(LAS u32x4*)(Sx + n * 136 + cc * 8) = sx[it]; }
#pragma unroll
        for (int it = 0; it < 8; ++it) { const int idx = tid + NTHR * it, n = idx >> 6, pp = idx & 63; XT[pp * 72 + n] = xx[it]; }
    }
    __syncthreads();
    for (int id = F.wave; id < 16; id += 8) { const int tt = id >> 2, st = id & 3;
        const bool skip = dir == 0 ? st > tt : st < tt;
        f32x4 acc = (f32x4){0.f, 0.f, 0.f, 0.f};
        if (!skip) acc = mma16<128>(Cm + tt * 16 * 136, 136, Bm + st * 16 * 136, 136, lane, acc);
        const int s = st * 16 + (lane & 15); const float cs = cum[s], ds = dtv[s];
#pragma unroll
        for (int i = 0; i < 4; ++i) { const int t = tt * 16 + 4 * (lane >> 4) + i; const bool ok = !skip && (dir == 0 ? s <= t : s >= t);
            W[t * 72 + s] = (bf16)f2bf(ok ? acc[i] * __expf(cum[t] - cs) * ds : 0.f); } }
    __syncthreads();
    float* Y = WSP(float, WS_YSS) + (size_t)dir * MTOK * 512;
    for (int id = F.wave; id < 16; id += 8) { const int tt = id >> 2, pt = id & 3;
        const f32x4 a1 = mma16<64>(W + tt * 16 * 72, 72, XT + pt * 16 * 72, 72, lane, (f32x4){0.f, 0.f, 0.f, 0.f});
        const f32x4 a2 = mma16<128>(Cm + tt * 16 * 136, 136, Sx + pt * 16 * 136, 136, lane, (f32x4){0.f, 0.f, 0.f, 0.f});
#pragma unroll
        for (int i = 0; i < 4; ++i) { const int t = tt * 16 + 4 * (lane >> 4) + i;
            Y[(size_t)rowof(b, tc * 64 + t) * 512 + h * 64 + pt * 16 + (lane & 15)] = a1[i] + a2[i] * __expf(cum[t]); } }
    __syncthreads();
}

DI void m5_finish_phase(Frame& F, int l, int nrows) {
    const int gw = F.bid * NWAVES + F.wave, NGW = F.G * NWAVES, lane = F.lane;
    const bf16* P = WSP(bf16, WS_P); const float* H0 = WSP(float, WS_HML); const float* H1 = H0 + (size_t)MTOK * 512;
    const float* Y0 = WSP(float, WS_YSS); const float* Y1 = Y0 + (size_t)MTOK * 512; const bf16* XBC = WSP(bf16, WS_XBC);
    bf16* A2 = WSP(bf16, WS_A2);
    for (int row = gw; row < nrows; row += NGW) {
        const bf16* p = P + (size_t)row * DINP;
        float hv[8], ov[8], yv[8], zv[8]; bf16 xv[8];
#pragma unroll
        for (int u = 0; u < 8; ++u) { const int c = lane + 64 * u;
            hv[u] = H0[(size_t)row * 512 + c] + H1[(size_t)row * 512 + c]; ov[u] = bf2f(p[PC_MLO + c]);
            yv[u] = Y0[(size_t)row * 512 + c] + Y1[(size_t)row * 512 + c]; zv[u] = bf2f(p[PC_Z + c]); xv[u] = XBC[(size_t)row * 1024 + c]; }
        const float* gn = F.in[11] + l * 512; const float* sn = F.in[17] + l * 512;
#pragma unroll
        for (int h = 0; h < 4; ++h) {
            const float v0 = hv[2 * h], v1 = hv[2 * h + 1]; const int c0 = h * 128 + lane, c1 = c0 + 64;
            const float rstd = 1.0f / sqrtf(wave_sum(v0 * v0 + v1 * v1) * (1.f / 128.f) + EPS);
            A2[(size_t)row * D + c0] = (bf16)f2bf(v0 * rstd * gn[c0] * sigmoidf_(ov[2 * h]));
            A2[(size_t)row * D + c1] = (bf16)f2bf(v1 * rstd * gn[c1] * sigmoidf_(ov[2 * h + 1]));
        }
        float y[8]; float ss = 0.f;
#pragma unroll
        for (int u = 0; u < 8; ++u) { float v = yv[u] + F.in[16][l * 8 + u] * bf2f(xv[u]); v *= siluf(zv[u]); y[u] = v; ss += v * v; }
        const float rstd = 1.0f / sqrtf(wave_sum(ss) * (1.f / 512.f) + EPS);
#pragma unroll
        for (int u = 0; u < 8; ++u) { const int c = lane + 64 * u; A2[(size_t)row * D + 512 + c] = (bf16)f2bf(y[u] * rstd * sn[c]); }
    }
}
#ifndef PROBE_MASK
#define PROBE_MASK 0ull
#endif
#define NREP(k) ((((unsigned long long)(PROBE_MASK) >> (k)) & 1ull) ? 2 : 1)
#ifndef UNIT_REP
#define UNIT_REP 0
#endif
#define UREP(i) for (int rp_ = 0; rp_ <= ((F.rep >> (i)) & 1); ++rp_)
#ifndef ONE_LAUNCH
#define ONE_LAUNCH 1
#endif
#define IN(k) (lo <= (k) && (k) < hi)
#define SEAM(k) do { if (ONE_LAUNCH && hi > (k) + 1) xcd_barrier(bar); } while (0)
#ifndef FILL_MASK
#define FILL_MASK 0x7fffffffull
#endif
#define FILL(k, work) do { if (ONE_LAUNCH) conv_fill(F, (k), (work)); } while (0)
#ifndef NCV_P
#define NCV_P 48
#define NCV_OUT 112
#define NCV_UP 24
#define NCV_DOWN 112
#endif
template <int l> DI void layer_phases(Frame& F, const XcdBarrier& bar, const int lo, const int hi) {
    LAS int* mtb = (LAS int*)(F.lds + RING_BYTES);
        const int pb = 1 + 16 * l;
        const bool wc = (l == 0);
        const int nrows = wc ? MTOK : MLAT;
        const float* modl = WSP(float, WS_MOD) + (size_t)l * 5 * D6;
        if (IN(pb + 0)) {
            if (l == 0) norm_phase<false>(F, l, F.in[0], F.in[2], F.in[6] + l * D, 0, MTOK);
            else norm_phase<false>(F, l, WSP(float, WS_X), WSP(float, WS_X) + (size_t)MLAT * D, F.in[6] + l * D, 0, MTOK);
            if (l == 1) conv_drain(F, CV_NQ1 - CV_EAGER); SEAM(pb + 0);
        }
        if (IN(pb + 1)) {
            const int ncv = ONE_LAUNCH ? NCV_P : 0, gw_ = F.G - ncv;
            if (F.bid < gw_) { pg8::Gemm g{WSP(bf16, WS_HN), WSP(bf16, WS_WIN) + (size_t)l * DINP * D, D, D}; pg8::StaticOrder S; S.init(MTOK / 256, DINP / 256, gw_, F.bid);
                EpiP E{WSP(bf16, WS_P), WSP(float, WS_GRAW)};
                pg8::gemm_phase<EpiP, pg8::StaticOrder>(F.lds, g, S, E); }
            FILL(pb + 1, F.bid >= gw_);
            SEAM(pb + 1);
        }
        if (IN(pb + 2)) {
            for (int u = F.bid; u < NB * 72; u += F.G) m1_prep_unit(F, l, u / 72, u % 72);
            SEAM(pb + 2);
        }
        if (IN(pb + 3)) {
            { pg8::Gemm g{WSP(bf16, WS_CQN), WSP(bf16, WS_WQB) + (size_t)l * 768 * 512, 512, 512}; pg8::StaticOrder S; S.init(MTOK / 256, 3, F.G, F.bid);
              EpiBf16 E{WSP(bf16, WS_QRAW), 768}; pg8::gemm_phase<EpiBf16, pg8::StaticOrder>(F.lds, g, S, E); }
            __syncthreads();
            { pg8::Gemm g{WSP(bf16, WS_CKVN), WSP(bf16, WS_WKVB) + (size_t)l * 1024 * 256, 256, 256}; pg8::StaticOrder S; S.init(MTOK / 256, 4, F.G, (F.bid + 128) % F.G);
              EpiBf16 E{WSP(bf16, WS_KVRAW), 1024}; pg8::gemm_phase<EpiBf16, pg8::StaticOrder>(F.lds, g, S, E); }
            __syncthreads();
            UREP(2) for (int u = F.bid; u < 1152; u += F.G) ml_a_unit(F, u / 36, u % 36);
            UREP(3) for (int v = (F.bid + 128) % F.G; v < 576; v += F.G) ss_a_unit(F, l, v / 144, (v / 72) & 1, (v % 72) >> 1, v & 1);
            SEAM(pb + 3);
        }
        if (IN(pb + 4)) {
            UREP(4) for (int u = F.bid; u < 256; u += F.G) {
                const int bh = u >> 4, qb = u & 15, b = bh >> 2, h = bh & 3;
                const int r0a = 2 * qb - 4 < 0 ? 0 : (2 * qb - 4 > 24 ? 24 : 2 * qb - 4), r0b = 2 * qb - 3 < 0 ? 0 : (2 * qb - 3 > 24 ? 24 : 2 * qb - 3);
                attn_unit2<128, true>(F, WSP(bf16, WS_QNA) + ((size_t)bh * TS + qb * 128) * 128, WSP(bf16, WS_KNA) + (size_t)bh * TS * 128, WSP(bf16, WS_VTNA) + (size_t)bh * 128 * TS,
                                     4, 32, r0b + 8 - r0a, r0a, 0.12751743082459868f,
                                     WSP(bf16, WS_A2) + (size_t)(b * TL + qb * 128) * D + 1536 + h * 128, 2 * qb, F.in[26] + (size_t)(l * 4 + h) * 15 * 31);
            }
            if (wc) UREP(5) for (int v = F.bid; v < 32; v += F.G) {
                const int bh2 = v >> 1, qc = v & 1, b2 = bh2 >> 2, h2 = bh2 & 3;
                attn_unit2<128, false>(F, WSP(bf16, WS_QNA) + ((size_t)bh2 * TS + TL + qc * 128) * 128, WSP(bf16, WS_KNA) + (size_t)bh2 * TS * 128, WSP(bf16, WS_VTNA) + (size_t)bh2 * 128 * TS,
                                      4, 32, 0, 0, 0.12751743082459868f, WSP(bf16, WS_A2) + (size_t)(MLAT + b2 * TC + qc * 128) * D + 1536 + h2 * 128, 0, nullptr);
            }
            UREP(6) for (int v = (F.bid + 32) % F.G; v < 128; v += F.G) ml_scan_unit(F, v >> 2, v & 3);
            UREP(7) for (int v = (F.bid + 96) % F.G; v < 128; v += F.G) ss_scan_unit(F, v >> 1, v & 1);
            UREP(8) for (int v = F.bid; v < 288; v += F.G) mla_post_unit(F, l, v / 72, v % 72);
            SEAM(pb + 4);
        }
        if (IN(pb + 5)) {
            const int p0 = wc ? 0 : 4, npp = 36 - p0;
            UREP(9) for (int u = F.bid; u < 256; u += F.G) { const int bh = u >> 4, qb = u & 15, b = bh >> 2, h = bh & 3;
                attn_unit2<192, false>(F, WSP(bf16, WS_QMLA) + ((size_t)bh * TS + qb * 128) * 192, WSP(bf16, WS_KMLA) + (size_t)bh * TS * 192, WSP(bf16, WS_VTMLA) + (size_t)bh * 128 * TS,
                                      36, 0, 0, 0, 0.10411754627862817f, WSP(bf16, WS_A2) + (size_t)(b * TL + qb * 128) * D + 1024 + h * 128, 0, nullptr); }
            if (wc) UREP(10) for (int v = F.bid; v < 32; v += F.G) { const int bh = v >> 1, qc = v & 1, b = bh >> 2, h = bh & 3;
                attn_unit2<192, false>(F, WSP(bf16, WS_QMLA) + ((size_t)bh * TS + TL + qc * 128) * 192, WSP(bf16, WS_KMLA) + (size_t)bh * TS * 192, WSP(bf16, WS_VTMLA) + (size_t)bh * 128 * TS,
                                      4, 32, 0, 0, 0.10411754627862817f, WSP(bf16, WS_A2) + (size_t)(MLAT + b * TC + qc * 128) * D + 1024 + h * 128, 0, nullptr); }
            UREP(11) for (int v = (F.bid + 32) % F.G; v < 32 * npp; v += F.G) ml_c_unit(F, v / npp, p0 + v % npp);
            UREP(12) for (int v = (F.bid + 160) % F.G; v < 64 * npp; v += F.G) ss_c_unit(F, l, v / npp, p0 + v % npp);
            SEAM(pb + 5);
        }
        if (IN(pb + 6)) { m5_finish_phase(F, l, nrows); SEAM(pb + 6); }
        if (IN(pb + 7)) {
            const int ncv = (ONE_LAUNCH && l == 0) ? NCV_OUT : 0, gw_ = F.G - ncv;
            if (F.bid < gw_) { pg8::Gemm g{WSP(bf16, WS_A2), WSP(bf16, WS_WOUT) + (size_t)l * D * D, D, D}; pg8::StaticOrder S; S.init(nrows / 256, D / 256, gw_, F.bid);
                EpiResid E{l == 0 ? F.in[0] : WSP(float, WS_X), l == 0 ? F.in[2] : WSP(float, WS_X) + (size_t)MLAT * D, WSP(float, WS_X), modl + 2 * D};
                pg8::gemm_phase<EpiResid, pg8::StaticOrder>(F.lds, g, S, E); }
            FILL(pb + 7, F.bid >= gw_);
            SEAM(pb + 7);
        }
        if (IN(pb + 8)) {
            if (l == 0) { norm_phase<false>(F, l, WSP(float, WS_X), WSP(float, WS_X) + (size_t)MLAT * D, F.in[27] + l * D, 3 * D, nrows); conv_drain(F, CV_NE - CV_EAGER); }
            else norm_phase<true>(F, l, WSP(float, WS_X), WSP(float, WS_X) + (size_t)MLAT * D, F.in[27] + l * D, 3 * D, nrows);
            SEAM(pb + 8);
        }
        if (l == 0) {
            if (IN(pb + 10)) {
                const int ncv = ONE_LAUNCH ? NCV_UP : 0, gw_ = F.G - ncv;
                if (F.bid < gw_) { pg8::Gemm g{WSP(bf16, WS_HN), WSP(bf16, WS_W13), D, D}; pg8::StaticOrder S; S.init(MTOK / 256, 2 * FF / 256, gw_, F.bid);
                    EpiSwiglu E{WSP(bf16, WS_G), FF}; pg8::gemm_phase<EpiSwiglu, pg8::StaticOrder>(F.lds, g, S, E); }
                FILL(pb + 10, F.bid >= gw_);
                SEAM(pb + 10);
            }
            if (IN(pb + 11)) {
                const int ncv = ONE_LAUNCH ? NCV_DOWN : 0, gw_ = F.G - ncv;
                if (F.bid < gw_) { pg8::Gemm g{WSP(bf16, WS_G), WSP(bf16, WS_W2), FF, FF}; pg8::StaticOrder S; S.init(MTOK / 256, D / 256, gw_, F.bid);
                    EpiResid E{WSP(float, WS_X), WSP(float, WS_X) + (size_t)MLAT * D, WSP(float, WS_X), modl + 5 * D};
                    pg8::gemm_phase<EpiResid, pg8::StaticOrder>(F.lds, g, S, E); }
                FILL(pb + 11, F.bid >= gw_);
                SEAM(pb + 11);
            }
        } else {
            if (IN(pb + 9)) { moe_gather_phase(F); conv_drain(F, CV_NDEF); SEAM(pb + 9); }
            if (IN(pb + 10)) {
                __syncthreads(); moe_tables(F, mtb, 2 * FE / 256);
                pg8::Gemm g{WSP(bf16, WS_XG), WSP(bf16, WS_MW13), D, D}; MoeOrder S{mtb, 2 * FE / 256, F.G, F.bid, 0, mtb[40], 1, 0};
                EpiSwiglu E{WSP(bf16, WS_G), FE}; pg8::gemm_phase<EpiSwiglu, MoeOrder>(F.lds, g, S, E);
                SEAM(pb + 10);
            }
            if (IN(pb + 11)) {
                __syncthreads(); moe_tables(F, mtb, D / 256);
                const int nun = mtb[40], nfull0 = (nun / F.G) * F.G, nt0 = nun - nfull0;
                const int SK = nt0 == 0 ? 1 : (nt0 <= 32 ? 8 : (nt0 <= 64 ? 4 : (nt0 <= 128 ? 2 : 1)));
                const int nfull = SK == 1 ? nun : nfull0, ntail = nun - nfull;
                { pg8::Gemm g{WSP(bf16, WS_G), WSP(bf16, WS_MW2), FE, FE}; MoeOrder S{mtb, D / 256, F.G, F.bid, 0, nfull, 1, 0};
                  EpiF32 E{WSP(float, WS_Y), D}; pg8::gemm_phase<EpiF32, MoeOrder>(F.lds, g, S, E); }
                if (ntail > 0) { __syncthreads();
                  pg8::Gemm g{WSP(bf16, WS_G), WSP(bf16, WS_MW2), FE / SK, FE}; MoeOrder S{mtb, D / 256, F.G, F.bid, nfull, ntail * SK, SK, FE / SK};
                  EpiPart E{WSP(float, WS_PART)}; pg8::gemm_phase<EpiPart, MoeOrder>(F.lds, g, S, E); }
                SEAM(pb + 11);
            }
            if (IN(pb + 12)) {
                __syncthreads(); moe_tables(F, mtb, D / 256);
                const int nun = mtb[40], nfull0 = (nun / F.G) * F.G, nt0 = nun - nfull0;
                const int SK = nt0 == 0 ? 1 : (nt0 <= 32 ? 8 : (nt0 <= 64 ? 4 : (nt0 <= 128 ? 2 : 1)));
                const int nfull = SK == 1 ? nun : nfull0, ntail = nun - nfull;
                for (int it = F.bid; it < ntail * 8; it += F.G) { const int t = it >> 3, cg = it & 7;
                    MoeOrder S{mtb, D / 256, 1, 0, nfull + t, 1, 1, 0}; pg8::Unit u; S.next(0, u);
                    if (SK == 8) splitk_reduce_f32<8>(WSP(float, WS_PART), t, cg, u, WSP(float, WS_Y), D);
                    else if (SK == 4) splitk_reduce_f32<4>(WSP(float, WS_PART), t, cg, u, WSP(float, WS_Y), D);
                    else splitk_reduce_f32<2>(WSP(float, WS_PART), t, cg, u, WSP(float, WS_Y), D); }
                SEAM(pb + 12);
            }
            if (IN(pb + 13)) { moe_combine_phase(F, l); }
        }
}
__global__ void __launch_bounds__(NTHR, 2) fwd_kernel(Args args) {
    extern __shared__ __attribute__((aligned(16))) unsigned char lds[];
    Frame F;
    F.lds = (LAS unsigned char*)lds; F.ws = args.ws; F.out = args.out;
#pragma unroll
    for (int i = 0; i < 35; ++i) F.in[i] = args.in[i];
    F.tid = threadIdx.x; F.lane = F.tid & 63; F.wave = __builtin_amdgcn_readfirstlane(F.tid >> 6); F.G = gridDim.x; F.bid = blockIdx.x; F.rep = args.rep;
    volatile LAS unsigned* MISC = (volatile LAS unsigned*)(F.lds + MISC_OFF);
    if (F.tid < 64) MISC[F.tid] = 0u;
    __syncthreads();
    XcdBarrier bar; bar.bar = WSP(unsigned, WS_CTL) + CW_BAR; bar.x = 0; bar.st = nullptr;
    if (ONE_LAUNCH) bar = xcd_barrier_post(WSP(unsigned, WS_CTL) + CW_BAR, MISC + 8);
    const int lo = args.ph_lo, hi = args.ph_hi;

    if (IN(0)) { p0_prologue(F); SEAM(0); }

    layer_phases<0>(F, bar, lo, hi);
    layer_phases<1>(F, bar, lo, hi);
#undef IN
#undef SEAM
}

extern "C" void kernel_launch(void* const* d_in, const int* in_sizes, int n_in, void* d_out, int out_size, void* d_ws, size_t ws_size, hipStream_t stream) {
    static int grid = 0;
    if (grid == 0) {
        if (n_in != 35 || out_size != MLAT * D || ws_size < WS_END) { fprintf(stderr, "kernel_launch: unexpected shapes (n_in %d out %d ws %zu need %zu)\n", n_in, out_size, ws_size, (size_t)WS_END); grid = -1; return; }
        int dev = 0, cus = 0, per_cu = 0;
        if (hipGetDevice(&dev) != hipSuccess || hipDeviceGetAttribute(&cus, hipDeviceAttributeMultiprocessorCount, dev) != hipSuccess) { grid = -1; return; }
        if (hipFuncSetAttribute((const void*)fwd_kernel, hipFuncAttributeMaxDynamicSharedMemorySize, LDS_BYTES) != hipSuccess) { fprintf(stderr, "kernel_launch: hipFuncSetAttribute failed\n"); grid = -1; return; }
        if (hipOccupancyMaxActiveBlocksPerMultiprocessor(&per_cu, (const void*)fwd_kernel, NTHR, LDS_BYTES) != hipSuccess || per_cu < 1) { fprintf(stderr, "kernel_launch: occupancy query says %d\n", per_cu); }
        (void)hipGetLastError();
        grid = cus;
    }
    if (grid < 0) return;
    (void)hipMemsetAsync((char*)d_ws + WS_CTL, 0, CTL_ZERO_BYTES, stream);
    Args a{};
    for (int i = 0; i < 35; ++i) a.in[i] = (const float*)d_in[i];
    a.out = (float*)d_out; a.ws = (unsigned char*)d_ws; a.rep = UNIT_REP;
#if ONE_LAUNCH
    a.ph_lo = 0; a.ph_hi = 64;
    hipLaunchKernelGGL(fwd_kernel, dim3(grid), dim3(NTHR), LDS_BYTES, stream, a);
#else
    static const int phases[] = {0, 1, 2, 3, 4, 5, 6, 7, 8, 9, 11, 12, 17, 18, 19, 20, 21, 22, 23, 24, 25, 26, 27, 28, 29, 30};
    for (int k = 0; k < (int)(sizeof(phases) / sizeof(phases[0])); ++k) {
        a.ph_lo = phases[k]; a.ph_hi = phases[k] + 1;
        for (int rp = 0; rp < NREP(phases[k]); ++rp) hipLaunchKernelGGL(fwd_kernel, dim3(grid), dim3(NTHR), LDS_BYTES, stream, a);
    }
#endif
}
```

```cpp
#define NCV_P 48
#define NCV_OUT 96
#define NCV_UP 24
#define NCV_DOWN 96
#define FILL_MASK 0x7fffffffull
#define PROBE_MASK (0ull)
#define ONE_LAUNCH 1
#define UNIT_REP 0
#include <hip/hip_runtime.h>
#include <cstdio>
#include <cstdint>

#define DI __device__ __forceinline__
#define LAS __attribute__((address_space(3)))
#define GAS __attribute__((address_space(1)))
typedef unsigned short bf16;
typedef short bf16x8 __attribute__((ext_vector_type(8)));
typedef float f32x4 __attribute__((ext_vector_type(4)));
typedef float f32x2 __attribute__((ext_vector_type(2)));
typedef unsigned u32x4 __attribute__((ext_vector_type(4)));
typedef unsigned u32x2 __attribute__((ext_vector_type(2)));

namespace pg8 {
constexpr int BM = 256, BK = 64, HALF = 128, HTB = HALF * BK * 2, STAGE_BYTES = 8 * HTB, NXCD = 8, WGM = 8;
__host__ __device__ __forceinline__ int lds_byte(int r, int c) { const int st = (r >> 4) * 2 + (c >> 5), rr = r & 15, cc = c & 31, ob = rr * 64 + cc * 2; return st * 1024 + (ob ^ (((ob >> 9) & 1) << 5)); }
__host__ __device__ __forceinline__ void stage_rc(int b, int& R, int& C) { const int st = b / 1024, sb = b % 1024, swz = sb ^ (((sb >> 9) & 1) << 5); R = (st >> 1) * 16 + swz / 64; C = (st & 1) * 32 + (swz % 64) / 2; }
__host__ __device__ __forceinline__ int perm32(int rho) { const int n = rho >> 4, i = rho & 15; return 8 * (i >> 2) + 4 * n + (i & 3); }

struct Unit { int pm, pn, pb, koff, aux, pa; };
struct Gemm { const bf16* A; const bf16* Bt; int K, ld; };

DI int xcd_remap(int L, int nwg) { const int q = nwg / NXCD, r = nwg % NXCD, xcd = L % NXCD, off = L / NXCD; return (xcd < r ? xcd * (q + 1) : r * (q + 1) + (xcd - r) * q) + off; }

struct StaticOrder {
    int nM, nN, nwg, G, c;
    DI void init(int nM_, int nN_, int G_, int c_) { nM = nM_; nN = nN_; nwg = nM * nN; G = G_; c = c_; }
    DI bool next(int i, Unit& u) const {
        const long L = (long)i * G + c; if (L >= nwg) return false;
        const int wgid = xcd_remap((int)L, nwg);
        const int nig = WGM * nN, gid = wgid / nig, fm = gid * WGM, gsz = (nM - fm) < WGM ? (nM - fm) : WGM;
        u.pm = fm + ((wgid % nig) % gsz); u.pn = (wgid % nig) / gsz; u.pb = u.pn; u.koff = 0; u.aux = 0; u.pa = u.pm; return true;
    }
};

DI unsigned cvt_pk_bf16(float lo, float hi) { unsigned r; asm volatile("v_cvt_pk_bf16_f32 %0, %1, %2" : "=v"(r) : "v"(lo), "v"(hi)); return r; }

template <class Epi, class Sched, bool ALIGN_EPI = true>
DI void gemm_phase(LAS unsigned char* lds, const Gemm g, const Sched& S, const Epi& E) {
    const int tid = threadIdx.x, wid = __builtin_amdgcn_readfirstlane(tid >> 6), lane = tid & 63, wr = wid >> 2, wc = wid & 3, fr = lane & 15, fq = lane >> 4;
    const int K = g.K, nt = K / BK;
    unsigned voffA[2], voffB[2];
#pragma unroll
    for (int i = 0; i < 2; ++i) { int R, C; stage_rc(tid * 16 + i * 8192, R, C); const int Rb = Epi::PERM ? ((R & ~31) + perm32(R & 31)) : R;
        voffA[i] = (unsigned)(R * g.ld + C) * 2u; voffB[i] = (unsigned)(Rb * g.ld + C) * 2u; }
    const size_t kstep = (size_t)(BK * 2);
    const size_t hstep = (size_t)HALF * g.ld * 2;
    const size_t tstep = 2 * hstep;
    const unsigned ldsw = (unsigned)wid * 1024u;
    const int aoff = lds_byte(wr * 64 + fr, fq * 8), boff = lds_byte(wc * 32 + fr, fq * 8);
#define PG8_SA(b, h) (((b) * 2 + (h)) * HTB)
#define PG8_SB(b, h) ((4 + (b) * 2 + (h)) * HTB)
#define PG8_STAGE(bufoff, gbase, voff) do { _Pragma("unroll") for (int _i = 0; _i < 2; ++_i) \
        __builtin_amdgcn_global_load_lds((const unsigned*)((const char*)(gbase) + (voff)[_i]), (LAS unsigned*)(lds + (bufoff) + ldsw + _i * 8192), 16, 0, 0); } while (0)
#define PG8_LDA(dst, b, h) do { _Pragma("unroll") for (int m = 0; m < 4; ++m) _Pragma("unroll") for (int k = 0; k < 2; ++k) dst[m][k] = *(const LAS bf16x8*)(lds + PG8_SA(b, h) + aoff + m * 2048 + k * 1024); } while (0)
#define PG8_LDB(dst, b, h) do { _Pragma("unroll") for (int n = 0; n < 2; ++n) _Pragma("unroll") for (int k = 0; k < 2; ++k) dst[n][k] = *(const LAS bf16x8*)(lds + PG8_SB(b, h) + boff + n * 2048 + k * 1024); } while (0)
#define PG8_MMA(ai, bj, At, Bt) do { __builtin_amdgcn_s_setprio(1); _Pragma("unroll") for (int m = 0; m < 4; ++m) _Pragma("unroll") for (int n = 0; n < 2; ++n) _Pragma("unroll") for (int k = 0; k < 2; ++k) \
        acc[ai][bj][m][n] = __builtin_amdgcn_mfma_f32_16x16x32_bf16(Bt[n][k], At[m][k], acc[ai][bj][m][n], 0, 0, 0); __builtin_amdgcn_s_setprio(0); } while (0)
#define PG8_WAIT_V(n) asm volatile("s_waitcnt vmcnt(" #n ")" ::: "memory")
#define PG8_WAIT_L(n) asm volatile("s_waitcnt lgkmcnt(" #n ")" ::: "memory")
#define PG8_BAR __builtin_amdgcn_s_barrier()
#define PG8_SCHED __builtin_amdgcn_sched_barrier(0)
    Unit cur, nxt; int ui = 0;
    if (!S.next(0, cur)) return;
    f32x4 acc[2][2][4][2];
#pragma unroll
    for (int a = 0; a < 2; ++a)
#pragma unroll
        for (int b = 0; b < 2; ++b)
#pragma unroll
            for (int m = 0; m < 4; ++m)
#pragma unroll
                for (int n = 0; n < 2; ++n) acc[a][b][m][n] = (f32x4){0.f, 0.f, 0.f, 0.f};
    bf16x8 At[4][2], B0[2][2], B1[2][2];
    const char* cA = (const char*)g.A + (size_t)cur.pa * tstep + (size_t)cur.koff * 2; const char* cB = (const char*)g.Bt + (size_t)cur.pb * tstep + (size_t)cur.koff * 2;
    {
        PG8_STAGE(PG8_SB(0, 0), cB, voffB); PG8_STAGE(PG8_SB(0, 1), cB + hstep, voffB); PG8_STAGE(PG8_SA(0, 0), cA, voffA); PG8_STAGE(PG8_SA(0, 1), cA + hstep, voffA);
        if (wr == 1) PG8_BAR;
        PG8_WAIT_V(2); PG8_BAR;
        PG8_STAGE(PG8_SB(1, 0), cB + kstep, voffB); PG8_STAGE(PG8_SA(1, 0), cA + kstep, voffA); PG8_STAGE(PG8_SB(1, 1), cB + hstep + kstep, voffB);
        PG8_WAIT_V(6); PG8_BAR;
    }
    for (;;) {
        const bool has_next = S.next(ui + 1, nxt);
        const char* nA = has_next ? (const char*)g.A + (size_t)nxt.pa * tstep + (size_t)nxt.koff * 2 : cA; const char* nB = has_next ? (const char*)g.Bt + (size_t)nxt.pb * tstep + (size_t)nxt.koff * 2 : cB;
        for (int t = 0; t < nt; t += 2) {
            const bool last = (t == nt - 2);
            const char* a1 = cA + (size_t)(t + 1) * kstep;
            const char* a2 = last ? nA : cA + (size_t)(t + 2) * kstep; const char* b2 = last ? nB : cB + (size_t)(t + 2) * kstep;
            const char* a3 = a2 + kstep; const char* b3 = b2 + kstep;
            PG8_LDB(B0, 0, 0); PG8_LDB(B1, 0, 1); PG8_SCHED; PG8_LDA(At, 0, 0); PG8_STAGE(PG8_SA(1, 1), a1 + hstep, voffA);
            PG8_WAIT_V(8); PG8_WAIT_L(0); PG8_BAR; PG8_MMA(0, 0, At, B0); PG8_MMA(0, 1, At, B1); PG8_BAR; PG8_SCHED;
            PG8_LDA(At, 0, 1); PG8_STAGE(PG8_SB(0, 0), b2, voffB); PG8_STAGE(PG8_SB(0, 1), b2 + hstep, voffB); PG8_STAGE(PG8_SA(0, 0), a2, voffA);
            PG8_WAIT_V(8); PG8_WAIT_L(0); PG8_BAR; PG8_MMA(1, 0, At, B0); PG8_MMA(1, 1, At, B1); PG8_BAR; PG8_SCHED;
            PG8_LDB(B0, 1, 0); PG8_LDB(B1, 1, 1); PG8_SCHED; PG8_LDA(At, 1, 0); PG8_STAGE(PG8_SA(0, 1), a2 + hstep, voffA);
            PG8_WAIT_V(8); PG8_WAIT_L(0); PG8_BAR; PG8_MMA(0, 0, At, B0); PG8_MMA(0, 1, At, B1); PG8_BAR; PG8_SCHED;
            PG8_LDA(At, 1, 1); PG8_STAGE(PG8_SB(1, 0), b3, voffB); PG8_STAGE(PG8_SB(1, 1), b3 + hstep, voffB); PG8_STAGE(PG8_SA(1, 0), a3, voffA);
            PG8_WAIT_V(8); PG8_WAIT_L(0); PG8_BAR; PG8_MMA(1, 0, At, B0); PG8_MMA(1, 1, At, B1); PG8_BAR; PG8_SCHED;
        }
        if constexpr (ALIGN_EPI) { if (wr == 0) PG8_BAR; }
        E(acc, cur, wr, wc, fr, fq);
        if (!has_next) break;
#pragma unroll
        for (int a = 0; a < 2; ++a)
#pragma unroll
            for (int b = 0; b < 2; ++b)
#pragma unroll
                for (int m = 0; m < 4; ++m)
#pragma unroll
                    for (int n = 0; n < 2; ++n) acc[a][b][m][n] = (f32x4){0.f, 0.f, 0.f, 0.f};
        cur = nxt; cA = nA; cB = nB; ++ui;
        if constexpr (ALIGN_EPI) { if (wr == 1) PG8_BAR; }
    }
    PG8_WAIT_V(0);
    if constexpr (!ALIGN_EPI) { if (wr == 0) PG8_BAR; }
    PG8_BAR;
#undef PG8_SA
#undef PG8_SB
#undef PG8_STAGE
#undef PG8_LDA
#undef PG8_LDB
#undef PG8_MMA
#undef PG8_WAIT_V
#undef PG8_WAIT_L
#undef PG8_BAR
#undef PG8_SCHED
}
}
constexpr int D = 2048, NB = 4, TL = 2048, TC = 256, TS = TL + TC  ;
constexpr int MLAT = NB * TL  , MTOK = NB * (TL + TC)  ;
constexpr int DIN = 5824, DINP = 5888, D6 = 6 * D;
constexpr int FF = 5632, FE = 7168, NEXP = 8;
constexpr float EPS = 1e-6f;
constexpr int PC_MLQ = 0, PC_MLK = 512, PC_MLV = 1024, PC_MLO = 1536, PC_IG = 2048, PC_FG = 2056, PC_Z = 2064, PC_XBC = 2576, PC_DT = 3600,
              PC_CQ = 3616, PC_CKV = 4064, PC_KR = 4224, PC_NQ = 4288, PC_NK = 4800, PC_NV = 5312;
constexpr int NCHUNK = 36;
constexpr int MAXMT = 72;

constexpr size_t MiB = 1u << 20;
constexpr size_t WS_CTL = 0, CTL_ZERO_BYTES = 1 * MiB;
constexpr size_t WS_MOD = 1 * MiB;
constexpr size_t WS_WIN = 2 * MiB;
constexpr size_t WS_WOUT = WS_WIN + 46 * MiB;
constexpr size_t WS_WQB = WS_WOUT + 16 * MiB;
constexpr size_t WS_WKVB = WS_WQB + 2 * MiB;
constexpr size_t WS_W13 = WS_WKVB + 1 * MiB;
constexpr size_t WS_W2 = WS_W13 + 44 * MiB;
constexpr size_t WS_MW13 = WS_W2 + 22 * MiB;
constexpr size_t WS_MW2 = WS_MW13 + 448 * MiB;
constexpr size_t WS_HN = WS_MW2 + 224 * MiB;
constexpr size_t WS_A2 = WS_HN + 36 * MiB;
constexpr size_t WS_X = WS_A2 + 36 * MiB;
constexpr size_t WS_BIG = WS_X + 72 * MiB;
constexpr size_t WS_P = WS_BIG;
constexpr size_t WS_GRAW = WS_BIG + 104 * MiB;
constexpr size_t WS_CQN = WS_P + 207 * MiB;
constexpr size_t WS_CKVN = WS_CQN + 9 * MiB;
constexpr size_t WS_QRAW = WS_CKVN + 5 * MiB;
constexpr size_t WS_KVRAW = WS_QRAW + 14 * MiB;
constexpr size_t WS_QMLA = WS_KVRAW + 18 * MiB;
constexpr size_t WS_KMLA = WS_QMLA + 14 * MiB;
constexpr size_t WS_VTMLA = WS_KMLA + 14 * MiB;
constexpr size_t WS_QNA = WS_VTMLA + 9 * MiB;
constexpr size_t WS_KNA = WS_QNA + 9 * MiB;
constexpr size_t WS_VTNA = WS_KNA + 9 * MiB;
constexpr size_t WS_XBC = WS_VTNA + 9 * MiB;
constexpr size_t WS_DT = WS_XBC + 18 * MiB;
constexpr size_t WS_GATES = WS_DT + 1 * MiB;
constexpr size_t WS_MLSC = WS_GATES + 1 * MiB;
constexpr size_t WS_SSSC = WS_MLSC + 64 * 1024;
constexpr size_t WS_MLU = WS_MLSC + 1 * MiB;
constexpr size_t WS_MLS = WS_MLU + 73 * MiB;
constexpr size_t WS_SSU = WS_MLS + 37 * MiB;
constexpr size_t WS_SSS = WS_SSU + 72 * MiB;
constexpr size_t WS_HML = WS_SSS + 36 * MiB;
constexpr size_t WS_YSS = WS_HML + 36 * MiB;
constexpr size_t WS_MIXEND = WS_YSS + 36 * MiB;
constexpr size_t WS_G = WS_BIG;
constexpr size_t WS_Y = WS_G + 252 * MiB;
constexpr size_t WS_XG = WS_Y + 144 * MiB;
constexpr size_t WS_TOK = WS_XG + 256 * MiB;
constexpr size_t WS_PART = WS_TOK + 1 * MiB;
constexpr size_t WS_FFNEND = WS_PART + 64 * MiB;
constexpr size_t WS_END = (WS_MIXEND > WS_FFNEND ? WS_MIXEND : WS_FFNEND);
static_assert(WS_END < (size_t)1800 * MiB, "workspace budget");
static_assert((size_t)MTOK * DINP * 4 <= 207 * MiB && (size_t)32 * 36 * 129 * 128 * 4 <= 73 * MiB, "sizes");
constexpr int CW_BAR = 4096;
constexpr int CW_MOE = 16384;
constexpr int CW_QH = 20480;
constexpr int CW_ARR = 32768;

constexpr int RING_BYTES = 131072;
constexpr int MISC_OFF = 147456 - 256;
constexpr int LDS_BYTES = 147456;
constexpr int NWAVES = 8, NTHR = 512;

#define RLX_AGENT __ATOMIC_RELAXED, __HIP_MEMORY_SCOPE_AGENT
#define LDS_WAIT() asm volatile("s_waitcnt lgkmcnt(0)" ::: "memory")
#define VM_WAIT() asm volatile("s_waitcnt vmcnt(0)" ::: "memory")
DI unsigned f2bf(float f) { unsigned u = __builtin_bit_cast(unsigned, f); return (u + 0x7fffu + ((u >> 16) & 1u)) >> 16; }
DI unsigned pk2(float lo, float hi) { return f2bf(lo) | (f2bf(hi) << 16); }
DI float bf2f(unsigned b) { return __builtin_bit_cast(float, b << 16); }
DI float wave_sum(float v) {
#pragma unroll
    for (int o = 1; o < 64; o <<= 1) v += __shfl_xor(v, o);
    return v;
}
DI float wave_max(float v) {
#pragma unroll
    for (int o = 1; o < 64; o <<= 1) v = fmaxf(v, __shfl_xor(v, o));
    return v;
}
DI float wave_incl_scan(float v, int lane) {
#pragma unroll
    for (int o = 1; o < 64; o <<= 1) { const float t = __shfl_up(v, o); if (lane >= o) v += t; }
    return v;
}
DI float siluf(float x) { return x / (1.f + __expf(-x)); }
DI float sigmoidf_(float x) { return 1.f / (1.f + __expf(-x)); }
DI float softplusf_(float x) { return fmaxf(x, 0.f) + log1pf(__expf(-fabsf(x))); }
DI float logsigmoidf_(float x) { return fminf(x, 0.f) - log1pf(__expf(-fabsf(x))); }

#define XB_TMO      128
#define XB_XCNT(j)  (256  + 64 * (j))
#define XB_XSUB(j)  (1280 + 64 * (j))
#define XB_XGEN(j)  (2304 + 64 * (j))
#define XB_TOP      3328
#define XB_TOPGEN   3392
#define XCD_BAR_WORDS 3456
#define XB_SPIN_CAP (1u << 22)
DI unsigned xb_ld(unsigned* p)              { return __hip_atomic_load(p, __ATOMIC_RELAXED, __HIP_MEMORY_SCOPE_AGENT); }
DI unsigned xb_add(unsigned* p, unsigned v) { return __hip_atomic_fetch_add(p, v, __ATOMIC_RELAXED, __HIP_MEMORY_SCOPE_AGENT); }
DI unsigned xb_xcc_id() { return (unsigned)__builtin_amdgcn_s_getreg((3 << 11) | 20) & 0xFu; }
#define XB_SPIN(cond, bar) do { unsigned _sp = 0; while (cond) { __builtin_amdgcn_s_sleep(1); \
    if ((++_sp & 255u) == 0u) { if (xb_ld(&(bar)[XB_TMO])) break; if (_sp > XB_SPIN_CAP) { atomicAdd(&(bar)[XB_TMO], 1u); break; } } } } while (0)
struct XcdBarrier { unsigned* bar; unsigned x; volatile LAS unsigned* st; };
DI XcdBarrier xcd_barrier_post(unsigned* bar, volatile LAS unsigned* st) {
    XcdBarrier b; b.bar = bar; b.x = xb_xcc_id(); b.st = st;
    if (threadIdx.x == 0) (void)xb_add(&bar[XB_XCNT(b.x)], 1u);
    return b;
}
DI void xcd_barrier_complete(unsigned* bar, unsigned x, unsigned& nloc, unsigned& nx) {
    const unsigned G = gridDim.x * gridDim.y * gridDim.z;
    unsigned sum, cnt, mine, sp = 0u;
    for (;;) {
        sum = 0u; cnt = 0u; mine = 0u;
#pragma unroll
        for (unsigned j = 0; j < 16; ++j) { const unsigned c = xb_ld(&bar[XB_XCNT(j)]); sum += c; cnt += (c > 0u) ? 1u : 0u; mine = (j == x) ? c : mine; }
        if (sum == G) break;
        __builtin_amdgcn_s_sleep(1);
        if ((++sp & 255u) == 0u) { if (xb_ld(&bar[XB_TMO])) break; if (sp > XB_SPIN_CAP) { atomicAdd(&bar[XB_TMO], 1u); break; } }
    }
    nloc = mine > 0u ? mine : 1u; nx = cnt > 0u ? cnt : 1u;
}
DI void xcd_barrier(const XcdBarrier& b) {
    asm volatile("s_waitcnt vmcnt(0)" ::: "memory");
    __syncthreads();
    if (threadIdx.x == 0) {
        unsigned* bar = b.bar;
        __builtin_amdgcn_s_waitcnt(0);
        unsigned nloc = b.st[0], nx = b.st[1];
        if (nloc == 0u) { xcd_barrier_complete(bar, b.x, nloc, nx); b.st[0] = nloc; b.st[1] = nx; }
        const unsigned old = xb_add(&bar[XB_XSUB(b.x)], 1u);
        const unsigned gen = old / nloc;
        if (old + 1u == (gen + 1u) * nloc) {
            __builtin_amdgcn_fence(__ATOMIC_RELEASE, "agent");
            asm volatile("s_waitcnt vmcnt(0)" ::: "memory");
            const unsigned og = xb_add(&bar[XB_TOP], 1u);
            const unsigned tg = og / nx;
            if (og + 1u == (tg + 1u) * nx) xb_add(&bar[XB_TOPGEN], 1u);
            else XB_SPIN(xb_ld(&bar[XB_TOPGEN]) == tg, bar);
            __builtin_amdgcn_fence(__ATOMIC_ACQUIRE, "agent");
            xb_add(&bar[XB_XGEN(b.x)], 1u);
            asm volatile("s_waitcnt vmcnt(0)" ::: "memory");
        } else {
            XB_SPIN(xb_ld(&bar[XB_XGEN(b.x)]) == gen, bar);
            __builtin_amdgcn_fence(__ATOMIC_ACQUIRE, "agent");
            asm volatile("s_waitcnt vmcnt(0)" ::: "memory");
        }
    }
    __syncthreads();
}

struct Args { const float* in[35]; float* out; unsigned char* ws; int ph_lo, ph_hi, rep, pad; };
struct Frame {
    LAS unsigned char* lds;
    unsigned char* ws;
    const float* in[35];
    float* out;
    int tid, lane, wave, G, bid, rep;
};
#define WSP(T, off) ((T*)(F.ws + (off)))
DI int rowof(int b, int j) { return j < TL ? b * TL + j : MLAT + b * TC + (j - TL); }

template <int K> DI f32x4 mma16(const LAS bf16* A, int lda, const LAS bf16* Bt, int ldb, int lane, f32x4 acc) {
    const int r = lane & 15, q = lane >> 4;
    const LAS bf16* pa = A + r * lda + 8 * q; const LAS bf16* pb = Bt + r * ldb + 8 * q;
#pragma unroll
    for (int k = 0; k < K; k += 32) {
        const bf16x8 a = *(const LAS bf16x8*)(pa + k); const bf16x8 b = *(const LAS bf16x8*)(pb + k);
        acc = __builtin_amdgcn_mfma_f32_16x16x32_bf16(a, b, acc, 0, 0, 0);
    }
    return acc;
}
struct CvDesc { const float* src; bf16* dst; size_t ld, Kd; int Kv, Nv, k0, n0, dn0; };
DI void tr_load(const CvDesc& d, f32x4 (&v)[16], int lane) {
    const int nn = 4 * (lane & 15), kq = lane >> 4;
#pragma unroll
    for (int i = 0; i < 16; ++i) { const int kk = 4 * i + kq;
        v[i] = (f32x4){0.f, 0.f, 0.f, 0.f};
        if (d.k0 + kk < d.Kv && d.n0 + nn < d.Nv) v[i] = __builtin_nontemporal_load((const f32x4*)(d.src + (size_t)(d.k0 + kk) * d.ld + d.n0 + nn)); }
}
DI void tr_lds(const f32x4 (&v)[16], LAS float* scr, int lane) {
    const int nn = 4 * (lane & 15), kq = lane >> 4;
#pragma unroll
    for (int i = 0; i < 16; ++i) { const int kk = 4 * i + kq; LAS float* s = scr + kk * 65 + nn; s[0] = v[i][0]; s[1] = v[i][1]; s[2] = v[i][2]; s[3] = v[i][3]; }
    LDS_WAIT(); asm volatile("" ::: "memory");
}
DI void tr_out(const CvDesc& d, LAS float* scr, int lane) {
    const int c = lane & 7;
#pragma unroll
    for (int j = 0; j < 8; ++j) { const int n = (lane >> 3) + 8 * j; const LAS float* s = scr + (8 * c) * 65 + n;
        u32x4 o; o.x = pk2(s[0 * 65], s[1 * 65]); o.y = pk2(s[2 * 65], s[3 * 65]); o.z = pk2(s[4 * 65], s[5 * 65]); o.w = pk2(s[6 * 65], s[7 * 65]);
        *(u32x4*)(d.dst + (size_t)(d.dn0 + n) * d.Kd + d.k0 + 8 * c) = o; }
    LDS_WAIT(); asm volatile("" ::: "memory");
}
DI int il_row(int n0, int which) { return (n0 >> 7) * 256 + (n0 & 127) + which * 128; }

constexpr int I_IN = 32 * 92, I_OUT = 32 * 32, I_QB = 8 * 12, I_KVB = 4 * 16, I_F1 = 32 * 88, I_F2 = 88 * 32, I_M1 = 32 * 112, I_M2 = 112 * 32;
constexpr int I_L = I_IN + I_OUT + I_QB + I_KVB;
constexpr int CV_NE = I_L + 2 * I_F1 + I_F2, CV_NQ1 = CV_NE + I_L, CV_NALL = CV_NQ1 + NEXP * (2 * I_M1 + I_M2);
DI CvDesc conv_decode(Frame& F, int it) {
    int r = it;
    if (r >= CV_NQ1) { r -= CV_NQ1;
        if (r < NEXP * 2 * I_M1) { const int e = r / (2 * I_M1); r -= e * 2 * I_M1; const int which = r / I_M1; r -= which * I_M1; const int kb = r / 112, nb = r % 112;
            return CvDesc{(which ? F.in[33] : F.in[32]) + (size_t)e * D * FE, WSP(bf16, WS_MW13) + (size_t)e * 2 * FE * D, (size_t)(FE), (size_t)(D), D, FE, 64 * kb, 64 * nb, il_row(64 * nb, which)}; }
        r -= NEXP * 2 * I_M1;
        { const int e = r / I_M2; r -= e * I_M2; const int kb = r / 32, nb = r % 32;
            return CvDesc{F.in[34] + (size_t)e * FE * D, WSP(bf16, WS_MW2) + (size_t)e * D * FE, (size_t)(D), (size_t)(FE), FE, D, 64 * kb, 64 * nb, 64 * nb}; }
    }
    int l = 0;
    if (r >= CV_NE) { r -= CV_NE; l = 1; }
    else if (r >= I_L) { r -= I_L;
        if (r < 2 * I_F1) { const int which = r / I_F1; r -= which * I_F1; const int kb = r / 88, nb = r % 88;
            return CvDesc{(which ? F.in[29] : F.in[28]), WSP(bf16, WS_W13), (size_t)(FF), (size_t)(D), D, FF, 64 * kb, 64 * nb, il_row(64 * nb, which)}; }
        r -= 2 * I_F1;
        { const int kb = r / 32, nb = r % 32; return CvDesc{F.in[30], WSP(bf16, WS_W2), (size_t)(D), (size_t)(FF), FF, D, 64 * kb, 64 * nb, 64 * nb}; }
    }
    if (r < I_IN) { const int kb = r / 92, nb = r % 92;
        return CvDesc{F.in[7] + (size_t)l * D * DIN, WSP(bf16, WS_WIN) + (size_t)l * DINP * D, (size_t)(DIN), (size_t)(D), D, DIN, 64 * kb, 64 * nb, 64 * nb}; }
    r -= I_IN;
    if (r < I_OUT) { const int kb = r / 32, nb = r % 32;
        return CvDesc{F.in[8] + (size_t)l * D * D, WSP(bf16, WS_WOUT) + (size_t)l * D * D, (size_t)(D), (size_t)(D), D, D, 64 * kb, 64 * nb, 64 * nb}; }
    r -= I_OUT;
    if (r < I_QB) { const int kb = r / 12, nb = r % 12;
        return CvDesc{F.in[19] + (size_t)l * 448 * 768, WSP(bf16, WS_WQB) + (size_t)l * 768 * 512, (size_t)(768), (size_t)(512), 448, 768, 64 * kb, 64 * nb, 64 * nb}; }
    r -= I_QB;
    { const int kb = r / 16, nb = r % 16;
        return CvDesc{F.in[21] + (size_t)l * 160 * 1024, WSP(bf16, WS_WKVB) + (size_t)l * 1024 * 256, (size_t)(1024), (size_t)(256), 160, 1024, 64 * kb, 64 * nb, 64 * nb}; }
}

DI void conv_item(Frame& F, int it, LAS float* scr) { const CvDesc d = conv_decode(F, it); f32x4 v[16]; tr_load(d, v, F.lane); tr_lds(v, scr, F.lane); tr_out(d, scr, F.lane); }
DI void conv_items(Frame& F, int it0, int n, LAS float* scr) {
    if (it0 >= CV_NALL) return;
    if (it0 + n > CV_NALL) n = CV_NALL - it0;
    CvDesc d = conv_decode(F, it0); f32x4 v[16]; tr_load(d, v, F.lane);
    for (int k = 0; k < n; ++k) {
        tr_lds(v, scr, F.lane);
        CvDesc dn = d;
        if (k + 1 < n) { dn = conv_decode(F, it0 + k + 1); tr_load(dn, v, F.lane); }
        tr_out(d, scr, F.lane);
        d = dn;
    }
}
DI void p0_prologue(Frame& F) {
    {
        LAS float* sc = (LAS float*)F.lds;
        LAS float* red = (LAS float*)(F.lds + 5 * 2048 * 4);
        bool have = false;
        for (int u = F.bid; u < 2 * 96; u += F.G) {
            if (!have) {
                for (int i = F.tid; i < 5 * 2048; i += NTHR) { const float x = (i < 4 * 2048) ? F.in[1][i] : F.in[3][i - 4 * 2048]; sc[i] = siluf(x); }
                have = true;
            }
            __syncthreads();
            const int l = u / 96, j0 = (u % 96) * 128;
            const float* W = F.in[4] + (size_t)l * D * D6 + j0 + 2 * F.lane;
            f32x2 acc[5];
#pragma unroll
            for (int r = 0; r < 5; ++r) acc[r] = (f32x2){0.f, 0.f};
            const int kb = F.wave * 256;
            for (int k = 0; k < 256; k += 8) {
                f32x2 w[8];
#pragma unroll
                for (int i = 0; i < 8; ++i) w[i] = *(const f32x2*)(W + (size_t)(kb + k + i) * D6);
#pragma unroll
                for (int i = 0; i < 8; ++i)
#pragma unroll
                    for (int r = 0; r < 5; ++r) { const float s = sc[r * 2048 + kb + k + i]; acc[r] += w[i] * s; }
            }
#pragma unroll
            for (int r = 0; r < 5; ++r) { red[(F.wave * 5 + r) * 128 + 2 * F.lane] = acc[r][0]; red[(F.wave * 5 + r) * 128 + 2 * F.lane + 1] = acc[r][1]; }
            __syncthreads();
            for (int i = F.tid; i < 5 * 128; i += NTHR) { const int r = i / 128, j = i % 128; float s = F.in[5][l * D6 + j0 + j];
#pragma unroll
                for (int w = 0; w < 8; ++w) s += red[(w * 5 + r) * 128 + j];
                WSP(float, WS_MOD)[(l * 5 + r) * D6 + j0 + j] = s; }
        }
        __syncthreads();
    }
    LAS float* scr = (LAS float*)(F.lds + F.wave * 16640);
    const int gw = F.bid * NWAVES + F.wave, NGW = F.G * NWAVES;
    for (int it = gw; it < I_L; it += NGW) conv_item(F, it, scr);
}

constexpr int CV_EAGER = I_L;
constexpr int CV_NDEF = CV_NALL - CV_EAGER;
DI void conv_fill(Frame& F, int phase, bool work) {
    LAS float* scr = (LAS float*)(F.lds + F.wave * 16640);
    volatile LAS int* bc = (volatile LAS int*)(F.lds + MISC_OFF) + 16;
    unsigned* ctl = WSP(unsigned, WS_CTL);
    __syncthreads();
    if (F.tid == 0) __hip_atomic_fetch_add(ctl + CW_ARR + 64 * phase, 1u, RLX_AGENT);
    if (!work) return;
    for (;;) {
        if (F.tid == 0) {
            int base = -1;
            if (__hip_atomic_load(ctl + CW_ARR + 64 * phase, RLX_AGENT) < (unsigned)F.G) { base = (int)__hip_atomic_fetch_add(ctl + CW_QH, 32u, RLX_AGENT); if (base >= CV_NDEF) base = -1; }
            bc[0] = base;
        }
        __syncthreads();
        const int base = bc[0];
        __syncthreads();
        if (base < 0) break;
        conv_items(F, CV_EAGER + base + F.wave * 4, 4, scr);
    }
}
DI void conv_drain(Frame& F, int upto) {
    LAS float* scr = (LAS float*)(F.lds + F.wave * 16640);
    volatile LAS int* bc = (volatile LAS int*)(F.lds + MISC_OFF) + 16;
    unsigned* ctl = WSP(unsigned, WS_CTL);
    __syncthreads();
    for (;;) {
        if (F.tid == 0) {
            int base = -1;
            if ((int)__hip_atomic_load(ctl + CW_QH, RLX_AGENT) < upto) { base = (int)__hip_atomic_fetch_add(ctl + CW_QH, 64u, RLX_AGENT); if (base >= CV_NDEF) base = -1; }
            bc[0] = base;
        }
        __syncthreads();
        const int base = bc[0];
        __syncthreads();
        if (base < 0) break;
        conv_items(F, CV_EAGER + base + F.wave * 8, 8, scr);
    }
}
template <bool ROUTE>
DI void norm_phase(Frame& F, int l, const float* srcLat, const float* srcCtx, const float* g, int shoff, int nrows) {
    LAS float* rl = (LAS float*)F.lds;
    if (ROUTE) { for (int i = F.tid; i < D * NEXP; i += NTHR) rl[i] = F.in[31][i]; __syncthreads(); }
    const int gw = F.bid * NWAVES + F.wave, NGW = F.G * NWAVES;
    bf16* HN = WSP(bf16, WS_HN);
    for (int row = gw; row < nrows; row += NGW) {
        const float* xr = row < MLAT ? srcLat + (size_t)row * D : srcCtx + (size_t)(row - MLAT) * D;
        const int br = row < MLAT ? row / TL : 4;
        const float* mrow = WSP(float, WS_MOD) + (size_t)(l * 5 + br) * D6 + shoff;
        f32x4 v[8]; float ss = 0.f;
#pragma unroll
        for (int j = 0; j < 8; ++j) { v[j] = *(const f32x4*)(xr + 4 * F.lane + 256 * j); ss += (v[j][0] * v[j][0] + v[j][1] * v[j][1]) + (v[j][2] * v[j][2] + v[j][3] * v[j][3]); }
        const float rstd = 1.0f / sqrtf(wave_sum(ss) * (1.f / D) + EPS);
        float lg[8]; u32x2 wk[8];
        if (ROUTE) {
#pragma unroll
            for (int e = 0; e < 8; ++e) lg[e] = 0.f; }
#pragma unroll
        for (int j = 0; j < 8; ++j) { const int c = 4 * F.lane + 256 * j;
            const f32x4 gg = *(const f32x4*)(g + c), sh = *(const f32x4*)(mrow + c), sc = *(const f32x4*)(mrow + D + c);
            f32x4 o;
#pragma unroll
            for (int i = 0; i < 4; ++i) o[i] = v[j][i] * rstd * gg[i] * (1.f + sc[i]) + sh[i];
            u32x2 w; w.x = pk2(o[0], o[1]); w.y = pk2(o[2], o[3]);
            if (ROUTE) wk[j] = w; else *(u32x2*)(HN + (size_t)row * D + c) = w;
            if (ROUTE) {
#pragma unroll
                for (int i = 0; i < 4; ++i) { const f32x4 r0 = *(const LAS f32x4*)(rl + (c + i) * 8), r1 = *(const LAS f32x4*)(rl + (c + i) * 8 + 4);
                    lg[0] += o[i] * r0[0]; lg[1] += o[i] * r0[1]; lg[2] += o[i] * r0[2]; lg[3] += o[i] * r0[3];
                    lg[4] += o[i] * r1[0]; lg[5] += o[i] * r1[1]; lg[6] += o[i] * r1[2]; lg[7] += o[i] * r1[3]; }
                __builtin_amdgcn_sched_barrier(0);
            }
        }
        if (ROUTE) {
#pragma unroll
            for (int e = 0; e < 8; ++e) lg[e] = wave_sum(lg[e]);
            int r1 = 0, r2 = 0;
            if (F.lane == 0) {
                int e1 = 0; float v1 = lg[0];
#pragma unroll
                for (int e = 1; e < 8; ++e) if (lg[e] > v1) { v1 = lg[e]; e1 = e; }
                int e2 = -1; float v2 = -3.0e38f;
#pragma unroll
                for (int e = 0; e < 8; ++e) if (e != e1 && lg[e] > v2) { v2 = lg[e]; e2 = e; }
                const float g2 = 1.f / (1.f + expf(v1 - v2)), g1 = 1.f - g2;
                unsigned* cnt = WSP(unsigned, WS_CTL) + CW_MOE;
                const unsigned p1 = __hip_atomic_fetch_add(cnt + e1, 1u, RLX_AGENT), p2 = __hip_atomic_fetch_add(cnt + e2, 1u, RLX_AGENT);
                int* tk = WSP(int, WS_TOK) + (size_t)row * 8;
                tk[0] = e1; tk[1] = (int)p1; tk[2] = e2; tk[3] = (int)p2; ((float*)tk)[4] = g1; ((float*)tk)[5] = g2;
                r1 = e1 * MLAT + (int)p1; r2 = e2 * MLAT + (int)p2;
            }
            r1 = __shfl(r1, 0); r2 = __shfl(r2, 0);
            bf16* XS = WSP(bf16, WS_XG);
#pragma unroll
            for (int j = 0; j < 8; ++j) { const int c = 4 * F.lane + 256 * j; *(u32x2*)(XS + (size_t)r1 * D + c) = wk[j]; *(u32x2*)(XS + (size_t)r2 * D + c) = wk[j]; }
        }
    }
}

DI void moe_tables(Frame& F, LAS int* tb, int NT) {
    if (F.tid == 0) {
        const unsigned* cnt = WSP(unsigned, WS_CTL) + CW_MOE; int ts = 0, us = 0;
        for (int e = 0; e < 8; ++e) { const int c = (int)__hip_atomic_load(cnt + e, RLX_AGENT); const int t = (c + 255) >> 8; tb[e] = c; tb[8 + e] = t; tb[16 + e] = ts; tb[32 + e] = us; ts += t; us += t * NT; }
        tb[24] = ts; tb[40] = us;
    }
    __syncthreads();
}
DI void moe_combine_phase(Frame& F, int l) {
    LAS int* tb = (LAS int*)F.lds; __syncthreads(); moe_tables(F, tb, 1);
    const int gw = F.bid * NWAVES + F.wave, NGW = F.G * NWAVES;
    const float* Y = WSP(float, WS_Y); const float* X = WSP(float, WS_X);
    for (int row = gw; row < MLAT; row += NGW) {
        const int* tk = WSP(int, WS_TOK) + (size_t)row * 8;
        const float g1 = ((const float*)tk)[4], g2 = ((const float*)tk)[5];
        const int s1 = tb[16 + tk[0]] * 256 + tk[1], s2 = tb[16 + tk[2]] * 256 + tk[3];
        const float* mrow = WSP(float, WS_MOD) + (size_t)(l * 5 + row / TL) * D6 + 5 * D;
        f32x4 xv[8], y1[8], y2[8];
#pragma unroll
        for (int j = 0; j < 8; ++j) { const int c = 4 * F.lane + 256 * j;
            xv[j] = *(const f32x4*)(X + (size_t)row * D + c); y1[j] = *(const f32x4*)(Y + (size_t)s1 * D + c); y2[j] = *(const f32x4*)(Y + (size_t)s2 * D + c); }
#pragma unroll
        for (int j = 0; j < 8; ++j) { const int c = 4 * F.lane + 256 * j; const f32x4 gg = *(const f32x4*)(mrow + c);
            *(f32x4*)(F.out + (size_t)row * D + c) = xv[j] + gg * (y1[j] * g1 + y2[j] * g2); }
    }
}
using pg8::Unit;
struct EpiF32 {
    static constexpr bool PERM = false;
    float* C; int ldc;
    DI void operator()(const f32x4 (&acc)[2][2][4][2], const Unit& u, int wr, int wc, int fr, int fq) const {
        const int row0 = u.pm * 256 + wr * 64 + fr, col0 = u.pn * 256 + wc * 32 + 4 * fq;
#pragma unroll
        for (int ai = 0; ai < 2; ++ai)
#pragma unroll
            for (int m = 0; m < 4; ++m) { float* rowp = C + (size_t)(row0 + ai * 128 + m * 16) * ldc + col0;
#pragma unroll
                for (int bj = 0; bj < 2; ++bj)
#pragma unroll
                    for (int n = 0; n < 2; ++n) *(f32x4*)(rowp + bj * 128 + n * 16) = acc[ai][bj][m][n]; }
    }
};
struct EpiBf16 {
    static constexpr bool PERM = true;
    bf16* O; int ldc;
    DI void operator()(const f32x4 (&acc)[2][2][4][2], const Unit& u, int wr, int wc, int fr, int fq) const {
        const int row0 = u.pm * 256 + wr * 64 + fr, col0 = u.pn * 256 + wc * 32 + 8 * fq;
#pragma unroll
        for (int ai = 0; ai < 2; ++ai)
#pragma unroll
            for (int m = 0; m < 4; ++m) { bf16* rowp = O + (size_t)(row0 + ai * 128 + m * 16) * ldc + col0;
#pragma unroll
                for (int bj = 0; bj < 2; ++bj) { const f32x4 v0 = acc[ai][bj][m][0], v1 = acc[ai][bj][m][1];
                    u32x4 w; w.x = pg8::cvt_pk_bf16(v0[0], v0[1]); w.y = pg8::cvt_pk_bf16(v0[2], v0[3]); w.z = pg8::cvt_pk_bf16(v1[0], v1[1]); w.w = pg8::cvt_pk_bf16(v1[2], v1[3]);
                    *(u32x4*)(rowp + bj * 128) = w; } }
    }
};
struct EpiP {
    static constexpr bool PERM = true;
    bf16* O; float* graw;
    DI void operator()(const f32x4 (&acc)[2][2][4][2], const Unit& u, int wr, int wc, int fr, int fq) const {
        const int row0 = u.pm * 256 + wr * 64 + fr, col0 = u.pn * 256 + wc * 32 + 8 * fq;
#pragma unroll
        for (int ai = 0; ai < 2; ++ai)
#pragma unroll
            for (int m = 0; m < 4; ++m) { bf16* rowp = O + (size_t)(row0 + ai * 128 + m * 16) * DINP + col0;
#pragma unroll
                for (int bj = 0; bj < 2; ++bj) { const f32x4 v0 = acc[ai][bj][m][0], v1 = acc[ai][bj][m][1];
                    u32x4 w; w.x = pg8::cvt_pk_bf16(v0[0], v0[1]); w.y = pg8::cvt_pk_bf16(v0[2], v0[3]); w.z = pg8::cvt_pk_bf16(v1[0], v1[1]); w.w = pg8::cvt_pk_bf16(v1[2], v1[3]);
                    *(u32x4*)(rowp + bj * 128) = w; } }
        const bool gsel = (u.pn == 8 && wc == 0 && fq < 2), dsel = (u.pn == 14 && wc == 0 && fq >= 2);
        if (gsel || dsel) { const int off = gsel ? 8 * fq : 16 + 8 * (fq - 2);
#pragma unroll
            for (int ai = 0; ai < 2; ++ai)
#pragma unroll
                for (int m = 0; m < 4; ++m) { float* gp = graw + (size_t)(row0 + ai * 128 + m * 16) * 32 + off;
                    *(f32x4*)gp = acc[ai][0][m][0]; *(f32x4*)(gp + 4) = acc[ai][0][m][1]; } }
    }
};
struct EpiSwiglu {
    static constexpr bool PERM = true;
    bf16* O; int ldc;
    DI void operator()(const f32x4 (&acc)[2][2][4][2], const Unit& u, int wr, int wc, int fr, int fq) const {
        const int row0 = u.pm * 256 + wr * 64 + fr, col0 = u.pn * 128 + wc * 32 + 8 * fq;
#pragma unroll
        for (int ai = 0; ai < 2; ++ai)
#pragma unroll
            for (int m = 0; m < 4; ++m) { bf16* rowp = O + (size_t)(row0 + ai * 128 + m * 16) * ldc + col0;
                f32x4 v0, v1;
#pragma unroll
                for (int j = 0; j < 4; ++j) { v0[j] = siluf(acc[ai][0][m][0][j]) * acc[ai][1][m][0][j]; v1[j] = siluf(acc[ai][0][m][1][j]) * acc[ai][1][m][1][j]; }
                u32x4 w; w.x = pg8::cvt_pk_bf16(v0[0], v0[1]); w.y = pg8::cvt_pk_bf16(v0[2], v0[3]); w.z = pg8::cvt_pk_bf16(v1[0], v1[1]); w.w = pg8::cvt_pk_bf16(v1[2], v1[3]);
                *(u32x4*)rowp = w; }
    }
};
struct EpiResid {
    static constexpr bool PERM = false;
    const float* baseLat; const float* baseCtx; float* out; const float* mod;
    DI void operator()(const f32x4 (&acc)[2][2][4][2], const Unit& u, int wr, int wc, int fr, int fq) const {
        const int row0 = u.pm * 256 + wr * 64 + fr, col0 = u.pn * 256 + wc * 32 + 4 * fq;
        const int br = (u.pm * 256 < MLAT) ? (u.pm * 256) / TL : 4;
        const float* gate = mod + (size_t)br * D6 + col0;
        f32x4 gv[2][2];
#pragma unroll
        for (int bj = 0; bj < 2; ++bj)
#pragma unroll
            for (int n = 0; n < 2; ++n) gv[bj][n] = *(const f32x4*)(gate + bj * 128 + n * 16);
#pragma unroll
        for (int ai = 0; ai < 2; ++ai)
#pragma unroll
            for (int m = 0; m < 4; ++m) { const int row = row0 + ai * 128 + m * 16;
                const float* bp = (row < MLAT ? baseLat + (size_t)row * D : baseCtx + (size_t)(row - MLAT) * D) + col0; float* op = out + (size_t)row * D + col0;
#pragma unroll
                for (int bj = 0; bj < 2; ++bj)
#pragma unroll
                    for (int n = 0; n < 2; ++n) { const f32x4 b = *(const f32x4*)(bp + bj * 128 + n * 16); *(f32x4*)(op + bj * 128 + n * 16) = b + gv[bj][n] * acc[ai][bj][m][n]; } }
    }
};
struct MoeOrder {
    const LAS int* tb; int NT, G, c, L0, nT, S, KS, acap;
    DI bool next(int i, Unit& u) const {
        const long T = (long)i * G + c; if (T >= nT) return false;
        const int nun = tb[40], L = L0 + (int)T / S, sl = (int)T % S;
        const int w = pg8::xcd_remap(L, nun); int e = 0;
#pragma unroll
        for (int k = 1; k < 8; ++k) if (w >= tb[32 + k]) e = k;
        const int rem = w - tb[32 + e], tiles = tb[8 + e], nt = rem / tiles, mtl = rem - nt * tiles;
        u.pm = tb[16 + e] + mtl; u.pn = nt; u.pb = e * NT + nt; u.koff = sl * KS; u.aux = (int)T; u.pa = acap ? e * acap + mtl : u.pm; return true;
    }
};
struct EpiPart {
    static constexpr bool PERM = false;
    float* part;
    DI void operator()(const f32x4 (&acc)[2][2][4][2], const Unit& u, int wr, int wc, int fr, int fq) const {
        f32x4* p = (f32x4*)part + (size_t)u.aux * (32 * NTHR) + threadIdx.x;
#pragma unroll
        for (int ai = 0; ai < 2; ++ai)
#pragma unroll
            for (int bj = 0; bj < 2; ++bj)
#pragma unroll
                for (int m = 0; m < 4; ++m)
#pragma unroll
                    for (int n = 0; n < 2; ++n) p[(size_t)(((ai * 2 + bj) * 4 + m) * 2 + n) * NTHR] = acc[ai][bj][m][n];
    }
};
template <int S> DI void splitk_reduce_f32(const float* part, int t, int cg, const Unit& u, float* C, int ldc) {
    const int tid = threadIdx.x, wid = tid >> 6, lane = tid & 63, wr = wid >> 2, wc = wid & 3, fr = lane & 15, fq = lane >> 4;
    f32x4 v[4][S];
#pragma unroll
    for (int k = 0; k < 4; ++k)
#pragma unroll
        for (int s = 0; s < S; ++s) v[k][s] = *((const f32x4*)part + ((size_t)(t * S + s) * 32 + (cg * 4 + k)) * NTHR + tid);
#pragma unroll
    for (int k = 0; k < 4; ++k) { const int ch = cg * 4 + k, n = ch & 1, m = (ch >> 1) & 3, bj = (ch >> 3) & 1, ai = ch >> 4;
        f32x4 a = v[k][0];
#pragma unroll
        for (int s = 1; s < S; ++s) a += v[k][s];
        *(f32x4*)(C + (size_t)(u.pm * 256 + ai * 128 + wr * 64 + m * 16 + fr) * ldc + u.pn * 256 + bj * 128 + wc * 32 + n * 16 + 4 * fq) = a; }
}
DI int tc_of(int dir, int p) { return dir == 0 ? (p < 4 ? 32 + p : p - 4) : 35 - p; }

DI void m1_prep_unit(Frame& F, int l, int b, int tt) {
    const bf16* P = WSP(bf16, WS_P); const float* GR = WSP(float, WS_GRAW);
    const int j0 = tt * 32, lane = F.lane;
    LAS bf16* vs = (LAS bf16*)F.lds;
    for (int i = F.wave; i < 32; i += 8) {
        const int j = j0 + i, row = rowof(b, j);
        const bf16* p = P + (size_t)row * DINP; const float* gr = GR + (size_t)row * 32;
        float cq[7], ckv[3], nq[4][2], nk[4][2]; bf16 nv[8];
#pragma unroll
        for (int u = 0; u < 7; ++u) cq[u] = bf2f(p[PC_CQ + lane + 64 * u]);
#pragma unroll
        for (int u = 0; u < 3; ++u) { const int idx = lane + 64 * u; ckv[u] = idx < 160 ? bf2f(p[PC_CKV + idx]) : 0.f; }
#pragma unroll
        for (int h = 0; h < 4; ++h) { nq[h][0] = bf2f(p[PC_NQ + h * 128 + lane]); nq[h][1] = bf2f(p[PC_NQ + h * 128 + 64 + lane]); nk[h][0] = bf2f(p[PC_NK + h * 128 + lane]); nk[h][1] = bf2f(p[PC_NK + h * 128 + 64 + lane]); }
#pragma unroll
        for (int u = 0; u < 8; ++u) nv[u] = p[PC_NV + lane + 64 * u];
        const float gi = lane < 8 ? gr[lane] : 0.f, gf = lane < 8 ? gr[8 + lane] : 0.f, gd = lane < 16 ? gr[16 + lane] : 0.f;
        {
            float ss = 0.f;
#pragma unroll
            for (int u = 0; u < 7; ++u) ss += cq[u] * cq[u];
            const float rstd = 1.0f / sqrtf(wave_sum(ss) * (1.f / 448.f) + EPS);
            const float* qn = F.in[18] + l * 448; bf16* o = WSP(bf16, WS_CQN) + (size_t)row * 512;
#pragma unroll
            for (int u = 0; u < 7; ++u) o[lane + 64 * u] = (bf16)f2bf(cq[u] * rstd * qn[lane + 64 * u]);
            o[448 + lane] = 0;
        }
        {
            float ss = 0.f;
#pragma unroll
            for (int u = 0; u < 3; ++u) ss += ckv[u] * ckv[u];
            const float rstd = 1.0f / sqrtf(wave_sum(ss) * (1.f / 160.f) + EPS);
            const float* kn = F.in[20] + l * 160; bf16* o = WSP(bf16, WS_CKVN) + (size_t)row * 256;
#pragma unroll
            for (int u = 0; u < 3; ++u) { const int idx = lane + 64 * u; o[idx] = idx < 160 ? (bf16)f2bf(ckv[u] * rstd * kn[idx]) : (bf16)0; }
            o[192 + lane] = 0;
        }
        const float* gq = F.in[24] + l * 128; const float* gk = F.in[25] + l * 128;
#pragma unroll
        for (int h = 0; h < 4; ++h) {
            const float rq = 1.0f / sqrtf(wave_sum(nq[h][0] * nq[h][0] + nq[h][1] * nq[h][1]) * (1.f / 128.f) + EPS);
            const float rk = 1.0f / sqrtf(wave_sum(nk[h][0] * nk[h][0] + nk[h][1] * nk[h][1]) * (1.f / 128.f) + EPS);
            bf16* oq = WSP(bf16, WS_QNA) + ((size_t)(b * 4 + h) * TS + j) * 128; bf16* ok = WSP(bf16, WS_KNA) + ((size_t)(b * 4 + h) * TS + j) * 128;
            oq[lane] = (bf16)f2bf(nq[h][0] * rq * gq[lane]); oq[64 + lane] = (bf16)f2bf(nq[h][1] * rq * gq[64 + lane]);
            ok[lane] = (bf16)f2bf(nk[h][0] * rk * gk[lane]); ok[64 + lane] = (bf16)f2bf(nk[h][1] * rk * gk[64 + lane]);
        }
#pragma unroll
        for (int u = 0; u < 8; ++u) vs[i * 520 + lane + 64 * u] = nv[u];
        if (lane < 8) {
            float* gt = WSP(float, WS_GATES) + (size_t)row * 16;
            gt[lane] = gi + F.in[9][l * 8 + lane];
            gt[8 + lane] = logsigmoidf_(gf + F.in[10][l * 8 + lane]);
        }
        if (lane < 16) WSP(float, WS_DT)[(size_t)row * 16 + lane] = softplusf_(gd + F.in[14][l * 16 + lane]);
    }
    {
        const int ch = 2 * F.tid;
        const int seglo = j0 < TL ? 0 : TL, seghi = j0 < TL ? TL : TS;
        const float* cw = F.in[12] + (size_t)l * 5 * 1024 + ch; const float* cb = F.in[13] + (size_t)l * 1024 + ch;
        f32x2 w[5];
#pragma unroll
        for (int d = 0; d < 5; ++d) w[d] = *(const f32x2*)(cw + d * 1024);
        const f32x2 bias = *(const f32x2*)cb;
        f32x2 xin[36];
#pragma unroll
        for (int d = 0; d < 36; ++d) { const int jj = j0 - 2 + d; unsigned xw = 0u; if (jj >= seglo && jj < seghi) xw = *(const unsigned*)(P + (size_t)rowof(b, jj) * DINP + PC_XBC + ch); xin[d] = (f32x2){bf2f(xw & 0xffffu), bf2f(xw >> 16)}; }
#pragma unroll
        for (int i = 0; i < 32; ++i) {
            f32x2 a = bias;
#pragma unroll
            for (int d = 0; d < 5; ++d) a += w[d] * xin[i + d];
            *(unsigned*)(WSP(bf16, WS_XBC) + (size_t)rowof(b, j0 + i) * 1024 + ch) = pk2(siluf(a[0]), siluf(a[1]));
        }
    }
    __syncthreads();
    {
        const int t = F.tid; unsigned wv[16];
#pragma unroll
        for (int i = 0; i < 16; ++i) wv[i] = (unsigned)vs[(2 * i) * 520 + t] | ((unsigned)vs[(2 * i + 1) * 520 + t] << 16);
        u32x4* dst = (u32x4*)(WSP(bf16, WS_VTNA) + ((size_t)(b * 4 + (t >> 7)) * 128 + (t & 127)) * TS + j0);
#pragma unroll
        for (int k = 0; k < 4; ++k) dst[k] = (u32x4){wv[4 * k], wv[4 * k + 1], wv[4 * k + 2], wv[4 * k + 3]};
    }
    __syncthreads();
}

DI void ml_a_unit(Frame& F, int seq, int p) {
    const int b = seq >> 3, h = (seq >> 1) & 3, dir = seq & 1, tc = tc_of(dir, p), lane = F.lane;
    const bf16* P = WSP(bf16, WS_P);
    LAS bf16* VW = (LAS bf16*)F.lds;
    LAS bf16* KT = (LAS bf16*)(F.lds + 20736);
    LAS float* wgs = (LAS float*)(F.lds + 39168);
    if (F.wave == 0) {
        const int row = rowof(b, tc * 64 + lane);
        const float* gt = WSP(float, WS_GATES) + (size_t)row * 16;
        const float li = gt[dir * 4 + h], lf = gt[8 + dir * 4 + h];
        const float pre = wave_incl_scan(lf, lane), tot = __shfl(pre, 63);
        const float g = dir == 0 ? (tot - pre) + li : (pre - lf) + li;
        const float mloc = wave_max(g);
        wgs[lane] = __expf(g - mloc);
        if (lane == 0) { float* sc = WSP(float, WS_MLSC) + (size_t)(seq * 36 + p) * 4; sc[0] = tot; sc[1] = mloc; }
    }
    {
        float vv[16], kk[16];
#pragma unroll
        for (int it = 0; it < 16; ++it) { const int idx = F.tid + NTHR * it, n = idx >> 7, d = idx & 127;
            const bf16* pr = P + (size_t)rowof(b, tc * 64 + n) * DINP + h * 128 + d; vv[it] = bf2f(pr[PC_MLV]); kk[it] = bf2f(pr[PC_MLK]); }
        __syncthreads();
#pragma unroll
        for (int it = 0; it < 16; ++it) { const int idx = F.tid + NTHR * it, n = idx >> 7, d = idx & 127;
            VW[d * 72 + n] = (bf16)f2bf(vv[it] * wgs[n]); KT[d * 72 + n] = (bf16)f2bf(kk[it]); }
    }
    for (int idx = F.tid; idx < 16 * 64; idx += NTHR) { const int rr = idx >> 6, n = idx & 63; VW[(128 + rr) * 72 + n] = rr == 0 ? (bf16)f2bf(wgs[n]) : (bf16)0; }
    __syncthreads();
    float* U = WSP(float, WS_MLU) + (size_t)(seq * 36 + p) * (129 * 128);
    for (int id = F.wave; id < 72; id += 8) { const int dt = id >> 3, et = id & 7;
        const f32x4 acc = mma16<64>(VW + dt * 16 * 72, 72, KT + et * 16 * 72, 72, lane, (f32x4){0.f, 0.f, 0.f, 0.f});
#pragma unroll
        for (int i = 0; i < 4; ++i) { const int d = dt * 16 + 4 * (lane >> 4) + i; if (d < 129) U[d * 128 + et * 16 + (lane & 15)] = acc[i]; } }
    __syncthreads();
}

DI void ss_a_unit(Frame& F, int l, int b, int dir, int p, int g) {
    const int tc = tc_of(dir, p), lane = F.lane;
    LAS bf16* XT = (LAS bf16*)F.lds;
    LAS bf16* BT = (LAS bf16*)(F.lds + 36864);
    LAS float* tails = (LAS float*)(F.lds + 55296);
    const bf16* XBC = WSP(bf16, WS_XBC);
    if (F.wave < 4) {
        const int h = 4 * g + F.wave, row = rowof(b, tc * 64 + lane);
        const float dt = WSP(float, WS_DT)[(size_t)row * 16 + dir * 8 + h];
        const float A = -__expf(F.in[15][l * 16 + dir * 8 + h]);
        const float a = dt * A, pre = wave_incl_scan(a, lane), tot = __shfl(pre, 63);
        tails[F.wave * 64 + lane] = (dir == 0 ? __expf(tot - pre) : __expf(pre - a)) * dt;
        if (lane == 0) WSP(float, WS_SSSC)[(size_t)((b * 8 + h) * 2 + dir) * 36 + p] = __expf(tot);
    }
    {
        bf16 xv[32], bv[16];
#pragma unroll
        for (int it = 0; it < 32; ++it) { const int idx = F.tid + NTHR * it, n = idx >> 8, c = idx & 255; xv[it] = XBC[(size_t)rowof(b, tc * 64 + n) * 1024 + g * 256 + c]; }
#pragma unroll
        for (int it = 0; it < 16; ++it) { const int idx = F.tid + NTHR * it, n = idx >> 7, nn = idx & 127; bv[it] = XBC[(size_t)rowof(b, tc * 64 + n) * 1024 + 512 + g * 128 + nn]; }
        __syncthreads();
#pragma unroll
        for (int it = 0; it < 32; ++it) { const int idx = F.tid + NTHR * it, n = idx >> 8, c = idx & 255; XT[c * 72 + n] = (bf16)f2bf(bf2f(xv[it]) * tails[(c >> 6) * 64 + n]); }
#pragma unroll
        for (int it = 0; it < 16; ++it) { const int idx = F.tid + NTHR * it, n = idx >> 7, nn = idx & 127; BT[nn * 72 + n] = bv[it]; }
    }
    __syncthreads();
    for (int id = F.wave; id < 128; id += 8) { const int hh = id >> 5, rem = id & 31, pt = rem >> 3, nt = rem & 7;
        const f32x4 acc = mma16<64>(XT + (hh * 64 + pt * 16) * 72, 72, BT + nt * 16 * 72, 72, lane, (f32x4){0.f, 0.f, 0.f, 0.f});
        float* U = WSP(float, WS_SSU) + (size_t)(((b * 8 + 4 * g + hh) * 2 + dir) * 36 + p) * 8192;
#pragma unroll
        for (int i = 0; i < 4; ++i) U[(pt * 16 + 4 * (lane >> 4) + i) * 128 + nt * 16 + (lane & 15)] = acc[i]; }
    __syncthreads();
}
DI void ml_scan_unit(Frame& F, int seq, int s4) {
    float* sc = WSP(float, WS_MLSC) + (size_t)seq * 36 * 4;
    const float* U = WSP(float, WS_MLU) + (size_t)seq * 36 * 16512 + s4 * 4128 + F.tid; bf16* S = WSP(bf16, WS_MLS) + (size_t)seq * 36 * 16512 + s4 * 4128 + F.tid;
    float st[9]; float m = 0.f;
#pragma unroll
    for (int k = 0; k < 9; ++k) st[k] = 0.f;
    for (int pg = 0; pg < 36; pg += 12) {
        float u[12][9];
#pragma unroll
        for (int pp = 0; pp < 12; ++pp)
#pragma unroll
            for (int k = 0; k < 9; ++k) u[pp][k] = (F.tid + 512 * k < 4128) ? U[(size_t)(pg + pp) * 16512 + 512 * k] : 0.f;
#pragma unroll
        for (int pp = 0; pp < 12; ++pp) { const int p = pg + pp;
            const float bl = sc[p * 4], mloc = sc[p * 4 + 1];
            const float mn = fmaxf(bl + m, mloc), wc = __expf(bl + m - mn), wu = __expf(mloc - mn);
            if (s4 == 0 && F.tid == 0) sc[p * 4 + 2] = m;
#pragma unroll
            for (int k = 0; k < 9; ++k) { if (F.tid + 512 * k < 4128) S[(size_t)p * 16512 + 512 * k] = (bf16)f2bf(st[k]); st[k] = wc * st[k] + wu * u[pp][k]; }
            m = mn; }
    }
}
DI void ss_scan_unit(Frame& F, int sq, int half) {
    const float* dec = WSP(float, WS_SSSC) + (size_t)sq * 36;
    const float* U = WSP(float, WS_SSU) + (size_t)sq * 36 * 8192 + half * 4096 + F.tid; bf16* S = WSP(bf16, WS_SSS) + (size_t)sq * 36 * 8192 + half * 4096 + F.tid;
    float st[8];
#pragma unroll
    for (int k = 0; k < 8; ++k) st[k] = 0.f;
    for (int pg = 0; pg < 36; pg += 12) {
        float u[12][8];
#pragma unroll
        for (int pp = 0; pp < 12; ++pp)
#pragma unroll
            for (int k = 0; k < 8; ++k) u[pp][k] = U[(size_t)(pg + pp) * 8192 + 512 * k];
#pragma unroll
        for (int pp = 0; pp < 12; ++pp) { const int p = pg + pp; const float dc = dec[p];
#pragma unroll
            for (int k = 0; k < 8; ++k) { S[(size_t)p * 8192 + 512 * k] = (bf16)f2bf(st[k]); st[k] = st[k] * dc + u[pp][k]; } }
    }
}
DI void mla_post_unit(Frame& F, int l, int b, int tt) {
    const bf16* P = WSP(bf16, WS_P);
    const bf16* QRAW = WSP(bf16, WS_QRAW); const bf16* KVRAW = WSP(bf16, WS_KVRAW);
    const int j0 = tt * 32, lane = F.lane;
    LAS bf16* vs = (LAS bf16*)F.lds;
    const float* gq = F.in[22] + l * 192; const float* gk = F.in[23] + l * 192;
    float qv[4][4][3], kk[4][4][2], krv[4]; bf16 vv[4][4][2];
#pragma unroll
    for (int it = 0; it < 4; ++it) {
        const int row = rowof(b, j0 + F.wave + 8 * it);
        krv[it] = bf2f(P[(size_t)row * DINP + PC_KR + lane]);
#pragma unroll
        for (int h = 0; h < 4; ++h) { const bf16* q = QRAW + (size_t)row * 768 + h * 192; const bf16* kv = KVRAW + (size_t)row * 1024 + h * 256;
            qv[it][h][0] = bf2f(q[lane]); qv[it][h][1] = bf2f(q[64 + lane]); qv[it][h][2] = bf2f(q[128 + lane]);
            kk[it][h][0] = bf2f(kv[lane]); kk[it][h][1] = bf2f(kv[64 + lane]); vv[it][h][0] = kv[128 + lane]; vv[it][h][1] = kv[192 + lane]; }
    }
    const float gq0 = gq[lane], gq1 = gq[64 + lane], gq2 = gq[128 + lane], gk0 = gk[lane], gk1 = gk[64 + lane], gk2 = gk[128 + lane];
    const int a = lane & 31;
    const float fr = exp2f(-(float)(a & 15) * (13.287712379549449f / 16.f));
#pragma unroll
    for (int it = 0; it < 4; ++it) {
        const int i = F.wave + 8 * it, j = j0 + i; const bool lat = j < TL;
        const float pos = (float)(a < 16 ? (j >> 6) : (j & 63));
        const float ang = pos * fr; const float cs = __cosf(ang), sn = __sinf(ang);
#pragma unroll
        for (int h = 0; h < 4; ++h) {
            {
                const float v0 = qv[it][h][0], v1 = qv[it][h][1], v2 = qv[it][h][2];
                const float rstd = 1.0f / sqrtf(wave_sum(v0 * v0 + v1 * v1 + v2 * v2) * (1.f / 192.f) + EPS);
                const float n0 = v0 * rstd * gq0, n1 = v1 * rstd * gq1; float n2 = v2 * rstd * gq2;
                const float pr = __shfl_xor(n2, 32);
                if (lat) n2 = lane < 32 ? n2 * cs - pr * sn : pr * sn + n2 * cs;
                bf16* o = WSP(bf16, WS_QMLA) + ((size_t)(b * 4 + h) * TS + j) * 192;
                o[lane] = (bf16)f2bf(n0); o[64 + lane] = (bf16)f2bf(n1); o[128 + lane] = (bf16)f2bf(n2);
            }
            {
                const float v0 = kk[it][h][0], v1 = kk[it][h][1], v2 = krv[it];
                const float rstd = 1.0f / sqrtf(wave_sum(v0 * v0 + v1 * v1 + v2 * v2) * (1.f / 192.f) + EPS);
                const float n0 = v0 * rstd * gk0, n1 = v1 * rstd * gk1; float n2 = v2 * rstd * gk2;
                const float pr = __shfl_xor(n2, 32);
                if (lat) n2 = lane < 32 ? n2 * cs - pr * sn : pr * sn + n2 * cs;
                bf16* o = WSP(bf16, WS_KMLA) + ((size_t)(b * 4 + h) * TS + j) * 192;
                o[lane] = (bf16)f2bf(n0); o[64 + lane] = (bf16)f2bf(n1); o[128 + lane] = (bf16)f2bf(n2);
                vs[i * 520 + h * 128 + lane] = vv[it][h][0]; vs[i * 520 + h * 128 + 64 + lane] = vv[it][h][1];
            }
        }
    }
    __syncthreads();
    {
        const int t = F.tid; unsigned wv[16];
#pragma unroll
        for (int i = 0; i < 16; ++i) wv[i] = (unsigned)vs[(2 * i) * 520 + t] | ((unsigned)vs[(2 * i + 1) * 520 + t] << 16);
        u32x4* dst = (u32x4*)(WSP(bf16, WS_VTMLA) + ((size_t)(b * 4 + (t >> 7)) * 128 + (t & 127)) * TS + j0);
#pragma unroll
        for (int k = 0; k < 4; ++k) dst[k] = (u32x4){wv[4 * k], wv[4 * k + 1], wv[4 * k + 2], wv[4 * k + 3]};
    }
    __syncthreads();
}

template <int DK, bool NA>
DI void attn_unit(Frame& F, const bf16* Qg, const bf16* Kg, const bf16* VTg, int nA, int tA0, int nB, int tB0, float scale, bf16* Og, int qrow0, const float* rpb) {
    constexpr int KP = DK + 8, KCH = DK / 8, NKC = 64 * KCH / NTHR;
    LAS bf16* Ks = (LAS bf16*)F.lds;
    LAS bf16* VTs = (LAS bf16*)(F.lds + 64 * KP * 2);
    LAS bf16* Ps = (LAS bf16*)(F.lds + 64 * KP * 2 + 128 * 72 * 2) + F.wave * (16 * 72);
    LAS float* rp = (LAS float*)(F.lds + 64 * KP * 2 + 128 * 72 * 2 + 8 * 16 * 72 * 2);
    const int lane = F.lane, r = lane & 15, q = lane >> 4, tid = F.tid, w = F.wave;
    if (NA) { for (int i = tid; i < 15 * 31; i += NTHR) rp[i] = rpb[i]; }
    bf16x8 qf[DK / 32];
#pragma unroll
    for (int kk = 0; kk < DK / 32; ++kk) qf[kk] = *(const bf16x8*)(Qg + (size_t)(w * 16 + r) * DK + 32 * kk + 8 * q);
    f32x4 o[8]; float mrow[4], lrow[4];
#pragma unroll
    for (int d = 0; d < 8; ++d) o[d] = (f32x4){0.f, 0.f, 0.f, 0.f};
#pragma unroll
    for (int i = 0; i < 4; ++i) { mrow[i] = -1.0e30f; lrow[i] = 0.f; }
    const int ntile = nA + nB;
    u32x4 kreg[NKC], vreg[2];
    const int rq = qrow0 + (w >> 2);
    const int r0 = rq - 4 < 0 ? 0 : (rq - 4 > 24 ? 24 : rq - 4);
#define ATT_LOAD(kt) do { _Pragma("unroll") for (int c = 0; c < NKC; ++c) { const int id = tid + NTHR * c, rr = id / KCH, cc = id % KCH; kreg[c] = *(const u32x4*)(Kg + (size_t)((kt) * 64 + rr) * DK + cc * 8); } \
        _Pragma("unroll") for (int c = 0; c < 2; ++c) { const int id = tid + NTHR * c, dd = id >> 3, cc = id & 7; vreg[c] = *(const u32x4*)(VTg + (size_t)dd * TS + (kt) * 64 + cc * 8); } } while (0)
    ATT_LOAD(nA > 0 ? tA0 : tB0);
    for (int it = 0; it < ntile; ++it) {
        const int kt = it < nA ? tA0 + it : tB0 + (it - nA);
        __syncthreads();
#pragma unroll
        for (int c = 0; c < NKC; ++c) { const int id = tid + NTHR * c, rr = id / KCH, cc = id % KCH; *(LAS u32x4*)(Ks + rr * KP + cc * 8) = kreg[c]; }
#pragma unroll
        for (int c = 0; c < 2; ++c) { const int id = tid + NTHR * c, dd = id >> 3, cc = id & 7; *(LAS u32x4*)(VTs + dd * 72 + cc * 8) = vreg[c]; }
        __syncthreads();
        if (it + 1 < ntile) { const int kn = (it + 1) < nA ? tA0 + it + 1 : tB0 + (it + 1 - nA); ATT_LOAD(kn); }
        const bool nbt = NA && kt < 32;
        if (nbt && (kt < r0 || kt >= r0 + 8)) continue;
        f32x4 s[4];
#pragma unroll
        for (int n = 0; n < 4; ++n) s[n] = (f32x4){0.f, 0.f, 0.f, 0.f};
#pragma unroll
        for (int kk = 0; kk < DK / 32; ++kk)
#pragma unroll
            for (int n = 0; n < 4; ++n) { const bf16x8 kf = *(const LAS bf16x8*)(Ks + (n * 16 + r) * KP + 32 * kk + 8 * q); s[n] = __builtin_amdgcn_mfma_f32_16x16x32_bf16(qf[kk], kf, s[n], 0, 0, 0); }
        float mx[4];
#pragma unroll
        for (int i = 0; i < 4; ++i) mx[i] = -1.0e30f;
#pragma unroll
        for (int n = 0; n < 4; ++n)
#pragma unroll
            for (int i = 0; i < 4; ++i) {
                float v = s[n][i] * scale;
                if (nbt) { const int c = (w & 3) * 16 + 4 * q + i, kc = n * 16 + r; const int c0 = c - 8 < 0 ? 0 : (c - 8 > 48 ? 48 : c - 8);
                    v = (kc >= c0 && kc < c0 + 16) ? v + rp[(kt - rq + 7) * 31 + (kc - c + 15)] : -1.0e30f; }
                s[n][i] = v; mx[i] = fmaxf(mx[i], v);
            }
        float alpha[4], rs[4];
#pragma unroll
        for (int i = 0; i < 4; ++i) {
            float m = mx[i]; m = fmaxf(m, __shfl_xor(m, 1)); m = fmaxf(m, __shfl_xor(m, 2)); m = fmaxf(m, __shfl_xor(m, 4)); m = fmaxf(m, __shfl_xor(m, 8));
            const float mn = fmaxf(mrow[i], m); alpha[i] = __expf(mrow[i] - mn); mrow[i] = mn; rs[i] = 0.f;
        }
#pragma unroll
        for (int n = 0; n < 4; ++n)
#pragma unroll
            for (int i = 0; i < 4; ++i) { const float pv = __expf(s[n][i] - mrow[i]); rs[i] += pv; Ps[(4 * q + i) * 72 + n * 16 + r] = (bf16)f2bf(pv); }
#pragma unroll
        for (int i = 0; i < 4; ++i) {
            float t = rs[i]; t += __shfl_xor(t, 1); t += __shfl_xor(t, 2); t += __shfl_xor(t, 4); t += __shfl_xor(t, 8);
            lrow[i] = lrow[i] * alpha[i] + t;
        }
#pragma unroll
        for (int d = 0; d < 8; ++d)
#pragma unroll
            for (int i = 0; i < 4; ++i) o[d][i] *= alpha[i];
        asm volatile("s_waitcnt lgkmcnt(0)" ::: "memory");
#pragma unroll
        for (int kk = 0; kk < 2; ++kk) { const bf16x8 pf = *(const LAS bf16x8*)(Ps + r * 72 + 32 * kk + 8 * q);
#pragma unroll
            for (int d = 0; d < 8; ++d) { const bf16x8 vf = *(const LAS bf16x8*)(VTs + (d * 16 + r) * 72 + 32 * kk + 8 * q); o[d] = __builtin_amdgcn_mfma_f32_16x16x32_bf16(pf, vf, o[d], 0, 0, 0); } }
    }
#undef ATT_LOAD
#pragma unroll
    for (int i = 0; i < 4; ++i) { const float inv = 1.0f / lrow[i]; bf16* op = Og + (size_t)(w * 16 + 4 * q + i) * D + r;
#pragma unroll
        for (int d = 0; d < 8; ++d) op[d * 16] = (bf16)f2bf(o[d][i] * inv); }
    __syncthreads();
}
typedef float f32x16 __attribute__((ext_vector_type(16)));
typedef short s16x4 __attribute__((ext_vector_type(4)));
template <int DK, bool NA>
DI void attn_unit2(Frame& F, const bf16* Qg, const bf16* Kg, const bf16* VTg, int nA, int tA0, int nB, int tB0, float sc2, bf16* Og, int qrow0, const float* rpb) {
    constexpr int KP = DK + 8, KCH = DK / 8, NKC = 64 * KCH / NTHR, NKK = DK / 16;
    constexpr int KTB = 64 * KP * 2, VTB = 128 * 72 * 2, BUFB = KTB + VTB;
    const int lane = F.lane, l32 = lane & 31, h = lane >> 5, tid = F.tid, w = F.wave, g = w & 3, kp = w >> 2;
    LAS float* rp = (LAS float*)(F.lds + 2 * BUFB);
    if (NA) { for (int i = tid; i < 15 * 31; i += NTHR) rp[i] = rpb[i] * 1.4426950408889634f; }
    bf16x8 qf[NKK];
#pragma unroll
    for (int kk = 0; kk < NKK; ++kk) qf[kk] = *(const bf16x8*)(Qg + (size_t)(32 * g + l32) * DK + 16 * kk + 8 * h);
    f32x16 o[4]; float mrun = -1.0e30f, lrun = 0.f;
#pragma unroll
    for (int d = 0; d < 4; ++d)
#pragma unroll
        for (int i = 0; i < 16; ++i) o[d][i] = 0.f;
    const int ntile = nA + nB;
    const int rq = qrow0 + (g >> 1), r0 = rq - 4 < 0 ? 0 : (rq - 4 > 24 ? 24 : rq - 4);
    const int cq = 32 * (g & 1) + l32, c0 = cq - 8 < 0 ? 0 : (cq - 8 > 48 ? 48 : cq - 8);
    u32x4 kreg[NKC], vreg[2];
#define ATT2_TILE(it) ((it) < nA ? tA0 + (it) : tB0 + ((it) - nA))
#define ATT2_LOAD(it) do { const int kt_ = ATT2_TILE(it); \
        _Pragma("unroll") for (int c = 0; c < NKC; ++c) { const int id = tid + NTHR * c, rr = id / KCH, cc = id % KCH; kreg[c] = *(const u32x4*)(Kg + (size_t)(kt_ * 64 + rr) * DK + cc * 8); } \
        _Pragma("unroll") for (int c = 0; c < 2; ++c) { const int id = tid + NTHR * c, dd = id >> 3, cc = id & 7; vreg[c] = *(const u32x4*)(VTg + (size_t)dd * TS + kt_ * 64 + cc * 8); } } while (0)
#define ATT2_STORE(b) do { \
        _Pragma("unroll") for (int c = 0; c < NKC; ++c) { const int id = tid + NTHR * c, rr = id / KCH, cc = id % KCH; *(LAS u32x4*)(F.lds + (b) * BUFB + (rr * KP + cc * 8) * 2) = kreg[c]; } \
        _Pragma("unroll") for (int c = 0; c < 2; ++c) { const int id = tid + NTHR * c, dd = id >> 3, cc = id & 7; *(LAS u32x4*)(F.lds + (b) * BUFB + KTB + (dd * 72 + cc * 8) * 2) = vreg[c]; } } while (0)
    ATT2_LOAD(0); ATT2_STORE(0);
    __syncthreads();
    for (int st = 0; st < ntile; ++st) {
        if (st + 1 < ntile) ATT2_LOAD(st + 1);
        const int kt = ATT2_TILE(st);
        const bool nbt = NA && kt < 32;
        if (!(nbt && (kt < r0 || kt >= r0 + 8))) {
            const LAS bf16* Ks = (const LAS bf16*)(F.lds + (st & 1) * BUFB) + (kp * 32 + l32) * KP + 8 * h;
            const LAS bf16* VTs = (const LAS bf16*)(F.lds + (st & 1) * BUFB + KTB) + l32 * 72 + kp * 32 + 4 * h;
            f32x16 s;
#pragma unroll
            for (int i = 0; i < 16; ++i) s[i] = 0.f;
#pragma unroll
            for (int kk = 0; kk < NKK; ++kk) { const bf16x8 kf = *(const LAS bf16x8*)(Ks + 16 * kk); s = __builtin_amdgcn_mfma_f32_32x32x16_bf16(kf, qf[kk], s, 0, 0, 0); }
            float mx = -1.0e30f;
#pragma unroll
            for (int i = 0; i < 16; ++i) {
                float v = s[i] * sc2;
                if (nbt) { const int kc = kp * 32 + 8 * (i >> 2) + 4 * h + (i & 3); v = (kc >= c0 && kc < c0 + 16) ? v + rp[(kt - rq + 7) * 31 + (kc - cq + 15)] : -1.0e30f; }
                s[i] = v; mx = fmaxf(mx, v);
            }
            mx = fmaxf(mx, __shfl_xor(mx, 32));
            const float mn = fmaxf(mrun, mx), alpha = __builtin_amdgcn_exp2f(mrun - mn); mrun = mn;
            float rs = 0.f;
#pragma unroll
            for (int i = 0; i < 16; ++i) { const float pv = __builtin_amdgcn_exp2f(s[i] - mn); s[i] = pv; rs += pv; }
            rs += __shfl_xor(rs, 32);
            lrun = lrun * alpha + rs;
            if (__any(alpha != 1.0f)) {
#pragma unroll
                for (int d = 0; d < 4; ++d)
#pragma unroll
                    for (int i = 0; i < 16; ++i) o[d][i] *= alpha;
            }
#pragma unroll
            for (int sp = 0; sp < 2; ++sp) {
                u32x4 pw; pw.x = pg8::cvt_pk_bf16(s[8 * sp + 0], s[8 * sp + 1]); pw.y = pg8::cvt_pk_bf16(s[8 * sp + 2], s[8 * sp + 3]);
                pw.z = pg8::cvt_pk_bf16(s[8 * sp + 4], s[8 * sp + 5]); pw.w = pg8::cvt_pk_bf16(s[8 * sp + 6], s[8 * sp + 7]);
                const bf16x8 pf = __builtin_bit_cast(bf16x8, pw);
#pragma unroll
                for (int d = 0; d < 4; ++d) { const LAS bf16* vp = VTs + d * 32 * 72 + 16 * sp;
                    const u32x2 lo = *(const LAS u32x2*)vp, hi = *(const LAS u32x2*)(vp + 8);
                    const u32x4 vv = (u32x4){lo.x, lo.y, hi.x, hi.y};
                    o[d] = __builtin_amdgcn_mfma_f32_32x32x16_bf16(__builtin_bit_cast(bf16x8, vv), pf, o[d], 0, 0, 0); }
            }
        }
        if (st + 1 < ntile) ATT2_STORE((st + 1) & 1);
        __syncthreads();
    }
#undef ATT2_LOAD
#undef ATT2_STORE
#undef ATT2_TILE
    LAS float* ob = (LAS float*)F.lds + g * (66 * 64);
    if (kp == 1) {
#pragma unroll
        for (int d = 0; d < 4; ++d)
#pragma unroll
            for (int i = 0; i < 16; ++i) ob[(d * 16 + i) * 64 + lane] = o[d][i];
        ob[64 * 64 + lane] = mrun; ob[65 * 64 + lane] = lrun;
    }
    __syncthreads();
    if (kp == 0) {
        const float m1 = ob[64 * 64 + lane], l1 = ob[65 * 64 + lane];
        const float mf = fmaxf(mrun, m1), a0 = __builtin_amdgcn_exp2f(mrun - mf), a1 = __builtin_amdgcn_exp2f(m1 - mf);
        const float inv = 1.0f / (lrun * a0 + l1 * a1);
        bf16* op = Og + (size_t)(32 * g + l32) * D + 4 * h;
#pragma unroll
        for (int d = 0; d < 4; ++d)
#pragma unroll
            for (int i4 = 0; i4 < 4; ++i4) {
                float r[4];
#pragma unroll
                for (int j = 0; j < 4; ++j) r[j] = (o[d][4 * i4 + j] * a0 + ob[(d * 16 + 4 * i4 + j) * 64 + lane] * a1) * inv;
                u32x2 wv; wv.x = pk2(r[0], r[1]); wv.y = pk2(r[2], r[3]);
                *(u32x2*)(op + d * 32 + 8 * i4) = wv;
            }
    }
    __syncthreads();
}
DI void ml_c_unit(Frame& F, int seq, int p) {
    const int b = seq >> 3, h = (seq >> 1) & 3, dir = seq & 1, tc = tc_of(dir, p), lane = F.lane, tid = F.tid;
    const bf16* P = WSP(bf16, WS_P);
    constexpr float QS = 0.08838834764831845f;
    LAS bf16* Qs = (LAS bf16*)F.lds;
    LAS bf16* Ksm = (LAS bf16*)(F.lds + 17408);
    LAS bf16* VT = (LAS bf16*)(F.lds + 34816);
    LAS bf16* Cx = (LAS bf16*)(F.lds + 55552);
    LAS bf16* SW = (LAS bf16*)(F.lds + 94720);
    LAS float* av = (LAS float*)(F.lds + 103936);
    LAS float* Mt = av + 64;
    LAS float* Bt = av + 128;
    LAS float* den = av + 192;
    const float m_p = WSP(float, WS_MLSC)[(size_t)(seq * 36 + p) * 4 + 2];
    if (F.wave == 0) {
        const int row = rowof(b, tc * 64 + lane);
        const float* gt = WSP(float, WS_GATES) + (size_t)row * 16;
        const float li = gt[dir * 4 + h], lf = gt[8 + dir * 4 + h];
        const float pre = wave_incl_scan(lf, lane), tot = __shfl(pre, 63);
        const float B = dir == 0 ? pre : (tot - pre) + lf;
        const float a = li - B;
        float cm = a;
#pragma unroll
        for (int o = 1; o < 64; o <<= 1) { const float t = dir == 0 ? __shfl_up(cm, o) : __shfl_down(cm, o); const bool ok = dir == 0 ? (lane >= o) : (lane + o < 64); if (ok) cm = fmaxf(cm, t); }
        av[lane] = a; Mt[lane] = fmaxf(m_p, cm); Bt[lane] = B;
    }
    {
        u32x4 qv[2], kv[2]; bf16 vv[16]; u32x4 cx[5];
        const bf16* Sg = WSP(bf16, WS_MLS) + (size_t)(seq * 36 + p) * 16512;
#pragma unroll
        for (int it = 0; it < 2; ++it) { const int idx = tid + NTHR * it, n = idx >> 4, cc = idx & 15;
            const bf16* pr = P + (size_t)rowof(b, tc * 64 + n) * DINP + h * 128 + cc * 8; qv[it] = *(const u32x4*)(pr + PC_MLQ); kv[it] = *(const u32x4*)(pr + PC_MLK); }
#pragma unroll
        for (int it = 0; it < 16; ++it) { const int idx = tid + NTHR * it, n = idx >> 7, d = idx & 127; vv[it] = P[(size_t)rowof(b, tc * 64 + n) * DINP + PC_MLV + h * 128 + d]; }
#pragma unroll
        for (int it = 0; it < 5; ++it) { const int idx = tid + NTHR * it, rr = idx >> 4, cc = idx & 15; cx[it] = (idx < 144 * 16 && rr < 129) ? *(const u32x4*)(Sg + rr * 128 + cc * 8) : (u32x4){0u, 0u, 0u, 0u}; }
#pragma unroll
        for (int it = 0; it < 2; ++it) { const int idx = tid + NTHR * it, n = idx >> 4, cc = idx & 15; *(LAS u32x4*)(Qs + n * 136 + cc * 8) = qv[it]; *(LAS u32x4*)(Ksm + n * 136 + cc * 8) = kv[it]; }
#pragma unroll
        for (int it = 0; it < 16; ++it) { const int idx = tid + NTHR * it, n = idx >> 7, d = idx & 127; VT[d * 72 + n] = vv[it]; }
#pragma unroll
        for (int it = 0; it < 5; ++it) { const int idx = tid + NTHR * it, rr = idx >> 4, cc = idx & 15; if (idx < 144 * 16) *(LAS u32x4*)(Cx + rr * 136 + cc * 8) = cx[it]; }
    }
    for (int idx = tid; idx < 16 * 64; idx += NTHR) { const int rr = idx >> 6, n = idx & 63; VT[(128 + rr) * 72 + n] = rr == 0 ? (bf16)0x3f80 : (bf16)0; }
    __syncthreads();
    for (int id = F.wave; id < 16; id += 8) { const int tt = id >> 2, st = id & 3;
        const bool skip = dir == 0 ? st > tt : st < tt;
        f32x4 acc = (f32x4){0.f, 0.f, 0.f, 0.f};
        if (!skip) acc = mma16<128>(Qs + tt * 16 * 136, 136, Ksm + st * 16 * 136, 136, lane, acc);
        const int s = st * 16 + (lane & 15); const float as = av[s];
#pragma unroll
        for (int i = 0; i < 4; ++i) { const int t = tt * 16 + 4 * (lane >> 4) + i; const bool ok = !skip && (dir == 0 ? s <= t : s >= t);
            SW[t * 72 + s] = (bf16)f2bf(ok ? acc[i] * QS * __expf(as - Mt[t]) : 0.f); } }
    __syncthreads();
    const int tt = F.wave & 3, d0 = F.wave < 4 ? 0 : 5, nd = F.wave < 4 ? 5 : 4;
    f32x4 val[5];
#pragma unroll
    for (int k = 0; k < 5; ++k) { val[k] = (f32x4){0.f, 0.f, 0.f, 0.f};
        if (k < nd) { const int dt = d0 + k;
            const f32x4 a1 = mma16<64>(SW + tt * 16 * 72, 72, VT + dt * 16 * 72, 72, lane, (f32x4){0.f, 0.f, 0.f, 0.f});
            const f32x4 a2 = mma16<128>(Qs + tt * 16 * 136, 136, Cx + dt * 16 * 136, 136, lane, (f32x4){0.f, 0.f, 0.f, 0.f});
#pragma unroll
            for (int i = 0; i < 4; ++i) { const int t = tt * 16 + 4 * (lane >> 4) + i; val[k][i] = a1[i] + a2[i] * QS * __expf(m_p - Mt[t]); }
            if (dt == 8 && (lane & 15) == 0) {
#pragma unroll
                for (int i = 0; i < 4; ++i) den[tt * 16 + 4 * (lane >> 4) + i] = val[k][i]; } } }
    __syncthreads();
    float* H = WSP(float, WS_HML) + (size_t)dir * MTOK * 512;
#pragma unroll
    for (int k = 0; k < 5; ++k) { const int dt = d0 + k; if (k < nd && dt < 8) {
#pragma unroll
        for (int i = 0; i < 4; ++i) { const int t = tt * 16 + 4 * (lane >> 4) + i;
            const float dn = fmaxf(fabsf(den[t]), __expf(-(Bt[t] + Mt[t])));
            H[(size_t)rowof(b, tc * 64 + t) * 512 + h * 128 + dt * 16 + (lane & 15)] = val[k][i] / dn; } } }
    __syncthreads();
}

DI void ss_c_unit(Frame& F, int l, int sq, int p) {
    const int b = sq >> 4, h = (sq >> 1) & 7, dir = sq & 1, g = h >> 2, tc = tc_of(dir, p), lane = F.lane, tid = F.tid;
    const bf16* XBC = WSP(bf16, WS_XBC);
    LAS bf16* Cm = (LAS bf16*)F.lds;
    LAS bf16* Bm = (LAS bf16*)(F.lds + 17408);
    LAS bf16* XT = (LAS bf16*)(F.lds + 34816);
    LAS bf16* Sx = (LAS bf16*)(F.lds + 44032);
    LAS bf16* W = (LAS bf16*)(F.lds + 61440);
    LAS float* cum = (LAS float*)(F.lds + 70656);
    LAS float* dtv = cum + 64;
    if (F.wave == 0) {
        const int row = rowof(b, tc * 64 + lane);
        const float dt = WSP(float, WS_DT)[(size_t)row * 16 + dir * 8 + h];
        const float A = -__expf(F.in[15][l * 16 + dir * 8 + h]);
        const float a = dt * A, pre = wave_incl_scan(a, lane), tot = __shfl(pre, 63);
        cum[lane] = dir == 0 ? pre : (tot - pre) + a; dtv[lane] = dt;
    }
    {
        u32x4 bb[2], cc_[2], sx[2]; bf16 xx[8];
        const bf16* Sg = WSP(bf16, WS_SSS) + (size_t)(sq * 36 + p) * 8192;
#pragma unroll
        for (int it = 0; it < 2; ++it) { const int idx = tid + NTHR * it, n = idx >> 4, cc = idx & 15; const bf16* xr = XBC + (size_t)rowof(b, tc * 64 + n) * 1024;
            bb[it] = *(const u32x4*)(xr + 512 + g * 128 + cc * 8); cc_[it] = *(const u32x4*)(xr + 768 + g * 128 + cc * 8); sx[it] = *(const u32x4*)(Sg + n * 128 + cc * 8); }
#pragma unroll
        for (int it = 0; it < 8; ++it) { const int idx = tid + NTHR * it, n = idx >> 6, pp = idx & 63; xx[it] = XBC[(size_t)rowof(b, tc * 64 + n) * 1024 + h * 64 + pp]; }
#pragma unroll
        for (int it = 0; it < 2; ++it) { const int idx = tid + NTHR * it, n = idx >> 4, cc = idx & 15;
            *(LAS u32x4*)(Bm + n * 136 + cc * 8) = bb[it]; *(LAS u32x4*)(Cm + n * 136 + cc * 8) = cc_[it]; *(LAS u32x4*)(Sx + n * 136 + cc * 8) = sx[it]; }
#pragma unroll
        for (int it = 0; it < 8; ++it) { const int idx = tid + NTHR * it, n = idx >> 6, pp = idx & 63; XT[pp * 72 + n] = xx[it]; }
    }
    __syncthreads();
    for (int id = F.wave; id < 16; id += 8) { const int tt = id >> 2, st = id & 3;
        const bool skip = dir == 0 ? st > tt : st < tt;
        f32x4 acc = (f32x4){0.f, 0.f, 0.f, 0.f};
        if (!skip) acc = mma16<128>(Cm + tt * 16 * 136, 136, Bm + st * 16 * 136, 136, lane, acc);
        const int s = st * 16 + (lane & 15); const float cs = cum[s], ds = dtv[s];
#pragma unroll
        for (int i = 0; i < 4; ++i) { const int t = tt * 16 + 4 * (lane >> 4) + i; const bool ok = !skip && (dir == 0 ? s <= t : s >= t);
            W[t * 72 + s] = (bf16)f2bf(ok ? acc[i] * __expf(cum[t] - cs) * ds : 0.f); } }
    __syncthreads();
    float* Y = WSP(float, WS_YSS) + (size_t)dir * MTOK * 512;
    for (int id = F.wave; id < 16; id += 8) { const int tt = id >> 2, pt = id & 3;
        const f32x4 a1 = mma16<64>(W + tt * 16 * 72, 72, XT + pt * 16 * 72, 72, lane, (f32x4){0.f, 0.f, 0.f, 0.f});
        const f32x4 a2 = mma16<128>(Cm + tt * 16 * 136, 136, Sx + pt * 16 * 136, 136, lane, (f32x4){0.f, 0.f, 0.f, 0.f});
#pragma unroll
        for (int i = 0; i < 4; ++i) { const int t = tt * 16 + 4 * (lane >> 4) + i;
            Y[(size_t)rowof(b, tc * 64 + t) * 512 + h * 64 + pt * 16 + (lane & 15)] = a1[i] + a2[i] * __expf(cum[t]); } }
    __syncthreads();
}

DI void m5_finish_phase(Frame& F, int l, int nrows) {
    const int gw = F.bid * NWAVES + F.wave, NGW = F.G * NWAVES, lane = F.lane;
    const bf16* P = WSP(bf16, WS_P); const float* H0 = WSP(float, WS_HML); const float* H1 = H0 + (size_t)MTOK * 512;
    const float* Y0 = WSP(float, WS_YSS); const float* Y1 = Y0 + (size_t)MTOK * 512; const bf16* XBC = WSP(bf16, WS_XBC);
    bf16* A2 = WSP(bf16, WS_A2);
    for (int row = gw; row < nrows; row += NGW) {
        const bf16* p = P + (size_t)row * DINP;
        float hv[8], ov[8], yv[8], zv[8]; bf16 xv[8];
#pragma unroll
        for (int u = 0; u < 8; ++u) { const int c = lane + 64 * u;
            hv[u] = H0[(size_t)row * 512 + c] + H1[(size_t)row * 512 + c]; ov[u] = bf2f(p[PC_MLO + c]);
            yv[u] = Y0[(size_t)row * 512 + c] + Y1[(size_t)row * 512 + c]; zv[u] = bf2f(p[PC_Z + c]); xv[u] = XBC[(size_t)row * 1024 + c]; }
        const float* gn = F.in[11] + l * 512; const float* sn = F.in[17] + l * 512;
#pragma unroll
        for (int h = 0; h < 4; ++h) {
            const float v0 = hv[2 * h], v1 = hv[2 * h + 1]; const int c0 = h * 128 + lane, c1 = c0 + 64;
            const float rstd = 1.0f / sqrtf(wave_sum(v0 * v0 + v1 * v1) * (1.f / 128.f) + EPS);
            A2[(size_t)row * D + c0] = (bf16)f2bf(v0 * rstd * gn[c0] * sigmoidf_(ov[2 * h]));
            A2[(size_t)row * D + c1] = (bf16)f2bf(v1 * rstd * gn[c1] * sigmoidf_(ov[2 * h + 1]));
        }
        float y[8]; float ss = 0.f;
#pragma unroll
        for (int u = 0; u < 8; ++u) { float v = yv[u] + F.in[16][l * 8 + u] * bf2f(xv[u]); v *= siluf(zv[u]); y[u] = v; ss += v * v; }
        const float rstd = 1.0f / sqrtf(wave_sum(ss) * (1.f / 512.f) + EPS);
#pragma unroll
        for (int u = 0; u < 8; ++u) { const int c = lane + 64 * u; A2[(size_t)row * D + 512 + c] = (bf16)f2bf(y[u] * rstd * sn[c]); }
    }
}
#ifndef PROBE_MASK
#define PROBE_MASK 0ull
#endif
#define NREP(k) ((((unsigned long long)(PROBE_MASK) >> (k)) & 1ull) ? 2 : 1)
#ifndef UNIT_REP
#define UNIT_REP 0
#endif
#define UREP(i) for (int rp_ = 0; rp_ <= ((F.rep >> (i)) & 1); ++rp_)
#ifndef ONE_LAUNCH
#define ONE_LAUNCH 1
#endif
#define IN(k) (lo <= (k) && (k) < hi)
#define SEAM(k) do { if (ONE_LAUNCH && hi > (k) + 1) xcd_barrier(bar); } while (0)
#ifndef FILL_MASK
#define FILL_MASK 0x7fffffffull
#endif
#define FILL(k, work) do { if (ONE_LAUNCH) conv_fill(F, (k), (work)); } while (0)
#ifndef NCV_P
#define NCV_P 48
#define NCV_OUT 112
#define NCV_UP 24
#define NCV_DOWN 112
#endif
template <int l> DI void layer_phases(Frame& F, const XcdBarrier& bar, const int lo, const int hi) {
    LAS int* mtb = (LAS int*)(F.lds + RING_BYTES);
        const int pb = 1 + 16 * l;
        const bool wc = (l == 0);
        const int nrows = wc ? MTOK : MLAT;
        const float* modl = WSP(float, WS_MOD) + (size_t)l * 5 * D6;
        if (IN(pb + 0)) {
            if (l == 0) norm_phase<false>(F, l, F.in[0], F.in[2], F.in[6] + l * D, 0, MTOK);
            else norm_phase<false>(F, l, WSP(float, WS_X), WSP(float, WS_X) + (size_t)MLAT * D, F.in[6] + l * D, 0, MTOK);
            if (l == 1) conv_drain(F, CV_NQ1 - CV_EAGER); SEAM(pb + 0);
        }
        if (IN(pb + 1)) {
            const int ncv = ONE_LAUNCH ? NCV_P : 0, gw_ = F.G - ncv;
            if (F.bid < gw_) { pg8::Gemm g{WSP(bf16, WS_HN), WSP(bf16, WS_WIN) + (size_t)l * DINP * D, D, D}; pg8::StaticOrder S; S.init(MTOK / 256, DINP / 256, gw_, F.bid);
                EpiP E{WSP(bf16, WS_P), WSP(float, WS_GRAW)};
                pg8::gemm_phase<EpiP, pg8::StaticOrder>(F.lds, g, S, E); }
            FILL(pb + 1, F.bid >= gw_);
            SEAM(pb + 1);
        }
        if (IN(pb + 2)) {
            for (int u = F.bid; u < NB * 72; u += F.G) m1_prep_unit(F, l, u / 72, u % 72);
            SEAM(pb + 2);
        }
        if (IN(pb + 3)) {
            { pg8::Gemm g{WSP(bf16, WS_CQN), WSP(bf16, WS_WQB) + (size_t)l * 768 * 512, 512, 512}; pg8::StaticOrder S; S.init(MTOK / 256, 3, F.G, F.bid);
              EpiBf16 E{WSP(bf16, WS_QRAW), 768}; pg8::gemm_phase<EpiBf16, pg8::StaticOrder>(F.lds, g, S, E); }
            __syncthreads();
            { pg8::Gemm g{WSP(bf16, WS_CKVN), WSP(bf16, WS_WKVB) + (size_t)l * 1024 * 256, 256, 256}; pg8::StaticOrder S; S.init(MTOK / 256, 4, F.G, (F.bid + 128) % F.G);
              EpiBf16 E{WSP(bf16, WS_KVRAW), 1024}; pg8::gemm_phase<EpiBf16, pg8::StaticOrder>(F.lds, g, S, E); }
            __syncthreads();
            UREP(2) for (int u = F.bid; u < 1152; u += F.G) ml_a_unit(F, u / 36, u % 36);
            UREP(3) for (int v = (F.bid + 128) % F.G; v < 576; v += F.G) ss_a_unit(F, l, v / 144, (v / 72) & 1, (v % 72) >> 1, v & 1);
            SEAM(pb + 3);
        }
        if (IN(pb + 4)) {
            UREP(4) for (int u = F.bid; u < 256; u += F.G) {
                const int bh = u >> 4, qb = u & 15, b = bh >> 2, h = bh & 3;
                const int r0a = 2 * qb - 4 < 0 ? 0 : (2 * qb - 4 > 24 ? 24 : 2 * qb - 4), r0b = 2 * qb - 3 < 0 ? 0 : (2 * qb - 3 > 24 ? 24 : 2 * qb - 3);
                attn_unit2<128, true>(F, WSP(bf16, WS_QNA) + ((size_t)bh * TS + qb * 128) * 128, WSP(bf16, WS_KNA) + (size_t)bh * TS * 128, WSP(bf16, WS_VTNA) + (size_t)bh * 128 * TS,
                                     4, 32, r0b + 8 - r0a, r0a, 0.12751743082459868f,
                                     WSP(bf16, WS_A2) + (size_t)(b * TL + qb * 128) * D + 1536 + h * 128, 2 * qb, F.in[26] + (size_t)(l * 4 + h) * 15 * 31);
            }
            if (wc) UREP(5) for (int v = F.bid; v < 32; v += F.G) {
                const int bh2 = v >> 1, qc = v & 1, b2 = bh2 >> 2, h2 = bh2 & 3;
                attn_unit2<128, false>(F, WSP(bf16, WS_QNA) + ((size_t)bh2 * TS + TL + qc * 128) * 128, WSP(bf16, WS_KNA) + (size_t)bh2 * TS * 128, WSP(bf16, WS_VTNA) + (size_t)bh2 * 128 * TS,
                                      4, 32, 0, 0, 0.12751743082459868f, WSP(bf16, WS_A2) + (size_t)(MLAT + b2 * TC + qc * 128) * D + 1536 + h2 * 128, 0, nullptr);
            }
            UREP(6) for (int v = (F.bid + 32) % F.G; v < 128; v += F.G) ml_scan_unit(F, v >> 2, v & 3);
            UREP(7) for (int v = (F.bid + 96) % F.G; v < 128; v += F.G) ss_scan_unit(F, v >> 1, v & 1);
            UREP(8) for (int v = F.bid; v < 288; v += F.G) mla_post_unit(F, l, v / 72, v % 72);
            SEAM(pb + 4);
        }
        if (IN(pb + 5)) {
            const int p0 = wc ? 0 : 4, npp = 36 - p0;
            UREP(9) for (int u = F.bid; u < 256; u += F.G) { const int bh = u >> 4, qb = u & 15, b = bh >> 2, h = bh & 3;
                attn_unit2<192, false>(F, WSP(bf16, WS_QMLA) + ((size_t)bh * TS + qb * 128) * 192, WSP(bf16, WS_KMLA) + (size_t)bh * TS * 192, WSP(bf16, WS_VTMLA) + (size_t)bh * 128 * TS,
                                      36, 0, 0, 0, 0.10411754627862817f, WSP(bf16, WS_A2) + (size_t)(b * TL + qb * 128) * D + 1024 + h * 128, 0, nullptr); }
            if (wc) UREP(10) for (int v = F.bid; v < 32; v += F.G) { const int bh = v >> 1, qc = v & 1, b = bh >> 2, h = bh & 3;
                attn_unit2<192, false>(F, WSP(bf16, WS_QMLA) + ((size_t)bh * TS + TL + qc * 128) * 192, WSP(bf16, WS_KMLA) + (size_t)bh * TS * 192, WSP(bf16, WS_VTMLA) + (size_t)bh * 128 * TS,
                                      4, 32, 0, 0, 0.10411754627862817f, WSP(bf16, WS_A2) + (size_t)(MLAT + b * TC + qc * 128) * D + 1024 + h * 128, 0, nullptr); }
            UREP(11) for (int v = (F.bid + 32) % F.G; v < 32 * npp; v += F.G) ml_c_unit(F, v / npp, p0 + v % npp);
            UREP(12) for (int v = (F.bid + 160) % F.G; v < 64 * npp; v += F.G) ss_c_unit(F, l, v / npp, p0 + v % npp);
            SEAM(pb + 5);
        }
        if (IN(pb + 6)) { m5_finish_phase(F, l, nrows); SEAM(pb + 6); }
        if (IN(pb + 7)) {
            const int ncv = (ONE_LAUNCH && l == 0) ? NCV_OUT : 0, gw_ = F.G - ncv;
            if (F.bid < gw_) { pg8::Gemm g{WSP(bf16, WS_A2), WSP(bf16, WS_WOUT) + (size_t)l * D * D, D, D}; pg8::StaticOrder S; S.init(nrows / 256, D / 256, gw_, F.bid);
                EpiResid E{l == 0 ? F.in[0] : WSP(float, WS_X), l == 0 ? F.in[2] : WSP(float, WS_X) + (size_t)MLAT * D, WSP(float, WS_X), modl + 2 * D};
                pg8::gemm_phase<EpiResid, pg8::StaticOrder>(F.lds, g, S, E); }
            FILL(pb + 7, F.bid >= gw_);
            SEAM(pb + 7);
        }
        if (IN(pb + 8)) {
            if (l == 0) { norm_phase<false>(F, l, WSP(float, WS_X), WSP(float, WS_X) + (size_t)MLAT * D, F.in[27] + l * D, 3 * D, nrows); conv_drain(F, CV_NE - CV_EAGER); }
            else { norm_phase<true>(F, l, WSP(float, WS_X), WSP(float, WS_X) + (size_t)MLAT * D, F.in[27] + l * D, 3 * D, nrows); conv_drain(F, CV_NDEF); }
            SEAM(pb + 8);
        }
        if (l == 0) {
            if (IN(pb + 10)) {
                const int ncv = ONE_LAUNCH ? NCV_UP : 0, gw_ = F.G - ncv;
                if (F.bid < gw_) { pg8::Gemm g{WSP(bf16, WS_HN), WSP(bf16, WS_W13), D, D}; pg8::StaticOrder S; S.init(MTOK / 256, 2 * FF / 256, gw_, F.bid);
                    EpiSwiglu E{WSP(bf16, WS_G), FF}; pg8::gemm_phase<EpiSwiglu, pg8::StaticOrder>(F.lds, g, S, E); }
                FILL(pb + 10, F.bid >= gw_);
                SEAM(pb + 10);
            }
            if (IN(pb + 11)) {
                const int ncv = ONE_LAUNCH ? NCV_DOWN : 0, gw_ = F.G - ncv;
                if (F.bid < gw_) { pg8::Gemm g{WSP(bf16, WS_G), WSP(bf16, WS_W2), FF, FF}; pg8::StaticOrder S; S.init(MTOK / 256, D / 256, gw_, F.bid);
                    EpiResid E{WSP(float, WS_X), WSP(float, WS_X) + (size_t)MLAT * D, WSP(float, WS_X), modl + 5 * D};
                    pg8::gemm_phase<EpiResid, pg8::StaticOrder>(F.lds, g, S, E); }
                FILL(pb + 11, F.bid >= gw_);
                SEAM(pb + 11);
            }
        } else {
            if (IN(pb + 10)) {
                __syncthreads(); moe_tables(F, mtb, 2 * FE / 256);
                pg8::Gemm g{WSP(bf16, WS_XG), WSP(bf16, WS_MW13), D, D}; MoeOrder S{mtb, 2 * FE / 256, F.G, F.bid, 0, mtb[40], 1, 0, MLAT / 256};
                EpiSwiglu E{WSP(bf16, WS_G), FE}; pg8::gemm_phase<EpiSwiglu, MoeOrder>(F.lds, g, S, E);
                SEAM(pb + 10);
            }
            if (IN(pb + 11)) {
                __syncthreads(); moe_tables(F, mtb, D / 256);
                const int nun = mtb[40], nfull0 = (nun / F.G) * F.G, nt0 = nun - nfull0;
                const int SK = nt0 == 0 ? 1 : (nt0 <= 32 ? 8 : (nt0 <= 64 ? 4 : (nt0 <= 128 ? 2 : 1)));
                const int nfull = SK == 1 ? nun : nfull0, ntail = nun - nfull;
                { pg8::Gemm g{WSP(bf16, WS_G), WSP(bf16, WS_MW2), FE, FE}; MoeOrder S{mtb, D / 256, F.G, F.bid, 0, nfull, 1, 0, 0};
                  EpiF32 E{WSP(float, WS_Y), D}; pg8::gemm_phase<EpiF32, MoeOrder>(F.lds, g, S, E); }
                if (ntail > 0) { __syncthreads();
                  pg8::Gemm g{WSP(bf16, WS_G), WSP(bf16, WS_MW2), FE / SK, FE}; MoeOrder S{mtb, D / 256, F.G, F.bid, nfull, ntail * SK, SK, FE / SK, 0};
                  EpiPart E{WSP(float, WS_PART)}; pg8::gemm_phase<EpiPart, MoeOrder>(F.lds, g, S, E); }
                SEAM(pb + 11);
            }
            if (IN(pb + 12)) {
                __syncthreads(); moe_tables(F, mtb, D / 256);
                const int nun = mtb[40], nfull0 = (nun / F.G) * F.G, nt0 = nun - nfull0;
                const int SK = nt0 == 0 ? 1 : (nt0 <= 32 ? 8 : (nt0 <= 64 ? 4 : (nt0 <= 128 ? 2 : 1)));
                const int nfull = SK == 1 ? nun : nfull0, ntail = nun - nfull;
                for (int it = F.bid; it < ntail * 8; it += F.G) { const int t = it >> 3, cg = it & 7;
                    MoeOrder S{mtb, D / 256, 1, 0, nfull + t, 1, 1, 0, 0}; pg8::Unit u; S.next(0, u);
                    if (SK == 8) splitk_reduce_f32<8>(WSP(float, WS_PART), t, cg, u, WSP(float, WS_Y), D);
                    else if (SK == 4) splitk_reduce_f32<4>(WSP(float, WS_PART), t, cg, u, WSP(float, WS_Y), D);
                    else splitk_reduce_f32<2>(WSP(float, WS_PART), t, cg, u, WSP(float, WS_Y), D); }
                SEAM(pb + 12);
            }
            if (IN(pb + 13)) { moe_combine_phase(F, l); }
        }
}
__global__ void __launch_bounds__(NTHR, 2) fwd_kernel(Args args) {
    extern __shared__ __attribute__((aligned(16))) unsigned char lds[];
    Frame F;
    F.lds = (LAS unsigned char*)lds; F.ws = args.ws; F.out = args.out;
#pragma unroll
    for (int i = 0; i < 35; ++i) F.in[i] = args.in[i];
    F.tid = threadIdx.x; F.lane = F.tid & 63; F.wave = __builtin_amdgcn_readfirstlane(F.tid >> 6); F.G = gridDim.x; F.bid = blockIdx.x; F.rep = args.rep;
    volatile LAS unsigned* MISC = (volatile LAS unsigned*)(F.lds + MISC_OFF);
    if (F.tid < 64) MISC[F.tid] = 0u;
    __syncthreads();
    XcdBarrier bar; bar.bar = WSP(unsigned, WS_CTL) + CW_BAR; bar.x = 0; bar.st = nullptr;
    if (ONE_LAUNCH) bar = xcd_barrier_post(WSP(unsigned, WS_CTL) + CW_BAR, MISC + 8);
    const int lo = args.ph_lo, hi = args.ph_hi;

    if (IN(0)) { p0_prologue(F); SEAM(0); }

    layer_phases<0>(F, bar, lo, hi);
    layer_phases<1>(F, bar, lo, hi);
#undef IN
#undef SEAM
}

extern "C" void kernel_launch(void* const* d_in, const int* in_sizes, int n_in, void* d_out, int out_size, void* d_ws, size_t ws_size, hipStream_t stream) {
    static int grid = 0;
    if (grid == 0) {
        if (n_in != 35 || out_size != MLAT * D || ws_size < WS_END) { fprintf(stderr, "kernel_launch: unexpected shapes (n_in %d out %d ws %zu need %zu)\n", n_in, out_size, ws_size, (size_t)WS_END); grid = -1; return; }
        int dev = 0, cus = 0, per_cu = 0;
        if (hipGetDevice(&dev) != hipSuccess || hipDeviceGetAttribute(&cus, hipDeviceAttributeMultiprocessorCount, dev) != hipSuccess) { grid = -1; return; }
        if (hipFuncSetAttribute((const void*)fwd_kernel, hipFuncAttributeMaxDynamicSharedMemorySize, LDS_BYTES) != hipSuccess) { fprintf(stderr, "kernel_launch: hipFuncSetAttribute failed\n"); grid = -1; return; }
        if (hipOccupancyMaxActiveBlocksPerMultiprocessor(&per_cu, (const void*)fwd_kernel, NTHR, LDS_BYTES) != hipSuccess || per_cu < 1) { fprintf(stderr, "kernel_launch: occupancy query says %d\n", per_cu); }
        (void)hipGetLastError();
        grid = cus;
    }
    if (grid < 0) return;
    (void)hipMemsetAsync((char*)d_ws + WS_CTL, 0, CTL_ZERO_BYTES, stream);
    Args a{};
    for (int i = 0; i < 35; ++i) a.in[i] = (const float*)d_in[i];
    a.out = (float*)d_out; a.ws = (unsigned char*)d_ws; a.rep = UNIT_REP;
#if ONE_LAUNCH
    a.ph_lo = 0; a.ph_hi = 64;
    hipLaunchKernelGGL(fwd_kernel, dim3(grid), dim3(NTHR), LDS_BYTES, stream, a);
#else
    static const int phases[] = {0, 1, 2, 3, 4, 5, 6, 7, 8, 9, 11, 12, 17, 18, 19, 20, 21, 22, 23, 24, 25, 27, 28, 29, 30};
    for (int k = 0; k < (int)(sizeof(phases) / sizeof(phases[0])); ++k) {
        a.ph_lo = phases[k]; a.ph_hi = phases[k] + 1;
        for (int rp = 0; rp < NREP(phases[k]); ++rp) hipLaunchKernelGGL(fwd_kernel, dim3(grid), dim3(NTHR), LDS_BYTES, stream, a);
    }
#endif
}
```

```cpp
#define NCV_P 48
#define NCV_OUT 96
#define NCV_UP 24
#define NCV_DOWN 96
#define FILL_MASK 0x7fffffffull
#define PROBE_MASK (0ull)
#define ONE_LAUNCH 1
#define UNIT_REP 0
#include <hip/hip_runtime.h>
#include <cstdio>
#include <cstdint>

#define DI __device__ __forceinline__
#define LAS __attribute__((address_space(3)))
#define GAS __attribute__((address_space(1)))
typedef unsigned short bf16;
typedef short bf16x8 __attribute__((ext_vector_type(8)));
typedef float f32x4 __attribute__((ext_vector_type(4)));
typedef float f32x2 __attribute__((ext_vector_type(2)));
typedef unsigned u32x4 __attribute__((ext_vector_type(4)));
typedef unsigned u32x2 __attribute__((ext_vector_type(2)));

namespace pg8 {
constexpr int BM = 256, BK = 64, HALF = 128, HTB = HALF * BK * 2, STAGE_BYTES = 8 * HTB, NXCD = 8, WGM = 8;
__host__ __device__ __forceinline__ int lds_byte(int r, int c) { const int st = (r >> 4) * 2 + (c >> 5), rr = r & 15, cc = c & 31, ob = rr * 64 + cc * 2; return st * 1024 + (ob ^ (((ob >> 9) & 1) << 5)); }
__host__ __device__ __forceinline__ void stage_rc(int b, int& R, int& C) { const int st = b / 1024, sb = b % 1024, swz = sb ^ (((sb >> 9) & 1) << 5); R = (st >> 1) * 16 + swz / 64; C = (st & 1) * 32 + (swz % 64) / 2; }
__host__ __device__ __forceinline__ int perm32(int rho) { const int n = rho >> 4, i = rho & 15; return 8 * (i >> 2) + 4 * n + (i & 3); }

struct Unit { int pm, pn, pb, koff, aux, pa; };
struct Gemm { const bf16* A; const bf16* Bt; int K, ld; };

DI int xcd_remap(int L, int nwg) { const int q = nwg / NXCD, r = nwg % NXCD, xcd = L % NXCD, off = L / NXCD; return (xcd < r ? xcd * (q + 1) : r * (q + 1) + (xcd - r) * q) + off; }

struct StaticOrder {
    int nM, nN, nwg, G, c;
    DI void init(int nM_, int nN_, int G_, int c_) { nM = nM_; nN = nN_; nwg = nM * nN; G = G_; c = c_; }
    DI bool next(int i, Unit& u) const {
        const long L = (long)i * G + c; if (L >= nwg) return false;
        const int wgid = xcd_remap((int)L, nwg);
        const int nig = WGM * nN, gid = wgid / nig, fm = gid * WGM, gsz = (nM - fm) < WGM ? (nM - fm) : WGM;
        u.pm = fm + ((wgid % nig) % gsz); u.pn = (wgid % nig) / gsz; u.pb = u.pn; u.koff = 0; u.aux = 0; u.pa = u.pm; return true;
    }
};

DI unsigned cvt_pk_bf16(float lo, float hi) { unsigned r; asm volatile("v_cvt_pk_bf16_f32 %0, %1, %2" : "=v"(r) : "v"(lo), "v"(hi)); return r; }

template <class Epi, class Sched, bool ALIGN_EPI = true>
DI void gemm_phase(LAS unsigned char* lds, const Gemm g, const Sched& S, const Epi& E) {
    const int tid = threadIdx.x, wid = __builtin_amdgcn_readfirstlane(tid >> 6), lane = tid & 63, wr = wid >> 2, wc = wid & 3, fr = lane & 15, fq = lane >> 4;
    const int K = g.K, nt = K / BK;
    unsigned voffA[2], voffB[2];
#pragma unroll
    for (int i = 0; i < 2; ++i) { int R, C; stage_rc(tid * 16 + i * 8192, R, C); const int Rb = Epi::PERM ? ((R & ~31) + perm32(R & 31)) : R;
        voffA[i] = (unsigned)(R * g.ld + C) * 2u; voffB[i] = (unsigned)(Rb * g.ld + C) * 2u; }
    const size_t kstep = (size_t)(BK * 2);
    const size_t hstep = (size_t)HALF * g.ld * 2;
    const size_t tstep = 2 * hstep;
    const unsigned ldsw = (unsigned)wid * 1024u;
    const int aoff = lds_byte(wr * 64 + fr, fq * 8), boff = lds_byte(wc * 32 + fr, fq * 8);
#define PG8_SA(b, h) (((b) * 2 + (h)) * HTB)
#define PG8_SB(b, h) ((4 + (b) * 2 + (h)) * HTB)
#define PG8_STAGE(bufoff, gbase, voff) do { _Pragma("unroll") for (int _i = 0; _i < 2; ++_i) \
        __builtin_amdgcn_global_load_lds((const unsigned*)((const char*)(gbase) + (voff)[_i]), (LAS unsigned*)(lds + (bufoff) + ldsw + _i * 8192), 16, 0, 0); } while (0)
#define PG8_LDA(dst, b, h) do { _Pragma("unroll") for (int m = 0; m < 4; ++m) _Pragma("unroll") for (int k = 0; k < 2; ++k) dst[m][k] = *(const LAS bf16x8*)(lds + PG8_SA(b, h) + aoff + m * 2048 + k * 1024); } while (0)
#define PG8_LDB(dst, b, h) do { _Pragma("unroll") for (int n = 0; n < 2; ++n) _Pragma("unroll") for (int k = 0; k < 2; ++k) dst[n][k] = *(const LAS bf16x8*)(lds + PG8_SB(b, h) + boff + n * 2048 + k * 1024); } while (0)
#define PG8_MMA(ai, bj, At, Bt) do { __builtin_amdgcn_s_setprio(1); _Pragma("unroll") for (int m = 0; m < 4; ++m) _Pragma("unroll") for (int n = 0; n < 2; ++n) _Pragma("unroll") for (int k = 0; k < 2; ++k) \
        acc[ai][bj][m][n] = __builtin_amdgcn_mfma_f32_16x16x32_bf16(Bt[n][k], At[m][k], acc[ai][bj][m][n], 0, 0, 0); __builtin_amdgcn_s_setprio(0); } while (0)
#define PG8_WAIT_V(n) asm volatile("s_waitcnt vmcnt(" #n ")" ::: "memory")
#define PG8_WAIT_L(n) asm volatile("s_waitcnt lgkmcnt(" #n ")" ::: "memory")
#define PG8_BAR __builtin_amdgcn_s_barrier()
#define PG8_SCHED __builtin_amdgcn_sched_barrier(0)
    Unit cur, nxt; int ui = 0;
    if (!S.next(0, cur)) return;
    f32x4 acc[2][2][4][2];
#pragma unroll
    for (int a = 0; a < 2; ++a)
#pragma unroll
        for (int b = 0; b < 2; ++b)
#pragma unroll
            for (int m = 0; m < 4; ++m)
#pragma unroll
                for (int n = 0; n < 2; ++n) acc[a][b][m][n] = (f32x4){0.f, 0.f, 0.f, 0.f};
    bf16x8 At[4][2], B0[2][2], B1[2][2];
    const char* cA = (const char*)g.A + (size_t)cur.pa * tstep + (size_t)cur.koff * 2; const char* cB = (const char*)g.Bt + (size_t)cur.pb * tstep + (size_t)cur.koff * 2;
    {
        PG8_STAGE(PG8_SB(0, 0), cB, voffB); PG8_STAGE(PG8_SB(0, 1), cB + hstep, voffB); PG8_STAGE(PG8_SA(0, 0), cA, voffA); PG8_STAGE(PG8_SA(0, 1), cA + hstep, voffA);
        if (wr == 1) PG8_BAR;
        PG8_WAIT_V(2); PG8_BAR;
        PG8_STAGE(PG8_SB(1, 0), cB + kstep, voffB); PG8_STAGE(PG8_SA(1, 0), cA + kstep, voffA); PG8_STAGE(PG8_SB(1, 1), cB + hstep + kstep, voffB);
        PG8_WAIT_V(6); PG8_BAR;
    }
    for (;;) {
        const bool has_next = S.next(ui + 1, nxt);
        const char* nA = has_next ? (const char*)g.A + (size_t)nxt.pa * tstep + (size_t)nxt.koff * 2 : cA; const char* nB = has_next ? (const char*)g.Bt + (size_t)nxt.pb * tstep + (size_t)nxt.koff * 2 : cB;
        for (int t = 0; t < nt; t += 2) {
            const bool last = (t == nt - 2);
            const char* a1 = cA + (size_t)(t + 1) * kstep;
            const char* a2 = last ? nA : cA + (size_t)(t + 2) * kstep; const char* b2 = last ? nB : cB + (size_t)(t + 2) * kstep;
            const char* a3 = a2 + kstep; const char* b3 = b2 + kstep;
            PG8_LDB(B0, 0, 0); PG8_LDB(B1, 0, 1); PG8_SCHED; PG8_LDA(At, 0, 0); PG8_STAGE(PG8_SA(1, 1), a1 + hstep, voffA);
            PG8_WAIT_V(8); PG8_WAIT_L(0); PG8_BAR; PG8_MMA(0, 0, At, B0); PG8_MMA(0, 1, At, B1); PG8_BAR; PG8_SCHED;
            PG8_LDA(At, 0, 1); PG8_STAGE(PG8_SB(0, 0), b2, voffB); PG8_STAGE(PG8_SB(0, 1), b2 + hstep, voffB); PG8_STAGE(PG8_SA(0, 0), a2, voffA);
            PG8_WAIT_V(8); PG8_WAIT_L(0); PG8_BAR; PG8_MMA(1, 0, At, B0); PG8_MMA(1, 1, At, B1); PG8_BAR; PG8_SCHED;
            PG8_LDB(B0, 1, 0); PG8_LDB(B1, 1, 1); PG8_SCHED; PG8_LDA(At, 1, 0); PG8_STAGE(PG8_SA(0, 1), a2 + hstep, voffA);
            PG8_WAIT_V(8); PG8_WAIT_L(0); PG8_BAR; PG8_MMA(0, 0, At, B0); PG8_MMA(0, 1, At, B1); PG8_BAR; PG8_SCHED;
            PG8_LDA(At, 1, 1); PG8_STAGE(PG8_SB(1, 0), b3, voffB); PG8_STAGE(PG8_SB(1, 1), b3 + hstep, voffB); PG8_STAGE(PG8_SA(1, 0), a3, voffA);
            PG8_WAIT_V(8); PG8_WAIT_L(0); PG8_BAR; PG8_MMA(1, 0, At, B0); PG8_MMA(1, 1, At, B1); PG8_BAR; PG8_SCHED;
        }
        if constexpr (ALIGN_EPI) { if (wr == 0) PG8_BAR; }
        E(acc, cur, wr, wc, fr, fq);
        if (!has_next) break;
#pragma unroll
        for (int a = 0; a < 2; ++a)
#pragma unroll
            for (int b = 0; b < 2; ++b)
#pragma unroll
                for (int m = 0; m < 4; ++m)
#pragma unroll
                    for (int n = 0; n < 2; ++n) acc[a][b][m][n] = (f32x4){0.f, 0.f, 0.f, 0.f};
        cur = nxt; cA = nA; cB = nB; ++ui;
        if constexpr (ALIGN_EPI) { if (wr == 1) PG8_BAR; }
    }
    PG8_WAIT_V(0);
    if constexpr (!ALIGN_EPI) { if (wr == 0) PG8_BAR; }
    PG8_BAR;
#undef PG8_SA
#undef PG8_SB
#undef PG8_STAGE
#undef PG8_LDA
#undef PG8_LDB
#undef PG8_MMA
#undef PG8_WAIT_V
#undef PG8_WAIT_L
#undef PG8_BAR
#undef PG8_SCHED
}
}
constexpr int D = 2048, NB = 4, TL = 2048, TC = 256, TS = TL + TC  ;
constexpr int MLAT = NB * TL  , MTOK = NB * (TL + TC)  ;
constexpr int DIN = 5824, DINP = 5888, D6 = 6 * D;
constexpr int FF = 5632, FE = 7168, NEXP = 8;
constexpr float EPS = 1e-6f;
constexpr int PC_MLQ = 0, PC_MLK = 512, PC_MLV = 1024, PC_MLO = 1536, PC_IG = 2048, PC_FG = 2056, PC_Z = 2064, PC_XBC = 2576, PC_DT = 3600,
              PC_CQ = 3616, PC_CKV = 4064, PC_KR = 4224, PC_NQ = 4288, PC_NK = 4800, PC_NV = 5312;
constexpr int NCHUNK = 36;
constexpr int MAXMT = 72;

constexpr size_t MiB = 1u << 20;
constexpr size_t WS_CTL = 0, CTL_ZERO_BYTES = 1 * MiB;
constexpr size_t WS_MOD = 1 * MiB;
constexpr size_t WS_WIN = 2 * MiB;
constexpr size_t WS_WOUT = WS_WIN + 46 * MiB;
constexpr size_t WS_WQB = WS_WOUT + 16 * MiB;
constexpr size_t WS_WKVB = WS_WQB + 2 * MiB;
constexpr size_t WS_W13 = WS_WKVB + 1 * MiB;
constexpr size_t WS_W2 = WS_W13 + 44 * MiB;
constexpr size_t WS_MW13 = WS_W2 + 22 * MiB;
constexpr size_t WS_MW2 = WS_MW13 + 448 * MiB;
constexpr size_t WS_HN = WS_MW2 + 224 * MiB;
constexpr size_t WS_A2 = WS_HN + 36 * MiB;
constexpr size_t WS_X = WS_A2 + 36 * MiB;
constexpr size_t WS_BIG = WS_X + 72 * MiB;
constexpr size_t WS_P = WS_BIG;
constexpr size_t WS_GRAW = WS_BIG + 104 * MiB;
constexpr size_t WS_CQN = WS_P + 207 * MiB;
constexpr size_t WS_CKVN = WS_CQN + 9 * MiB;
constexpr size_t WS_QRAW = WS_CKVN + 5 * MiB;
constexpr size_t WS_KVRAW = WS_QRAW + 14 * MiB;
constexpr size_t WS_QMLA = WS_KVRAW + 18 * MiB;
constexpr size_t WS_KMLA = WS_QMLA + 14 * MiB;
constexpr size_t WS_VTMLA = WS_KMLA + 14 * MiB;
constexpr size_t WS_QNA = WS_VTMLA + 9 * MiB;
constexpr size_t WS_KNA = WS_QNA + 9 * MiB;
constexpr size_t WS_VTNA = WS_KNA + 9 * MiB;
constexpr size_t WS_XBC = WS_VTNA + 9 * MiB;
constexpr size_t WS_DT = WS_XBC + 18 * MiB;
constexpr size_t WS_GATES = WS_DT + 1 * MiB;
constexpr size_t WS_MLSC = WS_GATES + 1 * MiB;
constexpr size_t WS_SSSC = WS_MLSC + 64 * 1024;
constexpr size_t WS_MLU = WS_MLSC + 1 * MiB;
constexpr size_t WS_MLS = WS_MLU + 73 * MiB;
constexpr size_t WS_SSU = WS_MLS + 37 * MiB;
constexpr size_t WS_SSS = WS_SSU + 72 * MiB;
constexpr size_t WS_HML = WS_SSS + 36 * MiB;
constexpr size_t WS_YSS = WS_HML + 36 * MiB;
constexpr size_t WS_MIXEND = WS_YSS + 36 * MiB;
constexpr size_t WS_G = WS_BIG;
constexpr size_t WS_Y = WS_G + 252 * MiB;
constexpr size_t WS_XG = WS_Y + 144 * MiB;
constexpr size_t WS_TOK = WS_XG + 256 * MiB;
constexpr size_t WS_PART = WS_TOK + 1 * MiB;
constexpr size_t WS_FFNEND = WS_PART + 64 * MiB;
constexpr size_t WS_END = (WS_MIXEND > WS_FFNEND ? WS_MIXEND : WS_FFNEND);
static_assert(WS_END < (size_t)1800 * MiB, "workspace budget");
static_assert((size_t)MTOK * DINP * 4 <= 207 * MiB && (size_t)32 * 36 * 129 * 128 * 4 <= 73 * MiB, "sizes");
constexpr int CW_BAR = 4096;
constexpr int CW_MOE = 16384;
constexpr int CW_QH = 20480;
constexpr int CW_ARR = 32768;

constexpr int RING_BYTES = 131072;
constexpr int MISC_OFF = 147456 - 256;
constexpr int LDS_BYTES = 147456;
constexpr int NWAVES = 8, NTHR = 512;

#define RLX_AGENT __ATOMIC_RELAXED, __HIP_MEMORY_SCOPE_AGENT
#define LDS_WAIT() asm volatile("s_waitcnt lgkmcnt(0)" ::: "memory")
#define VM_WAIT() asm volatile("s_waitcnt vmcnt(0)" ::: "memory")
DI unsigned f2bf(float f) { unsigned u = __builtin_bit_cast(unsigned, f); return (u + 0x7fffu + ((u >> 16) & 1u)) >> 16; }
DI unsigned pk2(float lo, float hi) { return f2bf(lo) | (f2bf(hi) << 16); }
DI float bf2f(unsigned b) { return __builtin_bit_cast(float, b << 16); }
#define PINV(x) asm volatile("" : "+v"(x))
#define PIN4(a) asm volatile("" : "+v"((a)[0]), "+v"((a)[1]), "+v"((a)[2]), "+v"((a)[3]))
#define PIN8(a) asm volatile("" : "+v"((a)[0]), "+v"((a)[1]), "+v"((a)[2]), "+v"((a)[3]), "+v"((a)[4]), "+v"((a)[5]), "+v"((a)[6]), "+v"((a)[7]))
DI float wave_sum(float v) {
#pragma unroll
    for (int o = 1; o < 64; o <<= 1) v += __shfl_xor(v, o);
    return v;
}
DI float wave_max(float v) {
#pragma unroll
    for (int o = 1; o < 64; o <<= 1) v = fmaxf(v, __shfl_xor(v, o));
    return v;
}
DI float wave_incl_scan(float v, int lane) {
#pragma unroll
    for (int o = 1; o < 64; o <<= 1) { const float t = __shfl_up(v, o); if (lane >= o) v += t; }
    return v;
}
DI float siluf(float x) { return x / (1.f + __expf(-x)); }
DI float sigmoidf_(float x) { return 1.f / (1.f + __expf(-x)); }
DI float softplusf_(float x) { return fmaxf(x, 0.f) + log1pf(__expf(-fabsf(x))); }
DI float logsigmoidf_(float x) { return fminf(x, 0.f) - log1pf(__expf(-fabsf(x))); }

#define XB_TMO      128
#define XB_XCNT(j)  (256  + 64 * (j))
#define XB_XSUB(j)  (1280 + 64 * (j))
#define XB_XGEN(j)  (2304 + 64 * (j))
#define XB_TOP      3328
#define XB_TOPGEN   3392
#define XCD_BAR_WORDS 3456
#define XB_SPIN_CAP (1u << 22)
DI unsigned xb_ld(unsigned* p)              { return __hip_atomic_load(p, __ATOMIC_RELAXED, __HIP_MEMORY_SCOPE_AGENT); }
DI unsigned xb_add(unsigned* p, unsigned v) { return __hip_atomic_fetch_add(p, v, __ATOMIC_RELAXED, __HIP_MEMORY_SCOPE_AGENT); }
DI unsigned xb_xcc_id() { return (unsigned)__builtin_amdgcn_s_getreg((3 << 11) | 20) & 0xFu; }
#define XB_SPIN(cond, bar) do { unsigned _sp = 0; while (cond) { __builtin_amdgcn_s_sleep(1); \
    if ((++_sp & 255u) == 0u) { if (xb_ld(&(bar)[XB_TMO])) break; if (_sp > XB_SPIN_CAP) { atomicAdd(&(bar)[XB_TMO], 1u); break; } } } } while (0)
struct XcdBarrier { unsigned* bar; unsigned x; volatile LAS unsigned* st; };
DI XcdBarrier xcd_barrier_post(unsigned* bar, volatile LAS unsigned* st) {
    XcdBarrier b; b.bar = bar; b.x = xb_xcc_id(); b.st = st;
    if (threadIdx.x == 0) (void)xb_add(&bar[XB_XCNT(b.x)], 1u);
    return b;
}
DI void xcd_barrier_complete(unsigned* bar, unsigned x, unsigned& nloc, unsigned& nx) {
    const unsigned G = gridDim.x * gridDim.y * gridDim.z;
    unsigned sum, cnt, mine, sp = 0u;
    for (;;) {
        sum = 0u; cnt = 0u; mine = 0u;
#pragma unroll
        for (unsigned j = 0; j < 16; ++j) { const unsigned c = xb_ld(&bar[XB_XCNT(j)]); sum += c; cnt += (c > 0u) ? 1u : 0u; mine = (j == x) ? c : mine; }
        if (sum == G) break;
        __builtin_amdgcn_s_sleep(1);
        if ((++sp & 255u) == 0u) { if (xb_ld(&bar[XB_TMO])) break; if (sp > XB_SPIN_CAP) { atomicAdd(&bar[XB_TMO], 1u); break; } }
    }
    nloc = mine > 0u ? mine : 1u; nx = cnt > 0u ? cnt : 1u;
}
DI void xcd_barrier(const XcdBarrier& b) {
    asm volatile("s_waitcnt vmcnt(0)" ::: "memory");
    __syncthreads();
    if (threadIdx.x == 0) {
        unsigned* bar = b.bar;
        __builtin_amdgcn_s_waitcnt(0);
        unsigned nloc = b.st[0], nx = b.st[1];
        if (nloc == 0u) { xcd_barrier_complete(bar, b.x, nloc, nx); b.st[0] = nloc; b.st[1] = nx; }
        const unsigned old = xb_add(&bar[XB_XSUB(b.x)], 1u);
        const unsigned gen = old / nloc;
        if (old + 1u == (gen + 1u) * nloc) {
            __builtin_amdgcn_fence(__ATOMIC_RELEASE, "agent");
            asm volatile("s_waitcnt vmcnt(0)" ::: "memory");
            const unsigned og = xb_add(&bar[XB_TOP], 1u);
            const unsigned tg = og / nx;
            if (og + 1u == (tg + 1u) * nx) xb_add(&bar[XB_TOPGEN], 1u);
            else XB_SPIN(xb_ld(&bar[XB_TOPGEN]) == tg, bar);
            __builtin_amdgcn_fence(__ATOMIC_ACQUIRE, "agent");
            xb_add(&bar[XB_XGEN(b.x)], 1u);
            asm volatile("s_waitcnt vmcnt(0)" ::: "memory");
        } else {
            XB_SPIN(xb_ld(&bar[XB_XGEN(b.x)]) == gen, bar);
            __builtin_amdgcn_fence(__ATOMIC_ACQUIRE, "agent");
            asm volatile("s_waitcnt vmcnt(0)" ::: "memory");
        }
    }
    __syncthreads();
}

struct Args { const float* in[35]; float* out; unsigned char* ws; int ph_lo, ph_hi, rep, pad; };
struct Frame {
    LAS unsigned char* lds;
    unsigned char* ws;
    const float* in[35];
    float* out;
    int tid, lane, wave, G, bid, rep;
};
#define WSP(T, off) ((T*)(F.ws + (off)))
DI int rowof(int b, int j) { return j < TL ? b * TL + j : MLAT + b * TC + (j - TL); }

template <int K> DI f32x4 mma16(const LAS bf16* A, int lda, const LAS bf16* Bt, int ldb, int lane, f32x4 acc) {
    const int r = lane & 15, q = lane >> 4;
    const LAS bf16* pa = A + r * lda + 8 * q; const LAS bf16* pb = Bt + r * ldb + 8 * q;
#pragma unroll
    for (int k = 0; k < K; k += 32) {
        const bf16x8 a = *(const LAS bf16x8*)(pa + k); const bf16x8 b = *(const LAS bf16x8*)(pb + k);
        acc = __builtin_amdgcn_mfma_f32_16x16x32_bf16(a, b, acc, 0, 0, 0);
    }
    return acc;
}
struct CvDesc { const float* src; bf16* dst; size_t ld, Kd; int Kv, Nv, k0, n0, dn0; };
DI void tr_load(const CvDesc& d, f32x4 (&v)[16], int lane) {
    const int nn = 4 * (lane & 15), kq = lane >> 4;
#pragma unroll
    for (int i = 0; i < 16; ++i) { const int kk = 4 * i + kq;
        v[i] = (f32x4){0.f, 0.f, 0.f, 0.f};
        if (d.k0 + kk < d.Kv && d.n0 + nn < d.Nv) v[i] = __builtin_nontemporal_load((const f32x4*)(d.src + (size_t)(d.k0 + kk) * d.ld + d.n0 + nn)); }
}
DI void tr_lds(const f32x4 (&v)[16], LAS float* scr, int lane) {
    const int nn = 4 * (lane & 15), kq = lane >> 4;
#pragma unroll
    for (int i = 0; i < 16; ++i) { const int kk = 4 * i + kq; LAS float* s = scr + kk * 65 + nn; s[0] = v[i][0]; s[1] = v[i][1]; s[2] = v[i][2]; s[3] = v[i][3]; }
    LDS_WAIT(); asm volatile("" ::: "memory");
}
DI void tr_out(const CvDesc& d, LAS float* scr, int lane) {
    const int c = lane & 7;
#pragma unroll
    for (int j = 0; j < 8; ++j) { const int n = (lane >> 3) + 8 * j; const LAS float* s = scr + (8 * c) * 65 + n;
        u32x4 o; o.x = pk2(s[0 * 65], s[1 * 65]); o.y = pk2(s[2 * 65], s[3 * 65]); o.z = pk2(s[4 * 65], s[5 * 65]); o.w = pk2(s[6 * 65], s[7 * 65]);
        *(u32x4*)(d.dst + (size_t)(d.dn0 + n) * d.Kd + d.k0 + 8 * c) = o; }
    LDS_WAIT(); asm volatile("" ::: "memory");
}
DI int il_row(int n0, int which) { return (n0 >> 7) * 256 + (n0 & 127) + which * 128; }

constexpr int I_IN = 32 * 92, I_OUT = 32 * 32, I_QB = 8 * 12, I_KVB = 4 * 16, I_F1 = 32 * 88, I_F2 = 88 * 32, I_M1 = 32 * 112, I_M2 = 112 * 32;
constexpr int I_L = I_IN + I_OUT + I_QB + I_KVB;
constexpr int CV_NE = I_L + 2 * I_F1 + I_F2, CV_NQ1 = CV_NE + I_L, CV_NALL = CV_NQ1 + NEXP * (2 * I_M1 + I_M2);
DI CvDesc conv_decode(Frame& F, int it) {
    int r = it;
    if (r >= CV_NQ1) { r -= CV_NQ1;
        if (r < NEXP * 2 * I_M1) { const int e = r / (2 * I_M1); r -= e * 2 * I_M1; const int which = r / I_M1; r -= which * I_M1; const int kb = r / 112, nb = r % 112;
            return CvDesc{(which ? F.in[33] : F.in[32]) + (size_t)e * D * FE, WSP(bf16, WS_MW13) + (size_t)e * 2 * FE * D, (size_t)(FE), (size_t)(D), D, FE, 64 * kb, 64 * nb, il_row(64 * nb, which)}; }
        r -= NEXP * 2 * I_M1;
        { const int e = r / I_M2; r -= e * I_M2; const int kb = r / 32, nb = r % 32;
            return CvDesc{F.in[34] + (size_t)e * FE * D, WSP(bf16, WS_MW2) + (size_t)e * D * FE, (size_t)(D), (size_t)(FE), FE, D, 64 * kb, 64 * nb, 64 * nb}; }
    }
    int l = 0;
    if (r >= CV_NE) { r -= CV_NE; l = 1; }
    else if (r >= I_L) { r -= I_L;
        if (r < 2 * I_F1) { const int which = r / I_F1; r -= which * I_F1; const int kb = r / 88, nb = r % 88;
            return CvDesc{(which ? F.in[29] : F.in[28]), WSP(bf16, WS_W13), (size_t)(FF), (size_t)(D), D, FF, 64 * kb, 64 * nb, il_row(64 * nb, which)}; }
        r -= 2 * I_F1;
        { const int kb = r / 32, nb = r % 32; return CvDesc{F.in[30], WSP(bf16, WS_W2), (size_t)(D), (size_t)(FF), FF, D, 64 * kb, 64 * nb, 64 * nb}; }
    }
    if (r < I_IN) { const int kb = r / 92, nb = r % 92;
        return CvDesc{F.in[7] + (size_t)l * D * DIN, WSP(bf16, WS_WIN) + (size_t)l * DINP * D, (size_t)(DIN), (size_t)(D), D, DIN, 64 * kb, 64 * nb, 64 * nb}; }
    r -= I_IN;
    if (r < I_OUT) { const int kb = r / 32, nb = r % 32;
        return CvDesc{F.in[8] + (size_t)l * D * D, WSP(bf16, WS_WOUT) + (size_t)l * D * D, (size_t)(D), (size_t)(D), D, D, 64 * kb, 64 * nb, 64 * nb}; }
    r -= I_OUT;
    if (r < I_QB) { const int kb = r / 12, nb = r % 12;
        return CvDesc{F.in[19] + (size_t)l * 448 * 768, WSP(bf16, WS_WQB) + (size_t)l * 768 * 512, (size_t)(768), (size_t)(512), 448, 768, 64 * kb, 64 * nb, 64 * nb}; }
    r -= I_QB;
    { const int kb = r / 16, nb = r % 16;
        return CvDesc{F.in[21] + (size_t)l * 160 * 1024, WSP(bf16, WS_WKVB) + (size_t)l * 1024 * 256, (size_t)(1024), (size_t)(256), 160, 1024, 64 * kb, 64 * nb, 64 * nb}; }
}

DI void conv_item(Frame& F, int it, LAS float* scr) { const CvDesc d = conv_decode(F, it); f32x4 v[16]; tr_load(d, v, F.lane); tr_lds(v, scr, F.lane); tr_out(d, scr, F.lane); }
DI void conv_items(Frame& F, int it0, int n, LAS float* scr) {
    if (it0 >= CV_NALL) return;
    if (it0 + n > CV_NALL) n = CV_NALL - it0;
    CvDesc d = conv_decode(F, it0); f32x4 v[16]; tr_load(d, v, F.lane);
    for (int k = 0; k < n; ++k) {
        tr_lds(v, scr, F.lane);
        CvDesc dn = d;
        if (k + 1 < n) { dn = conv_decode(F, it0 + k + 1); tr_load(dn, v, F.lane); }
        tr_out(d, scr, F.lane);
        d = dn;
    }
}
DI void p0_prologue(Frame& F) {
    {
        LAS float* sc = (LAS float*)F.lds;
        LAS float* red = (LAS float*)(F.lds + 5 * 2048 * 4);
        bool have = false;
        for (int u = F.bid; u < 2 * 96; u += F.G) {
            if (!have) {
                for (int i = F.tid; i < 5 * 2048; i += NTHR) { const float x = (i < 4 * 2048) ? F.in[1][i] : F.in[3][i - 4 * 2048]; sc[i] = siluf(x); }
                have = true;
            }
            __syncthreads();
            const int l = u / 96, j0 = (u % 96) * 128;
            const float* W = F.in[4] + (size_t)l * D * D6 + j0 + 2 * F.lane;
            f32x2 acc[5];
#pragma unroll
            for (int r = 0; r < 5; ++r) acc[r] = (f32x2){0.f, 0.f};
            const int kb = F.wave * 256;
            for (int k = 0; k < 256; k += 8) {
                f32x2 w[8];
#pragma unroll
                for (int i = 0; i < 8; ++i) w[i] = *(const f32x2*)(W + (size_t)(kb + k + i) * D6);
#pragma unroll
                for (int i = 0; i < 8; ++i)
#pragma unroll
                    for (int r = 0; r < 5; ++r) { const float s = sc[r * 2048 + kb + k + i]; acc[r] += w[i] * s; }
            }
#pragma unroll
            for (int r = 0; r < 5; ++r) { red[(F.wave * 5 + r) * 128 + 2 * F.lane] = acc[r][0]; red[(F.wave * 5 + r) * 128 + 2 * F.lane + 1] = acc[r][1]; }
            __syncthreads();
            for (int i = F.tid; i < 5 * 128; i += NTHR) { const int r = i / 128, j = i % 128; float s = F.in[5][l * D6 + j0 + j];
#pragma unroll
                for (int w = 0; w < 8; ++w) s += red[(w * 5 + r) * 128 + j];
                WSP(float, WS_MOD)[(l * 5 + r) * D6 + j0 + j] = s; }
        }
        __syncthreads();
    }
    LAS float* scr = (LAS float*)(F.lds + F.wave * 16640);
    const int gw = F.bid * NWAVES + F.wave, NGW = F.G * NWAVES;
    for (int it = gw; it < I_L; it += NGW) conv_item(F, it, scr);
}

constexpr int CV_EAGER = I_L;
constexpr int CV_NDEF = CV_NALL - CV_EAGER;
DI void conv_fill(Frame& F, int phase, bool work) {
    LAS float* scr = (LAS float*)(F.lds + F.wave * 16640);
    volatile LAS int* bc = (volatile LAS int*)(F.lds + MISC_OFF) + 16;
    unsigned* ctl = WSP(unsigned, WS_CTL);
    __syncthreads();
    if (F.tid == 0) __hip_atomic_fetch_add(ctl + CW_ARR + 64 * phase, 1u, RLX_AGENT);
    if (!work) return;
    for (;;) {
        if (F.tid == 0) {
            int base = -1;
            if (__hip_atomic_load(ctl + CW_ARR + 64 * phase, RLX_AGENT) < (unsigned)F.G) { base = (int)__hip_atomic_fetch_add(ctl + CW_QH, 32u, RLX_AGENT); if (base >= CV_NDEF) base = -1; }
            bc[0] = base;
        }
        __syncthreads();
        const int base = bc[0];
        __syncthreads();
        if (base < 0) break;
        conv_items(F, CV_EAGER + base + F.wave * 4, 4, scr);
    }
}
DI void conv_drain(Frame& F, int upto) {
    LAS float* scr = (LAS float*)(F.lds + F.wave * 16640);
    volatile LAS int* bc = (volatile LAS int*)(F.lds + MISC_OFF) + 16;
    unsigned* ctl = WSP(unsigned, WS_CTL);
    __syncthreads();
    for (;;) {
        if (F.tid == 0) {
            int base = -1;
            if ((int)__hip_atomic_load(ctl + CW_QH, RLX_AGENT) < upto) { base = (int)__hip_atomic_fetch_add(ctl + CW_QH, 64u, RLX_AGENT); if (base >= CV_NDEF) base = -1; }
            bc[0] = base;
        }
        __syncthreads();
        const int base = bc[0];
        __syncthreads();
        if (base < 0) break;
        conv_items(F, CV_EAGER + base + F.wave * 8, 8, scr);
    }
}
template <bool ROUTE>
DI void norm_phase(Frame& F, int l, const float* srcLat, const float* srcCtx, const float* g, int shoff, int nrows) {
    LAS float* rl = (LAS float*)F.lds;
    if (ROUTE) { for (int i = F.tid; i < D * NEXP; i += NTHR) rl[i] = F.in[31][i]; __syncthreads(); }
    const int gw = F.bid * NWAVES + F.wave, NGW = F.G * NWAVES;
    bf16* HN = WSP(bf16, WS_HN);
    f32x4 gv[8];
#pragma unroll
    for (int j = 0; j < 8; ++j) gv[j] = *(const f32x4*)(g + 4 * F.lane + 256 * j);
    for (int row = gw; row < nrows; row += NGW) {
        const float* xr = row < MLAT ? srcLat + (size_t)row * D : srcCtx + (size_t)(row - MLAT) * D;
        const int br = row < MLAT ? row / TL : 4;
        const float* mrow = WSP(float, WS_MOD) + (size_t)(l * 5 + br) * D6 + shoff;
        f32x4 v[8], shv[8], scv[8]; float ss = 0.f;
#pragma unroll
        for (int j = 0; j < 8; ++j) { const int c = 4 * F.lane + 256 * j; v[j] = *(const f32x4*)(xr + c); shv[j] = *(const f32x4*)(mrow + c); scv[j] = *(const f32x4*)(mrow + D + c); }
#pragma unroll
        for (int j = 0; j < 8; ++j) { PINV(v[j]); PINV(shv[j]); PINV(scv[j]); }
#pragma unroll
        for (int j = 0; j < 8; ++j) ss += (v[j][0] * v[j][0] + v[j][1] * v[j][1]) + (v[j][2] * v[j][2] + v[j][3] * v[j][3]);
        const float rstd = 1.0f / sqrtf(wave_sum(ss) * (1.f / D) + EPS);
        float lg[8]; u32x2 wk[8];
        if (ROUTE) {
#pragma unroll
            for (int e = 0; e < 8; ++e) lg[e] = 0.f; }
#pragma unroll
        for (int j = 0; j < 8; ++j) { const int c = 4 * F.lane + 256 * j;
            const f32x4 gg = gv[j], sh = shv[j], sc = scv[j];
            f32x4 o;
#pragma unroll
            for (int i = 0; i < 4; ++i) o[i] = v[j][i] * rstd * gg[i] * (1.f + sc[i]) + sh[i];
            u32x2 w; w.x = pk2(o[0], o[1]); w.y = pk2(o[2], o[3]);
            if (ROUTE) wk[j] = w; else *(u32x2*)(HN + (size_t)row * D + c) = w;
            if (ROUTE) {
#pragma unroll
                for (int i = 0; i < 4; ++i) { const f32x4 r0 = *(const LAS f32x4*)(rl + (c + i) * 8), r1 = *(const LAS f32x4*)(rl + (c + i) * 8 + 4);
                    lg[0] += o[i] * r0[0]; lg[1] += o[i] * r0[1]; lg[2] += o[i] * r0[2]; lg[3] += o[i] * r0[3];
                    lg[4] += o[i] * r1[0]; lg[5] += o[i] * r1[1]; lg[6] += o[i] * r1[2]; lg[7] += o[i] * r1[3]; }
                __builtin_amdgcn_sched_barrier(0);
            }
        }
        if (ROUTE) {
#pragma unroll
            for (int e = 0; e < 8; ++e) lg[e] = wave_sum(lg[e]);
            int r1 = 0, r2 = 0;
            if (F.lane == 0) {
                int e1 = 0; float v1 = lg[0];
#pragma unroll
                for (int e = 1; e < 8; ++e) if (lg[e] > v1) { v1 = lg[e]; e1 = e; }
                int e2 = -1; float v2 = -3.0e38f;
#pragma unroll
                for (int e = 0; e < 8; ++e) if (e != e1 && lg[e] > v2) { v2 = lg[e]; e2 = e; }
                const float g2 = 1.f / (1.f + expf(v1 - v2)), g1 = 1.f - g2;
                unsigned* cnt = WSP(unsigned, WS_CTL) + CW_MOE;
                const unsigned p1 = __hip_atomic_fetch_add(cnt + e1, 1u, RLX_AGENT), p2 = __hip_atomic_fetch_add(cnt + e2, 1u, RLX_AGENT);
                int* tk = WSP(int, WS_TOK) + (size_t)row * 8;
                tk[0] = e1; tk[1] = (int)p1; tk[2] = e2; tk[3] = (int)p2; ((float*)tk)[4] = g1; ((float*)tk)[5] = g2;
                r1 = e1 * MLAT + (int)p1; r2 = e2 * MLAT + (int)p2;
            }
            r1 = __shfl(r1, 0); r2 = __shfl(r2, 0);
            bf16* XS = WSP(bf16, WS_XG);
#pragma unroll
            for (int j = 0; j < 8; ++j) { const int c = 4 * F.lane + 256 * j; *(u32x2*)(XS + (size_t)r1 * D + c) = wk[j]; *(u32x2*)(XS + (size_t)r2 * D + c) = wk[j]; }
        }
    }
}

DI void moe_tables(Frame& F, LAS int* tb, int NT) {
    if (F.tid == 0) {
        const unsigned* cnt = WSP(unsigned, WS_CTL) + CW_MOE; int ts = 0, us = 0;
        for (int e = 0; e < 8; ++e) { const int c = (int)__hip_atomic_load(cnt + e, RLX_AGENT); const int t = (c + 255) >> 8; tb[e] = c; tb[8 + e] = t; tb[16 + e] = ts; tb[32 + e] = us; ts += t; us += t * NT; }
        tb[24] = ts; tb[40] = us;
    }
    __syncthreads();
}
DI void moe_combine_phase(Frame& F, int l) {
    LAS int* tb = (LAS int*)F.lds; __syncthreads(); moe_tables(F, tb, 1);
    const int gw = F.bid * NWAVES + F.wave, NGW = F.G * NWAVES;
    const float* Y = WSP(float, WS_Y); const float* X = WSP(float, WS_X);
    for (int row = gw; row < MLAT; row += NGW) {
        const int* tk = WSP(int, WS_TOK) + (size_t)row * 8;
        const float g1 = ((const float*)tk)[4], g2 = ((const float*)tk)[5];
        const int s1 = tb[16 + tk[0]] * 256 + tk[1], s2 = tb[16 + tk[2]] * 256 + tk[3];
        const float* mrow = WSP(float, WS_MOD) + (size_t)(l * 5 + row / TL) * D6 + 5 * D;
        f32x4 xv[8], y1[8], y2[8], gq[8];
#pragma unroll
        for (int j = 0; j < 8; ++j) { const int c = 4 * F.lane + 256 * j;
            xv[j] = *(const f32x4*)(X + (size_t)row * D + c); y1[j] = *(const f32x4*)(Y + (size_t)s1 * D + c); y2[j] = *(const f32x4*)(Y + (size_t)s2 * D + c); gq[j] = *(const f32x4*)(mrow + c); }
#pragma unroll
        for (int j = 0; j < 8; ++j) { PINV(xv[j]); PINV(y1[j]); PINV(y2[j]); PINV(gq[j]); }
#pragma unroll
        for (int j = 0; j < 8; ++j) { const int c = 4 * F.lane + 256 * j; const f32x4 gg = gq[j];
            *(f32x4*)(F.out + (size_t)row * D + c) = xv[j] + gg * (y1[j] * g1 + y2[j] * g2); }
    }
}
using pg8::Unit;
struct EpiF32 {
    static constexpr bool PERM = false;
    float* C; int ldc;
    DI void operator()(const f32x4 (&acc)[2][2][4][2], const Unit& u, int wr, int wc, int fr, int fq) const {
        const int row0 = u.pm * 256 + wr * 64 + fr, col0 = u.pn * 256 + wc * 32 + 4 * fq;
#pragma unroll
        for (int ai = 0; ai < 2; ++ai)
#pragma unroll
            for (int m = 0; m < 4; ++m) { float* rowp = C + (size_t)(row0 + ai * 128 + m * 16) * ldc + col0;
#pragma unroll
                for (int bj = 0; bj < 2; ++bj)
#pragma unroll
                    for (int n = 0; n < 2; ++n) *(f32x4*)(rowp + bj * 128 + n * 16) = acc[ai][bj][m][n]; }
    }
};
struct EpiBf16 {
    static constexpr bool PERM = true;
    bf16* O; int ldc;
    DI void operator()(const f32x4 (&acc)[2][2][4][2], const Unit& u, int wr, int wc, int fr, int fq) const {
        const int row0 = u.pm * 256 + wr * 64 + fr, col0 = u.pn * 256 + wc * 32 + 8 * fq;
#pragma unroll
        for (int ai = 0; ai < 2; ++ai)
#pragma unroll
            for (int m = 0; m < 4; ++m) { bf16* rowp = O + (size_t)(row0 + ai * 128 + m * 16) * ldc + col0;
#pragma unroll
                for (int bj = 0; bj < 2; ++bj) { const f32x4 v0 = acc[ai][bj][m][0], v1 = acc[ai][bj][m][1];
                    u32x4 w; w.x = pg8::cvt_pk_bf16(v0[0], v0[1]); w.y = pg8::cvt_pk_bf16(v0[2], v0[3]); w.z = pg8::cvt_pk_bf16(v1[0], v1[1]); w.w = pg8::cvt_pk_bf16(v1[2], v1[3]);
                    *(u32x4*)(rowp + bj * 128) = w; } }
    }
};
struct EpiP {
    static constexpr bool PERM = true;
    bf16* O; float* graw;
    DI void operator()(const f32x4 (&acc)[2][2][4][2], const Unit& u, int wr, int wc, int fr, int fq) const {
        const int row0 = u.pm * 256 + wr * 64 + fr, col0 = u.pn * 256 + wc * 32 + 8 * fq;
#pragma unroll
        for (int ai = 0; ai < 2; ++ai)
#pragma unroll
            for (int m = 0; m < 4; ++m) { bf16* rowp = O + (size_t)(row0 + ai * 128 + m * 16) * DINP + col0;
#pragma unroll
                for (int bj = 0; bj < 2; ++bj) { const f32x4 v0 = acc[ai][bj][m][0], v1 = acc[ai][bj][m][1];
                    u32x4 w; w.x = pg8::cvt_pk_bf16(v0[0], v0[1]); w.y = pg8::cvt_pk_bf16(v0[2], v0[3]); w.z = pg8::cvt_pk_bf16(v1[0], v1[1]); w.w = pg8::cvt_pk_bf16(v1[2], v1[3]);
                    *(u32x4*)(rowp + bj * 128) = w; } }
        const bool gsel = (u.pn == 8 && wc == 0 && fq < 2), dsel = (u.pn == 14 && wc == 0 && fq >= 2);
        if (gsel || dsel) { const int off = gsel ? 8 * fq : 16 + 8 * (fq - 2);
#pragma unroll
            for (int ai = 0; ai < 2; ++ai)
#pragma unroll
                for (int m = 0; m < 4; ++m) { float* gp = graw + (size_t)(row0 + ai * 128 + m * 16) * 32 + off;
                    *(f32x4*)gp = acc[ai][0][m][0]; *(f32x4*)(gp + 4) = acc[ai][0][m][1]; } }
    }
};
struct EpiSwiglu {
    static constexpr bool PERM = true;
    bf16* O; int ldc;
    DI void operator()(const f32x4 (&acc)[2][2][4][2], const Unit& u, int wr, int wc, int fr, int fq) const {
        const int row0 = u.pm * 256 + wr * 64 + fr, col0 = u.pn * 128 + wc * 32 + 8 * fq;
#pragma unroll
        for (int ai = 0; ai < 2; ++ai)
#pragma unroll
            for (int m = 0; m < 4; ++m) { bf16* rowp = O + (size_t)(row0 + ai * 128 + m * 16) * ldc + col0;
                f32x4 v0, v1;
#pragma unroll
                for (int j = 0; j < 4; ++j) { v0[j] = siluf(acc[ai][0][m][0][j]) * acc[ai][1][m][0][j]; v1[j] = siluf(acc[ai][0][m][1][j]) * acc[ai][1][m][1][j]; }
                u32x4 w; w.x = pg8::cvt_pk_bf16(v0[0], v0[1]); w.y = pg8::cvt_pk_bf16(v0[2], v0[3]); w.z = pg8::cvt_pk_bf16(v1[0], v1[1]); w.w = pg8::cvt_pk_bf16(v1[2], v1[3]);
                *(u32x4*)rowp = w; }
    }
};
struct EpiResid {
    static constexpr bool PERM = false;
    const float* baseLat; const float* baseCtx; float* out; const float* mod;
    DI void operator()(const f32x4 (&acc)[2][2][4][2], const Unit& u, int wr, int wc, int fr, int fq) const {
        const int row0 = u.pm * 256 + wr * 64 + fr, col0 = u.pn * 256 + wc * 32 + 4 * fq;
        const int br = (u.pm * 256 < MLAT) ? (u.pm * 256) / TL : 4;
        const float* gate = mod + (size_t)br * D6 + col0;
        f32x4 gv[2][2];
#pragma unroll
        for (int bj = 0; bj < 2; ++bj)
#pragma unroll
            for (int n = 0; n < 2; ++n) gv[bj][n] = *(const f32x4*)(gate + bj * 128 + n * 16);
#pragma unroll
        for (int ai = 0; ai < 2; ++ai)
#pragma unroll
            for (int m = 0; m < 4; ++m) { const int row = row0 + ai * 128 + m * 16;
                const float* bp = (row < MLAT ? baseLat + (size_t)row * D : baseCtx + (size_t)(row - MLAT) * D) + col0; float* op = out + (size_t)row * D + col0;
#pragma unroll
                for (int bj = 0; bj < 2; ++bj)
#pragma unroll
                    for (int n = 0; n < 2; ++n) { const f32x4 b = *(const f32x4*)(bp + bj * 128 + n * 16); *(f32x4*)(op + bj * 128 + n * 16) = b + gv[bj][n] * acc[ai][bj][m][n]; } }
    }
};
struct MoeOrder {
    const LAS int* tb; int NT, G, c, L0, nT, S, KS, acap;
    DI bool next(int i, Unit& u) const {
        const long T = (long)i * G + c; if (T >= nT) return false;
        const int nun = tb[40], L = L0 + (int)T / S, sl = (int)T % S;
        const int w = pg8::xcd_remap(L, nun); int e = 0;
#pragma unroll
        for (int k = 1; k < 8; ++k) if (w >= tb[32 + k]) e = k;
        const int rem = w - tb[32 + e], tiles = tb[8 + e], nt = rem / tiles, mtl = rem - nt * tiles;
        u.pm = tb[16 + e] + mtl; u.pn = nt; u.pb = e * NT + nt; u.koff = sl * KS; u.aux = (int)T; u.pa = acap ? e * acap + mtl : u.pm; return true;
    }
};
struct EpiPart {
    static constexpr bool PERM = false;
    float* part;
    DI void operator()(const f32x4 (&acc)[2][2][4][2], const Unit& u, int wr, int wc, int fr, int fq) const {
        f32x4* p = (f32x4*)part + (size_t)u.aux * (32 * NTHR) + threadIdx.x;
#pragma unroll
        for (int ai = 0; ai < 2; ++ai)
#pragma unroll
            for (int bj = 0; bj < 2; ++bj)
#pragma unroll
                for (int m = 0; m < 4; ++m)
#pragma unroll
                    for (int n = 0; n < 2; ++n) p[(size_t)(((ai * 2 + bj) * 4 + m) * 2 + n) * NTHR] = acc[ai][bj][m][n];
    }
};
template <int S> DI void splitk_reduce_f32(const float* part, int t, int cg, const Unit& u, float* C, int ldc) {
    const int tid = threadIdx.x, wid = tid >> 6, lane = tid & 63, wr = wid >> 2, wc = wid & 3, fr = lane & 15, fq = lane >> 4;
    f32x4 v[4][S];
#pragma unroll
    for (int k = 0; k < 4; ++k)
#pragma unroll
        for (int s = 0; s < S; ++s) v[k][s] = *((const f32x4*)part + ((size_t)(t * S + s) * 32 + (cg * 4 + k)) * NTHR + tid);
#pragma unroll
    for (int k = 0; k < 4; ++k) { const int ch = cg * 4 + k, n = ch & 1, m = (ch >> 1) & 3, bj = (ch >> 3) & 1, ai = ch >> 4;
        f32x4 a = v[k][0];
#pragma unroll
        for (int s = 1; s < S; ++s) a += v[k][s];
        *(f32x4*)(C + (size_t)(u.pm * 256 + ai * 128 + wr * 64 + m * 16 + fr) * ldc + u.pn * 256 + bj * 128 + wc * 32 + n * 16 + 4 * fq) = a; }
}
DI int tc_of(int dir, int p) { return dir == 0 ? (p < 4 ? 32 + p : p - 4) : 35 - p; }

DI void m1_prep_unit(Frame& F, int l, int b, int tt) {
    const bf16* P = WSP(bf16, WS_P); const float* GR = WSP(float, WS_GRAW);
    const int j0 = tt * 32, lane = F.lane;
    LAS bf16* vs = (LAS bf16*)F.lds;
    for (int i = F.wave; i < 32; i += 8) {
        const int j = j0 + i, row = rowof(b, j);
        const bf16* p = P + (size_t)row * DINP; const float* gr = GR + (size_t)row * 32;
        float cq[7], ckv[3], nq[4][2], nk[4][2]; bf16 nv[8];
#pragma unroll
        for (int u = 0; u < 7; ++u) cq[u] = bf2f(p[PC_CQ + lane + 64 * u]);
#pragma unroll
        for (int u = 0; u < 3; ++u) { const int idx = lane + 64 * u; ckv[u] = idx < 160 ? bf2f(p[PC_CKV + idx]) : 0.f; }
#pragma unroll
        for (int h = 0; h < 4; ++h) { nq[h][0] = bf2f(p[PC_NQ + h * 128 + lane]); nq[h][1] = bf2f(p[PC_NQ + h * 128 + 64 + lane]); nk[h][0] = bf2f(p[PC_NK + h * 128 + lane]); nk[h][1] = bf2f(p[PC_NK + h * 128 + 64 + lane]); }
#pragma unroll
        for (int u = 0; u < 8; ++u) nv[u] = p[PC_NV + lane + 64 * u];
        const float gi = lane < 8 ? gr[lane] : 0.f, gf = lane < 8 ? gr[8 + lane] : 0.f, gd = lane < 16 ? gr[16 + lane] : 0.f;
        {
            float ss = 0.f;
#pragma unroll
            for (int u = 0; u < 7; ++u) ss += cq[u] * cq[u];
            const float rstd = 1.0f / sqrtf(wave_sum(ss) * (1.f / 448.f) + EPS);
            const float* qn = F.in[18] + l * 448; bf16* o = WSP(bf16, WS_CQN) + (size_t)row * 512;
#pragma unroll
            for (int u = 0; u < 7; ++u) o[lane + 64 * u] = (bf16)f2bf(cq[u] * rstd * qn[lane + 64 * u]);
            o[448 + lane] = 0;
        }
        {
            float ss = 0.f;
#pragma unroll
            for (int u = 0; u < 3; ++u) ss += ckv[u] * ckv[u];
            const float rstd = 1.0f / sqrtf(wave_sum(ss) * (1.f / 160.f) + EPS);
            const float* kn = F.in[20] + l * 160; bf16* o = WSP(bf16, WS_CKVN) + (size_t)row * 256;
#pragma unroll
            for (int u = 0; u < 3; ++u) { const int idx = lane + 64 * u; o[idx] = idx < 160 ? (bf16)f2bf(ckv[u] * rstd * kn[idx]) : (bf16)0; }
            o[192 + lane] = 0;
        }
        const float* gq = F.in[24] + l * 128; const float* gk = F.in[25] + l * 128;
#pragma unroll
        for (int h = 0; h < 4; ++h) {
            const float rq = 1.0f / sqrtf(wave_sum(nq[h][0] * nq[h][0] + nq[h][1] * nq[h][1]) * (1.f / 128.f) + EPS);
            const float rk = 1.0f / sqrtf(wave_sum(nk[h][0] * nk[h][0] + nk[h][1] * nk[h][1]) * (1.f / 128.f) + EPS);
            bf16* oq = WSP(bf16, WS_QNA) + ((size_t)(b * 4 + h) * TS + j) * 128; bf16* ok = WSP(bf16, WS_KNA) + ((size_t)(b * 4 + h) * TS + j) * 128;
            oq[lane] = (bf16)f2bf(nq[h][0] * rq * gq[lane]); oq[64 + lane] = (bf16)f2bf(nq[h][1] * rq * gq[64 + lane]);
            ok[lane] = (bf16)f2bf(nk[h][0] * rk * gk[lane]); ok[64 + lane] = (bf16)f2bf(nk[h][1] * rk * gk[64 + lane]);
        }
#pragma unroll
        for (int u = 0; u < 8; ++u) vs[i * 520 + lane + 64 * u] = nv[u];
        if (lane < 8) {
            float* gt = WSP(float, WS_GATES) + (size_t)row * 16;
            gt[lane] = gi + F.in[9][l * 8 + lane];
            gt[8 + lane] = logsigmoidf_(gf + F.in[10][l * 8 + lane]);
        }
        if (lane < 16) WSP(float, WS_DT)[(size_t)row * 16 + lane] = softplusf_(gd + F.in[14][l * 16 + lane]);
    }
    {
        const int ch = 2 * F.tid;
        const int seglo = j0 < TL ? 0 : TL, seghi = j0 < TL ? TL : TS;
        const float* cw = F.in[12] + (size_t)l * 5 * 1024 + ch; const float* cb = F.in[13] + (size_t)l * 1024 + ch;
        f32x2 w[5];
#pragma unroll
        for (int d = 0; d < 5; ++d) w[d] = *(const f32x2*)(cw + d * 1024);
        const f32x2 bias = *(const f32x2*)cb;
        f32x2 xin[36];
#pragma unroll
        for (int d = 0; d < 36; ++d) { const int jj = j0 - 2 + d; unsigned xw = 0u; if (jj >= seglo && jj < seghi) xw = *(const unsigned*)(P + (size_t)rowof(b, jj) * DINP + PC_XBC + ch); xin[d] = (f32x2){bf2f(xw & 0xffffu), bf2f(xw >> 16)}; }
#pragma unroll
        for (int i = 0; i < 32; ++i) {
            f32x2 a = bias;
#pragma unroll
            for (int d = 0; d < 5; ++d) a += w[d] * xin[i + d];
            *(unsigned*)(WSP(bf16, WS_XBC) + (size_t)rowof(b, j0 + i) * 1024 + ch) = pk2(siluf(a[0]), siluf(a[1]));
        }
    }
    __syncthreads();
    {
        const int t = F.tid; unsigned wv[16];
#pragma unroll
        for (int i = 0; i < 16; ++i) wv[i] = (unsigned)vs[(2 * i) * 520 + t] | ((unsigned)vs[(2 * i + 1) * 520 + t] << 16);
        u32x4* dst = (u32x4*)(WSP(bf16, WS_VTNA) + ((size_t)(b * 4 + (t >> 7)) * 128 + (t & 127)) * TS + j0);
#pragma unroll
        for (int k = 0; k < 4; ++k) dst[k] = (u32x4){wv[4 * k], wv[4 * k + 1], wv[4 * k + 2], wv[4 * k + 3]};
    }
    __syncthreads();
}

DI void ml_a_unit(Frame& F, int seq, int p) {
    const int b = seq >> 3, h = (seq >> 1) & 3, dir = seq & 1, tc = tc_of(dir, p), lane = F.lane;
    const bf16* P = WSP(bf16, WS_P);
    LAS bf16* VW = (LAS bf16*)F.lds;
    LAS bf16* KT = (LAS bf16*)(F.lds + 20736);
    LAS float* wgs = (LAS float*)(F.lds + 39168);
    if (F.wave == 0) {
        const int row = rowof(b, tc * 64 + lane);
        const float* gt = WSP(float, WS_GATES) + (size_t)row * 16;
        const float li = gt[dir * 4 + h], lf = gt[8 + dir * 4 + h];
        const float pre = wave_incl_scan(lf, lane), tot = __shfl(pre, 63);
        const float g = dir == 0 ? (tot - pre) + li : (pre - lf) + li;
        const float mloc = wave_max(g);
        wgs[lane] = __expf(g - mloc);
        if (lane == 0) { float* sc = WSP(float, WS_MLSC) + (size_t)(seq * 36 + p) * 4; sc[0] = tot; sc[1] = mloc; }
    }
    {
        float vv[16], kk[16];
#pragma unroll
        for (int it = 0; it < 16; ++it) { const int idx = F.tid + NTHR * it, n = idx >> 7, d = idx & 127;
            const bf16* pr = P + (size_t)rowof(b, tc * 64 + n) * DINP + h * 128 + d; vv[it] = bf2f(pr[PC_MLV]); kk[it] = bf2f(pr[PC_MLK]); }
        __syncthreads();
#pragma unroll
        for (int it = 0; it < 16; ++it) { const int idx = F.tid + NTHR * it, n = idx >> 7, d = idx & 127;
            VW[d * 72 + n] = (bf16)f2bf(vv[it] * wgs[n]); KT[d * 72 + n] = (bf16)f2bf(kk[it]); }
    }
    for (int idx = F.tid; idx < 16 * 64; idx += NTHR) { const int rr = idx >> 6, n = idx & 63; VW[(128 + rr) * 72 + n] = rr == 0 ? (bf16)f2bf(wgs[n]) : (bf16)0; }
    __syncthreads();
    float* U = WSP(float, WS_MLU) + (size_t)(seq * 36 + p) * (129 * 128);
    for (int id = F.wave; id < 72; id += 8) { const int dt = id >> 3, et = id & 7;
        const f32x4 acc = mma16<64>(VW + dt * 16 * 72, 72, KT + et * 16 * 72, 72, lane, (f32x4){0.f, 0.f, 0.f, 0.f});
#pragma unroll
        for (int i = 0; i < 4; ++i) { const int d = dt * 16 + 4 * (lane >> 4) + i; if (d < 129) U[d * 128 + et * 16 + (lane & 15)] = acc[i]; } }
    __syncthreads();
}

DI void ss_a_unit(Frame& F, int l, int b, int dir, int p, int g) {
    const int tc = tc_of(dir, p), lane = F.lane;
    LAS bf16* XT = (LAS bf16*)F.lds;
    LAS bf16* BT = (LAS bf16*)(F.lds + 36864);
    LAS float* tails = (LAS float*)(F.lds + 55296);
    const bf16* XBC = WSP(bf16, WS_XBC);
    if (F.wave < 4) {
        const int h = 4 * g + F.wave, row = rowof(b, tc * 64 + lane);
        const float dt = WSP(float, WS_DT)[(size_t)row * 16 + dir * 8 + h];
        const float A = -__expf(F.in[15][l * 16 + dir * 8 + h]);
        const float a = dt * A, pre = wave_incl_scan(a, lane), tot = __shfl(pre, 63);
        tails[F.wave * 64 + lane] = (dir == 0 ? __expf(tot - pre) : __expf(pre - a)) * dt;
        if (lane == 0) WSP(float, WS_SSSC)[(size_t)((b * 8 + h) * 2 + dir) * 36 + p] = __expf(tot);
    }
    {
        bf16 xv[32], bv[16];
#pragma unroll
        for (int it = 0; it < 32; ++it) { const int idx = F.tid + NTHR * it, n = idx >> 8, c = idx & 255; xv[it] = XBC[(size_t)rowof(b, tc * 64 + n) * 1024 + g * 256 + c]; }
#pragma unroll
        for (int it = 0; it < 16; ++it) { const int idx = F.tid + NTHR * it, n = idx >> 7, nn = idx & 127; bv[it] = XBC[(size_t)rowof(b, tc * 64 + n) * 1024 + 512 + g * 128 + nn]; }
        __syncthreads();
#pragma unroll
        for (int it = 0; it < 32; ++it) { const int idx = F.tid + NTHR * it, n = idx >> 8, c = idx & 255; XT[c * 72 + n] = (bf16)f2bf(bf2f(xv[it]) * tails[(c >> 6) * 64 + n]); }
#pragma unroll
        for (int it = 0; it < 16; ++it) { const int idx = F.tid + NTHR * it, n = idx >> 7, nn = idx & 127; BT[nn * 72 + n] = bv[it]; }
    }
    __syncthreads();
    for (int id = F.wave; id < 128; id += 8) { const int hh = id >> 5, rem = id & 31, pt = rem >> 3, nt = rem & 7;
        const f32x4 acc = mma16<64>(XT + (hh * 64 + pt * 16) * 72, 72, BT + nt * 16 * 72, 72, lane, (f32x4){0.f, 0.f, 0.f, 0.f});
        float* U = WSP(float, WS_SSU) + (size_t)(((b * 8 + 4 * g + hh) * 2 + dir) * 36 + p) * 8192;
#pragma unroll
        for (int i = 0; i < 4; ++i) U[(pt * 16 + 4 * (lane >> 4) + i) * 128 + nt * 16 + (lane & 15)] = acc[i]; }
    __syncthreads();
}
DI void ml_scan_unit(Frame& F, int seq, int s4) {
    float* sc = WSP(float, WS_MLSC) + (size_t)seq * 36 * 4;
    const float* U = WSP(float, WS_MLU) + (size_t)seq * 36 * 16512 + s4 * 4128 + F.tid; bf16* S = WSP(bf16, WS_MLS) + (size_t)seq * 36 * 16512 + s4 * 4128 + F.tid;
    float st[9]; float m = 0.f;
#pragma unroll
    for (int k = 0; k < 9; ++k) st[k] = 0.f;
    for (int pg = 0; pg < 36; pg += 12) {
        float u[12][9];
#pragma unroll
        for (int pp = 0; pp < 12; ++pp)
#pragma unroll
            for (int k = 0; k < 9; ++k) u[pp][k] = (F.tid + 512 * k < 4128) ? U[(size_t)(pg + pp) * 16512 + 512 * k] : 0.f;
#pragma unroll
        for (int pp = 0; pp < 12; ++pp) { const int p = pg + pp;
            const float bl = sc[p * 4], mloc = sc[p * 4 + 1];
            const float mn = fmaxf(bl + m, mloc), wc = __expf(bl + m - mn), wu = __expf(mloc - mn);
            if (s4 == 0 && F.tid == 0) sc[p * 4 + 2] = m;
#pragma unroll
            for (int k = 0; k < 9; ++k) { if (F.tid + 512 * k < 4128) S[(size_t)p * 16512 + 512 * k] = (bf16)f2bf(st[k]); st[k] = wc * st[k] + wu * u[pp][k]; }
            m = mn; }
    }
}
DI void ss_scan_unit(Frame& F, int sq, int half) {
    const float* dec = WSP(float, WS_SSSC) + (size_t)sq * 36;
    const float* U = WSP(float, WS_SSU) + (size_t)sq * 36 * 8192 + half * 4096 + F.tid; bf16* S = WSP(bf16, WS_SSS) + (size_t)sq * 36 * 8192 + half * 4096 + F.tid;
    float st[8];
#pragma unroll
    for (int k = 0; k < 8; ++k) st[k] = 0.f;
    for (int pg = 0; pg < 36; pg += 12) {
        float u[12][8];
#pragma unroll
        for (int pp = 0; pp < 12; ++pp)
#pragma unroll
            for (int k = 0; k < 8; ++k) u[pp][k] = U[(size_t)(pg + pp) * 8192 + 512 * k];
#pragma unroll
        for (int pp = 0; pp < 12; ++pp) { const int p = pg + pp; const float dc = dec[p];
#pragma unroll
            for (int k = 0; k < 8; ++k) { S[(size_t)p * 8192 + 512 * k] = (bf16)f2bf(st[k]); st[k] = st[k] * dc + u[pp][k]; } }
    }
}
DI void mla_post_unit(Frame& F, int l, int b, int tt) {
    const bf16* P = WSP(bf16, WS_P);
    const bf16* QRAW = WSP(bf16, WS_QRAW); const bf16* KVRAW = WSP(bf16, WS_KVRAW);
    const int j0 = tt * 32, lane = F.lane;
    LAS bf16* vs = (LAS bf16*)F.lds;
    const float* gq = F.in[22] + l * 192; const float* gk = F.in[23] + l * 192;
    float qv[4][4][3], kk[4][4][2], krv[4]; bf16 vv[4][4][2];
#pragma unroll
    for (int it = 0; it < 4; ++it) {
        const int row = rowof(b, j0 + F.wave + 8 * it);
        krv[it] = bf2f(P[(size_t)row * DINP + PC_KR + lane]);
#pragma unroll
        for (int h = 0; h < 4; ++h) { const bf16* q = QRAW + (size_t)row * 768 + h * 192; const bf16* kv = KVRAW + (size_t)row * 1024 + h * 256;
            qv[it][h][0] = bf2f(q[lane]); qv[it][h][1] = bf2f(q[64 + lane]); qv[it][h][2] = bf2f(q[128 + lane]);
            kk[it][h][0] = bf2f(kv[lane]); kk[it][h][1] = bf2f(kv[64 + lane]); vv[it][h][0] = kv[128 + lane]; vv[it][h][1] = kv[192 + lane]; }
    }
    const float gq0 = gq[lane], gq1 = gq[64 + lane], gq2 = gq[128 + lane], gk0 = gk[lane], gk1 = gk[64 + lane], gk2 = gk[128 + lane];
    const int a = lane & 31;
    const float fr = exp2f(-(float)(a & 15) * (13.287712379549449f / 16.f));
#pragma unroll
    for (int it = 0; it < 4; ++it) {
        const int i = F.wave + 8 * it, j = j0 + i; const bool lat = j < TL;
        const float pos = (float)(a < 16 ? (j >> 6) : (j & 63));
        const float ang = pos * fr; const float cs = __cosf(ang), sn = __sinf(ang);
#pragma unroll
        for (int h = 0; h < 4; ++h) {
            {
                const float v0 = qv[it][h][0], v1 = qv[it][h][1], v2 = qv[it][h][2];
                const float rstd = 1.0f / sqrtf(wave_sum(v0 * v0 + v1 * v1 + v2 * v2) * (1.f / 192.f) + EPS);
                const float n0 = v0 * rstd * gq0, n1 = v1 * rstd * gq1; float n2 = v2 * rstd * gq2;
                const float pr = __shfl_xor(n2, 32);
                if (lat) n2 = lane < 32 ? n2 * cs - pr * sn : pr * sn + n2 * cs;
                bf16* o = WSP(bf16, WS_QMLA) + ((size_t)(b * 4 + h) * TS + j) * 192;
                o[lane] = (bf16)f2bf(n0); o[64 + lane] = (bf16)f2bf(n1); o[128 + lane] = (bf16)f2bf(n2);
            }
            {
                const float v0 = kk[it][h][0], v1 = kk[it][h][1], v2 = krv[it];
                const float rstd = 1.0f / sqrtf(wave_sum(v0 * v0 + v1 * v1 + v2 * v2) * (1.f / 192.f) + EPS);
                const float n0 = v0 * rstd * gk0, n1 = v1 * rstd * gk1; float n2 = v2 * rstd * gk2;
                const float pr = __shfl_xor(n2, 32);
                if (lat) n2 = lane < 32 ? n2 * cs - pr * sn : pr * sn + n2 * cs;
                bf16* o = WSP(bf16, WS_KMLA) + ((size_t)(b * 4 + h) * TS + j) * 192;
                o[lane] = (bf16)f2bf(n0); o[64 + lane] = (bf16)f2bf(n1); o[128 + lane] = (bf16)f2bf(n2);
                vs[i * 520 + h * 128 + lane] = vv[it][h][0]; vs[i * 520 + h * 128 + 64 + lane] = vv[it][h][1];
            }
        }
    }
    __syncthreads();
    {
        const int t = F.tid; unsigned wv[16];
#pragma unroll
        for (int i = 0; i < 16; ++i) wv[i] = (unsigned)vs[(2 * i) * 520 + t] | ((unsigned)vs[(2 * i + 1) * 520 + t] << 16);
        u32x4* dst = (u32x4*)(WSP(bf16, WS_VTMLA) + ((size_t)(b * 4 + (t >> 7)) * 128 + (t & 127)) * TS + j0);
#pragma unroll
        for (int k = 0; k < 4; ++k) dst[k] = (u32x4){wv[4 * k], wv[4 * k + 1], wv[4 * k + 2], wv[4 * k + 3]};
    }
    __syncthreads();
}

template <int DK, bool NA>
DI void attn_unit(Frame& F, const bf16* Qg, const bf16* Kg, const bf16* VTg, int nA, int tA0, int nB, int tB0, float scale, bf16* Og, int qrow0, const float* rpb) {
    constexpr int KP = DK + 8, KCH = DK / 8, NKC = 64 * KCH / NTHR;
    LAS bf16* Ks = (LAS bf16*)F.lds;
    LAS bf16* VTs = (LAS bf16*)(F.lds + 64 * KP * 2);
    LAS bf16* Ps = (LAS bf16*)(F.lds + 64 * KP * 2 + 128 * 72 * 2) + F.wave * (16 * 72);
    LAS float* rp = (LAS float*)(F.lds + 64 * KP * 2 + 128 * 72 * 2 + 8 * 16 * 72 * 2);
    const int lane = F.lane, r = lane & 15, q = lane >> 4, tid = F.tid, w = F.wave;
    if (NA) { for (int i = tid; i < 15 * 31; i += NTHR) rp[i] = rpb[i]; }
    bf16x8 qf[DK / 32];
#pragma unroll
    for (int kk = 0; kk < DK / 32; ++kk) qf[kk] = *(const bf16x8*)(Qg + (size_t)(w * 16 + r) * DK + 32 * kk + 8 * q);
    f32x4 o[8]; float mrow[4], lrow[4];
#pragma unroll
    for (int d = 0; d < 8; ++d) o[d] = (f32x4){0.f, 0.f, 0.f, 0.f};
#pragma unroll
    for (int i = 0; i < 4; ++i) { mrow[i] = -1.0e30f; lrow[i] = 0.f; }
    const int ntile = nA + nB;
    u32x4 kreg[NKC], vreg[2];
    const int rq = qrow0 + (w >> 2);
    const int r0 = rq - 4 < 0 ? 0 : (rq - 4 > 24 ? 24 : rq - 4);
#define ATT_LOAD(kt) do { _Pragma("unroll") for (int c = 0; c < NKC; ++c) { const int id = tid + NTHR * c, rr = id / KCH, cc = id % KCH; kreg[c] = *(const u32x4*)(Kg + (size_t)((kt) * 64 + rr) * DK + cc * 8); } \
        _Pragma("unroll") for (int c = 0; c < 2; ++c) { const int id = tid + NTHR * c, dd = id >> 3, cc = id & 7; vreg[c] = *(const u32x4*)(VTg + (size_t)dd * TS + (kt) * 64 + cc * 8); } } while (0)
    ATT_LOAD(nA > 0 ? tA0 : tB0);
    for (int it = 0; it < ntile; ++it) {
        const int kt = it < nA ? tA0 + it : tB0 + (it - nA);
        __syncthreads();
#pragma unroll
        for (int c = 0; c < NKC; ++c) { const int id = tid + NTHR * c, rr = id / KCH, cc = id % KCH; *(LAS u32x4*)(Ks + rr * KP + cc * 8) = kreg[c]; }
#pragma unroll
        for (int c = 0; c < 2; ++c) { const int id = tid + NTHR * c, dd = id >> 3, cc = id & 7; *(LAS u32x4*)(VTs + dd * 72 + cc * 8) = vreg[c]; }
        __syncthreads();
        if (it + 1 < ntile) { const int kn = (it + 1) < nA ? tA0 + it + 1 : tB0 + (it + 1 - nA); ATT_LOAD(kn); }
        const bool nbt = NA && kt < 32;
        if (nbt && (kt < r0 || kt >= r0 + 8)) continue;
        f32x4 s[4];
#pragma unroll
        for (int n = 0; n < 4; ++n) s[n] = (f32x4){0.f, 0.f, 0.f, 0.f};
#pragma unroll
        for (int kk = 0; kk < DK / 32; ++kk)
#pragma unroll
            for (int n = 0; n < 4; ++n) { const bf16x8 kf = *(const LAS bf16x8*)(Ks + (n * 16 + r) * KP + 32 * kk + 8 * q); s[n] = __builtin_amdgcn_mfma_f32_16x16x32_bf16(qf[kk], kf, s[n], 0, 0, 0); }
        float mx[4];
#pragma unroll
        for (int i = 0; i < 4; ++i) mx[i] = -1.0e30f;
#pragma unroll
        for (int n = 0; n < 4; ++n)
#pragma unroll
            for (int i = 0; i < 4; ++i) {
                float v = s[n][i] * scale;
                if (nbt) { const int c = (w & 3) * 16 + 4 * q + i, kc = n * 16 + r; const int c0 = c - 8 < 0 ? 0 : (c - 8 > 48 ? 48 : c - 8);
                    v = (kc >= c0 && kc < c0 + 16) ? v + rp[(kt - rq + 7) * 31 + (kc - c + 15)] : -1.0e30f; }
                s[n][i] = v; mx[i] = fmaxf(mx[i], v);
            }
        float alpha[4], rs[4];
#pragma unroll
        for (int i = 0; i < 4; ++i) {
            float m = mx[i]; m = fmaxf(m, __shfl_xor(m, 1)); m = fmaxf(m, __shfl_xor(m, 2)); m = fmaxf(m, __shfl_xor(m, 4)); m = fmaxf(m, __shfl_xor(m, 8));
            const float mn = fmaxf(mrow[i], m); alpha[i] = __expf(mrow[i] - mn); mrow[i] = mn; rs[i] = 0.f;
        }
#pragma unroll
        for (int n = 0; n < 4; ++n)
#pragma unroll
            for (int i = 0; i < 4; ++i) { const float pv = __expf(s[n][i] - mrow[i]); rs[i] += pv; Ps[(4 * q + i) * 72 + n * 16 + r] = (bf16)f2bf(pv); }
#pragma unroll
        for (int i = 0; i < 4; ++i) {
            float t = rs[i]; t += __shfl_xor(t, 1); t += __shfl_xor(t, 2); t += __shfl_xor(t, 4); t += __shfl_xor(t, 8);
            lrow[i] = lrow[i] * alpha[i] + t;
        }
#pragma unroll
        for (int d = 0; d < 8; ++d)
#pragma unroll
            for (int i = 0; i < 4; ++i) o[d][i] *= alpha[i];
        asm volatile("s_waitcnt lgkmcnt(0)" ::: "memory");
#pragma unroll
        for (int kk = 0; kk < 2; ++kk) { const bf16x8 pf = *(const LAS bf16x8*)(Ps + r * 72 + 32 * kk + 8 * q);
#pragma unroll
            for (int d = 0; d < 8; ++d) { const bf16x8 vf = *(const LAS bf16x8*)(VTs + (d * 16 + r) * 72 + 32 * kk + 8 * q); o[d] = __builtin_amdgcn_mfma_f32_16x16x32_bf16(pf, vf, o[d], 0, 0, 0); } }
    }
#undef ATT_LOAD
#pragma unroll
    for (int i = 0; i < 4; ++i) { const float inv = 1.0f / lrow[i]; bf16* op = Og + (size_t)(w * 16 + 4 * q + i) * D + r;
#pragma unroll
        for (int d = 0; d < 8; ++d) op[d * 16] = (bf16)f2bf(o[d][i] * inv); }
    __syncthreads();
}
typedef float f32x16 __attribute__((ext_vector_type(16)));
typedef short s16x4 __attribute__((ext_vector_type(4)));
template <int DK, bool NA>
DI void attn_unit2(Frame& F, const bf16* Qg, const bf16* Kg, const bf16* VTg, int nA, int tA0, int nB, int tB0, float sc2, bf16* Og, int qrow0, const float* rpb) {
    constexpr int KP = DK + 8, KCH = DK / 8, NKC = 64 * KCH / NTHR, NKK = DK / 16;
    constexpr int KTB = 64 * KP * 2, VTB = 128 * 72 * 2, BUFB = KTB + VTB;
    const int lane = F.lane, l32 = lane & 31, h = lane >> 5, tid = F.tid, w = F.wave, g = w & 3, kp = w >> 2;
    LAS float* rp = (LAS float*)(F.lds + 2 * BUFB);
    if (NA) { for (int i = tid; i < 15 * 31; i += NTHR) rp[i] = rpb[i] * 1.4426950408889634f; }
    bf16x8 qf[NKK];
#pragma unroll
    for (int kk = 0; kk < NKK; ++kk) qf[kk] = *(const bf16x8*)(Qg + (size_t)(32 * g + l32) * DK + 16 * kk + 8 * h);
    f32x16 o[4]; float mrun = -1.0e30f, lrun = 0.f;
#pragma unroll
    for (int d = 0; d < 4; ++d)
#pragma unroll
        for (int i = 0; i < 16; ++i) o[d][i] = 0.f;
    const int ntile = nA + nB;
    const int rq = qrow0 + (g >> 1), r0 = rq - 4 < 0 ? 0 : (rq - 4 > 24 ? 24 : rq - 4);
    const int cq = 32 * (g & 1) + l32, c0 = cq - 8 < 0 ? 0 : (cq - 8 > 48 ? 48 : cq - 8);
    u32x4 kreg[NKC], vreg[2];
#define ATT2_TILE(it) ((it) < nA ? tA0 + (it) : tB0 + ((it) - nA))
#define ATT2_LOAD(it) do { const int kt_ = ATT2_TILE(it); \
        _Pragma("unroll") for (int c = 0; c < NKC; ++c) { const int id = tid + NTHR * c, rr = id / KCH, cc = id % KCH; kreg[c] = *(const u32x4*)(Kg + (size_t)(kt_ * 64 + rr) * DK + cc * 8); } \
        _Pragma("unroll") for (int c = 0; c < 2; ++c) { const int id = tid + NTHR * c, dd = id >> 3, cc = id & 7; vreg[c] = *(const u32x4*)(VTg + (size_t)dd * TS + kt_ * 64 + cc * 8); } } while (0)
#define ATT2_STORE(b) do { \
        _Pragma("unroll") for (int c = 0; c < NKC; ++c) { const int id = tid + NTHR * c, rr = id / KCH, cc = id % KCH; *(LAS u32x4*)(F.lds + (b) * BUFB + (rr * KP + cc * 8) * 2) = kreg[c]; } \
        _Pragma("unroll") for (int c = 0; c < 2; ++c) { const int id = tid + NTHR * c, dd = id >> 3, cc = id & 7; *(LAS u32x4*)(F.lds + (b) * BUFB + KTB + (dd * 72 + cc * 8) * 2) = vreg[c]; } } while (0)
    ATT2_LOAD(0); ATT2_STORE(0);
    __syncthreads();
    for (int st = 0; st < ntile; ++st) {
        if (st + 1 < ntile) ATT2_LOAD(st + 1);
        const int kt = ATT2_TILE(st);
        const bool nbt = NA && kt < 32;
        if (!(nbt && (kt < r0 || kt >= r0 + 8))) {
            const LAS bf16* Ks = (const LAS bf16*)(F.lds + (st & 1) * BUFB) + (kp * 32 + l32) * KP + 8 * h;
            const LAS bf16* VTs = (const LAS bf16*)(F.lds + (st & 1) * BUFB + KTB) + l32 * 72 + kp * 32 + 4 * h;
            f32x16 s;
#pragma unroll
            for (int i = 0; i < 16; ++i) s[i] = 0.f;
#pragma unroll
            for (int kk = 0; kk < NKK; ++kk) { const bf16x8 kf = *(const LAS bf16x8*)(Ks + 16 * kk); s = __builtin_amdgcn_mfma_f32_32x32x16_bf16(kf, qf[kk], s, 0, 0, 0); }
            float mx = -1.0e30f;
#pragma unroll
            for (int i = 0; i < 16; ++i) {
                float v = s[i] * sc2;
                if (nbt) { const int kc = kp * 32 + 8 * (i >> 2) + 4 * h + (i & 3); v = (kc >= c0 && kc < c0 + 16) ? v + rp[(kt - rq + 7) * 31 + (kc - cq + 15)] : -1.0e30f; }
                s[i] = v; mx = fmaxf(mx, v);
            }
            mx = fmaxf(mx, __shfl_xor(mx, 32));
            const float mn = fmaxf(mrun, mx), alpha = __builtin_amdgcn_exp2f(mrun - mn); mrun = mn;
            float rs = 0.f;
#pragma unroll
            for (int i = 0; i < 16; ++i) { const float pv = __builtin_amdgcn_exp2f(s[i] - mn); s[i] = pv; rs += pv; }
            rs += __shfl_xor(rs, 32);
            lrun = lrun * alpha + rs;
            if (__any(alpha != 1.0f)) {
#pragma unroll
                for (int d = 0; d < 4; ++d)
#pragma unroll
                    for (int i = 0; i < 16; ++i) o[d][i] *= alpha;
            }
#pragma unroll
            for (int sp = 0; sp < 2; ++sp) {
                u32x4 pw; pw.x = pg8::cvt_pk_bf16(s[8 * sp + 0], s[8 * sp + 1]); pw.y = pg8::cvt_pk_bf16(s[8 * sp + 2], s[8 * sp + 3]);
                pw.z = pg8::cvt_pk_bf16(s[8 * sp + 4], s[8 * sp + 5]); pw.w = pg8::cvt_pk_bf16(s[8 * sp + 6], s[8 * sp + 7]);
                const bf16x8 pf = __builtin_bit_cast(bf16x8, pw);
#pragma unroll
                for (int d = 0; d < 4; ++d) { const LAS bf16* vp = VTs + d * 32 * 72 + 16 * sp;
                    const u32x2 lo = *(const LAS u32x2*)vp, hi = *(const LAS u32x2*)(vp + 8);
                    const u32x4 vv = (u32x4){lo.x, lo.y, hi.x, hi.y};
                    o[d] = __builtin_amdgcn_mfma_f32_32x32x16_bf16(__builtin_bit_cast(bf16x8, vv), pf, o[d], 0, 0, 0); }
            }
        }
        if (st + 1 < ntile) ATT2_STORE((st + 1) & 1);
        __syncthreads();
    }
#undef ATT2_LOAD
#undef ATT2_STORE
#undef ATT2_TILE
    LAS float* ob = (LAS float*)F.lds + g * (66 * 64);
    if (kp == 1) {
#pragma unroll
        for (int d = 0; d < 4; ++d)
#pragma unroll
            for (int i = 0; i < 16; ++i) ob[(d * 16 + i) * 64 + lane] = o[d][i];
        ob[64 * 64 + lane] = mrun; ob[65 * 64 + lane] = lrun;
    }
    __syncthreads();
    if (kp == 0) {
        const float m1 = ob[64 * 64 + lane], l1 = ob[65 * 64 + lane];
        const float mf = fmaxf(mrun, m1), a0 = __builtin_amdgcn_exp2f(mrun - mf), a1 = __builtin_amdgcn_exp2f(m1 - mf);
        const float inv = 1.0f / (lrun * a0 + l1 * a1);
        bf16* op = Og + (size_t)(32 * g + l32) * D + 4 * h;
#pragma unroll
        for (int d = 0; d < 4; ++d)
#pragma unroll
            for (int i4 = 0; i4 < 4; ++i4) {
                float r[4];
#pragma unroll
                for (int j = 0; j < 4; ++j) r[j] = (o[d][4 * i4 + j] * a0 + ob[(d * 16 + 4 * i4 + j) * 64 + lane] * a1) * inv;
                u32x2 wv; wv.x = pk2(r[0], r[1]); wv.y = pk2(r[2], r[3]);
                *(u32x2*)(op + d * 32 + 8 * i4) = wv;
            }
    }
    __syncthreads();
}
DI void ml_c_unit(Frame& F, int seq, int p) {
    const int b = seq >> 3, h = (seq >> 1) & 3, dir = seq & 1, tc = tc_of(dir, p), lane = F.lane, tid = F.tid;
    const bf16* P = WSP(bf16, WS_P);
    constexpr float QS = 0.08838834764831845f;
    LAS bf16* Qs = (LAS bf16*)F.lds;
    LAS bf16* Ksm = (LAS bf16*)(F.lds + 17408);
    LAS bf16* VT = (LAS bf16*)(F.lds + 34816);
    LAS bf16* Cx = (LAS bf16*)(F.lds + 55552);
    LAS bf16* SW = (LAS bf16*)(F.lds + 94720);
    LAS float* av = (LAS float*)(F.lds + 103936);
    LAS float* Mt = av + 64;
    LAS float* Bt = av + 128;
    LAS float* den = av + 192;
    const float m_p = WSP(float, WS_MLSC)[(size_t)(seq * 36 + p) * 4 + 2];
    if (F.wave == 0) {
        const int row = rowof(b, tc * 64 + lane);
        const float* gt = WSP(float, WS_GATES) + (size_t)row * 16;
        const float li = gt[dir * 4 + h], lf = gt[8 + dir * 4 + h];
        const float pre = wave_incl_scan(lf, lane), tot = __shfl(pre, 63);
        const float B = dir == 0 ? pre : (tot - pre) + lf;
        const float a = li - B;
        float cm = a;
#pragma unroll
        for (int o = 1; o < 64; o <<= 1) { const float t = dir == 0 ? __shfl_up(cm, o) : __shfl_down(cm, o); const bool ok = dir == 0 ? (lane >= o) : (lane + o < 64); if (ok) cm = fmaxf(cm, t); }
        av[lane] = a; Mt[lane] = fmaxf(m_p, cm); Bt[lane] = B;
    }
    {
        u32x4 qv[2], kv[2]; bf16 vv[16]; u32x4 cx[5];
        const bf16* Sg = WSP(bf16, WS_MLS) + (size_t)(seq * 36 + p) * 16512;
#pragma unroll
        for (int it = 0; it < 2; ++it) { const int idx = tid + NTHR * it, n = idx >> 4, cc = idx & 15;
            const bf16* pr = P + (size_t)rowof(b, tc * 64 + n) * DINP + h * 128 + cc * 8; qv[it] = *(const u32x4*)(pr + PC_MLQ); kv[it] = *(const u32x4*)(pr + PC_MLK); }
#pragma unroll
        for (int it = 0; it < 16; ++it) { const int idx = tid + NTHR * it, n = idx >> 7, d = idx & 127; vv[it] = P[(size_t)rowof(b, tc * 64 + n) * DINP + PC_MLV + h * 128 + d]; }
#pragma unroll
        for (int it = 0; it < 5; ++it) { const int idx = tid + NTHR * it, rr = idx >> 4, cc = idx & 15; cx[it] = (idx < 144 * 16 && rr < 129) ? *(const u32x4*)(Sg + rr * 128 + cc * 8) : (u32x4){0u, 0u, 0u, 0u}; }
#pragma unroll
        for (int it = 0; it < 2; ++it) { const int idx = tid + NTHR * it, n = idx >> 4, cc = idx & 15; *(LAS u32x4*)(Qs + n * 136 + cc * 8) = qv[it]; *(LAS u32x4*)(Ksm + n * 136 + cc * 8) = kv[it]; }
#pragma unroll
        for (int it = 0; it < 16; ++it) { const int idx = tid + NTHR * it, n = idx >> 7, d = idx & 127; VT[d * 72 + n] = vv[it]; }
#pragma unroll
        for (int it = 0; it < 5; ++it) { const int idx = tid + NTHR * it, rr = idx >> 4, cc = idx & 15; if (idx < 144 * 16) *(LAS u32x4*)(Cx + rr * 136 + cc * 8) = cx[it]; }
    }
    for (int idx = tid; idx < 16 * 64; idx += NTHR) { const int rr = idx >> 6, n = idx & 63; VT[(128 + rr) * 72 + n] = rr == 0 ? (bf16)0x3f80 : (bf16)0; }
    __syncthreads();
    for (int id = F.wave; id < 16; id += 8) { const int tt = id >> 2, st = id & 3;
        const bool skip = dir == 0 ? st > tt : st < tt;
        f32x4 acc = (f32x4){0.f, 0.f, 0.f, 0.f};
        if (!skip) acc = mma16<128>(Qs + tt * 16 * 136, 136, Ksm + st * 16 * 136, 136, lane, acc);
        const int s = st * 16 + (lane & 15); const float as = av[s];
#pragma unroll
        for (int i = 0; i < 4; ++i) { const int t = tt * 16 + 4 * (lane >> 4) + i; const bool ok = !skip && (dir == 0 ? s <= t : s >= t);
            SW[t * 72 + s] = (bf16)f2bf(ok ? acc[i] * QS * __expf(as - Mt[t]) : 0.f); } }
    __syncthreads();
    const int tt = F.wave & 3, d0 = F.wave < 4 ? 0 : 5, nd = F.wave < 4 ? 5 : 4;
    f32x4 val[5];
#pragma unroll
    for (int k = 0; k < 5; ++k) { val[k] = (f32x4){0.f, 0.f, 0.f, 0.f};
        if (k < nd) { const int dt = d0 + k;
            const f32x4 a1 = mma16<64>(SW + tt * 16 * 72, 72, VT + dt * 16 * 72, 72, lane, (f32x4){0.f, 0.f, 0.f, 0.f});
            const f32x4 a2 = mma16<128>(Qs + tt * 16 * 136, 136, Cx + dt * 16 * 136, 136, lane, (f32x4){0.f, 0.f, 0.f, 0.f});
#pragma unroll
            for (int i = 0; i < 4; ++i) { const int t = tt * 16 + 4 * (lane >> 4) + i; val[k][i] = a1[i] + a2[i] * QS * __expf(m_p - Mt[t]); }
            if (dt == 8 && (lane & 15) == 0) {
#pragma unroll
                for (int i = 0; i < 4; ++i) den[tt * 16 + 4 * (lane >> 4) + i] = val[k][i]; } } }
    __syncthreads();
    float* H = WSP(float, WS_HML) + (size_t)dir * MTOK * 512;
#pragma unroll
    for (int k = 0; k < 5; ++k) { const int dt = d0 + k; if (k < nd && dt < 8) {
#pragma unroll
        for (int i = 0; i < 4; ++i) { const int t = tt * 16 + 4 * (lane >> 4) + i;
            const float dn = fmaxf(fabsf(den[t]), __expf(-(Bt[t] + Mt[t])));
            H[(size_t)rowof(b, tc * 64 + t) * 512 + h * 128 + dt * 16 + (lane & 15)] = val[k][i] / dn; } } }
    __syncthreads();
}

DI void ss_c_unit(Frame& F, int l, int sq, int p) {
    const int b = sq >> 4, h = (sq >> 1) & 7, dir = sq & 1, g = h >> 2, tc = tc_of(dir, p), lane = F.lane, tid = F.tid;
    const bf16* XBC = WSP(bf16, WS_XBC);
    LAS bf16* Cm = (LAS bf16*)F.lds;
    LAS bf16* Bm = (LAS bf16*)(F.lds + 17408);
    LAS bf16* XT = (LAS bf16*)(F.lds + 34816);
    LAS bf16* Sx = (LAS bf16*)(F.lds + 44032);
    LAS bf16* W = (LAS bf16*)(F.lds + 61440);
    LAS float* cum = (LAS float*)(F.lds + 70656);
    LAS float* dtv = cum + 64;
    if (F.wave == 0) {
        const int row = rowof(b, tc * 64 + lane);
        const float dt = WSP(float, WS_DT)[(size_t)row * 16 + dir * 8 + h];
        const float A = -__expf(F.in[15][l * 16 + dir * 8 + h]);
        const float a = dt * A, pre = wave_incl_scan(a, lane), tot = __shfl(pre, 63);
        cum[lane] = dir == 0 ? pre : (tot - pre) + a; dtv[lane] = dt;
    }
    {
        u32x4 bb[2], cc_[2], sx[2]; bf16 xx[8];
        const bf16* Sg = WSP(bf16, WS_SSS) + (size_t)(sq * 36 + p) * 8192;
#pragma unroll
        for (int it = 0; it < 2; ++it) { const int idx = tid + NTHR * it, n = idx >> 4, cc = idx & 15; const bf16* xr = XBC + (size_t)rowof(b, tc * 64 + n) * 1024;
            bb[it] = *(const u32x4*)(xr + 512 + g * 128 + cc * 8); cc_[it] = *(const u32x4*)(xr + 768 + g * 128 + cc * 8); sx[it] = *(const u32x4*)(Sg + n * 128 + cc * 8); }
#pragma unroll
        for (int it = 0; it < 8; ++it) { const int idx = tid + NTHR * it, n = idx >> 6, pp = idx & 63; xx[it] = XBC[(size_t)rowof(b, tc * 64 + n) * 1024 + h * 64 + pp]; }
#pragma unroll
        for (int it = 0; it < 2; ++it) { const int idx = tid + NTHR * it, n = idx >> 4, cc = idx & 15;
            *(LAS u32x4*)(Bm + n * 136 + cc * 8) = bb[it]; *(LAS u32x4*)(Cm + n * 136 + cc * 8) = cc_[it]; *(LAS u32x4*)(Sx + n * 136 + cc * 8) = sx[it]; }
#pragma unroll
        for (int it = 0; it < 8; ++it) { const int idx = tid + NTHR * it, n = idx >> 6, pp = idx & 63; XT[pp * 72 + n] = xx[it]; }
    }
    __syncthreads();
    for (int id = F.wave; id < 16; id += 8) { const int tt = id >> 2, st = id & 3;
        const bool skip = dir == 0 ? st > tt : st < tt;
        f32x4 acc = (f32x4){0.f, 0.f, 0.f, 0.f};
        if (!skip) acc = mma16<128>(Cm + tt * 16 * 136, 136, Bm + st * 16 * 136, 136, lane, acc);
        const int s = st * 16 + (lane & 15); const float cs = cum[s], ds = dtv[s];
#pragma unroll
        for (int i = 0; i < 4; ++i) { const int t = tt * 16 + 4 * (lane >> 4) + i; const bool ok = !skip && (dir == 0 ? s <= t : s >= t);
            W[t * 72 + s] = (bf16)f2bf(ok ? acc[i] * __expf(cum[t] - cs) * ds : 0.f); } }
    __syncthreads();
    float* Y = WSP(float, WS_YSS) + (size_t)dir * MTOK * 512;
    for (int id = F.wave; id < 16; id += 8) { const int tt = id >> 2, pt = id & 3;
        const f32x4 a1 = mma16<64>(W + tt * 16 * 72, 72, XT + pt * 16 * 72, 72, lane, (f32x4){0.f, 0.f, 0.f, 0.f});
        const f32x4 a2 = mma16<128>(Cm + tt * 16 * 136, 136, Sx + pt * 16 * 136, 136, lane, (f32x4){0.f, 0.f, 0.f, 0.f});
#pragma unroll
        for (int i = 0; i < 4; ++i) { const int t = tt * 16 + 4 * (lane >> 4) + i;
            Y[(size_t)rowof(b, tc * 64 + t) * 512 + h * 64 + pt * 16 + (lane & 15)] = a1[i] + a2[i] * __expf(cum[t]); } }
    __syncthreads();
}

DI void m5_finish_phase(Frame& F, int l, int nrows) {
    const int gw = F.bid * NWAVES + F.wave, NGW = F.G * NWAVES, lane = F.lane;
    const bf16* P = WSP(bf16, WS_P); const float* H0 = WSP(float, WS_HML); const float* H1 = H0 + (size_t)MTOK * 512;
    const float* Y0 = WSP(float, WS_YSS); const float* Y1 = Y0 + (size_t)MTOK * 512; const bf16* XBC = WSP(bf16, WS_XBC);
    bf16* A2 = WSP(bf16, WS_A2);
    float gn[8], sn[8], dsk[8];
#pragma unroll
    for (int u = 0; u < 8; ++u) { gn[u] = F.in[11][l * 512 + lane + 64 * u]; sn[u] = F.in[17][l * 512 + lane + 64 * u]; dsk[u] = F.in[16][l * 8 + u]; }
    for (int row = gw; row < nrows; row += NGW) {
        const bf16* p = P + (size_t)row * DINP;
        float h0[8], h1[8], y0[8], y1[8], hv[8], ov[8], yv[8], zv[8]; unsigned ow[8], zw[8], xw[8];
#pragma unroll
        for (int u = 0; u < 8; ++u) { const int c = lane + 64 * u;
            h0[u] = H0[(size_t)row * 512 + c]; h1[u] = H1[(size_t)row * 512 + c]; y0[u] = Y0[(size_t)row * 512 + c]; y1[u] = Y1[(size_t)row * 512 + c];
            ow[u] = p[PC_MLO + c]; zw[u] = p[PC_Z + c]; xw[u] = XBC[(size_t)row * 1024 + c]; }
        PIN8(h0); PIN8(h1); PIN8(y0); PIN8(y1); PIN8(ow); PIN8(zw); PIN8(xw);
        bf16 xv[8];
#pragma unroll
        for (int u = 0; u < 8; ++u) { hv[u] = h0[u] + h1[u]; yv[u] = y0[u] + y1[u]; ov[u] = bf2f(ow[u]); zv[u] = bf2f(zw[u]); xv[u] = (bf16)xw[u]; }
#pragma unroll
        for (int h = 0; h < 4; ++h) {
            const float v0 = hv[2 * h], v1 = hv[2 * h + 1]; const int c0 = h * 128 + lane, c1 = c0 + 64;
            const float rstd = 1.0f / sqrtf(wave_sum(v0 * v0 + v1 * v1) * (1.f / 128.f) + EPS);
            A2[(size_t)row * D + c0] = (bf16)f2bf(v0 * rstd * gn[2 * h] * sigmoidf_(ov[2 * h]));
            A2[(size_t)row * D + c1] = (bf16)f2bf(v1 * rstd * gn[2 * h + 1] * sigmoidf_(ov[2 * h + 1]));
        }
        float y[8]; float ss = 0.f;
#pragma unroll
        for (int u = 0; u < 8; ++u) { float v = yv[u] + dsk[u] * bf2f(xv[u]); v *= siluf(zv[u]); y[u] = v; ss += v * v; }
        const float rstd = 1.0f / sqrtf(wave_sum(ss) * (1.f / 512.f) + EPS);
#pragma unroll
        for (int u = 0; u < 8; ++u) { const int c = lane + 64 * u; A2[(size_t)row * D + 512 + c] = (bf16)f2bf(y[u] * rstd * sn[u]); }
    }
}
#ifndef PROBE_MASK
#define PROBE_MASK 0ull
#endif
#define NREP(k) ((((unsigned long long)(PROBE_MASK) >> (k)) & 1ull) ? 2 : 1)
#ifndef UNIT_REP
#define UNIT_REP 0
#endif
#define UREP(i) for (int rp_ = 0; rp_ <= ((F.rep >> (i)) & 1); ++rp_)
#ifndef ONE_LAUNCH
#define ONE_LAUNCH 1
#endif
#ifndef TPROBE_MASK
#define TPROBE_MASK 0ull
#endif
#ifndef TPROBE_AMP
#define TPROBE_AMP 8
#endif
#define TPB(k) do { if (((unsigned long long)(TPROBE_MASK) >> (k)) & 1ull) { if (F.bid == 0 && F.tid == 0) { volatile LAS unsigned long long* tp_ = (volatile LAS unsigned long long*)(F.lds + MISC_OFF + 128); tp_[0] = wall_clock64(); } } } while (0)
#define TPE(k) do { if (((unsigned long long)(TPROBE_MASK) >> (k)) & 1ull) { if (F.bid == 0 && F.tid == 0) { volatile LAS unsigned long long* tp_ = (volatile LAS unsigned long long*)(F.lds + MISC_OFF + 128); tp_[1] += wall_clock64() - tp_[0]; } } } while (0)
#define IN(k) (lo <= (k) && (k) < hi)
#define SEAM(k) do { if (ONE_LAUNCH && hi > (k) + 1) xcd_barrier(bar); } while (0)
#ifndef FILL_MASK
#define FILL_MASK 0x7fffffffull
#endif
#define FILL(k, work) do { if (ONE_LAUNCH) conv_fill(F, (k), (work)); } while (0)
#ifndef NCV_P
#define NCV_P 48
#define NCV_OUT 112
#define NCV_UP 24
#define NCV_DOWN 112
#endif
template <int l> DI void layer_phases(Frame& F, const XcdBarrier& bar, const int lo, const int hi) {
    LAS int* mtb = (LAS int*)(F.lds + RING_BYTES);
        const int pb = 1 + 16 * l;
        const bool wc = (l == 0);
        const int nrows = wc ? MTOK : MLAT;
        const float* modl = WSP(float, WS_MOD) + (size_t)l * 5 * D6;
        if (IN(pb + 0)) { TPB(pb + 0);
            if (l == 0) norm_phase<false>(F, l, F.in[0], F.in[2], F.in[6] + l * D, 0, MTOK);
            else norm_phase<false>(F, l, WSP(float, WS_X), WSP(float, WS_X) + (size_t)MLAT * D, F.in[6] + l * D, 0, MTOK);
            if (l == 1) conv_drain(F, CV_NQ1 - CV_EAGER); SEAM(pb + 0); TPE(pb + 0);
        }
        if (IN(pb + 1)) { TPB(pb + 1);
            const int ncv = ONE_LAUNCH ? NCV_P : 0, gw_ = F.G - ncv;
            if (F.bid < gw_) { pg8::Gemm g{WSP(bf16, WS_HN), WSP(bf16, WS_WIN) + (size_t)l * DINP * D, D, D}; pg8::StaticOrder S; S.init(MTOK / 256, DINP / 256, gw_, F.bid);
                EpiP E{WSP(bf16, WS_P), WSP(float, WS_GRAW)};
                pg8::gemm_phase<EpiP, pg8::StaticOrder>(F.lds, g, S, E); }
            FILL(pb + 1, F.bid >= gw_);
            SEAM(pb + 1); TPE(pb + 1);
        }
        if (IN(pb + 2)) { TPB(pb + 2);
            for (int u = F.bid; u < NB * 72; u += F.G) m1_prep_unit(F, l, u / 72, u % 72);
            SEAM(pb + 2); TPE(pb + 2);
        }
        if (IN(pb + 3)) { TPB(pb + 3);
            { pg8::Gemm g{WSP(bf16, WS_CQN), WSP(bf16, WS_WQB) + (size_t)l * 768 * 512, 512, 512}; pg8::StaticOrder S; S.init(MTOK / 256, 3, F.G, F.bid);
              EpiBf16 E{WSP(bf16, WS_QRAW), 768}; pg8::gemm_phase<EpiBf16, pg8::StaticOrder>(F.lds, g, S, E); }
            __syncthreads();
            { pg8::Gemm g{WSP(bf16, WS_CKVN), WSP(bf16, WS_WKVB) + (size_t)l * 1024 * 256, 256, 256}; pg8::StaticOrder S; S.init(MTOK / 256, 4, F.G, (F.bid + 128) % F.G);
              EpiBf16 E{WSP(bf16, WS_KVRAW), 1024}; pg8::gemm_phase<EpiBf16, pg8::StaticOrder>(F.lds, g, S, E); }
            __syncthreads();
            UREP(2) for (int u = F.bid; u < 1152; u += F.G) ml_a_unit(F, u / 36, u % 36);
            UREP(3) for (int v = (F.bid + 128) % F.G; v < 576; v += F.G) ss_a_unit(F, l, v / 144, (v / 72) & 1, (v % 72) >> 1, v & 1);
            SEAM(pb + 3); TPE(pb + 3);
        }
        if (IN(pb + 4)) { TPB(pb + 4);
            UREP(4) for (int u = F.bid; u < 256; u += F.G) {
                const int bh = u >> 4, qb = u & 15, b = bh >> 2, h = bh & 3;
                const int r0a = 2 * qb - 4 < 0 ? 0 : (2 * qb - 4 > 24 ? 24 : 2 * qb - 4), r0b = 2 * qb - 3 < 0 ? 0 : (2 * qb - 3 > 24 ? 24 : 2 * qb - 3);
                attn_unit2<128, true>(F, WSP(bf16, WS_QNA) + ((size_t)bh * TS + qb * 128) * 128, WSP(bf16, WS_KNA) + (size_t)bh * TS * 128, WSP(bf16, WS_VTNA) + (size_t)bh * 128 * TS,
                                     4, 32, r0b + 8 - r0a, r0a, 0.12751743082459868f,
                                     WSP(bf16, WS_A2) + (size_t)(b * TL + qb * 128) * D + 1536 + h * 128, 2 * qb, F.in[26] + (size_t)(l * 4 + h) * 15 * 31);
            }
            if (wc) UREP(5) for (int v = F.bid; v < 32; v += F.G) {
                const int bh2 = v >> 1, qc = v & 1, b2 = bh2 >> 2, h2 = bh2 & 3;
                attn_unit2<128, false>(F, WSP(bf16, WS_QNA) + ((size_t)bh2 * TS + TL + qc * 128) * 128, WSP(bf16, WS_KNA) + (size_t)bh2 * TS * 128, WSP(bf16, WS_VTNA) + (size_t)bh2 * 128 * TS,
                                      4, 32, 0, 0, 0.12751743082459868f, WSP(bf16, WS_A2) + (size_t)(MLAT + b2 * TC + qc * 128) * D + 1536 + h2 * 128, 0, nullptr);
            }
            UREP(6) for (int v = (F.bid + 32) % F.G; v < 128; v += F.G) ml_scan_unit(F, v >> 2, v & 3);
            UREP(7) for (int v = (F.bid + 96) % F.G; v < 128; v += F.G) ss_scan_unit(F, v >> 1, v & 1);
            UREP(8) for (int v = F.bid; v < 288; v += F.G) mla_post_unit(F, l, v / 72, v % 72);
            SEAM(pb + 4); TPE(pb + 4);
        }
        if (IN(pb + 5)) { TPB(pb + 5);
            const int p0 = wc ? 0 : 4, npp = 36 - p0;
            UREP(9) for (int u = F.bid; u < 256; u += F.G) { const int bh = u >> 4, qb = u & 15, b = bh >> 2, h = bh & 3;
                attn_unit2<192, false>(F, WSP(bf16, WS_QMLA) + ((size_t)bh * TS + qb * 128) * 192, WSP(bf16, WS_KMLA) + (size_t)bh * TS * 192, WSP(bf16, WS_VTMLA) + (size_t)bh * 128 * TS,
                                      36, 0, 0, 0, 0.10411754627862817f, WSP(bf16, WS_A2) + (size_t)(b * TL + qb * 128) * D + 1024 + h * 128, 0, nullptr); }
            if (wc) UREP(10) for (int v = F.bid; v < 32; v += F.G) { const int bh = v >> 1, qc = v & 1, b = bh >> 2, h = bh & 3;
                attn_unit2<192, false>(F, WSP(bf16, WS_QMLA) + ((size_t)bh * TS + TL + qc * 128) * 192, WSP(bf16, WS_KMLA) + (size_t)bh * TS * 192, WSP(bf16, WS_VTMLA) + (size_t)bh * 128 * TS,
                                      4, 32, 0, 0, 0.10411754627862817f, WSP(bf16, WS_A2) + (size_t)(MLAT + b * TC + qc * 128) * D + 1024 + h * 128, 0, nullptr); }
            UREP(11) for (int v = (F.bid + 32) % F.G; v < 32 * npp; v += F.G) ml_c_unit(F, v / npp, p0 + v % npp);
            UREP(12) for (int v = (F.bid + 160) % F.G; v < 64 * npp; v += F.G) ss_c_unit(F, l, v / npp, p0 + v % npp);
            SEAM(pb + 5); TPE(pb + 5);
        }
        if (IN(pb + 6)) { TPB(pb + 6); m5_finish_phase(F, l, nrows); SEAM(pb + 6); TPE(pb + 6); }
        if (IN(pb + 7)) { TPB(pb + 7);
            const int ncv = (ONE_LAUNCH && l == 0) ? NCV_OUT : 0, gw_ = F.G - ncv;
            if (F.bid < gw_) { pg8::Gemm g{WSP(bf16, WS_A2), WSP(bf16, WS_WOUT) + (size_t)l * D * D, D, D}; pg8::StaticOrder S; S.init(nrows / 256, D / 256, gw_, F.bid);
                EpiResid E{l == 0 ? F.in[0] : WSP(float, WS_X), l == 0 ? F.in[2] : WSP(float, WS_X) + (size_t)MLAT * D, WSP(float, WS_X), modl + 2 * D};
                pg8::gemm_phase<EpiResid, pg8::StaticOrder>(F.lds, g, S, E); }
            FILL(pb + 7, F.bid >= gw_);
            SEAM(pb + 7); TPE(pb + 7);
        }
        if (IN(pb + 8)) { TPB(pb + 8);
            if (l == 0) { norm_phase<false>(F, l, WSP(float, WS_X), WSP(float, WS_X) + (size_t)MLAT * D, F.in[27] + l * D, 3 * D, nrows); conv_drain(F, CV_NE - CV_EAGER); }
            else { norm_phase<true>(F, l, WSP(float, WS_X), WSP(float, WS_X) + (size_t)MLAT * D, F.in[27] + l * D, 3 * D, nrows); conv_drain(F, CV_NDEF); }
            SEAM(pb + 8); TPE(pb + 8);
        }
        if (l == 0) {
            if (IN(pb + 10)) { TPB(pb + 10);
                const int ncv = ONE_LAUNCH ? NCV_UP : 0, gw_ = F.G - ncv;
                if (F.bid < gw_) { pg8::Gemm g{WSP(bf16, WS_HN), WSP(bf16, WS_W13), D, D}; pg8::StaticOrder S; S.init(MTOK / 256, 2 * FF / 256, gw_, F.bid);
                    EpiSwiglu E{WSP(bf16, WS_G), FF}; pg8::gemm_phase<EpiSwiglu, pg8::StaticOrder>(F.lds, g, S, E); }
                FILL(pb + 10, F.bid >= gw_);
                SEAM(pb + 10); TPE(pb + 10);
            }
            if (IN(pb + 11)) { TPB(pb + 11);
                const int ncv = ONE_LAUNCH ? NCV_DOWN : 0, gw_ = F.G - ncv;
                if (F.bid < gw_) { pg8::Gemm g{WSP(bf16, WS_G), WSP(bf16, WS_W2), FF, FF}; pg8::StaticOrder S; S.init(MTOK / 256, D / 256, gw_, F.bid);
                    EpiResid E{WSP(float, WS_X), WSP(float, WS_X) + (size_t)MLAT * D, WSP(float, WS_X), modl + 5 * D};
                    pg8::gemm_phase<EpiResid, pg8::StaticOrder>(F.lds, g, S, E); }
                FILL(pb + 11, F.bid >= gw_);
                SEAM(pb + 11); TPE(pb + 11);
            }
        } else {
            if (IN(pb + 10)) { TPB(pb + 10);
                __syncthreads(); moe_tables(F, mtb, 2 * FE / 256);
                pg8::Gemm g{WSP(bf16, WS_XG), WSP(bf16, WS_MW13), D, D}; MoeOrder S{mtb, 2 * FE / 256, F.G, F.bid, 0, mtb[40], 1, 0, MLAT / 256};
                EpiSwiglu E{WSP(bf16, WS_G), FE}; pg8::gemm_phase<EpiSwiglu, MoeOrder>(F.lds, g, S, E);
                SEAM(pb + 10); TPE(pb + 10);
            }
            if (IN(pb + 11)) { TPB(pb + 11);
                __syncthreads(); moe_tables(F, mtb, D / 256);
                const int nun = mtb[40], nfull0 = (nun / F.G) * F.G, nt0 = nun - nfull0;
                const int SK = nt0 == 0 ? 1 : (nt0 <= 32 ? 8 : (nt0 <= 64 ? 4 : (nt0 <= 128 ? 2 : 1)));
                const int nfull = SK == 1 ? nun : nfull0, ntail = nun - nfull;
                { pg8::Gemm g{WSP(bf16, WS_G), WSP(bf16, WS_MW2), FE, FE}; MoeOrder S{mtb, D / 256, F.G, F.bid, 0, nfull, 1, 0, 0};
                  EpiF32 E{WSP(float, WS_Y), D}; pg8::gemm_phase<EpiF32, MoeOrder>(F.lds, g, S, E); }
                if (ntail > 0) { __syncthreads();
                  pg8::Gemm g{WSP(bf16, WS_G), WSP(bf16, WS_MW2), FE / SK, FE}; MoeOrder S{mtb, D / 256, F.G, F.bid, nfull, ntail * SK, SK, FE / SK, 0};
                  EpiPart E{WSP(float, WS_PART)}; pg8::gemm_phase<EpiPart, MoeOrder>(F.lds, g, S, E); }
                SEAM(pb + 11); TPE(pb + 11);
            }
            if (IN(pb + 12)) { TPB(pb + 12);
                __syncthreads(); moe_tables(F, mtb, D / 256);
                const int nun = mtb[40], nfull0 = (nun / F.G) * F.G, nt0 = nun - nfull0;
                const int SK = nt0 == 0 ? 1 : (nt0 <= 32 ? 8 : (nt0 <= 64 ? 4 : (nt0 <= 128 ? 2 : 1)));
                const int nfull = SK == 1 ? nun : nfull0, ntail = nun - nfull;
                for (int it = F.bid; it < ntail * 8; it += F.G) { const int t = it >> 3, cg = it & 7;
                    MoeOrder S{mtb, D / 256, 1, 0, nfull + t, 1, 1, 0, 0}; pg8::Unit u; S.next(0, u);
                    if (SK == 8) splitk_reduce_f32<8>(WSP(float, WS_PART), t, cg, u, WSP(float, WS_Y), D);
                    else if (SK == 4) splitk_reduce_f32<4>(WSP(float, WS_PART), t, cg, u, WSP(float, WS_Y), D);
                    else splitk_reduce_f32<2>(WSP(float, WS_PART), t, cg, u, WSP(float, WS_Y), D); }
                SEAM(pb + 12); TPE(pb + 12);
            }
            if (IN(pb + 13)) { TPB(pb + 13); moe_combine_phase(F, l); __syncthreads(); TPE(pb + 13); }
        }
}
__global__ void __launch_bounds__(NTHR, 2) fwd_kernel(Args args) {
    extern __shared__ __attribute__((aligned(16))) unsigned char lds[];
    Frame F;
    F.lds = (LAS unsigned char*)lds; F.ws = args.ws; F.out = args.out;
#pragma unroll
    for (int i = 0; i < 35; ++i) F.in[i] = args.in[i];
    F.tid = threadIdx.x; F.lane = F.tid & 63; F.wave = __builtin_amdgcn_readfirstlane(F.tid >> 6); F.G = gridDim.x; F.bid = blockIdx.x; F.rep = args.rep;
    volatile LAS unsigned* MISC = (volatile LAS unsigned*)(F.lds + MISC_OFF);
    if (F.tid < 64) MISC[F.tid] = 0u;
    __syncthreads();
    XcdBarrier bar; bar.bar = WSP(unsigned, WS_CTL) + CW_BAR; bar.x = 0; bar.st = nullptr;
    if (ONE_LAUNCH) bar = xcd_barrier_post(WSP(unsigned, WS_CTL) + CW_BAR, MISC + 8);
    const int lo = args.ph_lo, hi = args.ph_hi;

    if (IN(0)) { TPB(0); p0_prologue(F); SEAM(0); TPE(0); }

    layer_phases<0>(F, bar, lo, hi);
    layer_phases<1>(F, bar, lo, hi);
    if (TPROBE_MASK != 0ull && F.bid == 0 && F.tid == 0) { volatile LAS unsigned long long* tp_ = (volatile LAS unsigned long long*)(F.lds + MISC_OFF + 128);
        const unsigned long long t0 = wall_clock64(), dur = tp_[1] * TPROBE_AMP; while (wall_clock64() - t0 < dur) __builtin_amdgcn_s_sleep(8); }
#undef IN
#undef SEAM
}

extern "C" void kernel_launch(void* const* d_in, const int* in_sizes, int n_in, void* d_out, int out_size, void* d_ws, size_t ws_size, hipStream_t stream) {
    static int grid = 0;
    if (grid == 0) {
        if (n_in != 35 || out_size != MLAT * D || ws_size < WS_END) { fprintf(stderr, "kernel_launch: unexpected shapes (n_in %d out %d ws %zu need %zu)\n", n_in, out_size, ws_size, (size_t)WS_END); grid = -1; return; }
        int dev = 0, cus = 0, per_cu = 0;
        if (hipGetDevice(&dev) != hipSuccess || hipDeviceGetAttribute(&cus, hipDeviceAttributeMultiprocessorCount, dev) != hipSuccess) { grid = -1; return; }
        if (hipFuncSetAttribute((const void*)fwd_kernel, hipFuncAttributeMaxDynamicSharedMemorySize, LDS_BYTES) != hipSuccess) { fprintf(stderr, "kernel_launch: hipFuncSetAttribute failed\n"); grid = -1; return; }
        if (hipOccupancyMaxActiveBlocksPerMultiprocessor(&per_cu, (const void*)fwd_kernel, NTHR, LDS_BYTES) != hipSuccess || per_cu < 1) { fprintf(stderr, "kernel_launch: occupancy query says %d\n", per_cu); }
        (void)hipGetLastError();
        grid = cus;
    }
    if (grid < 0) return;
    (void)hipMemsetAsync((char*)d_ws + WS_CTL, 0, CTL_ZERO_BYTES, stream);
    Args a{};
    for (int i = 0; i < 35; ++i) a.in[i] = (const float*)d_in[i];
    a.out = (float*)d_out; a.ws = (unsigned char*)d_ws; a.rep = UNIT_REP;
#if ONE_LAUNCH
    a.ph_lo = 0; a.ph_hi = 64;
    hipLaunchKernelGGL(fwd_kernel, dim3(grid), dim3(NTHR), LDS_BYTES, stream, a);
#else
    static const int phases[] = {0, 1, 2, 3, 4, 5, 6, 7, 8, 9, 11, 12, 17, 18, 19, 20, 21, 22, 23, 24, 25, 27, 28, 29, 30};
    for (int k = 0; k < (int)(sizeof(phases) / sizeof(phases[0])); ++k) {
        a.ph_lo = phases[k]; a.ph_hi = phases[k] + 1;
        for (int rp = 0; rp < NREP(phases[k]); ++rp) hipLaunchKernelGGL(fwd_kernel, dim3(grid), dim3(NTHR), LDS_BYTES, stream, a);
    }
#endif
}
```

```cpp
#define NCV_P 48
#define NCV_OUT 96
#define NCV_UP 24
#define NCV_DOWN 96
#define FILL_MASK 0x7fffffffull
#define PROBE_MASK (0ull)
#define ONE_LAUNCH 1
#define UNIT_REP 0
#include <hip/hip_runtime.h>
#include <cstdio>
#include <cstdint>

#define DI __device__ __forceinline__
#define LAS __attribute__((address_space(3)))
#define GAS __attribute__((address_space(1)))
typedef unsigned short bf16;
typedef short bf16x8 __attribute__((ext_vector_type(8)));
typedef float f32x4 __attribute__((ext_vector_type(4)));
typedef float f32x2 __attribute__((ext_vector_type(2)));
typedef unsigned u32x4 __attribute__((ext_vector_type(4)));
typedef unsigned u32x2 __attribute__((ext_vector_type(2)));

namespace pg8 {
constexpr int BM = 256, BK = 64, HALF = 128, HTB = HALF * BK * 2, STAGE_BYTES = 8 * HTB, NXCD = 8, WGM = 8;
__host__ __device__ __forceinline__ int lds_byte(int r, int c) { const int st = (r >> 4) * 2 + (c >> 5), rr = r & 15, cc = c & 31, ob = rr * 64 + cc * 2; return st * 1024 + (ob ^ (((ob >> 9) & 1) << 5)); }
__host__ __device__ __forceinline__ void stage_rc(int b, int& R, int& C) { const int st = b / 1024, sb = b % 1024, swz = sb ^ (((sb >> 9) & 1) << 5); R = (st >> 1) * 16 + swz / 64; C = (st & 1) * 32 + (swz % 64) / 2; }
__host__ __device__ __forceinline__ int perm32(int rho) { const int n = rho >> 4, i = rho & 15; return 8 * (i >> 2) + 4 * n + (i & 3); }

struct Unit { int pm, pn, pb, koff, aux, pa; };
struct Gemm { const bf16* A; const bf16* Bt; int K, ld; };

DI int xcd_remap(int L, int nwg) { const int q = nwg / NXCD, r = nwg % NXCD, xcd = L % NXCD, off = L / NXCD; return (xcd < r ? xcd * (q + 1) : r * (q + 1) + (xcd - r) * q) + off; }

struct StaticOrder {
    int nM, nN, nwg, G, c;
    DI void init(int nM_, int nN_, int G_, int c_) { nM = nM_; nN = nN_; nwg = nM * nN; G = G_; c = c_; }
    DI bool next(int i, Unit& u) const {
        const long L = (long)i * G + c; if (L >= nwg) return false;
        const int wgid = xcd_remap((int)L, nwg);
        const int nig = WGM * nN, gid = wgid / nig, fm = gid * WGM, gsz = (nM - fm) < WGM ? (nM - fm) : WGM;
        u.pm = fm + ((wgid % nig) % gsz); u.pn = (wgid % nig) / gsz; u.pb = u.pn; u.koff = 0; u.aux = 0; u.pa = u.pm; return true;
    }
};

DI unsigned cvt_pk_bf16(float lo, float hi) { unsigned r; asm volatile("v_cvt_pk_bf16_f32 %0, %1, %2" : "=v"(r) : "v"(lo), "v"(hi)); return r; }

template <class Epi, class Sched, bool ALIGN_EPI = true>
DI void gemm_phase(LAS unsigned char* lds, const Gemm g, const Sched& S, const Epi& E) {
    const int tid = threadIdx.x, wid = __builtin_amdgcn_readfirstlane(tid >> 6), lane = tid & 63, wr = wid >> 2, wc = wid & 3, fr = lane & 15, fq = lane >> 4;
    const int K = g.K, nt = K / BK;
    unsigned voffA[2], voffB[2];
#pragma unroll
    for (int i = 0; i < 2; ++i) { int R, C; stage_rc(tid * 16 + i * 8192, R, C); const int Rb = Epi::PERM ? ((R & ~31) + perm32(R & 31)) : R;
        voffA[i] = (unsigned)(R * g.ld + C) * 2u; voffB[i] = (unsigned)(Rb * g.ld + C) * 2u; }
    const size_t kstep = (size_t)(BK * 2);
    const size_t hstep = (size_t)HALF * g.ld * 2;
    const size_t tstep = 2 * hstep;
    const unsigned ldsw = (unsigned)wid * 1024u;
    const int aoff = lds_byte(wr * 64 + fr, fq * 8), boff = lds_byte(wc * 32 + fr, fq * 8);
#define PG8_SA(b, h) (((b) * 2 + (h)) * HTB)
#define PG8_SB(b, h) ((4 + (b) * 2 + (h)) * HTB)
#define PG8_STAGE(bufoff, gbase, voff) do { _Pragma("unroll") for (int _i = 0; _i < 2; ++_i) \
        __builtin_amdgcn_global_load_lds((const unsigned*)((const char*)(gbase) + (voff)[_i]), (LAS unsigned*)(lds + (bufoff) + ldsw + _i * 8192), 16, 0, 0); } while (0)
#define PG8_LDA(dst, b, h) do { _Pragma("unroll") for (int m = 0; m < 4; ++m) _Pragma("unroll") for (int k = 0; k < 2; ++k) dst[m][k] = *(const LAS bf16x8*)(lds + PG8_SA(b, h) + aoff + m * 2048 + k * 1024); } while (0)
#define PG8_LDB(dst, b, h) do { _Pragma("unroll") for (int n = 0; n < 2; ++n) _Pragma("unroll") for (int k = 0; k < 2; ++k) dst[n][k] = *(const LAS bf16x8*)(lds + PG8_SB(b, h) + boff + n * 2048 + k * 1024); } while (0)
#define PG8_MMA(ai, bj, At, Bt) do { __builtin_amdgcn_s_setprio(1); _Pragma("unroll") for (int m = 0; m < 4; ++m) _Pragma("unroll") for (int n = 0; n < 2; ++n) _Pragma("unroll") for (int k = 0; k < 2; ++k) \
        acc[ai][bj][m][n] = __builtin_amdgcn_mfma_f32_16x16x32_bf16(Bt[n][k], At[m][k], acc[ai][bj][m][n], 0, 0, 0); __builtin_amdgcn_s_setprio(0); } while (0)
#define PG8_WAIT_V(n) asm volatile("s_waitcnt vmcnt(" #n ")" ::: "memory")
#define PG8_WAIT_L(n) asm volatile("s_waitcnt lgkmcnt(" #n ")" ::: "memory")
#define PG8_BAR __builtin_amdgcn_s_barrier()
#define PG8_SCHED __builtin_amdgcn_sched_barrier(0)
    Unit cur, nxt; int ui = 0;
    if (!S.next(0, cur)) return;
    f32x4 acc[2][2][4][2];
#pragma unroll
    for (int a = 0; a < 2; ++a)
#pragma unroll
        for (int b = 0; b < 2; ++b)
#pragma unroll
            for (int m = 0; m < 4; ++m)
#pragma unroll
                for (int n = 0; n < 2; ++n) acc[a][b][m][n] = (f32x4){0.f, 0.f, 0.f, 0.f};
    bf16x8 At[4][2], B0[2][2], B1[2][2];
    const char* cA = (const char*)g.A + (size_t)cur.pa * tstep + (size_t)cur.koff * 2; const char* cB = (const char*)g.Bt + (size_t)cur.pb * tstep + (size_t)cur.koff * 2;
    {
        PG8_STAGE(PG8_SB(0, 0), cB, voffB); PG8_STAGE(PG8_SB(0, 1), cB + hstep, voffB); PG8_STAGE(PG8_SA(0, 0), cA, voffA); PG8_STAGE(PG8_SA(0, 1), cA + hstep, voffA);
        if (wr == 1) PG8_BAR;
        PG8_WAIT_V(2); PG8_BAR;
        PG8_STAGE(PG8_SB(1, 0), cB + kstep, voffB); PG8_STAGE(PG8_SA(1, 0), cA + kstep, voffA); PG8_STAGE(PG8_SB(1, 1), cB + hstep + kstep, voffB);
        PG8_WAIT_V(6); PG8_BAR;
    }
    for (;;) {
        const bool has_next = S.next(ui + 1, nxt);
        const char* nA = has_next ? (const char*)g.A + (size_t)nxt.pa * tstep + (size_t)nxt.koff * 2 : cA; const char* nB = has_next ? (const char*)g.Bt + (size_t)nxt.pb * tstep + (size_t)nxt.koff * 2 : cB;
        for (int t = 0; t < nt; t += 2) {
            const bool last = (t == nt - 2);
            const char* a1 = cA + (size_t)(t + 1) * kstep;
            const char* a2 = last ? nA : cA + (size_t)(t + 2) * kstep; const char* b2 = last ? nB : cB + (size_t)(t + 2) * kstep;
            const char* a3 = a2 + kstep; const char* b3 = b2 + kstep;
            PG8_LDB(B0, 0, 0); PG8_LDB(B1, 0, 1); PG8_SCHED; PG8_LDA(At, 0, 0); PG8_STAGE(PG8_SA(1, 1), a1 + hstep, voffA);
            PG8_WAIT_V(8); PG8_WAIT_L(0); PG8_BAR; PG8_MMA(0, 0, At, B0); PG8_MMA(0, 1, At, B1); PG8_BAR; PG8_SCHED;
            PG8_LDA(At, 0, 1); PG8_STAGE(PG8_SB(0, 0), b2, voffB); PG8_STAGE(PG8_SB(0, 1), b2 + hstep, voffB); PG8_STAGE(PG8_SA(0, 0), a2, voffA);
            PG8_WAIT_V(8); PG8_WAIT_L(0); PG8_BAR; PG8_MMA(1, 0, At, B0); PG8_MMA(1, 1, At, B1); PG8_BAR; PG8_SCHED;
            PG8_LDB(B0, 1, 0); PG8_LDB(B1, 1, 1); PG8_SCHED; PG8_LDA(At, 1, 0); PG8_STAGE(PG8_SA(0, 1), a2 + hstep, voffA);
            PG8_WAIT_V(8); PG8_WAIT_L(0); PG8_BAR; PG8_MMA(0, 0, At, B0); PG8_MMA(0, 1, At, B1); PG8_BAR; PG8_SCHED;
            PG8_LDA(At, 1, 1); PG8_STAGE(PG8_SB(1, 0), b3, voffB); PG8_STAGE(PG8_SB(1, 1), b3 + hstep, voffB); PG8_STAGE(PG8_SA(1, 0), a3, voffA);
            PG8_WAIT_V(8); PG8_WAIT_L(0); PG8_BAR; PG8_MMA(1, 0, At, B0); PG8_MMA(1, 1, At, B1); PG8_BAR; PG8_SCHED;
        }
        if constexpr (ALIGN_EPI) { if (wr == 0) PG8_BAR; }
        E(acc, cur, wr, wc, fr, fq);
        if (!has_next) break;
#pragma unroll
        for (int a = 0; a < 2; ++a)
#pragma unroll
            for (int b = 0; b < 2; ++b)
#pragma unroll
                for (int m = 0; m < 4; ++m)
#pragma unroll
                    for (int n = 0; n < 2; ++n) acc[a][b][m][n] = (f32x4){0.f, 0.f, 0.f, 0.f};
        cur = nxt; cA = nA; cB = nB; ++ui;
        if constexpr (ALIGN_EPI) { if (wr == 1) PG8_BAR; }
    }
    PG8_WAIT_V(0);
    if constexpr (!ALIGN_EPI) { if (wr == 0) PG8_BAR; }
    PG8_BAR;
#undef PG8_SA
#undef PG8_SB
#undef PG8_STAGE
#undef PG8_LDA
#undef PG8_LDB
#undef PG8_MMA
#undef PG8_WAIT_V
#undef PG8_WAIT_L
#undef PG8_BAR
#undef PG8_SCHED
}
}
constexpr int D = 2048, NB = 4, TL = 2048, TC = 256, TS = TL + TC  ;
constexpr int MLAT = NB * TL  , MTOK = NB * (TL + TC)  ;
constexpr int DIN = 5824, DINP = 5888, D6 = 6 * D;
constexpr int FF = 5632, FE = 7168, NEXP = 8;
constexpr float EPS = 1e-6f;
constexpr int PC_MLQ = 0, PC_MLK = 512, PC_MLV = 1024, PC_MLO = 1536, PC_IG = 2048, PC_FG = 2056, PC_Z = 2064, PC_XBC = 2576, PC_DT = 3600,
              PC_CQ = 3616, PC_CKV = 4064, PC_KR = 4224, PC_NQ = 4288, PC_NK = 4800, PC_NV = 5312;
constexpr int NCHUNK = 36;
constexpr int MAXMT = 72;

constexpr size_t MiB = 1u << 20;
constexpr size_t WS_CTL = 0, CTL_ZERO_BYTES = 1 * MiB;
constexpr size_t WS_MOD = 1 * MiB;
constexpr size_t WS_WIN = 2 * MiB;
constexpr size_t WS_WOUT = WS_WIN + 46 * MiB;
constexpr size_t WS_WQB = WS_WOUT + 16 * MiB;
constexpr size_t WS_WKVB = WS_WQB + 2 * MiB;
constexpr size_t WS_W13 = WS_WKVB + 1 * MiB;
constexpr size_t WS_W2 = WS_W13 + 44 * MiB;
constexpr size_t WS_MW13 = WS_W2 + 22 * MiB;
constexpr size_t WS_MW2 = WS_MW13 + 448 * MiB;
constexpr size_t WS_HN = WS_MW2 + 224 * MiB;
constexpr size_t WS_A2 = WS_HN + 36 * MiB;
constexpr size_t WS_X = WS_A2 + 36 * MiB;
constexpr size_t WS_BIG = WS_X + 72 * MiB;
constexpr size_t WS_P = WS_BIG;
constexpr size_t WS_GRAW = WS_BIG + 104 * MiB;
constexpr size_t WS_CQN = WS_P + 207 * MiB;
constexpr size_t WS_CKVN = WS_CQN + 9 * MiB;
constexpr size_t WS_QRAW = WS_CKVN + 5 * MiB;
constexpr size_t WS_KVRAW = WS_QRAW + 14 * MiB;
constexpr size_t WS_QMLA = WS_KVRAW + 18 * MiB;
constexpr size_t WS_KMLA = WS_QMLA + 14 * MiB;
constexpr size_t WS_VTMLA = WS_KMLA + 14 * MiB;
constexpr size_t WS_QNA = WS_VTMLA + 9 * MiB;
constexpr size_t WS_KNA = WS_QNA + 9 * MiB;
constexpr size_t WS_VTNA = WS_KNA + 9 * MiB;
constexpr size_t WS_XBC = WS_VTNA + 9 * MiB;
constexpr size_t WS_DT = WS_XBC + 18 * MiB;
constexpr size_t WS_GATES = WS_DT + 1 * MiB;
constexpr size_t WS_MLSC = WS_GATES + 1 * MiB;
constexpr size_t WS_SSSC = WS_MLSC + 64 * 1024;
constexpr size_t WS_MLU = WS_MLSC + 1 * MiB;
constexpr size_t WS_MLS = WS_MLU + 73 * MiB;
constexpr size_t WS_SSU = WS_MLS + 37 * MiB;
constexpr size_t WS_SSS = WS_SSU + 72 * MiB;
constexpr size_t WS_HML = WS_SSS + 36 * MiB;
constexpr size_t WS_YSS = WS_HML + 36 * MiB;
constexpr size_t WS_MIXEND = WS_YSS + 36 * MiB;
constexpr size_t WS_G = WS_BIG;
constexpr size_t WS_Y = WS_G + 252 * MiB;
constexpr size_t WS_XG = WS_Y + 144 * MiB;
constexpr size_t WS_TOK = WS_XG + 256 * MiB;
constexpr size_t WS_PART = WS_TOK + 1 * MiB;
constexpr size_t WS_FFNEND = WS_PART + 64 * MiB;
constexpr size_t WS_END = (WS_MIXEND > WS_FFNEND ? WS_MIXEND : WS_FFNEND);
static_assert(WS_END < (size_t)1800 * MiB, "workspace budget");
static_assert((size_t)MTOK * DINP * 4 <= 207 * MiB && (size_t)32 * 36 * 129 * 128 * 4 <= 73 * MiB, "sizes");
constexpr int CW_BAR = 4096;
constexpr int CW_MOE = 16384;
constexpr int CW_QH = 20480;
constexpr int CW_ARR = 32768;

constexpr int RING_BYTES = 131072;
constexpr int MISC_OFF = 147456 - 256;
constexpr int LDS_BYTES = 147456;
constexpr int NWAVES = 8, NTHR = 512;

#define RLX_AGENT __ATOMIC_RELAXED, __HIP_MEMORY_SCOPE_AGENT
#define LDS_WAIT() asm volatile("s_waitcnt lgkmcnt(0)" ::: "memory")
#define VM_WAIT() asm volatile("s_waitcnt vmcnt(0)" ::: "memory")
DI unsigned f2bf(float f) { unsigned u = __builtin_bit_cast(unsigned, f); return (u + 0x7fffu + ((u >> 16) & 1u)) >> 16; }
DI unsigned pk2(float lo, float hi) { return f2bf(lo) | (f2bf(hi) << 16); }
DI float bf2f(unsigned b) { return __builtin_bit_cast(float, b << 16); }
#define PINV(x) asm volatile("" : "+v"(x))
#define PIN4(a) asm volatile("" : "+v"((a)[0]), "+v"((a)[1]), "+v"((a)[2]), "+v"((a)[3]))
#define PIN8(a) asm volatile("" : "+v"((a)[0]), "+v"((a)[1]), "+v"((a)[2]), "+v"((a)[3]), "+v"((a)[4]), "+v"((a)[5]), "+v"((a)[6]), "+v"((a)[7]))
DI float wave_sum(float v) {
#pragma unroll
    for (int o = 1; o < 64; o <<= 1) v += __shfl_xor(v, o);
    return v;
}
DI float wave_max(float v) {
#pragma unroll
    for (int o = 1; o < 64; o <<= 1) v = fmaxf(v, __shfl_xor(v, o));
    return v;
}
DI float wave_incl_scan(float v, int lane) {
#pragma unroll
    for (int o = 1; o < 64; o <<= 1) { const float t = __shfl_up(v, o); if (lane >= o) v += t; }
    return v;
}
DI float siluf(float x) { return x / (1.f + __expf(-x)); }
DI float sigmoidf_(float x) { return 1.f / (1.f + __expf(-x)); }
DI float softplusf_(float x) { return fmaxf(x, 0.f) + log1pf(__expf(-fabsf(x))); }
DI float logsigmoidf_(float x) { return fminf(x, 0.f) - log1pf(__expf(-fabsf(x))); }

#define XB_TMO      128
#define XB_XCNT(j)  (256  + 64 * (j))
#define XB_XSUB(j)  (1280 + 64 * (j))
#define XB_XGEN(j)  (2304 + 64 * (j))
#define XB_TOP      3328
#define XB_TOPGEN   3392
#define XCD_BAR_WORDS 3456
#define XB_SPIN_CAP (1u << 22)
DI unsigned xb_ld(unsigned* p)              { return __hip_atomic_load(p, __ATOMIC_RELAXED, __HIP_MEMORY_SCOPE_AGENT); }
DI unsigned xb_add(unsigned* p, unsigned v) { return __hip_atomic_fetch_add(p, v, __ATOMIC_RELAXED, __HIP_MEMORY_SCOPE_AGENT); }
DI unsigned xb_xcc_id() { return (unsigned)__builtin_amdgcn_s_getreg((3 << 11) | 20) & 0xFu; }
#define XB_SPIN(cond, bar) do { unsigned _sp = 0; while (cond) { __builtin_amdgcn_s_sleep(1); \
    if ((++_sp & 255u) == 0u) { if (xb_ld(&(bar)[XB_TMO])) break; if (_sp > XB_SPIN_CAP) { atomicAdd(&(bar)[XB_TMO], 1u); break; } } } } while (0)
struct XcdBarrier { unsigned* bar; unsigned x; volatile LAS unsigned* st; };
DI XcdBarrier xcd_barrier_post(unsigned* bar, volatile LAS unsigned* st) {
    XcdBarrier b; b.bar = bar; b.x = xb_xcc_id(); b.st = st;
    if (threadIdx.x == 0) (void)xb_add(&bar[XB_XCNT(b.x)], 1u);
    return b;
}
DI void xcd_barrier_complete(unsigned* bar, unsigned x, unsigned& nloc, unsigned& nx) {
    const unsigned G = gridDim.x * gridDim.y * gridDim.z;
    unsigned sum, cnt, mine, sp = 0u;
    for (;;) {
        sum = 0u; cnt = 0u; mine = 0u;
#pragma unroll
        for (unsigned j = 0; j < 16; ++j) { const unsigned c = xb_ld(&bar[XB_XCNT(j)]); sum += c; cnt += (c > 0u) ? 1u : 0u; mine = (j == x) ? c : mine; }
        if (sum == G) break;
        __builtin_amdgcn_s_sleep(1);
        if ((++sp & 255u) == 0u) { if (xb_ld(&bar[XB_TMO])) break; if (sp > XB_SPIN_CAP) { atomicAdd(&bar[XB_TMO], 1u); break; } }
    }
    nloc = mine > 0u ? mine : 1u; nx = cnt > 0u ? cnt : 1u;
}
DI void xcd_barrier(const XcdBarrier& b) {
    asm volatile("s_waitcnt vmcnt(0)" ::: "memory");
    __syncthreads();
    if (threadIdx.x == 0) {
        unsigned* bar = b.bar;
        __builtin_amdgcn_s_waitcnt(0);
        unsigned nloc = b.st[0], nx = b.st[1];
        if (nloc == 0u) { xcd_barrier_complete(bar, b.x, nloc, nx); b.st[0] = nloc; b.st[1] = nx; }
        const unsigned old = xb_add(&bar[XB_XSUB(b.x)], 1u);
        const unsigned gen = old / nloc;
        if (old + 1u == (gen + 1u) * nloc) {
            __builtin_amdgcn_fence(__ATOMIC_RELEASE, "agent");
            asm volatile("s_waitcnt vmcnt(0)" ::: "memory");
            const unsigned og = xb_add(&bar[XB_TOP], 1u);
            const unsigned tg = og / nx;
            if (og + 1u == (tg + 1u) * nx) xb_add(&bar[XB_TOPGEN], 1u);
            else XB_SPIN(xb_ld(&bar[XB_TOPGEN]) == tg, bar);
            __builtin_amdgcn_fence(__ATOMIC_ACQUIRE, "agent");
            xb_add(&bar[XB_XGEN(b.x)], 1u);
            asm volatile("s_waitcnt vmcnt(0)" ::: "memory");
        } else {
            XB_SPIN(xb_ld(&bar[XB_XGEN(b.x)]) == gen, bar);
            __builtin_amdgcn_fence(__ATOMIC_ACQUIRE, "agent");
            asm volatile("s_waitcnt vmcnt(0)" ::: "memory");
        }
    }
    __syncthreads();
}

struct Args { const float* in[35]; float* out; unsigned char* ws; int ph_lo, ph_hi, rep, pad; };
struct Frame {
    LAS unsigned char* lds;
    unsigned char* ws;
    const float* in[35];
    float* out;
    int tid, lane, wave, G, bid, rep;
};
#define WSP(T, off) ((T*)(F.ws + (off)))
DI int rowof(int b, int j) { return j < TL ? b * TL + j : MLAT + b * TC + (j - TL); }

template <int K> DI f32x4 mma16(const LAS bf16* A, int lda, const LAS bf16* Bt, int ldb, int lane, f32x4 acc) {
    const int r = lane & 15, q = lane >> 4;
    const LAS bf16* pa = A + r * lda + 8 * q; const LAS bf16* pb = Bt + r * ldb + 8 * q;
#pragma unroll
    for (int k = 0; k < K; k += 32) {
        const bf16x8 a = *(const LAS bf16x8*)(pa + k); const bf16x8 b = *(const LAS bf16x8*)(pb + k);
        acc = __builtin_amdgcn_mfma_f32_16x16x32_bf16(a, b, acc, 0, 0, 0);
    }
    return acc;
}
struct CvDesc { const float* src; bf16* dst; size_t ld, Kd; int Kv, Nv, k0, n0, dn0; };
DI void tr_load(const CvDesc& d, f32x4 (&v)[16], int lane) {
    const int nn = 4 * (lane & 15), kq = lane >> 4;
#pragma unroll
    for (int i = 0; i < 16; ++i) { const int kk = 4 * i + kq;
        v[i] = (f32x4){0.f, 0.f, 0.f, 0.f};
        if (d.k0 + kk < d.Kv && d.n0 + nn < d.Nv) v[i] = __builtin_nontemporal_load((const f32x4*)(d.src + (size_t)(d.k0 + kk) * d.ld + d.n0 + nn)); }
#pragma unroll
    for (int i = 0; i < 16; ++i) PINV(v[i]);
}
DI void tr_lds(const f32x4 (&v)[16], LAS float* scr, int lane) {
    const int nn = 4 * (lane & 15), kq = lane >> 4;
#pragma unroll
    for (int i = 0; i < 16; ++i) { const int kk = 4 * i + kq; LAS float* s = scr + kk * 65 + nn; s[0] = v[i][0]; s[1] = v[i][1]; s[2] = v[i][2]; s[3] = v[i][3]; }
    LDS_WAIT(); asm volatile("" ::: "memory");
}
DI void tr_out(const CvDesc& d, LAS float* scr, int lane) {
    const int c = lane & 7;
#pragma unroll
    for (int j = 0; j < 8; ++j) { const int n = (lane >> 3) + 8 * j; const LAS float* s = scr + (8 * c) * 65 + n;
        u32x4 o; o.x = pk2(s[0 * 65], s[1 * 65]); o.y = pk2(s[2 * 65], s[3 * 65]); o.z = pk2(s[4 * 65], s[5 * 65]); o.w = pk2(s[6 * 65], s[7 * 65]);
        *(u32x4*)(d.dst + (size_t)(d.dn0 + n) * d.Kd + d.k0 + 8 * c) = o; }
    LDS_WAIT(); asm volatile("" ::: "memory");
}
DI int il_row(int n0, int which) { return (n0 >> 7) * 256 + (n0 & 127) + which * 128; }

constexpr int I_IN = 32 * 92, I_OUT = 32 * 32, I_QB = 8 * 12, I_KVB = 4 * 16, I_F1 = 32 * 88, I_F2 = 88 * 32, I_M1 = 32 * 112, I_M2 = 112 * 32;
constexpr int I_L = I_IN + I_OUT + I_QB + I_KVB;
constexpr int CV_NE = I_L + 2 * I_F1 + I_F2, CV_NQ1 = CV_NE + I_L, CV_NALL = CV_NQ1 + NEXP * (2 * I_M1 + I_M2);
DI CvDesc conv_decode(Frame& F, int it) {
    int r = it;
    if (r >= CV_NQ1) { r -= CV_NQ1;
        if (r < NEXP * 2 * I_M1) { const int e = r / (2 * I_M1); r -= e * 2 * I_M1; const int which = r / I_M1; r -= which * I_M1; const int kb = r / 112, nb = r % 112;
            return CvDesc{(which ? F.in[33] : F.in[32]) + (size_t)e * D * FE, WSP(bf16, WS_MW13) + (size_t)e * 2 * FE * D, (size_t)(FE), (size_t)(D), D, FE, 64 * kb, 64 * nb, il_row(64 * nb, which)}; }
        r -= NEXP * 2 * I_M1;
        { const int e = r / I_M2; r -= e * I_M2; const int kb = r / 32, nb = r % 32;
            return CvDesc{F.in[34] + (size_t)e * FE * D, WSP(bf16, WS_MW2) + (size_t)e * D * FE, (size_t)(D), (size_t)(FE), FE, D, 64 * kb, 64 * nb, 64 * nb}; }
    }
    int l = 0;
    if (r >= CV_NE) { r -= CV_NE; l = 1; }
    else if (r >= I_L) { r -= I_L;
        if (r < 2 * I_F1) { const int which = r / I_F1; r -= which * I_F1; const int kb = r / 88, nb = r % 88;
            return CvDesc{(which ? F.in[29] : F.in[28]), WSP(bf16, WS_W13), (size_t)(FF), (size_t)(D), D, FF, 64 * kb, 64 * nb, il_row(64 * nb, which)}; }
        r -= 2 * I_F1;
        { const int kb = r / 32, nb = r % 32; return CvDesc{F.in[30], WSP(bf16, WS_W2), (size_t)(D), (size_t)(FF), FF, D, 64 * kb, 64 * nb, 64 * nb}; }
    }
    if (r < I_IN) { const int kb = r / 92, nb = r % 92;
        return CvDesc{F.in[7] + (size_t)l * D * DIN, WSP(bf16, WS_WIN) + (size_t)l * DINP * D, (size_t)(DIN), (size_t)(D), D, DIN, 64 * kb, 64 * nb, 64 * nb}; }
    r -= I_IN;
    if (r < I_OUT) { const int kb = r / 32, nb = r % 32;
        return CvDesc{F.in[8] + (size_t)l * D * D, WSP(bf16, WS_WOUT) + (size_t)l * D * D, (size_t)(D), (size_t)(D), D, D, 64 * kb, 64 * nb, 64 * nb}; }
    r -= I_OUT;
    if (r < I_QB) { const int kb = r / 12, nb = r % 12;
        return CvDesc{F.in[19] + (size_t)l * 448 * 768, WSP(bf16, WS_WQB) + (size_t)l * 768 * 512, (size_t)(768), (size_t)(512), 448, 768, 64 * kb, 64 * nb, 64 * nb}; }
    r -= I_QB;
    { const int kb = r / 16, nb = r % 16;
        return CvDesc{F.in[21] + (size_t)l * 160 * 1024, WSP(bf16, WS_WKVB) + (size_t)l * 1024 * 256, (size_t)(1024), (size_t)(256), 160, 1024, 64 * kb, 64 * nb, 64 * nb}; }
}

DI void conv_item(Frame& F, int it, LAS float* scr) { const CvDesc d = conv_decode(F, it); f32x4 v[16]; tr_load(d, v, F.lane); tr_lds(v, scr, F.lane); tr_out(d, scr, F.lane); }
DI void conv_items(Frame& F, int it0, int n, LAS float* scr) {
    if (it0 >= CV_NALL) return;
    if (it0 + n > CV_NALL) n = CV_NALL - it0;
    CvDesc d = conv_decode(F, it0); f32x4 v[16]; tr_load(d, v, F.lane);
    for (int k = 0; k < n; ++k) {
        tr_lds(v, scr, F.lane);
        CvDesc dn = d;
        if (k + 1 < n) { dn = conv_decode(F, it0 + k + 1); tr_load(dn, v, F.lane); }
        tr_out(d, scr, F.lane);
        d = dn;
    }
}
DI void p0_prologue(Frame& F) {
    {
        LAS float* sc = (LAS float*)F.lds;
        LAS float* red = (LAS float*)(F.lds + 5 * 2048 * 4);
        bool have = false;
        for (int u = F.bid; u < 2 * 96; u += F.G) {
            if (!have) {
                float cv[20];
#pragma unroll
                for (int k = 0; k < 20; ++k) { const int i = F.tid + NTHR * k; cv[k] = (i < 4 * 2048) ? F.in[1][i] : F.in[3][i - 4 * 2048]; }
                PIN8(cv); PIN8(cv + 8); PIN4(cv + 16);
#pragma unroll
                for (int k = 0; k < 20; ++k) sc[F.tid + NTHR * k] = siluf(cv[k]);
                have = true;
            }
            __syncthreads();
            const int l = u / 96, j0 = (u % 96) * 128;
            const float* W = F.in[4] + (size_t)l * D * D6 + j0 + 2 * F.lane;
            f32x2 acc[5];
#pragma unroll
            for (int r = 0; r < 5; ++r) acc[r] = (f32x2){0.f, 0.f};
            const int kb = F.wave * 256;
            for (int k = 0; k < 256; k += 8) {
                f32x2 w[8];
#pragma unroll
                for (int i = 0; i < 8; ++i) w[i] = *(const f32x2*)(W + (size_t)(kb + k + i) * D6);
#pragma unroll
                for (int i = 0; i < 8; ++i)
#pragma unroll
                    for (int r = 0; r < 5; ++r) { const float s = sc[r * 2048 + kb + k + i]; acc[r] += w[i] * s; }
            }
#pragma unroll
            for (int r = 0; r < 5; ++r) { red[(F.wave * 5 + r) * 128 + 2 * F.lane] = acc[r][0]; red[(F.wave * 5 + r) * 128 + 2 * F.lane + 1] = acc[r][1]; }
            __syncthreads();
            for (int i = F.tid; i < 5 * 128; i += NTHR) { const int r = i / 128, j = i % 128; float s = F.in[5][l * D6 + j0 + j];
#pragma unroll
                for (int w = 0; w < 8; ++w) s += red[(w * 5 + r) * 128 + j];
                WSP(float, WS_MOD)[(l * 5 + r) * D6 + j0 + j] = s; }
        }
        __syncthreads();
    }
    LAS float* scr = (LAS float*)(F.lds + F.wave * 16640);
    const int gw = F.bid * NWAVES + F.wave, NGW = F.G * NWAVES;
    for (int it = gw; it < I_L; it += NGW) conv_item(F, it, scr);
}

constexpr int CV_EAGER = I_L;
constexpr int CV_NDEF = CV_NALL - CV_EAGER;
DI void conv_fill(Frame& F, int phase, bool work) {
    LAS float* scr = (LAS float*)(F.lds + F.wave * 16640);
    volatile LAS int* bc = (volatile LAS int*)(F.lds + MISC_OFF) + 16;
    unsigned* ctl = WSP(unsigned, WS_CTL);
    __syncthreads();
    if (F.tid == 0) __hip_atomic_fetch_add(ctl + CW_ARR + 64 * phase, 1u, RLX_AGENT);
    if (!work) return;
    for (;;) {
        if (F.tid == 0) {
            int base = -1;
            if (__hip_atomic_load(ctl + CW_ARR + 64 * phase, RLX_AGENT) < (unsigned)F.G) { base = (int)__hip_atomic_fetch_add(ctl + CW_QH, 32u, RLX_AGENT); if (base >= CV_NDEF) base = -1; }
            bc[0] = base;
        }
        __syncthreads();
        const int base = bc[0];
        __syncthreads();
        if (base < 0) break;
        conv_items(F, CV_EAGER + base + F.wave * 4, 4, scr);
    }
}
DI void conv_drain(Frame& F, int upto) {
    LAS float* scr = (LAS float*)(F.lds + F.wave * 16640);
    volatile LAS int* bc = (volatile LAS int*)(F.lds + MISC_OFF) + 16;
    unsigned* ctl = WSP(unsigned, WS_CTL);
    __syncthreads();
    for (;;) {
        if (F.tid == 0) {
            int base = -1;
            if ((int)__hip_atomic_load(ctl + CW_QH, RLX_AGENT) < upto) { base = (int)__hip_atomic_fetch_add(ctl + CW_QH, 64u, RLX_AGENT); if (base >= CV_NDEF) base = -1; }
            bc[0] = base;
        }
        __syncthreads();
        const int base = bc[0];
        __syncthreads();
        if (base < 0) break;
        conv_items(F, CV_EAGER + base + F.wave * 8, 8, scr);
    }
}
template <bool ROUTE>
DI void norm_phase(Frame& F, int l, const float* srcLat, const float* srcCtx, const float* g, int shoff, int nrows) {
    LAS float* rl = (LAS float*)F.lds;
    if (ROUTE) {
        f32x4 rv[8];
#pragma unroll
        for (int i = 0; i < 8; ++i) rv[i] = *(const f32x4*)(F.in[31] + 4 * (F.tid + NTHR * i));
#pragma unroll
        for (int i = 0; i < 8; ++i) PINV(rv[i]);
#pragma unroll
        for (int i = 0; i < 8; ++i) *(LAS f32x4*)(rl + 4 * (F.tid + NTHR * i)) = rv[i];
        __syncthreads(); }
    const int gw = F.bid * NWAVES + F.wave, NGW = F.G * NWAVES;
    bf16* HN = WSP(bf16, WS_HN);
    f32x4 gv[8];
#pragma unroll
    for (int j = 0; j < 8; ++j) gv[j] = *(const f32x4*)(g + 4 * F.lane + 256 * j);
    for (int row = gw; row < nrows; row += NGW) {
        const float* xr = row < MLAT ? srcLat + (size_t)row * D : srcCtx + (size_t)(row - MLAT) * D;
        const int br = row < MLAT ? row / TL : 4;
        const float* mrow = WSP(float, WS_MOD) + (size_t)(l * 5 + br) * D6 + shoff;
        f32x4 v[8], shv[8], scv[8]; float ss = 0.f;
#pragma unroll
        for (int j = 0; j < 8; ++j) { const int c = 4 * F.lane + 256 * j; v[j] = *(const f32x4*)(xr + c); shv[j] = *(const f32x4*)(mrow + c); scv[j] = *(const f32x4*)(mrow + D + c); }
#pragma unroll
        for (int j = 0; j < 8; ++j) { PINV(v[j]); PINV(shv[j]); PINV(scv[j]); }
#pragma unroll
        for (int j = 0; j < 8; ++j) ss += (v[j][0] * v[j][0] + v[j][1] * v[j][1]) + (v[j][2] * v[j][2] + v[j][3] * v[j][3]);
        const float rstd = 1.0f / sqrtf(wave_sum(ss) * (1.f / D) + EPS);
        float lg[8]; u32x2 wk[8];
        if (ROUTE) {
#pragma unroll
            for (int e = 0; e < 8; ++e) lg[e] = 0.f; }
#pragma unroll
        for (int j = 0; j < 8; ++j) { const int c = 4 * F.lane + 256 * j;
            const f32x4 gg = gv[j], sh = shv[j], sc = scv[j];
            f32x4 o;
#pragma unroll
            for (int i = 0; i < 4; ++i) o[i] = v[j][i] * rstd * gg[i] * (1.f + sc[i]) + sh[i];
            u32x2 w; w.x = pk2(o[0], o[1]); w.y = pk2(o[2], o[3]);
            if (ROUTE) wk[j] = w; else *(u32x2*)(HN + (size_t)row * D + c) = w;
            if (ROUTE) {
#pragma unroll
                for (int i = 0; i < 4; ++i) { const f32x4 r0 = *(const LAS f32x4*)(rl + (c + i) * 8), r1 = *(const LAS f32x4*)(rl + (c + i) * 8 + 4);
                    lg[0] += o[i] * r0[0]; lg[1] += o[i] * r0[1]; lg[2] += o[i] * r0[2]; lg[3] += o[i] * r0[3];
                    lg[4] += o[i] * r1[0]; lg[5] += o[i] * r1[1]; lg[6] += o[i] * r1[2]; lg[7] += o[i] * r1[3]; }
                __builtin_amdgcn_sched_barrier(0);
            }
        }
        if (ROUTE) {
#pragma unroll
            for (int e = 0; e < 8; ++e) lg[e] = wave_sum(lg[e]);
            int r1 = 0, r2 = 0;
            if (F.lane == 0) {
                int e1 = 0; float v1 = lg[0];
#pragma unroll
                for (int e = 1; e < 8; ++e) if (lg[e] > v1) { v1 = lg[e]; e1 = e; }
                int e2 = -1; float v2 = -3.0e38f;
#pragma unroll
                for (int e = 0; e < 8; ++e) if (e != e1 && lg[e] > v2) { v2 = lg[e]; e2 = e; }
                const float g2 = 1.f / (1.f + expf(v1 - v2)), g1 = 1.f - g2;
                unsigned* cnt = WSP(unsigned, WS_CTL) + CW_MOE;
                const unsigned p1 = __hip_atomic_fetch_add(cnt + e1, 1u, RLX_AGENT), p2 = __hip_atomic_fetch_add(cnt + e2, 1u, RLX_AGENT);
                int* tk = WSP(int, WS_TOK) + (size_t)row * 8;
                tk[0] = e1; tk[1] = (int)p1; tk[2] = e2; tk[3] = (int)p2; ((float*)tk)[4] = g1; ((float*)tk)[5] = g2;
                r1 = e1 * MLAT + (int)p1; r2 = e2 * MLAT + (int)p2;
            }
            r1 = __shfl(r1, 0); r2 = __shfl(r2, 0);
            bf16* XS = WSP(bf16, WS_XG);
#pragma unroll
            for (int j = 0; j < 8; ++j) { const int c = 4 * F.lane + 256 * j; *(u32x2*)(XS + (size_t)r1 * D + c) = wk[j]; *(u32x2*)(XS + (size_t)r2 * D + c) = wk[j]; }
        }
    }
}

DI void moe_tables(Frame& F, LAS int* tb, int NT) {
    if (F.tid == 0) {
        const unsigned* cnt = WSP(unsigned, WS_CTL) + CW_MOE; int ts = 0, us = 0;
        for (int e = 0; e < 8; ++e) { const int c = (int)__hip_atomic_load(cnt + e, RLX_AGENT); const int t = (c + 255) >> 8; tb[e] = c; tb[8 + e] = t; tb[16 + e] = ts; tb[32 + e] = us; ts += t; us += t * NT; }
        tb[24] = ts; tb[40] = us;
    }
    __syncthreads();
}
DI void moe_combine_phase(Frame& F, int l) {
    LAS int* tb = (LAS int*)F.lds; __syncthreads(); moe_tables(F, tb, 1);
    const int gw = F.bid * NWAVES + F.wave, NGW = F.G * NWAVES;
    const float* Y = WSP(float, WS_Y); const float* X = WSP(float, WS_X);
    for (int row = gw; row < MLAT; row += NGW) {
        const int* tk = WSP(int, WS_TOK) + (size_t)row * 8;
        const float g1 = ((const float*)tk)[4], g2 = ((const float*)tk)[5];
        const int s1 = tb[16 + tk[0]] * 256 + tk[1], s2 = tb[16 + tk[2]] * 256 + tk[3];
        const float* mrow = WSP(float, WS_MOD) + (size_t)(l * 5 + row / TL) * D6 + 5 * D;
        f32x4 xv[8], y1[8], y2[8], gq[8];
#pragma unroll
        for (int j = 0; j < 8; ++j) { const int c = 4 * F.lane + 256 * j;
            xv[j] = *(const f32x4*)(X + (size_t)row * D + c); y1[j] = *(const f32x4*)(Y + (size_t)s1 * D + c); y2[j] = *(const f32x4*)(Y + (size_t)s2 * D + c); gq[j] = *(const f32x4*)(mrow + c); }
#pragma unroll
        for (int j = 0; j < 8; ++j) { PINV(xv[j]); PINV(y1[j]); PINV(y2[j]); PINV(gq[j]); }
#pragma unroll
        for (int j = 0; j < 8; ++j) { const int c = 4 * F.lane + 256 * j; const f32x4 gg = gq[j];
            *(f32x4*)(F.out + (size_t)row * D + c) = xv[j] + gg * (y1[j] * g1 + y2[j] * g2); }
    }
}
using pg8::Unit;
struct EpiF32 {
    static constexpr bool PERM = false;
    float* C; int ldc;
    DI void operator()(const f32x4 (&acc)[2][2][4][2], const Unit& u, int wr, int wc, int fr, int fq) const {
        const int row0 = u.pm * 256 + wr * 64 + fr, col0 = u.pn * 256 + wc * 32 + 4 * fq;
#pragma unroll
        for (int ai = 0; ai < 2; ++ai)
#pragma unroll
            for (int m = 0; m < 4; ++m) { float* rowp = C + (size_t)(row0 + ai * 128 + m * 16) * ldc + col0;
#pragma unroll
                for (int bj = 0; bj < 2; ++bj)
#pragma unroll
                    for (int n = 0; n < 2; ++n) *(f32x4*)(rowp + bj * 128 + n * 16) = acc[ai][bj][m][n]; }
    }
};
struct EpiBf16 {
    static constexpr bool PERM = true;
    bf16* O; int ldc;
    DI void operator()(const f32x4 (&acc)[2][2][4][2], const Unit& u, int wr, int wc, int fr, int fq) const {
        const int row0 = u.pm * 256 + wr * 64 + fr, col0 = u.pn * 256 + wc * 32 + 8 * fq;
#pragma unroll
        for (int ai = 0; ai < 2; ++ai)
#pragma unroll
            for (int m = 0; m < 4; ++m) { bf16* rowp = O + (size_t)(row0 + ai * 128 + m * 16) * ldc + col0;
#pragma unroll
                for (int bj = 0; bj < 2; ++bj) { const f32x4 v0 = acc[ai][bj][m][0], v1 = acc[ai][bj][m][1];
                    u32x4 w; w.x = pg8::cvt_pk_bf16(v0[0], v0[1]); w.y = pg8::cvt_pk_bf16(v0[2], v0[3]); w.z = pg8::cvt_pk_bf16(v1[0], v1[1]); w.w = pg8::cvt_pk_bf16(v1[2], v1[3]);
                    *(u32x4*)(rowp + bj * 128) = w; } }
    }
};
struct EpiP {
    static constexpr bool PERM = true;
    bf16* O; float* graw;
    DI void operator()(const f32x4 (&acc)[2][2][4][2], const Unit& u, int wr, int wc, int fr, int fq) const {
        const int row0 = u.pm * 256 + wr * 64 + fr, col0 = u.pn * 256 + wc * 32 + 8 * fq;
#pragma unroll
        for (int ai = 0; ai < 2; ++ai)
#pragma unroll
            for (int m = 0; m < 4; ++m) { bf16* rowp = O + (size_t)(row0 + ai * 128 + m * 16) * DINP + col0;
#pragma unroll
                for (int bj = 0; bj < 2; ++bj) { const f32x4 v0 = acc[ai][bj][m][0], v1 = acc[ai][bj][m][1];
                    u32x4 w; w.x = pg8::cvt_pk_bf16(v0[0], v0[1]); w.y = pg8::cvt_pk_bf16(v0[2], v0[3]); w.z = pg8::cvt_pk_bf16(v1[0], v1[1]); w.w = pg8::cvt_pk_bf16(v1[2], v1[3]);
                    *(u32x4*)(rowp + bj * 128) = w; } }
        const bool gsel = (u.pn == 8 && wc == 0 && fq < 2), dsel = (u.pn == 14 && wc == 0 && fq >= 2);
        if (gsel || dsel) { const int off = gsel ? 8 * fq : 16 + 8 * (fq - 2);
#pragma unroll
            for (int ai = 0; ai < 2; ++ai)
#pragma unroll
                for (int m = 0; m < 4; ++m) { float* gp = graw + (size_t)(row0 + ai * 128 + m * 16) * 32 + off;
                    *(f32x4*)gp = acc[ai][0][m][0]; *(f32x4*)(gp + 4) = acc[ai][0][m][1]; } }
    }
};
struct EpiSwiglu {
    static constexpr bool PERM = true;
    bf16* O; int ldc;
    DI void operator()(const f32x4 (&acc)[2][2][4][2], const Unit& u, int wr, int wc, int fr, int fq) const {
        const int row0 = u.pm * 256 + wr * 64 + fr, col0 = u.pn * 128 + wc * 32 + 8 * fq;
#pragma unroll
        for (int ai = 0; ai < 2; ++ai)
#pragma unroll
            for (int m = 0; m < 4; ++m) { bf16* rowp = O + (size_t)(row0 + ai * 128 + m * 16) * ldc + col0;
                f32x4 v0, v1;
#pragma unroll
                for (int j = 0; j < 4; ++j) { v0[j] = siluf(acc[ai][0][m][0][j]) * acc[ai][1][m][0][j]; v1[j] = siluf(acc[ai][0][m][1][j]) * acc[ai][1][m][1][j]; }
                u32x4 w; w.x = pg8::cvt_pk_bf16(v0[0], v0[1]); w.y = pg8::cvt_pk_bf16(v0[2], v0[3]); w.z = pg8::cvt_pk_bf16(v1[0], v1[1]); w.w = pg8::cvt_pk_bf16(v1[2], v1[3]);
                *(u32x4*)rowp = w; }
    }
};
struct EpiResid {
    static constexpr bool PERM = false;
    const float* baseLat; const float* baseCtx; float* out; const float* mod;
    DI void operator()(const f32x4 (&acc)[2][2][4][2], const Unit& u, int wr, int wc, int fr, int fq) const {
        const int row0 = u.pm * 256 + wr * 64 + fr, col0 = u.pn * 256 + wc * 32 + 4 * fq;
        const int br = (u.pm * 256 < MLAT) ? (u.pm * 256) / TL : 4;
        const float* gate = mod + (size_t)br * D6 + col0;
        f32x4 gv[2][2];
#pragma unroll
        for (int bj = 0; bj < 2; ++bj)
#pragma unroll
            for (int n = 0; n < 2; ++n) gv[bj][n] = *(const f32x4*)(gate + bj * 128 + n * 16);
#pragma unroll
        for (int ai = 0; ai < 2; ++ai)
#pragma unroll
            for (int mp = 0; mp < 2; ++mp) {
                f32x4 bv[2][2][2];
#pragma unroll
                for (int mi = 0; mi < 2; ++mi) { const int row = row0 + ai * 128 + (2 * mp + mi) * 16;
                    const float* bp = (row < MLAT ? baseLat + (size_t)row * D : baseCtx + (size_t)(row - MLAT) * D) + col0;
#pragma unroll
                    for (int bj = 0; bj < 2; ++bj)
#pragma unroll
                        for (int n = 0; n < 2; ++n) bv[mi][bj][n] = *(const f32x4*)(bp + bj * 128 + n * 16); }
#pragma unroll
                for (int mi = 0; mi < 2; ++mi)
#pragma unroll
                    for (int bj = 0; bj < 2; ++bj)
#pragma unroll
                        for (int n = 0; n < 2; ++n) PINV(bv[mi][bj][n]);
#pragma unroll
                for (int mi = 0; mi < 2; ++mi) { const int m = 2 * mp + mi, row = row0 + ai * 128 + m * 16; float* op = out + (size_t)row * D + col0;
#pragma unroll
                    for (int bj = 0; bj < 2; ++bj)
#pragma unroll
                        for (int n = 0; n < 2; ++n) *(f32x4*)(op + bj * 128 + n * 16) = bv[mi][bj][n] + gv[bj][n] * acc[ai][bj][m][n]; }
            }
    }
};
struct MoeOrder {
    const LAS int* tb; int NT, G, c, L0, nT, S, KS, acap;
    DI bool next(int i, Unit& u) const {
        const long T = (long)i * G + c; if (T >= nT) return false;
        const int nun = tb[40], L = L0 + (int)T / S, sl = (int)T % S;
        const int w = pg8::xcd_remap(L, nun); int e = 0;
#pragma unroll
        for (int k = 1; k < 8; ++k) if (w >= tb[32 + k]) e = k;
        const int rem = w - tb[32 + e], tiles = tb[8 + e], nt = rem / tiles, mtl = rem - nt * tiles;
        u.pm = tb[16 + e] + mtl; u.pn = nt; u.pb = e * NT + nt; u.koff = sl * KS; u.aux = (int)T; u.pa = acap ? e * acap + mtl : u.pm; return true;
    }
};
struct EpiPart {
    static constexpr bool PERM = false;
    float* part;
    DI void operator()(const f32x4 (&acc)[2][2][4][2], const Unit& u, int wr, int wc, int fr, int fq) const {
        f32x4* p = (f32x4*)part + (size_t)u.aux * (32 * NTHR) + threadIdx.x;
#pragma unroll
        for (int ai = 0; ai < 2; ++ai)
#pragma unroll
            for (int bj = 0; bj < 2; ++bj)
#pragma unroll
                for (int m = 0; m < 4; ++m)
#pragma unroll
                    for (int n = 0; n < 2; ++n) p[(size_t)(((ai * 2 + bj) * 4 + m) * 2 + n) * NTHR] = acc[ai][bj][m][n];
    }
};
template <int S> DI void splitk_reduce_f32(const float* part, int t, int cg, const Unit& u, float* C, int ldc) {
    const int tid = threadIdx.x, wid = tid >> 6, lane = tid & 63, wr = wid >> 2, wc = wid & 3, fr = lane & 15, fq = lane >> 4;
    f32x4 v[4][S];
#pragma unroll
    for (int k = 0; k < 4; ++k)
#pragma unroll
        for (int s = 0; s < S; ++s) v[k][s] = *((const f32x4*)part + ((size_t)(t * S + s) * 32 + (cg * 4 + k)) * NTHR + tid);
#pragma unroll
    for (int k = 0; k < 4; ++k) { const int ch = cg * 4 + k, n = ch & 1, m = (ch >> 1) & 3, bj = (ch >> 3) & 1, ai = ch >> 4;
        f32x4 a = v[k][0];
#pragma unroll
        for (int s = 1; s < S; ++s) a += v[k][s];
        *(f32x4*)(C + (size_t)(u.pm * 256 + ai * 128 + wr * 64 + m * 16 + fr) * ldc + u.pn * 256 + bj * 128 + wc * 32 + n * 16 + 4 * fq) = a; }
}
DI int tc_of(int dir, int p) { return dir == 0 ? (p < 4 ? 32 + p : p - 4) : 35 - p; }

DI void m1_prep_unit(Frame& F, int l, int b, int tt) {
    const bf16* P = WSP(bf16, WS_P); const float* GR = WSP(float, WS_GRAW);
    const int j0 = tt * 32, lane = F.lane;
    LAS bf16* vs = (LAS bf16*)F.lds;
    float qnv[7], knv[3], gqv[2], gkv[2];
#pragma unroll
    for (int u = 0; u < 7; ++u) qnv[u] = F.in[18][l * 448 + lane + 64 * u];
#pragma unroll
    for (int u = 0; u < 3; ++u) knv[u] = (lane + 64 * u < 160) ? F.in[20][l * 160 + lane + 64 * u] : 0.f;
    gqv[0] = F.in[24][l * 128 + lane]; gqv[1] = F.in[24][l * 128 + 64 + lane]; gkv[0] = F.in[25][l * 128 + lane]; gkv[1] = F.in[25][l * 128 + 64 + lane];
    const float ib = lane < 8 ? F.in[9][l * 8 + lane] : 0.f, fb = lane < 8 ? F.in[10][l * 8 + lane] : 0.f, db = lane < 16 ? F.in[14][l * 16 + lane] : 0.f;
    for (int i = F.wave; i < 32; i += 8) {
        const int j = j0 + i, row = rowof(b, j);
        const bf16* p = P + (size_t)row * DINP; const float* gr = GR + (size_t)row * 32;
        unsigned cqw[7], ckw[3], nqw[4][2], nkw[4][2], nvw[8];
#pragma unroll
        for (int u = 0; u < 7; ++u) cqw[u] = p[PC_CQ + lane + 64 * u];
#pragma unroll
        for (int u = 0; u < 3; ++u) { const int idx = lane + 64 * u; ckw[u] = idx < 160 ? (unsigned)p[PC_CKV + idx] : 0u; }
#pragma unroll
        for (int h = 0; h < 4; ++h) { nqw[h][0] = p[PC_NQ + h * 128 + lane]; nqw[h][1] = p[PC_NQ + h * 128 + 64 + lane]; nkw[h][0] = p[PC_NK + h * 128 + lane]; nkw[h][1] = p[PC_NK + h * 128 + 64 + lane]; }
#pragma unroll
        for (int u = 0; u < 8; ++u) nvw[u] = p[PC_NV + lane + 64 * u];
        float gi = lane < 8 ? gr[lane] : 0.f, gf = lane < 8 ? gr[8 + lane] : 0.f, gd = lane < 16 ? gr[16 + lane] : 0.f;
        PIN4(cqw); PINV(cqw[4]); PINV(cqw[5]); PINV(cqw[6]); PINV(ckw[0]); PINV(ckw[1]); PINV(ckw[2]); PIN8(nvw); PINV(gi); PINV(gf); PINV(gd);
#pragma unroll
        for (int h = 0; h < 4; ++h) { PINV(nqw[h][0]); PINV(nqw[h][1]); PINV(nkw[h][0]); PINV(nkw[h][1]); }
        float cq[7], ckv[3], nq[4][2], nk[4][2]; bf16 nv[8];
#pragma unroll
        for (int u = 0; u < 7; ++u) cq[u] = bf2f(cqw[u]);
#pragma unroll
        for (int u = 0; u < 3; ++u) ckv[u] = bf2f(ckw[u]);
#pragma unroll
        for (int h = 0; h < 4; ++h) { nq[h][0] = bf2f(nqw[h][0]); nq[h][1] = bf2f(nqw[h][1]); nk[h][0] = bf2f(nkw[h][0]); nk[h][1] = bf2f(nkw[h][1]); }
#pragma unroll
        for (int u = 0; u < 8; ++u) nv[u] = (bf16)nvw[u];
        {
            float ss = 0.f;
#pragma unroll
            for (int u = 0; u < 7; ++u) ss += cq[u] * cq[u];
            const float rstd = 1.0f / sqrtf(wave_sum(ss) * (1.f / 448.f) + EPS);
            bf16* o = WSP(bf16, WS_CQN) + (size_t)row * 512;
#pragma unroll
            for (int u = 0; u < 7; ++u) o[lane + 64 * u] = (bf16)f2bf(cq[u] * rstd * qnv[u]);
            o[448 + lane] = 0;
        }
        {
            float ss = 0.f;
#pragma unroll
            for (int u = 0; u < 3; ++u) ss += ckv[u] * ckv[u];
            const float rstd = 1.0f / sqrtf(wave_sum(ss) * (1.f / 160.f) + EPS);
            bf16* o = WSP(bf16, WS_CKVN) + (size_t)row * 256;
#pragma unroll
            for (int u = 0; u < 3; ++u) { const int idx = lane + 64 * u; o[idx] = idx < 160 ? (bf16)f2bf(ckv[u] * rstd * knv[u]) : (bf16)0; }
            o[192 + lane] = 0;
        }
#pragma unroll
        for (int h = 0; h < 4; ++h) {
            const float rq = 1.0f / sqrtf(wave_sum(nq[h][0] * nq[h][0] + nq[h][1] * nq[h][1]) * (1.f / 128.f) + EPS);
            const float rk = 1.0f / sqrtf(wave_sum(nk[h][0] * nk[h][0] + nk[h][1] * nk[h][1]) * (1.f / 128.f) + EPS);
            bf16* oq = WSP(bf16, WS_QNA) + ((size_t)(b * 4 + h) * TS + j) * 128; bf16* ok = WSP(bf16, WS_KNA) + ((size_t)(b * 4 + h) * TS + j) * 128;
            oq[lane] = (bf16)f2bf(nq[h][0] * rq * gqv[0]); oq[64 + lane] = (bf16)f2bf(nq[h][1] * rq * gqv[1]);
            ok[lane] = (bf16)f2bf(nk[h][0] * rk * gkv[0]); ok[64 + lane] = (bf16)f2bf(nk[h][1] * rk * gkv[1]);
        }
#pragma unroll
        for (int u = 0; u < 8; ++u) vs[i * 520 + lane + 64 * u] = nv[u];
        if (lane < 8) {
            float* gt = WSP(float, WS_GATES) + (size_t)row * 16;
            gt[lane] = gi + ib;
            gt[8 + lane] = logsigmoidf_(gf + fb);
        }
        if (lane < 16) WSP(float, WS_DT)[(size_t)row * 16 + lane] = softplusf_(gd + db);
    }
    {
        const int ch = 2 * F.tid;
        const int seglo = j0 < TL ? 0 : TL, seghi = j0 < TL ? TL : TS;
        const float* cw = F.in[12] + (size_t)l * 5 * 1024 + ch; const float* cb = F.in[13] + (size_t)l * 1024 + ch;
        f32x2 w[5];
#pragma unroll
        for (int d = 0; d < 5; ++d) w[d] = *(const f32x2*)(cw + d * 1024);
        const f32x2 bias = *(const f32x2*)cb;
        unsigned xww[36];
#pragma unroll
        for (int d = 0; d < 36; ++d) { const int jj = j0 - 2 + d; xww[d] = 0u; if (jj >= seglo && jj < seghi) xww[d] = *(const unsigned*)(P + (size_t)rowof(b, jj) * DINP + PC_XBC + ch); }
        PIN8(xww); PIN8(xww + 8); PIN8(xww + 16); PIN8(xww + 24); PIN4(xww + 32);
        f32x2 xin[36];
#pragma unroll
        for (int d = 0; d < 36; ++d) xin[d] = (f32x2){bf2f(xww[d] & 0xffffu), bf2f(xww[d] >> 16)};
#pragma unroll
        for (int i = 0; i < 32; ++i) {
            f32x2 a = bias;
#pragma unroll
            for (int d = 0; d < 5; ++d) a += w[d] * xin[i + d];
            *(unsigned*)(WSP(bf16, WS_XBC) + (size_t)rowof(b, j0 + i) * 1024 + ch) = pk2(siluf(a[0]), siluf(a[1]));
        }
    }
    __syncthreads();
    {
        const int t = F.tid; unsigned wv[16];
#pragma unroll
        for (int i = 0; i < 16; ++i) wv[i] = (unsigned)vs[(2 * i) * 520 + t] | ((unsigned)vs[(2 * i + 1) * 520 + t] << 16);
        u32x4* dst = (u32x4*)(WSP(bf16, WS_VTNA) + ((size_t)(b * 4 + (t >> 7)) * 128 + (t & 127)) * TS + j0);
#pragma unroll
        for (int k = 0; k < 4; ++k) dst[k] = (u32x4){wv[4 * k], wv[4 * k + 1], wv[4 * k + 2], wv[4 * k + 3]};
    }
    __syncthreads();
}

DI void ml_a_unit(Frame& F, int seq, int p) {
    const int b = seq >> 3, h = (seq >> 1) & 3, dir = seq & 1, tc = tc_of(dir, p), lane = F.lane;
    const bf16* P = WSP(bf16, WS_P);
    LAS bf16* VW = (LAS bf16*)F.lds;
    LAS bf16* KT = (LAS bf16*)(F.lds + 20736);
    LAS float* wgs = (LAS float*)(F.lds + 39168);
    if (F.wave == 0) {
        const int row = rowof(b, tc * 64 + lane);
        const float* gt = WSP(float, WS_GATES) + (size_t)row * 16;
        const float li = gt[dir * 4 + h], lf = gt[8 + dir * 4 + h];
        const float pre = wave_incl_scan(lf, lane), tot = __shfl(pre, 63);
        const float g = dir == 0 ? (tot - pre) + li : (pre - lf) + li;
        const float mloc = wave_max(g);
        wgs[lane] = __expf(g - mloc);
        if (lane == 0) { float* sc = WSP(float, WS_MLSC) + (size_t)(seq * 36 + p) * 4; sc[0] = tot; sc[1] = mloc; }
    }
    {
        unsigned vw[16], kw[16];
#pragma unroll
        for (int it = 0; it < 16; ++it) { const int idx = F.tid + NTHR * it, n = idx >> 7, d = idx & 127;
            const bf16* pr = P + (size_t)rowof(b, tc * 64 + n) * DINP + h * 128 + d; vw[it] = pr[PC_MLV]; kw[it] = pr[PC_MLK]; }
        PIN8(vw); PIN8(vw + 8); PIN8(kw); PIN8(kw + 8);
        float vv[16]; bf16 kk[16];
#pragma unroll
        for (int it = 0; it < 16; ++it) { vv[it] = bf2f(vw[it]); kk[it] = (bf16)kw[it]; }
        __syncthreads();
#pragma unroll
        for (int it = 0; it < 16; ++it) { const int idx = F.tid + NTHR * it, n = idx >> 7, d = idx & 127;
            VW[d * 72 + n] = (bf16)f2bf(vv[it] * wgs[n]); KT[d * 72 + n] = kk[it]; }
    }
    for (int idx = F.tid; idx < 16 * 64; idx += NTHR) { const int rr = idx >> 6, n = idx & 63; VW[(128 + rr) * 72 + n] = rr == 0 ? (bf16)f2bf(wgs[n]) : (bf16)0; }
    __syncthreads();
    float* U = WSP(float, WS_MLU) + (size_t)(seq * 36 + p) * (129 * 128);
    for (int id = F.wave; id < 72; id += 8) { const int dt = id >> 3, et = id & 7;
        const f32x4 acc = mma16<64>(VW + dt * 16 * 72, 72, KT + et * 16 * 72, 72, lane, (f32x4){0.f, 0.f, 0.f, 0.f});
#pragma unroll
        for (int i = 0; i < 4; ++i) { const int d = dt * 16 + 4 * (lane >> 4) + i; if (d < 129) U[d * 128 + et * 16 + (lane & 15)] = acc[i]; } }
    __syncthreads();
}

DI void ss_a_unit(Frame& F, int l, int b, int dir, int p, int g) {
    const int tc = tc_of(dir, p), lane = F.lane;
    LAS bf16* XT = (LAS bf16*)F.lds;
    LAS bf16* BT = (LAS bf16*)(F.lds + 36864);
    LAS float* tails = (LAS float*)(F.lds + 55296);
    const bf16* XBC = WSP(bf16, WS_XBC);
    if (F.wave < 4) {
        const int h = 4 * g + F.wave, row = rowof(b, tc * 64 + lane);
        const float dt = WSP(float, WS_DT)[(size_t)row * 16 + dir * 8 + h];
        const float A = -__expf(F.in[15][l * 16 + dir * 8 + h]);
        const float a = dt * A, pre = wave_incl_scan(a, lane), tot = __shfl(pre, 63);
        tails[F.wave * 64 + lane] = (dir == 0 ? __expf(tot - pre) : __expf(pre - a)) * dt;
        if (lane == 0) WSP(float, WS_SSSC)[(size_t)((b * 8 + h) * 2 + dir) * 36 + p] = __expf(tot);
    }
    {
        unsigned xv[32], bv[16];
#pragma unroll
        for (int it = 0; it < 32; ++it) { const int idx = F.tid + NTHR * it, n = idx >> 8, c = idx & 255; xv[it] = XBC[(size_t)rowof(b, tc * 64 + n) * 1024 + g * 256 + c]; }
#pragma unroll
        for (int it = 0; it < 16; ++it) { const int idx = F.tid + NTHR * it, n = idx >> 7, nn = idx & 127; bv[it] = XBC[(size_t)rowof(b, tc * 64 + n) * 1024 + 512 + g * 128 + nn]; }
        PIN8(xv); PIN8(xv + 8); PIN8(xv + 16); PIN8(xv + 24); PIN8(bv); PIN8(bv + 8);
        __syncthreads();
#pragma unroll
        for (int it = 0; it < 32; ++it) { const int idx = F.tid + NTHR * it, n = idx >> 8, c = idx & 255; XT[c * 72 + n] = (bf16)f2bf(bf2f(xv[it]) * tails[(c >> 6) * 64 + n]); }
#pragma unroll
        for (int it = 0; it < 16; ++it) { const int idx = F.tid + NTHR * it, n = idx >> 7, nn = idx & 127; BT[nn * 72 + n] = (bf16)bv[it]; }
    }
    __syncthreads();
    for (int id = F.wave; id < 128; id += 8) { const int hh = id >> 5, rem = id & 31, pt = rem >> 3, nt = rem & 7;
        const f32x4 acc = mma16<64>(XT + (hh * 64 + pt * 16) * 72, 72, BT + nt * 16 * 72, 72, lane, (f32x4){0.f, 0.f, 0.f, 0.f});
        float* U = WSP(float, WS_SSU) + (size_t)(((b * 8 + 4 * g + hh) * 2 + dir) * 36 + p) * 8192;
#pragma unroll
        for (int i = 0; i < 4; ++i) U[(pt * 16 + 4 * (lane >> 4) + i) * 128 + nt * 16 + (lane & 15)] = acc[i]; }
    __syncthreads();
}
DI void ml_scan_unit(Frame& F, int seq, int s4) {
    float* sc = WSP(float, WS_MLSC) + (size_t)seq * 36 * 4;
    const float* U = WSP(float, WS_MLU) + (size_t)seq * 36 * 16512 + s4 * 4128 + F.tid; bf16* S = WSP(bf16, WS_MLS) + (size_t)seq * 36 * 16512 + s4 * 4128 + F.tid;
    float st[9]; float m = 0.f;
#pragma unroll
    for (int k = 0; k < 9; ++k) st[k] = 0.f;
    for (int pg = 0; pg < 36; pg += 12) {
        float u[12][9];
#pragma unroll
        for (int pp = 0; pp < 12; ++pp)
#pragma unroll
            for (int k = 0; k < 9; ++k) u[pp][k] = (F.tid + 512 * k < 4128) ? U[(size_t)(pg + pp) * 16512 + 512 * k] : 0.f;
#pragma unroll
        for (int pp = 0; pp < 12; ++pp) { PIN8(u[pp]); PINV(u[pp][8]); }
#pragma unroll
        for (int pp = 0; pp < 12; ++pp) { const int p = pg + pp;
            const float bl = sc[p * 4], mloc = sc[p * 4 + 1];
            const float mn = fmaxf(bl + m, mloc), wc = __expf(bl + m - mn), wu = __expf(mloc - mn);
            if (s4 == 0 && F.tid == 0) sc[p * 4 + 2] = m;
#pragma unroll
            for (int k = 0; k < 9; ++k) { if (F.tid + 512 * k < 4128) S[(size_t)p * 16512 + 512 * k] = (bf16)f2bf(st[k]); st[k] = wc * st[k] + wu * u[pp][k]; }
            m = mn; }
    }
}
DI void ss_scan_unit(Frame& F, int sq, int half) {
    const float* dec = WSP(float, WS_SSSC) + (size_t)sq * 36;
    const float* U = WSP(float, WS_SSU) + (size_t)sq * 36 * 8192 + half * 4096 + F.tid; bf16* S = WSP(bf16, WS_SSS) + (size_t)sq * 36 * 8192 + half * 4096 + F.tid;
    float st[8];
#pragma unroll
    for (int k = 0; k < 8; ++k) st[k] = 0.f;
    for (int pg = 0; pg < 36; pg += 12) {
        float u[12][8];
#pragma unroll
        for (int pp = 0; pp < 12; ++pp)
#pragma unroll
            for (int k = 0; k < 8; ++k) u[pp][k] = U[(size_t)(pg + pp) * 8192 + 512 * k];
#pragma unroll
        for (int pp = 0; pp < 12; ++pp) PIN8(u[pp]);
#pragma unroll
        for (int pp = 0; pp < 12; ++pp) { const int p = pg + pp; const float dc = dec[p];
#pragma unroll
            for (int k = 0; k < 8; ++k) { S[(size_t)p * 8192 + 512 * k] = (bf16)f2bf(st[k]); st[k] = st[k] * dc + u[pp][k]; } }
    }
}
DI void mla_post_unit(Frame& F, int l, int b, int tt) {
    const bf16* P = WSP(bf16, WS_P);
    const bf16* QRAW = WSP(bf16, WS_QRAW); const bf16* KVRAW = WSP(bf16, WS_KVRAW);
    const int j0 = tt * 32, lane = F.lane;
    LAS bf16* vs = (LAS bf16*)F.lds;
    const float* gq = F.in[22] + l * 192; const float* gk = F.in[23] + l * 192;
    unsigned qw[4][4][3], kw[4][4][2], vw[4][4][2], krw[4];
#pragma unroll
    for (int it = 0; it < 4; ++it) {
        const int row = rowof(b, j0 + F.wave + 8 * it);
        krw[it] = P[(size_t)row * DINP + PC_KR + lane];
#pragma unroll
        for (int h = 0; h < 4; ++h) { const bf16* q = QRAW + (size_t)row * 768 + h * 192; const bf16* kv = KVRAW + (size_t)row * 1024 + h * 256;
            qw[it][h][0] = q[lane]; qw[it][h][1] = q[64 + lane]; qw[it][h][2] = q[128 + lane];
            kw[it][h][0] = kv[lane]; kw[it][h][1] = kv[64 + lane]; vw[it][h][0] = kv[128 + lane]; vw[it][h][1] = kv[192 + lane]; }
    }
#pragma unroll
    for (int it = 0; it < 4; ++it) { PIN4(krw);
#pragma unroll
        for (int h = 0; h < 4; ++h) { PINV(qw[it][h][0]); PINV(qw[it][h][1]); PINV(qw[it][h][2]); PINV(kw[it][h][0]); PINV(kw[it][h][1]); PINV(vw[it][h][0]); PINV(vw[it][h][1]); } }
    float qv[4][4][3], kk[4][4][2], krv[4]; bf16 vv[4][4][2];
#pragma unroll
    for (int it = 0; it < 4; ++it) { krv[it] = bf2f(krw[it]);
#pragma unroll
        for (int h = 0; h < 4; ++h) { qv[it][h][0] = bf2f(qw[it][h][0]); qv[it][h][1] = bf2f(qw[it][h][1]); qv[it][h][2] = bf2f(qw[it][h][2]);
            kk[it][h][0] = bf2f(kw[it][h][0]); kk[it][h][1] = bf2f(kw[it][h][1]); vv[it][h][0] = (bf16)vw[it][h][0]; vv[it][h][1] = (bf16)vw[it][h][1]; } }
    const float gq0 = gq[lane], gq1 = gq[64 + lane], gq2 = gq[128 + lane], gk0 = gk[lane], gk1 = gk[64 + lane], gk2 = gk[128 + lane];
    const int a = lane & 31;
    const float fr = exp2f(-(float)(a & 15) * (13.287712379549449f / 16.f));
#pragma unroll
    for (int it = 0; it < 4; ++it) {
        const int i = F.wave + 8 * it, j = j0 + i; const bool lat = j < TL;
        const float pos = (float)(a < 16 ? (j >> 6) : (j & 63));
        const float ang = pos * fr; const float cs = __cosf(ang), sn = __sinf(ang);
#pragma unroll
        for (int h = 0; h < 4; ++h) {
            {
                const float v0 = qv[it][h][0], v1 = qv[it][h][1], v2 = qv[it][h][2];
                const float rstd = 1.0f / sqrtf(wave_sum(v0 * v0 + v1 * v1 + v2 * v2) * (1.f / 192.f) + EPS);
                const float n0 = v0 * rstd * gq0, n1 = v1 * rstd * gq1; float n2 = v2 * rstd * gq2;
                const float pr = __shfl_xor(n2, 32);
                if (lat) n2 = lane < 32 ? n2 * cs - pr * sn : pr * sn + n2 * cs;
                bf16* o = WSP(bf16, WS_QMLA) + ((size_t)(b * 4 + h) * TS + j) * 192;
                o[lane] = (bf16)f2bf(n0); o[64 + lane] = (bf16)f2bf(n1); o[128 + lane] = (bf16)f2bf(n2);
            }
            {
                const float v0 = kk[it][h][0], v1 = kk[it][h][1], v2 = krv[it];
                const float rstd = 1.0f / sqrtf(wave_sum(v0 * v0 + v1 * v1 + v2 * v2) * (1.f / 192.f) + EPS);
                const float n0 = v0 * rstd * gk0, n1 = v1 * rstd * gk1; float n2 = v2 * rstd * gk2;
                const float pr = __shfl_xor(n2, 32);
                if (lat) n2 = lane < 32 ? n2 * cs - pr * sn : pr * sn + n2 * cs;
                bf16* o = WSP(bf16, WS_KMLA) + ((size_t)(b * 4 + h) * TS + j) * 192;
                o[lane] = (bf16)f2bf(n0); o[64 + lane] = (bf16)f2bf(n1); o[128 + lane] = (bf16)f2bf(n2);
                vs[i * 520 + h * 128 + lane] = vv[it][h][0]; vs[i * 520 + h * 128 + 64 + lane] = vv[it][h][1];
            }
        }
    }
    __syncthreads();
    {
        const int t = F.tid; unsigned wv[16];
#pragma unroll
        for (int i = 0; i < 16; ++i) wv[i] = (unsigned)vs[(2 * i) * 520 + t] | ((unsigned)vs[(2 * i + 1) * 520 + t] << 16);
        u32x4* dst = (u32x4*)(WSP(bf16, WS_VTMLA) + ((size_t)(b * 4 + (t >> 7)) * 128 + (t & 127)) * TS + j0);
#pragma unroll
        for (int k = 0; k < 4; ++k) dst[k] = (u32x4){wv[4 * k], wv[4 * k + 1], wv[4 * k + 2], wv[4 * k + 3]};
    }
    __syncthreads();
}

template <int DK, bool NA>
DI void attn_unit(Frame& F, const bf16* Qg, const bf16* Kg, const bf16* VTg, int nA, int tA0, int nB, int tB0, float scale, bf16* Og, int qrow0, const float* rpb) {
    constexpr int KP = DK + 8, KCH = DK / 8, NKC = 64 * KCH / NTHR;
    LAS bf16* Ks = (LAS bf16*)F.lds;
    LAS bf16* VTs = (LAS bf16*)(F.lds + 64 * KP * 2);
    LAS bf16* Ps = (LAS bf16*)(F.lds + 64 * KP * 2 + 128 * 72 * 2) + F.wave * (16 * 72);
    LAS float* rp = (LAS float*)(F.lds + 64 * KP * 2 + 128 * 72 * 2 + 8 * 16 * 72 * 2);
    const int lane = F.lane, r = lane & 15, q = lane >> 4, tid = F.tid, w = F.wave;
    if (NA) { for (int i = tid; i < 15 * 31; i += NTHR) rp[i] = rpb[i]; }
    bf16x8 qf[DK / 32];
#pragma unroll
    for (int kk = 0; kk < DK / 32; ++kk) qf[kk] = *(const bf16x8*)(Qg + (size_t)(w * 16 + r) * DK + 32 * kk + 8 * q);
    f32x4 o[8]; float mrow[4], lrow[4];
#pragma unroll
    for (int d = 0; d < 8; ++d) o[d] = (f32x4){0.f, 0.f, 0.f, 0.f};
#pragma unroll
    for (int i = 0; i < 4; ++i) { mrow[i] = -1.0e30f; lrow[i] = 0.f; }
    const int ntile = nA + nB;
    u32x4 kreg[NKC], vreg[2];
    const int rq = qrow0 + (w >> 2);
    const int r0 = rq - 4 < 0 ? 0 : (rq - 4 > 24 ? 24 : rq - 4);
#define ATT_LOAD(kt) do { _Pragma("unroll") for (int c = 0; c < NKC; ++c) { const int id = tid + NTHR * c, rr = id / KCH, cc = id % KCH; kreg[c] = *(const u32x4*)(Kg + (size_t)((kt) * 64 + rr) * DK + cc * 8); } \
        _Pragma("unroll") for (int c = 0; c < 2; ++c) { const int id = tid + NTHR * c, dd = id >> 3, cc = id & 7; vreg[c] = *(const u32x4*)(VTg + (size_t)dd * TS + (kt) * 64 + cc * 8); } } while (0)
    ATT_LOAD(nA > 0 ? tA0 : tB0);
    for (int it = 0; it < ntile; ++it) {
        const int kt = it < nA ? tA0 + it : tB0 + (it - nA);
        __syncthreads();
#pragma unroll
        for (int c = 0; c < NKC; ++c) { const int id = tid + NTHR * c, rr = id / KCH, cc = id % KCH; *(LAS u32x4*)(Ks + rr * KP + cc * 8) = kreg[c]; }
#pragma unroll
        for (int c = 0; c < 2; ++c) { const int id = tid + NTHR * c, dd = id >> 3, cc = id & 7; *(LAS u32x4*)(VTs + dd * 72 + cc * 8) = vreg[c]; }
        __syncthreads();
        if (it + 1 < ntile) { const int kn = (it + 1) < nA ? tA0 + it + 1 : tB0 + (it + 1 - nA); ATT_LOAD(kn); }
        const bool nbt = NA && kt < 32;
        if (nbt && (kt < r0 || kt >= r0 + 8)) continue;
        f32x4 s[4];
#pragma unroll
        for (int n = 0; n < 4; ++n) s[n] = (f32x4){0.f, 0.f, 0.f, 0.f};
#pragma unroll
        for (int kk = 0; kk < DK / 32; ++kk)
#pragma unroll
            for (int n = 0; n < 4; ++n) { const bf16x8 kf = *(const LAS bf16x8*)(Ks + (n * 16 + r) * KP + 32 * kk + 8 * q); s[n] = __builtin_amdgcn_mfma_f32_16x16x32_bf16(qf[kk], kf, s[n], 0, 0, 0); }
        float mx[4];
#pragma unroll
        for (int i = 0; i < 4; ++i) mx[i] = -1.0e30f;
#pragma unroll
        for (int n = 0; n < 4; ++n)
#pragma unroll
            for (int i = 0; i < 4; ++i) {
                float v = s[n][i] * scale;
                if (nbt) { const int c = (w & 3) * 16 + 4 * q + i, kc = n * 16 + r; const int c0 = c - 8 < 0 ? 0 : (c - 8 > 48 ? 48 : c - 8);
                    v = (kc >= c0 && kc < c0 + 16) ? v + rp[(kt - rq + 7) * 31 + (kc - c + 15)] : -1.0e30f; }
                s[n][i] = v; mx[i] = fmaxf(mx[i], v);
            }
        float alpha[4], rs[4];
#pragma unroll
        for (int i = 0; i < 4; ++i) {
            float m = mx[i]; m = fmaxf(m, __shfl_xor(m, 1)); m = fmaxf(m, __shfl_xor(m, 2)); m = fmaxf(m, __shfl_xor(m, 4)); m = fmaxf(m, __shfl_xor(m, 8));
            const float mn = fmaxf(mrow[i], m); alpha[i] = __expf(mrow[i] - mn); mrow[i] = mn; rs[i] = 0.f;
        }
#pragma unroll
        for (int n = 0; n < 4; ++n)
#pragma unroll
            for (int i = 0; i < 4; ++i) { const float pv = __expf(s[n][i] - mrow[i]); rs[i] += pv; Ps[(4 * q + i) * 72 + n * 16 + r] = (bf16)f2bf(pv); }
#pragma unroll
        for (int i = 0; i < 4; ++i) {
            float t = rs[i]; t += __shfl_xor(t, 1); t += __shfl_xor(t, 2); t += __shfl_xor(t, 4); t += __shfl_xor(t, 8);
            lrow[i] = lrow[i] * alpha[i] + t;
        }
#pragma unroll
        for (int d = 0; d < 8; ++d)
#pragma unroll
            for (int i = 0; i < 4; ++i) o[d][i] *= alpha[i];
        asm volatile("s_waitcnt lgkmcnt(0)" ::: "memory");
#pragma unroll
        for (int kk = 0; kk < 2; ++kk) { const bf16x8 pf = *(const LAS bf16x8*)(Ps + r * 72 + 32 * kk + 8 * q);
#pragma unroll
            for (int d = 0; d < 8; ++d) { const bf16x8 vf = *(const LAS bf16x8*)(VTs + (d * 16 + r) * 72 + 32 * kk + 8 * q); o[d] = __builtin_amdgcn_mfma_f32_16x16x32_bf16(pf, vf, o[d], 0, 0, 0); } }
    }
#undef ATT_LOAD
#pragma unroll
    for (int i = 0; i < 4; ++i) { const float inv = 1.0f / lrow[i]; bf16* op = Og + (size_t)(w * 16 + 4 * q + i) * D + r;
#pragma unroll
        for (int d = 0; d < 8; ++d) op[d * 16] = (bf16)f2bf(o[d][i] * inv); }
    __syncthreads();
}
typedef float f32x16 __attribute__((ext_vector_type(16)));
typedef short s16x4 __attribute__((ext_vector_type(4)));
template <int DK, bool NA>
DI void attn_unit2(Frame& F, const bf16* Qg, const bf16* Kg, const bf16* VTg, int nA, int tA0, int nB, int tB0, float sc2, bf16* Og, int qrow0, const float* rpb) {
    constexpr int KP = DK + 8, KCH = DK / 8, NKC = 64 * KCH / NTHR, NKK = DK / 16;
    constexpr int KTB = 64 * KP * 2, VTB = 128 * 72 * 2, BUFB = KTB + VTB;
    const int lane = F.lane, l32 = lane & 31, h = lane >> 5, tid = F.tid, w = F.wave, g = w & 3, kp = w >> 2;
    LAS float* rp = (LAS float*)(F.lds + 2 * BUFB);
    if (NA) { for (int i = tid; i < 15 * 31; i += NTHR) rp[i] = rpb[i] * 1.4426950408889634f; }
    bf16x8 qf[NKK];
#pragma unroll
    for (int kk = 0; kk < NKK; ++kk) qf[kk] = *(const bf16x8*)(Qg + (size_t)(32 * g + l32) * DK + 16 * kk + 8 * h);
    f32x16 o[4]; float mrun = -1.0e30f, lrun = 0.f;
#pragma unroll
    for (int d = 0; d < 4; ++d)
#pragma unroll
        for (int i = 0; i < 16; ++i) o[d][i] = 0.f;
    const int ntile = nA + nB;
    const int rq = qrow0 + (g >> 1), r0 = rq - 4 < 0 ? 0 : (rq - 4 > 24 ? 24 : rq - 4);
    const int cq = 32 * (g & 1) + l32, c0 = cq - 8 < 0 ? 0 : (cq - 8 > 48 ? 48 : cq - 8);
    u32x4 kreg[NKC], vreg[2];
#define ATT2_TILE(it) ((it) < nA ? tA0 + (it) : tB0 + ((it) - nA))
#define ATT2_LOAD(it) do { const int kt_ = ATT2_TILE(it); \
        _Pragma("unroll") for (int c = 0; c < NKC; ++c) { const int id = tid + NTHR * c, rr = id / KCH, cc = id % KCH; kreg[c] = *(const u32x4*)(Kg + (size_t)(kt_ * 64 + rr) * DK + cc * 8); } \
        _Pragma("unroll") for (int c = 0; c < 2; ++c) { const int id = tid + NTHR * c, dd = id >> 3, cc = id & 7; vreg[c] = *(const u32x4*)(VTg + (size_t)dd * TS + kt_ * 64 + cc * 8); } } while (0)
#define ATT2_STORE(b) do { \
        _Pragma("unroll") for (int c = 0; c < NKC; ++c) { const int id = tid + NTHR * c, rr = id / KCH, cc = id % KCH; *(LAS u32x4*)(F.lds + (b) * BUFB + (rr * KP + cc * 8) * 2) = kreg[c]; } \
        _Pragma("unroll") for (int c = 0; c < 2; ++c) { const int id = tid + NTHR * c, dd = id >> 3, cc = id & 7; *(LAS u32x4*)(F.lds + (b) * BUFB + KTB + (dd * 72 + cc * 8) * 2) = vreg[c]; } } while (0)
    ATT2_LOAD(0); ATT2_STORE(0);
    __syncthreads();
    for (int st = 0; st < ntile; ++st) {
        if (st + 1 < ntile) ATT2_LOAD(st + 1);
        const int kt = ATT2_TILE(st);
        const bool nbt = NA && kt < 32;
        if (!(nbt && (kt < r0 || kt >= r0 + 8))) {
            const LAS bf16* Ks = (const LAS bf16*)(F.lds + (st & 1) * BUFB) + (kp * 32 + l32) * KP + 8 * h;
            const LAS bf16* VTs = (const LAS bf16*)(F.lds + (st & 1) * BUFB + KTB) + l32 * 72 + kp * 32 + 4 * h;
            f32x16 s;
#pragma unroll
            for (int i = 0; i < 16; ++i) s[i] = 0.f;
#pragma unroll
            for (int kk = 0; kk < NKK; ++kk) { const bf16x8 kf = *(const LAS bf16x8*)(Ks + 16 * kk); s = __builtin_amdgcn_mfma_f32_32x32x16_bf16(kf, qf[kk], s, 0, 0, 0); }
            float mx = -1.0e30f;
#pragma unroll
            for (int i = 0; i < 16; ++i) {
                float v = s[i] * sc2;
                if (nbt) { const int kc = kp * 32 + 8 * (i >> 2) + 4 * h + (i & 3); v = (kc >= c0 && kc < c0 + 16) ? v + rp[(kt - rq + 7) * 31 + (kc - cq + 15)] : -1.0e30f; }
                s[i] = v; mx = fmaxf(mx, v);
            }
            mx = fmaxf(mx, __shfl_xor(mx, 32));
            const float mn = fmaxf(mrun, mx), alpha = __builtin_amdgcn_exp2f(mrun - mn); mrun = mn;
            float rs = 0.f;
#pragma unroll
            for (int i = 0; i < 16; ++i) { const float pv = __builtin_amdgcn_exp2f(s[i] - mn); s[i] = pv; rs += pv; }
            rs += __shfl_xor(rs, 32);
            lrun = lrun * alpha + rs;
            if (__any(alpha != 1.0f)) {
#pragma unroll
                for (int d = 0; d < 4; ++d)
#pragma unroll
                    for (int i = 0; i < 16; ++i) o[d][i] *= alpha;
            }
#pragma unroll
            for (int sp = 0; sp < 2; ++sp) {
                u32x4 pw; pw.x = pg8::cvt_pk_bf16(s[8 * sp + 0], s[8 * sp + 1]); pw.y = pg8::cvt_pk_bf16(s[8 * sp + 2], s[8 * sp + 3]);
                pw.z = pg8::cvt_pk_bf16(s[8 * sp + 4], s[8 * sp + 5]); pw.w = pg8::cvt_pk_bf16(s[8 * sp + 6], s[8 * sp + 7]);
                const bf16x8 pf = __builtin_bit_cast(bf16x8, pw);
#pragma unroll
                for (int d = 0; d < 4; ++d) { const LAS bf16* vp = VTs + d * 32 * 72 + 16 * sp;
                    const u32x2 lo = *(const LAS u32x2*)vp, hi = *(const LAS u32x2*)(vp + 8);
                    const u32x4 vv = (u32x4){lo.x, lo.y, hi.x, hi.y};
                    o[d] = __builtin_amdgcn_mfma_f32_32x32x16_bf16(__builtin_bit_cast(bf16x8, vv), pf, o[d], 0, 0, 0); }
            }
        }
        if (st + 1 < ntile) ATT2_STORE((st + 1) & 1);
        __syncthreads();
    }
#undef ATT2_LOAD
#undef ATT2_STORE
#undef ATT2_TILE
    LAS float* ob = (LAS float*)F.lds + g * (66 * 64);
    if (kp == 1) {
#pragma unroll
        for (int d = 0; d < 4; ++d)
#pragma unroll
            for (int i = 0; i < 16; ++i) ob[(d * 16 + i) * 64 + lane] = o[d][i];
        ob[64 * 64 + lane] = mrun; ob[65 * 64 + lane] = lrun;
    }
    __syncthreads();
    if (kp == 0) {
        const float m1 = ob[64 * 64 + lane], l1 = ob[65 * 64 + lane];
        const float mf = fmaxf(mrun, m1), a0 = __builtin_amdgcn_exp2f(mrun - mf), a1 = __builtin_amdgcn_exp2f(m1 - mf);
        const float inv = 1.0f / (lrun * a0 + l1 * a1);
        bf16* op = Og + (size_t)(32 * g + l32) * D + 4 * h;
#pragma unroll
        for (int d = 0; d < 4; ++d)
#pragma unroll
            for (int i4 = 0; i4 < 4; ++i4) {
                float r[4];
#pragma unroll
                for (int j = 0; j < 4; ++j) r[j] = (o[d][4 * i4 + j] * a0 + ob[(d * 16 + 4 * i4 + j) * 64 + lane] * a1) * inv;
                u32x2 wv; wv.x = pk2(r[0], r[1]); wv.y = pk2(r[2], r[3]);
                *(u32x2*)(op + d * 32 + 8 * i4) = wv;
            }
    }
    __syncthreads();
}
DI void ml_c_unit(Frame& F, int seq, int p) {
    const int b = seq >> 3, h = (seq >> 1) & 3, dir = seq & 1, tc = tc_of(dir, p), lane = F.lane, tid = F.tid;
    const bf16* P = WSP(bf16, WS_P);
    constexpr float QS = 0.08838834764831845f;
    LAS bf16* Qs = (LAS bf16*)F.lds;
    LAS bf16* Ksm = (LAS bf16*)(F.lds + 17408);
    LAS bf16* VT = (LAS bf16*)(F.lds + 34816);
    LAS bf16* Cx = (LAS bf16*)(F.lds + 55552);
    LAS bf16* SW = (LAS bf16*)(F.lds + 94720);
    LAS float* av = (LAS float*)(F.lds + 103936);
    LAS float* Mt = av + 64;
    LAS float* Bt = av + 128;
    LAS float* den = av + 192;
    const float m_p = WSP(float, WS_MLSC)[(size_t)(seq * 36 + p) * 4 + 2];
    if (F.wave == 0) {
        const int row = rowof(b, tc * 64 + lane);
        const float* gt = WSP(float, WS_GATES) + (size_t)row * 16;
        const float li = gt[dir * 4 + h], lf = gt[8 + dir * 4 + h];
        const float pre = wave_incl_scan(lf, lane), tot = __shfl(pre, 63);
        const float B = dir == 0 ? pre : (tot - pre) + lf;
        const float a = li - B;
        float cm = a;
#pragma unroll
        for (int o = 1; o < 64; o <<= 1) { const float t = dir == 0 ? __shfl_up(cm, o) : __shfl_down(cm, o); const bool ok = dir == 0 ? (lane >= o) : (lane + o < 64); if (ok) cm = fmaxf(cm, t); }
        av[lane] = a; Mt[lane] = fmaxf(m_p, cm); Bt[lane] = B;
    }
    {
        u32x4 qv[2], kv[2]; unsigned vv[16]; u32x4 cx[5];
        const bf16* Sg = WSP(bf16, WS_MLS) + (size_t)(seq * 36 + p) * 16512;
#pragma unroll
        for (int it = 0; it < 2; ++it) { const int idx = tid + NTHR * it, n = idx >> 4, cc = idx & 15;
            const bf16* pr = P + (size_t)rowof(b, tc * 64 + n) * DINP + h * 128 + cc * 8; qv[it] = *(const u32x4*)(pr + PC_MLQ); kv[it] = *(const u32x4*)(pr + PC_MLK); }
#pragma unroll
        for (int it = 0; it < 16; ++it) { const int idx = tid + NTHR * it, n = idx >> 7, d = idx & 127; vv[it] = P[(size_t)rowof(b, tc * 64 + n) * DINP + PC_MLV + h * 128 + d]; }
#pragma unroll
        for (int it = 0; it < 5; ++it) { const int idx = tid + NTHR * it, rr = idx >> 4, cc = idx & 15; cx[it] = (idx < 144 * 16 && rr < 129) ? *(const u32x4*)(Sg + rr * 128 + cc * 8) : (u32x4){0u, 0u, 0u, 0u}; }
        PINV(qv[0]); PINV(qv[1]); PINV(kv[0]); PINV(kv[1]); PIN8(vv); PIN8(vv + 8); PINV(cx[0]); PINV(cx[1]); PINV(cx[2]); PINV(cx[3]); PINV(cx[4]);
#pragma unroll
        for (int it = 0; it < 2; ++it) { const int idx = tid + NTHR * it, n = idx >> 4, cc = idx & 15; *(LAS u32x4*)(Qs + n * 136 + cc * 8) = qv[it]; *(LAS u32x4*)(Ksm + n * 136 + cc * 8) = kv[it]; }
#pragma unroll
        for (int it = 0; it < 16; ++it) { const int idx = tid + NTHR * it, n = idx >> 7, d = idx & 127; VT[d * 72 + n] = (bf16)vv[it]; }
#pragma unroll
        for (int it = 0; it < 5; ++it) { const int idx = tid + NTHR * it, rr = idx >> 4, cc = idx & 15; if (idx < 144 * 16) *(LAS u32x4*)(Cx + rr * 136 + cc * 8) = cx[it]; }
    }
    for (int idx = tid; idx < 16 * 64; idx += NTHR) { const int rr = idx >> 6, n = idx & 63; VT[(128 + rr) * 72 + n] = rr == 0 ? (bf16)0x3f80 : (bf16)0; }
    __syncthreads();
    for (int id = F.wave; id < 16; id += 8) { const int tt = id >> 2, st = id & 3;
        const bool skip = dir == 0 ? st > tt : st < tt;
        f32x4 acc = (f32x4){0.f, 0.f, 0.f, 0.f};
        if (!skip) acc = mma16<128>(Qs + tt * 16 * 136, 136, Ksm + st * 16 * 136, 136, lane, acc);
        const int s = st * 16 + (lane & 15); const float as = av[s];
#pragma unroll
        for (int i = 0; i < 4; ++i) { const int t = tt * 16 + 4 * (lane >> 4) + i; const bool ok = !skip && (dir == 0 ? s <= t : s >= t);
            SW[t * 72 + s] = (bf16)f2bf(ok ? acc[i] * QS * __expf(as - Mt[t]) : 0.f); } }
    __syncthreads();
    const int tt = F.wave & 3, d0 = F.wave < 4 ? 0 : 5, nd = F.wave < 4 ? 5 : 4;
    f32x4 val[5];
#pragma unroll
    for (int k = 0; k < 5; ++k) { val[k] = (f32x4){0.f, 0.f, 0.f, 0.f};
        if (k < nd) { const int dt = d0 + k;
            const f32x4 a1 = mma16<64>(SW + tt * 16 * 72, 72, VT + dt * 16 * 72, 72, lane, (f32x4){0.f, 0.f, 0.f, 0.f});
            const f32x4 a2 = mma16<128>(Qs + tt * 16 * 136, 136, Cx + dt * 16 * 136, 136, lane, (f32x4){0.f, 0.f, 0.f, 0.f});
#pragma unroll
            for (int i = 0; i < 4; ++i) { const int t = tt * 16 + 4 * (lane >> 4) + i; val[k][i] = a1[i] + a2[i] * QS * __expf(m_p - Mt[t]); }
            if (dt == 8 && (lane & 15) == 0) {
#pragma unroll
                for (int i = 0; i < 4; ++i) den[tt * 16 + 4 * (lane >> 4) + i] = val[k][i]; } } }
    __syncthreads();
    float* H = WSP(float, WS_HML) + (size_t)dir * MTOK * 512;
#pragma unroll
    for (int k = 0; k < 5; ++k) { const int dt = d0 + k; if (k < nd && dt < 8) {
#pragma unroll
        for (int i = 0; i < 4; ++i) { const int t = tt * 16 + 4 * (lane >> 4) + i;
            const float dn = fmaxf(fabsf(den[t]), __expf(-(Bt[t] + Mt[t])));
            H[(size_t)rowof(b, tc * 64 + t) * 512 + h * 128 + dt * 16 + (lane & 15)] = val[k][i] / dn; } } }
    __syncthreads();
}

DI void ss_c_unit(Frame& F, int l, int sq, int p) {
    const int b = sq >> 4, h = (sq >> 1) & 7, dir = sq & 1, g = h >> 2, tc = tc_of(dir, p), lane = F.lane, tid = F.tid;
    const bf16* XBC = WSP(bf16, WS_XBC);
    LAS bf16* Cm = (LAS bf16*)F.lds;
    LAS bf16* Bm = (LAS bf16*)(F.lds + 17408);
    LAS bf16* XT = (LAS bf16*)(F.lds + 34816);
    LAS bf16* Sx = (LAS bf16*)(F.lds + 44032);
    LAS bf16* W = (LAS bf16*)(F.lds + 61440);
    LAS float* cum = (LAS float*)(F.lds + 70656);
    LAS float* dtv = cum + 64;
    if (F.wave == 0) {
        const int row = rowof(b, tc * 64 + lane);
        const float dt = WSP(float, WS_DT)[(size_t)row * 16 + dir * 8 + h];
        const float A = -__expf(F.in[15][l * 16 + dir * 8 + h]);
        const float a = dt * A, pre = wave_incl_scan(a, lane), tot = __shfl(pre, 63);
        cum[lane] = dir == 0 ? pre : (tot - pre) + a; dtv[lane] = dt;
    }
    {
        u32x4 bb[2], cc_[2], sx[2]; unsigned xx[8];
        const bf16* Sg = WSP(bf16, WS_SSS) + (size_t)(sq * 36 + p) * 8192;
#pragma unroll
        for (int it = 0; it < 2; ++it) { const int idx = tid + NTHR * it, n = idx >> 4, cc = idx & 15; const bf16* xr = XBC + (size_t)rowof(b, tc * 64 + n) * 1024;
            bb[it] = *(const u32x4*)(xr + 512 + g * 128 + cc * 8); cc_[it] = *(const u32x4*)(xr + 768 + g * 128 + cc * 8); sx[it] = *(const u32x4*)(Sg + n * 128 + cc * 8); }
#pragma unroll
        for (int it = 0; it < 8; ++it) { const int idx = tid + NTHR * it, n = idx >> 6, pp = idx & 63; xx[it] = XBC[(size_t)rowof(b, tc * 64 + n) * 1024 + h * 64 + pp]; }
        PINV(bb[0]); PINV(bb[1]); PINV(cc_[0]); PINV(cc_[1]); PINV(sx[0]); PINV(sx[1]); PIN8(xx);
#pragma unroll
        for (int it = 0; it < 2; ++it) { const int idx = tid + NTHR * it, n = idx >> 4, cc = idx & 15;
            *(LAS u32x4*)(Bm + n * 136 + cc * 8) = bb[it]; *(LAS u32x4*)(Cm + n * 136 + cc * 8) = cc_[it]; *(LAS u32x4*)(Sx + n * 136 + cc * 8) = sx[it]; }
#pragma unroll
        for (int it = 0; it < 8; ++it) { const int idx = tid + NTHR * it, n = idx >> 6, pp = idx & 63; XT[pp * 72 + n] = (bf16)xx[it]; }
    }
    __syncthreads();
    for (int id = F.wave; id < 16; id += 8) { const int tt = id >> 2, st = id & 3;
        const bool skip = dir == 0 ? st > tt : st < tt;
        f32x4 acc = (f32x4){0.f, 0.f, 0.f, 0.f};
        if (!skip) acc = mma16<128>(Cm + tt * 16 * 136, 136, Bm + st * 16 * 136, 136, lane, acc);
        const int s = st * 16 + (lane & 15); const float cs = cum[s], ds = dtv[s];
#pragma unroll
        for (int i = 0; i < 4; ++i) { const int t = tt * 16 + 4 * (lane >> 4) + i; const bool ok = !skip && (dir == 0 ? s <= t : s >= t);
            W[t * 72 + s] = (bf16)f2bf(ok ? acc[i] * __expf(cum[t] - cs) * ds : 0.f); } }
    __syncthreads();
    float* Y = WSP(float, WS_YSS) + (size_t)dir * MTOK * 512;
    for (int id = F.wave; id < 16; id += 8) { const int tt = id >> 2, pt = id & 3;
        const f32x4 a1 = mma16<64>(W + tt * 16 * 72, 72, XT + pt * 16 * 72, 72, lane, (f32x4){0.f, 0.f, 0.f, 0.f});
        const f32x4 a2 = mma16<128>(Cm + tt * 16 * 136, 136, Sx + pt * 16 * 136, 136, lane, (f32x4){0.f, 0.f, 0.f, 0.f});
#pragma unroll
        for (int i = 0; i < 4; ++i) { const int t = tt * 16 + 4 * (lane >> 4) + i;
            Y[(size_t)rowof(b, tc * 64 + t) * 512 + h * 64 + pt * 16 + (lane & 15)] = a1[i] + a2[i] * __expf(cum[t]); } }
    __syncthreads();
}

DI void m5_finish_phase(Frame& F, int l, int nrows) {
    const int gw = F.bid * NWAVES + F.wave, NGW = F.G * NWAVES, lane = F.lane;
    const bf16* P = WSP(bf16, WS_P); const float* H0 = WSP(float, WS_HML); const float* H1 = H0 + (size_t)MTOK * 512;
    const float* Y0 = WSP(float, WS_YSS); const float* Y1 = Y0 + (size_t)MTOK * 512; const bf16* XBC = WSP(bf16, WS_XBC);
    bf16* A2 = WSP(bf16, WS_A2);
    float gn[8], sn[8], dsk[8];
#pragma unroll
    for (int u = 0; u < 8; ++u) { gn[u] = F.in[11][l * 512 + lane + 64 * u]; sn[u] = F.in[17][l * 512 + lane + 64 * u]; dsk[u] = F.in[16][l * 8 + u]; }
    for (int row = gw; row < nrows; row += NGW) {
        const bf16* p = P + (size_t)row * DINP;
        float h0[8], h1[8], y0[8], y1[8], hv[8], ov[8], yv[8], zv[8]; unsigned ow[8], zw[8], xw[8];
#pragma unroll
        for (int u = 0; u < 8; ++u) { const int c = lane + 64 * u;
            h0[u] = H0[(size_t)row * 512 + c]; h1[u] = H1[(size_t)row * 512 + c]; y0[u] = Y0[(size_t)row * 512 + c]; y1[u] = Y1[(size_t)row * 512 + c];
            ow[u] = p[PC_MLO + c]; zw[u] = p[PC_Z + c]; xw[u] = XBC[(size_t)row * 1024 + c]; }
        PIN8(h0); PIN8(h1); PIN8(y0); PIN8(y1); PIN8(ow); PIN8(zw); PIN8(xw);
        bf16 xv[8];
#pragma unroll
        for (int u = 0; u < 8; ++u) { hv[u] = h0[u] + h1[u]; yv[u] = y0[u] + y1[u]; ov[u] = bf2f(ow[u]); zv[u] = bf2f(zw[u]); xv[u] = (bf16)xw[u]; }
#pragma unroll
        for (int h = 0; h < 4; ++h) {
            const float v0 = hv[2 * h], v1 = hv[2 * h + 1]; const int c0 = h * 128 + lane, c1 = c0 + 64;
            const float rstd = 1.0f / sqrtf(wave_sum(v0 * v0 + v1 * v1) * (1.f / 128.f) + EPS);
            A2[(size_t)row * D + c0] = (bf16)f2bf(v0 * rstd * gn[2 * h] * sigmoidf_(ov[2 * h]));
            A2[(size_t)row * D + c1] = (bf16)f2bf(v1 * rstd * gn[2 * h + 1] * sigmoidf_(ov[2 * h + 1]));
        }
        float y[8]; float ss = 0.f;
#pragma unroll
        for (int u = 0; u < 8; ++u) { float v = yv[u] + dsk[u] * bf2f(xv[u]); v *= siluf(zv[u]); y[u] = v; ss += v * v; }
        const float rstd = 1.0f / sqrtf(wave_sum(ss) * (1.f / 512.f) + EPS);
#pragma unroll
        for (int u = 0; u < 8; ++u) { const int c = lane + 64 * u; A2[(size_t)row * D + 512 + c] = (bf16)f2bf(y[u] * rstd * sn[u]); }
    }
}
#ifndef PROBE_MASK
#define PROBE_MASK 0ull
#endif
#define NREP(k) ((((unsigned long long)(PROBE_MASK) >> (k)) & 1ull) ? 2 : 1)
#ifndef UNIT_REP
#define UNIT_REP 0
#endif
#define UREP(i) for (int rp_ = 0; rp_ <= ((F.rep >> (i)) & 1); ++rp_)
#ifndef ONE_LAUNCH
#define ONE_LAUNCH 1
#endif
#ifndef TPROBE_MASK
#define TPROBE_MASK 0ull
#endif
#ifndef TPROBE_AMP
#define TPROBE_AMP 8
#endif
#define TPB(k) do { if (((unsigned long long)(TPROBE_MASK) >> (k)) & 1ull) { if (F.bid == 0 && F.tid == 0) { volatile LAS unsigned long long* tp_ = (volatile LAS unsigned long long*)(F.lds + MISC_OFF + 128); tp_[0] = wall_clock64(); } } } while (0)
#define TPE(k) do { if (((unsigned long long)(TPROBE_MASK) >> (k)) & 1ull) { if (F.bid == 0 && F.tid == 0) { volatile LAS unsigned long long* tp_ = (volatile LAS unsigned long long*)(F.lds + MISC_OFF + 128); tp_[1] += wall_clock64() - tp_[0]; } } } while (0)
#define IN(k) (lo <= (k) && (k) < hi)
#define SEAM(k) do { if (ONE_LAUNCH && hi > (k) + 1) xcd_barrier(bar); } while (0)
#ifndef FILL_MASK
#define FILL_MASK 0x7fffffffull
#endif
#define FILL(k, work) do { if (ONE_LAUNCH) conv_fill(F, (k), (work)); } while (0)
#ifndef NCV_P
#define NCV_P 48
#define NCV_OUT 112
#define NCV_UP 24
#define NCV_DOWN 112
#endif
template <int l> DI void layer_phases(Frame& F, const XcdBarrier& bar, const int lo, const int hi) {
    LAS int* mtb = (LAS int*)(F.lds + RING_BYTES);
        const int pb = 1 + 16 * l;
        const bool wc = (l == 0);
        const int nrows = wc ? MTOK : MLAT;
        const float* modl = WSP(float, WS_MOD) + (size_t)l * 5 * D6;
        if (IN(pb + 0)) { TPB(pb + 0);
            if (l == 0) norm_phase<false>(F, l, F.in[0], F.in[2], F.in[6] + l * D, 0, MTOK);
            else norm_phase<false>(F, l, WSP(float, WS_X), WSP(float, WS_X) + (size_t)MLAT * D, F.in[6] + l * D, 0, MTOK);
            if (l == 1) conv_drain(F, CV_NQ1 - CV_EAGER); SEAM(pb + 0); TPE(pb + 0);
        }
        if (IN(pb + 1)) { TPB(pb + 1);
            const int ncv = ONE_LAUNCH ? NCV_P : 0, gw_ = F.G - ncv;
            if (F.bid < gw_) { pg8::Gemm g{WSP(bf16, WS_HN), WSP(bf16, WS_WIN) + (size_t)l * DINP * D, D, D}; pg8::StaticOrder S; S.init(MTOK / 256, DINP / 256, gw_, F.bid);
                EpiP E{WSP(bf16, WS_P), WSP(float, WS_GRAW)};
                pg8::gemm_phase<EpiP, pg8::StaticOrder>(F.lds, g, S, E); }
            FILL(pb + 1, F.bid >= gw_);
            SEAM(pb + 1); TPE(pb + 1);
        }
        if (IN(pb + 2)) { TPB(pb + 2);
            for (int u = F.bid; u < NB * 72; u += F.G) m1_prep_unit(F, l, u / 72, u % 72);
            SEAM(pb + 2); TPE(pb + 2);
        }
        if (IN(pb + 3)) { TPB(pb + 3);
            { pg8::Gemm g{WSP(bf16, WS_CQN), WSP(bf16, WS_WQB) + (size_t)l * 768 * 512, 512, 512}; pg8::StaticOrder S; S.init(MTOK / 256, 3, F.G, F.bid);
              EpiBf16 E{WSP(bf16, WS_QRAW), 768}; pg8::gemm_phase<EpiBf16, pg8::StaticOrder>(F.lds, g, S, E); }
            __syncthreads();
            { pg8::Gemm g{WSP(bf16, WS_CKVN), WSP(bf16, WS_WKVB) + (size_t)l * 1024 * 256, 256, 256}; pg8::StaticOrder S; S.init(MTOK / 256, 4, F.G, (F.bid + 128) % F.G);
              EpiBf16 E{WSP(bf16, WS_KVRAW), 1024}; pg8::gemm_phase<EpiBf16, pg8::StaticOrder>(F.lds, g, S, E); }
            __syncthreads();
            UREP(2) for (int u = F.bid; u < 1152; u += F.G) ml_a_unit(F, u / 36, u % 36);
            UREP(3) for (int v = (F.bid + 128) % F.G; v < 576; v += F.G) ss_a_unit(F, l, v / 144, (v / 72) & 1, (v % 72) >> 1, v & 1);
            SEAM(pb + 3); TPE(pb + 3);
        }
        if (IN(pb + 4)) { TPB(pb + 4);
            UREP(4) for (int u = F.bid; u < 256; u += F.G) {
                const int bh = u >> 4, qb = u & 15, b = bh >> 2, h = bh & 3;
                const int r0a = 2 * qb - 4 < 0 ? 0 : (2 * qb - 4 > 24 ? 24 : 2 * qb - 4), r0b = 2 * qb - 3 < 0 ? 0 : (2 * qb - 3 > 24 ? 24 : 2 * qb - 3);
                attn_unit2<128, true>(F, WSP(bf16, WS_QNA) + ((size_t)bh * TS + qb * 128) * 128, WSP(bf16, WS_KNA) + (size_t)bh * TS * 128, WSP(bf16, WS_VTNA) + (size_t)bh * 128 * TS,
                                     4, 32, r0b + 8 - r0a, r0a, 0.12751743082459868f,
                                     WSP(bf16, WS_A2) + (size_t)(b * TL + qb * 128) * D + 1536 + h * 128, 2 * qb, F.in[26] + (size_t)(l * 4 + h) * 15 * 31);
            }
            if (wc) UREP(5) for (int v = F.bid; v < 32; v += F.G) {
                const int bh2 = v >> 1, qc = v & 1, b2 = bh2 >> 2, h2 = bh2 & 3;
                attn_unit2<128, false>(F, WSP(bf16, WS_QNA) + ((size_t)bh2 * TS + TL + qc * 128) * 128, WSP(bf16, WS_KNA) + (size_t)bh2 * TS * 128, WSP(bf16, WS_VTNA) + (size_t)bh2 * 128 * TS,
                                      4, 32, 0, 0, 0.12751743082459868f, WSP(bf16, WS_A2) + (size_t)(MLAT + b2 * TC + qc * 128) * D + 1536 + h2 * 128, 0, nullptr);
            }
            UREP(6) for (int v = (F.bid + 32) % F.G; v < 128; v += F.G) ml_scan_unit(F, v >> 2, v & 3);
            UREP(7) for (int v = (F.bid + 96) % F.G; v < 128; v += F.G) ss_scan_unit(F, v >> 1, v & 1);
            UREP(8) for (int v = F.bid; v < 288; v += F.G) mla_post_unit(F, l, v / 72, v % 72);
            SEAM(pb + 4); TPE(pb + 4);
        }
        if (IN(pb + 5)) { TPB(pb + 5);
            const int p0 = wc ? 0 : 4, npp = 36 - p0;
            UREP(9) for (int u = F.bid; u < 256; u += F.G) { const int bh = u >> 4, qb = u & 15, b = bh >> 2, h = bh & 3;
                attn_unit2<192, false>(F, WSP(bf16, WS_QMLA) + ((size_t)bh * TS + qb * 128) * 192, WSP(bf16, WS_KMLA) + (size_t)bh * TS * 192, WSP(bf16, WS_VTMLA) + (size_t)bh * 128 * TS,
                                      36, 0, 0, 0, 0.10411754627862817f, WSP(bf16, WS_A2) + (size_t)(b * TL + qb * 128) * D + 1024 + h * 128, 0, nullptr); }
            if (wc) UREP(10) for (int v = F.bid; v < 32; v += F.G) { const int bh = v >> 1, qc = v & 1, b = bh >> 2, h = bh & 3;
                attn_unit2<192, false>(F, WSP(bf16, WS_QMLA) + ((size_t)bh * TS + TL + qc * 128) * 192, WSP(bf16, WS_KMLA) + (size_t)bh * TS * 192, WSP(bf16, WS_VTMLA) + (size_t)bh * 128 * TS,
                                      4, 32, 0, 0, 0.10411754627862817f, WSP(bf16, WS_A2) + (size_t)(MLAT + b * TC + qc * 128) * D + 1024 + h * 128, 0, nullptr); }
            UREP(11) for (int v = (F.bid + 32) % F.G; v < 32 * npp; v += F.G) ml_c_unit(F, v / npp, p0 + v % npp);
            UREP(12) for (int v = (F.bid + 160) % F.G; v < 64 * npp; v += F.G) ss_c_unit(F, l, v / npp, p0 + v % npp);
            SEAM(pb + 5); TPE(pb + 5);
        }
        if (IN(pb + 6)) { TPB(pb + 6); m5_finish_phase(F, l, nrows); SEAM(pb + 6); TPE(pb + 6); }
        if (IN(pb + 7)) { TPB(pb + 7);
            const int ncv = (ONE_LAUNCH && l == 0) ? NCV_OUT : 0, gw_ = F.G - ncv;
            if (F.bid < gw_) { pg8::Gemm g{WSP(bf16, WS_A2), WSP(bf16, WS_WOUT) + (size_t)l * D * D, D, D}; pg8::StaticOrder S; S.init(nrows / 256, D / 256, gw_, F.bid);
                EpiResid E{l == 0 ? F.in[0] : WSP(float, WS_X), l == 0 ? F.in[2] : WSP(float, WS_X) + (size_t)MLAT * D, WSP(float, WS_X), modl + 2 * D};
                pg8::gemm_phase<EpiResid, pg8::StaticOrder>(F.lds, g, S, E); }
            FILL(pb + 7, F.bid >= gw_);
            SEAM(pb + 7); TPE(pb + 7);
        }
        if (IN(pb + 8)) { TPB(pb + 8);
            if (l == 0) { norm_phase<false>(F, l, WSP(float, WS_X), WSP(float, WS_X) + (size_t)MLAT * D, F.in[27] + l * D, 3 * D, nrows); conv_drain(F, CV_NE - CV_EAGER); }
            else { norm_phase<true>(F, l, WSP(float, WS_X), WSP(float, WS_X) + (size_t)MLAT * D, F.in[27] + l * D, 3 * D, nrows); conv_drain(F, CV_NDEF); }
            SEAM(pb + 8); TPE(pb + 8);
        }
        if (l == 0) {
            if (IN(pb + 10)) { TPB(pb + 10);
                const int ncv = ONE_LAUNCH ? NCV_UP : 0, gw_ = F.G - ncv;
                if (F.bid < gw_) { pg8::Gemm g{WSP(bf16, WS_HN), WSP(bf16, WS_W13), D, D}; pg8::StaticOrder S; S.init(MTOK / 256, 2 * FF / 256, gw_, F.bid);
                    EpiSwiglu E{WSP(bf16, WS_G), FF}; pg8::gemm_phase<EpiSwiglu, pg8::StaticOrder>(F.lds, g, S, E); }
                FILL(pb + 10, F.bid >= gw_);
                SEAM(pb + 10); TPE(pb + 10);
            }
            if (IN(pb + 11)) { TPB(pb + 11);
                const int ncv = ONE_LAUNCH ? NCV_DOWN : 0, gw_ = F.G - ncv;
                if (F.bid < gw_) { pg8::Gemm g{WSP(bf16, WS_G), WSP(bf16, WS_W2), FF, FF}; pg8::StaticOrder S; S.init(MTOK / 256, D / 256, gw_, F.bid);
                    EpiResid E{WSP(float, WS_X), WSP(float, WS_X) + (size_t)MLAT * D, WSP(float, WS_X), modl + 5 * D};
                    pg8::gemm_phase<EpiResid, pg8::StaticOrder>(F.lds, g, S, E); }
                FILL(pb + 11, F.bid >= gw_);
                SEAM(pb + 11); TPE(pb + 11);
            }
        } else {
            if (IN(pb + 10)) { TPB(pb + 10);
                __syncthreads(); moe_tables(F, mtb, 2 * FE / 256);
                pg8::Gemm g{WSP(bf16, WS_XG), WSP(bf16, WS_MW13), D, D}; MoeOrder S{mtb, 2 * FE / 256, F.G, F.bid, 0, mtb[40], 1, 0, MLAT / 256};
                EpiSwiglu E{WSP(bf16, WS_G), FE}; pg8::gemm_phase<EpiSwiglu, MoeOrder>(F.lds, g, S, E);
                SEAM(pb + 10); TPE(pb + 10);
            }
            if (IN(pb + 11)) { TPB(pb + 11);
                __syncthreads(); moe_tables(F, mtb, D / 256);
                const int nun = mtb[40], nfull0 = (nun / F.G) * F.G, nt0 = nun - nfull0;
                const int SK = nt0 == 0 ? 1 : (nt0 <= 32 ? 8 : (nt0 <= 64 ? 4 : (nt0 <= 128 ? 2 : 1)));
                const int nfull = SK == 1 ? nun : nfull0, ntail = nun - nfull;
                { pg8::Gemm g{WSP(bf16, WS_G), WSP(bf16, WS_MW2), FE, FE}; MoeOrder S{mtb, D / 256, F.G, F.bid, 0, nfull, 1, 0, 0};
                  EpiF32 E{WSP(float, WS_Y), D}; pg8::gemm_phase<EpiF32, MoeOrder>(F.lds, g, S, E); }
                if (ntail > 0) { __syncthreads();
                  pg8::Gemm g{WSP(bf16, WS_G), WSP(bf16, WS_MW2), FE / SK, FE}; MoeOrder S{mtb, D / 256, F.G, F.bid, nfull, ntail * SK, SK, FE / SK, 0};
                  EpiPart E{WSP(float, WS_PART)}; pg8::gemm_phase<EpiPart, MoeOrder>(F.lds, g, S, E); }
                SEAM(pb + 11); TPE(pb + 11);
            }
            if (IN(pb + 12)) { TPB(pb + 12);
                __syncthreads(); moe_tables(F, mtb, D / 256);
                const int nun = mtb[40], nfull0 = (nun / F.G) * F.G, nt0 = nun - nfull0;
                const int SK = nt0 == 0 ? 1 : (nt0 <= 32 ? 8 : (nt0 <= 64 ? 4 : (nt0 <= 128 ? 2 : 1)));
                const int nfull = SK == 1 ? nun : nfull0, ntail = nun - nfull;
                for (int it = F.bid; it < ntail * 8; it += F.G) { const int t = it >> 3, cg = it & 7;
                    MoeOrder S{mtb, D / 256, 1, 0, nfull + t, 1, 1, 0, 0}; pg8::Unit u; S.next(0, u);
                    if (SK == 8) splitk_reduce_f32<8>(WSP(float, WS_PART), t, cg, u, WSP(float, WS_Y), D);
                    else if (SK == 4) splitk_reduce_f32<4>(WSP(float, WS_PART), t, cg, u, WSP(float, WS_Y), D);
                    else splitk_reduce_f32<2>(WSP(float, WS_PART), t, cg, u, WSP(float, WS_Y), D); }
                SEAM(pb + 12); TPE(pb + 12);
            }
            if (IN(pb + 13)) { TPB(pb + 13); moe_combine_phase(F, l); __syncthreads(); TPE(pb + 13); }
        }
}
__global__ void __launch_bounds__(NTHR, 2) fwd_kernel(Args args) {
    extern __shared__ __attribute__((aligned(16))) unsigned char lds[];
    Frame F;
    F.lds = (LAS unsigned char*)lds; F.ws = args.ws; F.out = args.out;
#pragma unroll
    for (int i = 0; i < 35; ++i) F.in[i] = args.in[i];
    F.tid = threadIdx.x; F.lane = F.tid & 63; F.wave = __builtin_amdgcn_readfirstlane(F.tid >> 6); F.G = gridDim.x; F.bid = blockIdx.x; F.rep = args.rep;
    volatile LAS unsigned* MISC = (volatile LAS unsigned*)(F.lds + MISC_OFF);
    if (F.tid < 64) MISC[F.tid] = 0u;
    __syncthreads();
    XcdBarrier bar; bar.bar = WSP(unsigned, WS_CTL) + CW_BAR; bar.x = 0; bar.st = nullptr;
    if (ONE_LAUNCH) bar = xcd_barrier_post(WSP(unsigned, WS_CTL) + CW_BAR, MISC + 8);
    const int lo = args.ph_lo, hi = args.ph_hi;

    if (IN(0)) { TPB(0); p0_prologue(F); SEAM(0); TPE(0); }

    layer_phases<0>(F, bar, lo, hi);
    layer_phases<1>(F, bar, lo, hi);
    if (TPROBE_MASK != 0ull && F.bid == 0 && F.tid == 0) { volatile LAS unsigned long long* tp_ = (volatile LAS unsigned long long*)(F.lds + MISC_OFF + 128);
        const unsigned long long t0 = wall_clock64(), dur = tp_[1] * TPROBE_AMP; while (wall_clock64() - t0 < dur) __builtin_amdgcn_s_sleep(8); }
#undef IN
#undef SEAM
}

extern "C" void kernel_launch(void* const* d_in, const int* in_sizes, int n_in, void* d_out, int out_size, void* d_ws, size_t ws_size, hipStream_t stream) {
    static int grid = 0;
    if (grid == 0) {
        if (n_in != 35 || out_size != MLAT * D || ws_size < WS_END) { fprintf(stderr, "kernel_launch: unexpected shapes (n_in %d out %d ws %zu need %zu)\n", n_in, out_size, ws_size, (size_t)WS_END); grid = -1; return; }
        int dev = 0, cus = 0, per_cu = 0;
        if (hipGetDevice(&dev) != hipSuccess || hipDeviceGetAttribute(&cus, hipDeviceAttributeMultiprocessorCount, dev) != hipSuccess) { grid = -1; return; }
        if (hipFuncSetAttribute((const void*)fwd_kernel, hipFuncAttributeMaxDynamicSharedMemorySize, LDS_BYTES) != hipSuccess) { fprintf(stderr, "kernel_launch: hipFuncSetAttribute failed\n"); grid = -1; return; }
        if (hipOccupancyMaxActiveBlocksPerMultiprocessor(&per_cu, (const void*)fwd_kernel, NTHR, LDS_BYTES) != hipSuccess || per_cu < 1) { fprintf(stderr, "kernel_launch: occupancy query says %d\n", per_cu); }
        (void)hipGetLastError();
        grid = cus;
    }
    if (grid < 0) return;
    (void)hipMemsetAsync((char*)d_ws + WS_CTL, 0, CTL_ZERO_BYTES, stream);
    Args a{};
    for (int i = 0; i < 35; ++i) a.in[i] = (const float*)d_in[i];
    a.out = (float*)d_out; a.ws = (unsigned char*)d_ws; a.rep = UNIT_REP;
#if ONE_LAUNCH
    a.ph_lo = 0; a.ph_hi = 64;
    hipLaunchKernelGGL(fwd_kernel, dim3(grid), dim3(NTHR), LDS_BYTES, stream, a);
#else
    static const int phases[] = {0, 1, 2, 3, 4, 5, 6, 7, 8, 9, 11, 12, 17, 18, 19, 20, 21, 22, 23, 24, 25, 27, 28, 29, 30};
    for (int k = 0; k < (int)(sizeof(phases) / sizeof(phases[0])); ++k) {
        a.ph_lo = phases[k]; a.ph_hi = phases[k] + 1;
        for (int rp = 0; rp < NREP(phases[k]); ++rp) hipLaunchKernelGGL(fwd_kernel, dim3(grid), dim3(NTHR), LDS_BYTES, stream, a);
    }
#endif
}
```

```cpp
#define NCV_P 48
#define NCV_OUT 96
#define NCV_UP 24
#define NCV_DOWN 96
#define FILL_MASK 0x7fffffffull
#define PROBE_MASK (0ull)
#define ONE_LAUNCH 1
#define UNIT_REP 0
#include <hip/hip_runtime.h>
#include <cstdio>
#include <cstdint>

#define DI __device__ __forceinline__
#define LAS __attribute__((address_space(3)))
#define GAS __attribute__((address_space(1)))
typedef unsigned short bf16;
typedef short bf16x8 __attribute__((ext_vector_type(8)));
typedef float f32x4 __attribute__((ext_vector_type(4)));
typedef float f32x2 __attribute__((ext_vector_type(2)));
typedef unsigned u32x4 __attribute__((ext_vector_type(4)));
typedef unsigned u32x2 __attribute__((ext_vector_type(2)));

namespace pg8 {
constexpr int BM = 256, BK = 64, HALF = 128, HTB = HALF * BK * 2, STAGE_BYTES = 8 * HTB, NXCD = 8, WGM = 8;
__host__ __device__ __forceinline__ int lds_byte(int r, int c) { const int st = (r >> 4) * 2 + (c >> 5), rr = r & 15, cc = c & 31, ob = rr * 64 + cc * 2; return st * 1024 + (ob ^ (((ob >> 9) & 1) << 5)); }
__host__ __device__ __forceinline__ void stage_rc(int b, int& R, int& C) { const int st = b / 1024, sb = b % 1024, swz = sb ^ (((sb >> 9) & 1) << 5); R = (st >> 1) * 16 + swz / 64; C = (st & 1) * 32 + (swz % 64) / 2; }
__host__ __device__ __forceinline__ int perm32(int rho) { const int n = rho >> 4, i = rho & 15; return 8 * (i >> 2) + 4 * n + (i & 3); }

struct Unit { int pm, pn, pb, koff, aux, pa; };
struct Gemm { const bf16* A; const bf16* Bt; int K, ld; };

DI int xcd_remap(int L, int nwg) { const int q = nwg / NXCD, r = nwg % NXCD, xcd = L % NXCD, off = L / NXCD; return (xcd < r ? xcd * (q + 1) : r * (q + 1) + (xcd - r) * q) + off; }

struct StaticOrder {
    int nM, nN, nwg, G, c;
    DI void init(int nM_, int nN_, int G_, int c_) { nM = nM_; nN = nN_; nwg = nM * nN; G = G_; c = c_; }
    DI bool next(int i, Unit& u) const {
        const long L = (long)i * G + c; if (L >= nwg) return false;
        const int wgid = xcd_remap((int)L, nwg);
        const int nig = WGM * nN, gid = wgid / nig, fm = gid * WGM, gsz = (nM - fm) < WGM ? (nM - fm) : WGM;
        u.pm = fm + ((wgid % nig) % gsz); u.pn = (wgid % nig) / gsz; u.pb = u.pn; u.koff = 0; u.aux = 0; u.pa = u.pm; return true;
    }
};

DI unsigned cvt_pk_bf16(float lo, float hi) { unsigned r; asm volatile("v_cvt_pk_bf16_f32 %0, %1, %2" : "=v"(r) : "v"(lo), "v"(hi)); return r; }

template <class Epi, class Sched, bool ALIGN_EPI = true>
DI void gemm_phase(LAS unsigned char* lds, const Gemm g, const Sched& S, const Epi& E) {
    const int tid = threadIdx.x, wid = __builtin_amdgcn_readfirstlane(tid >> 6), lane = tid & 63, wr = wid >> 2, wc = wid & 3, fr = lane & 15, fq = lane >> 4;
    const int K = g.K, nt = K / BK;
    unsigned voffA[2], voffB[2];
#pragma unroll
    for (int i = 0; i < 2; ++i) { int R, C; stage_rc(tid * 16 + i * 8192, R, C); const int Rb = Epi::PERM ? ((R & ~31) + perm32(R & 31)) : R;
        voffA[i] = (unsigned)(R * g.ld + C) * 2u; voffB[i] = (unsigned)(Rb * g.ld + C) * 2u; }
    const size_t kstep = (size_t)(BK * 2);
    const size_t hstep = (size_t)HALF * g.ld * 2;
    const size_t tstep = 2 * hstep;
    const unsigned ldsw = (unsigned)wid * 1024u;
    const int aoff = lds_byte(wr * 64 + fr, fq * 8), boff = lds_byte(wc * 32 + fr, fq * 8);
#define PG8_SA(b, h) (((b) * 2 + (h)) * HTB)
#define PG8_SB(b, h) ((4 + (b) * 2 + (h)) * HTB)
#define PG8_STAGE(bufoff, gbase, voff) do { _Pragma("unroll") for (int _i = 0; _i < 2; ++_i) \
        __builtin_amdgcn_global_load_lds((const unsigned*)((const char*)(gbase) + (voff)[_i]), (LAS unsigned*)(lds + (bufoff) + ldsw + _i * 8192), 16, 0, 0); } while (0)
#define PG8_LDA(dst, b, h) do { _Pragma("unroll") for (int m = 0; m < 4; ++m) _Pragma("unroll") for (int k = 0; k < 2; ++k) dst[m][k] = *(const LAS bf16x8*)(lds + PG8_SA(b, h) + aoff + m * 2048 + k * 1024); } while (0)
#define PG8_LDB(dst, b, h) do { _Pragma("unroll") for (int n = 0; n < 2; ++n) _Pragma("unroll") for (int k = 0; k < 2; ++k) dst[n][k] = *(const LAS bf16x8*)(lds + PG8_SB(b, h) + boff + n * 2048 + k * 1024); } while (0)
#define PG8_MMA(ai, bj, At, Bt) do { __builtin_amdgcn_s_setprio(1); _Pragma("unroll") for (int m = 0; m < 4; ++m) _Pragma("unroll") for (int n = 0; n < 2; ++n) _Pragma("unroll") for (int k = 0; k < 2; ++k) \
        acc[ai][bj][m][n] = __builtin_amdgcn_mfma_f32_16x16x32_bf16(Bt[n][k], At[m][k], acc[ai][bj][m][n], 0, 0, 0); __builtin_amdgcn_s_setprio(0); } while (0)
#define PG8_WAIT_V(n) asm volatile("s_waitcnt vmcnt(" #n ")" ::: "memory")
#define PG8_WAIT_L(n) asm volatile("s_waitcnt lgkmcnt(" #n ")" ::: "memory")
#define PG8_BAR __builtin_amdgcn_s_barrier()
#define PG8_SCHED __builtin_amdgcn_sched_barrier(0)
    Unit cur, nxt; int ui = 0;
    if (!S.next(0, cur)) return;
    f32x4 acc[2][2][4][2];
#pragma unroll
    for (int a = 0; a < 2; ++a)
#pragma unroll
        for (int b = 0; b < 2; ++b)
#pragma unroll
            for (int m = 0; m < 4; ++m)
#pragma unroll
                for (int n = 0; n < 2; ++n) acc[a][b][m][n] = (f32x4){0.f, 0.f, 0.f, 0.f};
    bf16x8 At[4][2], B0[2][2], B1[2][2];
    const char* cA = (const char*)g.A + (size_t)cur.pa * tstep + (size_t)cur.koff * 2; const char* cB = (const char*)g.Bt + (size_t)cur.pb * tstep + (size_t)cur.koff * 2;
    {
        PG8_STAGE(PG8_SB(0, 0), cB, voffB); PG8_STAGE(PG8_SB(0, 1), cB + hstep, voffB); PG8_STAGE(PG8_SA(0, 0), cA, voffA); PG8_STAGE(PG8_SA(0, 1), cA + hstep, voffA);
        if (wr == 1) PG8_BAR;
        PG8_WAIT_V(2); PG8_BAR;
        PG8_STAGE(PG8_SB(1, 0), cB + kstep, voffB); PG8_STAGE(PG8_SA(1, 0), cA + kstep, voffA); PG8_STAGE(PG8_SB(1, 1), cB + hstep + kstep, voffB);
        PG8_WAIT_V(6); PG8_BAR;
    }
    for (;;) {
        const bool has_next = S.next(ui + 1, nxt);
        const char* nA = has_next ? (const char*)g.A + (size_t)nxt.pa * tstep + (size_t)nxt.koff * 2 : cA; const char* nB = has_next ? (const char*)g.Bt + (size_t)nxt.pb * tstep + (size_t)nxt.koff * 2 : cB;
        for (int t = 0; t < nt; t += 2) {
            const bool last = (t == nt - 2);
            const char* a1 = cA + (size_t)(t + 1) * kstep;
            const char* a2 = last ? nA : cA + (size_t)(t + 2) * kstep; const char* b2 = last ? nB : cB + (size_t)(t + 2) * kstep;
            const char* a3 = a2 + kstep; const char* b3 = b2 + kstep;
            PG8_LDB(B0, 0, 0); PG8_LDB(B1, 0, 1); PG8_SCHED; PG8_LDA(At, 0, 0); PG8_STAGE(PG8_SA(1, 1), a1 + hstep, voffA);
            PG8_WAIT_V(8); PG8_WAIT_L(0); PG8_BAR; PG8_MMA(0, 0, At, B0); PG8_MMA(0, 1, At, B1); PG8_BAR; PG8_SCHED;
            PG8_LDA(At, 0, 1); PG8_STAGE(PG8_SB(0, 0), b2, voffB); PG8_STAGE(PG8_SB(0, 1), b2 + hstep, voffB); PG8_STAGE(PG8_SA(0, 0), a2, voffA);
            PG8_WAIT_V(8); PG8_WAIT_L(0); PG8_BAR; PG8_MMA(1, 0, At, B0); PG8_MMA(1, 1, At, B1); PG8_BAR; PG8_SCHED;
            PG8_LDB(B0, 1, 0); PG8_LDB(B1, 1, 1); PG8_SCHED; PG8_LDA(At, 1, 0); PG8_STAGE(PG8_SA(0, 1), a2 + hstep, voffA);
            PG8_WAIT_V(8); PG8_WAIT_L(0); PG8_BAR; PG8_MMA(0, 0, At, B0); PG8_MMA(0, 1, At, B1); PG8_BAR; PG8_SCHED;
            PG8_LDA(At, 1, 1); PG8_STAGE(PG8_SB(1, 0), b3, voffB); PG8_STAGE(PG8_SB(1, 1), b3 + hstep, voffB); PG8_STAGE(PG8_SA(1, 0), a3, voffA);
            PG8_WAIT_V(8); PG8_WAIT_L(0); PG8_BAR; PG8_MMA(1, 0, At, B0); PG8_MMA(1, 1, At, B1); PG8_BAR; PG8_SCHED;
        }
        if constexpr (ALIGN_EPI) { if (wr == 0) PG8_BAR; }
        E(acc, cur, wr, wc, fr, fq);
        if (!has_next) break;
#pragma unroll
        for (int a = 0; a < 2; ++a)
#pragma unroll
            for (int b = 0; b < 2; ++b)
#pragma unroll
                for (int m = 0; m < 4; ++m)
#pragma unroll
                    for (int n = 0; n < 2; ++n) acc[a][b][m][n] = (f32x4){0.f, 0.f, 0.f, 0.f};
        cur = nxt; cA = nA; cB = nB; ++ui;
        if constexpr (ALIGN_EPI) { if (wr == 1) PG8_BAR; }
    }
    PG8_WAIT_V(0);
    if constexpr (!ALIGN_EPI) { if (wr == 0) PG8_BAR; }
    PG8_BAR;
#undef PG8_SA
#undef PG8_SB
#undef PG8_STAGE
#undef PG8_LDA
#undef PG8_LDB
#undef PG8_MMA
#undef PG8_WAIT_V
#undef PG8_WAIT_L
#undef PG8_BAR
#undef PG8_SCHED
}
}
constexpr int D = 2048, NB = 4, TL = 2048, TC = 256, TS = TL + TC  ;
constexpr int MLAT = NB * TL  , MTOK = NB * (TL + TC)  ;
constexpr int DIN = 5824, DINP = 5888, D6 = 6 * D;
constexpr int FF = 5632, FE = 7168, NEXP = 8;
constexpr float EPS = 1e-6f;
constexpr int PC_MLQ = 0, PC_MLK = 512, PC_MLV = 1024, PC_MLO = 1536, PC_IG = 2048, PC_FG = 2056, PC_Z = 2064, PC_XBC = 2576, PC_DT = 3600,
              PC_CQ = 3616, PC_CKV = 4064, PC_KR = 4224, PC_NQ = 4288, PC_NK = 4800, PC_NV = 5312;
constexpr int NCHUNK = 36;
constexpr int MAXMT = 72;

constexpr size_t MiB = 1u << 20;
constexpr size_t WS_CTL = 0, CTL_ZERO_BYTES = 1 * MiB;
constexpr size_t WS_MOD = 1 * MiB;
constexpr size_t WS_WIN = 2 * MiB;
constexpr size_t WS_WOUT = WS_WIN + 46 * MiB;
constexpr size_t WS_WQB = WS_WOUT + 16 * MiB;
constexpr size_t WS_WKVB = WS_WQB + 2 * MiB;
constexpr size_t WS_W13 = WS_WKVB + 1 * MiB;
constexpr size_t WS_W2 = WS_W13 + 44 * MiB;
constexpr size_t WS_MW13 = WS_W2 + 22 * MiB;
constexpr size_t WS_MW2 = WS_MW13 + 448 * MiB;
constexpr size_t WS_HN = WS_MW2 + 224 * MiB;
constexpr size_t WS_A2 = WS_HN + 36 * MiB;
constexpr size_t WS_X = WS_A2 + 36 * MiB;
constexpr size_t WS_BIG = WS_X + 72 * MiB;
constexpr size_t WS_P = WS_BIG;
constexpr size_t WS_GRAW = WS_BIG + 104 * MiB;
constexpr size_t WS_CQN = WS_P + 207 * MiB;
constexpr size_t WS_CKVN = WS_CQN + 9 * MiB;
constexpr size_t WS_QRAW = WS_CKVN + 5 * MiB;
constexpr size_t WS_KVRAW = WS_QRAW + 14 * MiB;
constexpr size_t WS_QMLA = WS_KVRAW + 18 * MiB;
constexpr size_t WS_KMLA = WS_QMLA + 14 * MiB;
constexpr size_t WS_VTMLA = WS_KMLA + 14 * MiB;
constexpr size_t WS_QNA = WS_VTMLA + 9 * MiB;
constexpr size_t WS_KNA = WS_QNA + 9 * MiB;
constexpr size_t WS_VTNA = WS_KNA + 9 * MiB;
constexpr size_t WS_XBC = WS_VTNA + 9 * MiB;
constexpr size_t WS_DT = WS_XBC + 18 * MiB;
constexpr size_t WS_GATES = WS_DT + 1 * MiB;
constexpr size_t WS_MLSC = WS_GATES + 1 * MiB;
constexpr size_t WS_SSSC = WS_MLSC + 64 * 1024;
constexpr size_t WS_MLU = WS_MLSC + 1 * MiB;
constexpr size_t WS_MLS = WS_MLU + 73 * MiB;
constexpr size_t WS_SSU = WS_MLS + 37 * MiB;
constexpr size_t WS_SSS = WS_SSU + 72 * MiB;
constexpr size_t WS_HML = WS_SSS + 36 * MiB;
constexpr size_t WS_YSS = WS_HML + 36 * MiB;
constexpr size_t WS_MIXEND = WS_YSS + 36 * MiB;
constexpr size_t WS_G = WS_BIG;
constexpr size_t WS_Y = WS_G + 252 * MiB;
constexpr size_t WS_XG = WS_Y + 144 * MiB;
constexpr size_t WS_TOK = WS_XG + 256 * MiB;
constexpr size_t WS_PART = WS_TOK + 1 * MiB;
constexpr size_t WS_FFNEND = WS_PART + 64 * MiB;
constexpr size_t WS_END = (WS_MIXEND > WS_FFNEND ? WS_MIXEND : WS_FFNEND);
static_assert(WS_END < (size_t)1800 * MiB, "workspace budget");
static_assert((size_t)MTOK * DINP * 4 <= 207 * MiB && (size_t)32 * 36 * 129 * 128 * 4 <= 73 * MiB, "sizes");
constexpr int CW_BAR = 4096;
constexpr int CW_MOE = 16384;
constexpr int CW_QH = 20480;
constexpr int CW_ARR = 32768;

constexpr int RING_BYTES = 131072;
constexpr int MISC_OFF = 147456 - 256;
constexpr int LDS_BYTES = 147456;
constexpr int NWAVES = 8, NTHR = 512;

#define RLX_AGENT __ATOMIC_RELAXED, __HIP_MEMORY_SCOPE_AGENT
#define LDS_WAIT() asm volatile("s_waitcnt lgkmcnt(0)" ::: "memory")
#define VM_WAIT() asm volatile("s_waitcnt vmcnt(0)" ::: "memory")
DI unsigned pk2(float lo, float hi) { unsigned r; asm("v_cvt_pk_bf16_f32 %0, %1, %2" : "=v"(r) : "v"(lo), "v"(hi)); return r; }
DI unsigned f2bf(float f) { return pk2(f, 0.f) & 0xffffu; }
DI float bf2f(unsigned b) { return __builtin_bit_cast(float, b << 16); }
#define PINV(x) asm volatile("" : "+v"(x))
#define PIN4(a) asm volatile("" : "+v"((a)[0]), "+v"((a)[1]), "+v"((a)[2]), "+v"((a)[3]))
#define PIN8(a) asm volatile("" : "+v"((a)[0]), "+v"((a)[1]), "+v"((a)[2]), "+v"((a)[3]), "+v"((a)[4]), "+v"((a)[5]), "+v"((a)[6]), "+v"((a)[7]))
DI float wave_sum(float v) {
    v += __builtin_bit_cast(float, __builtin_amdgcn_update_dpp(0, __builtin_bit_cast(int, v), 0xB1, 0xf, 0xf, true));
    v += __builtin_bit_cast(float, __builtin_amdgcn_update_dpp(0, __builtin_bit_cast(int, v), 0x4E, 0xf, 0xf, true));
    v += __builtin_bit_cast(float, __builtin_amdgcn_update_dpp(0, __builtin_bit_cast(int, v), 0x141, 0xf, 0xf, true));
    v += __builtin_bit_cast(float, __builtin_amdgcn_update_dpp(0, __builtin_bit_cast(int, v), 0x140, 0xf, 0xf, true));
    const int b = __builtin_bit_cast(int, v);
    const float r0 = __builtin_bit_cast(float, __builtin_amdgcn_readlane(b, 0)), r1 = __builtin_bit_cast(float, __builtin_amdgcn_readlane(b, 16));
    const float r2 = __builtin_bit_cast(float, __builtin_amdgcn_readlane(b, 32)), r3 = __builtin_bit_cast(float, __builtin_amdgcn_readlane(b, 48));
    return (r0 + r1) + (r2 + r3);
}
DI float wave_max(float v) {
    v = fmaxf(v, __builtin_bit_cast(float, __builtin_amdgcn_update_dpp(0, __builtin_bit_cast(int, v), 0xB1, 0xf, 0xf, true)));
    v = fmaxf(v, __builtin_bit_cast(float, __builtin_amdgcn_update_dpp(0, __builtin_bit_cast(int, v), 0x4E, 0xf, 0xf, true)));
    v = fmaxf(v, __builtin_bit_cast(float, __builtin_amdgcn_update_dpp(0, __builtin_bit_cast(int, v), 0x141, 0xf, 0xf, true)));
    v = fmaxf(v, __builtin_bit_cast(float, __builtin_amdgcn_update_dpp(0, __builtin_bit_cast(int, v), 0x140, 0xf, 0xf, true)));
    const int b = __builtin_bit_cast(int, v);
    const float r0 = __builtin_bit_cast(float, __builtin_amdgcn_readlane(b, 0)), r1 = __builtin_bit_cast(float, __builtin_amdgcn_readlane(b, 16));
    const float r2 = __builtin_bit_cast(float, __builtin_amdgcn_readlane(b, 32)), r3 = __builtin_bit_cast(float, __builtin_amdgcn_readlane(b, 48));
    return fmaxf(fmaxf(r0, r1), fmaxf(r2, r3));
}
DI float xor32_max(float v) { const auto r = __builtin_amdgcn_permlane32_swap(__builtin_bit_cast(unsigned, v), __builtin_bit_cast(unsigned, v), false, false); return fmaxf(__builtin_bit_cast(float, r[0]), __builtin_bit_cast(float, r[1])); }
DI float xor32_get(float v, int lane) { const auto r = __builtin_amdgcn_permlane32_swap(__builtin_bit_cast(unsigned, v), __builtin_bit_cast(unsigned, v), false, false); return __builtin_bit_cast(float, lane < 32 ? r[1] : r[0]); }
DI float xor32_sum(float v) { const auto r = __builtin_amdgcn_permlane32_swap(__builtin_bit_cast(unsigned, v), __builtin_bit_cast(unsigned, v), false, false); return __builtin_bit_cast(float, r[0]) + __builtin_bit_cast(float, r[1]); }
DI float wave_incl_scan(float v, int lane) {
    v += __builtin_bit_cast(float, __builtin_amdgcn_update_dpp(0, __builtin_bit_cast(int, v), 0x111, 0xf, 0xf, true));
    v += __builtin_bit_cast(float, __builtin_amdgcn_update_dpp(0, __builtin_bit_cast(int, v), 0x112, 0xf, 0xf, true));
    v += __builtin_bit_cast(float, __builtin_amdgcn_update_dpp(0, __builtin_bit_cast(int, v), 0x114, 0xf, 0xf, true));
    v += __builtin_bit_cast(float, __builtin_amdgcn_update_dpp(0, __builtin_bit_cast(int, v), 0x118, 0xf, 0xf, true));
    const int b = __builtin_bit_cast(int, v);
    const float t0 = __builtin_bit_cast(float, __builtin_amdgcn_readlane(b, 15)), t1 = __builtin_bit_cast(float, __builtin_amdgcn_readlane(b, 31)), t2 = __builtin_bit_cast(float, __builtin_amdgcn_readlane(b, 47));
    return v + (lane >= 16 ? t0 : 0.f) + (lane >= 32 ? t1 : 0.f) + (lane >= 48 ? t2 : 0.f);
}
DI float lane_bcast(float v, int srclane_const) { return __builtin_bit_cast(float, __builtin_amdgcn_readlane(__builtin_bit_cast(int, v), srclane_const)); }
DI float wave_prefix_max(float v, int lane) {
    const int NEG = __builtin_bit_cast(int, -3.0e38f);
    v = fmaxf(v, __builtin_bit_cast(float, __builtin_amdgcn_update_dpp(NEG, __builtin_bit_cast(int, v), 0x111, 0xf, 0xf, false)));
    v = fmaxf(v, __builtin_bit_cast(float, __builtin_amdgcn_update_dpp(NEG, __builtin_bit_cast(int, v), 0x112, 0xf, 0xf, false)));
    v = fmaxf(v, __builtin_bit_cast(float, __builtin_amdgcn_update_dpp(NEG, __builtin_bit_cast(int, v), 0x114, 0xf, 0xf, false)));
    v = fmaxf(v, __builtin_bit_cast(float, __builtin_amdgcn_update_dpp(NEG, __builtin_bit_cast(int, v), 0x118, 0xf, 0xf, false)));
    const int b = __builtin_bit_cast(int, v);
    const float t0 = __builtin_bit_cast(float, __builtin_amdgcn_readlane(b, 15)), t1 = __builtin_bit_cast(float, __builtin_amdgcn_readlane(b, 31)), t2 = __builtin_bit_cast(float, __builtin_amdgcn_readlane(b, 47));
    const float m1 = t0, m2 = fmaxf(t0, t1), m3 = fmaxf(m2, t2);
    return fmaxf(v, lane >= 48 ? m3 : (lane >= 32 ? m2 : (lane >= 16 ? m1 : -3.0e38f)));
}
DI float wave_suffix_max(float v, int lane) {
    const int NEG = __builtin_bit_cast(int, -3.0e38f);
    v = fmaxf(v, __builtin_bit_cast(float, __builtin_amdgcn_update_dpp(NEG, __builtin_bit_cast(int, v), 0x101, 0xf, 0xf, false)));
    v = fmaxf(v, __builtin_bit_cast(float, __builtin_amdgcn_update_dpp(NEG, __builtin_bit_cast(int, v), 0x102, 0xf, 0xf, false)));
    v = fmaxf(v, __builtin_bit_cast(float, __builtin_amdgcn_update_dpp(NEG, __builtin_bit_cast(int, v), 0x104, 0xf, 0xf, false)));
    v = fmaxf(v, __builtin_bit_cast(float, __builtin_amdgcn_update_dpp(NEG, __builtin_bit_cast(int, v), 0x108, 0xf, 0xf, false)));
    const int b = __builtin_bit_cast(int, v);
    const float t1 = __builtin_bit_cast(float, __builtin_amdgcn_readlane(b, 16)), t2 = __builtin_bit_cast(float, __builtin_amdgcn_readlane(b, 32)), t3 = __builtin_bit_cast(float, __builtin_amdgcn_readlane(b, 48));
    const float m2 = t3, m1 = fmaxf(t3, t2), m0 = fmaxf(m1, t1);
    return fmaxf(v, lane < 16 ? m0 : (lane < 32 ? m1 : (lane < 48 ? m2 : -3.0e38f)));
}
DI float siluf(float x) { return x / (1.f + __expf(-x)); }
DI float sigmoidf_(float x) { return 1.f / (1.f + __expf(-x)); }
DI float softplusf_(float x) { return fmaxf(x, 0.f) + log1pf(__expf(-fabsf(x))); }
DI float logsigmoidf_(float x) { return fminf(x, 0.f) - log1pf(__expf(-fabsf(x))); }

#define XB_TMO      128
#define XB_XCNT(j)  (256  + 64 * (j))
#define XB_XSUB(j)  (1280 + 64 * (j))
#define XB_XGEN(j)  (2304 + 64 * (j))
#define XB_TOP      3328
#define XB_TOPGEN   3392
#define XCD_BAR_WORDS 3456
#define XB_SPIN_CAP (1u << 22)
DI unsigned xb_ld(unsigned* p)              { return __hip_atomic_load(p, __ATOMIC_RELAXED, __HIP_MEMORY_SCOPE_AGENT); }
DI unsigned xb_add(unsigned* p, unsigned v) { return __hip_atomic_fetch_add(p, v, __ATOMIC_RELAXED, __HIP_MEMORY_SCOPE_AGENT); }
DI unsigned xb_xcc_id() { return (unsigned)__builtin_amdgcn_s_getreg((3 << 11) | 20) & 0xFu; }
#define XB_SPIN(cond, bar) do { unsigned _sp = 0; while (cond) { __builtin_amdgcn_s_sleep(1); \
    if ((++_sp & 255u) == 0u) { if (xb_ld(&(bar)[XB_TMO])) break; if (_sp > XB_SPIN_CAP) { atomicAdd(&(bar)[XB_TMO], 1u); break; } } } } while (0)
struct XcdBarrier { unsigned* bar; unsigned x; volatile LAS unsigned* st; };
DI XcdBarrier xcd_barrier_post(unsigned* bar, volatile LAS unsigned* st) {
    XcdBarrier b; b.bar = bar; b.x = xb_xcc_id(); b.st = st;
    if (threadIdx.x == 0) (void)xb_add(&bar[XB_XCNT(b.x)], 1u);
    return b;
}
DI void xcd_barrier_complete(unsigned* bar, unsigned x, unsigned& nloc, unsigned& nx) {
    const unsigned G = gridDim.x * gridDim.y * gridDim.z;
    unsigned sum, cnt, mine, sp = 0u;
    for (;;) {
        sum = 0u; cnt = 0u; mine = 0u;
#pragma unroll
        for (unsigned j = 0; j < 16; ++j) { const unsigned c = xb_ld(&bar[XB_XCNT(j)]); sum += c; cnt += (c > 0u) ? 1u : 0u; mine = (j == x) ? c : mine; }
        if (sum == G) break;
        __builtin_amdgcn_s_sleep(1);
        if ((++sp & 255u) == 0u) { if (xb_ld(&bar[XB_TMO])) break; if (sp > XB_SPIN_CAP) { atomicAdd(&bar[XB_TMO], 1u); break; } }
    }
    nloc = mine > 0u ? mine : 1u; nx = cnt > 0u ? cnt : 1u;
}
DI void xcd_barrier(const XcdBarrier& b) {
    asm volatile("s_waitcnt vmcnt(0)" ::: "memory");
    __syncthreads();
    if (threadIdx.x == 0) {
        unsigned* bar = b.bar;
        __builtin_amdgcn_s_waitcnt(0);
        unsigned nloc = b.st[0], nx = b.st[1];
        if (nloc == 0u) { xcd_barrier_complete(bar, b.x, nloc, nx); b.st[0] = nloc; b.st[1] = nx; }
        const unsigned old = xb_add(&bar[XB_XSUB(b.x)], 1u);
        const unsigned gen = old / nloc;
        if (old + 1u == (gen + 1u) * nloc) {
            __builtin_amdgcn_fence(__ATOMIC_RELEASE, "agent");
            asm volatile("s_waitcnt vmcnt(0)" ::: "memory");
            const unsigned og = xb_add(&bar[XB_TOP], 1u);
            const unsigned tg = og / nx;
            if (og + 1u == (tg + 1u) * nx) xb_add(&bar[XB_TOPGEN], 1u);
            else XB_SPIN(xb_ld(&bar[XB_TOPGEN]) == tg, bar);
            __builtin_amdgcn_fence(__ATOMIC_ACQUIRE, "agent");
            xb_add(&bar[XB_XGEN(b.x)], 1u);
            asm volatile("s_waitcnt vmcnt(0)" ::: "memory");
        } else {
            XB_SPIN(xb_ld(&bar[XB_XGEN(b.x)]) == gen, bar);
            __builtin_amdgcn_fence(__ATOMIC_ACQUIRE, "agent");
            asm volatile("s_waitcnt vmcnt(0)" ::: "memory");
        }
    }
    __syncthreads();
}

struct Args { const float* in[35]; float* out; unsigned char* ws; int ph_lo, ph_hi, rep, pad; };
struct Frame {
    LAS unsigned char* lds;
    unsigned char* ws;
    const float* in[35];
    float* out;
    int tid, lane, wave, G, bid, rep;
};
#define WSP(T, off) ((T*)(F.ws + (off)))
DI int rowof(int b, int j) { return j < TL ? b * TL + j : MLAT + b * TC + (j - TL); }

template <int K> DI f32x4 mma16(const LAS bf16* A, int lda, const LAS bf16* Bt, int ldb, int lane, f32x4 acc) {
    const int r = lane & 15, q = lane >> 4;
    const LAS bf16* pa = A + r * lda + 8 * q; const LAS bf16* pb = Bt + r * ldb + 8 * q;
#pragma unroll
    for (int k = 0; k < K; k += 32) {
        const bf16x8 a = *(const LAS bf16x8*)(pa + k); const bf16x8 b = *(const LAS bf16x8*)(pb + k);
        acc = __builtin_amdgcn_mfma_f32_16x16x32_bf16(a, b, acc, 0, 0, 0);
    }
    return acc;
}
struct CvDesc { const float* src; bf16* dst; size_t ld, Kd; int Kv, Nv, k0, n0, dn0; };
DI void tr_load(const CvDesc& d, f32x4 (&v)[16], int lane) {
    const int nn = 4 * (lane & 15), kq = lane >> 4;
#pragma unroll
    for (int i = 0; i < 16; ++i) { const int kk = 4 * i + kq;
        v[i] = (f32x4){0.f, 0.f, 0.f, 0.f};
        if (d.k0 + kk < d.Kv && d.n0 + nn < d.Nv) v[i] = __builtin_nontemporal_load((const f32x4*)(d.src + (size_t)(d.k0 + kk) * d.ld + d.n0 + nn)); }
#pragma unroll
    for (int i = 0; i < 16; ++i) PINV(v[i]);
}
DI void tr_lds(const f32x4 (&v)[16], LAS float* scr, int lane) {
    const int nn = 4 * (lane & 15), kq = lane >> 4;
#pragma unroll
    for (int i = 0; i < 16; ++i) { const int kk = 4 * i + kq; LAS float* s = scr + kk * 65 + nn; s[0] = v[i][0]; s[1] = v[i][1]; s[2] = v[i][2]; s[3] = v[i][3]; }
    LDS_WAIT(); asm volatile("" ::: "memory");
}
DI void tr_out(const CvDesc& d, LAS float* scr, int lane) {
    const int c = lane & 7;
#pragma unroll
    for (int j = 0; j < 8; ++j) { const int n = (lane >> 3) + 8 * j; const LAS float* s = scr + (8 * c) * 65 + n;
        u32x4 o; o.x = pk2(s[0 * 65], s[1 * 65]); o.y = pk2(s[2 * 65], s[3 * 65]); o.z = pk2(s[4 * 65], s[5 * 65]); o.w = pk2(s[6 * 65], s[7 * 65]);
        *(u32x4*)(d.dst + (size_t)(d.dn0 + n) * d.Kd + d.k0 + 8 * c) = o; }
    LDS_WAIT(); asm volatile("" ::: "memory");
}
DI int il_row(int n0, int which) { return (n0 >> 7) * 256 + (n0 & 127) + which * 128; }

constexpr int I_IN = 32 * 92, I_OUT = 32 * 32, I_QB = 8 * 12, I_KVB = 4 * 16, I_F1 = 32 * 88, I_F2 = 88 * 32, I_M1 = 32 * 112, I_M2 = 112 * 32;
constexpr int I_L = I_IN + I_OUT + I_QB + I_KVB;
constexpr int CV_NE = I_L + 2 * I_F1 + I_F2, CV_NQ1 = CV_NE + I_L, CV_NALL = CV_NQ1 + NEXP * (2 * I_M1 + I_M2);
DI CvDesc conv_decode(Frame& F, int it) {
    int r = it;
    if (r >= CV_NQ1) { r -= CV_NQ1;
        if (r < NEXP * 2 * I_M1) { const int e = r / (2 * I_M1); r -= e * 2 * I_M1; const int which = r / I_M1; r -= which * I_M1; const int kb = r / 112, nb = r % 112;
            return CvDesc{(which ? F.in[33] : F.in[32]) + (size_t)e * D * FE, WSP(bf16, WS_MW13) + (size_t)e * 2 * FE * D, (size_t)(FE), (size_t)(D), D, FE, 64 * kb, 64 * nb, il_row(64 * nb, which)}; }
        r -= NEXP * 2 * I_M1;
        { const int e = r / I_M2; r -= e * I_M2; const int kb = r / 32, nb = r % 32;
            return CvDesc{F.in[34] + (size_t)e * FE * D, WSP(bf16, WS_MW2) + (size_t)e * D * FE, (size_t)(D), (size_t)(FE), FE, D, 64 * kb, 64 * nb, 64 * nb}; }
    }
    int l = 0;
    if (r >= CV_NE) { r -= CV_NE; l = 1; }
    else if (r >= I_L) { r -= I_L;
        if (r < 2 * I_F1) { const int which = r / I_F1; r -= which * I_F1; const int kb = r / 88, nb = r % 88;
            return CvDesc{(which ? F.in[29] : F.in[28]), WSP(bf16, WS_W13), (size_t)(FF), (size_t)(D), D, FF, 64 * kb, 64 * nb, il_row(64 * nb, which)}; }
        r -= 2 * I_F1;
        { const int kb = r / 32, nb = r % 32; return CvDesc{F.in[30], WSP(bf16, WS_W2), (size_t)(D), (size_t)(FF), FF, D, 64 * kb, 64 * nb, 64 * nb}; }
    }
    if (r < I_IN) { const int kb = r / 92, nb = r % 92;
        return CvDesc{F.in[7] + (size_t)l * D * DIN, WSP(bf16, WS_WIN) + (size_t)l * DINP * D, (size_t)(DIN), (size_t)(D), D, DIN, 64 * kb, 64 * nb, 64 * nb}; }
    r -= I_IN;
    if (r < I_OUT) { const int kb = r / 32, nb = r % 32;
        return CvDesc{F.in[8] + (size_t)l * D * D, WSP(bf16, WS_WOUT) + (size_t)l * D * D, (size_t)(D), (size_t)(D), D, D, 64 * kb, 64 * nb, 64 * nb}; }
    r -= I_OUT;
    if (r < I_QB) { const int kb = r / 12, nb = r % 12;
        return CvDesc{F.in[19] + (size_t)l * 448 * 768, WSP(bf16, WS_WQB) + (size_t)l * 768 * 512, (size_t)(768), (size_t)(512), 448, 768, 64 * kb, 64 * nb, 64 * nb}; }
    r -= I_QB;
    { const int kb = r / 16, nb = r % 16;
        return CvDesc{F.in[21] + (size_t)l * 160 * 1024, WSP(bf16, WS_WKVB) + (size_t)l * 1024 * 256, (size_t)(1024), (size_t)(256), 160, 1024, 64 * kb, 64 * nb, 64 * nb}; }
}

DI void conv_item(Frame& F, int it, LAS float* scr) { const CvDesc d = conv_decode(F, it); f32x4 v[16]; tr_load(d, v, F.lane); tr_lds(v, scr, F.lane); tr_out(d, scr, F.lane); }
DI void conv_items(Frame& F, int it0, int n, LAS float* scr) {
    if (it0 >= CV_NALL) return;
    if (it0 + n > CV_NALL) n = CV_NALL - it0;
    CvDesc d = conv_decode(F, it0); f32x4 v[16]; tr_load(d, v, F.lane);
    for (int k = 0; k < n; ++k) {
        tr_lds(v, scr, F.lane);
        CvDesc dn = d;
        if (k + 1 < n) { dn = conv_decode(F, it0 + k + 1); tr_load(dn, v, F.lane); }
        tr_out(d, scr, F.lane);
        d = dn;
    }
}
DI void p0_prologue(Frame& F) {
    {
        LAS float* sc = (LAS float*)F.lds;
        LAS float* red = (LAS float*)(F.lds + 5 * 2048 * 4);
        bool have = false;
        for (int u = F.bid; u < 2 * 96; u += F.G) {
            if (!have) {
                float cv[20];
#pragma unroll
                for (int k = 0; k < 20; ++k) { const int i = F.tid + NTHR * k; cv[k] = (i < 4 * 2048) ? F.in[1][i] : F.in[3][i - 4 * 2048]; }
                PIN8(cv); PIN8(cv + 8); PIN4(cv + 16);
#pragma unroll
                for (int k = 0; k < 20; ++k) sc[F.tid + NTHR * k] = siluf(cv[k]);
                have = true;
            }
            __syncthreads();
            const int l = u / 96, j0 = (u % 96) * 128;
            const float* W = F.in[4] + (size_t)l * D * D6 + j0 + 2 * F.lane;
            f32x2 acc[5];
#pragma unroll
            for (int r = 0; r < 5; ++r) acc[r] = (f32x2){0.f, 0.f};
            const int kb = F.wave * 256;
            for (int k = 0; k < 256; k += 8) {
                f32x2 w[8];
#pragma unroll
                for (int i = 0; i < 8; ++i) w[i] = *(const f32x2*)(W + (size_t)(kb + k + i) * D6);
#pragma unroll
                for (int i = 0; i < 8; ++i)
#pragma unroll
                    for (int r = 0; r < 5; ++r) { const float s = sc[r * 2048 + kb + k + i]; acc[r] += w[i] * s; }
            }
#pragma unroll
            for (int r = 0; r < 5; ++r) { red[(F.wave * 5 + r) * 128 + 2 * F.lane] = acc[r][0]; red[(F.wave * 5 + r) * 128 + 2 * F.lane + 1] = acc[r][1]; }
            __syncthreads();
            for (int i = F.tid; i < 5 * 128; i += NTHR) { const int r = i / 128, j = i % 128; float s = F.in[5][l * D6 + j0 + j];
#pragma unroll
                for (int w = 0; w < 8; ++w) s += red[(w * 5 + r) * 128 + j];
                WSP(float, WS_MOD)[(l * 5 + r) * D6 + j0 + j] = s; }
        }
        __syncthreads();
    }
    LAS float* scr = (LAS float*)(F.lds + F.wave * 16640);
    const int gw = F.bid * NWAVES + F.wave, NGW = F.G * NWAVES;
    for (int it = gw; it < I_L; it += NGW) conv_item(F, it, scr);
}

constexpr int CV_EAGER = I_L;
constexpr int CV_NDEF = CV_NALL - CV_EAGER;
DI void conv_fill(Frame& F, int phase, bool work) {
    LAS float* scr = (LAS float*)(F.lds + F.wave * 16640);
    volatile LAS int* bc = (volatile LAS int*)(F.lds + MISC_OFF) + 16;
    unsigned* ctl = WSP(unsigned, WS_CTL);
    __syncthreads();
    if (F.tid == 0) __hip_atomic_fetch_add(ctl + CW_ARR + 64 * phase, 1u, RLX_AGENT);
    if (!work) return;
    for (;;) {
        if (F.tid == 0) {
            int base = -1;
            if (__hip_atomic_load(ctl + CW_ARR + 64 * phase, RLX_AGENT) < (unsigned)F.G) { base = (int)__hip_atomic_fetch_add(ctl + CW_QH, 32u, RLX_AGENT); if (base >= CV_NDEF) base = -1; }
            bc[0] = base;
        }
        __syncthreads();
        const int base = bc[0];
        __syncthreads();
        if (base < 0) break;
        conv_items(F, CV_EAGER + base + F.wave * 4, 4, scr);
    }
}
DI void conv_drain(Frame& F, int upto) {
    LAS float* scr = (LAS float*)(F.lds + F.wave * 16640);
    volatile LAS int* bc = (volatile LAS int*)(F.lds + MISC_OFF) + 16;
    unsigned* ctl = WSP(unsigned, WS_CTL);
    __syncthreads();
    for (;;) {
        if (F.tid == 0) {
            int base = -1;
            if ((int)__hip_atomic_load(ctl + CW_QH, RLX_AGENT) < upto) { base = (int)__hip_atomic_fetch_add(ctl + CW_QH, 64u, RLX_AGENT); if (base >= CV_NDEF) base = -1; }
            bc[0] = base;
        }
        __syncthreads();
        const int base = bc[0];
        __syncthreads();
        if (base < 0) break;
        conv_items(F, CV_EAGER + base + F.wave * 8, 8, scr);
    }
}
template <bool ROUTE>
DI void norm_phase(Frame& F, int l, const float* srcLat, const float* srcCtx, const float* g, int shoff, int nrows) {
    LAS float* rl = (LAS float*)F.lds;
    if (ROUTE) {
        f32x4 rv[8];
#pragma unroll
        for (int i = 0; i < 8; ++i) rv[i] = *(const f32x4*)(F.in[31] + 4 * (F.tid + NTHR * i));
#pragma unroll
        for (int i = 0; i < 8; ++i) PINV(rv[i]);
#pragma unroll
        for (int i = 0; i < 8; ++i) *(LAS f32x4*)(rl + 4 * (F.tid + NTHR * i)) = rv[i];
        __syncthreads(); }
    const int gw = F.bid * NWAVES + F.wave, NGW = F.G * NWAVES;
    bf16* HN = WSP(bf16, WS_HN);
    f32x4 gv[8];
#pragma unroll
    for (int j = 0; j < 8; ++j) gv[j] = *(const f32x4*)(g + 4 * F.lane + 256 * j);
    for (int row = gw; row < nrows; row += NGW) {
        const float* xr = row < MLAT ? srcLat + (size_t)row * D : srcCtx + (size_t)(row - MLAT) * D;
        const int br = row < MLAT ? row / TL : 4;
        const float* mrow = WSP(float, WS_MOD) + (size_t)(l * 5 + br) * D6 + shoff;
        f32x4 v[8], shv[8], scv[8]; float ss = 0.f;
#pragma unroll
        for (int j = 0; j < 8; ++j) { const int c = 4 * F.lane + 256 * j; v[j] = *(const f32x4*)(xr + c); shv[j] = *(const f32x4*)(mrow + c); scv[j] = *(const f32x4*)(mrow + D + c); }
#pragma unroll
        for (int j = 0; j < 8; ++j) { PINV(v[j]); PINV(shv[j]); PINV(scv[j]); }
#pragma unroll
        for (int j = 0; j < 8; ++j) ss += (v[j][0] * v[j][0] + v[j][1] * v[j][1]) + (v[j][2] * v[j][2] + v[j][3] * v[j][3]);
        const float rstd = 1.0f / sqrtf(wave_sum(ss) * (1.f / D) + EPS);
        float lg[8]; u32x2 wk[8];
        if (ROUTE) {
#pragma unroll
            for (int e = 0; e < 8; ++e) lg[e] = 0.f; }
#pragma unroll
        for (int j = 0; j < 8; ++j) { const int c = 4 * F.lane + 256 * j;
            const f32x4 gg = gv[j], sh = shv[j], sc = scv[j];
            f32x4 o;
#pragma unroll
            for (int i = 0; i < 4; ++i) o[i] = v[j][i] * rstd * gg[i] * (1.f + sc[i]) + sh[i];
            u32x2 w; w.x = pk2(o[0], o[1]); w.y = pk2(o[2], o[3]);
            if (ROUTE) wk[j] = w; else *(u32x2*)(HN + (size_t)row * D + c) = w;
            if (ROUTE) {
#pragma unroll
                for (int i = 0; i < 4; ++i) { const f32x4 r0 = *(const LAS f32x4*)(rl + (c + i) * 8), r1 = *(const LAS f32x4*)(rl + (c + i) * 8 + 4);
                    lg[0] += o[i] * r0[0]; lg[1] += o[i] * r0[1]; lg[2] += o[i] * r0[2]; lg[3] += o[i] * r0[3];
                    lg[4] += o[i] * r1[0]; lg[5] += o[i] * r1[1]; lg[6] += o[i] * r1[2]; lg[7] += o[i] * r1[3]; }
                __builtin_amdgcn_sched_barrier(0);
            }
        }
        if (ROUTE) {
#pragma unroll
            for (int e = 0; e < 8; ++e) lg[e] = wave_sum(lg[e]);
            int r1 = 0, r2 = 0;
            if (F.lane == 0) {
                int e1 = 0; float v1 = lg[0];
#pragma unroll
                for (int e = 1; e < 8; ++e) if (lg[e] > v1) { v1 = lg[e]; e1 = e; }
                int e2 = -1; float v2 = -3.0e38f;
#pragma unroll
                for (int e = 0; e < 8; ++e) if (e != e1 && lg[e] > v2) { v2 = lg[e]; e2 = e; }
                const float g2 = 1.f / (1.f + expf(v1 - v2)), g1 = 1.f - g2;
                unsigned* cnt = WSP(unsigned, WS_CTL) + CW_MOE;
                const unsigned p1 = __hip_atomic_fetch_add(cnt + e1, 1u, RLX_AGENT), p2 = __hip_atomic_fetch_add(cnt + e2, 1u, RLX_AGENT);
                int* tk = WSP(int, WS_TOK) + (size_t)row * 8;
                tk[0] = e1; tk[1] = (int)p1; tk[2] = e2; tk[3] = (int)p2; ((float*)tk)[4] = g1; ((float*)tk)[5] = g2;
                r1 = e1 * MLAT + (int)p1; r2 = e2 * MLAT + (int)p2;
            }
            r1 = __builtin_amdgcn_readfirstlane(r1); r2 = __builtin_amdgcn_readfirstlane(r2);
            bf16* XS = WSP(bf16, WS_XG);
#pragma unroll
            for (int j = 0; j < 8; ++j) { const int c = 4 * F.lane + 256 * j; *(u32x2*)(XS + (size_t)r1 * D + c) = wk[j]; *(u32x2*)(XS + (size_t)r2 * D + c) = wk[j]; }
        }
    }
}

DI void moe_tables(Frame& F, LAS int* tb, int NT) {
    if (F.tid == 0) {
        const unsigned* cnt = WSP(unsigned, WS_CTL) + CW_MOE; int ts = 0, us = 0;
        for (int e = 0; e < 8; ++e) { const int c = (int)__hip_atomic_load(cnt + e, RLX_AGENT); const int t = (c + 255) >> 8; tb[e] = c; tb[8 + e] = t; tb[16 + e] = ts; tb[32 + e] = us; ts += t; us += t * NT; }
        tb[24] = ts; tb[40] = us;
    }
    __syncthreads();
}
DI void moe_combine_phase(Frame& F, int l) {
    LAS int* tb = (LAS int*)F.lds; __syncthreads(); moe_tables(F, tb, 1);
    const int gw = F.bid * NWAVES + F.wave, NGW = F.G * NWAVES;
    const float* Y = WSP(float, WS_Y); const float* X = WSP(float, WS_X);
    for (int row = gw; row < MLAT; row += NGW) {
        const int* tk = WSP(int, WS_TOK) + (size_t)row * 8;
        const float g1 = ((const float*)tk)[4], g2 = ((const float*)tk)[5];
        const int s1 = tb[16 + tk[0]] * 256 + tk[1], s2 = tb[16 + tk[2]] * 256 + tk[3];
        const float* mrow = WSP(float, WS_MOD) + (size_t)(l * 5 + row / TL) * D6 + 5 * D;
        f32x4 xv[8], y1[8], y2[8], gq[8];
#pragma unroll
        for (int j = 0; j < 8; ++j) { const int c = 4 * F.lane + 256 * j;
            xv[j] = *(const f32x4*)(X + (size_t)row * D + c); y1[j] = *(const f32x4*)(Y + (size_t)s1 * D + c); y2[j] = *(const f32x4*)(Y + (size_t)s2 * D + c); gq[j] = *(const f32x4*)(mrow + c); }
#pragma unroll
        for (int j = 0; j < 8; ++j) { PINV(xv[j]); PINV(y1[j]); PINV(y2[j]); PINV(gq[j]); }
#pragma unroll
        for (int j = 0; j < 8; ++j) { const int c = 4 * F.lane + 256 * j; const f32x4 gg = gq[j];
            *(f32x4*)(F.out + (size_t)row * D + c) = xv[j] + gg * (y1[j] * g1 + y2[j] * g2); }
    }
}
using pg8::Unit;
struct EpiF32 {
    static constexpr bool PERM = false;
    float* C; int ldc;
    DI void operator()(const f32x4 (&acc)[2][2][4][2], const Unit& u, int wr, int wc, int fr, int fq) const {
        const int row0 = u.pm * 256 + wr * 64 + fr, col0 = u.pn * 256 + wc * 32 + 4 * fq;
#pragma unroll
        for (int ai = 0; ai < 2; ++ai)
#pragma unroll
            for (int m = 0; m < 4; ++m) { float* rowp = C + (size_t)(row0 + ai * 128 + m * 16) * ldc + col0;
#pragma unroll
                for (int bj = 0; bj < 2; ++bj)
#pragma unroll
                    for (int n = 0; n < 2; ++n) *(f32x4*)(rowp + bj * 128 + n * 16) = acc[ai][bj][m][n]; }
    }
};
struct EpiBf16 {
    static constexpr bool PERM = true;
    bf16* O; int ldc;
    DI void operator()(const f32x4 (&acc)[2][2][4][2], const Unit& u, int wr, int wc, int fr, int fq) const {
        const int row0 = u.pm * 256 + wr * 64 + fr, col0 = u.pn * 256 + wc * 32 + 8 * fq;
#pragma unroll
        for (int ai = 0; ai < 2; ++ai)
#pragma unroll
            for (int m = 0; m < 4; ++m) { bf16* rowp = O + (size_t)(row0 + ai * 128 + m * 16) * ldc + col0;
#pragma unroll
                for (int bj = 0; bj < 2; ++bj) { const f32x4 v0 = acc[ai][bj][m][0], v1 = acc[ai][bj][m][1];
                    u32x4 w; w.x = pg8::cvt_pk_bf16(v0[0], v0[1]); w.y = pg8::cvt_pk_bf16(v0[2], v0[3]); w.z = pg8::cvt_pk_bf16(v1[0], v1[1]); w.w = pg8::cvt_pk_bf16(v1[2], v1[3]);
                    *(u32x4*)(rowp + bj * 128) = w; } }
    }
};
struct EpiP {
    static constexpr bool PERM = true;
    bf16* O; float* graw;
    DI void operator()(const f32x4 (&acc)[2][2][4][2], const Unit& u, int wr, int wc, int fr, int fq) const {
        const int row0 = u.pm * 256 + wr * 64 + fr, col0 = u.pn * 256 + wc * 32 + 8 * fq;
#pragma unroll
        for (int ai = 0; ai < 2; ++ai)
#pragma unroll
            for (int m = 0; m < 4; ++m) { bf16* rowp = O + (size_t)(row0 + ai * 128 + m * 16) * DINP + col0;
#pragma unroll
                for (int bj = 0; bj < 2; ++bj) { const f32x4 v0 = acc[ai][bj][m][0], v1 = acc[ai][bj][m][1];
                    u32x4 w; w.x = pg8::cvt_pk_bf16(v0[0], v0[1]); w.y = pg8::cvt_pk_bf16(v0[2], v0[3]); w.z = pg8::cvt_pk_bf16(v1[0], v1[1]); w.w = pg8::cvt_pk_bf16(v1[2], v1[3]);
                    *(u32x4*)(rowp + bj * 128) = w; } }
        const bool gsel = (u.pn == 8 && wc == 0 && fq < 2), dsel = (u.pn == 14 && wc == 0 && fq >= 2);
        if (gsel || dsel) { const int off = gsel ? 8 * fq : 16 + 8 * (fq - 2);
#pragma unroll
            for (int ai = 0; ai < 2; ++ai)
#pragma unroll
                for (int m = 0; m < 4; ++m) { float* gp = graw + (size_t)(row0 + ai * 128 + m * 16) * 32 + off;
                    *(f32x4*)gp = acc[ai][0][m][0]; *(f32x4*)(gp + 4) = acc[ai][0][m][1]; } }
    }
};
struct EpiSwiglu {
    static constexpr bool PERM = true;
    bf16* O; int ldc;
    DI void operator()(const f32x4 (&acc)[2][2][4][2], const Unit& u, int wr, int wc, int fr, int fq) const {
        const int row0 = u.pm * 256 + wr * 64 + fr, col0 = u.pn * 128 + wc * 32 + 8 * fq;
#pragma unroll
        for (int ai = 0; ai < 2; ++ai)
#pragma unroll
            for (int m = 0; m < 4; ++m) { bf16* rowp = O + (size_t)(row0 + ai * 128 + m * 16) * ldc + col0;
                f32x4 v0, v1;
#pragma unroll
                for (int j = 0; j < 4; ++j) { v0[j] = siluf(acc[ai][0][m][0][j]) * acc[ai][1][m][0][j]; v1[j] = siluf(acc[ai][0][m][1][j]) * acc[ai][1][m][1][j]; }
                u32x4 w; w.x = pg8::cvt_pk_bf16(v0[0], v0[1]); w.y = pg8::cvt_pk_bf16(v0[2], v0[3]); w.z = pg8::cvt_pk_bf16(v1[0], v1[1]); w.w = pg8::cvt_pk_bf16(v1[2], v1[3]);
                *(u32x4*)rowp = w; }
    }
};
struct EpiResid {
    static constexpr bool PERM = false;
    const float* baseLat; const float* baseCtx; float* out; const float* mod;
    DI void operator()(const f32x4 (&acc)[2][2][4][2], const Unit& u, int wr, int wc, int fr, int fq) const {
        const int row0 = u.pm * 256 + wr * 64 + fr, col0 = u.pn * 256 + wc * 32 + 4 * fq;
        const int br = (u.pm * 256 < MLAT) ? (u.pm * 256) / TL : 4;
        const float* gate = mod + (size_t)br * D6 + col0;
        f32x4 gv[2][2];
#pragma unroll
        for (int bj = 0; bj < 2; ++bj)
#pragma unroll
            for (int n = 0; n < 2; ++n) gv[bj][n] = *(const f32x4*)(gate + bj * 128 + n * 16);
#pragma unroll
        for (int ai = 0; ai < 2; ++ai)
#pragma unroll
            for (int mp = 0; mp < 2; ++mp) {
                f32x4 bv[2][2][2];
#pragma unroll
                for (int mi = 0; mi < 2; ++mi) { const int row = row0 + ai * 128 + (2 * mp + mi) * 16;
                    const float* bp = (row < MLAT ? baseLat + (size_t)row * D : baseCtx + (size_t)(row - MLAT) * D) + col0;
#pragma unroll
                    for (int bj = 0; bj < 2; ++bj)
#pragma unroll
                        for (int n = 0; n < 2; ++n) bv[mi][bj][n] = *(const f32x4*)(bp + bj * 128 + n * 16); }
#pragma unroll
                for (int mi = 0; mi < 2; ++mi)
#pragma unroll
                    for (int bj = 0; bj < 2; ++bj)
#pragma unroll
                        for (int n = 0; n < 2; ++n) PINV(bv[mi][bj][n]);
#pragma unroll
                for (int mi = 0; mi < 2; ++mi) { const int m = 2 * mp + mi, row = row0 + ai * 128 + m * 16; float* op = out + (size_t)row * D + col0;
#pragma unroll
                    for (int bj = 0; bj < 2; ++bj)
#pragma unroll
                        for (int n = 0; n < 2; ++n) *(f32x4*)(op + bj * 128 + n * 16) = bv[mi][bj][n] + gv[bj][n] * acc[ai][bj][m][n]; }
            }
    }
};
struct MoeOrder {
    const LAS int* tb; int NT, G, c, L0, nT, S, KS, acap;
    DI bool next(int i, Unit& u) const {
        const long T = (long)i * G + c; if (T >= nT) return false;
        const int nun = tb[40], L = L0 + (int)T / S, sl = (int)T % S;
        const int w = pg8::xcd_remap(L, nun); int e = 0;
#pragma unroll
        for (int k = 1; k < 8; ++k) if (w >= tb[32 + k]) e = k;
        const int rem = w - tb[32 + e], tiles = tb[8 + e], nt = rem / tiles, mtl = rem - nt * tiles;
        u.pm = tb[16 + e] + mtl; u.pn = nt; u.pb = e * NT + nt; u.koff = sl * KS; u.aux = (int)T; u.pa = acap ? e * acap + mtl : u.pm; return true;
    }
};
struct EpiPart {
    static constexpr bool PERM = false;
    float* part;
    DI void operator()(const f32x4 (&acc)[2][2][4][2], const Unit& u, int wr, int wc, int fr, int fq) const {
        f32x4* p = (f32x4*)part + (size_t)u.aux * (32 * NTHR) + threadIdx.x;
#pragma unroll
        for (int ai = 0; ai < 2; ++ai)
#pragma unroll
            for (int bj = 0; bj < 2; ++bj)
#pragma unroll
                for (int m = 0; m < 4; ++m)
#pragma unroll
                    for (int n = 0; n < 2; ++n) p[(size_t)(((ai * 2 + bj) * 4 + m) * 2 + n) * NTHR] = acc[ai][bj][m][n];
    }
};
template <int S> DI void splitk_reduce_f32(const float* part, int t, int cg, const Unit& u, float* C, int ldc) {
    const int tid = threadIdx.x, wid = tid >> 6, lane = tid & 63, wr = wid >> 2, wc = wid & 3, fr = lane & 15, fq = lane >> 4;
    f32x4 v[4][S];
#pragma unroll
    for (int k = 0; k < 4; ++k)
#pragma unroll
        for (int s = 0; s < S; ++s) v[k][s] = *((const f32x4*)part + ((size_t)(t * S + s) * 32 + (cg * 4 + k)) * NTHR + tid);
#pragma unroll
    for (int k = 0; k < 4; ++k) { const int ch = cg * 4 + k, n = ch & 1, m = (ch >> 1) & 3, bj = (ch >> 3) & 1, ai = ch >> 4;
        f32x4 a = v[k][0];
#pragma unroll
        for (int s = 1; s < S; ++s) a += v[k][s];
        *(f32x4*)(C + (size_t)(u.pm * 256 + ai * 128 + wr * 64 + m * 16 + fr) * ldc + u.pn * 256 + bj * 128 + wc * 32 + n * 16 + 4 * fq) = a; }
}
DI int tc_of(int dir, int p) { return dir == 0 ? (p < 4 ? 32 + p : p - 4) : 35 - p; }

DI void m1_prep_unit(Frame& F, int l, int b, int tt) {
    const bf16* P = WSP(bf16, WS_P); const float* GR = WSP(float, WS_GRAW);
    const int j0 = tt * 32, lane = F.lane;
    LAS bf16* vs = (LAS bf16*)F.lds;
    float qnv[7], knv[3], gqv[2], gkv[2];
#pragma unroll
    for (int u = 0; u < 7; ++u) qnv[u] = F.in[18][l * 448 + lane + 64 * u];
#pragma unroll
    for (int u = 0; u < 3; ++u) knv[u] = (lane + 64 * u < 160) ? F.in[20][l * 160 + lane + 64 * u] : 0.f;
    gqv[0] = F.in[24][l * 128 + lane]; gqv[1] = F.in[24][l * 128 + 64 + lane]; gkv[0] = F.in[25][l * 128 + lane]; gkv[1] = F.in[25][l * 128 + 64 + lane];
    const float ib = lane < 8 ? F.in[9][l * 8 + lane] : 0.f, fb = lane < 8 ? F.in[10][l * 8 + lane] : 0.f, db = lane < 16 ? F.in[14][l * 16 + lane] : 0.f;
    for (int i = F.wave; i < 32; i += 8) {
        const int j = j0 + i, row = rowof(b, j);
        const bf16* p = P + (size_t)row * DINP; const float* gr = GR + (size_t)row * 32;
        unsigned cqw[7], ckw[3], nqw[4][2], nkw[4][2], nvw[8];
#pragma unroll
        for (int u = 0; u < 7; ++u) cqw[u] = p[PC_CQ + lane + 64 * u];
#pragma unroll
        for (int u = 0; u < 3; ++u) { const int idx = lane + 64 * u; ckw[u] = idx < 160 ? (unsigned)p[PC_CKV + idx] : 0u; }
#pragma unroll
        for (int h = 0; h < 4; ++h) { nqw[h][0] = p[PC_NQ + h * 128 + lane]; nqw[h][1] = p[PC_NQ + h * 128 + 64 + lane]; nkw[h][0] = p[PC_NK + h * 128 + lane]; nkw[h][1] = p[PC_NK + h * 128 + 64 + lane]; }
#pragma unroll
        for (int u = 0; u < 8; ++u) nvw[u] = p[PC_NV + lane + 64 * u];
        float gi = lane < 8 ? gr[lane] : 0.f, gf = lane < 8 ? gr[8 + lane] : 0.f, gd = lane < 16 ? gr[16 + lane] : 0.f;
        PIN4(cqw); PINV(cqw[4]); PINV(cqw[5]); PINV(cqw[6]); PINV(ckw[0]); PINV(ckw[1]); PINV(ckw[2]); PIN8(nvw); PINV(gi); PINV(gf); PINV(gd);
#pragma unroll
        for (int h = 0; h < 4; ++h) { PINV(nqw[h][0]); PINV(nqw[h][1]); PINV(nkw[h][0]); PINV(nkw[h][1]); }
        float cq[7], ckv[3], nq[4][2], nk[4][2]; bf16 nv[8];
#pragma unroll
        for (int u = 0; u < 7; ++u) cq[u] = bf2f(cqw[u]);
#pragma unroll
        for (int u = 0; u < 3; ++u) ckv[u] = bf2f(ckw[u]);
#pragma unroll
        for (int h = 0; h < 4; ++h) { nq[h][0] = bf2f(nqw[h][0]); nq[h][1] = bf2f(nqw[h][1]); nk[h][0] = bf2f(nkw[h][0]); nk[h][1] = bf2f(nkw[h][1]); }
#pragma unroll
        for (int u = 0; u < 8; ++u) nv[u] = (bf16)nvw[u];
        {
            float ss = 0.f;
#pragma unroll
            for (int u = 0; u < 7; ++u) ss += cq[u] * cq[u];
            const float rstd = 1.0f / sqrtf(wave_sum(ss) * (1.f / 448.f) + EPS);
            bf16* o = WSP(bf16, WS_CQN) + (size_t)row * 512;
#pragma unroll
            for (int u = 0; u < 7; ++u) o[lane + 64 * u] = (bf16)f2bf(cq[u] * rstd * qnv[u]);
            o[448 + lane] = 0;
        }
        {
            float ss = 0.f;
#pragma unroll
            for (int u = 0; u < 3; ++u) ss += ckv[u] * ckv[u];
            const float rstd = 1.0f / sqrtf(wave_sum(ss) * (1.f / 160.f) + EPS);
            bf16* o = WSP(bf16, WS_CKVN) + (size_t)row * 256;
#pragma unroll
            for (int u = 0; u < 3; ++u) { const int idx = lane + 64 * u; o[idx] = idx < 160 ? (bf16)f2bf(ckv[u] * rstd * knv[u]) : (bf16)0; }
            o[192 + lane] = 0;
        }
#pragma unroll
        for (int h = 0; h < 4; ++h) {
            const float rq = 1.0f / sqrtf(wave_sum(nq[h][0] * nq[h][0] + nq[h][1] * nq[h][1]) * (1.f / 128.f) + EPS);
            const float rk = 1.0f / sqrtf(wave_sum(nk[h][0] * nk[h][0] + nk[h][1] * nk[h][1]) * (1.f / 128.f) + EPS);
            bf16* oq = WSP(bf16, WS_QNA) + ((size_t)(b * 4 + h) * TS + j) * 128; bf16* ok = WSP(bf16, WS_KNA) + ((size_t)(b * 4 + h) * TS + j) * 128;
            oq[lane] = (bf16)f2bf(nq[h][0] * rq * gqv[0]); oq[64 + lane] = (bf16)f2bf(nq[h][1] * rq * gqv[1]);
            ok[lane] = (bf16)f2bf(nk[h][0] * rk * gkv[0]); ok[64 + lane] = (bf16)f2bf(nk[h][1] * rk * gkv[1]);
        }
#pragma unroll
        for (int u = 0; u < 8; ++u) vs[i * 520 + lane + 64 * u] = nv[u];
        if (lane < 8) {
            float* gt = WSP(float, WS_GATES) + (size_t)row * 16;
            gt[lane] = gi + ib;
            gt[8 + lane] = logsigmoidf_(gf + fb);
        }
        if (lane < 16) WSP(float, WS_DT)[(size_t)row * 16 + lane] = softplusf_(gd + db);
    }
    {
        const int ch = 2 * F.tid;
        const int seglo = j0 < TL ? 0 : TL, seghi = j0 < TL ? TL : TS;
        const float* cw = F.in[12] + (size_t)l * 5 * 1024 + ch; const float* cb = F.in[13] + (size_t)l * 1024 + ch;
        f32x2 w[5];
#pragma unroll
        for (int d = 0; d < 5; ++d) w[d] = *(const f32x2*)(cw + d * 1024);
        const f32x2 bias = *(const f32x2*)cb;
        unsigned xww[36];
#pragma unroll
        for (int d = 0; d < 36; ++d) { const int jj = j0 - 2 + d; xww[d] = 0u; if (jj >= seglo && jj < seghi) xww[d] = *(const unsigned*)(P + (size_t)rowof(b, jj) * DINP + PC_XBC + ch); }
        PIN8(xww); PIN8(xww + 8); PIN8(xww + 16); PIN8(xww + 24); PIN4(xww + 32);
        f32x2 xin[36];
#pragma unroll
        for (int d = 0; d < 36; ++d) xin[d] = (f32x2){bf2f(xww[d] & 0xffffu), bf2f(xww[d] >> 16)};
#pragma unroll
        for (int i = 0; i < 32; ++i) {
            f32x2 a = bias;
#pragma unroll
            for (int d = 0; d < 5; ++d) a += w[d] * xin[i + d];
            *(unsigned*)(WSP(bf16, WS_XBC) + (size_t)rowof(b, j0 + i) * 1024 + ch) = pk2(siluf(a[0]), siluf(a[1]));
        }
    }
    __syncthreads();
    {
        const int t = F.tid; unsigned wv[16];
#pragma unroll
        for (int i = 0; i < 16; ++i) wv[i] = (unsigned)vs[(2 * i) * 520 + t] | ((unsigned)vs[(2 * i + 1) * 520 + t] << 16);
        u32x4* dst = (u32x4*)(WSP(bf16, WS_VTNA) + ((size_t)(b * 4 + (t >> 7)) * 128 + (t & 127)) * TS + j0);
#pragma unroll
        for (int k = 0; k < 4; ++k) dst[k] = (u32x4){wv[4 * k], wv[4 * k + 1], wv[4 * k + 2], wv[4 * k + 3]};
    }
    __syncthreads();
}

DI void ml_a_unit(Frame& F, int seq, int p) {
    const int b = seq >> 3, h = (seq >> 1) & 3, dir = seq & 1, tc = tc_of(dir, p), lane = F.lane;
    const bf16* P = WSP(bf16, WS_P);
    LAS bf16* VW = (LAS bf16*)F.lds;
    LAS bf16* KT = (LAS bf16*)(F.lds + 20736);
    LAS float* wgs = (LAS float*)(F.lds + 39168);
    if (F.wave == 0) {
        const int row = rowof(b, tc * 64 + lane);
        const float* gt = WSP(float, WS_GATES) + (size_t)row * 16;
        const float li = gt[dir * 4 + h], lf = gt[8 + dir * 4 + h];
        const float pre = wave_incl_scan(lf, lane), tot = lane_bcast(pre, 63);
        const float g = dir == 0 ? (tot - pre) + li : (pre - lf) + li;
        const float mloc = wave_max(g);
        wgs[lane] = __expf(g - mloc);
        if (lane == 0) { float* sc = WSP(float, WS_MLSC) + (size_t)(seq * 36 + p) * 4; sc[0] = tot; sc[1] = mloc; }
    }
    {
        unsigned vw[16], kw[16];
#pragma unroll
        for (int it = 0; it < 16; ++it) { const int idx = F.tid + NTHR * it, n = idx >> 7, d = idx & 127;
            const bf16* pr = P + (size_t)rowof(b, tc * 64 + n) * DINP + h * 128 + d; vw[it] = pr[PC_MLV]; kw[it] = pr[PC_MLK]; }
        PIN8(vw); PIN8(vw + 8); PIN8(kw); PIN8(kw + 8);
        float vv[16]; bf16 kk[16];
#pragma unroll
        for (int it = 0; it < 16; ++it) { vv[it] = bf2f(vw[it]); kk[it] = (bf16)kw[it]; }
        __syncthreads();
#pragma unroll
        for (int it = 0; it < 16; ++it) { const int idx = F.tid + NTHR * it, n = idx >> 7, d = idx & 127;
            VW[d * 72 + n] = (bf16)f2bf(vv[it] * wgs[n]); KT[d * 72 + n] = kk[it]; }
    }
    for (int idx = F.tid; idx < 16 * 64; idx += NTHR) { const int rr = idx >> 6, n = idx & 63; VW[(128 + rr) * 72 + n] = rr == 0 ? (bf16)f2bf(wgs[n]) : (bf16)0; }
    __syncthreads();
    float* U = WSP(float, WS_MLU) + (size_t)(seq * 36 + p) * (129 * 128);
    for (int id = F.wave; id < 72; id += 8) { const int dt = id >> 3, et = id & 7;
        const f32x4 acc = mma16<64>(VW + dt * 16 * 72, 72, KT + et * 16 * 72, 72, lane, (f32x4){0.f, 0.f, 0.f, 0.f});
#pragma unroll
        for (int i = 0; i < 4; ++i) { const int d = dt * 16 + 4 * (lane >> 4) + i; if (d < 129) U[d * 128 + et * 16 + (lane & 15)] = acc[i]; } }
    __syncthreads();
}

DI void ss_a_unit(Frame& F, int l, int b, int dir, int p, int g) {
    const int tc = tc_of(dir, p), lane = F.lane;
    LAS bf16* XT = (LAS bf16*)F.lds;
    LAS bf16* BT = (LAS bf16*)(F.lds + 36864);
    LAS float* tails = (LAS float*)(F.lds + 55296);
    const bf16* XBC = WSP(bf16, WS_XBC);
    if (F.wave < 4) {
        const int h = 4 * g + F.wave, row = rowof(b, tc * 64 + lane);
        const float dt = WSP(float, WS_DT)[(size_t)row * 16 + dir * 8 + h];
        const float A = -__expf(F.in[15][l * 16 + dir * 8 + h]);
        const float a = dt * A, pre = wave_incl_scan(a, lane), tot = lane_bcast(pre, 63);
        tails[F.wave * 64 + lane] = (dir == 0 ? __expf(tot - pre) : __expf(pre - a)) * dt;
        if (lane == 0) WSP(float, WS_SSSC)[(size_t)((b * 8 + h) * 2 + dir) * 36 + p] = __expf(tot);
    }
    {
        unsigned xv[32], bv[16];
#pragma unroll
        for (int it = 0; it < 32; ++it) { const int idx = F.tid + NTHR * it, n = idx >> 8, c = idx & 255; xv[it] = XBC[(size_t)rowof(b, tc * 64 + n) * 1024 + g * 256 + c]; }
#pragma unroll
        for (int it = 0; it < 16; ++it) { const int idx = F.tid + NTHR * it, n = idx >> 7, nn = idx & 127; bv[it] = XBC[(size_t)rowof(b, tc * 64 + n) * 1024 + 512 + g * 128 + nn]; }
        PIN8(xv); PIN8(xv + 8); PIN8(xv + 16); PIN8(xv + 24); PIN8(bv); PIN8(bv + 8);
        __syncthreads();
#pragma unroll
        for (int it = 0; it < 32; ++it) { const int idx = F.tid + NTHR * it, n = idx >> 8, c = idx & 255; XT[c * 72 + n] = (bf16)f2bf(bf2f(xv[it]) * tails[(c >> 6) * 64 + n]); }
#pragma unroll
        for (int it = 0; it < 16; ++it) { const int idx = F.tid + NTHR * it, n = idx >> 7, nn = idx & 127; BT[nn * 72 + n] = (bf16)bv[it]; }
    }
    __syncthreads();
    for (int id = F.wave; id < 128; id += 8) { const int hh = id >> 5, rem = id & 31, pt = rem >> 3, nt = rem & 7;
        const f32x4 acc = mma16<64>(XT + (hh * 64 + pt * 16) * 72, 72, BT + nt * 16 * 72, 72, lane, (f32x4){0.f, 0.f, 0.f, 0.f});
        float* U = WSP(float, WS_SSU) + (size_t)(((b * 8 + 4 * g + hh) * 2 + dir) * 36 + p) * 8192;
#pragma unroll
        for (int i = 0; i < 4; ++i) U[(pt * 16 + 4 * (lane >> 4) + i) * 128 + nt * 16 + (lane & 15)] = acc[i]; }
    __syncthreads();
}
DI void ml_scan_unit(Frame& F, int seq, int s4) {
    float* sc = WSP(float, WS_MLSC) + (size_t)seq * 36 * 4;
    const float* U = WSP(float, WS_MLU) + (size_t)seq * 36 * 16512 + s4 * 4128 + F.tid; bf16* S = WSP(bf16, WS_MLS) + (size_t)seq * 36 * 16512 + s4 * 4128 + F.tid;
    float st[9]; float m = 0.f;
#pragma unroll
    for (int k = 0; k < 9; ++k) st[k] = 0.f;
    for (int pg = 0; pg < 36; pg += 12) {
        float u[12][9];
#pragma unroll
        for (int pp = 0; pp < 12; ++pp)
#pragma unroll
            for (int k = 0; k < 9; ++k) u[pp][k] = (F.tid + 512 * k < 4128) ? U[(size_t)(pg + pp) * 16512 + 512 * k] : 0.f;
#pragma unroll
        for (int pp = 0; pp < 12; ++pp) { PIN8(u[pp]); PINV(u[pp][8]); }
#pragma unroll
        for (int pp = 0; pp < 12; ++pp) { const int p = pg + pp;
            const float bl = sc[p * 4], mloc = sc[p * 4 + 1];
            const float mn = fmaxf(bl + m, mloc), wc = __expf(bl + m - mn), wu = __expf(mloc - mn);
            if (s4 == 0 && F.tid == 0) sc[p * 4 + 2] = m;
#pragma unroll
            for (int k = 0; k < 9; ++k) { if (F.tid + 512 * k < 4128) S[(size_t)p * 16512 + 512 * k] = (bf16)f2bf(st[k]); st[k] = wc * st[k] + wu * u[pp][k]; }
            m = mn; }
    }
}
DI void ss_scan_unit(Frame& F, int sq, int half) {
    const float* dec = WSP(float, WS_SSSC) + (size_t)sq * 36;
    const float* U = WSP(float, WS_SSU) + (size_t)sq * 36 * 8192 + half * 4096 + F.tid; bf16* S = WSP(bf16, WS_SSS) + (size_t)sq * 36 * 8192 + half * 4096 + F.tid;
    float st[8];
#pragma unroll
    for (int k = 0; k < 8; ++k) st[k] = 0.f;
    for (int pg = 0; pg < 36; pg += 12) {
        float u[12][8];
#pragma unroll
        for (int pp = 0; pp < 12; ++pp)
#pragma unroll
            for (int k = 0; k < 8; ++k) u[pp][k] = U[(size_t)(pg + pp) * 8192 + 512 * k];
#pragma unroll
        for (int pp = 0; pp < 12; ++pp) PIN8(u[pp]);
#pragma unroll
        for (int pp = 0; pp < 12; ++pp) { const int p = pg + pp; const float dc = dec[p];
#pragma unroll
            for (int k = 0; k < 8; ++k) { S[(size_t)p * 8192 + 512 * k] = (bf16)f2bf(st[k]); st[k] = st[k] * dc + u[pp][k]; } }
    }
}
DI void mla_post_unit(Frame& F, int l, int b, int tt) {
    const bf16* P = WSP(bf16, WS_P);
    const bf16* QRAW = WSP(bf16, WS_QRAW); const bf16* KVRAW = WSP(bf16, WS_KVRAW);
    const int j0 = tt * 32, lane = F.lane;
    LAS bf16* vs = (LAS bf16*)F.lds;
    const float* gq = F.in[22] + l * 192; const float* gk = F.in[23] + l * 192;
    unsigned qw[4][4][3], kw[4][4][2], vw[4][4][2], krw[4];
#pragma unroll
    for (int it = 0; it < 4; ++it) {
        const int row = rowof(b, j0 + F.wave + 8 * it);
        krw[it] = P[(size_t)row * DINP + PC_KR + lane];
#pragma unroll
        for (int h = 0; h < 4; ++h) { const bf16* q = QRAW + (size_t)row * 768 + h * 192; const bf16* kv = KVRAW + (size_t)row * 1024 + h * 256;
            qw[it][h][0] = q[lane]; qw[it][h][1] = q[64 + lane]; qw[it][h][2] = q[128 + lane];
            kw[it][h][0] = kv[lane]; kw[it][h][1] = kv[64 + lane]; vw[it][h][0] = kv[128 + lane]; vw[it][h][1] = kv[192 + lane]; }
    }
#pragma unroll
    for (int it = 0; it < 4; ++it) { PIN4(krw);
#pragma unroll
        for (int h = 0; h < 4; ++h) { PINV(qw[it][h][0]); PINV(qw[it][h][1]); PINV(qw[it][h][2]); PINV(kw[it][h][0]); PINV(kw[it][h][1]); PINV(vw[it][h][0]); PINV(vw[it][h][1]); } }
    float qv[4][4][3], kk[4][4][2], krv[4]; bf16 vv[4][4][2];
#pragma unroll
    for (int it = 0; it < 4; ++it) { krv[it] = bf2f(krw[it]);
#pragma unroll
        for (int h = 0; h < 4; ++h) { qv[it][h][0] = bf2f(qw[it][h][0]); qv[it][h][1] = bf2f(qw[it][h][1]); qv[it][h][2] = bf2f(qw[it][h][2]);
            kk[it][h][0] = bf2f(kw[it][h][0]); kk[it][h][1] = bf2f(kw[it][h][1]); vv[it][h][0] = (bf16)vw[it][h][0]; vv[it][h][1] = (bf16)vw[it][h][1]; } }
    const float gq0 = gq[lane], gq1 = gq[64 + lane], gq2 = gq[128 + lane], gk0 = gk[lane], gk1 = gk[64 + lane], gk2 = gk[128 + lane];
    const int a = lane & 31;
    const float fr = exp2f(-(float)(a & 15) * (13.287712379549449f / 16.f));
#pragma unroll
    for (int it = 0; it < 4; ++it) {
        const int i = F.wave + 8 * it, j = j0 + i; const bool lat = j < TL;
        const float pos = (float)(a < 16 ? (j >> 6) : (j & 63));
        const float ang = pos * fr; const float cs = __cosf(ang), sn = __sinf(ang);
#pragma unroll
        for (int h = 0; h < 4; ++h) {
            {
                const float v0 = qv[it][h][0], v1 = qv[it][h][1], v2 = qv[it][h][2];
                const float rstd = 1.0f / sqrtf(wave_sum(v0 * v0 + v1 * v1 + v2 * v2) * (1.f / 192.f) + EPS);
                const float n0 = v0 * rstd * gq0, n1 = v1 * rstd * gq1; float n2 = v2 * rstd * gq2;
                const float pr = xor32_get(n2, lane);
                if (lat) n2 = lane < 32 ? n2 * cs - pr * sn : pr * sn + n2 * cs;
                bf16* o = WSP(bf16, WS_QMLA) + ((size_t)(b * 4 + h) * TS + j) * 192;
                o[lane] = (bf16)f2bf(n0); o[64 + lane] = (bf16)f2bf(n1); o[128 + lane] = (bf16)f2bf(n2);
            }
            {
                const float v0 = kk[it][h][0], v1 = kk[it][h][1], v2 = krv[it];
                const float rstd = 1.0f / sqrtf(wave_sum(v0 * v0 + v1 * v1 + v2 * v2) * (1.f / 192.f) + EPS);
                const float n0 = v0 * rstd * gk0, n1 = v1 * rstd * gk1; float n2 = v2 * rstd * gk2;
                const float pr = xor32_get(n2, lane);
                if (lat) n2 = lane < 32 ? n2 * cs - pr * sn : pr * sn + n2 * cs;
                bf16* o = WSP(bf16, WS_KMLA) + ((size_t)(b * 4 + h) * TS + j) * 192;
                o[lane] = (bf16)f2bf(n0); o[64 + lane] = (bf16)f2bf(n1); o[128 + lane] = (bf16)f2bf(n2);
                vs[i * 520 + h * 128 + lane] = vv[it][h][0]; vs[i * 520 + h * 128 + 64 + lane] = vv[it][h][1];
            }
        }
    }
    __syncthreads();
    {
        const int t = F.tid; unsigned wv[16];
#pragma unroll
        for (int i = 0; i < 16; ++i) wv[i] = (unsigned)vs[(2 * i) * 520 + t] | ((unsigned)vs[(2 * i + 1) * 520 + t] << 16);
        u32x4* dst = (u32x4*)(WSP(bf16, WS_VTMLA) + ((size_t)(b * 4 + (t >> 7)) * 128 + (t & 127)) * TS + j0);
#pragma unroll
        for (int k = 0; k < 4; ++k) dst[k] = (u32x4){wv[4 * k], wv[4 * k + 1], wv[4 * k + 2], wv[4 * k + 3]};
    }
    __syncthreads();
}

template <int DK, bool NA>
DI void attn_unit(Frame& F, const bf16* Qg, const bf16* Kg, const bf16* VTg, int nA, int tA0, int nB, int tB0, float scale, bf16* Og, int qrow0, const float* rpb) {
    constexpr int KP = DK + 8, KCH = DK / 8, NKC = 64 * KCH / NTHR;
    LAS bf16* Ks = (LAS bf16*)F.lds;
    LAS bf16* VTs = (LAS bf16*)(F.lds + 64 * KP * 2);
    LAS bf16* Ps = (LAS bf16*)(F.lds + 64 * KP * 2 + 128 * 72 * 2) + F.wave * (16 * 72);
    LAS float* rp = (LAS float*)(F.lds + 64 * KP * 2 + 128 * 72 * 2 + 8 * 16 * 72 * 2);
    const int lane = F.lane, r = lane & 15, q = lane >> 4, tid = F.tid, w = F.wave;
    if (NA) { for (int i = tid; i < 15 * 31; i += NTHR) rp[i] = rpb[i]; }
    bf16x8 qf[DK / 32];
#pragma unroll
    for (int kk = 0; kk < DK / 32; ++kk) qf[kk] = *(const bf16x8*)(Qg + (size_t)(w * 16 + r) * DK + 32 * kk + 8 * q);
    f32x4 o[8]; float mrow[4], lrow[4];
#pragma unroll
    for (int d = 0; d < 8; ++d) o[d] = (f32x4){0.f, 0.f, 0.f, 0.f};
#pragma unroll
    for (int i = 0; i < 4; ++i) { mrow[i] = -1.0e30f; lrow[i] = 0.f; }
    const int ntile = nA + nB;
    u32x4 kreg[NKC], vreg[2];
    const int rq = qrow0 + (w >> 2);
    const int r0 = rq - 4 < 0 ? 0 : (rq - 4 > 24 ? 24 : rq - 4);
#define ATT_LOAD(kt) do { _Pragma("unroll") for (int c = 0; c < NKC; ++c) { const int id = tid + NTHR * c, rr = id / KCH, cc = id % KCH; kreg[c] = *(const u32x4*)(Kg + (size_t)((kt) * 64 + rr) * DK + cc * 8); } \
        _Pragma("unroll") for (int c = 0; c < 2; ++c) { const int id = tid + NTHR * c, dd = id >> 3, cc = id & 7; vreg[c] = *(const u32x4*)(VTg + (size_t)dd * TS + (kt) * 64 + cc * 8); } } while (0)
    ATT_LOAD(nA > 0 ? tA0 : tB0);
    for (int it = 0; it < ntile; ++it) {
        const int kt = it < nA ? tA0 + it : tB0 + (it - nA);
        __syncthreads();
#pragma unroll
        for (int c = 0; c < NKC; ++c) { const int id = tid + NTHR * c, rr = id / KCH, cc = id % KCH; *(LAS u32x4*)(Ks + rr * KP + cc * 8) = kreg[c]; }
#pragma unroll
        for (int c = 0; c < 2; ++c) { const int id = tid + NTHR * c, dd = id >> 3, cc = id & 7; *(LAS u32x4*)(VTs + dd * 72 + cc * 8) = vreg[c]; }
        __syncthreads();
        if (it + 1 < ntile) { const int kn = (it + 1) < nA ? tA0 + it + 1 : tB0 + (it + 1 - nA); ATT_LOAD(kn); }
        const bool nbt = NA && kt < 32;
        if (nbt && (kt < r0 || kt >= r0 + 8)) continue;
        f32x4 s[4];
#pragma unroll
        for (int n = 0; n < 4; ++n) s[n] = (f32x4){0.f, 0.f, 0.f, 0.f};
#pragma unroll
        for (int kk = 0; kk < DK / 32; ++kk)
#pragma unroll
            for (int n = 0; n < 4; ++n) { const bf16x8 kf = *(const LAS bf16x8*)(Ks + (n * 16 + r) * KP + 32 * kk + 8 * q); s[n] = __builtin_amdgcn_mfma_f32_16x16x32_bf16(qf[kk], kf, s[n], 0, 0, 0); }
        float mx[4];
#pragma unroll
        for (int i = 0; i < 4; ++i) mx[i] = -1.0e30f;
#pragma unroll
        for (int n = 0; n < 4; ++n)
#pragma unroll
            for (int i = 0; i < 4; ++i) {
                float v = s[n][i] * scale;
                if (nbt) { const int c = (w & 3) * 16 + 4 * q + i, kc = n * 16 + r; const int c0 = c - 8 < 0 ? 0 : (c - 8 > 48 ? 48 : c - 8);
                    v = (kc >= c0 && kc < c0 + 16) ? v + rp[(kt - rq + 7) * 31 + (kc - c + 15)] : -1.0e30f; }
                s[n][i] = v; mx[i] = fmaxf(mx[i], v);
            }
        float alpha[4], rs[4];
#pragma unroll
        for (int i = 0; i < 4; ++i) {
            float m = mx[i]; m = fmaxf(m, __shfl_xor(m, 1)); m = fmaxf(m, __shfl_xor(m, 2)); m = fmaxf(m, __shfl_xor(m, 4)); m = fmaxf(m, __shfl_xor(m, 8));
            const float mn = fmaxf(mrow[i], m); alpha[i] = __expf(mrow[i] - mn); mrow[i] = mn; rs[i] = 0.f;
        }
#pragma unroll
        for (int n = 0; n < 4; ++n)
#pragma unroll
            for (int i = 0; i < 4; ++i) { const float pv = __expf(s[n][i] - mrow[i]); rs[i] += pv; Ps[(4 * q + i) * 72 + n * 16 + r] = (bf16)f2bf(pv); }
#pragma unroll
        for (int i = 0; i < 4; ++i) {
            float t = rs[i]; t += __shfl_xor(t, 1); t += __shfl_xor(t, 2); t += __shfl_xor(t, 4); t += __shfl_xor(t, 8);
            lrow[i] = lrow[i] * alpha[i] + t;
        }
#pragma unroll
        for (int d = 0; d < 8; ++d)
#pragma unroll
            for (int i = 0; i < 4; ++i) o[d][i] *= alpha[i];
        asm volatile("s_waitcnt lgkmcnt(0)" ::: "memory");
#pragma unroll
        for (int kk = 0; kk < 2; ++kk) { const bf16x8 pf = *(const LAS bf16x8*)(Ps + r * 72 + 32 * kk + 8 * q);
#pragma unroll
            for (int d = 0; d < 8; ++d) { const bf16x8 vf = *(const LAS bf16x8*)(VTs + (d * 16 + r) * 72 + 32 * kk + 8 * q); o[d] = __builtin_amdgcn_mfma_f32_16x16x32_bf16(pf, vf, o[d], 0, 0, 0); } }
    }
#undef ATT_LOAD
#pragma unroll
    for (int i = 0; i < 4; ++i) { const float inv = 1.0f / lrow[i]; bf16* op = Og + (size_t)(w * 16 + 4 * q + i) * D + r;
#pragma unroll
        for (int d = 0; d < 8; ++d) op[d * 16] = (bf16)f2bf(o[d][i] * inv); }
    __syncthreads();
}
typedef float f32x16 __attribute__((ext_vector_type(16)));
typedef short s16x4 __attribute__((ext_vector_type(4)));
template <int DK, bool NA>
DI void attn_unit2(Frame& F, const bf16* Qg, const bf16* Kg, const bf16* VTg, int nA, int tA0, int nB, int tB0, float sc2, bf16* Og, int qrow0, const float* rpb) {
    constexpr int KP = DK + 8, KCH = DK / 8, NKC = 64 * KCH / NTHR, NKK = DK / 16;
    constexpr int KTB = 64 * KP * 2, VTB = 128 * 72 * 2, BUFB = KTB + VTB;
    const int lane = F.lane, l32 = lane & 31, h = lane >> 5, tid = F.tid, w = F.wave, g = w & 3, kp = w >> 2;
    LAS float* rp = (LAS float*)(F.lds + 2 * BUFB);
    if (NA) { for (int i = tid; i < 15 * 31; i += NTHR) rp[i] = rpb[i] * 1.4426950408889634f; }
    bf16x8 qf[NKK];
#pragma unroll
    for (int kk = 0; kk < NKK; ++kk) qf[kk] = *(const bf16x8*)(Qg + (size_t)(32 * g + l32) * DK + 16 * kk + 8 * h);
    f32x16 o[4]; float mrun = -1.0e30f, lrun = 0.f;
#pragma unroll
    for (int d = 0; d < 4; ++d)
#pragma unroll
        for (int i = 0; i < 16; ++i) o[d][i] = 0.f;
    const int ntile = nA + nB;
    const int rq = qrow0 + (g >> 1), r0 = rq - 4 < 0 ? 0 : (rq - 4 > 24 ? 24 : rq - 4);
    const int cq = 32 * (g & 1) + l32, c0 = cq - 8 < 0 ? 0 : (cq - 8 > 48 ? 48 : cq - 8);
    u32x4 kreg[NKC], vreg[2];
#define ATT2_TILE(it) ((it) < nA ? tA0 + (it) : tB0 + ((it) - nA))
#define ATT2_LOAD(it) do { const int kt_ = ATT2_TILE(it); \
        _Pragma("unroll") for (int c = 0; c < NKC; ++c) { const int id = tid + NTHR * c, rr = id / KCH, cc = id % KCH; kreg[c] = *(const u32x4*)(Kg + (size_t)(kt_ * 64 + rr) * DK + cc * 8); } \
        _Pragma("unroll") for (int c = 0; c < 2; ++c) { const int id = tid + NTHR * c, dd = id >> 3, cc = id & 7; vreg[c] = *(const u32x4*)(VTg + (size_t)dd * TS + kt_ * 64 + cc * 8); } } while (0)
#define ATT2_STORE(b) do { \
        _Pragma("unroll") for (int c = 0; c < NKC; ++c) { const int id = tid + NTHR * c, rr = id / KCH, cc = id % KCH; *(LAS u32x4*)(F.lds + (b) * BUFB + (rr * KP + cc * 8) * 2) = kreg[c]; } \
        _Pragma("unroll") for (int c = 0; c < 2; ++c) { const int id = tid + NTHR * c, dd = id >> 3, cc = id & 7; *(LAS u32x4*)(F.lds + (b) * BUFB + KTB + (dd * 72 + cc * 8) * 2) = vreg[c]; } } while (0)
    ATT2_LOAD(0); ATT2_STORE(0);
    __syncthreads();
    for (int st = 0; st < ntile; ++st) {
        if (st + 1 < ntile) ATT2_LOAD(st + 1);
        const int kt = ATT2_TILE(st);
        const bool nbt = NA && kt < 32;
        if (!(nbt && (kt < r0 || kt >= r0 + 8))) {
            const LAS bf16* Ks = (const LAS bf16*)(F.lds + (st & 1) * BUFB) + (kp * 32 + l32) * KP + 8 * h;
            const LAS bf16* VTs = (const LAS bf16*)(F.lds + (st & 1) * BUFB + KTB) + l32 * 72 + kp * 32 + 4 * h;
            f32x16 s;
#pragma unroll
            for (int i = 0; i < 16; ++i) s[i] = 0.f;
#pragma unroll
            for (int kk = 0; kk < NKK; ++kk) { const bf16x8 kf = *(const LAS bf16x8*)(Ks + 16 * kk); s = __builtin_amdgcn_mfma_f32_32x32x16_bf16(kf, qf[kk], s, 0, 0, 0); }
            float mx = -1.0e30f;
#pragma unroll
            for (int i = 0; i < 16; ++i) {
                float v = s[i] * sc2;
                if (nbt) { const int kc = kp * 32 + 8 * (i >> 2) + 4 * h + (i & 3); v = (kc >= c0 && kc < c0 + 16) ? v + rp[(kt - rq + 7) * 31 + (kc - cq + 15)] : -1.0e30f; }
                s[i] = v; mx = fmaxf(mx, v);
            }
            mx = xor32_max(mx);
            const float mn = fmaxf(mrun, mx), alpha = __builtin_amdgcn_exp2f(mrun - mn); mrun = mn;
            float rs = 0.f;
#pragma unroll
            for (int i = 0; i < 16; ++i) { const float pv = __builtin_amdgcn_exp2f(s[i] - mn); s[i] = pv; rs += pv; }
            rs = xor32_sum(rs);
            lrun = lrun * alpha + rs;
            if (__any(alpha != 1.0f)) {
#pragma unroll
                for (int d = 0; d < 4; ++d)
#pragma unroll
                    for (int i = 0; i < 16; ++i) o[d][i] *= alpha;
            }
#pragma unroll
            for (int sp = 0; sp < 2; ++sp) {
                u32x4 pw; pw.x = pg8::cvt_pk_bf16(s[8 * sp + 0], s[8 * sp + 1]); pw.y = pg8::cvt_pk_bf16(s[8 * sp + 2], s[8 * sp + 3]);
                pw.z = pg8::cvt_pk_bf16(s[8 * sp + 4], s[8 * sp + 5]); pw.w = pg8::cvt_pk_bf16(s[8 * sp + 6], s[8 * sp + 7]);
                const bf16x8 pf = __builtin_bit_cast(bf16x8, pw);
#pragma unroll
                for (int d = 0; d < 4; ++d) { const LAS bf16* vp = VTs + d * 32 * 72 + 16 * sp;
                    const u32x2 lo = *(const LAS u32x2*)vp, hi = *(const LAS u32x2*)(vp + 8);
                    const u32x4 vv = (u32x4){lo.x, lo.y, hi.x, hi.y};
                    o[d] = __builtin_amdgcn_mfma_f32_32x32x16_bf16(__builtin_bit_cast(bf16x8, vv), pf, o[d], 0, 0, 0); }
            }
        }
        if (st + 1 < ntile) ATT2_STORE((st + 1) & 1);
        __syncthreads();
    }
#undef ATT2_LOAD
#undef ATT2_STORE
#undef ATT2_TILE
    LAS float* ob = (LAS float*)F.lds + g * (66 * 64);
    if (kp == 1) {
#pragma unroll
        for (int d = 0; d < 4; ++d)
#pragma unroll
            for (int i = 0; i < 16; ++i) ob[(d * 16 + i) * 64 + lane] = o[d][i];
        ob[64 * 64 + lane] = mrun; ob[65 * 64 + lane] = lrun;
    }
    __syncthreads();
    if (kp == 0) {
        const float m1 = ob[64 * 64 + lane], l1 = ob[65 * 64 + lane];
        const float mf = fmaxf(mrun, m1), a0 = __builtin_amdgcn_exp2f(mrun - mf), a1 = __builtin_amdgcn_exp2f(m1 - mf);
        const float inv = 1.0f / (lrun * a0 + l1 * a1);
        bf16* op = Og + (size_t)(32 * g + l32) * D + 4 * h;
#pragma unroll
        for (int d = 0; d < 4; ++d)
#pragma unroll
            for (int i4 = 0; i4 < 4; ++i4) {
                float r[4];
#pragma unroll
                for (int j = 0; j < 4; ++j) r[j] = (o[d][4 * i4 + j] * a0 + ob[(d * 16 + 4 * i4 + j) * 64 + lane] * a1) * inv;
                u32x2 wv; wv.x = pk2(r[0], r[1]); wv.y = pk2(r[2], r[3]);
                *(u32x2*)(op + d * 32 + 8 * i4) = wv;
            }
    }
    __syncthreads();
}
DI void ml_c_unit(Frame& F, int seq, int p) {
    const int b = seq >> 3, h = (seq >> 1) & 3, dir = seq & 1, tc = tc_of(dir, p), lane = F.lane, tid = F.tid;
    const bf16* P = WSP(bf16, WS_P);
    constexpr float QS = 0.08838834764831845f;
    LAS bf16* Qs = (LAS bf16*)F.lds;
    LAS bf16* Ksm = (LAS bf16*)(F.lds + 17408);
    LAS bf16* VT = (LAS bf16*)(F.lds + 34816);
    LAS bf16* Cx = (LAS bf16*)(F.lds + 55552);
    LAS bf16* SW = (LAS bf16*)(F.lds + 94720);
    LAS float* av = (LAS float*)(F.lds + 103936);
    LAS float* Mt = av + 64;
    LAS float* Bt = av + 128;
    LAS float* den = av + 192;
    const float m_p = WSP(float, WS_MLSC)[(size_t)(seq * 36 + p) * 4 + 2];
    if (F.wave == 0) {
        const int row = rowof(b, tc * 64 + lane);
        const float* gt = WSP(float, WS_GATES) + (size_t)row * 16;
        const float li = gt[dir * 4 + h], lf = gt[8 + dir * 4 + h];
        const float pre = wave_incl_scan(lf, lane), tot = lane_bcast(pre, 63);
        const float B = dir == 0 ? pre : (tot - pre) + lf;
        const float a = li - B;
        const float cm = dir == 0 ? wave_prefix_max(a, lane) : wave_suffix_max(a, lane);
        av[lane] = a; Mt[lane] = fmaxf(m_p, cm); Bt[lane] = B;
    }
    {
        u32x4 qv[2], kv[2]; unsigned vv[16]; u32x4 cx[5];
        const bf16* Sg = WSP(bf16, WS_MLS) + (size_t)(seq * 36 + p) * 16512;
#pragma unroll
        for (int it = 0; it < 2; ++it) { const int idx = tid + NTHR * it, n = idx >> 4, cc = idx & 15;
            const bf16* pr = P + (size_t)rowof(b, tc * 64 + n) * DINP + h * 128 + cc * 8; qv[it] = *(const u32x4*)(pr + PC_MLQ); kv[it] = *(const u32x4*)(pr + PC_MLK); }
#pragma unroll
        for (int it = 0; it < 16; ++it) { const int idx = tid + NTHR * it, n = idx >> 7, d = idx & 127; vv[it] = P[(size_t)rowof(b, tc * 64 + n) * DINP + PC_MLV + h * 128 + d]; }
#pragma unroll
        for (int it = 0; it < 5; ++it) { const int idx = tid + NTHR * it, rr = idx >> 4, cc = idx & 15; cx[it] = (idx < 144 * 16 && rr < 129) ? *(const u32x4*)(Sg + rr * 128 + cc * 8) : (u32x4){0u, 0u, 0u, 0u}; }
        PINV(qv[0]); PINV(qv[1]); PINV(kv[0]); PINV(kv[1]); PIN8(vv); PIN8(vv + 8); PINV(cx[0]); PINV(cx[1]); PINV(cx[2]); PINV(cx[3]); PINV(cx[4]);
#pragma unroll
        for (int it = 0; it < 2; ++it) { const int idx = tid + NTHR * it, n = idx >> 4, cc = idx & 15; *(LAS u32x4*)(Qs + n * 136 + cc * 8) = qv[it]; *(LAS u32x4*)(Ksm + n * 136 + cc * 8) = kv[it]; }
#pragma unroll
        for (int it = 0; it < 16; ++it) { const int idx = tid + NTHR * it, n = idx >> 7, d = idx & 127; VT[d * 72 + n] = (bf16)vv[it]; }
#pragma unroll
        for (int it = 0; it < 5; ++it) { const int idx = tid + NTHR * it, rr = idx >> 4, cc = idx & 15; if (idx < 144 * 16) *(LAS u32x4*)(Cx + rr * 136 + cc * 8) = cx[it]; }
    }
    for (int idx = tid; idx < 16 * 64; idx += NTHR) { const int rr = idx >> 6, n = idx & 63; VT[(128 + rr) * 72 + n] = rr == 0 ? (bf16)0x3f80 : (bf16)0; }
    __syncthreads();
    for (int id = F.wave; id < 16; id += 8) { const int tt = id >> 2, st = id & 3;
        const bool skip = dir == 0 ? st > tt : st < tt;
        f32x4 acc = (f32x4){0.f, 0.f, 0.f, 0.f};
        if (!skip) acc = mma16<128>(Qs + tt * 16 * 136, 136, Ksm + st * 16 * 136, 136, lane, acc);
        const int s = st * 16 + (lane & 15); const float as = av[s];
#pragma unroll
        for (int i = 0; i < 4; ++i) { const int t = tt * 16 + 4 * (lane >> 4) + i; const bool ok = !skip && (dir == 0 ? s <= t : s >= t);
            SW[t * 72 + s] = (bf16)f2bf(ok ? acc[i] * QS * __expf(as - Mt[t]) : 0.f); } }
    __syncthreads();
    const int tt = F.wave & 3, d0 = F.wave < 4 ? 0 : 5, nd = F.wave < 4 ? 5 : 4;
    f32x4 val[5];
#pragma unroll
    for (int k = 0; k < 5; ++k) { val[k] = (f32x4){0.f, 0.f, 0.f, 0.f};
        if (k < nd) { const int dt = d0 + k;
            const f32x4 a1 = mma16<64>(SW + tt * 16 * 72, 72, VT + dt * 16 * 72, 72, lane, (f32x4){0.f, 0.f, 0.f, 0.f});
            const f32x4 a2 = mma16<128>(Qs + tt * 16 * 136, 136, Cx + dt * 16 * 136, 136, lane, (f32x4){0.f, 0.f, 0.f, 0.f});
#pragma unroll
            for (int i = 0; i < 4; ++i) { const int t = tt * 16 + 4 * (lane >> 4) + i; val[k][i] = a1[i] + a2[i] * QS * __expf(m_p - Mt[t]); }
            if (dt == 8 && (lane & 15) == 0) {
#pragma unroll
                for (int i = 0; i < 4; ++i) den[tt * 16 + 4 * (lane >> 4) + i] = val[k][i]; } } }
    __syncthreads();
    float* H = WSP(float, WS_HML) + (size_t)dir * MTOK * 512;
#pragma unroll
    for (int k = 0; k < 5; ++k) { const int dt = d0 + k; if (k < nd && dt < 8) {
#pragma unroll
        for (int i = 0; i < 4; ++i) { const int t = tt * 16 + 4 * (lane >> 4) + i;
            const float dn = fmaxf(fabsf(den[t]), __expf(-(Bt[t] + Mt[t])));
            H[(size_t)rowof(b, tc * 64 + t) * 512 + h * 128 + dt * 16 + (lane & 15)] = val[k][i] / dn; } } }
    __syncthreads();
}

DI void ss_c_unit(Frame& F, int l, int sq, int p) {
    const int b = sq >> 4, h = (sq >> 1) & 7, dir = sq & 1, g = h >> 2, tc = tc_of(dir, p), lane = F.lane, tid = F.tid;
    const bf16* XBC = WSP(bf16, WS_XBC);
    LAS bf16* Cm = (LAS bf16*)F.lds;
    LAS bf16* Bm = (LAS bf16*)(F.lds + 17408);
    LAS bf16* XT = (LAS bf16*)(F.lds + 34816);
    LAS bf16* Sx = (LAS bf16*)(F.lds + 44032);
    LAS bf16* W = (LAS bf16*)(F.lds + 61440);
    LAS float* cum = (LAS float*)(F.lds + 70656);
    LAS float* dtv = cum + 64;
    if (F.wave == 0) {
        const int row = rowof(b, tc * 64 + lane);
        const float dt = WSP(float, WS_DT)[(size_t)row * 16 + dir * 8 + h];
        const float A = -__expf(F.in[15][l * 16 + dir * 8 + h]);
        const float a = dt * A, pre = wave_incl_scan(a, lane), tot = lane_bcast(pre, 63);
        cum[lane] = dir == 0 ? pre : (tot - pre) + a; dtv[lane] = dt;
    }
    {
        u32x4 bb[2], cc_[2], sx[2]; unsigned xx[8];
        const bf16* Sg = WSP(bf16, WS_SSS) + (size_t)(sq * 36 + p) * 8192;
#pragma unroll
        for (int it = 0; it < 2; ++it) { const int idx = tid + NTHR * it, n = idx >> 4, cc = idx & 15; const bf16* xr = XBC + (size_t)rowof(b, tc * 64 + n) * 1024;
            bb[it] = *(const u32x4*)(xr + 512 + g * 128 + cc * 8); cc_[it] = *(const u32x4*)(xr + 768 + g * 128 + cc * 8); sx[it] = *(const u32x4*)(Sg + n * 128 + cc * 8); }
#pragma unroll
        for (int it = 0; it < 8; ++it) { const int idx = tid + NTHR * it, n = idx >> 6, pp = idx & 63; xx[it] = XBC[(size_t)rowof(b, tc * 64 + n) * 1024 + h * 64 + pp]; }
        PINV(bb[0]); PINV(bb[1]); PINV(cc_[0]); PINV(cc_[1]); PINV(sx[0]); PINV(sx[1]); PIN8(xx);
#pragma unroll
        for (int it = 0; it < 2; ++it) { const int idx = tid + NTHR * it, n = idx >> 4, cc = idx & 15;
            *(LAS u32x4*)(Bm + n * 136 + cc * 8) = bb[it]; *(LAS u32x4*)(Cm + n * 136 + cc * 8) = cc_[it]; *(LAS u32x4*)(Sx + n * 136 + cc * 8) = sx[it]; }
#pragma unroll
        for (int it = 0; it < 8; ++it) { const int idx = tid + NTHR * it, n = idx >> 6, pp = idx & 63; XT[pp * 72 + n] = (bf16)xx[it]; }
    }
    __syncthreads();
    for (int id = F.wave; id < 16; id += 8) { const int tt = id >> 2, st = id & 3;
        const bool skip = dir == 0 ? st > tt : st < tt;
        f32x4 acc = (f32x4){0.f, 0.f, 0.f, 0.f};
        if (!skip) acc = mma16<128>(Cm + tt * 16 * 136, 136, Bm + st * 16 * 136, 136, lane, acc);
        const int s = st * 16 + (lane & 15); const float cs = cum[s], ds = dtv[s];
#pragma unroll
        for (int i = 0; i < 4; ++i) { const int t = tt * 16 + 4 * (lane >> 4) + i; const bool ok = !skip && (dir == 0 ? s <= t : s >= t);
            W[t * 72 + s] = (bf16)f2bf(ok ? acc[i] * __expf(cum[t] - cs) * ds : 0.f); } }
    __syncthreads();
    float* Y = WSP(float, WS_YSS) + (size_t)dir * MTOK * 512;
    for (int id = F.wave; id < 16; id += 8) { const int tt = id >> 2, pt = id & 3;
        const f32x4 a1 = mma16<64>(W + tt * 16 * 72, 72, XT + pt * 16 * 72, 72, lane, (f32x4){0.f, 0.f, 0.f, 0.f});
        const f32x4 a2 = mma16<128>(Cm + tt * 16 * 136, 136, Sx + pt * 16 * 136, 136, lane, (f32x4){0.f, 0.f, 0.f, 0.f});
#pragma unroll
        for (int i = 0; i < 4; ++i) { const int t = tt * 16 + 4 * (lane >> 4) + i;
            Y[(size_t)rowof(b, tc * 64 + t) * 512 + h * 64 + pt * 16 + (lane & 15)] = a1[i] + a2[i] * __expf(cum[t]); } }
    __syncthreads();
}

DI void m5_finish_phase(Frame& F, int l, int nrows) {
    const int gw = F.bid * NWAVES + F.wave, NGW = F.G * NWAVES, lane = F.lane;
    const bf16* P = WSP(bf16, WS_P); const float* H0 = WSP(float, WS_HML); const float* H1 = H0 + (size_t)MTOK * 512;
    const float* Y0 = WSP(float, WS_YSS); const float* Y1 = Y0 + (size_t)MTOK * 512; const bf16* XBC = WSP(bf16, WS_XBC);
    bf16* A2 = WSP(bf16, WS_A2);
    float gn[8], sn[8], dsk[8];
#pragma unroll
    for (int u = 0; u < 8; ++u) { gn[u] = F.in[11][l * 512 + lane + 64 * u]; sn[u] = F.in[17][l * 512 + lane + 64 * u]; dsk[u] = F.in[16][l * 8 + u]; }
    for (int row = gw; row < nrows; row += NGW) {
        const bf16* p = P + (size_t)row * DINP;
        float h0[8], h1[8], y0[8], y1[8], hv[8], ov[8], yv[8], zv[8]; unsigned ow[8], zw[8], xw[8];
#pragma unroll
        for (int u = 0; u < 8; ++u) { const int c = lane + 64 * u;
            h0[u] = H0[(size_t)row * 512 + c]; h1[u] = H1[(size_t)row * 512 + c]; y0[u] = Y0[(size_t)row * 512 + c]; y1[u] = Y1[(size_t)row * 512 + c];
            ow[u] = p[PC_MLO + c]; zw[u] = p[PC_Z + c]; xw[u] = XBC[(size_t)row * 1024 + c]; }
        PIN8(h0); PIN8(h1); PIN8(y0); PIN8(y1); PIN8(ow); PIN8(zw); PIN8(xw);
        bf16 xv[8];
#pragma unroll
        for (int u = 0; u < 8; ++u) { hv[u] = h0[u] + h1[u]; yv[u] = y0[u] + y1[u]; ov[u] = bf2f(ow[u]); zv[u] = bf2f(zw[u]); xv[u] = (bf16)xw[u]; }
#pragma unroll
        for (int h = 0; h < 4; ++h) {
            const float v0 = hv[2 * h], v1 = hv[2 * h + 1]; const int c0 = h * 128 + lane, c1 = c0 + 64;
            const float rstd = 1.0f / sqrtf(wave_sum(v0 * v0 + v1 * v1) * (1.f / 128.f) + EPS);
            A2[(size_t)row * D + c0] = (bf16)f2bf(v0 * rstd * gn[2 * h] * sigmoidf_(ov[2 * h]));
            A2[(size_t)row * D + c1] = (bf16)f2bf(v1 * rstd * gn[2 * h + 1] * sigmoidf_(ov[2 * h + 1]));
        }
        float y[8]; float ss = 0.f;
#pragma unroll
        for (int u = 0; u < 8; ++u) { float v = yv[u] + dsk[u] * bf2f(xv[u]); v *= siluf(zv[u]); y[u] = v; ss += v * v; }
        const float rstd = 1.0f / sqrtf(wave_sum(ss) * (1.f / 512.f) + EPS);
#pragma unroll
        for (int u = 0; u < 8; ++u) { const int c = lane + 64 * u; A2[(size_t)row * D + 512 + c] = (bf16)f2bf(y[u] * rstd * sn[u]); }
    }
}
#ifndef PROBE_MASK
#define PROBE_MASK 0ull
#endif
#define NREP(k) ((((unsigned long long)(PROBE_MASK) >> (k)) & 1ull) ? 2 : 1)
#ifndef UNIT_REP
#define UNIT_REP 0
#endif
#define UREP(i) for (int rp_ = 0; rp_ <= ((F.rep >> (i)) & 1); ++rp_)
#ifndef ONE_LAUNCH
#define ONE_LAUNCH 1
#endif
#ifndef TPROBE_MASK
#define TPROBE_MASK 0ull
#endif
#ifndef TPROBE_AMP
#define TPROBE_AMP 8
#endif
#define TPB(k) do { if (((unsigned long long)(TPROBE_MASK) >> (k)) & 1ull) { if (F.bid == 0 && F.tid == 0) { volatile LAS unsigned long long* tp_ = (volatile LAS unsigned long long*)(F.lds + MISC_OFF + 128); tp_[0] = wall_clock64(); } } } while (0)
#define TPE(k) do { if (((unsigned long long)(TPROBE_MASK) >> (k)) & 1ull) { if (F.bid == 0 && F.tid == 0) { volatile LAS unsigned long long* tp_ = (volatile LAS unsigned long long*)(F.lds + MISC_OFF + 128); tp_[1] += wall_clock64() - tp_[0]; } } } while (0)
#define IN(k) (lo <= (k) && (k) < hi)
#define SEAM(k) do { if (ONE_LAUNCH && hi > (k) + 1) xcd_barrier(bar); } while (0)
#ifndef FILL_MASK
#define FILL_MASK 0x7fffffffull
#endif
#define FILL(k, work) do { if (ONE_LAUNCH) conv_fill(F, (k), (work)); } while (0)
#ifndef NCV_P
#define NCV_P 48
#define NCV_OUT 112
#define NCV_UP 24
#define NCV_DOWN 112
#endif
template <int l> DI void layer_phases(Frame& F, const XcdBarrier& bar, const int lo, const int hi) {
    LAS int* mtb = (LAS int*)(F.lds + RING_BYTES);
        const int pb = 1 + 16 * l;
        const bool wc = (l == 0);
        const int nrows = wc ? MTOK : MLAT;
        const float* modl = WSP(float, WS_MOD) + (size_t)l * 5 * D6;
        if (IN(pb + 0)) { TPB(pb + 0);
            if (l == 0) norm_phase<false>(F, l, F.in[0], F.in[2], F.in[6] + l * D, 0, MTOK);
            else norm_phase<false>(F, l, WSP(float, WS_X), WSP(float, WS_X) + (size_t)MLAT * D, F.in[6] + l * D, 0, MTOK);
            if (l == 1) conv_drain(F, CV_NQ1 - CV_EAGER); SEAM(pb + 0); TPE(pb + 0);
        }
        if (IN(pb + 1)) { TPB(pb + 1);
            const int ncv = ONE_LAUNCH ? NCV_P : 0, gw_ = F.G - ncv;
            if (F.bid < gw_) { pg8::Gemm g{WSP(bf16, WS_HN), WSP(bf16, WS_WIN) + (size_t)l * DINP * D, D, D}; pg8::StaticOrder S; S.init(MTOK / 256, DINP / 256, gw_, F.bid);
                EpiP E{WSP(bf16, WS_P), WSP(float, WS_GRAW)};
                pg8::gemm_phase<EpiP, pg8::StaticOrder>(F.lds, g, S, E); }
            FILL(pb + 1, F.bid >= gw_);
            SEAM(pb + 1); TPE(pb + 1);
        }
        if (IN(pb + 2)) { TPB(pb + 2);
            for (int u = F.bid; u < NB * 72; u += F.G) m1_prep_unit(F, l, u / 72, u % 72);
            SEAM(pb + 2); TPE(pb + 2);
        }
        if (IN(pb + 3)) { TPB(pb + 3);
            { pg8::Gemm g{WSP(bf16, WS_CQN), WSP(bf16, WS_WQB) + (size_t)l * 768 * 512, 512, 512}; pg8::StaticOrder S; S.init(MTOK / 256, 3, F.G, F.bid);
              EpiBf16 E{WSP(bf16, WS_QRAW), 768}; pg8::gemm_phase<EpiBf16, pg8::StaticOrder>(F.lds, g, S, E); }
            __syncthreads();
            { pg8::Gemm g{WSP(bf16, WS_CKVN), WSP(bf16, WS_WKVB) + (size_t)l * 1024 * 256, 256, 256}; pg8::StaticOrder S; S.init(MTOK / 256, 4, F.G, (F.bid + 128) % F.G);
              EpiBf16 E{WSP(bf16, WS_KVRAW), 1024}; pg8::gemm_phase<EpiBf16, pg8::StaticOrder>(F.lds, g, S, E); }
            __syncthreads();
            UREP(2) for (int u = F.bid; u < 1152; u += F.G) ml_a_unit(F, u / 36, u % 36);
            UREP(3) for (int v = (F.bid + 128) % F.G; v < 576; v += F.G) ss_a_unit(F, l, v / 144, (v / 72) & 1, (v % 72) >> 1, v & 1);
            SEAM(pb + 3); TPE(pb + 3);
        }
        if (IN(pb + 4)) { TPB(pb + 4);
            UREP(4) for (int u = F.bid; u < 256; u += F.G) {
                const int bh = u >> 4, qb = u & 15, b = bh >> 2, h = bh & 3;
                const int r0a = 2 * qb - 4 < 0 ? 0 : (2 * qb - 4 > 24 ? 24 : 2 * qb - 4), r0b = 2 * qb - 3 < 0 ? 0 : (2 * qb - 3 > 24 ? 24 : 2 * qb - 3);
                attn_unit2<128, true>(F, WSP(bf16, WS_QNA) + ((size_t)bh * TS + qb * 128) * 128, WSP(bf16, WS_KNA) + (size_t)bh * TS * 128, WSP(bf16, WS_VTNA) + (size_t)bh * 128 * TS,
                                     4, 32, r0b + 8 - r0a, r0a, 0.12751743082459868f,
                                     WSP(bf16, WS_A2) + (size_t)(b * TL + qb * 128) * D + 1536 + h * 128, 2 * qb, F.in[26] + (size_t)(l * 4 + h) * 15 * 31);
            }
            if (wc) UREP(5) for (int v = F.bid; v < 32; v += F.G) {
                const int bh2 = v >> 1, qc = v & 1, b2 = bh2 >> 2, h2 = bh2 & 3;
                attn_unit2<128, false>(F, WSP(bf16, WS_QNA) + ((size_t)bh2 * TS + TL + qc * 128) * 128, WSP(bf16, WS_KNA) + (size_t)bh2 * TS * 128, WSP(bf16, WS_VTNA) + (size_t)bh2 * 128 * TS,
                                      4, 32, 0, 0, 0.12751743082459868f, WSP(bf16, WS_A2) + (size_t)(MLAT + b2 * TC + qc * 128) * D + 1536 + h2 * 128, 0, nullptr);
            }
            UREP(6) for (int v = (F.bid + 32) % F.G; v < 128; v += F.G) ml_scan_unit(F, v >> 2, v & 3);
            UREP(7) for (int v = (F.bid + 96) % F.G; v < 128; v += F.G) ss_scan_unit(F, v >> 1, v & 1);
            UREP(8) for (int v = F.bid; v < 288; v += F.G) mla_post_unit(F, l, v / 72, v % 72);
            SEAM(pb + 4); TPE(pb + 4);
        }
        if (IN(pb + 5)) { TPB(pb + 5);
            const int p0 = wc ? 0 : 4, npp = 36 - p0;
            UREP(9) for (int u = F.bid; u < 256; u += F.G) { const int bh = u >> 4, qb = u & 15, b = bh >> 2, h = bh & 3;
                attn_unit2<192, false>(F, WSP(bf16, WS_QMLA) + ((size_t)bh * TS + qb * 128) * 192, WSP(bf16, WS_KMLA) + (size_t)bh * TS * 192, WSP(bf16, WS_VTMLA) + (size_t)bh * 128 * TS,
                                      36, 0, 0, 0, 0.10411754627862817f, WSP(bf16, WS_A2) + (size_t)(b * TL + qb * 128) * D + 1024 + h * 128, 0, nullptr); }
            if (wc) UREP(10) for (int v = F.bid; v < 32; v += F.G) { const int bh = v >> 1, qc = v & 1, b = bh >> 2, h = bh & 3;
                attn_unit2<192, false>(F, WSP(bf16, WS_QMLA) + ((size_t)bh * TS + TL + qc * 128) * 192, WSP(bf16, WS_KMLA) + (size_t)bh * TS * 192, WSP(bf16, WS_VTMLA) + (size_t)bh * 128 * TS,
                                      4, 32, 0, 0, 0.10411754627862817f, WSP(bf16, WS_A2) + (size_t)(MLAT + b * TC + qc * 128) * D + 1024 + h * 128, 0, nullptr); }
            UREP(11) for (int v = (F.bid + 32) % F.G; v < 32 * npp; v += F.G) ml_c_unit(F, v / npp, p0 + v % npp);
            UREP(12) for (int v = (F.bid + 160) % F.G; v < 64 * npp; v += F.G) ss_c_unit(F, l, v / npp, p0 + v % npp);
            SEAM(pb + 5); TPE(pb + 5);
        }
        if (IN(pb + 6)) { TPB(pb + 6); m5_finish_phase(F, l, nrows); SEAM(pb + 6); TPE(pb + 6); }
        if (IN(pb + 7)) { TPB(pb + 7);
            const int ncv = (ONE_LAUNCH && l == 0) ? NCV_OUT : 0, gw_ = F.G - ncv;
            if (F.bid < gw_) { pg8::Gemm g{WSP(bf16, WS_A2), WSP(bf16, WS_WOUT) + (size_t)l * D * D, D, D}; pg8::StaticOrder S; S.init(nrows / 256, D / 256, gw_, F.bid);
                EpiResid E{l == 0 ? F.in[0] : WSP(float, WS_X), l == 0 ? F.in[2] : WSP(float, WS_X) + (size_t)MLAT * D, WSP(float, WS_X), modl + 2 * D};
                pg8::gemm_phase<EpiResid, pg8::StaticOrder>(F.lds, g, S, E); }
            FILL(pb + 7, F.bid >= gw_);
            SEAM(pb + 7); TPE(pb + 7);
        }
        if (IN(pb + 8)) { TPB(pb + 8);
            if (l == 0) { norm_phase<false>(F, l, WSP(float, WS_X), WSP(float, WS_X) + (size_t)MLAT * D, F.in[27] + l * D, 3 * D, nrows); conv_drain(F, CV_NE - CV_EAGER); }
            else { norm_phase<true>(F, l, WSP(float, WS_X), WSP(float, WS_X) + (size_t)MLAT * D, F.in[27] + l * D, 3 * D, nrows); conv_drain(F, CV_NDEF); }
            SEAM(pb + 8); TPE(pb + 8);
        }
        if (l == 0) {
            if (IN(pb + 10)) { TPB(pb + 10);
                const int ncv = ONE_LAUNCH ? NCV_UP : 0, gw_ = F.G - ncv;
                if (F.bid < gw_) { pg8::Gemm g{WSP(bf16, WS_HN), WSP(bf16, WS_W13), D, D}; pg8::StaticOrder S; S.init(MTOK / 256, 2 * FF / 256, gw_, F.bid);
                    EpiSwiglu E{WSP(bf16, WS_G), FF}; pg8::gemm_phase<EpiSwiglu, pg8::StaticOrder>(F.lds, g, S, E); }
                FILL(pb + 10, F.bid >= gw_);
                SEAM(pb + 10); TPE(pb + 10);
            }
            if (IN(pb + 11)) { TPB(pb + 11);
                const int ncv = ONE_LAUNCH ? NCV_DOWN : 0, gw_ = F.G - ncv;
                if (F.bid < gw_) { pg8::Gemm g{WSP(bf16, WS_G), WSP(bf16, WS_W2), FF, FF}; pg8::StaticOrder S; S.init(MTOK / 256, D / 256, gw_, F.bid);
                    EpiResid E{WSP(float, WS_X), WSP(float, WS_X) + (size_t)MLAT * D, WSP(float, WS_X), modl + 5 * D};
                    pg8::gemm_phase<EpiResid, pg8::StaticOrder>(F.lds, g, S, E); }
                FILL(pb + 11, F.bid >= gw_);
                SEAM(pb + 11); TPE(pb + 11);
            }
        } else {
            if (IN(pb + 10)) { TPB(pb + 10);
                __syncthreads(); moe_tables(F, mtb, 2 * FE / 256);
                pg8::Gemm g{WSP(bf16, WS_XG), WSP(bf16, WS_MW13), D, D}; MoeOrder S{mtb, 2 * FE / 256, F.G, F.bid, 0, mtb[40], 1, 0, MLAT / 256};
                EpiSwiglu E{WSP(bf16, WS_G), FE}; pg8::gemm_phase<EpiSwiglu, MoeOrder>(F.lds, g, S, E);
                SEAM(pb + 10); TPE(pb + 10);
            }
            if (IN(pb + 11)) { TPB(pb + 11);
                __syncthreads(); moe_tables(F, mtb, D / 256);
                const int nun = mtb[40], nfull0 = (nun / F.G) * F.G, nt0 = nun - nfull0;
                const int SK = nt0 == 0 ? 1 : (nt0 <= 32 ? 8 : (nt0 <= 64 ? 4 : (nt0 <= 128 ? 2 : 1)));
                const int nfull = SK == 1 ? nun : nfull0, ntail = nun - nfull;
                { pg8::Gemm g{WSP(bf16, WS_G), WSP(bf16, WS_MW2), FE, FE}; MoeOrder S{mtb, D / 256, F.G, F.bid, 0, nfull, 1, 0, 0};
                  EpiF32 E{WSP(float, WS_Y), D}; pg8::gemm_phase<EpiF32, MoeOrder>(F.lds, g, S, E); }
                if (ntail > 0) { __syncthreads();
                  pg8::Gemm g{WSP(bf16, WS_G), WSP(bf16, WS_MW2), FE / SK, FE}; MoeOrder S{mtb, D / 256, F.G, F.bid, nfull, ntail * SK, SK, FE / SK, 0};
                  EpiPart E{WSP(float, WS_PART)}; pg8::gemm_phase<EpiPart, MoeOrder>(F.lds, g, S, E); }
                SEAM(pb + 11); TPE(pb + 11);
            }
            if (IN(pb + 12)) { TPB(pb + 12);
                __syncthreads(); moe_tables(F, mtb, D / 256);
                const int nun = mtb[40], nfull0 = (nun / F.G) * F.G, nt0 = nun - nfull0;
                const int SK = nt0 == 0 ? 1 : (nt0 <= 32 ? 8 : (nt0 <= 64 ? 4 : (nt0 <= 128 ? 2 : 1)));
                const int nfull = SK == 1 ? nun : nfull0, ntail = nun - nfull;
                for (int it = F.bid; it < ntail * 8; it += F.G) { const int t = it >> 3, cg = it & 7;
                    MoeOrder S{mtb, D / 256, 1, 0, nfull + t, 1, 1, 0, 0}; pg8::Unit u; S.next(0, u);
                    if (SK == 8) splitk_reduce_f32<8>(WSP(float, WS_PART), t, cg, u, WSP(float, WS_Y), D);
                    else if (SK == 4) splitk_reduce_f32<4>(WSP(float, WS_PART), t, cg, u, WSP(float, WS_Y), D);
                    else splitk_reduce_f32<2>(WSP(float, WS_PART), t, cg, u, WSP(float, WS_Y), D); }
                SEAM(pb + 12); TPE(pb + 12);
            }
            if (IN(pb + 13)) { TPB(pb + 13); moe_combine_phase(F, l); __syncthreads(); TPE(pb + 13); }
        }
}
__global__ void __launch_bounds__(NTHR, 2) fwd_kernel(Args args) {
    extern __shared__ __attribute__((aligned(16))) unsigned char lds[];
    Frame F;
    F.lds = (LAS unsigned char*)lds; F.ws = args.ws; F.out = args.out;
#pragma unroll
    for (int i = 0; i < 35; ++i) F.in[i] = args.in[i];
    F.tid = threadIdx.x; F.lane = F.tid & 63; F.wave = __builtin_amdgcn_readfirstlane(F.tid >> 6); F.G = gridDim.x; F.bid = blockIdx.x; F.rep = args.rep;
    volatile LAS unsigned* MISC = (volatile LAS unsigned*)(F.lds + MISC_OFF);
    if (F.tid < 64) MISC[F.tid] = 0u;
    __syncthreads();
    XcdBarrier bar; bar.bar = WSP(unsigned, WS_CTL) + CW_BAR; bar.x = 0; bar.st = nullptr;
    if (ONE_LAUNCH) bar = xcd_barrier_post(WSP(unsigned, WS_CTL) + CW_BAR, MISC + 8);
    const int lo = args.ph_lo, hi = args.ph_hi;

    if (IN(0)) { TPB(0); p0_prologue(F); SEAM(0); TPE(0); }

    layer_phases<0>(F, bar, lo, hi);
    layer_phases<1>(F, bar, lo, hi);
    if (TPROBE_MASK != 0ull && F.bid == 0 && F.tid == 0) { volatile LAS unsigned long long* tp_ = (volatile LAS unsigned long long*)(F.lds + MISC_OFF + 128);
        const unsigned long long t0 = wall_clock64(), dur = tp_[1] * TPROBE_AMP; while (wall_clock64() - t0 < dur) __builtin_amdgcn_s_sleep(8); }
#undef IN
#undef SEAM
}

extern "C" void kernel_launch(void* const* d_in, const int* in_sizes, int n_in, void* d_out, int out_size, void* d_ws, size_t ws_size, hipStream_t stream) {
    static int grid = 0;
    if (grid == 0) {
        if (n_in != 35 || out_size != MLAT * D || ws_size < WS_END) { fprintf(stderr, "kernel_launch: unexpected shapes (n_in %d out %d ws %zu need %zu)\n", n_in, out_size, ws_size, (size_t)WS_END); grid = -1; return; }
        int dev = 0, cus = 0, per_cu = 0;
        if (hipGetDevice(&dev) != hipSuccess || hipDeviceGetAttribute(&cus, hipDeviceAttributeMultiprocessorCount, dev) != hipSuccess) { grid = -1; return; }
        if (hipFuncSetAttribute((const void*)fwd_kernel, hipFuncAttributeMaxDynamicSharedMemorySize, LDS_BYTES) != hipSuccess) { fprintf(stderr, "kernel_launch: hipFuncSetAttribute failed\n"); grid = -1; return; }
        if (hipOccupancyMaxActiveBlocksPerMultiprocessor(&per_cu, (const void*)fwd_kernel, NTHR, LDS_BYTES) != hipSuccess || per_cu < 1) { fprintf(stderr, "kernel_launch: occupancy query says %d\n", per_cu); }
        (void)hipGetLastError();
        grid = cus;
    }
    if (grid < 0) return;
    (void)hipMemsetAsync((char*)d_ws + WS_CTL, 0, CTL_ZERO_BYTES, stream);
    Args a{};
    for (int i = 0; i < 35; ++i) a.in[i] = (const float*)d_in[i];
    a.out = (float*)d_out; a.ws = (unsigned char*)d_ws; a.rep = UNIT_REP;
#if ONE_LAUNCH
    a.ph_lo = 0; a.ph_hi = 64;
    hipLaunchKernelGGL(fwd_kernel, dim3(grid), dim3(NTHR), LDS_BYTES, stream, a);
#else
    static const int phases[] = {0, 1, 2, 3, 4, 5, 6, 7, 8, 9, 11, 12, 17, 18, 19, 20, 21, 22, 23, 24, 25, 27, 28, 29, 30};
    for (int k = 0; k < (int)(sizeof(phases) / sizeof(phases[0])); ++k) {
        a.ph_lo = phases[k]; a.ph_hi = phases[k] + 1;
        for (int rp = 0; rp < NREP(phases[k]); ++rp) hipLaunchKernelGGL(fwd_kernel, dim3(grid), dim3(NTHR), LDS_BYTES, stream, a);
    }
#endif
}
```

```cpp
#define NCV_P 48
#define NCV_OUT 96
#define NCV_UP 24
#define NCV_DOWN 96
#define FILL_MASK 0x7fffffffull
#define PROBE_MASK (0ull)
#define ONE_LAUNCH 1
#define UNIT_REP 0
#include <hip/hip_runtime.h>
#include <cstdio>
#include <cstdint>

#define DI __device__ __forceinline__
#define LAS __attribute__((address_space(3)))
#define GAS __attribute__((address_space(1)))
typedef unsigned short bf16;
typedef short bf16x8 __attribute__((ext_vector_type(8)));
typedef float f32x4 __attribute__((ext_vector_type(4)));
typedef float f32x2 __attribute__((ext_vector_type(2)));
typedef unsigned u32x4 __attribute__((ext_vector_type(4)));
typedef unsigned u32x2 __attribute__((ext_vector_type(2)));

namespace pg8 {
constexpr int BM = 256, BK = 64, HALF = 128, HTB = HALF * BK * 2, STAGE_BYTES = 8 * HTB, NXCD = 8, WGM = 8;
__host__ __device__ __forceinline__ int lds_byte(int r, int c) { const int st = (r >> 4) * 2 + (c >> 5), rr = r & 15, cc = c & 31, ob = rr * 64 + cc * 2; return st * 1024 + (ob ^ (((ob >> 9) & 1) << 5)); }
__host__ __device__ __forceinline__ void stage_rc(int b, int& R, int& C) { const int st = b / 1024, sb = b % 1024, swz = sb ^ (((sb >> 9) & 1) << 5); R = (st >> 1) * 16 + swz / 64; C = (st & 1) * 32 + (swz % 64) / 2; }
__host__ __device__ __forceinline__ int perm32(int rho) { const int n = rho >> 4, i = rho & 15; return 8 * (i >> 2) + 4 * n + (i & 3); }

struct Unit { int pm, pn, pb, koff, aux, pa; };
struct Gemm { const bf16* A; const bf16* Bt; int K, ld; };

DI int xcd_remap(int L, int nwg) { const int q = nwg / NXCD, r = nwg % NXCD, xcd = L % NXCD, off = L / NXCD; return (xcd < r ? xcd * (q + 1) : r * (q + 1) + (xcd - r) * q) + off; }

struct StaticOrder {
    int nM, nN, nwg, G, c;
    DI void init(int nM_, int nN_, int G_, int c_) { nM = nM_; nN = nN_; nwg = nM * nN; G = G_; c = c_; }
    DI bool next(int i, Unit& u) const {
        const long L = (long)i * G + c; if (L >= nwg) return false;
        const int wgid = xcd_remap((int)L, nwg);
        const int nig = WGM * nN, gid = wgid / nig, fm = gid * WGM, gsz = (nM - fm) < WGM ? (nM - fm) : WGM;
        u.pm = fm + ((wgid % nig) % gsz); u.pn = (wgid % nig) / gsz; u.pb = u.pn; u.koff = 0; u.aux = 0; u.pa = u.pm; return true;
    }
};

DI unsigned cvt_pk_bf16(float lo, float hi) { unsigned r; asm volatile("v_cvt_pk_bf16_f32 %0, %1, %2" : "=v"(r) : "v"(lo), "v"(hi)); return r; }

template <class Epi, class Sched, bool ALIGN_EPI = true>
DI void gemm_phase(LAS unsigned char* lds, const Gemm g, const Sched& S, const Epi& E) {
    const int tid = threadIdx.x, wid = __builtin_amdgcn_readfirstlane(tid >> 6), lane = tid & 63, wr = wid >> 2, wc = wid & 3, fr = lane & 15, fq = lane >> 4;
    const int K = g.K, nt = K / BK;
    unsigned voffA[2], voffB[2];
#pragma unroll
    for (int i = 0; i < 2; ++i) { int R, C; stage_rc(tid * 16 + i * 8192, R, C); const int Rb = Epi::PERM ? ((R & ~31) + perm32(R & 31)) : R;
        voffA[i] = (unsigned)(R * g.ld + C) * 2u; voffB[i] = (unsigned)(Rb * g.ld + C) * 2u; }
    const size_t kstep = (size_t)(BK * 2);
    const size_t hstep = (size_t)HALF * g.ld * 2;
    const size_t tstep = 2 * hstep;
    const unsigned ldsw = (unsigned)wid * 1024u;
    const int aoff = lds_byte(wr * 64 + fr, fq * 8), boff = lds_byte(wc * 32 + fr, fq * 8);
#define PG8_SA(b, h) (((b) * 2 + (h)) * HTB)
#define PG8_SB(b, h) ((4 + (b) * 2 + (h)) * HTB)
#define PG8_STAGE(bufoff, gbase, voff) do { _Pragma("unroll") for (int _i = 0; _i < 2; ++_i) \
        __builtin_amdgcn_global_load_lds((const unsigned*)((const char*)(gbase) + (voff)[_i]), (LAS unsigned*)(lds + (bufoff) + ldsw + _i * 8192), 16, 0, 0); } while (0)
#define PG8_LDA(dst, b, h) do { _Pragma("unroll") for (int m = 0; m < 4; ++m) _Pragma("unroll") for (int k = 0; k < 2; ++k) dst[m][k] = *(const LAS bf16x8*)(lds + PG8_SA(b, h) + aoff + m * 2048 + k * 1024); } while (0)
#define PG8_LDB(dst, b, h) do { _Pragma("unroll") for (int n = 0; n < 2; ++n) _Pragma("unroll") for (int k = 0; k < 2; ++k) dst[n][k] = *(const LAS bf16x8*)(lds + PG8_SB(b, h) + boff + n * 2048 + k * 1024); } while (0)
#define PG8_MMA(ai, bj, At, Bt) do { __builtin_amdgcn_s_setprio(1); _Pragma("unroll") for (int m = 0; m < 4; ++m) _Pragma("unroll") for (int n = 0; n < 2; ++n) _Pragma("unroll") for (int k = 0; k < 2; ++k) \
        acc[ai][bj][m][n] = __builtin_amdgcn_mfma_f32_16x16x32_bf16(Bt[n][k], At[m][k], acc[ai][bj][m][n], 0, 0, 0); __builtin_amdgcn_s_setprio(0); } while (0)
#define PG8_WAIT_V(n) asm volatile("s_waitcnt vmcnt(" #n ")" ::: "memory")
#define PG8_WAIT_L(n) asm volatile("s_waitcnt lgkmcnt(" #n ")" ::: "memory")
#define PG8_BAR __builtin_amdgcn_s_barrier()
#define PG8_SCHED __builtin_amdgcn_sched_barrier(0)
    Unit cur, nxt; int ui = 0;
    if (!S.next(0, cur)) return;
    f32x4 acc[2][2][4][2];
#pragma unroll
    for (int a = 0; a < 2; ++a)
#pragma unroll
        for (int b = 0; b < 2; ++b)
#pragma unroll
            for (int m = 0; m < 4; ++m)
#pragma unroll
                for (int n = 0; n < 2; ++n) acc[a][b][m][n] = (f32x4){0.f, 0.f, 0.f, 0.f};
    bf16x8 At[4][2], B0[2][2], B1[2][2];
    const char* cA = (const char*)g.A + (size_t)cur.pa * tstep + (size_t)cur.koff * 2; const char* cB = (const char*)g.Bt + (size_t)cur.pb * tstep + (size_t)cur.koff * 2;
    {
        PG8_STAGE(PG8_SB(0, 0), cB, voffB); PG8_STAGE(PG8_SB(0, 1), cB + hstep, voffB); PG8_STAGE(PG8_SA(0, 0), cA, voffA); PG8_STAGE(PG8_SA(0, 1), cA + hstep, voffA);
        if (wr == 1) PG8_BAR;
        PG8_WAIT_V(2); PG8_BAR;
        PG8_STAGE(PG8_SB(1, 0), cB + kstep, voffB); PG8_STAGE(PG8_SA(1, 0), cA + kstep, voffA); PG8_STAGE(PG8_SB(1, 1), cB + hstep + kstep, voffB);
        PG8_WAIT_V(6); PG8_BAR;
    }
    for (;;) {
        const bool has_next = S.next(ui + 1, nxt);
        const char* nA = has_next ? (const char*)g.A + (size_t)nxt.pa * tstep + (size_t)nxt.koff * 2 : cA; const char* nB = has_next ? (const char*)g.Bt + (size_t)nxt.pb * tstep + (size_t)nxt.koff * 2 : cB;
        for (int t = 0; t < nt; t += 2) {
            const bool last = (t == nt - 2);
            const char* a1 = cA + (size_t)(t + 1) * kstep;
            const char* a2 = last ? nA : cA + (size_t)(t + 2) * kstep; const char* b2 = last ? nB : cB + (size_t)(t + 2) * kstep;
            const char* a3 = a2 + kstep; const char* b3 = b2 + kstep;
            PG8_LDB(B0, 0, 0); PG8_LDB(B1, 0, 1); PG8_SCHED; PG8_LDA(At, 0, 0); PG8_STAGE(PG8_SA(1, 1), a1 + hstep, voffA);
            PG8_WAIT_V(8); PG8_WAIT_L(0); PG8_BAR; PG8_MMA(0, 0, At, B0); PG8_MMA(0, 1, At, B1); PG8_BAR; PG8_SCHED;
            PG8_LDA(At, 0, 1); PG8_STAGE(PG8_SB(0, 0), b2, voffB); PG8_STAGE(PG8_SB(0, 1), b2 + hstep, voffB); PG8_STAGE(PG8_SA(0, 0), a2, voffA);
            PG8_WAIT_V(8); PG8_WAIT_L(0); PG8_BAR; PG8_MMA(1, 0, At, B0); PG8_MMA(1, 1, At, B1); PG8_BAR; PG8_SCHED;
            PG8_LDB(B0, 1, 0); PG8_LDB(B1, 1, 1); PG8_SCHED; PG8_LDA(At, 1, 0); PG8_STAGE(PG8_SA(0, 1), a2 + hstep, voffA);
            PG8_WAIT_V(8); PG8_WAIT_L(0); PG8_BAR; PG8_MMA(0, 0, At, B0); PG8_MMA(0, 1, At, B1); PG8_BAR; PG8_SCHED;
            PG8_LDA(At, 1, 1); PG8_STAGE(PG8_SB(1, 0), b3, voffB); PG8_STAGE(PG8_SB(1, 1), b3 + hstep, voffB); PG8_STAGE(PG8_SA(1, 0), a3, voffA);
            PG8_WAIT_V(8); PG8_WAIT_L(0); PG8_BAR; PG8_MMA(1, 0, At, B0); PG8_MMA(1, 1, At, B1); PG8_BAR; PG8_SCHED;
        }
        if constexpr (ALIGN_EPI) { if (wr == 0) PG8_BAR; }
        E(acc, cur, wr, wc, fr, fq);
        if (!has_next) break;
#pragma unroll
        for (int a = 0; a < 2; ++a)
#pragma unroll
            for (int b = 0; b < 2; ++b)
#pragma unroll
                for (int m = 0; m < 4; ++m)
#pragma unroll
                    for (int n = 0; n < 2; ++n) acc[a][b][m][n] = (f32x4){0.f, 0.f, 0.f, 0.f};
        cur = nxt; cA = nA; cB = nB; ++ui;
        if constexpr (ALIGN_EPI) { if (wr == 1) PG8_BAR; }
    }
    PG8_WAIT_V(0);
    if constexpr (!ALIGN_EPI) { if (wr == 0) PG8_BAR; }
    PG8_BAR;
#undef PG8_SA
#undef PG8_SB
#undef PG8_STAGE
#undef PG8_LDA
#undef PG8_LDB
#undef PG8_MMA
#undef PG8_WAIT_V
#undef PG8_WAIT_L
#undef PG8_BAR
#undef PG8_SCHED
}
}
constexpr int D = 2048, NB = 4, TL = 2048, TC = 256, TS = TL + TC  ;
constexpr int MLAT = NB * TL  , MTOK = NB * (TL + TC)  ;
constexpr int DIN = 5824, DINP = 5888, D6 = 6 * D;
constexpr int FF = 5632, FE = 7168, NEXP = 8;
constexpr float EPS = 1e-6f;
constexpr int PC_MLQ = 0, PC_MLK = 512, PC_MLV = 1024, PC_MLO = 1536, PC_IG = 2048, PC_FG = 2056, PC_Z = 2064, PC_XBC = 2576, PC_DT = 3600,
              PC_CQ = 3616, PC_CKV = 4064, PC_KR = 4224, PC_NQ = 4288, PC_NK = 4800, PC_NV = 5312;
constexpr int NCHUNK = 36;
constexpr int MAXMT = 72;

constexpr size_t MiB = 1u << 20;
constexpr size_t WS_CTL = 0, CTL_ZERO_BYTES = 1 * MiB;
constexpr size_t WS_MOD = 1 * MiB;
constexpr size_t WS_WIN = 2 * MiB;
constexpr size_t WS_WOUT = WS_WIN + 46 * MiB;
constexpr size_t WS_WQB = WS_WOUT + 16 * MiB;
constexpr size_t WS_WKVB = WS_WQB + 2 * MiB;
constexpr size_t WS_W13 = WS_WKVB + 1 * MiB;
constexpr size_t WS_W2 = WS_W13 + 44 * MiB;
constexpr size_t WS_MW13 = WS_W2 + 22 * MiB;
constexpr size_t WS_MW2 = WS_MW13 + 448 * MiB;
constexpr size_t WS_HN = WS_MW2 + 224 * MiB;
constexpr size_t WS_A2 = WS_HN + 36 * MiB;
constexpr size_t WS_X = WS_A2 + 36 * MiB;
constexpr size_t WS_BIG = WS_X + 72 * MiB;
constexpr size_t WS_P = WS_BIG;
constexpr size_t WS_GRAW = WS_BIG + 104 * MiB;
constexpr size_t WS_CQN = WS_P + 207 * MiB;
constexpr size_t WS_CKVN = WS_CQN + 9 * MiB;
constexpr size_t WS_QRAW = WS_CKVN + 5 * MiB;
constexpr size_t WS_KVRAW = WS_QRAW + 14 * MiB;
constexpr size_t WS_QMLA = WS_KVRAW + 18 * MiB;
constexpr size_t WS_KMLA = WS_QMLA + 14 * MiB;
constexpr size_t WS_VTMLA = WS_KMLA + 14 * MiB;
constexpr size_t WS_QNA = WS_VTMLA + 9 * MiB;
constexpr size_t WS_KNA = WS_QNA + 9 * MiB;
constexpr size_t WS_VTNA = WS_KNA + 9 * MiB;
constexpr size_t WS_XBC = WS_VTNA + 9 * MiB;
constexpr size_t WS_DT = WS_XBC + 18 * MiB;
constexpr size_t WS_GATES = WS_DT + 1 * MiB;
constexpr size_t WS_MLSC = WS_GATES + 1 * MiB;
constexpr size_t WS_SSSC = WS_MLSC + 64 * 1024;
constexpr size_t WS_MLU = WS_MLSC + 1 * MiB;
constexpr size_t WS_MLS = WS_MLU + 73 * MiB;
constexpr size_t WS_SSU = WS_MLS + 37 * MiB;
constexpr size_t WS_SSS = WS_SSU + 72 * MiB;
constexpr size_t WS_HML = WS_SSS + 36 * MiB;
constexpr size_t WS_YSS = WS_HML + 36 * MiB;
constexpr size_t WS_MIXEND = WS_YSS + 36 * MiB;
constexpr size_t WS_G = WS_BIG;
constexpr size_t WS_Y = WS_G + 252 * MiB;
constexpr size_t WS_XG = WS_Y + 144 * MiB;
constexpr size_t WS_TOK = WS_XG + 256 * MiB;
constexpr size_t WS_PART = WS_TOK + 1 * MiB;
constexpr size_t WS_FFNEND = WS_PART + 64 * MiB;
constexpr size_t WS_END = (WS_MIXEND > WS_FFNEND ? WS_MIXEND : WS_FFNEND);
static_assert(WS_END < (size_t)1800 * MiB, "workspace budget");
static_assert((size_t)MTOK * DINP * 4 <= 207 * MiB && (size_t)32 * 36 * 129 * 128 * 4 <= 73 * MiB, "sizes");
constexpr int CW_BAR = 4096;
constexpr int CW_MOE = 16384;
constexpr int CW_QH = 20480;
constexpr int CW_ARR = 32768;

constexpr int RING_BYTES = 131072;
constexpr int MISC_OFF = 147456 - 256;
constexpr int LDS_BYTES = 147456;
constexpr int NWAVES = 8, NTHR = 512;

#define RLX_AGENT __ATOMIC_RELAXED, __HIP_MEMORY_SCOPE_AGENT
#define LDS_WAIT() asm volatile("s_waitcnt lgkmcnt(0)" ::: "memory")
#define VM_WAIT() asm volatile("s_waitcnt vmcnt(0)" ::: "memory")
DI unsigned pk2(float lo, float hi) { unsigned r; asm("v_cvt_pk_bf16_f32 %0, %1, %2" : "=v"(r) : "v"(lo), "v"(hi)); return r; }
DI unsigned f2bf(float f) { return pk2(f, 0.f) & 0xffffu; }
DI float bf2f(unsigned b) { return __builtin_bit_cast(float, b << 16); }
#define PINV(x) asm volatile("" : "+v"(x))
#define PIN4(a) asm volatile("" : "+v"((a)[0]), "+v"((a)[1]), "+v"((a)[2]), "+v"((a)[3]))
#define PIN8(a) asm volatile("" : "+v"((a)[0]), "+v"((a)[1]), "+v"((a)[2]), "+v"((a)[3]), "+v"((a)[4]), "+v"((a)[5]), "+v"((a)[6]), "+v"((a)[7]))
DI float wave_sum(float v) {
    v += __builtin_bit_cast(float, __builtin_amdgcn_update_dpp(0, __builtin_bit_cast(int, v), 0xB1, 0xf, 0xf, true));
    v += __builtin_bit_cast(float, __builtin_amdgcn_update_dpp(0, __builtin_bit_cast(int, v), 0x4E, 0xf, 0xf, true));
    v += __builtin_bit_cast(float, __builtin_amdgcn_update_dpp(0, __builtin_bit_cast(int, v), 0x141, 0xf, 0xf, true));
    v += __builtin_bit_cast(float, __builtin_amdgcn_update_dpp(0, __builtin_bit_cast(int, v), 0x140, 0xf, 0xf, true));
    const int b = __builtin_bit_cast(int, v);
    const float r0 = __builtin_bit_cast(float, __builtin_amdgcn_readlane(b, 0)), r1 = __builtin_bit_cast(float, __builtin_amdgcn_readlane(b, 16));
    const float r2 = __builtin_bit_cast(float, __builtin_amdgcn_readlane(b, 32)), r3 = __builtin_bit_cast(float, __builtin_amdgcn_readlane(b, 48));
    return (r0 + r1) + (r2 + r3);
}
DI float wave_max(float v) {
    v = fmaxf(v, __builtin_bit_cast(float, __builtin_amdgcn_update_dpp(0, __builtin_bit_cast(int, v), 0xB1, 0xf, 0xf, true)));
    v = fmaxf(v, __builtin_bit_cast(float, __builtin_amdgcn_update_dpp(0, __builtin_bit_cast(int, v), 0x4E, 0xf, 0xf, true)));
    v = fmaxf(v, __builtin_bit_cast(float, __builtin_amdgcn_update_dpp(0, __builtin_bit_cast(int, v), 0x141, 0xf, 0xf, true)));
    v = fmaxf(v, __builtin_bit_cast(float, __builtin_amdgcn_update_dpp(0, __builtin_bit_cast(int, v), 0x140, 0xf, 0xf, true)));
    const int b = __builtin_bit_cast(int, v);
    const float r0 = __builtin_bit_cast(float, __builtin_amdgcn_readlane(b, 0)), r1 = __builtin_bit_cast(float, __builtin_amdgcn_readlane(b, 16));
    const float r2 = __builtin_bit_cast(float, __builtin_amdgcn_readlane(b, 32)), r3 = __builtin_bit_cast(float, __builtin_amdgcn_readlane(b, 48));
    return fmaxf(fmaxf(r0, r1), fmaxf(r2, r3));
}
DI float xor32_max(float v) { const auto r = __builtin_amdgcn_permlane32_swap(__builtin_bit_cast(unsigned, v), __builtin_bit_cast(unsigned, v), false, false); return fmaxf(__builtin_bit_cast(float, r[0]), __builtin_bit_cast(float, r[1])); }
DI float xor32_get(float v, int lane) { const auto r = __builtin_amdgcn_permlane32_swap(__builtin_bit_cast(unsigned, v), __builtin_bit_cast(unsigned, v), false, false); return __builtin_bit_cast(float, lane < 32 ? r[1] : r[0]); }
DI float xor32_sum(float v) { const auto r = __builtin_amdgcn_permlane32_swap(__builtin_bit_cast(unsigned, v), __builtin_bit_cast(unsigned, v), false, false); return __builtin_bit_cast(float, r[0]) + __builtin_bit_cast(float, r[1]); }
DI float wave_incl_scan(float v, int lane) {
    v += __builtin_bit_cast(float, __builtin_amdgcn_update_dpp(0, __builtin_bit_cast(int, v), 0x111, 0xf, 0xf, true));
    v += __builtin_bit_cast(float, __builtin_amdgcn_update_dpp(0, __builtin_bit_cast(int, v), 0x112, 0xf, 0xf, true));
    v += __builtin_bit_cast(float, __builtin_amdgcn_update_dpp(0, __builtin_bit_cast(int, v), 0x114, 0xf, 0xf, true));
    v += __builtin_bit_cast(float, __builtin_amdgcn_update_dpp(0, __builtin_bit_cast(int, v), 0x118, 0xf, 0xf, true));
    const int b = __builtin_bit_cast(int, v);
    const float t0 = __builtin_bit_cast(float, __builtin_amdgcn_readlane(b, 15)), t1 = __builtin_bit_cast(float, __builtin_amdgcn_readlane(b, 31)), t2 = __builtin_bit_cast(float, __builtin_amdgcn_readlane(b, 47));
    return v + (lane >= 16 ? t0 : 0.f) + (lane >= 32 ? t1 : 0.f) + (lane >= 48 ? t2 : 0.f);
}
DI float lane_bcast(float v, int srclane_const) { return __builtin_bit_cast(float, __builtin_amdgcn_readlane(__builtin_bit_cast(int, v), srclane_const)); }
DI float wave_prefix_max(float v, int lane) {
    const int NEG = __builtin_bit_cast(int, -3.0e38f);
    v = fmaxf(v, __builtin_bit_cast(float, __builtin_amdgcn_update_dpp(NEG, __builtin_bit_cast(int, v), 0x111, 0xf, 0xf, false)));
    v = fmaxf(v, __builtin_bit_cast(float, __builtin_amdgcn_update_dpp(NEG, __builtin_bit_cast(int, v), 0x112, 0xf, 0xf, false)));
    v = fmaxf(v, __builtin_bit_cast(float, __builtin_amdgcn_update_dpp(NEG, __builtin_bit_cast(int, v), 0x114, 0xf, 0xf, false)));
    v = fmaxf(v, __builtin_bit_cast(float, __builtin_amdgcn_update_dpp(NEG, __builtin_bit_cast(int, v), 0x118, 0xf, 0xf, false)));
    const int b = __builtin_bit_cast(int, v);
    const float t0 = __builtin_bit_cast(float, __builtin_amdgcn_readlane(b, 15)), t1 = __builtin_bit_cast(float, __builtin_amdgcn_readlane(b, 31)), t2 = __builtin_bit_cast(float, __builtin_amdgcn_readlane(b, 47));
    const float m1 = t0, m2 = fmaxf(t0, t1), m3 = fmaxf(m2, t2);
    return fmaxf(v, lane >= 48 ? m3 : (lane >= 32 ? m2 : (lane >= 16 ? m1 : -3.0e38f)));
}
DI float wave_suffix_max(float v, int lane) {
    const int NEG = __builtin_bit_cast(int, -3.0e38f);
    v = fmaxf(v, __builtin_bit_cast(float, __builtin_amdgcn_update_dpp(NEG, __builtin_bit_cast(int, v), 0x101, 0xf, 0xf, false)));
    v = fmaxf(v, __builtin_bit_cast(float, __builtin_amdgcn_update_dpp(NEG, __builtin_bit_cast(int, v), 0x102, 0xf, 0xf, false)));
    v = fmaxf(v, __builtin_bit_cast(float, __builtin_amdgcn_update_dpp(NEG, __builtin_bit_cast(int, v), 0x104, 0xf, 0xf, false)));
    v = fmaxf(v, __builtin_bit_cast(float, __builtin_amdgcn_update_dpp(NEG, __builtin_bit_cast(int, v), 0x108, 0xf, 0xf, false)));
    const int b = __builtin_bit_cast(int, v);
    const float t1 = __builtin_bit_cast(float, __builtin_amdgcn_readlane(b, 16)), t2 = __builtin_bit_cast(float, __builtin_amdgcn_readlane(b, 32)), t3 = __builtin_bit_cast(float, __builtin_amdgcn_readlane(b, 48));
    const float m2 = t3, m1 = fmaxf(t3, t2), m0 = fmaxf(m1, t1);
    return fmaxf(v, lane < 16 ? m0 : (lane < 32 ? m1 : (lane < 48 ? m2 : -3.0e38f)));
}
DI float siluf(float x) { return x / (1.f + __expf(-x)); }
DI float sigmoidf_(float x) { return 1.f / (1.f + __expf(-x)); }
DI float softplusf_(float x) { return fmaxf(x, 0.f) + log1pf(__expf(-fabsf(x))); }
DI float logsigmoidf_(float x) { return fminf(x, 0.f) - log1pf(__expf(-fabsf(x))); }

#define XB_TMO      128
#define XB_XCNT(j)  (256  + 64 * (j))
#define XB_XSUB(j)  (1280 + 64 * (j))
#define XB_XGEN(j)  (2304 + 64 * (j))
#define XB_TOP      3328
#define XB_TOPGEN   3392
#define XCD_BAR_WORDS 3456
#define XB_SPIN_CAP (1u << 22)
DI unsigned xb_ld(unsigned* p)              { return __hip_atomic_load(p, __ATOMIC_RELAXED, __HIP_MEMORY_SCOPE_AGENT); }
DI unsigned xb_add(unsigned* p, unsigned v) { return __hip_atomic_fetch_add(p, v, __ATOMIC_RELAXED, __HIP_MEMORY_SCOPE_AGENT); }
DI unsigned xb_xcc_id() { return (unsigned)__builtin_amdgcn_s_getreg((3 << 11) | 20) & 0xFu; }
#define XB_SPIN(cond, bar) do { unsigned _sp = 0; while (cond) { __builtin_amdgcn_s_sleep(1); \
    if ((++_sp & 255u) == 0u) { if (xb_ld(&(bar)[XB_TMO])) break; if (_sp > XB_SPIN_CAP) { atomicAdd(&(bar)[XB_TMO], 1u); break; } } } } while (0)
struct XcdBarrier { unsigned* bar; unsigned x; volatile LAS unsigned* st; };
DI XcdBarrier xcd_barrier_post(unsigned* bar, volatile LAS unsigned* st) {
    XcdBarrier b; b.bar = bar; b.x = xb_xcc_id(); b.st = st;
    if (threadIdx.x == 0) (void)xb_add(&bar[XB_XCNT(b.x)], 1u);
    return b;
}
DI void xcd_barrier_complete(unsigned* bar, unsigned x, unsigned& nloc, unsigned& nx) {
    const unsigned G = gridDim.x * gridDim.y * gridDim.z;
    unsigned sum, cnt, mine, sp = 0u;
    for (;;) {
        sum = 0u; cnt = 0u; mine = 0u;
#pragma unroll
        for (unsigned j = 0; j < 16; ++j) { const unsigned c = xb_ld(&bar[XB_XCNT(j)]); sum += c; cnt += (c > 0u) ? 1u : 0u; mine = (j == x) ? c : mine; }
        if (sum == G) break;
        __builtin_amdgcn_s_sleep(1);
        if ((++sp & 255u) == 0u) { if (xb_ld(&bar[XB_TMO])) break; if (sp > XB_SPIN_CAP) { atomicAdd(&bar[XB_TMO], 1u); break; } }
    }
    nloc = mine > 0u ? mine : 1u; nx = cnt > 0u ? cnt : 1u;
}
DI void xcd_barrier(const XcdBarrier& b) {
    asm volatile("s_waitcnt vmcnt(0)" ::: "memory");
    __syncthreads();
    if (threadIdx.x == 0) {
        unsigned* bar = b.bar;
        __builtin_amdgcn_s_waitcnt(0);
        unsigned nloc = b.st[0], nx = b.st[1];
        if (nloc == 0u) { xcd_barrier_complete(bar, b.x, nloc, nx); b.st[0] = nloc; b.st[1] = nx; }
        const unsigned old = xb_add(&bar[XB_XSUB(b.x)], 1u);
        const unsigned gen = old / nloc;
        if (old + 1u == (gen + 1u) * nloc) {
            __builtin_amdgcn_fence(__ATOMIC_RELEASE, "agent");
            asm volatile("s_waitcnt vmcnt(0)" ::: "memory");
            const unsigned og = xb_add(&bar[XB_TOP], 1u);
            const unsigned tg = og / nx;
            if (og + 1u == (tg + 1u) * nx) xb_add(&bar[XB_TOPGEN], 1u);
            else XB_SPIN(xb_ld(&bar[XB_TOPGEN]) == tg, bar);
            __builtin_amdgcn_fence(__ATOMIC_ACQUIRE, "agent");
            xb_add(&bar[XB_XGEN(b.x)], 1u);
            asm volatile("s_waitcnt vmcnt(0)" ::: "memory");
        } else {
            XB_SPIN(xb_ld(&bar[XB_XGEN(b.x)]) == gen, bar);
            __builtin_amdgcn_fence(__ATOMIC_ACQUIRE, "agent");
            asm volatile("s_waitcnt vmcnt(0)" ::: "memory");
        }
    }
    __syncthreads();
}

struct Args { const float* in[35]; float* out; unsigned char* ws; int ph_lo, ph_hi, rep, pad; };
struct Frame {
    LAS unsigned char* lds;
    unsigned char* ws;
    const float* in[35];
    float* out;
    int tid, lane, wave, G, bid, rep;
};
#define WSP(T, off) ((T*)(F.ws + (off)))
DI int rowof(int b, int j) { return j < TL ? b * TL + j : MLAT + b * TC + (j - TL); }

template <int K> DI f32x4 mma16(const LAS bf16* A, int lda, const LAS bf16* Bt, int ldb, int lane, f32x4 acc) {
    const int r = lane & 15, q = lane >> 4;
    const LAS bf16* pa = A + r * lda + 8 * q; const LAS bf16* pb = Bt + r * ldb + 8 * q;
#pragma unroll
    for (int k = 0; k < K; k += 32) {
        const bf16x8 a = *(const LAS bf16x8*)(pa + k); const bf16x8 b = *(const LAS bf16x8*)(pb + k);
        acc = __builtin_amdgcn_mfma_f32_16x16x32_bf16(a, b, acc, 0, 0, 0);
    }
    return acc;
}
struct CvDesc { const float* src; bf16* dst; size_t ld, Kd; int Kv, Nv, k0, n0, dn0; };
DI void tr_load(const CvDesc& d, f32x4 (&v)[16], int lane) {
    const int nn = 4 * (lane & 15), kq = lane >> 4;
#pragma unroll
    for (int i = 0; i < 16; ++i) { const int kk = 4 * i + kq;
        v[i] = (f32x4){0.f, 0.f, 0.f, 0.f};
        if (d.k0 + kk < d.Kv && d.n0 + nn < d.Nv) v[i] = __builtin_nontemporal_load((const f32x4*)(d.src + (size_t)(d.k0 + kk) * d.ld + d.n0 + nn)); }
#pragma unroll
    for (int i = 0; i < 16; ++i) PINV(v[i]);
}
DI void tr_lds(const f32x4 (&v)[16], LAS float* scr, int lane) {
    const int nn = 4 * (lane & 15), kq = lane >> 4;
#pragma unroll
    for (int i = 0; i < 16; ++i) { const int kk = 4 * i + kq; LAS float* s = scr + kk * 65 + nn; s[0] = v[i][0]; s[1] = v[i][1]; s[2] = v[i][2]; s[3] = v[i][3]; }
    LDS_WAIT(); asm volatile("" ::: "memory");
}
DI void tr_out(const CvDesc& d, LAS float* scr, int lane) {
    const int c = lane & 7;
#pragma unroll
    for (int j = 0; j < 8; ++j) { const int n = (lane >> 3) + 8 * j; const LAS float* s = scr + (8 * c) * 65 + n;
        u32x4 o; o.x = pk2(s[0 * 65], s[1 * 65]); o.y = pk2(s[2 * 65], s[3 * 65]); o.z = pk2(s[4 * 65], s[5 * 65]); o.w = pk2(s[6 * 65], s[7 * 65]);
        __builtin_nontemporal_store(o, (u32x4*)(d.dst + (size_t)(d.dn0 + n) * d.Kd + d.k0 + 8 * c)); }
    LDS_WAIT(); asm volatile("" ::: "memory");
}
DI int il_row(int n0, int which) { return (n0 >> 7) * 256 + (n0 & 127) + which * 128; }

constexpr int I_IN = 32 * 92, I_OUT = 32 * 32, I_QB = 8 * 12, I_KVB = 4 * 16, I_F1 = 32 * 88, I_F2 = 88 * 32, I_M1 = 32 * 112, I_M2 = 112 * 32;
constexpr int I_L = I_IN + I_OUT + I_QB + I_KVB;
constexpr int CV_NE = I_L + 2 * I_F1 + I_F2, CV_NQ1 = CV_NE + I_L, CV_NALL = CV_NQ1 + NEXP * (2 * I_M1 + I_M2);
DI CvDesc conv_decode(Frame& F, int it) {
    int r = it;
    if (r >= CV_NQ1) { r -= CV_NQ1;
        if (r < NEXP * 2 * I_M1) { const int e = r / (2 * I_M1); r -= e * 2 * I_M1; const int which = r / I_M1; r -= which * I_M1; const int kb = r / 112, nb = r % 112;
            return CvDesc{(which ? F.in[33] : F.in[32]) + (size_t)e * D * FE, WSP(bf16, WS_MW13) + (size_t)e * 2 * FE * D, (size_t)(FE), (size_t)(D), D, FE, 64 * kb, 64 * nb, il_row(64 * nb, which)}; }
        r -= NEXP * 2 * I_M1;
        { const int e = r / I_M2; r -= e * I_M2; const int kb = r / 32, nb = r % 32;
            return CvDesc{F.in[34] + (size_t)e * FE * D, WSP(bf16, WS_MW2) + (size_t)e * D * FE, (size_t)(D), (size_t)(FE), FE, D, 64 * kb, 64 * nb, 64 * nb}; }
    }
    int l = 0;
    if (r >= CV_NE) { r -= CV_NE; l = 1; }
    else if (r >= I_L) { r -= I_L;
        if (r < 2 * I_F1) { const int which = r / I_F1; r -= which * I_F1; const int kb = r / 88, nb = r % 88;
            return CvDesc{(which ? F.in[29] : F.in[28]), WSP(bf16, WS_W13), (size_t)(FF), (size_t)(D), D, FF, 64 * kb, 64 * nb, il_row(64 * nb, which)}; }
        r -= 2 * I_F1;
        { const int kb = r / 32, nb = r % 32; return CvDesc{F.in[30], WSP(bf16, WS_W2), (size_t)(D), (size_t)(FF), FF, D, 64 * kb, 64 * nb, 64 * nb}; }
    }
    if (r < I_IN) { const int kb = r / 92, nb = r % 92;
        return CvDesc{F.in[7] + (size_t)l * D * DIN, WSP(bf16, WS_WIN) + (size_t)l * DINP * D, (size_t)(DIN), (size_t)(D), D, DIN, 64 * kb, 64 * nb, 64 * nb}; }
    r -= I_IN;
    if (r < I_OUT) { const int kb = r / 32, nb = r % 32;
        return CvDesc{F.in[8] + (size_t)l * D * D, WSP(bf16, WS_WOUT) + (size_t)l * D * D, (size_t)(D), (size_t)(D), D, D, 64 * kb, 64 * nb, 64 * nb}; }
    r -= I_OUT;
    if (r < I_QB) { const int kb = r / 12, nb = r % 12;
        return CvDesc{F.in[19] + (size_t)l * 448 * 768, WSP(bf16, WS_WQB) + (size_t)l * 768 * 512, (size_t)(768), (size_t)(512), 448, 768, 64 * kb, 64 * nb, 64 * nb}; }
    r -= I_QB;
    { const int kb = r / 16, nb = r % 16;
        return CvDesc{F.in[21] + (size_t)l * 160 * 1024, WSP(bf16, WS_WKVB) + (size_t)l * 1024 * 256, (size_t)(1024), (size_t)(256), 160, 1024, 64 * kb, 64 * nb, 64 * nb}; }
}

DI void conv_item(Frame& F, int it, LAS float* scr) { const CvDesc d = conv_decode(F, it); f32x4 v[16]; tr_load(d, v, F.lane); tr_lds(v, scr, F.lane); tr_out(d, scr, F.lane); }
DI void conv_items(Frame& F, int it0, int n, LAS float* scr) {
    if (it0 >= CV_NALL) return;
    if (it0 + n > CV_NALL) n = CV_NALL - it0;
    CvDesc d = conv_decode(F, it0); f32x4 v[16]; tr_load(d, v, F.lane);
    for (int k = 0; k < n; ++k) {
        tr_lds(v, scr, F.lane);
        CvDesc dn = d;
        if (k + 1 < n) { dn = conv_decode(F, it0 + k + 1); tr_load(dn, v, F.lane); }
        tr_out(d, scr, F.lane);
        d = dn;
    }
}
DI void p0_prologue(Frame& F) {
    {
        LAS float* sc = (LAS float*)F.lds;
        LAS float* red = (LAS float*)(F.lds + 5 * 2048 * 4);
        bool have = false;
        for (int u = F.bid; u < 2 * 96; u += F.G) {
            if (!have) {
                float cv[20];
#pragma unroll
                for (int k = 0; k < 20; ++k) { const int i = F.tid + NTHR * k; cv[k] = (i < 4 * 2048) ? F.in[1][i] : F.in[3][i - 4 * 2048]; }
                PIN8(cv); PIN8(cv + 8); PIN4(cv + 16);
#pragma unroll
                for (int k = 0; k < 20; ++k) sc[F.tid + NTHR * k] = siluf(cv[k]);
                have = true;
            }
            __syncthreads();
            const int l = u / 96, j0 = (u % 96) * 128;
            const float* W = F.in[4] + (size_t)l * D * D6 + j0 + 2 * F.lane;
            f32x2 acc[5];
#pragma unroll
            for (int r = 0; r < 5; ++r) acc[r] = (f32x2){0.f, 0.f};
            const int kb = F.wave * 256;
            for (int k = 0; k < 256; k += 16) {
                f32x2 w[16];
#pragma unroll
                for (int i = 0; i < 16; ++i) w[i] = __builtin_nontemporal_load((const f32x2*)(W + (size_t)(kb + k + i) * D6));
#pragma unroll
                for (int i = 0; i < 16; ++i) PINV(w[i]);
#pragma unroll
                for (int i = 0; i < 16; ++i)
#pragma unroll
                    for (int r = 0; r < 5; ++r) { const float s = sc[r * 2048 + kb + k + i]; acc[r] += w[i] * s; }
            }
#pragma unroll
            for (int r = 0; r < 5; ++r) { red[(F.wave * 5 + r) * 128 + 2 * F.lane] = acc[r][0]; red[(F.wave * 5 + r) * 128 + 2 * F.lane + 1] = acc[r][1]; }
            __syncthreads();
            for (int i = F.tid; i < 5 * 128; i += NTHR) { const int r = i / 128, j = i % 128; float s = F.in[5][l * D6 + j0 + j];
#pragma unroll
                for (int w = 0; w < 8; ++w) s += red[(w * 5 + r) * 128 + j];
                WSP(float, WS_MOD)[(l * 5 + r) * D6 + j0 + j] = s; }
        }
        __syncthreads();
    }
    LAS float* scr = (LAS float*)(F.lds + F.wave * 16640);
    const int gw = F.bid * NWAVES + F.wave, NGW = F.G * NWAVES;
    for (int it = gw; it < I_L; it += NGW) conv_item(F, it, scr);
}

constexpr int CV_EAGER = I_L;
constexpr int CV_NDEF = CV_NALL - CV_EAGER;
DI void conv_fill(Frame& F, int phase, bool work, int per_wave = 2) {
    LAS float* scr = (LAS float*)(F.lds + F.wave * 16640);
    volatile LAS int* bc = (volatile LAS int*)(F.lds + MISC_OFF) + 16;
    unsigned* ctl = WSP(unsigned, WS_CTL);
    __syncthreads();
    if (F.tid == 0) __hip_atomic_fetch_add(ctl + CW_ARR + 64 * phase, 1u, RLX_AGENT);
    if (!work) return;
    for (;;) {
        if (F.tid == 0) {
            int base = -1;
            if (__hip_atomic_load(ctl + CW_ARR + 64 * phase, RLX_AGENT) < (unsigned)F.G) { base = (int)__hip_atomic_fetch_add(ctl + CW_QH, (unsigned)(8 * per_wave), RLX_AGENT); if (base >= CV_NDEF) base = -1; }
            bc[0] = base;
        }
        __syncthreads();
        const int base = bc[0];
        __syncthreads();
        if (base < 0) break;
        conv_items(F, CV_EAGER + base + F.wave * per_wave, per_wave, scr);
    }
}
DI void conv_drain(Frame& F, int upto) {
    LAS float* scr = (LAS float*)(F.lds + F.wave * 16640);
    volatile LAS int* bc = (volatile LAS int*)(F.lds + MISC_OFF) + 16;
    unsigned* ctl = WSP(unsigned, WS_CTL);
    __syncthreads();
    for (;;) {
        if (F.tid == 0) {
            int base = -1;
            if ((int)__hip_atomic_load(ctl + CW_QH, RLX_AGENT) < upto) { base = (int)__hip_atomic_fetch_add(ctl + CW_QH, 64u, RLX_AGENT); if (base >= CV_NDEF) base = -1; }
            bc[0] = base;
        }
        __syncthreads();
        const int base = bc[0];
        __syncthreads();
        if (base < 0) break;
        conv_items(F, CV_EAGER + base + F.wave * 8, 8, scr);
    }
}
template <bool ROUTE>
DI void norm_phase(Frame& F, int l, const float* srcLat, const float* srcCtx, const float* g, int shoff, int nrows) {
    LAS float* rl = (LAS float*)F.lds;
    if (ROUTE) {
        f32x4 rv[8];
#pragma unroll
        for (int i = 0; i < 8; ++i) rv[i] = *(const f32x4*)(F.in[31] + 4 * (F.tid + NTHR * i));
#pragma unroll
        for (int i = 0; i < 8; ++i) PINV(rv[i]);
#pragma unroll
        for (int i = 0; i < 8; ++i) *(LAS f32x4*)(rl + 4 * (F.tid + NTHR * i)) = rv[i];
        __syncthreads(); }
    const int gw = F.bid * NWAVES + F.wave, NGW = F.G * NWAVES;
    bf16* HN = WSP(bf16, WS_HN);
    f32x4 gv[8];
#pragma unroll
    for (int j = 0; j < 8; ++j) gv[j] = *(const f32x4*)(g + 4 * F.lane + 256 * j);
    for (int row = gw; row < nrows; row += NGW) {
        const float* xr = row < MLAT ? srcLat + (size_t)row * D : srcCtx + (size_t)(row - MLAT) * D;
        const int br = row < MLAT ? row / TL : 4;
        const float* mrow = WSP(float, WS_MOD) + (size_t)(l * 5 + br) * D6 + shoff;
        f32x4 v[8], shv[8], scv[8]; float ss = 0.f;
#pragma unroll
        for (int j = 0; j < 8; ++j) { const int c = 4 * F.lane + 256 * j; v[j] = *(const f32x4*)(xr + c); shv[j] = *(const f32x4*)(mrow + c); scv[j] = *(const f32x4*)(mrow + D + c); }
#pragma unroll
        for (int j = 0; j < 8; ++j) { PINV(v[j]); PINV(shv[j]); PINV(scv[j]); }
#pragma unroll
        for (int j = 0; j < 8; ++j) ss += (v[j][0] * v[j][0] + v[j][1] * v[j][1]) + (v[j][2] * v[j][2] + v[j][3] * v[j][3]);
        const float rstd = 1.0f / sqrtf(wave_sum(ss) * (1.f / D) + EPS);
        float lg[8]; u32x2 wk[8];
        if (ROUTE) {
#pragma unroll
            for (int e = 0; e < 8; ++e) lg[e] = 0.f; }
#pragma unroll
        for (int j = 0; j < 8; ++j) { const int c = 4 * F.lane + 256 * j;
            const f32x4 gg = gv[j], sh = shv[j], sc = scv[j];
            f32x4 o;
#pragma unroll
            for (int i = 0; i < 4; ++i) o[i] = v[j][i] * rstd * gg[i] * (1.f + sc[i]) + sh[i];
            u32x2 w; w.x = pk2(o[0], o[1]); w.y = pk2(o[2], o[3]);
            if (ROUTE) wk[j] = w; else *(u32x2*)(HN + (size_t)row * D + c) = w;
            if (ROUTE) {
#pragma unroll
                for (int i = 0; i < 4; ++i) { const f32x4 r0 = *(const LAS f32x4*)(rl + (c + i) * 8), r1 = *(const LAS f32x4*)(rl + (c + i) * 8 + 4);
                    lg[0] += o[i] * r0[0]; lg[1] += o[i] * r0[1]; lg[2] += o[i] * r0[2]; lg[3] += o[i] * r0[3];
                    lg[4] += o[i] * r1[0]; lg[5] += o[i] * r1[1]; lg[6] += o[i] * r1[2]; lg[7] += o[i] * r1[3]; }
                __builtin_amdgcn_sched_barrier(0);
            }
        }
        if (ROUTE) {
#pragma unroll
            for (int e = 0; e < 8; ++e) lg[e] = wave_sum(lg[e]);
            int r1 = 0, r2 = 0;
            if (F.lane == 0) {
                int e1 = 0; float v1 = lg[0];
#pragma unroll
                for (int e = 1; e < 8; ++e) if (lg[e] > v1) { v1 = lg[e]; e1 = e; }
                int e2 = -1; float v2 = -3.0e38f;
#pragma unroll
                for (int e = 0; e < 8; ++e) if (e != e1 && lg[e] > v2) { v2 = lg[e]; e2 = e; }
                const float g2 = 1.f / (1.f + expf(v1 - v2)), g1 = 1.f - g2;
                unsigned* cnt = WSP(unsigned, WS_CTL) + CW_MOE;
                const unsigned p1 = __hip_atomic_fetch_add(cnt + e1, 1u, RLX_AGENT), p2 = __hip_atomic_fetch_add(cnt + e2, 1u, RLX_AGENT);
                int* tk = WSP(int, WS_TOK) + (size_t)row * 8;
                tk[0] = e1; tk[1] = (int)p1; tk[2] = e2; tk[3] = (int)p2; ((float*)tk)[4] = g1; ((float*)tk)[5] = g2;
                r1 = e1 * MLAT + (int)p1; r2 = e2 * MLAT + (int)p2;
            }
            r1 = __builtin_amdgcn_readfirstlane(r1); r2 = __builtin_amdgcn_readfirstlane(r2);
            bf16* XS = WSP(bf16, WS_XG);
#pragma unroll
            for (int j = 0; j < 8; ++j) { const int c = 4 * F.lane + 256 * j; *(u32x2*)(XS + (size_t)r1 * D + c) = wk[j]; *(u32x2*)(XS + (size_t)r2 * D + c) = wk[j]; }
        }
    }
}

DI void moe_tables(Frame& F, LAS int* tb, int NT) {
    if (F.tid == 0) {
        const unsigned* cnt = WSP(unsigned, WS_CTL) + CW_MOE; int ts = 0, us = 0;
        for (int e = 0; e < 8; ++e) { const int c = (int)__hip_atomic_load(cnt + e, RLX_AGENT); const int t = (c + 255) >> 8; tb[e] = c; tb[8 + e] = t; tb[16 + e] = ts; tb[32 + e] = us; ts += t; us += t * NT; }
        tb[24] = ts; tb[40] = us;
    }
    __syncthreads();
}
DI void moe_combine_phase(Frame& F, int l) {
    LAS int* tb = (LAS int*)F.lds; __syncthreads(); moe_tables(F, tb, 1);
    const int gw = F.bid * NWAVES + F.wave, NGW = F.G * NWAVES;
    const float* Y = WSP(float, WS_Y); const float* X = WSP(float, WS_X);
    for (int row = gw; row < MLAT; row += NGW) {
        const int* tk = WSP(int, WS_TOK) + (size_t)row * 8;
        const float g1 = ((const float*)tk)[4], g2 = ((const float*)tk)[5];
        const int s1 = tb[16 + tk[0]] * 256 + tk[1], s2 = tb[16 + tk[2]] * 256 + tk[3];
        const float* mrow = WSP(float, WS_MOD) + (size_t)(l * 5 + row / TL) * D6 + 5 * D;
        f32x4 xv[8], y1[8], y2[8], gq[8];
#pragma unroll
        for (int j = 0; j < 8; ++j) { const int c = 4 * F.lane + 256 * j;
            xv[j] = *(const f32x4*)(X + (size_t)row * D + c); y1[j] = *(const f32x4*)(Y + (size_t)s1 * D + c); y2[j] = *(const f32x4*)(Y + (size_t)s2 * D + c); gq[j] = *(const f32x4*)(mrow + c); }
#pragma unroll
        for (int j = 0; j < 8; ++j) { PINV(xv[j]); PINV(y1[j]); PINV(y2[j]); PINV(gq[j]); }
#pragma unroll
        for (int j = 0; j < 8; ++j) { const int c = 4 * F.lane + 256 * j; const f32x4 gg = gq[j];
            *(f32x4*)(F.out + (size_t)row * D + c) = xv[j] + gg * (y1[j] * g1 + y2[j] * g2); }
    }
}
using pg8::Unit;
struct EpiF32 {
    static constexpr bool PERM = false;
    float* C; int ldc;
    DI void operator()(const f32x4 (&acc)[2][2][4][2], const Unit& u, int wr, int wc, int fr, int fq) const {
        const int row0 = u.pm * 256 + wr * 64 + fr, col0 = u.pn * 256 + wc * 32 + 4 * fq;
#pragma unroll
        for (int ai = 0; ai < 2; ++ai)
#pragma unroll
            for (int m = 0; m < 4; ++m) { float* rowp = C + (size_t)(row0 + ai * 128 + m * 16) * ldc + col0;
#pragma unroll
                for (int bj = 0; bj < 2; ++bj)
#pragma unroll
                    for (int n = 0; n < 2; ++n) *(f32x4*)(rowp + bj * 128 + n * 16) = acc[ai][bj][m][n]; }
    }
};
struct EpiBf16 {
    static constexpr bool PERM = true;
    bf16* O; int ldc;
    DI void operator()(const f32x4 (&acc)[2][2][4][2], const Unit& u, int wr, int wc, int fr, int fq) const {
        const int row0 = u.pm * 256 + wr * 64 + fr, col0 = u.pn * 256 + wc * 32 + 8 * fq;
#pragma unroll
        for (int ai = 0; ai < 2; ++ai)
#pragma unroll
            for (int m = 0; m < 4; ++m) { bf16* rowp = O + (size_t)(row0 + ai * 128 + m * 16) * ldc + col0;
#pragma unroll
                for (int bj = 0; bj < 2; ++bj) { const f32x4 v0 = acc[ai][bj][m][0], v1 = acc[ai][bj][m][1];
                    u32x4 w; w.x = pg8::cvt_pk_bf16(v0[0], v0[1]); w.y = pg8::cvt_pk_bf16(v0[2], v0[3]); w.z = pg8::cvt_pk_bf16(v1[0], v1[1]); w.w = pg8::cvt_pk_bf16(v1[2], v1[3]);
                    *(u32x4*)(rowp + bj * 128) = w; } }
    }
};
struct EpiP {
    static constexpr bool PERM = true;
    bf16* O; float* graw;
    DI void operator()(const f32x4 (&acc)[2][2][4][2], const Unit& u, int wr, int wc, int fr, int fq) const {
        const int row0 = u.pm * 256 + wr * 64 + fr, col0 = u.pn * 256 + wc * 32 + 8 * fq;
#pragma unroll
        for (int ai = 0; ai < 2; ++ai)
#pragma unroll
            for (int m = 0; m < 4; ++m) { bf16* rowp = O + (size_t)(row0 + ai * 128 + m * 16) * DINP + col0;
#pragma unroll
                for (int bj = 0; bj < 2; ++bj) { const f32x4 v0 = acc[ai][bj][m][0], v1 = acc[ai][bj][m][1];
                    u32x4 w; w.x = pg8::cvt_pk_bf16(v0[0], v0[1]); w.y = pg8::cvt_pk_bf16(v0[2], v0[3]); w.z = pg8::cvt_pk_bf16(v1[0], v1[1]); w.w = pg8::cvt_pk_bf16(v1[2], v1[3]);
                    *(u32x4*)(rowp + bj * 128) = w; } }
        const bool gsel = (u.pn == 8 && wc == 0 && fq < 2), dsel = (u.pn == 14 && wc == 0 && fq >= 2);
        if (gsel || dsel) { const int off = gsel ? 8 * fq : 16 + 8 * (fq - 2);
#pragma unroll
            for (int ai = 0; ai < 2; ++ai)
#pragma unroll
                for (int m = 0; m < 4; ++m) { float* gp = graw + (size_t)(row0 + ai * 128 + m * 16) * 32 + off;
                    *(f32x4*)gp = acc[ai][0][m][0]; *(f32x4*)(gp + 4) = acc[ai][0][m][1]; } }
    }
};
struct EpiSwiglu {
    static constexpr bool PERM = true;
    bf16* O; int ldc;
    DI void operator()(const f32x4 (&acc)[2][2][4][2], const Unit& u, int wr, int wc, int fr, int fq) const {
        const int row0 = u.pm * 256 + wr * 64 + fr, col0 = u.pn * 128 + wc * 32 + 8 * fq;
#pragma unroll
        for (int ai = 0; ai < 2; ++ai)
#pragma unroll
            for (int m = 0; m < 4; ++m) { bf16* rowp = O + (size_t)(row0 + ai * 128 + m * 16) * ldc + col0;
                f32x4 v0, v1;
#pragma unroll
                for (int j = 0; j < 4; ++j) { v0[j] = siluf(acc[ai][0][m][0][j]) * acc[ai][1][m][0][j]; v1[j] = siluf(acc[ai][0][m][1][j]) * acc[ai][1][m][1][j]; }
                u32x4 w; w.x = pg8::cvt_pk_bf16(v0[0], v0[1]); w.y = pg8::cvt_pk_bf16(v0[2], v0[3]); w.z = pg8::cvt_pk_bf16(v1[0], v1[1]); w.w = pg8::cvt_pk_bf16(v1[2], v1[3]);
                *(u32x4*)rowp = w; }
    }
};
struct EpiResid {
    static constexpr bool PERM = false;
    const float* baseLat; const float* baseCtx; float* out; const float* mod;
    DI void operator()(const f32x4 (&acc)[2][2][4][2], const Unit& u, int wr, int wc, int fr, int fq) const {
        const int row0 = u.pm * 256 + wr * 64 + fr, col0 = u.pn * 256 + wc * 32 + 4 * fq;
        const int br = (u.pm * 256 < MLAT) ? (u.pm * 256) / TL : 4;
        const float* gate = mod + (size_t)br * D6 + col0;
        f32x4 gv[2][2];
#pragma unroll
        for (int bj = 0; bj < 2; ++bj)
#pragma unroll
            for (int n = 0; n < 2; ++n) gv[bj][n] = *(const f32x4*)(gate + bj * 128 + n * 16);
#pragma unroll
        for (int ai = 0; ai < 2; ++ai)
#pragma unroll
            for (int mp = 0; mp < 2; ++mp) {
                f32x4 bv[2][2][2];
#pragma unroll
                for (int mi = 0; mi < 2; ++mi) { const int row = row0 + ai * 128 + (2 * mp + mi) * 16;
                    const float* bp = (row < MLAT ? baseLat + (size_t)row * D : baseCtx + (size_t)(row - MLAT) * D) + col0;
#pragma unroll
                    for (int bj = 0; bj < 2; ++bj)
#pragma unroll
                        for (int n = 0; n < 2; ++n) bv[mi][bj][n] = *(const f32x4*)(bp + bj * 128 + n * 16); }
#pragma unroll
                for (int mi = 0; mi < 2; ++mi)
#pragma unroll
                    for (int bj = 0; bj < 2; ++bj)
#pragma unroll
                        for (int n = 0; n < 2; ++n) PINV(bv[mi][bj][n]);
#pragma unroll
                for (int mi = 0; mi < 2; ++mi) { const int m = 2 * mp + mi, row = row0 + ai * 128 + m * 16; float* op = out + (size_t)row * D + col0;
#pragma unroll
                    for (int bj = 0; bj < 2; ++bj)
#pragma unroll
                        for (int n = 0; n < 2; ++n) *(f32x4*)(op + bj * 128 + n * 16) = bv[mi][bj][n] + gv[bj][n] * acc[ai][bj][m][n]; }
            }
    }
};
struct MoeOrder {
    const LAS int* tb; int NT, G, c, L0, nT, S, KS, acap;
    DI bool next(int i, Unit& u) const {
        const long T = (long)i * G + c; if (T >= nT) return false;
        const int nun = tb[40], L = L0 + (int)T / S, sl = (int)T % S;
        const int w = pg8::xcd_remap(L, nun); int e = 0;
#pragma unroll
        for (int k = 1; k < 8; ++k) if (w >= tb[32 + k]) e = k;
        const int rem = w - tb[32 + e], tiles = tb[8 + e], nt = rem / tiles, mtl = rem - nt * tiles;
        u.pm = tb[16 + e] + mtl; u.pn = nt; u.pb = e * NT + nt; u.koff = sl * KS; u.aux = (int)T; u.pa = acap ? e * acap + mtl : u.pm; return true;
    }
};
struct EpiPart {
    static constexpr bool PERM = false;
    float* part;
    DI void operator()(const f32x4 (&acc)[2][2][4][2], const Unit& u, int wr, int wc, int fr, int fq) const {
        f32x4* p = (f32x4*)part + (size_t)u.aux * (32 * NTHR) + threadIdx.x;
#pragma unroll
        for (int ai = 0; ai < 2; ++ai)
#pragma unroll
            for (int bj = 0; bj < 2; ++bj)
#pragma unroll
                for (int m = 0; m < 4; ++m)
#pragma unroll
                    for (int n = 0; n < 2; ++n) p[(size_t)(((ai * 2 + bj) * 4 + m) * 2 + n) * NTHR] = acc[ai][bj][m][n];
    }
};
template <int S> DI void splitk_reduce_f32(const float* part, int t, int cg, const Unit& u, float* C, int ldc) {
    const int tid = threadIdx.x, wid = tid >> 6, lane = tid & 63, wr = wid >> 2, wc = wid & 3, fr = lane & 15, fq = lane >> 4;
    f32x4 v[4][S];
#pragma unroll
    for (int k = 0; k < 4; ++k)
#pragma unroll
        for (int s = 0; s < S; ++s) v[k][s] = *((const f32x4*)part + ((size_t)(t * S + s) * 32 + (cg * 4 + k)) * NTHR + tid);
#pragma unroll
    for (int k = 0; k < 4; ++k)
#pragma unroll
        for (int s = 0; s < S; ++s) PINV(v[k][s]);
#pragma unroll
    for (int k = 0; k < 4; ++k) { const int ch = cg * 4 + k, n = ch & 1, m = (ch >> 1) & 3, bj = (ch >> 3) & 1, ai = ch >> 4;
        f32x4 a = v[k][0];
#pragma unroll
        for (int s = 1; s < S; ++s) a += v[k][s];
        *(f32x4*)(C + (size_t)(u.pm * 256 + ai * 128 + wr * 64 + m * 16 + fr) * ldc + u.pn * 256 + bj * 128 + wc * 32 + n * 16 + 4 * fq) = a; }
}
DI int tc_of(int dir, int p) { return dir == 0 ? (p < 4 ? 32 + p : p - 4) : 35 - p; }

DI void m1_prep_unit(Frame& F, int l, int b, int tt) {
    const bf16* P = WSP(bf16, WS_P); const float* GR = WSP(float, WS_GRAW);
    const int j0 = tt * 32, lane = F.lane;
    LAS bf16* vs = (LAS bf16*)F.lds;
    float qnv[7], knv[3], gqv[2], gkv[2];
#pragma unroll
    for (int u = 0; u < 7; ++u) qnv[u] = F.in[18][l * 448 + lane + 64 * u];
#pragma unroll
    for (int u = 0; u < 3; ++u) knv[u] = (lane + 64 * u < 160) ? F.in[20][l * 160 + lane + 64 * u] : 0.f;
    gqv[0] = F.in[24][l * 128 + lane]; gqv[1] = F.in[24][l * 128 + 64 + lane]; gkv[0] = F.in[25][l * 128 + lane]; gkv[1] = F.in[25][l * 128 + 64 + lane];
    const float ib = lane < 8 ? F.in[9][l * 8 + lane] : 0.f, fb = lane < 8 ? F.in[10][l * 8 + lane] : 0.f, db = lane < 16 ? F.in[14][l * 16 + lane] : 0.f;
    for (int i = F.wave; i < 32; i += 8) {
        const int j = j0 + i, row = rowof(b, j);
        const bf16* p = P + (size_t)row * DINP; const float* gr = GR + (size_t)row * 32;
        unsigned cqw[7], ckw[3], nqw[4][2], nkw[4][2], nvw[8];
#pragma unroll
        for (int u = 0; u < 7; ++u) cqw[u] = p[PC_CQ + lane + 64 * u];
#pragma unroll
        for (int u = 0; u < 3; ++u) { const int idx = lane + 64 * u; ckw[u] = idx < 160 ? (unsigned)p[PC_CKV + idx] : 0u; }
#pragma unroll
        for (int h = 0; h < 4; ++h) { nqw[h][0] = p[PC_NQ + h * 128 + lane]; nqw[h][1] = p[PC_NQ + h * 128 + 64 + lane]; nkw[h][0] = p[PC_NK + h * 128 + lane]; nkw[h][1] = p[PC_NK + h * 128 + 64 + lane]; }
#pragma unroll
        for (int u = 0; u < 8; ++u) nvw[u] = p[PC_NV + lane + 64 * u];
        float gi = lane < 8 ? gr[lane] : 0.f, gf = lane < 8 ? gr[8 + lane] : 0.f, gd = lane < 16 ? gr[16 + lane] : 0.f;
        PIN4(cqw); PINV(cqw[4]); PINV(cqw[5]); PINV(cqw[6]); PINV(ckw[0]); PINV(ckw[1]); PINV(ckw[2]); PIN8(nvw); PINV(gi); PINV(gf); PINV(gd);
#pragma unroll
        for (int h = 0; h < 4; ++h) { PINV(nqw[h][0]); PINV(nqw[h][1]); PINV(nkw[h][0]); PINV(nkw[h][1]); }
        float cq[7], ckv[3], nq[4][2], nk[4][2]; bf16 nv[8];
#pragma unroll
        for (int u = 0; u < 7; ++u) cq[u] = bf2f(cqw[u]);
#pragma unroll
        for (int u = 0; u < 3; ++u) ckv[u] = bf2f(ckw[u]);
#pragma unroll
        for (int h = 0; h < 4; ++h) { nq[h][0] = bf2f(nqw[h][0]); nq[h][1] = bf2f(nqw[h][1]); nk[h][0] = bf2f(nkw[h][0]); nk[h][1] = bf2f(nkw[h][1]); }
#pragma unroll
        for (int u = 0; u < 8; ++u) nv[u] = (bf16)nvw[u];
        {
            float ss = 0.f;
#pragma unroll
            for (int u = 0; u < 7; ++u) ss += cq[u] * cq[u];
            const float rstd = 1.0f / sqrtf(wave_sum(ss) * (1.f / 448.f) + EPS);
            bf16* o = WSP(bf16, WS_CQN) + (size_t)row * 512;
#pragma unroll
            for (int u = 0; u < 7; ++u) o[lane + 64 * u] = (bf16)f2bf(cq[u] * rstd * qnv[u]);
            o[448 + lane] = 0;
        }
        {
            float ss = 0.f;
#pragma unroll
            for (int u = 0; u < 3; ++u) ss += ckv[u] * ckv[u];
            const float rstd = 1.0f / sqrtf(wave_sum(ss) * (1.f / 160.f) + EPS);
            bf16* o = WSP(bf16, WS_CKVN) + (size_t)row * 256;
#pragma unroll
            for (int u = 0; u < 3; ++u) { const int idx = lane + 64 * u; o[idx] = idx < 160 ? (bf16)f2bf(ckv[u] * rstd * knv[u]) : (bf16)0; }
            o[192 + lane] = 0;
        }
#pragma unroll
        for (int h = 0; h < 4; ++h) {
            const float rq = 1.0f / sqrtf(wave_sum(nq[h][0] * nq[h][0] + nq[h][1] * nq[h][1]) * (1.f / 128.f) + EPS);
            const float rk = 1.0f / sqrtf(wave_sum(nk[h][0] * nk[h][0] + nk[h][1] * nk[h][1]) * (1.f / 128.f) + EPS);
            bf16* oq = WSP(bf16, WS_QNA) + ((size_t)(b * 4 + h) * TS + j) * 128; bf16* ok = WSP(bf16, WS_KNA) + ((size_t)(b * 4 + h) * TS + j) * 128;
            oq[lane] = (bf16)f2bf(nq[h][0] * rq * gqv[0]); oq[64 + lane] = (bf16)f2bf(nq[h][1] * rq * gqv[1]);
            ok[lane] = (bf16)f2bf(nk[h][0] * rk * gkv[0]); ok[64 + lane] = (bf16)f2bf(nk[h][1] * rk * gkv[1]);
        }
#pragma unroll
        for (int u = 0; u < 8; ++u) vs[i * 520 + lane + 64 * u] = nv[u];
        if (lane < 8) {
            float* gt = WSP(float, WS_GATES) + (size_t)row * 16;
            gt[lane] = gi + ib;
            gt[8 + lane] = logsigmoidf_(gf + fb);
        }
        if (lane < 16) WSP(float, WS_DT)[(size_t)row * 16 + lane] = softplusf_(gd + db);
    }
    {
        const int ch = 2 * F.tid;
        const int seglo = j0 < TL ? 0 : TL, seghi = j0 < TL ? TL : TS;
        const float* cw = F.in[12] + (size_t)l * 5 * 1024 + ch; const float* cb = F.in[13] + (size_t)l * 1024 + ch;
        f32x2 w[5];
#pragma unroll
        for (int d = 0; d < 5; ++d) w[d] = *(const f32x2*)(cw + d * 1024);
        const f32x2 bias = *(const f32x2*)cb;
        unsigned xww[36];
#pragma unroll
        for (int d = 0; d < 36; ++d) { const int jj = j0 - 2 + d; xww[d] = 0u; if (jj >= seglo && jj < seghi) xww[d] = *(const unsigned*)(P + (size_t)rowof(b, jj) * DINP + PC_XBC + ch); }
        PIN8(xww); PIN8(xww + 8); PIN8(xww + 16); PIN8(xww + 24); PIN4(xww + 32);
        f32x2 xin[36];
#pragma unroll
        for (int d = 0; d < 36; ++d) xin[d] = (f32x2){bf2f(xww[d] & 0xffffu), bf2f(xww[d] >> 16)};
#pragma unroll
        for (int i = 0; i < 32; ++i) {
            f32x2 a = bias;
#pragma unroll
            for (int d = 0; d < 5; ++d) a += w[d] * xin[i + d];
            *(unsigned*)(WSP(bf16, WS_XBC) + (size_t)rowof(b, j0 + i) * 1024 + ch) = pk2(siluf(a[0]), siluf(a[1]));
        }
    }
    __syncthreads();
    {
        const int t = F.tid; unsigned wv[16];
#pragma unroll
        for (int i = 0; i < 16; ++i) wv[i] = (unsigned)vs[(2 * i) * 520 + t] | ((unsigned)vs[(2 * i + 1) * 520 + t] << 16);
        u32x4* dst = (u32x4*)(WSP(bf16, WS_VTNA) + ((size_t)(b * 4 + (t >> 7)) * 128 + (t & 127)) * TS + j0);
#pragma unroll
        for (int k = 0; k < 4; ++k) dst[k] = (u32x4){wv[4 * k], wv[4 * k + 1], wv[4 * k + 2], wv[4 * k + 3]};
    }
    __syncthreads();
}

DI void ml_a_unit(Frame& F, int seq, int p) {
    const int b = seq >> 3, h = (seq >> 1) & 3, dir = seq & 1, tc = tc_of(dir, p), lane = F.lane;
    const bf16* P = WSP(bf16, WS_P);
    LAS bf16* VW = (LAS bf16*)F.lds;
    LAS bf16* KT = (LAS bf16*)(F.lds + 20736);
    LAS float* wgs = (LAS float*)(F.lds + 39168);
    if (F.wave == 0) {
        const int row = rowof(b, tc * 64 + lane);
        const float* gt = WSP(float, WS_GATES) + (size_t)row * 16;
        const float li = gt[dir * 4 + h], lf = gt[8 + dir * 4 + h];
        const float pre = wave_incl_scan(lf, lane), tot = lane_bcast(pre, 63);
        const float g = dir == 0 ? (tot - pre) + li : (pre - lf) + li;
        const float mloc = wave_max(g);
        wgs[lane] = __expf(g - mloc);
        if (lane == 0) { float* sc = WSP(float, WS_MLSC) + (size_t)(seq * 36 + p) * 4; sc[0] = tot; sc[1] = mloc; }
    }
    {
        unsigned vw[16], kw[16];
#pragma unroll
        for (int it = 0; it < 16; ++it) { const int idx = F.tid + NTHR * it, n = idx >> 7, d = idx & 127;
            const bf16* pr = P + (size_t)rowof(b, tc * 64 + n) * DINP + h * 128 + d; vw[it] = pr[PC_MLV]; kw[it] = pr[PC_MLK]; }
        PIN8(vw); PIN8(vw + 8); PIN8(kw); PIN8(kw + 8);
        float vv[16]; bf16 kk[16];
#pragma unroll
        for (int it = 0; it < 16; ++it) { vv[it] = bf2f(vw[it]); kk[it] = (bf16)kw[it]; }
        __syncthreads();
#pragma unroll
        for (int it = 0; it < 16; ++it) { const int idx = F.tid + NTHR * it, n = idx >> 7, d = idx & 127;
            VW[d * 72 + n] = (bf16)f2bf(vv[it] * wgs[n]); KT[d * 72 + n] = kk[it]; }
    }
    for (int idx = F.tid; idx < 16 * 64; idx += NTHR) { const int rr = idx >> 6, n = idx & 63; VW[(128 + rr) * 72 + n] = rr == 0 ? (bf16)f2bf(wgs[n]) : (bf16)0; }
    __syncthreads();
    float* U = WSP(float, WS_MLU) + (size_t)(seq * 36 + p) * (129 * 128);
    for (int id = F.wave; id < 72; id += 8) { const int dt = id >> 3, et = id & 7;
        const f32x4 acc = mma16<64>(VW + dt * 16 * 72, 72, KT + et * 16 * 72, 72, lane, (f32x4){0.f, 0.f, 0.f, 0.f});
#pragma unroll
        for (int i = 0; i < 4; ++i) { const int d = dt * 16 + 4 * (lane >> 4) + i; if (d < 129) U[d * 128 + et * 16 + (lane & 15)] = acc[i]; } }
    __syncthreads();
}

DI void ss_a_unit(Frame& F, int l, int b, int dir, int p, int g) {
    const int tc = tc_of(dir, p), lane = F.lane;
    LAS bf16* XT = (LAS bf16*)F.lds;
    LAS bf16* BT = (LAS bf16*)(F.lds + 36864);
    LAS float* tails = (LAS float*)(F.lds + 55296);
    const bf16* XBC = WSP(bf16, WS_XBC);
    if (F.wave < 4) {
        const int h = 4 * g + F.wave, row = rowof(b, tc * 64 + lane);
        const float dt = WSP(float, WS_DT)[(size_t)row * 16 + dir * 8 + h];
        const float A = -__expf(F.in[15][l * 16 + dir * 8 + h]);
        const float a = dt * A, pre = wave_incl_scan(a, lane), tot = lane_bcast(pre, 63);
        tails[F.wave * 64 + lane] = (dir == 0 ? __expf(tot - pre) : __expf(pre - a)) * dt;
        if (lane == 0) WSP(float, WS_SSSC)[(size_t)((b * 8 + h) * 2 + dir) * 36 + p] = __expf(tot);
    }
    {
        unsigned xv[32], bv[16];
#pragma unroll
        for (int it = 0; it < 32; ++it) { const int idx = F.tid + NTHR * it, n = idx >> 8, c = idx & 255; xv[it] = XBC[(size_t)rowof(b, tc * 64 + n) * 1024 + g * 256 + c]; }
#pragma unroll
        for (int it = 0; it < 16; ++it) { const int idx = F.tid + NTHR * it, n = idx >> 7, nn = idx & 127; bv[it] = XBC[(size_t)rowof(b, tc * 64 + n) * 1024 + 512 + g * 128 + nn]; }
        PIN8(xv); PIN8(xv + 8); PIN8(xv + 16); PIN8(xv + 24); PIN8(bv); PIN8(bv + 8);
        __syncthreads();
#pragma unroll
        for (int it = 0; it < 32; ++it) { const int idx = F.tid + NTHR * it, n = idx >> 8, c = idx & 255; XT[c * 72 + n] = (bf16)f2bf(bf2f(xv[it]) * tails[(c >> 6) * 64 + n]); }
#pragma unroll
        for (int it = 0; it < 16; ++it) { const int idx = F.tid + NTHR * it, n = idx >> 7, nn = idx & 127; BT[nn * 72 + n] = (bf16)bv[it]; }
    }
    __syncthreads();
    for (int id = F.wave; id < 128; id += 8) { const int hh = id >> 5, rem = id & 31, pt = rem >> 3, nt = rem & 7;
        const f32x4 acc = mma16<64>(XT + (hh * 64 + pt * 16) * 72, 72, BT + nt * 16 * 72, 72, lane, (f32x4){0.f, 0.f, 0.f, 0.f});
        float* U = WSP(float, WS_SSU) + (size_t)(((b * 8 + 4 * g + hh) * 2 + dir) * 36 + p) * 8192;
#pragma unroll
        for (int i = 0; i < 4; ++i) U[(pt * 16 + 4 * (lane >> 4) + i) * 128 + nt * 16 + (lane & 15)] = acc[i]; }
    __syncthreads();
}
DI void ml_scan_unit(Frame& F, int seq, int s4) {
    float* sc = WSP(float, WS_MLSC) + (size_t)seq * 36 * 4;
    const float* U = WSP(float, WS_MLU) + (size_t)seq * 36 * 16512 + s4 * 4128 + F.tid; bf16* S = WSP(bf16, WS_MLS) + (size_t)seq * 36 * 16512 + s4 * 4128 + F.tid;
    float st[9]; float m = 0.f;
#pragma unroll
    for (int k = 0; k < 9; ++k) st[k] = 0.f;
    for (int pg = 0; pg < 36; pg += 12) {
        float u[12][9];
#pragma unroll
        for (int pp = 0; pp < 12; ++pp)
#pragma unroll
            for (int k = 0; k < 9; ++k) u[pp][k] = (F.tid + 512 * k < 4128) ? U[(size_t)(pg + pp) * 16512 + 512 * k] : 0.f;
#pragma unroll
        for (int pp = 0; pp < 12; ++pp) { PIN8(u[pp]); PINV(u[pp][8]); }
#pragma unroll
        for (int pp = 0; pp < 12; ++pp) { const int p = pg + pp;
            const float bl = sc[p * 4], mloc = sc[p * 4 + 1];
            const float mn = fmaxf(bl + m, mloc), wc = __expf(bl + m - mn), wu = __expf(mloc - mn);
            if (s4 == 0 && F.tid == 0) sc[p * 4 + 2] = m;
#pragma unroll
            for (int k = 0; k < 9; ++k) { if (F.tid + 512 * k < 4128) S[(size_t)p * 16512 + 512 * k] = (bf16)f2bf(st[k]); st[k] = wc * st[k] + wu * u[pp][k]; }
            m = mn; }
    }
}
DI void ss_scan_unit(Frame& F, int sq, int half) {
    const float* dec = WSP(float, WS_SSSC) + (size_t)sq * 36;
    const float* U = WSP(float, WS_SSU) + (size_t)sq * 36 * 8192 + half * 4096 + F.tid; bf16* S = WSP(bf16, WS_SSS) + (size_t)sq * 36 * 8192 + half * 4096 + F.tid;
    float st[8];
#pragma unroll
    for (int k = 0; k < 8; ++k) st[k] = 0.f;
    for (int pg = 0; pg < 36; pg += 12) {
        float u[12][8];
#pragma unroll
        for (int pp = 0; pp < 12; ++pp)
#pragma unroll
            for (int k = 0; k < 8; ++k) u[pp][k] = U[(size_t)(pg + pp) * 8192 + 512 * k];
#pragma unroll
        for (int pp = 0; pp < 12; ++pp) PIN8(u[pp]);
#pragma unroll
        for (int pp = 0; pp < 12; ++pp) { const int p = pg + pp; const float dc = dec[p];
#pragma unroll
            for (int k = 0; k < 8; ++k) { S[(size_t)p * 8192 + 512 * k] = (bf16)f2bf(st[k]); st[k] = st[k] * dc + u[pp][k]; } }
    }
}
DI void mla_post_unit(Frame& F, int l, int b, int tt) {
    const bf16* P = WSP(bf16, WS_P);
    const bf16* QRAW = WSP(bf16, WS_QRAW); const bf16* KVRAW = WSP(bf16, WS_KVRAW);
    const int j0 = tt * 32, lane = F.lane;
    LAS bf16* vs = (LAS bf16*)F.lds;
    const float* gq = F.in[22] + l * 192; const float* gk = F.in[23] + l * 192;
    unsigned qw[4][4][3], kw[4][4][2], vw[4][4][2], krw[4];
#pragma unroll
    for (int it = 0; it < 4; ++it) {
        const int row = rowof(b, j0 + F.wave + 8 * it);
        krw[it] = P[(size_t)row * DINP + PC_KR + lane];
#pragma unroll
        for (int h = 0; h < 4; ++h) { const bf16* q = QRAW + (size_t)row * 768 + h * 192; const bf16* kv = KVRAW + (size_t)row * 1024 + h * 256;
            qw[it][h][0] = q[lane]; qw[it][h][1] = q[64 + lane]; qw[it][h][2] = q[128 + lane];
            kw[it][h][0] = kv[lane]; kw[it][h][1] = kv[64 + lane]; vw[it][h][0] = kv[128 + lane]; vw[it][h][1] = kv[192 + lane]; }
    }
#pragma unroll
    for (int it = 0; it < 4; ++it) { PIN4(krw);
#pragma unroll
        for (int h = 0; h < 4; ++h) { PINV(qw[it][h][0]); PINV(qw[it][h][1]); PINV(qw[it][h][2]); PINV(kw[it][h][0]); PINV(kw[it][h][1]); PINV(vw[it][h][0]); PINV(vw[it][h][1]); } }
    float qv[4][4][3], kk[4][4][2], krv[4]; bf16 vv[4][4][2];
#pragma unroll
    for (int it = 0; it < 4; ++it) { krv[it] = bf2f(krw[it]);
#pragma unroll
        for (int h = 0; h < 4; ++h) { qv[it][h][0] = bf2f(qw[it][h][0]); qv[it][h][1] = bf2f(qw[it][h][1]); qv[it][h][2] = bf2f(qw[it][h][2]);
            kk[it][h][0] = bf2f(kw[it][h][0]); kk[it][h][1] = bf2f(kw[it][h][1]); vv[it][h][0] = (bf16)vw[it][h][0]; vv[it][h][1] = (bf16)vw[it][h][1]; } }
    const float gq0 = gq[lane], gq1 = gq[64 + lane], gq2 = gq[128 + lane], gk0 = gk[lane], gk1 = gk[64 + lane], gk2 = gk[128 + lane];
    const int a = lane & 31;
    const float fr = exp2f(-(float)(a & 15) * (13.287712379549449f / 16.f));
#pragma unroll
    for (int it = 0; it < 4; ++it) {
        const int i = F.wave + 8 * it, j = j0 + i; const bool lat = j < TL;
        const float pos = (float)(a < 16 ? (j >> 6) : (j & 63));
        const float ang = pos * fr; const float cs = __cosf(ang), sn = __sinf(ang);
#pragma unroll
        for (int h = 0; h < 4; ++h) {
            {
                const float v0 = qv[it][h][0], v1 = qv[it][h][1], v2 = qv[it][h][2];
                const float rstd = 1.0f / sqrtf(wave_sum(v0 * v0 + v1 * v1 + v2 * v2) * (1.f / 192.f) + EPS);
                const float n0 = v0 * rstd * gq0, n1 = v1 * rstd * gq1; float n2 = v2 * rstd * gq2;
                const float pr = xor32_get(n2, lane);
                if (lat) n2 = lane < 32 ? n2 * cs - pr * sn : pr * sn + n2 * cs;
                bf16* o = WSP(bf16, WS_QMLA) + ((size_t)(b * 4 + h) * TS + j) * 192;
                o[lane] = (bf16)f2bf(n0); o[64 + lane] = (bf16)f2bf(n1); o[128 + lane] = (bf16)f2bf(n2);
            }
            {
                const float v0 = kk[it][h][0], v1 = kk[it][h][1], v2 = krv[it];
                const float rstd = 1.0f / sqrtf(wave_sum(v0 * v0 + v1 * v1 + v2 * v2) * (1.f / 192.f) + EPS);
                const float n0 = v0 * rstd * gk0, n1 = v1 * rstd * gk1; float n2 = v2 * rstd * gk2;
                const float pr = xor32_get(n2, lane);
                if (lat) n2 = lane < 32 ? n2 * cs - pr * sn : pr * sn + n2 * cs;
                bf16* o = WSP(bf16, WS_KMLA) + ((size_t)(b * 4 + h) * TS + j) * 192;
                o[lane] = (bf16)f2bf(n0); o[64 + lane] = (bf16)f2bf(n1); o[128 + lane] = (bf16)f2bf(n2);
                vs[i * 520 + h * 128 + lane] = vv[it][h][0]; vs[i * 520 + h * 128 + 64 + lane] = vv[it][h][1];
            }
        }
    }
    __syncthreads();
    {
        const int t = F.tid; unsigned wv[16];
#pragma unroll
        for (int i = 0; i < 16; ++i) wv[i] = (unsigned)vs[(2 * i) * 520 + t] | ((unsigned)vs[(2 * i + 1) * 520 + t] << 16);
        u32x4* dst = (u32x4*)(WSP(bf16, WS_VTMLA) + ((size_t)(b * 4 + (t >> 7)) * 128 + (t & 127)) * TS + j0);
#pragma unroll
        for (int k = 0; k < 4; ++k) dst[k] = (u32x4){wv[4 * k], wv[4 * k + 1], wv[4 * k + 2], wv[4 * k + 3]};
    }
    __syncthreads();
}

template <int DK, bool NA>
DI void attn_unit(Frame& F, const bf16* Qg, const bf16* Kg, const bf16* VTg, int nA, int tA0, int nB, int tB0, float scale, bf16* Og, int qrow0, const float* rpb) {
    constexpr int KP = DK + 8, KCH = DK / 8, NKC = 64 * KCH / NTHR;
    LAS bf16* Ks = (LAS bf16*)F.lds;
    LAS bf16* VTs = (LAS bf16*)(F.lds + 64 * KP * 2);
    LAS bf16* Ps = (LAS bf16*)(F.lds + 64 * KP * 2 + 128 * 72 * 2) + F.wave * (16 * 72);
    LAS float* rp = (LAS float*)(F.lds + 64 * KP * 2 + 128 * 72 * 2 + 8 * 16 * 72 * 2);
    const int lane = F.lane, r = lane & 15, q = lane >> 4, tid = F.tid, w = F.wave;
    if (NA) { for (int i = tid; i < 15 * 31; i += NTHR) rp[i] = rpb[i]; }
    bf16x8 qf[DK / 32];
#pragma unroll
    for (int kk = 0; kk < DK / 32; ++kk) qf[kk] = *(const bf16x8*)(Qg + (size_t)(w * 16 + r) * DK + 32 * kk + 8 * q);
    f32x4 o[8]; float mrow[4], lrow[4];
#pragma unroll
    for (int d = 0; d < 8; ++d) o[d] = (f32x4){0.f, 0.f, 0.f, 0.f};
#pragma unroll
    for (int i = 0; i < 4; ++i) { mrow[i] = -1.0e30f; lrow[i] = 0.f; }
    const int ntile = nA + nB;
    u32x4 kreg[NKC], vreg[2];
    const int rq = qrow0 + (w >> 2);
    const int r0 = rq - 4 < 0 ? 0 : (rq - 4 > 24 ? 24 : rq - 4);
#define ATT_LOAD(kt) do { _Pragma("unroll") for (int c = 0; c < NKC; ++c) { const int id = tid + NTHR * c, rr = id / KCH, cc = id % KCH; kreg[c] = *(const u32x4*)(Kg + (size_t)((kt) * 64 + rr) * DK + cc * 8); } \
        _Pragma("unroll") for (int c = 0; c < 2; ++c) { const int id = tid + NTHR * c, dd = id >> 3, cc = id & 7; vreg[c] = *(const u32x4*)(VTg + (size_t)dd * TS + (kt) * 64 + cc * 8); } } while (0)
    ATT_LOAD(nA > 0 ? tA0 : tB0);
    for (int it = 0; it < ntile; ++it) {
        const int kt = it < nA ? tA0 + it : tB0 + (it - nA);
        __syncthreads();
#pragma unroll
        for (int c = 0; c < NKC; ++c) { const int id = tid + NTHR * c, rr = id / KCH, cc = id % KCH; *(LAS u32x4*)(Ks + rr * KP + cc * 8) = kreg[c]; }
#pragma unroll
        for (int c = 0; c < 2; ++c) { const int id = tid + NTHR * c, dd = id >> 3, cc = id & 7; *(LAS u32x4*)(VTs + dd * 72 + cc * 8) = vreg[c]; }
        __syncthreads();
        if (it + 1 < ntile) { const int kn = (it + 1) < nA ? tA0 + it + 1 : tB0 + (it + 1 - nA); ATT_LOAD(kn); }
        const bool nbt = NA && kt < 32;
        if (nbt && (kt < r0 || kt >= r0 + 8)) continue;
        f32x4 s[4];
#pragma unroll
        for (int n = 0; n < 4; ++n) s[n] = (f32x4){0.f, 0.f, 0.f, 0.f};
#pragma unroll
        for (int kk = 0; kk < DK / 32; ++kk)
#pragma unroll
            for (int n = 0; n < 4; ++n) { const bf16x8 kf = *(const LAS bf16x8*)(Ks + (n * 16 + r) * KP + 32 * kk + 8 * q); s[n] = __builtin_amdgcn_mfma_f32_16x16x32_bf16(qf[kk], kf, s[n], 0, 0, 0); }
        float mx[4];
#pragma unroll
        for (int i = 0; i < 4; ++i) mx[i] = -1.0e30f;
#pragma unroll
        for (int n = 0; n < 4; ++n)
#pragma unroll
            for (int i = 0; i < 4; ++i) {
                float v = s[n][i] * scale;
                if (nbt) { const int c = (w & 3) * 16 + 4 * q + i, kc = n * 16 + r; const int c0 = c - 8 < 0 ? 0 : (c - 8 > 48 ? 48 : c - 8);
                    v = (kc >= c0 && kc < c0 + 16) ? v + rp[(kt - rq + 7) * 31 + (kc - c + 15)] : -1.0e30f; }
                s[n][i] = v; mx[i] = fmaxf(mx[i], v);
            }
        float alpha[4], rs[4];
#pragma unroll
        for (int i = 0; i < 4; ++i) {
            float m = mx[i]; m = fmaxf(m, __shfl_xor(m, 1)); m = fmaxf(m, __shfl_xor(m, 2)); m = fmaxf(m, __shfl_xor(m, 4)); m = fmaxf(m, __shfl_xor(m, 8));
            const float mn = fmaxf(mrow[i], m); alpha[i] = __expf(mrow[i] - mn); mrow[i] = mn; rs[i] = 0.f;
        }
#pragma unroll
        for (int n = 0; n < 4; ++n)
#pragma unroll
            for (int i = 0; i < 4; ++i) { const float pv = __expf(s[n][i] - mrow[i]); rs[i] += pv; Ps[(4 * q + i) * 72 + n * 16 + r] = (bf16)f2bf(pv); }
#pragma unroll
        for (int i = 0; i < 4; ++i) {
            float t = rs[i]; t += __shfl_xor(t, 1); t += __shfl_xor(t, 2); t += __shfl_xor(t, 4); t += __shfl_xor(t, 8);
            lrow[i] = lrow[i] * alpha[i] + t;
        }
#pragma unroll
        for (int d = 0; d < 8; ++d)
#pragma unroll
            for (int i = 0; i < 4; ++i) o[d][i] *= alpha[i];
        asm volatile("s_waitcnt lgkmcnt(0)" ::: "memory");
#pragma unroll
        for (int kk = 0; kk < 2; ++kk) { const bf16x8 pf = *(const LAS bf16x8*)(Ps + r * 72 + 32 * kk + 8 * q);
#pragma unroll
            for (int d = 0; d < 8; ++d) { const bf16x8 vf = *(const LAS bf16x8*)(VTs + (d * 16 + r) * 72 + 32 * kk + 8 * q); o[d] = __builtin_amdgcn_mfma_f32_16x16x32_bf16(pf, vf, o[d], 0, 0, 0); } }
    }
#undef ATT_LOAD
#pragma unroll
    for (int i = 0; i < 4; ++i) { const float inv = 1.0f / lrow[i]; bf16* op = Og + (size_t)(w * 16 + 4 * q + i) * D + r;
#pragma unroll
        for (int d = 0; d < 8; ++d) op[d * 16] = (bf16)f2bf(o[d][i] * inv); }
    __syncthreads();
}
typedef float f32x16 __attribute__((ext_vector_type(16)));
typedef short s16x4 __attribute__((ext_vector_type(4)));
template <int DK, bool NA>
DI void attn_unit2(Frame& F, const bf16* Qg, const bf16* Kg, const bf16* VTg, int nA, int tA0, int nB, int tB0, float sc2, bf16* Og, int qrow0, const float* rpb) {
    constexpr int KP = DK + 8, KCH = DK / 8, NKC = 64 * KCH / NTHR, NKK = DK / 16;
    constexpr int KTB = 64 * KP * 2, VTB = 128 * 72 * 2, BUFB = KTB + VTB;
    const int lane = F.lane, l32 = lane & 31, h = lane >> 5, tid = F.tid, w = F.wave, g = w & 3, kp = w >> 2;
    LAS float* rp = (LAS float*)(F.lds + 2 * BUFB);
    if (NA) { for (int i = tid; i < 15 * 31; i += NTHR) rp[i] = rpb[i] * 1.4426950408889634f; }
    bf16x8 qf[NKK];
#pragma unroll
    for (int kk = 0; kk < NKK; ++kk) qf[kk] = *(const bf16x8*)(Qg + (size_t)(32 * g + l32) * DK + 16 * kk + 8 * h);
    f32x16 o[4]; float mrun = -1.0e30f, lrun = 0.f;
#pragma unroll
    for (int d = 0; d < 4; ++d)
#pragma unroll
        for (int i = 0; i < 16; ++i) o[d][i] = 0.f;
    const int ntile = nA + nB;
    const int rq = qrow0 + (g >> 1), r0 = rq - 4 < 0 ? 0 : (rq - 4 > 24 ? 24 : rq - 4);
    const int cq = 32 * (g & 1) + l32, c0 = cq - 8 < 0 ? 0 : (cq - 8 > 48 ? 48 : cq - 8);
    u32x4 kreg[NKC], vreg[2];
#define ATT2_TILE(it) ((it) < nA ? tA0 + (it) : tB0 + ((it) - nA))
#define ATT2_LOAD(it) do { const int kt_ = ATT2_TILE(it); \
        _Pragma("unroll") for (int c = 0; c < NKC; ++c) { const int id = tid + NTHR * c, rr = id / KCH, cc = id % KCH; kreg[c] = *(const u32x4*)(Kg + (size_t)(kt_ * 64 + rr) * DK + cc * 8); } \
        _Pragma("unroll") for (int c = 0; c < 2; ++c) { const int id = tid + NTHR * c, dd = id >> 3, cc = id & 7; vreg[c] = *(const u32x4*)(VTg + (size_t)dd * TS + kt_ * 64 + cc * 8); } } while (0)
#define ATT2_STORE(b) do { \
        _Pragma("unroll") for (int c = 0; c < NKC; ++c) { const int id = tid + NTHR * c, rr = id / KCH, cc = id % KCH; *(LAS u32x4*)(F.lds + (b) * BUFB + (rr * KP + cc * 8) * 2) = kreg[c]; } \
        _Pragma("unroll") for (int c = 0; c < 2; ++c) { const int id = tid + NTHR * c, dd = id >> 3, cc = id & 7; *(LAS u32x4*)(F.lds + (b) * BUFB + KTB + (dd * 72 + cc * 8) * 2) = vreg[c]; } } while (0)
    ATT2_LOAD(0); ATT2_STORE(0);
    __syncthreads();
    for (int st = 0; st < ntile; ++st) {
        if (st + 1 < ntile) ATT2_LOAD(st + 1);
        const int kt = ATT2_TILE(st);
        const bool nbt = NA && kt < 32;
        if (!(nbt && (kt < r0 || kt >= r0 + 8))) {
            const LAS bf16* Ks = (const LAS bf16*)(F.lds + (st & 1) * BUFB) + (kp * 32 + l32) * KP + 8 * h;
            const LAS bf16* VTs = (const LAS bf16*)(F.lds + (st & 1) * BUFB + KTB) + l32 * 72 + kp * 32 + 4 * h;
            f32x16 s;
#pragma unroll
            for (int i = 0; i < 16; ++i) s[i] = 0.f;
#pragma unroll
            for (int kk = 0; kk < NKK; ++kk) { const bf16x8 kf = *(const LAS bf16x8*)(Ks + 16 * kk); s = __builtin_amdgcn_mfma_f32_32x32x16_bf16(kf, qf[kk], s, 0, 0, 0); }
            float mx = -1.0e30f, mn, alpha, rs = 0.f;
            if (nbt) {
#pragma unroll
                for (int i = 0; i < 16; ++i) {
                    float v = s[i] * sc2;
                    const int kc = kp * 32 + 8 * (i >> 2) + 4 * h + (i & 3); v = (kc >= c0 && kc < c0 + 16) ? v + rp[(kt - rq + 7) * 31 + (kc - cq + 15)] : -1.0e30f;
                    s[i] = v; mx = fmaxf(mx, v);
                }
                mx = xor32_max(mx);
                mn = fmaxf(mrun, mx); alpha = __builtin_amdgcn_exp2f(mrun - mn); mrun = mn;
#pragma unroll
                for (int i = 0; i < 16; ++i) { const float pv = __builtin_amdgcn_exp2f(s[i] - mn); s[i] = pv; rs += pv; }
            } else {
#pragma unroll
                for (int i = 0; i < 16; ++i) mx = fmaxf(mx, s[i]);
                mx = xor32_max(mx) * sc2;
                mn = fmaxf(mrun, mx); alpha = __builtin_amdgcn_exp2f(mrun - mn); mrun = mn;
#pragma unroll
                for (int i = 0; i < 16; ++i) { const float pv = __builtin_amdgcn_exp2f(fmaf(s[i], sc2, -mn)); s[i] = pv; rs += pv; }
            }
            rs = xor32_sum(rs);
            lrun = lrun * alpha + rs;
            if (__any(alpha != 1.0f)) {
#pragma unroll
                for (int d = 0; d < 4; ++d)
#pragma unroll
                    for (int i = 0; i < 16; ++i) o[d][i] *= alpha;
            }
#pragma unroll
            for (int sp = 0; sp < 2; ++sp) {
                u32x4 pw; pw.x = pg8::cvt_pk_bf16(s[8 * sp + 0], s[8 * sp + 1]); pw.y = pg8::cvt_pk_bf16(s[8 * sp + 2], s[8 * sp + 3]);
                pw.z = pg8::cvt_pk_bf16(s[8 * sp + 4], s[8 * sp + 5]); pw.w = pg8::cvt_pk_bf16(s[8 * sp + 6], s[8 * sp + 7]);
                const bf16x8 pf = __builtin_bit_cast(bf16x8, pw);
#pragma unroll
                for (int d = 0; d < 4; ++d) { const LAS bf16* vp = VTs + d * 32 * 72 + 16 * sp;
                    const u32x2 lo = *(const LAS u32x2*)vp, hi = *(const LAS u32x2*)(vp + 8);
                    const u32x4 vv = (u32x4){lo.x, lo.y, hi.x, hi.y};
                    o[d] = __builtin_amdgcn_mfma_f32_32x32x16_bf16(__builtin_bit_cast(bf16x8, vv), pf, o[d], 0, 0, 0); }
            }
        }
        if (st + 1 < ntile) ATT2_STORE((st + 1) & 1);
        __syncthreads();
    }
#undef ATT2_LOAD
#undef ATT2_STORE
#undef ATT2_TILE
    LAS float* ob = (LAS float*)F.lds + g * (66 * 64);
    if (kp == 1) {
#pragma unroll
        for (int d = 0; d < 4; ++d)
#pragma unroll
            for (int i = 0; i < 16; ++i) ob[(d * 16 + i) * 64 + lane] = o[d][i];
        ob[64 * 64 + lane] = mrun; ob[65 * 64 + lane] = lrun;
    }
    __syncthreads();
    if (kp == 0) {
        const float m1 = ob[64 * 64 + lane], l1 = ob[65 * 64 + lane];
        const float mf = fmaxf(mrun, m1), a0 = __builtin_amdgcn_exp2f(mrun - mf), a1 = __builtin_amdgcn_exp2f(m1 - mf);
        const float inv = 1.0f / (lrun * a0 + l1 * a1);
        bf16* op = Og + (size_t)(32 * g + l32) * D + 4 * h;
#pragma unroll
        for (int d = 0; d < 4; ++d)
#pragma unroll
            for (int i4 = 0; i4 < 4; ++i4) {
                float r[4];
#pragma unroll
                for (int j = 0; j < 4; ++j) r[j] = (o[d][4 * i4 + j] * a0 + ob[(d * 16 + 4 * i4 + j) * 64 + lane] * a1) * inv;
                u32x2 wv; wv.x = pk2(r[0], r[1]); wv.y = pk2(r[2], r[3]);
                *(u32x2*)(op + d * 32 + 8 * i4) = wv;
            }
    }
    __syncthreads();
}
DI void ml_c_unit(Frame& F, int seq, int p) {
    const int b = seq >> 3, h = (seq >> 1) & 3, dir = seq & 1, tc = tc_of(dir, p), lane = F.lane, tid = F.tid;
    const bf16* P = WSP(bf16, WS_P);
    constexpr float QS = 0.08838834764831845f;
    LAS bf16* Qs = (LAS bf16*)F.lds;
    LAS bf16* Ksm = (LAS bf16*)(F.lds + 17408);
    LAS bf16* VT = (LAS bf16*)(F.lds + 34816);
    LAS bf16* Cx = (LAS bf16*)(F.lds + 55552);
    LAS bf16* SW = (LAS bf16*)(F.lds + 94720);
    LAS float* av = (LAS float*)(F.lds + 103936);
    LAS float* Mt = av + 64;
    LAS float* Bt = av + 128;
    LAS float* den = av + 192;
    const float m_p = WSP(float, WS_MLSC)[(size_t)(seq * 36 + p) * 4 + 2];
    if (F.wave == 0) {
        const int row = rowof(b, tc * 64 + lane);
        const float* gt = WSP(float, WS_GATES) + (size_t)row * 16;
        const float li = gt[dir * 4 + h], lf = gt[8 + dir * 4 + h];
        const float pre = wave_incl_scan(lf, lane), tot = lane_bcast(pre, 63);
        const float B = dir == 0 ? pre : (tot - pre) + lf;
        const float a = li - B;
        const float cm = dir == 0 ? wave_prefix_max(a, lane) : wave_suffix_max(a, lane);
        av[lane] = a; Mt[lane] = fmaxf(m_p, cm); Bt[lane] = B;
    }
    {
        u32x4 qv[2], kv[2]; unsigned vv[16]; u32x4 cx[5];
        const bf16* Sg = WSP(bf16, WS_MLS) + (size_t)(seq * 36 + p) * 16512;
#pragma unroll
        for (int it = 0; it < 2; ++it) { const int idx = tid + NTHR * it, n = idx >> 4, cc = idx & 15;
            const bf16* pr = P + (size_t)rowof(b, tc * 64 + n) * DINP + h * 128 + cc * 8; qv[it] = *(const u32x4*)(pr + PC_MLQ); kv[it] = *(const u32x4*)(pr + PC_MLK); }
#pragma unroll
        for (int it = 0; it < 16; ++it) { const int idx = tid + NTHR * it, n = idx >> 7, d = idx & 127; vv[it] = P[(size_t)rowof(b, tc * 64 + n) * DINP + PC_MLV + h * 128 + d]; }
#pragma unroll
        for (int it = 0; it < 5; ++it) { const int idx = tid + NTHR * it, rr = idx >> 4, cc = idx & 15; cx[it] = (idx < 144 * 16 && rr < 129) ? *(const u32x4*)(Sg + rr * 128 + cc * 8) : (u32x4){0u, 0u, 0u, 0u}; }
        PINV(qv[0]); PINV(qv[1]); PINV(kv[0]); PINV(kv[1]); PIN8(vv); PIN8(vv + 8); PINV(cx[0]); PINV(cx[1]); PINV(cx[2]); PINV(cx[3]); PINV(cx[4]);
#pragma unroll
        for (int it = 0; it < 2; ++it) { const int idx = tid + NTHR * it, n = idx >> 4, cc = idx & 15; *(LAS u32x4*)(Qs + n * 136 + cc * 8) = qv[it]; *(LAS u32x4*)(Ksm + n * 136 + cc * 8) = kv[it]; }
#pragma unroll
        for (int it = 0; it < 16; ++it) { const int idx = tid + NTHR * it, n = idx >> 7, d = idx & 127; VT[d * 72 + n] = (bf16)vv[it]; }
#pragma unroll
        for (int it = 0; it < 5; ++it) { const int idx = tid + NTHR * it, rr = idx >> 4, cc = idx & 15; if (idx < 144 * 16) *(LAS u32x4*)(Cx + rr * 136 + cc * 8) = cx[it]; }
    }
    for (int idx = tid; idx < 16 * 64; idx += NTHR) { const int rr = idx >> 6, n = idx & 63; VT[(128 + rr) * 72 + n] = rr == 0 ? (bf16)0x3f80 : (bf16)0; }
    __syncthreads();
    for (int id = F.wave; id < 16; id += 8) { const int tt = id >> 2, st = id & 3;
        const bool skip = dir == 0 ? st > tt : st < tt;
        f32x4 acc = (f32x4){0.f, 0.f, 0.f, 0.f};
        if (!skip) acc = mma16<128>(Qs + tt * 16 * 136, 136, Ksm + st * 16 * 136, 136, lane, acc);
        const int s = st * 16 + (lane & 15); const float as = av[s];
#pragma unroll
        for (int i = 0; i < 4; ++i) { const int t = tt * 16 + 4 * (lane >> 4) + i; const bool ok = !skip && (dir == 0 ? s <= t : s >= t);
            SW[t * 72 + s] = (bf16)f2bf(ok ? acc[i] * QS * __expf(as - Mt[t]) : 0.f); } }
    __syncthreads();
    const int tt = F.wave & 3, d0 = F.wave < 4 ? 0 : 5, nd = F.wave < 4 ? 5 : 4;
    f32x4 val[5];
#pragma unroll
    for (int k = 0; k < 5; ++k) { val[k] = (f32x4){0.f, 0.f, 0.f, 0.f};
        if (k < nd) { const int dt = d0 + k;
            const f32x4 a1 = mma16<64>(SW + tt * 16 * 72, 72, VT + dt * 16 * 72, 72, lane, (f32x4){0.f, 0.f, 0.f, 0.f});
            const f32x4 a2 = mma16<128>(Qs + tt * 16 * 136, 136, Cx + dt * 16 * 136, 136, lane, (f32x4){0.f, 0.f, 0.f, 0.f});
#pragma unroll
            for (int i = 0; i < 4; ++i) { const int t = tt * 16 + 4 * (lane >> 4) + i; val[k][i] = a1[i] + a2[i] * QS * __expf(m_p - Mt[t]); }
            if (dt == 8 && (lane & 15) == 0) {
#pragma unroll
                for (int i = 0; i < 4; ++i) den[tt * 16 + 4 * (lane >> 4) + i] = val[k][i]; } } }
    __syncthreads();
    float* H = WSP(float, WS_HML) + (size_t)dir * MTOK * 512;
#pragma unroll
    for (int k = 0; k < 5; ++k) { const int dt = d0 + k; if (k < nd && dt < 8) {
#pragma unroll
        for (int i = 0; i < 4; ++i) { const int t = tt * 16 + 4 * (lane >> 4) + i;
            const float dn = fmaxf(fabsf(den[t]), __expf(-(Bt[t] + Mt[t])));
            H[(size_t)rowof(b, tc * 64 + t) * 512 + h * 128 + dt * 16 + (lane & 15)] = val[k][i] / dn; } } }
    __syncthreads();
}

DI void ss_c_unit(Frame& F, int l, int sq, int p) {
    const int b = sq >> 4, h = (sq >> 1) & 7, dir = sq & 1, g = h >> 2, tc = tc_of(dir, p), lane = F.lane, tid = F.tid;
    const bf16* XBC = WSP(bf16, WS_XBC);
    LAS bf16* Cm = (LAS bf16*)F.lds;
    LAS bf16* Bm = (LAS bf16*)(F.lds + 17408);
    LAS bf16* XT = (LAS bf16*)(F.lds + 34816);
    LAS bf16* Sx = (LAS bf16*)(F.lds + 44032);
    LAS bf16* W = (LAS bf16*)(F.lds + 61440);
    LAS float* cum = (LAS float*)(F.lds + 70656);
    LAS float* dtv = cum + 64;
    if (F.wave == 0) {
        const int row = rowof(b, tc * 64 + lane);
        const float dt = WSP(float, WS_DT)[(size_t)row * 16 + dir * 8 + h];
        const float A = -__expf(F.in[15][l * 16 + dir * 8 + h]);
        const float a = dt * A, pre = wave_incl_scan(a, lane), tot = lane_bcast(pre, 63);
        cum[lane] = dir == 0 ? pre : (tot - pre) + a; dtv[lane] = dt;
    }
    {
        u32x4 bb[2], cc_[2], sx[2]; unsigned xx[8];
        const bf16* Sg = WSP(bf16, WS_SSS) + (size_t)(sq * 36 + p) * 8192;
#pragma unroll
        for (int it = 0; it < 2; ++it) { const int idx = tid + NTHR * it, n = idx >> 4, cc = idx & 15; const bf16* xr = XBC + (size_t)rowof(b, tc * 64 + n) * 1024;
            bb[it] = *(const u32x4*)(xr + 512 + g * 128 + cc * 8); cc_[it] = *(const u32x4*)(xr + 768 + g * 128 + cc * 8); sx[it] = *(const u32x4*)(Sg + n * 128 + cc * 8); }
#pragma unroll
        for (int it = 0; it < 8; ++it) { const int idx = tid + NTHR * it, n = idx >> 6, pp = idx & 63; xx[it] = XBC[(size_t)rowof(b, tc * 64 + n) * 1024 + h * 64 + pp]; }
        PINV(bb[0]); PINV(bb[1]); PINV(cc_[0]); PINV(cc_[1]); PINV(sx[0]); PINV(sx[1]); PIN8(xx);
#pragma unroll
        for (int it = 0; it < 2; ++it) { const int idx = tid + NTHR * it, n = idx >> 4, cc = idx & 15;
            *(LAS u32x4*)(Bm + n * 136 + cc * 8) = bb[it]; *(LAS u32x4*)(Cm + n * 136 + cc * 8) = cc_[it]; *(LAS u32x4*)(Sx + n * 136 + cc * 8) = sx[it]; }
#pragma unroll
        for (int it = 0; it < 8; ++it) { const int idx = tid + NTHR * it, n = idx >> 6, pp = idx & 63; XT[pp * 72 + n] = (bf16)xx[it]; }
    }
    __syncthreads();
    for (int id = F.wave; id < 16; id += 8) { const int tt = id >> 2, st = id & 3;
        const bool skip = dir == 0 ? st > tt : st < tt;
        f32x4 acc = (f32x4){0.f, 0.f, 0.f, 0.f};
        if (!skip) acc = mma16<128>(Cm + tt * 16 * 136, 136, Bm + st * 16 * 136, 136, lane, acc);
        const int s = st * 16 + (lane & 15); const float cs = cum[s], ds = dtv[s];
#pragma unroll
        for (int i = 0; i < 4; ++i) { const int t = tt * 16 + 4 * (lane >> 4) + i; const bool ok = !skip && (dir == 0 ? s <= t : s >= t);
            W[t * 72 + s] = (bf16)f2bf(ok ? acc[i] * __expf(cum[t] - cs) * ds : 0.f); } }
    __syncthreads();
    float* Y = WSP(float, WS_YSS) + (size_t)dir * MTOK * 512;
    for (int id = F.wave; id < 16; id += 8) { const int tt = id >> 2, pt = id & 3;
        const f32x4 a1 = mma16<64>(W + tt * 16 * 72, 72, XT + pt * 16 * 72, 72, lane, (f32x4){0.f, 0.f, 0.f, 0.f});
        const f32x4 a2 = mma16<128>(Cm + tt * 16 * 136, 136, Sx + pt * 16 * 136, 136, lane, (f32x4){0.f, 0.f, 0.f, 0.f});
#pragma unroll
        for (int i = 0; i < 4; ++i) { const int t = tt * 16 + 4 * (lane >> 4) + i;
            Y[(size_t)rowof(b, tc * 64 + t) * 512 + h * 64 + pt * 16 + (lane & 15)] = a1[i] + a2[i] * __expf(cum[t]); } }
    __syncthreads();
}

DI void m5_finish_phase(Frame& F, int l, int nrows) {
    const int gw = F.bid * NWAVES + F.wave, NGW = F.G * NWAVES, lane = F.lane;
    const bf16* P = WSP(bf16, WS_P); const float* H0 = WSP(float, WS_HML); const float* H1 = H0 + (size_t)MTOK * 512;
    const float* Y0 = WSP(float, WS_YSS); const float* Y1 = Y0 + (size_t)MTOK * 512; const bf16* XBC = WSP(bf16, WS_XBC);
    bf16* A2 = WSP(bf16, WS_A2);
    float gn[8], sn[8], dsk[8];
#pragma unroll
    for (int u = 0; u < 8; ++u) { gn[u] = F.in[11][l * 512 + lane + 64 * u]; sn[u] = F.in[17][l * 512 + lane + 64 * u]; dsk[u] = F.in[16][l * 8 + u]; }
    for (int row = gw; row < nrows; row += NGW) {
        const bf16* p = P + (size_t)row * DINP;
        float h0[8], h1[8], y0[8], y1[8], hv[8], ov[8], yv[8], zv[8]; unsigned ow[8], zw[8], xw[8];
#pragma unroll
        for (int u = 0; u < 8; ++u) { const int c = lane + 64 * u;
            h0[u] = H0[(size_t)row * 512 + c]; h1[u] = H1[(size_t)row * 512 + c]; y0[u] = Y0[(size_t)row * 512 + c]; y1[u] = Y1[(size_t)row * 512 + c];
            ow[u] = p[PC_MLO + c]; zw[u] = p[PC_Z + c]; xw[u] = XBC[(size_t)row * 1024 + c]; }
        PIN8(h0); PIN8(h1); PIN8(y0); PIN8(y1); PIN8(ow); PIN8(zw); PIN8(xw);
        bf16 xv[8];
#pragma unroll
        for (int u = 0; u < 8; ++u) { hv[u] = h0[u] + h1[u]; yv[u] = y0[u] + y1[u]; ov[u] = bf2f(ow[u]); zv[u] = bf2f(zw[u]); xv[u] = (bf16)xw[u]; }
#pragma unroll
        for (int h = 0; h < 4; ++h) {
            const float v0 = hv[2 * h], v1 = hv[2 * h + 1]; const int c0 = h * 128 + lane, c1 = c0 + 64;
            const float rstd = 1.0f / sqrtf(wave_sum(v0 * v0 + v1 * v1) * (1.f / 128.f) + EPS);
            A2[(size_t)row * D + c0] = (bf16)f2bf(v0 * rstd * gn[2 * h] * sigmoidf_(ov[2 * h]));
            A2[(size_t)row * D + c1] = (bf16)f2bf(v1 * rstd * gn[2 * h + 1] * sigmoidf_(ov[2 * h + 1]));
        }
        float y[8]; float ss = 0.f;
#pragma unroll
        for (int u = 0; u < 8; ++u) { float v = yv[u] + dsk[u] * bf2f(xv[u]); v *= siluf(zv[u]); y[u] = v; ss += v * v; }
        const float rstd = 1.0f / sqrtf(wave_sum(ss) * (1.f / 512.f) + EPS);
#pragma unroll
        for (int u = 0; u < 8; ++u) { const int c = lane + 64 * u; A2[(size_t)row * D + 512 + c] = (bf16)f2bf(y[u] * rstd * sn[u]); }
    }
}
#ifndef PROBE_MASK
#define PROBE_MASK 0ull
#endif
#define NREP(k) ((((unsigned long long)(PROBE_MASK) >> (k)) & 1ull) ? 2 : 1)
#ifndef UNIT_REP
#define UNIT_REP 0
#endif
#define UREP(i) for (int rp_ = 0; rp_ <= ((F.rep >> (i)) & 1); ++rp_)
#ifndef ONE_LAUNCH
#define ONE_LAUNCH 1
#endif
#ifndef TPROBE_MASK
#define TPROBE_MASK 0ull
#endif
#ifndef TPROBE_AMP
#define TPROBE_AMP 8
#endif
#define TPB(k) do { if (((unsigned long long)(TPROBE_MASK) >> (k)) & 1ull) { if (F.bid == 0 && F.tid == 0) { volatile LAS unsigned long long* tp_ = (volatile LAS unsigned long long*)(F.lds + MISC_OFF + 128); tp_[0] = wall_clock64(); } } } while (0)
#define TPE(k) do { if (((unsigned long long)(TPROBE_MASK) >> (k)) & 1ull) { if (F.bid == 0 && F.tid == 0) { volatile LAS unsigned long long* tp_ = (volatile LAS unsigned long long*)(F.lds + MISC_OFF + 128); tp_[1] += wall_clock64() - tp_[0]; } } } while (0)
#define IN(k) (lo <= (k) && (k) < hi)
#define SEAM(k) do { if (ONE_LAUNCH && hi > (k) + 1) xcd_barrier(bar); } while (0)
#ifndef FILL_MASK
#define FILL_MASK 0x7fffffffull
#endif
#define FILL(k, work) do { if (ONE_LAUNCH) conv_fill(F, (k), (work)); } while (0)
#define FILL1(k, work) do { if (ONE_LAUNCH) conv_fill(F, (k), (work), 1); } while (0)
#ifndef NCV_M1
#define NCV_M1 0
#define NCV_M2 0
#endif
#ifndef NCV_P
#define NCV_P 48
#define NCV_OUT 112
#define NCV_UP 24
#define NCV_DOWN 112
#endif
template <int l> DI void layer_phases(Frame& F, const XcdBarrier& bar, const int lo, const int hi) {
    LAS int* mtb = (LAS int*)(F.lds + RING_BYTES);
        const int pb = 1 + 16 * l;
        const bool wc = (l == 0);
        const int nrows = wc ? MTOK : MLAT;
        const float* modl = WSP(float, WS_MOD) + (size_t)l * 5 * D6;
        if (IN(pb + 0)) { TPB(pb + 0);
            if (l == 0) norm_phase<false>(F, l, F.in[0], F.in[2], F.in[6] + l * D, 0, MTOK);
            else norm_phase<false>(F, l, WSP(float, WS_X), WSP(float, WS_X) + (size_t)MLAT * D, F.in[6] + l * D, 0, MTOK);
            if (l == 1) conv_drain(F, CV_NQ1 - CV_EAGER); SEAM(pb + 0); TPE(pb + 0);
        }
        if (IN(pb + 1)) { TPB(pb + 1);
            const int ncv = ONE_LAUNCH ? NCV_P : 0, gw_ = F.G - ncv;
            if (F.bid < gw_) { pg8::Gemm g{WSP(bf16, WS_HN), WSP(bf16, WS_WIN) + (size_t)l * DINP * D, D, D}; pg8::StaticOrder S; S.init(MTOK / 256, DINP / 256, gw_, F.bid);
                EpiP E{WSP(bf16, WS_P), WSP(float, WS_GRAW)};
                pg8::gemm_phase<EpiP, pg8::StaticOrder>(F.lds, g, S, E); }
            FILL(pb + 1, F.bid >= gw_);
            SEAM(pb + 1); TPE(pb + 1);
        }
        if (IN(pb + 2)) { TPB(pb + 2);
            { const int ncv = ONE_LAUNCH ? NCV_M1 : 0, gw_ = F.G - ncv;
              if (F.bid < gw_) for (int u = F.bid; u < NB * 72; u += gw_) m1_prep_unit(F, l, u / 72, u % 72);
              if (ncv) FILL1(pb + 2, F.bid >= gw_); }
            SEAM(pb + 2); TPE(pb + 2);
        }
        if (IN(pb + 3)) { TPB(pb + 3);
            { const int ncv = ONE_LAUNCH ? NCV_M2 : 0, gw_ = F.G - ncv;
              if (F.bid < gw_) {
                { pg8::Gemm g{WSP(bf16, WS_CQN), WSP(bf16, WS_WQB) + (size_t)l * 768 * 512, 512, 512}; pg8::StaticOrder S; S.init(MTOK / 256, 3, gw_, F.bid);
                  EpiBf16 E{WSP(bf16, WS_QRAW), 768}; pg8::gemm_phase<EpiBf16, pg8::StaticOrder>(F.lds, g, S, E); }
                __syncthreads();
                { pg8::Gemm g{WSP(bf16, WS_CKVN), WSP(bf16, WS_WKVB) + (size_t)l * 1024 * 256, 256, 256}; pg8::StaticOrder S; S.init(MTOK / 256, 4, gw_, (F.bid + 128) % gw_);
                  EpiBf16 E{WSP(bf16, WS_KVRAW), 1024}; pg8::gemm_phase<EpiBf16, pg8::StaticOrder>(F.lds, g, S, E); }
                __syncthreads();
                UREP(2) for (int u = F.bid; u < 1152; u += gw_) ml_a_unit(F, u / 36, u % 36);
                UREP(3) for (int v = (F.bid + 128) % gw_; v < 576; v += gw_) ss_a_unit(F, l, v / 144, (v / 72) & 1, (v % 72) >> 1, v & 1);
              }
              if (ncv) FILL1(pb + 3, F.bid >= gw_); }
            SEAM(pb + 3); TPE(pb + 3);
        }
        if (IN(pb + 4)) { TPB(pb + 4);
            UREP(4) for (int u = F.bid; u < 256; u += F.G) {
                const int bh = u >> 4, qb = u & 15, b = bh >> 2, h = bh & 3;
                const int r0a = 2 * qb - 4 < 0 ? 0 : (2 * qb - 4 > 24 ? 24 : 2 * qb - 4), r0b = 2 * qb - 3 < 0 ? 0 : (2 * qb - 3 > 24 ? 24 : 2 * qb - 3);
                attn_unit2<128, true>(F, WSP(bf16, WS_QNA) + ((size_t)bh * TS + qb * 128) * 128, WSP(bf16, WS_KNA) + (size_t)bh * TS * 128, WSP(bf16, WS_VTNA) + (size_t)bh * 128 * TS,
                                     4, 32, r0b + 8 - r0a, r0a, 0.12751743082459868f,
                                     WSP(bf16, WS_A2) + (size_t)(b * TL + qb * 128) * D + 1536 + h * 128, 2 * qb, F.in[26] + (size_t)(l * 4 + h) * 15 * 31);
            }
            if (wc) UREP(5) for (int v = F.bid; v < 32; v += F.G) {
                const int bh2 = v >> 1, qc = v & 1, b2 = bh2 >> 2, h2 = bh2 & 3;
                attn_unit2<128, false>(F, WSP(bf16, WS_QNA) + ((size_t)bh2 * TS + TL + qc * 128) * 128, WSP(bf16, WS_KNA) + (size_t)bh2 * TS * 128, WSP(bf16, WS_VTNA) + (size_t)bh2 * 128 * TS,
                                      4, 32, 0, 0, 0.12751743082459868f, WSP(bf16, WS_A2) + (size_t)(MLAT + b2 * TC + qc * 128) * D + 1536 + h2 * 128, 0, nullptr);
            }
            UREP(6) for (int v = (F.bid + 32) % F.G; v < 128; v += F.G) ml_scan_unit(F, v >> 2, v & 3);
            UREP(7) for (int v = (F.bid + 96) % F.G; v < 128; v += F.G) ss_scan_unit(F, v >> 1, v & 1);
            UREP(8) for (int v = F.bid; v < 288; v += F.G) mla_post_unit(F, l, v / 72, v % 72);
            SEAM(pb + 4); TPE(pb + 4);
        }
        if (IN(pb + 5)) { TPB(pb + 5);
            const int p0 = wc ? 0 : 4, npp = 36 - p0;
            UREP(9) for (int u = F.bid; u < 256; u += F.G) { const int bh = u >> 4, qb = u & 15, b = bh >> 2, h = bh & 3;
                attn_unit2<192, false>(F, WSP(bf16, WS_QMLA) + ((size_t)bh * TS + qb * 128) * 192, WSP(bf16, WS_KMLA) + (size_t)bh * TS * 192, WSP(bf16, WS_VTMLA) + (size_t)bh * 128 * TS,
                                      36, 0, 0, 0, 0.10411754627862817f, WSP(bf16, WS_A2) + (size_t)(b * TL + qb * 128) * D + 1024 + h * 128, 0, nullptr); }
            if (wc) UREP(10) for (int v = F.bid; v < 32; v += F.G) { const int bh = v >> 1, qc = v & 1, b = bh >> 2, h = bh & 3;
                attn_unit2<192, false>(F, WSP(bf16, WS_QMLA) + ((size_t)bh * TS + TL + qc * 128) * 192, WSP(bf16, WS_KMLA) + (size_t)bh * TS * 192, WSP(bf16, WS_VTMLA) + (size_t)bh * 128 * TS,
                                      4, 32, 0, 0, 0.10411754627862817f, WSP(bf16, WS_A2) + (size_t)(MLAT + b * TC + qc * 128) * D + 1024 + h * 128, 0, nullptr); }
            UREP(11) for (int v = (F.bid + 32) % F.G; v < 32 * npp; v += F.G) ml_c_unit(F, v / npp, p0 + v % npp);
            UREP(12) for (int v = (F.bid + 160) % F.G; v < 64 * npp; v += F.G) ss_c_unit(F, l, v / npp, p0 + v % npp);
            SEAM(pb + 5); TPE(pb + 5);
        }
        if (IN(pb + 6)) { TPB(pb + 6); m5_finish_phase(F, l, nrows); SEAM(pb + 6); TPE(pb + 6); }
        if (IN(pb + 7)) { TPB(pb + 7);
            const int ncv = (ONE_LAUNCH && l == 0) ? NCV_OUT : 0, gw_ = F.G - ncv;
            if (F.bid < gw_) { pg8::Gemm g{WSP(bf16, WS_A2), WSP(bf16, WS_WOUT) + (size_t)l * D * D, D, D}; pg8::StaticOrder S; S.init(nrows / 256, D / 256, gw_, F.bid);
                EpiResid E{l == 0 ? F.in[0] : WSP(float, WS_X), l == 0 ? F.in[2] : WSP(float, WS_X) + (size_t)MLAT * D, WSP(float, WS_X), modl + 2 * D};
                pg8::gemm_phase<EpiResid, pg8::StaticOrder>(F.lds, g, S, E); }
            FILL(pb + 7, F.bid >= gw_);
            SEAM(pb + 7); TPE(pb + 7);
        }
        if (IN(pb + 8)) { TPB(pb + 8);
            if (l == 0) { norm_phase<false>(F, l, WSP(float, WS_X), WSP(float, WS_X) + (size_t)MLAT * D, F.in[27] + l * D, 3 * D, nrows); conv_drain(F, CV_NE - CV_EAGER); }
            else { norm_phase<true>(F, l, WSP(float, WS_X), WSP(float, WS_X) + (size_t)MLAT * D, F.in[27] + l * D, 3 * D, nrows); conv_drain(F, CV_NDEF); }
            SEAM(pb + 8); TPE(pb + 8);
        }
        if (l == 0) {
            if (IN(pb + 10)) { TPB(pb + 10);
                const int ncv = ONE_LAUNCH ? NCV_UP : 0, gw_ = F.G - ncv;
                if (F.bid < gw_) { pg8::Gemm g{WSP(bf16, WS_HN), WSP(bf16, WS_W13), D, D}; pg8::StaticOrder S; S.init(MTOK / 256, 2 * FF / 256, gw_, F.bid);
                    EpiSwiglu E{WSP(bf16, WS_G), FF}; pg8::gemm_phase<EpiSwiglu, pg8::StaticOrder>(F.lds, g, S, E); }
                FILL(pb + 10, F.bid >= gw_);
                SEAM(pb + 10); TPE(pb + 10);
            }
            if (IN(pb + 11)) { TPB(pb + 11);
                const int ncv = ONE_LAUNCH ? NCV_DOWN : 0, gw_ = F.G - ncv;
                if (F.bid < gw_) { pg8::Gemm g{WSP(bf16, WS_G), WSP(bf16, WS_W2), FF, FF}; pg8::StaticOrder S; S.init(MTOK / 256, D / 256, gw_, F.bid);
                    EpiResid E{WSP(float, WS_X), WSP(float, WS_X) + (size_t)MLAT * D, WSP(float, WS_X), modl + 5 * D};
                    pg8::gemm_phase<EpiResid, pg8::StaticOrder>(F.lds, g, S, E); }
                FILL(pb + 11, F.bid >= gw_);
                SEAM(pb + 11); TPE(pb + 11);
            }
        } else {
            if (IN(pb + 10)) { TPB(pb + 10);
                __syncthreads(); moe_tables(F, mtb, 2 * FE / 256);
                pg8::Gemm g{WSP(bf16, WS_XG), WSP(bf16, WS_MW13), D, D}; MoeOrder S{mtb, 2 * FE / 256, F.G, F.bid, 0, mtb[40], 1, 0, MLAT / 256};
                EpiSwiglu E{WSP(bf16, WS_G), FE}; pg8::gemm_phase<EpiSwiglu, MoeOrder>(F.lds, g, S, E);
                SEAM(pb + 10); TPE(pb + 10);
            }
            if (IN(pb + 11)) { TPB(pb + 11);
                __syncthreads(); moe_tables(F, mtb, D / 256);
                const int nun = mtb[40], nfull0 = (nun / F.G) * F.G, nt0 = nun - nfull0;
                const int SK = nt0 == 0 ? 1 : (nt0 <= 32 ? 8 : (nt0 <= 64 ? 4 : (nt0 <= 128 ? 2 : 1)));
                const int nfull = SK == 1 ? nun : nfull0, ntail = nun - nfull;
                { pg8::Gemm g{WSP(bf16, WS_G), WSP(bf16, WS_MW2), FE, FE}; MoeOrder S{mtb, D / 256, F.G, F.bid, 0, nfull, 1, 0, 0};
                  EpiF32 E{WSP(float, WS_Y), D}; pg8::gemm_phase<EpiF32, MoeOrder>(F.lds, g, S, E); }
                if (ntail > 0) { __syncthreads();
                  pg8::Gemm g{WSP(bf16, WS_G), WSP(bf16, WS_MW2), FE / SK, FE}; MoeOrder S{mtb, D / 256, F.G, F.bid, nfull, ntail * SK, SK, FE / SK, 0};
                  EpiPart E{WSP(float, WS_PART)}; pg8::gemm_phase<EpiPart, MoeOrder>(F.lds, g, S, E); }
                SEAM(pb + 11); TPE(pb + 11);
            }
            if (IN(pb + 12)) { TPB(pb + 12);
                __syncthreads(); moe_tables(F, mtb, D / 256);
                const int nun = mtb[40], nfull0 = (nun / F.G) * F.G, nt0 = nun - nfull0;
                const int SK = nt0 == 0 ? 1 : (nt0 <= 32 ? 8 : (nt0 <= 64 ? 4 : (nt0 <= 128 ? 2 : 1)));
                const int nfull = SK == 1 ? nun : nfull0, ntail = nun - nfull;
                for (int it = F.bid; it < ntail * 8; it += F.G) { const int t = it >> 3, cg = it & 7;
                    MoeOrder S{mtb, D / 256, 1, 0, nfull + t, 1, 1, 0, 0}; pg8::Unit u; S.next(0, u);
                    if (SK == 8) splitk_reduce_f32<8>(WSP(float, WS_PART), t, cg, u, WSP(float, WS_Y), D);
                    else if (SK == 4) splitk_reduce_f32<4>(WSP(float, WS_PART), t, cg, u, WSP(float, WS_Y), D);
                    else splitk_reduce_f32<2>(WSP(float, WS_PART), t, cg, u, WSP(float, WS_Y), D); }
                SEAM(pb + 12); TPE(pb + 12);
            }
            if (IN(pb + 13)) { TPB(pb + 13); moe_combine_phase(F, l); __syncthreads(); TPE(pb + 13); }
        }
}
__global__ void __launch_bounds__(NTHR, 2) fwd_kernel(Args args) {
    extern __shared__ __attribute__((aligned(16))) unsigned char lds[];
    Frame F;
    F.lds = (LAS unsigned char*)lds; F.ws = args.ws; F.out = args.out;
#pragma unroll
    for (int i = 0; i < 35; ++i) F.in[i] = args.in[i];
    F.tid = threadIdx.x; F.lane = F.tid & 63; F.wave = __builtin_amdgcn_readfirstlane(F.tid >> 6); F.G = gridDim.x; F.bid = blockIdx.x; F.rep = args.rep;
    volatile LAS unsigned* MISC = (volatile LAS unsigned*)(F.lds + MISC_OFF);
    if (F.tid < 64) MISC[F.tid] = 0u;
    __syncthreads();
    XcdBarrier bar; bar.bar = WSP(unsigned, WS_CTL) + CW_BAR; bar.x = 0; bar.st = nullptr;
    if (ONE_LAUNCH) bar = xcd_barrier_post(WSP(unsigned, WS_CTL) + CW_BAR, MISC + 8);
    const int lo = args.ph_lo, hi = args.ph_hi;

    if (IN(0)) { TPB(0); p0_prologue(F); SEAM(0); TPE(0); }

    layer_phases<0>(F, bar, lo, hi);
    layer_phases<1>(F, bar, lo, hi);
    if (TPROBE_MASK != 0ull && F.bid == 0 && F.tid == 0) { volatile LAS unsigned long long* tp_ = (volatile LAS unsigned long long*)(F.lds + MISC_OFF + 128);
        const unsigned long long t0 = wall_clock64(), dur = tp_[1] * TPROBE_AMP; while (wall_clock64() - t0 < dur) __builtin_amdgcn_s_sleep(8); }
#undef IN
#undef SEAM
}

extern "C" void kernel_launch(void* const* d_in, const int* in_sizes, int n_in, void* d_out, int out_size, void* d_ws, size_t ws_size, hipStream_t stream) {
    static int grid = 0;
    if (grid == 0) {
        if (n_in != 35 || out_size != MLAT * D || ws_size < WS_END) { fprintf(stderr, "kernel_launch: unexpected shapes (n_in %d out %d ws %zu need %zu)\n", n_in, out_size, ws_size, (size_t)WS_END); grid = -1; return; }
        int dev = 0, cus = 0, per_cu = 0;
        if (hipGetDevice(&dev) != hipSuccess || hipDeviceGetAttribute(&cus, hipDeviceAttributeMultiprocessorCount, dev) != hipSuccess) { grid = -1; return; }
        if (hipFuncSetAttribute((const void*)fwd_kernel, hipFuncAttributeMaxDynamicSharedMemorySize, LDS_BYTES) != hipSuccess) { fprintf(stderr, "kernel_launch: hipFuncSetAttribute failed\n"); grid = -1; return; }
        if (hipOccupancyMaxActiveBlocksPerMultiprocessor(&per_cu, (const void*)fwd_kernel, NTHR, LDS_BYTES) != hipSuccess || per_cu < 1) { fprintf(stderr, "kernel_launch: occupancy query says %d\n", per_cu); }
        (void)hipGetLastError();
        grid = cus;
    }
    if (grid < 0) return;
    (void)hipMemsetAsync((char*)d_ws + WS_CTL, 0, CTL_ZERO_BYTES, stream);
    Args a{};
    for (int i = 0; i < 35; ++i) a.in[i] = (const float*)d_in[i];
    a.out = (float*)d_out; a.ws = (unsigned char*)d_ws; a.rep = UNIT_REP;
#if ONE_LAUNCH
    a.ph_lo = 0; a.ph_hi = 64;
    hipLaunchKernelGGL(fwd_kernel, dim3(grid), dim3(NTHR), LDS_BYTES, stream, a);
#else
    static const int phases[] = {0, 1, 2, 3, 4, 5, 6, 7, 8, 9, 11, 12, 17, 18, 19, 20, 21, 22, 23, 24, 25, 27, 28, 29, 30};
    for (int k = 0; k < (int)(sizeof(phases) / sizeof(phases[0])); ++k) {
        a.ph_lo = phases[k]; a.ph_hi = phases[k] + 1;
        for (int rp = 0; rp < NREP(phases[k]); ++rp) hipLaunchKernelGGL(fwd_kernel, dim3(grid), dim3(NTHR), LDS_BYTES, stream, a);
    }
#endif
}
```

```cpp
#define NCV_P 48
#define NCV_OUT 112
#define NCV_UP 24
#define NCV_DOWN 112
#define FILL_MASK 0x7fffffffull
#define PROBE_MASK (0ull)
#define ONE_LAUNCH 1
#define UNIT_REP 0
#include <hip/hip_runtime.h>
#include <cstdio>
#include <cstdint>

#define DI __device__ __forceinline__
#define LAS __attribute__((address_space(3)))
#define GAS __attribute__((address_space(1)))
typedef unsigned short bf16;
typedef short bf16x8 __attribute__((ext_vector_type(8)));
typedef float f32x4 __attribute__((ext_vector_type(4)));
typedef float f32x2 __attribute__((ext_vector_type(2)));
typedef unsigned u32x4 __attribute__((ext_vector_type(4)));
typedef unsigned u32x2 __attribute__((ext_vector_type(2)));

namespace pg8 {
constexpr int BM = 256, BK = 64, HALF = 128, HTB = HALF * BK * 2, STAGE_BYTES = 8 * HTB, NXCD = 8, WGM = 8;
__host__ __device__ __forceinline__ int lds_byte(int r, int c) { const int st = (r >> 4) * 2 + (c >> 5), rr = r & 15, cc = c & 31, ob = rr * 64 + cc * 2; return st * 1024 + (ob ^ (((ob >> 9) & 1) << 5)); }
__host__ __device__ __forceinline__ void stage_rc(int b, int& R, int& C) { const int st = b / 1024, sb = b % 1024, swz = sb ^ (((sb >> 9) & 1) << 5); R = (st >> 1) * 16 + swz / 64; C = (st & 1) * 32 + (swz % 64) / 2; }
__host__ __device__ __forceinline__ int perm32(int rho) { const int n = rho >> 4, i = rho & 15; return 8 * (i >> 2) + 4 * n + (i & 3); }

struct Unit { int pm, pn, pb, koff, aux, pa; };
struct Gemm { const bf16* A; const bf16* Bt; int K, ld; };

DI int xcd_remap(int L, int nwg) { const int q = nwg / NXCD, r = nwg % NXCD, xcd = L % NXCD, off = L / NXCD; return (xcd < r ? xcd * (q + 1) : r * (q + 1) + (xcd - r) * q) + off; }

struct StaticOrder {
    int nM, nN, nwg, G, c;
    DI void init(int nM_, int nN_, int G_, int c_) { nM = nM_; nN = nN_; nwg = nM * nN; G = G_; c = c_; }
    DI bool next(int i, Unit& u) const {
        const long L = (long)i * G + c; if (L >= nwg) return false;
        const int wgid = xcd_remap((int)L, nwg);
        const int nig = WGM * nN, gid = wgid / nig, fm = gid * WGM, gsz = (nM - fm) < WGM ? (nM - fm) : WGM;
        u.pm = fm + ((wgid % nig) % gsz); u.pn = (wgid % nig) / gsz; u.pb = u.pn; u.koff = 0; u.aux = 0; u.pa = u.pm; return true;
    }
};

DI unsigned cvt_pk_bf16(float lo, float hi) { unsigned r; asm volatile("v_cvt_pk_bf16_f32 %0, %1, %2" : "=v"(r) : "v"(lo), "v"(hi)); return r; }

template <class Epi, class Sched, bool ALIGN_EPI = true>
DI void gemm_phase(LAS unsigned char* lds, const Gemm g, const Sched& S, const Epi& E) {
    const int tid = threadIdx.x, wid = __builtin_amdgcn_readfirstlane(tid >> 6), lane = tid & 63, wr = wid >> 2, wc = wid & 3, fr = lane & 15, fq = lane >> 4;
    const int K = g.K, nt = K / BK;
    unsigned voffA[2], voffB[2];
#pragma unroll
    for (int i = 0; i < 2; ++i) { int R, C; stage_rc(tid * 16 + i * 8192, R, C); const int Rb = Epi::PERM ? ((R & ~31) + perm32(R & 31)) : R;
        voffA[i] = (unsigned)(R * g.ld + C) * 2u; voffB[i] = (unsigned)(Rb * g.ld + C) * 2u; }
    const size_t kstep = (size_t)(BK * 2);
    const size_t hstep = (size_t)HALF * g.ld * 2;
    const size_t tstep = 2 * hstep;
    const unsigned ldsw = (unsigned)wid * 1024u;
    const int aoff = lds_byte(wr * 64 + fr, fq * 8), boff = lds_byte(wc * 32 + fr, fq * 8);
#define PG8_SA(b, h) (((b) * 2 + (h)) * HTB)
#define PG8_SB(b, h) ((4 + (b) * 2 + (h)) * HTB)
#define PG8_STAGE(bufoff, gbase, voff) do { _Pragma("unroll") for (int _i = 0; _i < 2; ++_i) \
        __builtin_amdgcn_global_load_lds((const unsigned*)((const char*)(gbase) + (voff)[_i]), (LAS unsigned*)(lds + (bufoff) + ldsw + _i * 8192), 16, 0, 0); } while (0)
#define PG8_LDA(dst, b, h) do { _Pragma("unroll") for (int m = 0; m < 4; ++m) _Pragma("unroll") for (int k = 0; k < 2; ++k) dst[m][k] = *(const LAS bf16x8*)(lds + PG8_SA(b, h) + aoff + m * 2048 + k * 1024); } while (0)
#define PG8_LDB(dst, b, h) do { _Pragma("unroll") for (int n = 0; n < 2; ++n) _Pragma("unroll") for (int k = 0; k < 2; ++k) dst[n][k] = *(const LAS bf16x8*)(lds + PG8_SB(b, h) + boff + n * 2048 + k * 1024); } while (0)
#define PG8_MMA(ai, bj, At, Bt) do { __builtin_amdgcn_s_setprio(1); _Pragma("unroll") for (int m = 0; m < 4; ++m) _Pragma("unroll") for (int n = 0; n < 2; ++n) _Pragma("unroll") for (int k = 0; k < 2; ++k) \
        acc[ai][bj][m][n] = __builtin_amdgcn_mfma_f32_16x16x32_bf16(Bt[n][k], At[m][k], acc[ai][bj][m][n], 0, 0, 0); __builtin_amdgcn_s_setprio(0); } while (0)
#define PG8_WAIT_V(n) asm volatile("s_waitcnt vmcnt(" #n ")" ::: "memory")
#define PG8_WAIT_L(n) asm volatile("s_waitcnt lgkmcnt(" #n ")" ::: "memory")
#define PG8_BAR __builtin_amdgcn_s_barrier()
#define PG8_SCHED __builtin_amdgcn_sched_barrier(0)
    Unit cur, nxt; int ui = 0;
    if (!S.next(0, cur)) return;
    f32x4 acc[2][2][4][2];
#pragma unroll
    for (int a = 0; a < 2; ++a)
#pragma unroll
        for (int b = 0; b < 2; ++b)
#pragma unroll
            for (int m = 0; m < 4; ++m)
#pragma unroll
                for (int n = 0; n < 2; ++n) acc[a][b][m][n] = (f32x4){0.f, 0.f, 0.f, 0.f};
    bf16x8 At[4][2], B0[2][2], B1[2][2];
    const char* cA = (const char*)g.A + (size_t)cur.pa * tstep + (size_t)cur.koff * 2; const char* cB = (const char*)g.Bt + (size_t)cur.pb * tstep + (size_t)cur.koff * 2;
    {
        PG8_STAGE(PG8_SB(0, 0), cB, voffB); PG8_STAGE(PG8_SB(0, 1), cB + hstep, voffB); PG8_STAGE(PG8_SA(0, 0), cA, voffA); PG8_STAGE(PG8_SA(0, 1), cA + hstep, voffA);
        if (wr == 1) PG8_BAR;
        PG8_WAIT_V(2); PG8_BAR;
        PG8_STAGE(PG8_SB(1, 0), cB + kstep, voffB); PG8_STAGE(PG8_SA(1, 0), cA + kstep, voffA); PG8_STAGE(PG8_SB(1, 1), cB + hstep + kstep, voffB);
        PG8_WAIT_V(6); PG8_BAR;
    }
    for (;;) {
        const bool has_next = S.next(ui + 1, nxt);
        const char* nA = has_next ? (const char*)g.A + (size_t)nxt.pa * tstep + (size_t)nxt.koff * 2 : cA; const char* nB = has_next ? (const char*)g.Bt + (size_t)nxt.pb * tstep + (size_t)nxt.koff * 2 : cB;
        for (int t = 0; t < nt; t += 2) {
            const bool last = (t == nt - 2);
            const char* a1 = cA + (size_t)(t + 1) * kstep;
            const char* a2 = last ? nA : cA + (size_t)(t + 2) * kstep; const char* b2 = last ? nB : cB + (size_t)(t + 2) * kstep;
            const char* a3 = a2 + kstep; const char* b3 = b2 + kstep;
            PG8_LDB(B0, 0, 0); PG8_LDB(B1, 0, 1); PG8_SCHED; PG8_LDA(At, 0, 0); PG8_STAGE(PG8_SA(1, 1), a1 + hstep, voffA);
            PG8_WAIT_V(8); PG8_WAIT_L(0); PG8_BAR; PG8_MMA(0, 0, At, B0); PG8_MMA(0, 1, At, B1); PG8_BAR; PG8_SCHED;
            PG8_LDA(At, 0, 1); PG8_STAGE(PG8_SB(0, 0), b2, voffB); PG8_STAGE(PG8_SB(0, 1), b2 + hstep, voffB); PG8_STAGE(PG8_SA(0, 0), a2, voffA);
            PG8_WAIT_V(8); PG8_WAIT_L(0); PG8_BAR; PG8_MMA(1, 0, At, B0); PG8_MMA(1, 1, At, B1); PG8_BAR; PG8_SCHED;
            PG8_LDB(B0, 1, 0); PG8_LDB(B1, 1, 1); PG8_SCHED; PG8_LDA(At, 1, 0); PG8_STAGE(PG8_SA(0, 1), a2 + hstep, voffA);
            PG8_WAIT_V(8); PG8_WAIT_L(0); PG8_BAR; PG8_MMA(0, 0, At, B0); PG8_MMA(0, 1, At, B1); PG8_BAR; PG8_SCHED;
            PG8_LDA(At, 1, 1); PG8_STAGE(PG8_SB(1, 0), b3, voffB); PG8_STAGE(PG8_SB(1, 1), b3 + hstep, voffB); PG8_STAGE(PG8_SA(1, 0), a3, voffA);
            PG8_WAIT_V(8); PG8_WAIT_L(0); PG8_BAR; PG8_MMA(1, 0, At, B0); PG8_MMA(1, 1, At, B1); PG8_BAR; PG8_SCHED;
        }
        if constexpr (ALIGN_EPI) { if (wr == 0) PG8_BAR; }
        E(acc, cur, wr, wc, fr, fq);
        if (!has_next) break;
#pragma unroll
        for (int a = 0; a < 2; ++a)
#pragma unroll
            for (int b = 0; b < 2; ++b)
#pragma unroll
                for (int m = 0; m < 4; ++m)
#pragma unroll
                    for (int n = 0; n < 2; ++n) acc[a][b][m][n] = (f32x4){0.f, 0.f, 0.f, 0.f};
        cur = nxt; cA = nA; cB = nB; ++ui;
        if constexpr (ALIGN_EPI) { if (wr == 1) PG8_BAR; }
    }
    PG8_WAIT_V(0);
    if constexpr (!ALIGN_EPI) { if (wr == 0) PG8_BAR; }
    PG8_BAR;
#undef PG8_SA
#undef PG8_SB
#undef PG8_STAGE
#undef PG8_LDA
#undef PG8_LDB
#undef PG8_MMA
#undef PG8_WAIT_V
#undef PG8_WAIT_L
#undef PG8_BAR
#undef PG8_SCHED
}
}
constexpr int D = 2048, NB = 4, TL = 2048, TC = 256, TS = TL + TC  ;
constexpr int MLAT = NB * TL  , MTOK = NB * (TL + TC)  ;
constexpr int DIN = 5824, DINP = 5888, D6 = 6 * D;
constexpr int FF = 5632, FE = 7168, NEXP = 8;
constexpr float EPS = 1e-6f;
constexpr int PC_MLQ = 0, PC_MLK = 512, PC_MLV = 1024, PC_MLO = 1536, PC_IG = 2048, PC_FG = 2056, PC_Z = 2064, PC_XBC = 2576, PC_DT = 3600,
              PC_CQ = 3616, PC_CKV = 4064, PC_KR = 4224, PC_NQ = 4288, PC_NK = 4800, PC_NV = 5312;
constexpr int NCHUNK = 36;
constexpr int MAXMT = 72;

constexpr size_t MiB = 1u << 20;
constexpr size_t WS_CTL = 0, CTL_ZERO_BYTES = 1 * MiB;
constexpr size_t WS_MOD = 1 * MiB;
constexpr size_t WS_WIN = 2 * MiB;
constexpr size_t WS_WOUT = WS_WIN + 46 * MiB;
constexpr size_t WS_WQB = WS_WOUT + 16 * MiB;
constexpr size_t WS_WKVB = WS_WQB + 2 * MiB;
constexpr size_t WS_W13 = WS_WKVB + 1 * MiB;
constexpr size_t WS_W2 = WS_W13 + 44 * MiB;
constexpr size_t WS_MW13 = WS_W2 + 22 * MiB;
constexpr size_t WS_MW2 = WS_MW13 + 448 * MiB;
constexpr size_t WS_HN = WS_MW2 + 224 * MiB;
constexpr size_t WS_A2 = WS_HN + 36 * MiB;
constexpr size_t WS_X = WS_A2 + 36 * MiB;
constexpr size_t WS_BIG = WS_X + 72 * MiB;
constexpr size_t WS_P = WS_BIG;
constexpr size_t WS_GRAW = WS_BIG + 104 * MiB;
constexpr size_t WS_CQN = WS_P + 207 * MiB;
constexpr size_t WS_CKVN = WS_CQN + 9 * MiB;
constexpr size_t WS_QRAW = WS_CKVN + 5 * MiB;
constexpr size_t WS_KVRAW = WS_QRAW + 14 * MiB;
constexpr size_t WS_QMLA = WS_KVRAW + 18 * MiB;
constexpr size_t WS_KMLA = WS_QMLA + 14 * MiB;
constexpr size_t WS_VTMLA = WS_KMLA + 14 * MiB;
constexpr size_t WS_QNA = WS_VTMLA + 9 * MiB;
constexpr size_t WS_KNA = WS_QNA + 9 * MiB;
constexpr size_t WS_VTNA = WS_KNA + 9 * MiB;
constexpr size_t WS_XBC = WS_VTNA + 9 * MiB;
constexpr size_t WS_DT = WS_XBC + 18 * MiB;
constexpr size_t WS_GATES = WS_DT + 1 * MiB;
constexpr size_t WS_MLSC = WS_GATES + 1 * MiB;
constexpr size_t WS_SSSC = WS_MLSC + 64 * 1024;
constexpr size_t WS_MLU = WS_MLSC + 1 * MiB;
constexpr size_t WS_MLS = WS_MLU + 73 * MiB;
constexpr size_t WS_SSU = WS_MLS + 37 * MiB;
constexpr size_t WS_SSS = WS_SSU + 72 * MiB;
constexpr size_t WS_HML = WS_SSS + 36 * MiB;
constexpr size_t WS_YSS = WS_HML + 36 * MiB;
constexpr size_t WS_MIXEND = WS_YSS + 36 * MiB;
constexpr size_t WS_G = WS_BIG;
constexpr size_t WS_Y = WS_G + 252 * MiB;
constexpr size_t WS_XG = WS_Y + 144 * MiB;
constexpr size_t WS_TOK = WS_XG + 256 * MiB;
constexpr size_t WS_PART = WS_TOK + 1 * MiB;
constexpr size_t WS_FFNEND = WS_PART + 64 * MiB;
constexpr size_t WS_END = (WS_MIXEND > WS_FFNEND ? WS_MIXEND : WS_FFNEND);
static_assert(WS_END < (size_t)1800 * MiB, "workspace budget");
static_assert((size_t)MTOK * DINP * 4 <= 207 * MiB && (size_t)32 * 36 * 129 * 128 * 4 <= 73 * MiB, "sizes");
constexpr int CW_BAR = 4096;
constexpr int CW_MOE = 16384;
constexpr int CW_QH = 20480;
constexpr int CW_ARR = 32768;

constexpr int RING_BYTES = 131072;
constexpr int MISC_OFF = 147456 - 256;
constexpr int LDS_BYTES = 147456;
constexpr int NWAVES = 8, NTHR = 512;

#define RLX_AGENT __ATOMIC_RELAXED, __HIP_MEMORY_SCOPE_AGENT
#define LDS_WAIT() asm volatile("s_waitcnt lgkmcnt(0)" ::: "memory")
#define VM_WAIT() asm volatile("s_waitcnt vmcnt(0)" ::: "memory")
DI unsigned pk2(float lo, float hi) { unsigned r; asm("v_cvt_pk_bf16_f32 %0, %1, %2" : "=v"(r) : "v"(lo), "v"(hi)); return r; }
DI unsigned f2bf(float f) { return pk2(f, 0.f) & 0xffffu; }
DI float bf2f(unsigned b) { return __builtin_bit_cast(float, b << 16); }
#define PINV(x) asm volatile("" : "+v"(x))
#define PIN4(a) asm volatile("" : "+v"((a)[0]), "+v"((a)[1]), "+v"((a)[2]), "+v"((a)[3]))
#define PIN8(a) asm volatile("" : "+v"((a)[0]), "+v"((a)[1]), "+v"((a)[2]), "+v"((a)[3]), "+v"((a)[4]), "+v"((a)[5]), "+v"((a)[6]), "+v"((a)[7]))
DI float wave_sum(float v) {
    v += __builtin_bit_cast(float, __builtin_amdgcn_update_dpp(0, __builtin_bit_cast(int, v), 0xB1, 0xf, 0xf, true));
    v += __builtin_bit_cast(float, __builtin_amdgcn_update_dpp(0, __builtin_bit_cast(int, v), 0x4E, 0xf, 0xf, true));
    v += __builtin_bit_cast(float, __builtin_amdgcn_update_dpp(0, __builtin_bit_cast(int, v), 0x141, 0xf, 0xf, true));
    v += __builtin_bit_cast(float, __builtin_amdgcn_update_dpp(0, __builtin_bit_cast(int, v), 0x140, 0xf, 0xf, true));
    const int b = __builtin_bit_cast(int, v);
    const float r0 = __builtin_bit_cast(float, __builtin_amdgcn_readlane(b, 0)), r1 = __builtin_bit_cast(float, __builtin_amdgcn_readlane(b, 16));
    const float r2 = __builtin_bit_cast(float, __builtin_amdgcn_readlane(b, 32)), r3 = __builtin_bit_cast(float, __builtin_amdgcn_readlane(b, 48));
    return (r0 + r1) + (r2 + r3);
}
DI float wave_max(float v) {
    v = fmaxf(v, __builtin_bit_cast(float, __builtin_amdgcn_update_dpp(0, __builtin_bit_cast(int, v), 0xB1, 0xf, 0xf, true)));
    v = fmaxf(v, __builtin_bit_cast(float, __builtin_amdgcn_update_dpp(0, __builtin_bit_cast(int, v), 0x4E, 0xf, 0xf, true)));
    v = fmaxf(v, __builtin_bit_cast(float, __builtin_amdgcn_update_dpp(0, __builtin_bit_cast(int, v), 0x141, 0xf, 0xf, true)));
    v = fmaxf(v, __builtin_bit_cast(float, __builtin_amdgcn_update_dpp(0, __builtin_bit_cast(int, v), 0x140, 0xf, 0xf, true)));
    const int b = __builtin_bit_cast(int, v);
    const float r0 = __builtin_bit_cast(float, __builtin_amdgcn_readlane(b, 0)), r1 = __builtin_bit_cast(float, __builtin_amdgcn_readlane(b, 16));
    const float r2 = __builtin_bit_cast(float, __builtin_amdgcn_readlane(b, 32)), r3 = __builtin_bit_cast(float, __builtin_amdgcn_readlane(b, 48));
    return fmaxf(fmaxf(r0, r1), fmaxf(r2, r3));
}
DI float xor32_max(float v) { const auto r = __builtin_amdgcn_permlane32_swap(__builtin_bit_cast(unsigned, v), __builtin_bit_cast(unsigned, v), false, false); return fmaxf(__builtin_bit_cast(float, r[0]), __builtin_bit_cast(float, r[1])); }
DI float xor32_get(float v, int lane) { const auto r = __builtin_amdgcn_permlane32_swap(__builtin_bit_cast(unsigned, v), __builtin_bit_cast(unsigned, v), false, false); return __builtin_bit_cast(float, lane < 32 ? r[1] : r[0]); }
DI float xor32_sum(float v) { const auto r = __builtin_amdgcn_permlane32_swap(__builtin_bit_cast(unsigned, v), __builtin_bit_cast(unsigned, v), false, false); return __builtin_bit_cast(float, r[0]) + __builtin_bit_cast(float, r[1]); }
DI float wave_incl_scan(float v, int lane) {
    v += __builtin_bit_cast(float, __builtin_amdgcn_update_dpp(0, __builtin_bit_cast(int, v), 0x111, 0xf, 0xf, true));
    v += __builtin_bit_cast(float, __builtin_amdgcn_update_dpp(0, __builtin_bit_cast(int, v), 0x112, 0xf, 0xf, true));
    v += __builtin_bit_cast(float, __builtin_amdgcn_update_dpp(0, __builtin_bit_cast(int, v), 0x114, 0xf, 0xf, true));
    v += __builtin_bit_cast(float, __builtin_amdgcn_update_dpp(0, __builtin_bit_cast(int, v), 0x118, 0xf, 0xf, true));
    const int b = __builtin_bit_cast(int, v);
    const float t0 = __builtin_bit_cast(float, __builtin_amdgcn_readlane(b, 15)), t1 = __builtin_bit_cast(float, __builtin_amdgcn_readlane(b, 31)), t2 = __builtin_bit_cast(float, __builtin_amdgcn_readlane(b, 47));
    return v + (lane >= 16 ? t0 : 0.f) + (lane >= 32 ? t1 : 0.f) + (lane >= 48 ? t2 : 0.f);
}
DI float lane_bcast(float v, int srclane_const) { return __builtin_bit_cast(float, __builtin_amdgcn_readlane(__builtin_bit_cast(int, v), srclane_const)); }
DI float wave_prefix_max(float v, int lane) {
    const int NEG = __builtin_bit_cast(int, -3.0e38f);
    v = fmaxf(v, __builtin_bit_cast(float, __builtin_amdgcn_update_dpp(NEG, __builtin_bit_cast(int, v), 0x111, 0xf, 0xf, false)));
    v = fmaxf(v, __builtin_bit_cast(float, __builtin_amdgcn_update_dpp(NEG, __builtin_bit_cast(int, v), 0x112, 0xf, 0xf, false)));
    v = fmaxf(v, __builtin_bit_cast(float, __builtin_amdgcn_update_dpp(NEG, __builtin_bit_cast(int, v), 0x114, 0xf, 0xf, false)));
    v = fmaxf(v, __builtin_bit_cast(float, __builtin_amdgcn_update_dpp(NEG, __builtin_bit_cast(int, v), 0x118, 0xf, 0xf, false)));
    const int b = __builtin_bit_cast(int, v);
    const float t0 = __builtin_bit_cast(float, __builtin_amdgcn_readlane(b, 15)), t1 = __builtin_bit_cast(float, __builtin_amdgcn_readlane(b, 31)), t2 = __builtin_bit_cast(float, __builtin_amdgcn_readlane(b, 47));
    const float m1 = t0, m2 = fmaxf(t0, t1), m3 = fmaxf(m2, t2);
    return fmaxf(v, lane >= 48 ? m3 : (lane >= 32 ? m2 : (lane >= 16 ? m1 : -3.0e38f)));
}
DI float wave_suffix_max(float v, int lane) {
    const int NEG = __builtin_bit_cast(int, -3.0e38f);
    v = fmaxf(v, __builtin_bit_cast(float, __builtin_amdgcn_update_dpp(NEG, __builtin_bit_cast(int, v), 0x101, 0xf, 0xf, false)));
    v = fmaxf(v, __builtin_bit_cast(float, __builtin_amdgcn_update_dpp(NEG, __builtin_bit_cast(int, v), 0x102, 0xf, 0xf, false)));
    v = fmaxf(v, __builtin_bit_cast(float, __builtin_amdgcn_update_dpp(NEG, __builtin_bit_cast(int, v), 0x104, 0xf, 0xf, false)));
    v = fmaxf(v, __builtin_bit_cast(float, __builtin_amdgcn_update_dpp(NEG, __builtin_bit_cast(int, v), 0x108, 0xf, 0xf, false)));
    const int b = __builtin_bit_cast(int, v);
    const float t1 = __builtin_bit_cast(float, __builtin_amdgcn_readlane(b, 16)), t2 = __builtin_bit_cast(float, __builtin_amdgcn_readlane(b, 32)), t3 = __builtin_bit_cast(float, __builtin_amdgcn_readlane(b, 48));
    const float m2 = t3, m1 = fmaxf(t3, t2), m0 = fmaxf(m1, t1);
    return fmaxf(v, lane < 16 ? m0 : (lane < 32 ? m1 : (lane < 48 ? m2 : -3.0e38f)));
}
DI float siluf(float x) { return x * __builtin_amdgcn_rcpf(1.f + __expf(-x)); }
DI float sigmoidf_(float x) { return __builtin_amdgcn_rcpf(1.f + __expf(-x)); }
DI float softplusf_(float x) { return fmaxf(x, 0.f) + log1pf(__expf(-fabsf(x))); }
DI float logsigmoidf_(float x) { return fminf(x, 0.f) - log1pf(__expf(-fabsf(x))); }

#define XB_TMO      128
#define XB_XCNT(j)  (256  + 64 * (j))
#define XB_XSUB(j)  (1280 + 64 * (j))
#define XB_XGEN(j)  (2304 + 64 * (j))
#define XB_TOP      3328
#define XB_TOPGEN   3392
#define XCD_BAR_WORDS 3456
#define XB_SPIN_CAP (1u << 22)
DI unsigned xb_ld(unsigned* p)              { return __hip_atomic_load(p, __ATOMIC_RELAXED, __HIP_MEMORY_SCOPE_AGENT); }
DI unsigned xb_add(unsigned* p, unsigned v) { return __hip_atomic_fetch_add(p, v, __ATOMIC_RELAXED, __HIP_MEMORY_SCOPE_AGENT); }
DI unsigned xb_xcc_id() { return (unsigned)__builtin_amdgcn_s_getreg((3 << 11) | 20) & 0xFu; }
#define XB_SPIN(cond, bar) do { unsigned _sp = 0; while (cond) { __builtin_amdgcn_s_sleep(1); \
    if ((++_sp & 255u) == 0u) { if (xb_ld(&(bar)[XB_TMO])) break; if (_sp > XB_SPIN_CAP) { atomicAdd(&(bar)[XB_TMO], 1u); break; } } } } while (0)
struct XcdBarrier { unsigned* bar; unsigned x; volatile LAS unsigned* st; };
DI XcdBarrier xcd_barrier_post(unsigned* bar, volatile LAS unsigned* st) {
    XcdBarrier b; b.bar = bar; b.x = xb_xcc_id(); b.st = st;
    if (threadIdx.x == 0) (void)xb_add(&bar[XB_XCNT(b.x)], 1u);
    return b;
}
DI void xcd_barrier_complete(unsigned* bar, unsigned x, unsigned& nloc, unsigned& nx) {
    const unsigned G = gridDim.x * gridDim.y * gridDim.z;
    unsigned sum, cnt, mine, sp = 0u;
    for (;;) {
        sum = 0u; cnt = 0u; mine = 0u;
#pragma unroll
        for (unsigned j = 0; j < 16; ++j) { const unsigned c = xb_ld(&bar[XB_XCNT(j)]); sum += c; cnt += (c > 0u) ? 1u : 0u; mine = (j == x) ? c : mine; }
        if (sum == G) break;
        __builtin_amdgcn_s_sleep(1);
        if ((++sp & 255u) == 0u) { if (xb_ld(&bar[XB_TMO])) break; if (sp > XB_SPIN_CAP) { atomicAdd(&bar[XB_TMO], 1u); break; } }
    }
    nloc = mine > 0u ? mine : 1u; nx = cnt > 0u ? cnt : 1u;
}
DI void xcd_barrier(const XcdBarrier& b) {
    asm volatile("s_waitcnt vmcnt(0)" ::: "memory");
    __syncthreads();
    if (threadIdx.x == 0) {
        unsigned* bar = b.bar;
        __builtin_amdgcn_s_waitcnt(0);
        unsigned nloc = b.st[0], nx = b.st[1];
        if (nloc == 0u) { xcd_barrier_complete(bar, b.x, nloc, nx); b.st[0] = nloc; b.st[1] = nx; }
        const unsigned old = xb_add(&bar[XB_XSUB(b.x)], 1u);
        const unsigned gen = old / nloc;
        if (old + 1u == (gen + 1u) * nloc) {
            __builtin_amdgcn_fence(__ATOMIC_RELEASE, "agent");
            asm volatile("s_waitcnt vmcnt(0)" ::: "memory");
            const unsigned og = xb_add(&bar[XB_TOP], 1u);
            const unsigned tg = og / nx;
            if (og + 1u == (tg + 1u) * nx) xb_add(&bar[XB_TOPGEN], 1u);
            else XB_SPIN(xb_ld(&bar[XB_TOPGEN]) == tg, bar);
            __builtin_amdgcn_fence(__ATOMIC_ACQUIRE, "agent");
            xb_add(&bar[XB_XGEN(b.x)], 1u);
            asm volatile("s_waitcnt vmcnt(0)" ::: "memory");
        } else {
            XB_SPIN(xb_ld(&bar[XB_XGEN(b.x)]) == gen, bar);
            __builtin_amdgcn_fence(__ATOMIC_ACQUIRE, "agent");
            asm volatile("s_waitcnt vmcnt(0)" ::: "memory");
        }
    }
    __syncthreads();
}

struct Args { const float* in[35]; float* out; unsigned char* ws; int ph_lo, ph_hi, rep, pad; };
struct Frame {
    LAS unsigned char* lds;
    unsigned char* ws;
    const float* in[35];
    float* out;
    int tid, lane, wave, G, bid, rep;
};
#define WSP(T, off) ((T*)(F.ws + (off)))
DI int rowof(int b, int j) { return j < TL ? b * TL + j : MLAT + b * TC + (j - TL); }

template <int K> DI f32x4 mma16(const LAS bf16* A, int lda, const LAS bf16* Bt, int ldb, int lane, f32x4 acc) {
    const int r = lane & 15, q = lane >> 4;
    const LAS bf16* pa = A + r * lda + 8 * q; const LAS bf16* pb = Bt + r * ldb + 8 * q;
#pragma unroll
    for (int k = 0; k < K; k += 32) {
        const bf16x8 a = *(const LAS bf16x8*)(pa + k); const bf16x8 b = *(const LAS bf16x8*)(pb + k);
        acc = __builtin_amdgcn_mfma_f32_16x16x32_bf16(a, b, acc, 0, 0, 0);
    }
    return acc;
}
struct CvDesc { const float* src; bf16* dst; size_t ld, Kd; int Kv, Nv, k0, n0, dn0; };
DI void tr_load(const CvDesc& d, f32x4 (&v)[16], int lane) {
    const int nn = 4 * (lane & 15), kq = lane >> 4;
#pragma unroll
    for (int i = 0; i < 16; ++i) { const int kk = 4 * i + kq;
        v[i] = (f32x4){0.f, 0.f, 0.f, 0.f};
        if (d.k0 + kk < d.Kv && d.n0 + nn < d.Nv) v[i] = __builtin_nontemporal_load((const f32x4*)(d.src + (size_t)(d.k0 + kk) * d.ld + d.n0 + nn)); }
#pragma unroll
    for (int i = 0; i < 16; ++i) PINV(v[i]);
}
DI void tr_lds(const f32x4 (&v)[16], LAS float* scr, int lane) {
    const int nn = 4 * (lane & 15), kq = lane >> 4;
#pragma unroll
    for (int i = 0; i < 16; ++i) { const int kk = 4 * i + kq; LAS float* s = scr + kk * 65 + nn; s[0] = v[i][0]; s[1] = v[i][1]; s[2] = v[i][2]; s[3] = v[i][3]; }
    LDS_WAIT(); asm volatile("" ::: "memory");
}
DI void tr_out(const CvDesc& d, LAS float* scr, int lane) {
    const int c = lane & 7;
#pragma unroll
    for (int j = 0; j < 8; ++j) { const int n = (lane >> 3) + 8 * j; const LAS float* s = scr + (8 * c) * 65 + n;
        u32x4 o; o.x = pk2(s[0 * 65], s[1 * 65]); o.y = pk2(s[2 * 65], s[3 * 65]); o.z = pk2(s[4 * 65], s[5 * 65]); o.w = pk2(s[6 * 65], s[7 * 65]);
        __builtin_nontemporal_store(o, (u32x4*)(d.dst + (size_t)(d.dn0 + n) * d.Kd + d.k0 + 8 * c)); }
    LDS_WAIT(); asm volatile("" ::: "memory");
}
DI int il_row(int n0, int which) { return (n0 >> 7) * 256 + (n0 & 127) + which * 128; }

constexpr int I_IN = 32 * 92, I_OUT = 32 * 32, I_QB = 8 * 12, I_KVB = 4 * 16, I_F1 = 32 * 88, I_F2 = 88 * 32, I_M1 = 32 * 112, I_M2 = 112 * 32;
constexpr int I_L = I_IN + I_OUT + I_QB + I_KVB;
constexpr int CV_NE = I_L + 2 * I_F1 + I_F2, CV_NQ1 = CV_NE + I_L, CV_NALL = CV_NQ1 + NEXP * (2 * I_M1 + I_M2);
DI CvDesc conv_decode(Frame& F, int it) {
    int r = it;
    if (r >= CV_NQ1) { r -= CV_NQ1;
        if (r < NEXP * 2 * I_M1) { const int e = r / (2 * I_M1); r -= e * 2 * I_M1; const int which = r / I_M1; r -= which * I_M1; const int kb = r / 112, nb = r % 112;
            return CvDesc{(which ? F.in[33] : F.in[32]) + (size_t)e * D * FE, WSP(bf16, WS_MW13) + (size_t)e * 2 * FE * D, (size_t)(FE), (size_t)(D), D, FE, 64 * kb, 64 * nb, il_row(64 * nb, which)}; }
        r -= NEXP * 2 * I_M1;
        { const int e = r / I_M2; r -= e * I_M2; const int kb = r / 32, nb = r % 32;
            return CvDesc{F.in[34] + (size_t)e * FE * D, WSP(bf16, WS_MW2) + (size_t)e * D * FE, (size_t)(D), (size_t)(FE), FE, D, 64 * kb, 64 * nb, 64 * nb}; }
    }
    int l = 0;
    if (r >= CV_NE) { r -= CV_NE; l = 1; }
    else if (r >= I_L) { r -= I_L;
        if (r < 2 * I_F1) { const int which = r / I_F1; r -= which * I_F1; const int kb = r / 88, nb = r % 88;
            return CvDesc{(which ? F.in[29] : F.in[28]), WSP(bf16, WS_W13), (size_t)(FF), (size_t)(D), D, FF, 64 * kb, 64 * nb, il_row(64 * nb, which)}; }
        r -= 2 * I_F1;
        { const int kb = r / 32, nb = r % 32; return CvDesc{F.in[30], WSP(bf16, WS_W2), (size_t)(D), (size_t)(FF), FF, D, 64 * kb, 64 * nb, 64 * nb}; }
    }
    if (r < I_IN) { const int kb = r / 92, nb = r % 92;
        return CvDesc{F.in[7] + (size_t)l * D * DIN, WSP(bf16, WS_WIN) + (size_t)l * DINP * D, (size_t)(DIN), (size_t)(D), D, DIN, 64 * kb, 64 * nb, 64 * nb}; }
    r -= I_IN;
    if (r < I_OUT) { const int kb = r / 32, nb = r % 32;
        return CvDesc{F.in[8] + (size_t)l * D * D, WSP(bf16, WS_WOUT) + (size_t)l * D * D, (size_t)(D), (size_t)(D), D, D, 64 * kb, 64 * nb, 64 * nb}; }
    r -= I_OUT;
    if (r < I_QB) { const int kb = r / 12, nb = r % 12;
        return CvDesc{F.in[19] + (size_t)l * 448 * 768, WSP(bf16, WS_WQB) + (size_t)l * 768 * 512, (size_t)(768), (size_t)(512), 448, 768, 64 * kb, 64 * nb, 64 * nb}; }
    r -= I_QB;
    { const int kb = r / 16, nb = r % 16;
        return CvDesc{F.in[21] + (size_t)l * 160 * 1024, WSP(bf16, WS_WKVB) + (size_t)l * 1024 * 256, (size_t)(1024), (size_t)(256), 160, 1024, 64 * kb, 64 * nb, 64 * nb}; }
}

DI void conv_item(Frame& F, int it, LAS float* scr) { const CvDesc d = conv_decode(F, it); f32x4 v[16]; tr_load(d, v, F.lane); tr_lds(v, scr, F.lane); tr_out(d, scr, F.lane); }
DI void conv_items(Frame& F, int it0, int n, LAS float* scr) {
    if (it0 >= CV_NALL) return;
    if (it0 + n > CV_NALL) n = CV_NALL - it0;
    CvDesc d = conv_decode(F, it0); f32x4 v[16]; tr_load(d, v, F.lane);
    for (int k = 0; k < n; ++k) {
        tr_lds(v, scr, F.lane);
        CvDesc dn = d;
        if (k + 1 < n) { dn = conv_decode(F, it0 + k + 1); tr_load(dn, v, F.lane); }
        tr_out(d, scr, F.lane);
        d = dn;
    }
}
DI void p0_prologue(Frame& F) {
    {
        LAS float* sc = (LAS float*)F.lds;
        LAS float* red = (LAS float*)(F.lds + 5 * 2048 * 4);
        bool have = false;
        for (int u = F.bid; u < 2 * 96; u += F.G) {
            if (!have) {
                float cv[20];
#pragma unroll
                for (int k = 0; k < 20; ++k) { const int i = F.tid + NTHR * k; cv[k] = (i < 4 * 2048) ? F.in[1][i] : F.in[3][i - 4 * 2048]; }
                PIN8(cv); PIN8(cv + 8); PIN4(cv + 16);
#pragma unroll
                for (int k = 0; k < 20; ++k) sc[F.tid + NTHR * k] = siluf(cv[k]);
                have = true;
            }
            __syncthreads();
            const int l = u / 96, j0 = (u % 96) * 128;
            const float* W = F.in[4] + (size_t)l * D * D6 + j0 + 2 * F.lane;
            f32x2 acc[5];
#pragma unroll
            for (int r = 0; r < 5; ++r) acc[r] = (f32x2){0.f, 0.f};
            const int kb = F.wave * 256;
            for (int k = 0; k < 256; k += 16) {
                f32x2 w[16];
#pragma unroll
                for (int i = 0; i < 16; ++i) w[i] = __builtin_nontemporal_load((const f32x2*)(W + (size_t)(kb + k + i) * D6));
#pragma unroll
                for (int i = 0; i < 16; ++i) PINV(w[i]);
#pragma unroll
                for (int i = 0; i < 16; ++i)
#pragma unroll
                    for (int r = 0; r < 5; ++r) { const float s = sc[r * 2048 + kb + k + i]; acc[r] += w[i] * s; }
            }
#pragma unroll
            for (int r = 0; r < 5; ++r) { red[(F.wave * 5 + r) * 128 + 2 * F.lane] = acc[r][0]; red[(F.wave * 5 + r) * 128 + 2 * F.lane + 1] = acc[r][1]; }
            __syncthreads();
            for (int i = F.tid; i < 5 * 128; i += NTHR) { const int r = i / 128, j = i % 128; float s = F.in[5][l * D6 + j0 + j];
#pragma unroll
                for (int w = 0; w < 8; ++w) s += red[(w * 5 + r) * 128 + j];
                WSP(float, WS_MOD)[(l * 5 + r) * D6 + j0 + j] = s; }
        }
        __syncthreads();
    }
    LAS float* scr = (LAS float*)(F.lds + F.wave * 16640);
    const int gw = F.bid * NWAVES + F.wave, NGW = F.G * NWAVES;
    for (int it = gw; it < I_L; it += NGW) conv_item(F, it, scr);
}

constexpr int CV_EAGER = I_L;
constexpr int CV_NDEF = CV_NALL - CV_EAGER;
DI void conv_fill(Frame& F, int phase, bool work, int per_wave = 2) {
    LAS float* scr = (LAS float*)(F.lds + F.wave * 16640);
    volatile LAS int* bc = (volatile LAS int*)(F.lds + MISC_OFF) + 16;
    unsigned* ctl = WSP(unsigned, WS_CTL);
    __syncthreads();
    if (F.tid == 0) __hip_atomic_fetch_add(ctl + CW_ARR + 64 * phase, 1u, RLX_AGENT);
    if (!work) return;
    for (;;) {
        if (F.tid == 0) {
            int base = -1;
            if (__hip_atomic_load(ctl + CW_ARR + 64 * phase, RLX_AGENT) < (unsigned)F.G) { base = (int)__hip_atomic_fetch_add(ctl + CW_QH, (unsigned)(8 * per_wave), RLX_AGENT); if (base >= CV_NDEF) base = -1; }
            bc[0] = base;
        }
        __syncthreads();
        const int base = bc[0];
        __syncthreads();
        if (base < 0) break;
        conv_items(F, CV_EAGER + base + F.wave * per_wave, per_wave, scr);
    }
}
DI void conv_drain(Frame& F, int upto) {
    LAS float* scr = (LAS float*)(F.lds + F.wave * 16640);
    volatile LAS int* bc = (volatile LAS int*)(F.lds + MISC_OFF) + 16;
    unsigned* ctl = WSP(unsigned, WS_CTL);
    __syncthreads();
    for (;;) {
        if (F.tid == 0) {
            int base = -1;
            if ((int)__hip_atomic_load(ctl + CW_QH, RLX_AGENT) < upto) { base = (int)__hip_atomic_fetch_add(ctl + CW_QH, 64u, RLX_AGENT); if (base >= CV_NDEF) base = -1; }
            bc[0] = base;
        }
        __syncthreads();
        const int base = bc[0];
        __syncthreads();
        if (base < 0) break;
        conv_items(F, CV_EAGER + base + F.wave * 8, 8, scr);
    }
}
template <bool ROUTE>
DI void norm_phase(Frame& F, int l, const float* srcLat, const float* srcCtx, const float* g, int shoff, int nrows) {
    LAS float* rl = (LAS float*)F.lds;
    if (ROUTE) {
        f32x4 rv[8];
#pragma unroll
        for (int i = 0; i < 8; ++i) rv[i] = *(const f32x4*)(F.in[31] + 4 * (F.tid + NTHR * i));
#pragma unroll
        for (int i = 0; i < 8; ++i) PINV(rv[i]);
#pragma unroll
        for (int i = 0; i < 8; ++i) *(LAS f32x4*)(rl + 4 * (F.tid + NTHR * i)) = rv[i];
        __syncthreads(); }
    const int gw = F.bid * NWAVES + F.wave, NGW = F.G * NWAVES;
    bf16* HN = WSP(bf16, WS_HN);
    f32x4 gv[8];
#pragma unroll
    for (int j = 0; j < 8; ++j) gv[j] = *(const f32x4*)(g + 4 * F.lane + 256 * j);
    for (int row = gw; row < nrows; row += NGW) {
        const float* xr = row < MLAT ? srcLat + (size_t)row * D : srcCtx + (size_t)(row - MLAT) * D;
        const int br = row < MLAT ? row / TL : 4;
        const float* mrow = WSP(float, WS_MOD) + (size_t)(l * 5 + br) * D6 + shoff;
        f32x4 v[8], shv[8], scv[8]; float ss = 0.f;
#pragma unroll
        for (int j = 0; j < 8; ++j) { const int c = 4 * F.lane + 256 * j; v[j] = *(const f32x4*)(xr + c); shv[j] = *(const f32x4*)(mrow + c); scv[j] = *(const f32x4*)(mrow + D + c); }
#pragma unroll
        for (int j = 0; j < 8; ++j) { PINV(v[j]); PINV(shv[j]); PINV(scv[j]); }
#pragma unroll
        for (int j = 0; j < 8; ++j) ss += (v[j][0] * v[j][0] + v[j][1] * v[j][1]) + (v[j][2] * v[j][2] + v[j][3] * v[j][3]);
        const float rstd = __builtin_amdgcn_rsqf(wave_sum(ss) * (1.f / D) + EPS);
        float lg[8]; u32x2 wk[8];
        if (ROUTE) {
#pragma unroll
            for (int e = 0; e < 8; ++e) lg[e] = 0.f; }
#pragma unroll
        for (int j = 0; j < 8; ++j) { const int c = 4 * F.lane + 256 * j;
            const f32x4 gg = gv[j], sh = shv[j], sc = scv[j];
            f32x4 o;
#pragma unroll
            for (int i = 0; i < 4; ++i) o[i] = v[j][i] * rstd * gg[i] * (1.f + sc[i]) + sh[i];
            u32x2 w; w.x = pk2(o[0], o[1]); w.y = pk2(o[2], o[3]);
            if (ROUTE) wk[j] = w; else *(u32x2*)(HN + (size_t)row * D + c) = w;
            if (ROUTE) {
#pragma unroll
                for (int i = 0; i < 4; ++i) { const f32x4 r0 = *(const LAS f32x4*)(rl + (c + i) * 8), r1 = *(const LAS f32x4*)(rl + (c + i) * 8 + 4);
                    lg[0] += o[i] * r0[0]; lg[1] += o[i] * r0[1]; lg[2] += o[i] * r0[2]; lg[3] += o[i] * r0[3];
                    lg[4] += o[i] * r1[0]; lg[5] += o[i] * r1[1]; lg[6] += o[i] * r1[2]; lg[7] += o[i] * r1[3]; }
                __builtin_amdgcn_sched_barrier(0);
            }
        }
        if (ROUTE) {
#pragma unroll
            for (int e = 0; e < 8; ++e) lg[e] = wave_sum(lg[e]);
            int r1 = 0, r2 = 0;
            if (F.lane == 0) {
                int e1 = 0; float v1 = lg[0];
#pragma unroll
                for (int e = 1; e < 8; ++e) if (lg[e] > v1) { v1 = lg[e]; e1 = e; }
                int e2 = -1; float v2 = -3.0e38f;
#pragma unroll
                for (int e = 0; e < 8; ++e) if (e != e1 && lg[e] > v2) { v2 = lg[e]; e2 = e; }
                const float g2 = 1.f / (1.f + expf(v1 - v2)), g1 = 1.f - g2;
                unsigned* cnt = WSP(unsigned, WS_CTL) + CW_MOE;
                const unsigned p1 = __hip_atomic_fetch_add(cnt + e1, 1u, RLX_AGENT), p2 = __hip_atomic_fetch_add(cnt + e2, 1u, RLX_AGENT);
                int* tk = WSP(int, WS_TOK) + (size_t)row * 8;
                tk[0] = e1; tk[1] = (int)p1; tk[2] = e2; tk[3] = (int)p2; ((float*)tk)[4] = g1; ((float*)tk)[5] = g2;
                r1 = e1 * MLAT + (int)p1; r2 = e2 * MLAT + (int)p2;
            }
            r1 = __builtin_amdgcn_readfirstlane(r1); r2 = __builtin_amdgcn_readfirstlane(r2);
            bf16* XS = WSP(bf16, WS_XG);
#pragma unroll
            for (int j = 0; j < 8; ++j) { const int c = 4 * F.lane + 256 * j; *(u32x2*)(XS + (size_t)r1 * D + c) = wk[j]; *(u32x2*)(XS + (size_t)r2 * D + c) = wk[j]; }
        }
    }
}

DI void moe_tables(Frame& F, LAS int* tb, int NT) {
    if (F.tid == 0) {
        const unsigned* cnt = WSP(unsigned, WS_CTL) + CW_MOE; int ts = 0, us = 0;
        for (int e = 0; e < 8; ++e) { const int c = (int)__hip_atomic_load(cnt + e, RLX_AGENT); const int t = (c + 255) >> 8; tb[e] = c; tb[8 + e] = t; tb[16 + e] = ts; tb[32 + e] = us; ts += t; us += t * NT; }
        tb[24] = ts; tb[40] = us;
    }
    __syncthreads();
}
DI void moe_combine_phase(Frame& F, int l) {
    LAS int* tb = (LAS int*)F.lds; __syncthreads(); moe_tables(F, tb, 1);
    const int gw = F.bid * NWAVES + F.wave, NGW = F.G * NWAVES;
    const float* Y = WSP(float, WS_Y); const float* X = WSP(float, WS_X);
    for (int row = gw; row < MLAT; row += NGW) {
        const int* tk = WSP(int, WS_TOK) + (size_t)row * 8;
        const float g1 = ((const float*)tk)[4], g2 = ((const float*)tk)[5];
        const int s1 = tb[16 + tk[0]] * 256 + tk[1], s2 = tb[16 + tk[2]] * 256 + tk[3];
        const float* mrow = WSP(float, WS_MOD) + (size_t)(l * 5 + row / TL) * D6 + 5 * D;
        f32x4 xv[8], y1[8], y2[8], gq[8];
#pragma unroll
        for (int j = 0; j < 8; ++j) { const int c = 4 * F.lane + 256 * j;
            xv[j] = *(const f32x4*)(X + (size_t)row * D + c); y1[j] = *(const f32x4*)(Y + (size_t)s1 * D + c); y2[j] = *(const f32x4*)(Y + (size_t)s2 * D + c); gq[j] = *(const f32x4*)(mrow + c); }
#pragma unroll
        for (int j = 0; j < 8; ++j) { PINV(xv[j]); PINV(y1[j]); PINV(y2[j]); PINV(gq[j]); }
#pragma unroll
        for (int j = 0; j < 8; ++j) { const int c = 4 * F.lane + 256 * j; const f32x4 gg = gq[j];
            *(f32x4*)(F.out + (size_t)row * D + c) = xv[j] + gg * (y1[j] * g1 + y2[j] * g2); }
    }
}
using pg8::Unit;
struct EpiF32 {
    static constexpr bool PERM = false;
    float* C; int ldc;
    DI void operator()(const f32x4 (&acc)[2][2][4][2], const Unit& u, int wr, int wc, int fr, int fq) const {
        const int row0 = u.pm * 256 + wr * 64 + fr, col0 = u.pn * 256 + wc * 32 + 4 * fq;
#pragma unroll
        for (int ai = 0; ai < 2; ++ai)
#pragma unroll
            for (int m = 0; m < 4; ++m) { float* rowp = C + (size_t)(row0 + ai * 128 + m * 16) * ldc + col0;
#pragma unroll
                for (int bj = 0; bj < 2; ++bj)
#pragma unroll
                    for (int n = 0; n < 2; ++n) *(f32x4*)(rowp + bj * 128 + n * 16) = acc[ai][bj][m][n]; }
    }
};
struct EpiBf16 {
    static constexpr bool PERM = true;
    bf16* O; int ldc;
    DI void operator()(const f32x4 (&acc)[2][2][4][2], const Unit& u, int wr, int wc, int fr, int fq) const {
        const int row0 = u.pm * 256 + wr * 64 + fr, col0 = u.pn * 256 + wc * 32 + 8 * fq;
#pragma unroll
        for (int ai = 0; ai < 2; ++ai)
#pragma unroll
            for (int m = 0; m < 4; ++m) { bf16* rowp = O + (size_t)(row0 + ai * 128 + m * 16) * ldc + col0;
#pragma unroll
                for (int bj = 0; bj < 2; ++bj) { const f32x4 v0 = acc[ai][bj][m][0], v1 = acc[ai][bj][m][1];
                    u32x4 w; w.x = pg8::cvt_pk_bf16(v0[0], v0[1]); w.y = pg8::cvt_pk_bf16(v0[2], v0[3]); w.z = pg8::cvt_pk_bf16(v1[0], v1[1]); w.w = pg8::cvt_pk_bf16(v1[2], v1[3]);
                    *(u32x4*)(rowp + bj * 128) = w; } }
    }
};
struct EpiP {
    static constexpr bool PERM = true;
    bf16* O; float* graw;
    DI void operator()(const f32x4 (&acc)[2][2][4][2], const Unit& u, int wr, int wc, int fr, int fq) const {
        const int row0 = u.pm * 256 + wr * 64 + fr, col0 = u.pn * 256 + wc * 32 + 8 * fq;
#pragma unroll
        for (int ai = 0; ai < 2; ++ai)
#pragma unroll
            for (int m = 0; m < 4; ++m) { bf16* rowp = O + (size_t)(row0 + ai * 128 + m * 16) * DINP + col0;
#pragma unroll
                for (int bj = 0; bj < 2; ++bj) { const f32x4 v0 = acc[ai][bj][m][0], v1 = acc[ai][bj][m][1];
                    u32x4 w; w.x = pg8::cvt_pk_bf16(v0[0], v0[1]); w.y = pg8::cvt_pk_bf16(v0[2], v0[3]); w.z = pg8::cvt_pk_bf16(v1[0], v1[1]); w.w = pg8::cvt_pk_bf16(v1[2], v1[3]);
                    *(u32x4*)(rowp + bj * 128) = w; } }
        const bool gsel = (u.pn == 8 && wc == 0 && fq < 2), dsel = (u.pn == 14 && wc == 0 && fq >= 2);
        if (gsel || dsel) { const int off = gsel ? 8 * fq : 16 + 8 * (fq - 2);
#pragma unroll
            for (int ai = 0; ai < 2; ++ai)
#pragma unroll
                for (int m = 0; m < 4; ++m) { float* gp = graw + (size_t)(row0 + ai * 128 + m * 16) * 32 + off;
                    *(f32x4*)gp = acc[ai][0][m][0]; *(f32x4*)(gp + 4) = acc[ai][0][m][1]; } }
    }
};
struct EpiSwiglu {
    static constexpr bool PERM = true;
    bf16* O; int ldc;
    DI void operator()(const f32x4 (&acc)[2][2][4][2], const Unit& u, int wr, int wc, int fr, int fq) const {
        const int row0 = u.pm * 256 + wr * 64 + fr, col0 = u.pn * 128 + wc * 32 + 8 * fq;
#pragma unroll
        for (int ai = 0; ai < 2; ++ai)
#pragma unroll
            for (int m = 0; m < 4; ++m) { bf16* rowp = O + (size_t)(row0 + ai * 128 + m * 16) * ldc + col0;
                f32x4 v0, v1;
#pragma unroll
                for (int j = 0; j < 4; ++j) { v0[j] = siluf(acc[ai][0][m][0][j]) * acc[ai][1][m][0][j]; v1[j] = siluf(acc[ai][0][m][1][j]) * acc[ai][1][m][1][j]; }
                u32x4 w; w.x = pg8::cvt_pk_bf16(v0[0], v0[1]); w.y = pg8::cvt_pk_bf16(v0[2], v0[3]); w.z = pg8::cvt_pk_bf16(v1[0], v1[1]); w.w = pg8::cvt_pk_bf16(v1[2], v1[3]);
                *(u32x4*)rowp = w; }
    }
};
struct EpiResid {
    static constexpr bool PERM = false;
    const float* baseLat; const float* baseCtx; float* out; const float* mod;
    DI void operator()(const f32x4 (&acc)[2][2][4][2], const Unit& u, int wr, int wc, int fr, int fq) const {
        const int row0 = u.pm * 256 + wr * 64 + fr, col0 = u.pn * 256 + wc * 32 + 4 * fq;
        const int br = (u.pm * 256 < MLAT) ? (u.pm * 256) / TL : 4;
        const float* gate = mod + (size_t)br * D6 + col0;
        f32x4 gv[2][2];
#pragma unroll
        for (int bj = 0; bj < 2; ++bj)
#pragma unroll
            for (int n = 0; n < 2; ++n) gv[bj][n] = *(const f32x4*)(gate + bj * 128 + n * 16);
#pragma unroll
        for (int ai = 0; ai < 2; ++ai)
#pragma unroll
            for (int mp = 0; mp < 2; ++mp) {
                f32x4 bv[2][2][2];
#pragma unroll
                for (int mi = 0; mi < 2; ++mi) { const int row = row0 + ai * 128 + (2 * mp + mi) * 16;
                    const float* bp = (row < MLAT ? baseLat + (size_t)row * D : baseCtx + (size_t)(row - MLAT) * D) + col0;
#pragma unroll
                    for (int bj = 0; bj < 2; ++bj)
#pragma unroll
                        for (int n = 0; n < 2; ++n) bv[mi][bj][n] = *(const f32x4*)(bp + bj * 128 + n * 16); }
#pragma unroll
                for (int mi = 0; mi < 2; ++mi)
#pragma unroll
                    for (int bj = 0; bj < 2; ++bj)
#pragma unroll
                        for (int n = 0; n < 2; ++n) PINV(bv[mi][bj][n]);
#pragma unroll
                for (int mi = 0; mi < 2; ++mi) { const int m = 2 * mp + mi, row = row0 + ai * 128 + m * 16; float* op = out + (size_t)row * D + col0;
#pragma unroll
                    for (int bj = 0; bj < 2; ++bj)
#pragma unroll
                        for (int n = 0; n < 2; ++n) *(f32x4*)(op + bj * 128 + n * 16) = bv[mi][bj][n] + gv[bj][n] * acc[ai][bj][m][n]; }
            }
    }
};
struct MoeOrder {
    const LAS int* tb; int NT, G, c, L0, nT, S, KS, acap;
    DI bool next(int i, Unit& u) const {
        const long T = (long)i * G + c; if (T >= nT) return false;
        const int nun = tb[40], L = L0 + (int)T / S, sl = (int)T % S;
        const int w = pg8::xcd_remap(L, nun); int e = 0;
#pragma unroll
        for (int k = 1; k < 8; ++k) if (w >= tb[32 + k]) e = k;
        const int rem = w - tb[32 + e], tiles = tb[8 + e], nt = rem / tiles, mtl = rem - nt * tiles;
        u.pm = tb[16 + e] + mtl; u.pn = nt; u.pb = e * NT + nt; u.koff = sl * KS; u.aux = (int)T; u.pa = acap ? e * acap + mtl : u.pm; return true;
    }
};
struct EpiPart {
    static constexpr bool PERM = false;
    float* part;
    DI void operator()(const f32x4 (&acc)[2][2][4][2], const Unit& u, int wr, int wc, int fr, int fq) const {
        f32x4* p = (f32x4*)part + (size_t)u.aux * (32 * NTHR) + threadIdx.x;
#pragma unroll
        for (int ai = 0; ai < 2; ++ai)
#pragma unroll
            for (int bj = 0; bj < 2; ++bj)
#pragma unroll
                for (int m = 0; m < 4; ++m)
#pragma unroll
                    for (int n = 0; n < 2; ++n) p[(size_t)(((ai * 2 + bj) * 4 + m) * 2 + n) * NTHR] = acc[ai][bj][m][n];
    }
};
template <int S> DI void splitk_reduce_f32(const float* part, int t, int cg, const Unit& u, float* C, int ldc) {
    const int tid = threadIdx.x, wid = tid >> 6, lane = tid & 63, wr = wid >> 2, wc = wid & 3, fr = lane & 15, fq = lane >> 4;
    f32x4 v[4][S];
#pragma unroll
    for (int k = 0; k < 4; ++k)
#pragma unroll
        for (int s = 0; s < S; ++s) v[k][s] = *((const f32x4*)part + ((size_t)(t * S + s) * 32 + (cg * 4 + k)) * NTHR + tid);
#pragma unroll
    for (int k = 0; k < 4; ++k)
#pragma unroll
        for (int s = 0; s < S; ++s) PINV(v[k][s]);
#pragma unroll
    for (int k = 0; k < 4; ++k) { const int ch = cg * 4 + k, n = ch & 1, m = (ch >> 1) & 3, bj = (ch >> 3) & 1, ai = ch >> 4;
        f32x4 a = v[k][0];
#pragma unroll
        for (int s = 1; s < S; ++s) a += v[k][s];
        *(f32x4*)(C + (size_t)(u.pm * 256 + ai * 128 + wr * 64 + m * 16 + fr) * ldc + u.pn * 256 + bj * 128 + wc * 32 + n * 16 + 4 * fq) = a; }
}
DI int tc_of(int dir, int p) { return dir == 0 ? (p < 4 ? 32 + p : p - 4) : 35 - p; }

DI void m1_prep_unit(Frame& F, int l, int b, int tt) {
    const bf16* P = WSP(bf16, WS_P); const float* GR = WSP(float, WS_GRAW);
    const int j0 = tt * 32, lane = F.lane;
    LAS bf16* vs = (LAS bf16*)F.lds;
    float qnv[7], knv[3], gqv[2], gkv[2];
#pragma unroll
    for (int u = 0; u < 7; ++u) qnv[u] = F.in[18][l * 448 + lane + 64 * u];
#pragma unroll
    for (int u = 0; u < 3; ++u) knv[u] = (lane + 64 * u < 160) ? F.in[20][l * 160 + lane + 64 * u] : 0.f;
    gqv[0] = F.in[24][l * 128 + lane]; gqv[1] = F.in[24][l * 128 + 64 + lane]; gkv[0] = F.in[25][l * 128 + lane]; gkv[1] = F.in[25][l * 128 + 64 + lane];
    const float ib = lane < 8 ? F.in[9][l * 8 + lane] : 0.f, fb = lane < 8 ? F.in[10][l * 8 + lane] : 0.f, db = lane < 16 ? F.in[14][l * 16 + lane] : 0.f;
    for (int i = F.wave; i < 32; i += 8) {
        const int j = j0 + i, row = rowof(b, j);
        const bf16* p = P + (size_t)row * DINP; const float* gr = GR + (size_t)row * 32;
        unsigned cqw[7], ckw[3], nqw[4][2], nkw[4][2], nvw[8];
#pragma unroll
        for (int u = 0; u < 7; ++u) cqw[u] = p[PC_CQ + lane + 64 * u];
#pragma unroll
        for (int u = 0; u < 3; ++u) { const int idx = lane + 64 * u; ckw[u] = idx < 160 ? (unsigned)p[PC_CKV + idx] : 0u; }
#pragma unroll
        for (int h = 0; h < 4; ++h) { nqw[h][0] = p[PC_NQ + h * 128 + lane]; nqw[h][1] = p[PC_NQ + h * 128 + 64 + lane]; nkw[h][0] = p[PC_NK + h * 128 + lane]; nkw[h][1] = p[PC_NK + h * 128 + 64 + lane]; }
#pragma unroll
        for (int u = 0; u < 8; ++u) nvw[u] = p[PC_NV + lane + 64 * u];
        float gi = lane < 8 ? gr[lane] : 0.f, gf = lane < 8 ? gr[8 + lane] : 0.f, gd = lane < 16 ? gr[16 + lane] : 0.f;
        PIN4(cqw); PINV(cqw[4]); PINV(cqw[5]); PINV(cqw[6]); PINV(ckw[0]); PINV(ckw[1]); PINV(ckw[2]); PIN8(nvw); PINV(gi); PINV(gf); PINV(gd);
#pragma unroll
        for (int h = 0; h < 4; ++h) { PINV(nqw[h][0]); PINV(nqw[h][1]); PINV(nkw[h][0]); PINV(nkw[h][1]); }
        float cq[7], ckv[3], nq[4][2], nk[4][2]; bf16 nv[8];
#pragma unroll
        for (int u = 0; u < 7; ++u) cq[u] = bf2f(cqw[u]);
#pragma unroll
        for (int u = 0; u < 3; ++u) ckv[u] = bf2f(ckw[u]);
#pragma unroll
        for (int h = 0; h < 4; ++h) { nq[h][0] = bf2f(nqw[h][0]); nq[h][1] = bf2f(nqw[h][1]); nk[h][0] = bf2f(nkw[h][0]); nk[h][1] = bf2f(nkw[h][1]); }
#pragma unroll
        for (int u = 0; u < 8; ++u) nv[u] = (bf16)nvw[u];
        {
            float ss = 0.f;
#pragma unroll
            for (int u = 0; u < 7; ++u) ss += cq[u] * cq[u];
            const float rstd = __builtin_amdgcn_rsqf(wave_sum(ss) * (1.f / 448.f) + EPS);
            bf16* o = WSP(bf16, WS_CQN) + (size_t)row * 512;
#pragma unroll
            for (int u = 0; u < 7; ++u) o[lane + 64 * u] = (bf16)f2bf(cq[u] * rstd * qnv[u]);
            o[448 + lane] = 0;
        }
        {
            float ss = 0.f;
#pragma unroll
            for (int u = 0; u < 3; ++u) ss += ckv[u] * ckv[u];
            const float rstd = __builtin_amdgcn_rsqf(wave_sum(ss) * (1.f / 160.f) + EPS);
            bf16* o = WSP(bf16, WS_CKVN) + (size_t)row * 256;
#pragma unroll
            for (int u = 0; u < 3; ++u) { const int idx = lane + 64 * u; o[idx] = idx < 160 ? (bf16)f2bf(ckv[u] * rstd * knv[u]) : (bf16)0; }
            o[192 + lane] = 0;
        }
#pragma unroll
        for (int h = 0; h < 4; ++h) {
            const float rq = __builtin_amdgcn_rsqf(wave_sum(nq[h][0] * nq[h][0] + nq[h][1] * nq[h][1]) * (1.f / 128.f) + EPS);
            const float rk = __builtin_amdgcn_rsqf(wave_sum(nk[h][0] * nk[h][0] + nk[h][1] * nk[h][1]) * (1.f / 128.f) + EPS);
            bf16* oq = WSP(bf16, WS_QNA) + ((size_t)(b * 4 + h) * TS + j) * 128; bf16* ok = WSP(bf16, WS_KNA) + ((size_t)(b * 4 + h) * TS + j) * 128;
            oq[lane] = (bf16)f2bf(nq[h][0] * rq * gqv[0]); oq[64 + lane] = (bf16)f2bf(nq[h][1] * rq * gqv[1]);
            ok[lane] = (bf16)f2bf(nk[h][0] * rk * gkv[0]); ok[64 + lane] = (bf16)f2bf(nk[h][1] * rk * gkv[1]);
        }
#pragma unroll
        for (int u = 0; u < 8; ++u) vs[i * 520 + lane + 64 * u] = nv[u];
        if (lane < 8) {
            float* gt = WSP(float, WS_GATES) + (size_t)row * 16;
            gt[lane] = gi + ib;
            gt[8 + lane] = logsigmoidf_(gf + fb);
        }
        if (lane < 16) WSP(float, WS_DT)[(size_t)row * 16 + lane] = softplusf_(gd + db);
    }
    {
        const int ch = 2 * F.tid;
        const int seglo = j0 < TL ? 0 : TL, seghi = j0 < TL ? TL : TS;
        const float* cw = F.in[12] + (size_t)l * 5 * 1024 + ch; const float* cb = F.in[13] + (size_t)l * 1024 + ch;
        f32x2 w[5];
#pragma unroll
        for (int d = 0; d < 5; ++d) w[d] = *(const f32x2*)(cw + d * 1024);
        const f32x2 bias = *(const f32x2*)cb;
        unsigned xww[36];
#pragma unroll
        for (int d = 0; d < 36; ++d) { const int jj = j0 - 2 + d; xww[d] = 0u; if (jj >= seglo && jj < seghi) xww[d] = *(const unsigned*)(P + (size_t)rowof(b, jj) * DINP + PC_XBC + ch); }
        PIN8(xww); PIN8(xww + 8); PIN8(xww + 16); PIN8(xww + 24); PIN4(xww + 32);
        f32x2 xin[36];
#pragma unroll
        for (int d = 0; d < 36; ++d) xin[d] = (f32x2){bf2f(xww[d] & 0xffffu), bf2f(xww[d] >> 16)};
#pragma unroll
        for (int i = 0; i < 32; ++i) {
            f32x2 a = bias;
#pragma unroll
            for (int d = 0; d < 5; ++d) a += w[d] * xin[i + d];
            *(unsigned*)(WSP(bf16, WS_XBC) + (size_t)rowof(b, j0 + i) * 1024 + ch) = pk2(siluf(a[0]), siluf(a[1]));
        }
    }
    __syncthreads();
    {
        const int t = F.tid; unsigned wv[16];
#pragma unroll
        for (int i = 0; i < 16; ++i) wv[i] = (unsigned)vs[(2 * i) * 520 + t] | ((unsigned)vs[(2 * i + 1) * 520 + t] << 16);
        u32x4* dst = (u32x4*)(WSP(bf16, WS_VTNA) + ((size_t)(b * 4 + (t >> 7)) * 128 + (t & 127)) * TS + j0);
#pragma unroll
        for (int k = 0; k < 4; ++k) dst[k] = (u32x4){wv[4 * k], wv[4 * k + 1], wv[4 * k + 2], wv[4 * k + 3]};
    }
    __syncthreads();
}

DI void ml_a_unit(Frame& F, int seq, int p) {
    const int b = seq >> 3, h = (seq >> 1) & 3, dir = seq & 1, tc = tc_of(dir, p), lane = F.lane;
    const bf16* P = WSP(bf16, WS_P);
    LAS bf16* VW = (LAS bf16*)F.lds;
    LAS bf16* KT = (LAS bf16*)(F.lds + 20736);
    LAS float* wgs = (LAS float*)(F.lds + 39168);
    if (F.wave == 0) {
        const int row = rowof(b, tc * 64 + lane);
        const float* gt = WSP(float, WS_GATES) + (size_t)row * 16;
        const float li = gt[dir * 4 + h], lf = gt[8 + dir * 4 + h];
        const float pre = wave_incl_scan(lf, lane), tot = lane_bcast(pre, 63);
        const float g = dir == 0 ? (tot - pre) + li : (pre - lf) + li;
        const float mloc = wave_max(g);
        wgs[lane] = __expf(g - mloc);
        if (lane == 0) { float* sc = WSP(float, WS_MLSC) + (size_t)(seq * 36 + p) * 4; sc[0] = tot; sc[1] = mloc; }
    }
    {
        unsigned vw[16], kw[16];
#pragma unroll
        for (int it = 0; it < 16; ++it) { const int idx = F.tid + NTHR * it, n = idx >> 7, d = idx & 127;
            const bf16* pr = P + (size_t)rowof(b, tc * 64 + n) * DINP + h * 128 + d; vw[it] = pr[PC_MLV]; kw[it] = pr[PC_MLK]; }
        PIN8(vw); PIN8(vw + 8); PIN8(kw); PIN8(kw + 8);
        float vv[16]; bf16 kk[16];
#pragma unroll
        for (int it = 0; it < 16; ++it) { vv[it] = bf2f(vw[it]); kk[it] = (bf16)kw[it]; }
        __syncthreads();
#pragma unroll
        for (int it = 0; it < 16; ++it) { const int idx = F.tid + NTHR * it, n = idx >> 7, d = idx & 127;
            VW[d * 72 + n] = (bf16)f2bf(vv[it] * wgs[n]); KT[d * 72 + n] = kk[it]; }
    }
    for (int idx = F.tid; idx < 16 * 64; idx += NTHR) { const int rr = idx >> 6, n = idx & 63; VW[(128 + rr) * 72 + n] = rr == 0 ? (bf16)f2bf(wgs[n]) : (bf16)0; }
    __syncthreads();
    float* U = WSP(float, WS_MLU) + (size_t)(seq * 36 + p) * (129 * 128);
    for (int id = F.wave; id < 72; id += 8) { const int dt = id >> 3, et = id & 7;
        const f32x4 acc = mma16<64>(VW + dt * 16 * 72, 72, KT + et * 16 * 72, 72, lane, (f32x4){0.f, 0.f, 0.f, 0.f});
#pragma unroll
        for (int i = 0; i < 4; ++i) { const int d = dt * 16 + 4 * (lane >> 4) + i; if (d < 129) U[d * 128 + et * 16 + (lane & 15)] = acc[i]; } }
    __syncthreads();
}

DI void ss_a_unit(Frame& F, int l, int b, int dir, int p, int g) {
    const int tc = tc_of(dir, p), lane = F.lane;
    LAS bf16* XT = (LAS bf16*)F.lds;
    LAS bf16* BT = (LAS bf16*)(F.lds + 36864);
    LAS float* tails = (LAS float*)(F.lds + 55296);
    const bf16* XBC = WSP(bf16, WS_XBC);
    if (F.wave < 4) {
        const int h = 4 * g + F.wave, row = rowof(b, tc * 64 + lane);
        const float dt = WSP(float, WS_DT)[(size_t)row * 16 + dir * 8 + h];
        const float A = -__expf(F.in[15][l * 16 + dir * 8 + h]);
        const float a = dt * A, pre = wave_incl_scan(a, lane), tot = lane_bcast(pre, 63);
        tails[F.wave * 64 + lane] = (dir == 0 ? __expf(tot - pre) : __expf(pre - a)) * dt;
        if (lane == 0) WSP(float, WS_SSSC)[(size_t)((b * 8 + h) * 2 + dir) * 36 + p] = __expf(tot);
    }
    {
        unsigned xv[32], bv[16];
#pragma unroll
        for (int it = 0; it < 32; ++it) { const int idx = F.tid + NTHR * it, n = idx >> 8, c = idx & 255; xv[it] = XBC[(size_t)rowof(b, tc * 64 + n) * 1024 + g * 256 + c]; }
#pragma unroll
        for (int it = 0; it < 16; ++it) { const int idx = F.tid + NTHR * it, n = idx >> 7, nn = idx & 127; bv[it] = XBC[(size_t)rowof(b, tc * 64 + n) * 1024 + 512 + g * 128 + nn]; }
        PIN8(xv); PIN8(xv + 8); PIN8(xv + 16); PIN8(xv + 24); PIN8(bv); PIN8(bv + 8);
        __syncthreads();
#pragma unroll
        for (int it = 0; it < 32; ++it) { const int idx = F.tid + NTHR * it, n = idx >> 8, c = idx & 255; XT[c * 72 + n] = (bf16)f2bf(bf2f(xv[it]) * tails[(c >> 6) * 64 + n]); }
#pragma unroll
        for (int it = 0; it < 16; ++it) { const int idx = F.tid + NTHR * it, n = idx >> 7, nn = idx & 127; BT[nn * 72 + n] = (bf16)bv[it]; }
    }
    __syncthreads();
    for (int id = F.wave; id < 128; id += 8) { const int hh = id >> 5, rem = id & 31, pt = rem >> 3, nt = rem & 7;
        const f32x4 acc = mma16<64>(XT + (hh * 64 + pt * 16) * 72, 72, BT + nt * 16 * 72, 72, lane, (f32x4){0.f, 0.f, 0.f, 0.f});
        float* U = WSP(float, WS_SSU) + (size_t)(((b * 8 + 4 * g + hh) * 2 + dir) * 36 + p) * 8192;
#pragma unroll
        for (int i = 0; i < 4; ++i) U[(pt * 16 + 4 * (lane >> 4) + i) * 128 + nt * 16 + (lane & 15)] = acc[i]; }
    __syncthreads();
}
DI void ml_scan_unit(Frame& F, int seq, int s4) {
    float* sc = WSP(float, WS_MLSC) + (size_t)seq * 36 * 4;
    const float* U = WSP(float, WS_MLU) + (size_t)seq * 36 * 16512 + s4 * 4128 + F.tid; bf16* S = WSP(bf16, WS_MLS) + (size_t)seq * 36 * 16512 + s4 * 4128 + F.tid;
    float st[9]; float m = 0.f;
#pragma unroll
    for (int k = 0; k < 9; ++k) st[k] = 0.f;
    for (int pg = 0; pg < 36; pg += 12) {
        float u[12][9];
#pragma unroll
        for (int pp = 0; pp < 12; ++pp)
#pragma unroll
            for (int k = 0; k < 9; ++k) u[pp][k] = (F.tid + 512 * k < 4128) ? U[(size_t)(pg + pp) * 16512 + 512 * k] : 0.f;
#pragma unroll
        for (int pp = 0; pp < 12; ++pp) { PIN8(u[pp]); PINV(u[pp][8]); }
#pragma unroll
        for (int pp = 0; pp < 12; ++pp) { const int p = pg + pp;
            const float bl = sc[p * 4], mloc = sc[p * 4 + 1];
            const float mn = fmaxf(bl + m, mloc), wc = __expf(bl + m - mn), wu = __expf(mloc - mn);
            if (s4 == 0 && F.tid == 0) sc[p * 4 + 2] = m;
#pragma unroll
            for (int k = 0; k < 9; ++k) { if (F.tid + 512 * k < 4128) S[(size_t)p * 16512 + 512 * k] = (bf16)f2bf(st[k]); st[k] = wc * st[k] + wu * u[pp][k]; }
            m = mn; }
    }
}
DI void ss_scan_unit(Frame& F, int sq, int half) {
    const float* dec = WSP(float, WS_SSSC) + (size_t)sq * 36;
    const float* U = WSP(float, WS_SSU) + (size_t)sq * 36 * 8192 + half * 4096 + F.tid; bf16* S = WSP(bf16, WS_SSS) + (size_t)sq * 36 * 8192 + half * 4096 + F.tid;
    float st[8];
#pragma unroll
    for (int k = 0; k < 8; ++k) st[k] = 0.f;
    for (int pg = 0; pg < 36; pg += 12) {
        float u[12][8];
#pragma unroll
        for (int pp = 0; pp < 12; ++pp)
#pragma unroll
            for (int k = 0; k < 8; ++k) u[pp][k] = U[(size_t)(pg + pp) * 8192 + 512 * k];
#pragma unroll
        for (int pp = 0; pp < 12; ++pp) PIN8(u[pp]);
#pragma unroll
        for (int pp = 0; pp < 12; ++pp) { const int p = pg + pp; const float dc = dec[p];
#pragma unroll
            for (int k = 0; k < 8; ++k) { S[(size_t)p * 8192 + 512 * k] = (bf16)f2bf(st[k]); st[k] = st[k] * dc + u[pp][k]; } }
    }
}
DI void mla_post_unit(Frame& F, int l, int b, int tt) {
    const bf16* P = WSP(bf16, WS_P);
    const bf16* QRAW = WSP(bf16, WS_QRAW); const bf16* KVRAW = WSP(bf16, WS_KVRAW);
    const int j0 = tt * 32, lane = F.lane;
    LAS bf16* vs = (LAS bf16*)F.lds;
    const float* gq = F.in[22] + l * 192; const float* gk = F.in[23] + l * 192;
    unsigned qw[4][4][3], kw[4][4][2], vw[4][4][2], krw[4];
#pragma unroll
    for (int it = 0; it < 4; ++it) {
        const int row = rowof(b, j0 + F.wave + 8 * it);
        krw[it] = P[(size_t)row * DINP + PC_KR + lane];
#pragma unroll
        for (int h = 0; h < 4; ++h) { const bf16* q = QRAW + (size_t)row * 768 + h * 192; const bf16* kv = KVRAW + (size_t)row * 1024 + h * 256;
            qw[it][h][0] = q[lane]; qw[it][h][1] = q[64 + lane]; qw[it][h][2] = q[128 + lane];
            kw[it][h][0] = kv[lane]; kw[it][h][1] = kv[64 + lane]; vw[it][h][0] = kv[128 + lane]; vw[it][h][1] = kv[192 + lane]; }
    }
#pragma unroll
    for (int it = 0; it < 4; ++it) { PIN4(krw);
#pragma unroll
        for (int h = 0; h < 4; ++h) { PINV(qw[it][h][0]); PINV(qw[it][h][1]); PINV(qw[it][h][2]); PINV(kw[it][h][0]); PINV(kw[it][h][1]); PINV(vw[it][h][0]); PINV(vw[it][h][1]); } }
    float qv[4][4][3], kk[4][4][2], krv[4]; bf16 vv[4][4][2];
#pragma unroll
    for (int it = 0; it < 4; ++it) { krv[it] = bf2f(krw[it]);
#pragma unroll
        for (int h = 0; h < 4; ++h) { qv[it][h][0] = bf2f(qw[it][h][0]); qv[it][h][1] = bf2f(qw[it][h][1]); qv[it][h][2] = bf2f(qw[it][h][2]);
            kk[it][h][0] = bf2f(kw[it][h][0]); kk[it][h][1] = bf2f(kw[it][h][1]); vv[it][h][0] = (bf16)vw[it][h][0]; vv[it][h][1] = (bf16)vw[it][h][1]; } }
    const float gq0 = gq[lane], gq1 = gq[64 + lane], gq2 = gq[128 + lane], gk0 = gk[lane], gk1 = gk[64 + lane], gk2 = gk[128 + lane];
    const int a = lane & 31;
    const float fr = exp2f(-(float)(a & 15) * (13.287712379549449f / 16.f));
#pragma unroll
    for (int it = 0; it < 4; ++it) {
        const int i = F.wave + 8 * it, j = j0 + i; const bool lat = j < TL;
        const float pos = (float)(a < 16 ? (j >> 6) : (j & 63));
        const float ang = pos * fr; const float cs = __cosf(ang), sn = __sinf(ang);
#pragma unroll
        for (int h = 0; h < 4; ++h) {
            {
                const float v0 = qv[it][h][0], v1 = qv[it][h][1], v2 = qv[it][h][2];
                const float rstd = __builtin_amdgcn_rsqf(wave_sum(v0 * v0 + v1 * v1 + v2 * v2) * (1.f / 192.f) + EPS);
                const float n0 = v0 * rstd * gq0, n1 = v1 * rstd * gq1; float n2 = v2 * rstd * gq2;
                const float pr = xor32_get(n2, lane);
                if (lat) n2 = lane < 32 ? n2 * cs - pr * sn : pr * sn + n2 * cs;
                bf16* o = WSP(bf16, WS_QMLA) + ((size_t)(b * 4 + h) * TS + j) * 192;
                o[lane] = (bf16)f2bf(n0); o[64 + lane] = (bf16)f2bf(n1); o[128 + lane] = (bf16)f2bf(n2);
            }
            {
                const float v0 = kk[it][h][0], v1 = kk[it][h][1], v2 = krv[it];
                const float rstd = __builtin_amdgcn_rsqf(wave_sum(v0 * v0 + v1 * v1 + v2 * v2) * (1.f / 192.f) + EPS);
                const float n0 = v0 * rstd * gk0, n1 = v1 * rstd * gk1; float n2 = v2 * rstd * gk2;
                const float pr = xor32_get(n2, lane);
                if (lat) n2 = lane < 32 ? n2 * cs - pr * sn : pr * sn + n2 * cs;
                bf16* o = WSP(bf16, WS_KMLA) + ((size_t)(b * 4 + h) * TS + j) * 192;
                o[lane] = (bf16)f2bf(n0); o[64 + lane] = (bf16)f2bf(n1); o[128 + lane] = (bf16)f2bf(n2);
                vs[i * 520 + h * 128 + lane] = vv[it][h][0]; vs[i * 520 + h * 128 + 64 + lane] = vv[it][h][1];
            }
        }
    }
    __syncthreads();
    {
        const int t = F.tid; unsigned wv[16];
#pragma unroll
        for (int i = 0; i < 16; ++i) wv[i] = (unsigned)vs[(2 * i) * 520 + t] | ((unsigned)vs[(2 * i + 1) * 520 + t] << 16);
        u32x4* dst = (u32x4*)(WSP(bf16, WS_VTMLA) + ((size_t)(b * 4 + (t >> 7)) * 128 + (t & 127)) * TS + j0);
#pragma unroll
        for (int k = 0; k < 4; ++k) dst[k] = (u32x4){wv[4 * k], wv[4 * k + 1], wv[4 * k + 2], wv[4 * k + 3]};
    }
    __syncthreads();
}

template <int DK, bool NA>
DI void attn_unit(Frame& F, const bf16* Qg, const bf16* Kg, const bf16* VTg, int nA, int tA0, int nB, int tB0, float scale, bf16* Og, int qrow0, const float* rpb) {
    constexpr int KP = DK + 8, KCH = DK / 8, NKC = 64 * KCH / NTHR;
    LAS bf16* Ks = (LAS bf16*)F.lds;
    LAS bf16* VTs = (LAS bf16*)(F.lds + 64 * KP * 2);
    LAS bf16* Ps = (LAS bf16*)(F.lds + 64 * KP * 2 + 128 * 72 * 2) + F.wave * (16 * 72);
    LAS float* rp = (LAS float*)(F.lds + 64 * KP * 2 + 128 * 72 * 2 + 8 * 16 * 72 * 2);
    const int lane = F.lane, r = lane & 15, q = lane >> 4, tid = F.tid, w = F.wave;
    if (NA) { for (int i = tid; i < 15 * 31; i += NTHR) rp[i] = rpb[i]; }
    bf16x8 qf[DK / 32];
#pragma unroll
    for (int kk = 0; kk < DK / 32; ++kk) qf[kk] = *(const bf16x8*)(Qg + (size_t)(w * 16 + r) * DK + 32 * kk + 8 * q);
    f32x4 o[8]; float mrow[4], lrow[4];
#pragma unroll
    for (int d = 0; d < 8; ++d) o[d] = (f32x4){0.f, 0.f, 0.f, 0.f};
#pragma unroll
    for (int i = 0; i < 4; ++i) { mrow[i] = -1.0e30f; lrow[i] = 0.f; }
    const int ntile = nA + nB;
    u32x4 kreg[NKC], vreg[2];
    const int rq = qrow0 + (w >> 2);
    const int r0 = rq - 4 < 0 ? 0 : (rq - 4 > 24 ? 24 : rq - 4);
#define ATT_LOAD(kt) do { _Pragma("unroll") for (int c = 0; c < NKC; ++c) { const int id = tid + NTHR * c, rr = id / KCH, cc = id % KCH; kreg[c] = *(const u32x4*)(Kg + (size_t)((kt) * 64 + rr) * DK + cc * 8); } \
        _Pragma("unroll") for (int c = 0; c < 2; ++c) { const int id = tid + NTHR * c, dd = id >> 3, cc = id & 7; vreg[c] = *(const u32x4*)(VTg + (size_t)dd * TS + (kt) * 64 + cc * 8); } } while (0)
    ATT_LOAD(nA > 0 ? tA0 : tB0);
    for (int it = 0; it < ntile; ++it) {
        const int kt = it < nA ? tA0 + it : tB0 + (it - nA);
        __syncthreads();
#pragma unroll
        for (int c = 0; c < NKC; ++c) { const int id = tid + NTHR * c, rr = id / KCH, cc = id % KCH; *(LAS u32x4*)(Ks + rr * KP + cc * 8) = kreg[c]; }
#pragma unroll
        for (int c = 0; c < 2; ++c) { const int id = tid + NTHR * c, dd = id >> 3, cc = id & 7; *(LAS u32x4*)(VTs + dd * 72 + cc * 8) = vreg[c]; }
        __syncthreads();
        if (it + 1 < ntile) { const int kn = (it + 1) < nA ? tA0 + it + 1 : tB0 + (it + 1 - nA); ATT_LOAD(kn); }
        const bool nbt = NA && kt < 32;
        if (nbt && (kt < r0 || kt >= r0 + 8)) continue;
        f32x4 s[4];
#pragma unroll
        for (int n = 0; n < 4; ++n) s[n] = (f32x4){0.f, 0.f, 0.f, 0.f};
#pragma unroll
        for (int kk = 0; kk < DK / 32; ++kk)
#pragma unroll
            for (int n = 0; n < 4; ++n) { const bf16x8 kf = *(const LAS bf16x8*)(Ks + (n * 16 + r) * KP + 32 * kk + 8 * q); s[n] = __builtin_amdgcn_mfma_f32_16x16x32_bf16(qf[kk], kf, s[n], 0, 0, 0); }
        float mx[4];
#pragma unroll
        for (int i = 0; i < 4; ++i) mx[i] = -1.0e30f;
#pragma unroll
        for (int n = 0; n < 4; ++n)
#pragma unroll
            for (int i = 0; i < 4; ++i) {
                float v = s[n][i] * scale;
                if (nbt) { const int c = (w & 3) * 16 + 4 * q + i, kc = n * 16 + r; const int c0 = c - 8 < 0 ? 0 : (c - 8 > 48 ? 48 : c - 8);
                    v = (kc >= c0 && kc < c0 + 16) ? v + rp[(kt - rq + 7) * 31 + (kc - c + 15)] : -1.0e30f; }
                s[n][i] = v; mx[i] = fmaxf(mx[i], v);
            }
        float alpha[4], rs[4];
#pragma unroll
        for (int i = 0; i < 4; ++i) {
            float m = mx[i]; m = fmaxf(m, __shfl_xor(m, 1)); m = fmaxf(m, __shfl_xor(m, 2)); m = fmaxf(m, __shfl_xor(m, 4)); m = fmaxf(m, __shfl_xor(m, 8));
            const float mn = fmaxf(mrow[i], m); alpha[i] = __expf(mrow[i] - mn); mrow[i] = mn; rs[i] = 0.f;
        }
#pragma unroll
        for (int n = 0; n < 4; ++n)
#pragma unroll
            for (int i = 0; i < 4; ++i) { const float pv = __expf(s[n][i] - mrow[i]); rs[i] += pv; Ps[(4 * q + i) * 72 + n * 16 + r] = (bf16)f2bf(pv); }
#pragma unroll
        for (int i = 0; i < 4; ++i) {
            float t = rs[i]; t += __shfl_xor(t, 1); t += __shfl_xor(t, 2); t += __shfl_xor(t, 4); t += __shfl_xor(t, 8);
            lrow[i] = lrow[i] * alpha[i] + t;
        }
#pragma unroll
        for (int d = 0; d < 8; ++d)
#pragma unroll
            for (int i = 0; i < 4; ++i) o[d][i] *= alpha[i];
        asm volatile("s_waitcnt lgkmcnt(0)" ::: "memory");
#pragma unroll
        for (int kk = 0; kk < 2; ++kk) { const bf16x8 pf = *(const LAS bf16x8*)(Ps + r * 72 + 32 * kk + 8 * q);
#pragma unroll
            for (int d = 0; d < 8; ++d) { const bf16x8 vf = *(const LAS bf16x8*)(VTs + (d * 16 + r) * 72 + 32 * kk + 8 * q); o[d] = __builtin_amdgcn_mfma_f32_16x16x32_bf16(pf, vf, o[d], 0, 0, 0); } }
    }
#undef ATT_LOAD
#pragma unroll
    for (int i = 0; i < 4; ++i) { const float inv = 1.0f / lrow[i]; bf16* op = Og + (size_t)(w * 16 + 4 * q + i) * D + r;
#pragma unroll
        for (int d = 0; d < 8; ++d) op[d * 16] = (bf16)f2bf(o[d][i] * inv); }
    __syncthreads();
}
typedef float f32x16 __attribute__((ext_vector_type(16)));
typedef short s16x4 __attribute__((ext_vector_type(4)));
template <int DK, bool NA>
DI void attn_unit2(Frame& F, const bf16* Qg, const bf16* Kg, const bf16* VTg, int nA, int tA0, int nB, int tB0, float sc2, bf16* Og, int qrow0, const float* rpb) {
    constexpr int KP = DK + 8, KCH = DK / 8, NKC = 64 * KCH / NTHR, NKK = DK / 16;
    constexpr int KTB = 64 * KP * 2, VTB = 128 * 72 * 2, BUFB = KTB + VTB;
    const int lane = F.lane, l32 = lane & 31, h = lane >> 5, tid = F.tid, w = F.wave, g = w & 3, kp = w >> 2;
    LAS float* rp = (LAS float*)(F.lds + 2 * BUFB);
    if (NA) { for (int i = tid; i < 15 * 31; i += NTHR) rp[i] = rpb[i] * 1.4426950408889634f; }
    bf16x8 qf[NKK];
#pragma unroll
    for (int kk = 0; kk < NKK; ++kk) qf[kk] = *(const bf16x8*)(Qg + (size_t)(32 * g + l32) * DK + 16 * kk + 8 * h);
    f32x16 o[4]; float mrun = -1.0e30f, lrun = 0.f;
#pragma unroll
    for (int d = 0; d < 4; ++d)
#pragma unroll
        for (int i = 0; i < 16; ++i) o[d][i] = 0.f;
    const int ntile = nA + nB;
    const int rq = qrow0 + (g >> 1), r0 = rq - 4 < 0 ? 0 : (rq - 4 > 24 ? 24 : rq - 4);
    const int cq = 32 * (g & 1) + l32, c0 = cq - 8 < 0 ? 0 : (cq - 8 > 48 ? 48 : cq - 8);
    u32x4 kreg[NKC], vreg[2];
#define ATT2_TILE(it) ((it) < nA ? tA0 + (it) : tB0 + ((it) - nA))
#define ATT2_LOAD(it) do { const int kt_ = ATT2_TILE(it); \
        _Pragma("unroll") for (int c = 0; c < NKC; ++c) { const int id = tid + NTHR * c, rr = id / KCH, cc = id % KCH; kreg[c] = *(const u32x4*)(Kg + (size_t)(kt_ * 64 + rr) * DK + cc * 8); } \
        _Pragma("unroll") for (int c = 0; c < 2; ++c) { const int id = tid + NTHR * c, dd = id >> 3, cc = id & 7; vreg[c] = *(const u32x4*)(VTg + (size_t)dd * TS + kt_ * 64 + cc * 8); } } while (0)
#define ATT2_STORE(b) do { \
        _Pragma("unroll") for (int c = 0; c < NKC; ++c) { const int id = tid + NTHR * c, rr = id / KCH, cc = id % KCH; *(LAS u32x4*)(F.lds + (b) * BUFB + (rr * KP + cc * 8) * 2) = kreg[c]; } \
        _Pragma("unroll") for (int c = 0; c < 2; ++c) { const int id = tid + NTHR * c, dd = id >> 3, cc = id & 7; *(LAS u32x4*)(F.lds + (b) * BUFB + KTB + (dd * 72 + cc * 8) * 2) = vreg[c]; } } while (0)
    ATT2_LOAD(0); ATT2_STORE(0);
    __syncthreads();
    for (int st = 0; st < ntile; ++st) {
        if (st + 1 < ntile) ATT2_LOAD(st + 1);
        const int kt = ATT2_TILE(st);
        const bool nbt = NA && kt < 32;
        if (!(nbt && (kt < r0 || kt >= r0 + 8))) {
            const LAS bf16* Ks = (const LAS bf16*)(F.lds + (st & 1) * BUFB) + (kp * 32 + l32) * KP + 8 * h;
            const LAS bf16* VTs = (const LAS bf16*)(F.lds + (st & 1) * BUFB + KTB) + l32 * 72 + kp * 32 + 4 * h;
            f32x16 s;
#pragma unroll
            for (int i = 0; i < 16; ++i) s[i] = 0.f;
#pragma unroll
            for (int kk = 0; kk < NKK; ++kk) { const bf16x8 kf = *(const LAS bf16x8*)(Ks + 16 * kk); s = __builtin_amdgcn_mfma_f32_32x32x16_bf16(kf, qf[kk], s, 0, 0, 0); }
            float mx = -1.0e30f, mn, alpha, rs = 0.f;
            if (nbt) {
#pragma unroll
                for (int i = 0; i < 16; ++i) {
                    float v = s[i] * sc2;
                    const int kc = kp * 32 + 8 * (i >> 2) + 4 * h + (i & 3); v = (kc >= c0 && kc < c0 + 16) ? v + rp[(kt - rq + 7) * 31 + (kc - cq + 15)] : -1.0e30f;
                    s[i] = v; mx = fmaxf(mx, v);
                }
                mx = xor32_max(mx);
                mn = fmaxf(mrun, mx); alpha = __builtin_amdgcn_exp2f(mrun - mn); mrun = mn;
#pragma unroll
                for (int i = 0; i < 16; ++i) { const float pv = __builtin_amdgcn_exp2f(s[i] - mn); s[i] = pv; rs += pv; }
            } else {
#pragma unroll
                for (int i = 0; i < 16; ++i) mx = fmaxf(mx, s[i]);
                mx = xor32_max(mx) * sc2;
                mn = fmaxf(mrun, mx); alpha = __builtin_amdgcn_exp2f(mrun - mn); mrun = mn;
#pragma unroll
                for (int i = 0; i < 16; ++i) { const float pv = __builtin_amdgcn_exp2f(fmaf(s[i], sc2, -mn)); s[i] = pv; rs += pv; }
            }
            rs = xor32_sum(rs);
            lrun = lrun * alpha + rs;
            if (__any(alpha != 1.0f)) {
#pragma unroll
                for (int d = 0; d < 4; ++d)
#pragma unroll
                    for (int i = 0; i < 16; ++i) o[d][i] *= alpha;
            }
#pragma unroll
            for (int sp = 0; sp < 2; ++sp) {
                u32x4 pw; pw.x = pg8::cvt_pk_bf16(s[8 * sp + 0], s[8 * sp + 1]); pw.y = pg8::cvt_pk_bf16(s[8 * sp + 2], s[8 * sp + 3]);
                pw.z = pg8::cvt_pk_bf16(s[8 * sp + 4], s[8 * sp + 5]); pw.w = pg8::cvt_pk_bf16(s[8 * sp + 6], s[8 * sp + 7]);
                const bf16x8 pf = __builtin_bit_cast(bf16x8, pw);
#pragma unroll
                for (int d = 0; d < 4; ++d) { const LAS bf16* vp = VTs + d * 32 * 72 + 16 * sp;
                    const u32x2 lo = *(const LAS u32x2*)vp, hi = *(const LAS u32x2*)(vp + 8);
                    const u32x4 vv = (u32x4){lo.x, lo.y, hi.x, hi.y};
                    o[d] = __builtin_amdgcn_mfma_f32_32x32x16_bf16(__builtin_bit_cast(bf16x8, vv), pf, o[d], 0, 0, 0); }
            }
        }
        if (st + 1 < ntile) ATT2_STORE((st + 1) & 1);
        __syncthreads();
    }
#undef ATT2_LOAD
#undef ATT2_STORE
#undef ATT2_TILE
    LAS float* ob = (LAS float*)F.lds + g * (66 * 64);
    if (kp == 1) {
#pragma unroll
        for (int d = 0; d < 4; ++d)
#pragma unroll
            for (int i = 0; i < 16; ++i) ob[(d * 16 + i) * 64 + lane] = o[d][i];
        ob[64 * 64 + lane] = mrun; ob[65 * 64 + lane] = lrun;
    }
    __syncthreads();
    if (kp == 0) {
        const float m1 = ob[64 * 64 + lane], l1 = ob[65 * 64 + lane];
        const float mf = fmaxf(mrun, m1), a0 = __builtin_amdgcn_exp2f(mrun - mf), a1 = __builtin_amdgcn_exp2f(m1 - mf);
        const float inv = 1.0f / (lrun * a0 + l1 * a1);
        bf16* op = Og + (size_t)(32 * g + l32) * D + 4 * h;
#pragma unroll
        for (int d = 0; d < 4; ++d)
#pragma unroll
            for (int i4 = 0; i4 < 4; ++i4) {
                float r[4];
#pragma unroll
                for (int j = 0; j < 4; ++j) r[j] = (o[d][4 * i4 + j] * a0 + ob[(d * 16 + 4 * i4 + j) * 64 + lane] * a1) * inv;
                u32x2 wv; wv.x = pk2(r[0], r[1]); wv.y = pk2(r[2], r[3]);
                *(u32x2*)(op + d * 32 + 8 * i4) = wv;
            }
    }
    __syncthreads();
}
DI void ml_c_unit(Frame& F, int seq, int p) {
    const int b = seq >> 3, h = (seq >> 1) & 3, dir = seq & 1, tc = tc_of(dir, p), lane = F.lane, tid = F.tid;
    const bf16* P = WSP(bf16, WS_P);
    constexpr float QS = 0.08838834764831845f;
    LAS bf16* Qs = (LAS bf16*)F.lds;
    LAS bf16* Ksm = (LAS bf16*)(F.lds + 17408);
    LAS bf16* VT = (LAS bf16*)(F.lds + 34816);
    LAS bf16* Cx = (LAS bf16*)(F.lds + 55552);
    LAS bf16* SW = (LAS bf16*)(F.lds + 94720);
    LAS float* av = (LAS float*)(F.lds + 103936);
    LAS float* Mt = av + 64;
    LAS float* Bt = av + 128;
    LAS float* den = av + 192;
    const float m_p = WSP(float, WS_MLSC)[(size_t)(seq * 36 + p) * 4 + 2];
    if (F.wave == 0) {
        const int row = rowof(b, tc * 64 + lane);
        const float* gt = WSP(float, WS_GATES) + (size_t)row * 16;
        const float li = gt[dir * 4 + h], lf = gt[8 + dir * 4 + h];
        const float pre = wave_incl_scan(lf, lane), tot = lane_bcast(pre, 63);
        const float B = dir == 0 ? pre : (tot - pre) + lf;
        const float a = li - B;
        const float cm = dir == 0 ? wave_prefix_max(a, lane) : wave_suffix_max(a, lane);
        av[lane] = a; Mt[lane] = fmaxf(m_p, cm); Bt[lane] = B;
    }
    {
        u32x4 qv[2], kv[2]; unsigned vv[16]; u32x4 cx[5];
        const bf16* Sg = WSP(bf16, WS_MLS) + (size_t)(seq * 36 + p) * 16512;
#pragma unroll
        for (int it = 0; it < 2; ++it) { const int idx = tid + NTHR * it, n = idx >> 4, cc = idx & 15;
            const bf16* pr = P + (size_t)rowof(b, tc * 64 + n) * DINP + h * 128 + cc * 8; qv[it] = *(const u32x4*)(pr + PC_MLQ); kv[it] = *(const u32x4*)(pr + PC_MLK); }
#pragma unroll
        for (int it = 0; it < 16; ++it) { const int idx = tid + NTHR * it, n = idx >> 7, d = idx & 127; vv[it] = P[(size_t)rowof(b, tc * 64 + n) * DINP + PC_MLV + h * 128 + d]; }
#pragma unroll
        for (int it = 0; it < 5; ++it) { const int idx = tid + NTHR * it, rr = idx >> 4, cc = idx & 15; cx[it] = (idx < 144 * 16 && rr < 129) ? *(const u32x4*)(Sg + rr * 128 + cc * 8) : (u32x4){0u, 0u, 0u, 0u}; }
        PINV(qv[0]); PINV(qv[1]); PINV(kv[0]); PINV(kv[1]); PIN8(vv); PIN8(vv + 8); PINV(cx[0]); PINV(cx[1]); PINV(cx[2]); PINV(cx[3]); PINV(cx[4]);
#pragma unroll
        for (int it = 0; it < 2; ++it) { const int idx = tid + NTHR * it, n = idx >> 4, cc = idx & 15; *(LAS u32x4*)(Qs + n * 136 + cc * 8) = qv[it]; *(LAS u32x4*)(Ksm + n * 136 + cc * 8) = kv[it]; }
#pragma unroll
        for (int it = 0; it < 16; ++it) { const int idx = tid + NTHR * it, n = idx >> 7, d = idx & 127; VT[d * 72 + n] = (bf16)vv[it]; }
#pragma unroll
        for (int it = 0; it < 5; ++it) { const int idx = tid + NTHR * it, rr = idx >> 4, cc = idx & 15; if (idx < 144 * 16) *(LAS u32x4*)(Cx + rr * 136 + cc * 8) = cx[it]; }
    }
    for (int idx = tid; idx < 16 * 64; idx += NTHR) { const int rr = idx >> 6, n = idx & 63; VT[(128 + rr) * 72 + n] = rr == 0 ? (bf16)0x3f80 : (bf16)0; }
    __syncthreads();
    for (int id = F.wave; id < 16; id += 8) { const int tt = id >> 2, st = id & 3;
        const bool skip = dir == 0 ? st > tt : st < tt;
        f32x4 acc = (f32x4){0.f, 0.f, 0.f, 0.f};
        if (!skip) acc = mma16<128>(Qs + tt * 16 * 136, 136, Ksm + st * 16 * 136, 136, lane, acc);
        const int s = st * 16 + (lane & 15); const float as = av[s];
#pragma unroll
        for (int i = 0; i < 4; ++i) { const int t = tt * 16 + 4 * (lane >> 4) + i; const bool ok = !skip && (dir == 0 ? s <= t : s >= t);
            SW[t * 72 + s] = (bf16)f2bf(ok ? acc[i] * QS * __expf(as - Mt[t]) : 0.f); } }
    __syncthreads();
    const int tt = F.wave & 3, d0 = F.wave < 4 ? 0 : 5, nd = F.wave < 4 ? 5 : 4;
    f32x4 val[5];
#pragma unroll
    for (int k = 0; k < 5; ++k) { val[k] = (f32x4){0.f, 0.f, 0.f, 0.f};
        if (k < nd) { const int dt = d0 + k;
            const f32x4 a1 = mma16<64>(SW + tt * 16 * 72, 72, VT + dt * 16 * 72, 72, lane, (f32x4){0.f, 0.f, 0.f, 0.f});
            const f32x4 a2 = mma16<128>(Qs + tt * 16 * 136, 136, Cx + dt * 16 * 136, 136, lane, (f32x4){0.f, 0.f, 0.f, 0.f});
#pragma unroll
            for (int i = 0; i < 4; ++i) { const int t = tt * 16 + 4 * (lane >> 4) + i; val[k][i] = a1[i] + a2[i] * QS * __expf(m_p - Mt[t]); }
            if (dt == 8 && (lane & 15) == 0) {
#pragma unroll
                for (int i = 0; i < 4; ++i) den[tt * 16 + 4 * (lane >> 4) + i] = val[k][i]; } } }
    __syncthreads();
    float* H = WSP(float, WS_HML) + (size_t)dir * MTOK * 512;
#pragma unroll
    for (int k = 0; k < 5; ++k) { const int dt = d0 + k; if (k < nd && dt < 8) {
#pragma unroll
        for (int i = 0; i < 4; ++i) { const int t = tt * 16 + 4 * (lane >> 4) + i;
            const float dn = fmaxf(fabsf(den[t]), __expf(-(Bt[t] + Mt[t])));
            H[(size_t)rowof(b, tc * 64 + t) * 512 + h * 128 + dt * 16 + (lane & 15)] = val[k][i] * __builtin_amdgcn_rcpf(dn); } } }
    __syncthreads();
}

DI void ss_c_unit(Frame& F, int l, int sq, int p) {
    const int b = sq >> 4, h = (sq >> 1) & 7, dir = sq & 1, g = h >> 2, tc = tc_of(dir, p), lane = F.lane, tid = F.tid;
    const bf16* XBC = WSP(bf16, WS_XBC);
    LAS bf16* Cm = (LAS bf16*)F.lds;
    LAS bf16* Bm = (LAS bf16*)(F.lds + 17408);
    LAS bf16* XT = (LAS bf16*)(F.lds + 34816);
    LAS bf16* Sx = (LAS bf16*)(F.lds + 44032);
    LAS bf16* W = (LAS bf16*)(F.lds + 61440);
    LAS float* cum = (LAS float*)(F.lds + 70656);
    LAS float* dtv = cum + 64;
    if (F.wave == 0) {
        const int row = rowof(b, tc * 64 + lane);
        const float dt = WSP(float, WS_DT)[(size_t)row * 16 + dir * 8 + h];
        const float A = -__expf(F.in[15][l * 16 + dir * 8 + h]);
        const float a = dt * A, pre = wave_incl_scan(a, lane), tot = lane_bcast(pre, 63);
        cum[lane] = dir == 0 ? pre : (tot - pre) + a; dtv[lane] = dt;
    }
    {
        u32x4 bb[2], cc_[2], sx[2]; unsigned xx[8];
        const bf16* Sg = WSP(bf16, WS_SSS) + (size_t)(sq * 36 + p) * 8192;
#pragma unroll
        for (int it = 0; it < 2; ++it) { const int idx = tid + NTHR * it, n = idx >> 4, cc = idx & 15; const bf16* xr = XBC + (size_t)rowof(b, tc * 64 + n) * 1024;
            bb[it] = *(const u32x4*)(xr + 512 + g * 128 + cc * 8); cc_[it] = *(const u32x4*)(xr + 768 + g * 128 + cc * 8); sx[it] = *(const u32x4*)(Sg + n * 128 + cc * 8); }
#pragma unroll
        for (int it = 0; it < 8; ++it) { const int idx = tid + NTHR * it, n = idx >> 6, pp = idx & 63; xx[it] = XBC[(size_t)rowof(b, tc * 64 + n) * 1024 + h * 64 + pp]; }
        PINV(bb[0]); PINV(bb[1]); PINV(cc_[0]); PINV(cc_[1]); PINV(sx[0]); PINV(sx[1]); PIN8(xx);
#pragma unroll
        for (int it = 0; it < 2; ++it) { const int idx = tid + NTHR * it, n = idx >> 4, cc = idx & 15;
            *(LAS u32x4*)(Bm + n * 136 + cc * 8) = bb[it]; *(LAS u32x4*)(Cm + n * 136 + cc * 8) = cc_[it]; *(LAS u32x4*)(Sx + n * 136 + cc * 8) = sx[it]; }
#pragma unroll
        for (int it = 0; it < 8; ++it) { const int idx = tid + NTHR * it, n = idx >> 6, pp = idx & 63; XT[pp * 72 + n] = (bf16)xx[it]; }
    }
    __syncthreads();
    for (int id = F.wave; id < 16; id += 8) { const int tt = id >> 2, st = id & 3;
        const bool skip = dir == 0 ? st > tt : st < tt;
        f32x4 acc = (f32x4){0.f, 0.f, 0.f, 0.f};
        if (!skip) acc = mma16<128>(Cm + tt * 16 * 136, 136, Bm + st * 16 * 136, 136, lane, acc);
        const int s = st * 16 + (lane & 15); const float cs = cum[s], ds = dtv[s];
#pragma unroll
        for (int i = 0; i < 4; ++i) { const int t = tt * 16 + 4 * (lane >> 4) + i; const bool ok = !skip && (dir == 0 ? s <= t : s >= t);
            W[t * 72 + s] = (bf16)f2bf(ok ? acc[i] * __expf(cum[t] - cs) * ds : 0.f); } }
    __syncthreads();
    float* Y = WSP(float, WS_YSS) + (size_t)dir * MTOK * 512;
    for (int id = F.wave; id < 16; id += 8) { const int tt = id >> 2, pt = id & 3;
        const f32x4 a1 = mma16<64>(W + tt * 16 * 72, 72, XT + pt * 16 * 72, 72, lane, (f32x4){0.f, 0.f, 0.f, 0.f});
        const f32x4 a2 = mma16<128>(Cm + tt * 16 * 136, 136, Sx + pt * 16 * 136, 136, lane, (f32x4){0.f, 0.f, 0.f, 0.f});
#pragma unroll
        for (int i = 0; i < 4; ++i) { const int t = tt * 16 + 4 * (lane >> 4) + i;
            Y[(size_t)rowof(b, tc * 64 + t) * 512 + h * 64 + pt * 16 + (lane & 15)] = a1[i] + a2[i] * __expf(cum[t]); } }
    __syncthreads();
}

DI void m5_finish_phase(Frame& F, int l, int nrows) {
    const int gw = F.bid * NWAVES + F.wave, NGW = F.G * NWAVES, lane = F.lane;
    const bf16* P = WSP(bf16, WS_P); const float* H0 = WSP(float, WS_HML); const float* H1 = H0 + (size_t)MTOK * 512;
    const float* Y0 = WSP(float, WS_YSS); const float* Y1 = Y0 + (size_t)MTOK * 512; const bf16* XBC = WSP(bf16, WS_XBC);
    bf16* A2 = WSP(bf16, WS_A2);
    float gn[8], sn[8], dsk[8];
#pragma unroll
    for (int u = 0; u < 8; ++u) { gn[u] = F.in[11][l * 512 + lane + 64 * u]; sn[u] = F.in[17][l * 512 + lane + 64 * u]; dsk[u] = F.in[16][l * 8 + u]; }
    for (int row = gw; row < nrows; row += NGW) {
        const bf16* p = P + (size_t)row * DINP;
        float h0[8], h1[8], y0[8], y1[8], hv[8], ov[8], yv[8], zv[8]; unsigned ow[8], zw[8], xw[8];
#pragma unroll
        for (int u = 0; u < 8; ++u) { const int c = lane + 64 * u;
            h0[u] = H0[(size_t)row * 512 + c]; h1[u] = H1[(size_t)row * 512 + c]; y0[u] = Y0[(size_t)row * 512 + c]; y1[u] = Y1[(size_t)row * 512 + c];
            ow[u] = p[PC_MLO + c]; zw[u] = p[PC_Z + c]; xw[u] = XBC[(size_t)row * 1024 + c]; }
        PIN8(h0); PIN8(h1); PIN8(y0); PIN8(y1); PIN8(ow); PIN8(zw); PIN8(xw);
        bf16 xv[8];
#pragma unroll
        for (int u = 0; u < 8; ++u) { hv[u] = h0[u] + h1[u]; yv[u] = y0[u] + y1[u]; ov[u] = bf2f(ow[u]); zv[u] = bf2f(zw[u]); xv[u] = (bf16)xw[u]; }
#pragma unroll
        for (int h = 0; h < 4; ++h) {
            const float v0 = hv[2 * h], v1 = hv[2 * h + 1]; const int c0 = h * 128 + lane, c1 = c0 + 64;
            const float rstd = __builtin_amdgcn_rsqf(wave_sum(v0 * v0 + v1 * v1) * (1.f / 128.f) + EPS);
            A2[(size_t)row * D + c0] = (bf16)f2bf(v0 * rstd * gn[2 * h] * sigmoidf_(ov[2 * h]));
            A2[(size_t)row * D + c1] = (bf16)f2bf(v1 * rstd * gn[2 * h + 1] * sigmoidf_(ov[2 * h + 1]));
        }
        float y[8]; float ss = 0.f;
#pragma unroll
        for (int u = 0; u < 8; ++u) { float v = yv[u] + dsk[u] * bf2f(xv[u]); v *= siluf(zv[u]); y[u] = v; ss += v * v; }
        const float rstd = __builtin_amdgcn_rsqf(wave_sum(ss) * (1.f / 512.f) + EPS);
#pragma unroll
        for (int u = 0; u < 8; ++u) { const int c = lane + 64 * u; A2[(size_t)row * D + 512 + c] = (bf16)f2bf(y[u] * rstd * sn[u]); }
    }
}
#ifndef PROBE_MASK
#define PROBE_MASK 0ull
#endif
#define NREP(k) ((((unsigned long long)(PROBE_MASK) >> (k)) & 1ull) ? 2 : 1)
#ifndef UNIT_REP
#define UNIT_REP 0
#endif
#define UREP(i) for (int rp_ = 0; rp_ <= ((F.rep >> (i)) & 1); ++rp_)
#ifndef ONE_LAUNCH
#define ONE_LAUNCH 1
#endif
#ifndef TPROBE_MASK
#define TPROBE_MASK 0ull
#endif
#ifndef TPROBE_AMP
#define TPROBE_AMP 8
#endif
#define TPB(k) do { if (((unsigned long long)(TPROBE_MASK) >> (k)) & 1ull) { if (F.bid == 0 && F.tid == 0) { volatile LAS unsigned long long* tp_ = (volatile LAS unsigned long long*)(F.lds + MISC_OFF + 128); tp_[0] = wall_clock64(); } } } while (0)
#define TPE(k) do { if (((unsigned long long)(TPROBE_MASK) >> (k)) & 1ull) { if (F.bid == 0 && F.tid == 0) { volatile LAS unsigned long long* tp_ = (volatile LAS unsigned long long*)(F.lds + MISC_OFF + 128); tp_[1] += wall_clock64() - tp_[0]; } } } while (0)
#define IN(k) (lo <= (k) && (k) < hi)
#define SEAM(k) do { if (ONE_LAUNCH && hi > (k) + 1) xcd_barrier(bar); } while (0)
#ifndef FILL_MASK
#define FILL_MASK 0x7fffffffull
#endif
#define FILL(k, work) do { if (ONE_LAUNCH) conv_fill(F, (k), (work)); } while (0)
#define FILL1(k, work) do { if (ONE_LAUNCH) conv_fill(F, (k), (work), 1); } while (0)
#ifndef NCV_M1
#define NCV_M1 0
#define NCV_M2 0
#endif
#ifndef NCV_P
#define NCV_P 48
#define NCV_OUT 112
#define NCV_UP 24
#define NCV_DOWN 112
#endif
template <int l> DI void layer_phases(Frame& F, const XcdBarrier& bar, const int lo, const int hi) {
    LAS int* mtb = (LAS int*)(F.lds + RING_BYTES);
        const int pb = 1 + 16 * l;
        const bool wc = (l == 0);
        const int nrows = wc ? MTOK : MLAT;
        const float* modl = WSP(float, WS_MOD) + (size_t)l * 5 * D6;
        if (IN(pb + 0)) { TPB(pb + 0);
            if (l == 0) norm_phase<false>(F, l, F.in[0], F.in[2], F.in[6] + l * D, 0, MTOK);
            else norm_phase<false>(F, l, WSP(float, WS_X), WSP(float, WS_X) + (size_t)MLAT * D, F.in[6] + l * D, 0, MTOK);
            if (l == 1) conv_drain(F, CV_NQ1 - CV_EAGER); SEAM(pb + 0); TPE(pb + 0);
        }
        if (IN(pb + 1)) { TPB(pb + 1);
            const int ncv = ONE_LAUNCH ? NCV_P : 0, gw_ = F.G - ncv;
            if (F.bid < gw_) { pg8::Gemm g{WSP(bf16, WS_HN), WSP(bf16, WS_WIN) + (size_t)l * DINP * D, D, D}; pg8::StaticOrder S; S.init(MTOK / 256, DINP / 256, gw_, F.bid);
                EpiP E{WSP(bf16, WS_P), WSP(float, WS_GRAW)};
                pg8::gemm_phase<EpiP, pg8::StaticOrder>(F.lds, g, S, E); }
            FILL(pb + 1, F.bid >= gw_);
            SEAM(pb + 1); TPE(pb + 1);
        }
        if (IN(pb + 2)) { TPB(pb + 2);
            { const int ncv = ONE_LAUNCH ? NCV_M1 : 0, gw_ = F.G - ncv;
              if (F.bid < gw_) for (int u = F.bid; u < NB * 72; u += gw_) m1_prep_unit(F, l, u / 72, u % 72);
              if (ncv) FILL1(pb + 2, F.bid >= gw_); }
            SEAM(pb + 2); TPE(pb + 2);
        }
        if (IN(pb + 3)) { TPB(pb + 3);
            { const int ncv = ONE_LAUNCH ? NCV_M2 : 0, gw_ = F.G - ncv;
              if (F.bid < gw_) {
                { pg8::Gemm g{WSP(bf16, WS_CQN), WSP(bf16, WS_WQB) + (size_t)l * 768 * 512, 512, 512}; pg8::StaticOrder S; S.init(MTOK / 256, 3, gw_, F.bid);
                  EpiBf16 E{WSP(bf16, WS_QRAW), 768}; pg8::gemm_phase<EpiBf16, pg8::StaticOrder>(F.lds, g, S, E); }
                __syncthreads();
                { pg8::Gemm g{WSP(bf16, WS_CKVN), WSP(bf16, WS_WKVB) + (size_t)l * 1024 * 256, 256, 256}; pg8::StaticOrder S; S.init(MTOK / 256, 4, gw_, (F.bid + 128) % gw_);
                  EpiBf16 E{WSP(bf16, WS_KVRAW), 1024}; pg8::gemm_phase<EpiBf16, pg8::StaticOrder>(F.lds, g, S, E); }
                __syncthreads();
                UREP(2) for (int u = F.bid; u < 1152; u += gw_) ml_a_unit(F, u / 36, u % 36);
                UREP(3) for (int v = (F.bid + 128) % gw_; v < 576; v += gw_) ss_a_unit(F, l, v / 144, (v / 72) & 1, (v % 72) >> 1, v & 1);
              }
              if (ncv) FILL1(pb + 3, F.bid >= gw_); }
            SEAM(pb + 3); TPE(pb + 3);
        }
        if (IN(pb + 4)) { TPB(pb + 4);
            UREP(4) for (int u = F.bid; u < 256; u += F.G) {
                const int bh = u >> 4, qb = u & 15, b = bh >> 2, h = bh & 3;
                const int r0a = 2 * qb - 4 < 0 ? 0 : (2 * qb - 4 > 24 ? 24 : 2 * qb - 4), r0b = 2 * qb - 3 < 0 ? 0 : (2 * qb - 3 > 24 ? 24 : 2 * qb - 3);
                attn_unit2<128, true>(F, WSP(bf16, WS_QNA) + ((size_t)bh * TS + qb * 128) * 128, WSP(bf16, WS_KNA) + (size_t)bh * TS * 128, WSP(bf16, WS_VTNA) + (size_t)bh * 128 * TS,
                                     4, 32, r0b + 8 - r0a, r0a, 0.12751743082459868f,
                                     WSP(bf16, WS_A2) + (size_t)(b * TL + qb * 128) * D + 1536 + h * 128, 2 * qb, F.in[26] + (size_t)(l * 4 + h) * 15 * 31);
            }
            if (wc) UREP(5) for (int v = F.bid; v < 32; v += F.G) {
                const int bh2 = v >> 1, qc = v & 1, b2 = bh2 >> 2, h2 = bh2 & 3;
                attn_unit2<128, false>(F, WSP(bf16, WS_QNA) + ((size_t)bh2 * TS + TL + qc * 128) * 128, WSP(bf16, WS_KNA) + (size_t)bh2 * TS * 128, WSP(bf16, WS_VTNA) + (size_t)bh2 * 128 * TS,
                                      4, 32, 0, 0, 0.12751743082459868f, WSP(bf16, WS_A2) + (size_t)(MLAT + b2 * TC + qc * 128) * D + 1536 + h2 * 128, 0, nullptr);
            }
            UREP(6) for (int v = (F.bid + 32) % F.G; v < 128; v += F.G) ml_scan_unit(F, v >> 2, v & 3);
            UREP(7) for (int v = (F.bid + 96) % F.G; v < 128; v += F.G) ss_scan_unit(F, v >> 1, v & 1);
            UREP(8) for (int v = F.bid; v < 288; v += F.G) mla_post_unit(F, l, v / 72, v % 72);
            SEAM(pb + 4); TPE(pb + 4);
        }
        if (IN(pb + 5)) { TPB(pb + 5);
            const int p0 = wc ? 0 : 4, npp = 36 - p0;
            UREP(9) for (int u = F.bid; u < 256; u += F.G) { const int bh = u >> 4, qb = u & 15, b = bh >> 2, h = bh & 3;
                attn_unit2<192, false>(F, WSP(bf16, WS_QMLA) + ((size_t)bh * TS + qb * 128) * 192, WSP(bf16, WS_KMLA) + (size_t)bh * TS * 192, WSP(bf16, WS_VTMLA) + (size_t)bh * 128 * TS,
                                      36, 0, 0, 0, 0.10411754627862817f, WSP(bf16, WS_A2) + (size_t)(b * TL + qb * 128) * D + 1024 + h * 128, 0, nullptr); }
            if (wc) UREP(10) for (int v = F.bid; v < 32; v += F.G) { const int bh = v >> 1, qc = v & 1, b = bh >> 2, h = bh & 3;
                attn_unit2<192, false>(F, WSP(bf16, WS_QMLA) + ((size_t)bh * TS + TL + qc * 128) * 192, WSP(bf16, WS_KMLA) + (size_t)bh * TS * 192, WSP(bf16, WS_VTMLA) + (size_t)bh * 128 * TS,
                                      4, 32, 0, 0, 0.10411754627862817f, WSP(bf16, WS_A2) + (size_t)(MLAT + b * TC + qc * 128) * D + 1024 + h * 128, 0, nullptr); }
            UREP(11) for (int v = (F.bid + 32) % F.G; v < 32 * npp; v += F.G) ml_c_unit(F, v / npp, p0 + v % npp);
            UREP(12) for (int v = (F.bid + 160) % F.G; v < 64 * npp; v += F.G) ss_c_unit(F, l, v / npp, p0 + v % npp);
            SEAM(pb + 5); TPE(pb + 5);
        }
        if (IN(pb + 6)) { TPB(pb + 6); m5_finish_phase(F, l, nrows); SEAM(pb + 6); TPE(pb + 6); }
        if (IN(pb + 7)) { TPB(pb + 7);
            const int ncv = (ONE_LAUNCH && l == 0) ? NCV_OUT : 0, gw_ = F.G - ncv;
            if (F.bid < gw_) { pg8::Gemm g{WSP(bf16, WS_A2), WSP(bf16, WS_WOUT) + (size_t)l * D * D, D, D}; pg8::StaticOrder S; S.init(nrows / 256, D / 256, gw_, F.bid);
                EpiResid E{l == 0 ? F.in[0] : WSP(float, WS_X), l == 0 ? F.in[2] : WSP(float, WS_X) + (size_t)MLAT * D, WSP(float, WS_X), modl + 2 * D};
                pg8::gemm_phase<EpiResid, pg8::StaticOrder>(F.lds, g, S, E); }
            FILL(pb + 7, F.bid >= gw_);
            SEAM(pb + 7); TPE(pb + 7);
        }
        if (IN(pb + 8)) { TPB(pb + 8);
            if (l == 0) { norm_phase<false>(F, l, WSP(float, WS_X), WSP(float, WS_X) + (size_t)MLAT * D, F.in[27] + l * D, 3 * D, nrows); conv_drain(F, CV_NE - CV_EAGER); }
            else { norm_phase<true>(F, l, WSP(float, WS_X), WSP(float, WS_X) + (size_t)MLAT * D, F.in[27] + l * D, 3 * D, nrows); conv_drain(F, CV_NDEF); }
            SEAM(pb + 8); TPE(pb + 8);
        }
        if (l == 0) {
            if (IN(pb + 10)) { TPB(pb + 10);
                const int ncv = ONE_LAUNCH ? NCV_UP : 0, gw_ = F.G - ncv;
                if (F.bid < gw_) { pg8::Gemm g{WSP(bf16, WS_HN), WSP(bf16, WS_W13), D, D}; pg8::StaticOrder S; S.init(MTOK / 256, 2 * FF / 256, gw_, F.bid);
                    EpiSwiglu E{WSP(bf16, WS_G), FF}; pg8::gemm_phase<EpiSwiglu, pg8::StaticOrder>(F.lds, g, S, E); }
                FILL(pb + 10, F.bid >= gw_);
                SEAM(pb + 10); TPE(pb + 10);
            }
            if (IN(pb + 11)) { TPB(pb + 11);
                const int ncv = ONE_LAUNCH ? NCV_DOWN : 0, gw_ = F.G - ncv;
                if (F.bid < gw_) { pg8::Gemm g{WSP(bf16, WS_G), WSP(bf16, WS_W2), FF, FF}; pg8::StaticOrder S; S.init(MTOK / 256, D / 256, gw_, F.bid);
                    EpiResid E{WSP(float, WS_X), WSP(float, WS_X) + (size_t)MLAT * D, WSP(float, WS_X), modl + 5 * D};
                    pg8::gemm_phase<EpiResid, pg8::StaticOrder>(F.lds, g, S, E); }
                FILL(pb + 11, F.bid >= gw_);
                SEAM(pb + 11); TPE(pb + 11);
            }
        } else {
            if (IN(pb + 10)) { TPB(pb + 10);
                __syncthreads(); moe_tables(F, mtb, 2 * FE / 256);
                pg8::Gemm g{WSP(bf16, WS_XG), WSP(bf16, WS_MW13), D, D}; MoeOrder S{mtb, 2 * FE / 256, F.G, F.bid, 0, mtb[40], 1, 0, MLAT / 256};
                EpiSwiglu E{WSP(bf16, WS_G), FE}; pg8::gemm_phase<EpiSwiglu, MoeOrder>(F.lds, g, S, E);
                SEAM(pb + 10); TPE(pb + 10);
            }
            if (IN(pb + 11)) { TPB(pb + 11);
                __syncthreads(); moe_tables(F, mtb, D / 256);
                const int nun = mtb[40], nfull0 = (nun / F.G) * F.G, nt0 = nun - nfull0;
                const int SK = nt0 == 0 ? 1 : (nt0 <= 32 ? 8 : (nt0 <= 64 ? 4 : (nt0 <= 128 ? 2 : 1)));
                const int nfull = SK == 1 ? nun : nfull0, ntail = nun - nfull;
                { pg8::Gemm g{WSP(bf16, WS_G), WSP(bf16, WS_MW2), FE, FE}; MoeOrder S{mtb, D / 256, F.G, F.bid, 0, nfull, 1, 0, 0};
                  EpiF32 E{WSP(float, WS_Y), D}; pg8::gemm_phase<EpiF32, MoeOrder>(F.lds, g, S, E); }
                if (ntail > 0) { __syncthreads();
                  pg8::Gemm g{WSP(bf16, WS_G), WSP(bf16, WS_MW2), FE / SK, FE}; MoeOrder S{mtb, D / 256, F.G, F.bid, nfull, ntail * SK, SK, FE / SK, 0};
                  EpiPart E{WSP(float, WS_PART)}; pg8::gemm_phase<EpiPart, MoeOrder>(F.lds, g, S, E); }
                SEAM(pb + 11); TPE(pb + 11);
            }
            if (IN(pb + 12)) { TPB(pb + 12);
                __syncthreads(); moe_tables(F, mtb, D / 256);
                const int nun = mtb[40], nfull0 = (nun / F.G) * F.G, nt0 = nun - nfull0;
                const int SK = nt0 == 0 ? 1 : (nt0 <= 32 ? 8 : (nt0 <= 64 ? 4 : (nt0 <= 128 ? 2 : 1)));
                const int nfull = SK == 1 ? nun : nfull0, ntail = nun - nfull;
                for (int it = F.bid; it < ntail * 8; it += F.G) { const int t = it >> 3, cg = it & 7;
                    MoeOrder S{mtb, D / 256, 1, 0, nfull + t, 1, 1, 0, 0}; pg8::Unit u; S.next(0, u);
                    if (SK == 8) splitk_reduce_f32<8>(WSP(float, WS_PART), t, cg, u, WSP(float, WS_Y), D);
                    else if (SK == 4) splitk_reduce_f32<4>(WSP(float, WS_PART), t, cg, u, WSP(float, WS_Y), D);
                    else splitk_reduce_f32<2>(WSP(float, WS_PART), t, cg, u, WSP(float, WS_Y), D); }
                SEAM(pb + 12); TPE(pb + 12);
            }
            if (IN(pb + 13)) { TPB(pb + 13); moe_combine_phase(F, l); __syncthreads(); TPE(pb + 13); }
        }
}
__global__ void __launch_bounds__(NTHR, 2) fwd_kernel(Args args) {
    extern __shared__ __attribute__((aligned(16))) unsigned char lds[];
    Frame F;
    F.lds = (LAS unsigned char*)lds; F.ws = args.ws; F.out = args.out;
#pragma unroll
    for (int i = 0; i < 35; ++i) F.in[i] = args.in[i];
    F.tid = threadIdx.x; F.lane = F.tid & 63; F.wave = __builtin_amdgcn_readfirstlane(F.tid >> 6); F.G = gridDim.x; F.bid = blockIdx.x; F.rep = args.rep;
    volatile LAS unsigned* MISC = (volatile LAS unsigned*)(F.lds + MISC_OFF);
    if (F.tid < 64) MISC[F.tid] = 0u;
    __syncthreads();
    XcdBarrier bar; bar.bar = WSP(unsigned, WS_CTL) + CW_BAR; bar.x = 0; bar.st = nullptr;
    if (ONE_LAUNCH) bar = xcd_barrier_post(WSP(unsigned, WS_CTL) + CW_BAR, MISC + 8);
    const int lo = args.ph_lo, hi = args.ph_hi;

    if (IN(0)) { TPB(0); p0_prologue(F); SEAM(0); TPE(0); }

    layer_phases<0>(F, bar, lo, hi);
    layer_phases<1>(F, bar, lo, hi);
    if (TPROBE_MASK != 0ull && F.bid == 0 && F.tid == 0) { volatile LAS unsigned long long* tp_ = (volatile LAS unsigned long long*)(F.lds + MISC_OFF + 128);
        const unsigned long long t0 = wall_clock64(), dur = tp_[1] * TPROBE_AMP; while (wall_clock64() - t0 < dur) __builtin_amdgcn_s_sleep(8); }
#undef IN
#undef SEAM
}

extern "C" void kernel_launch(void* const* d_in, const int* in_sizes, int n_in, void* d_out, int out_size, void* d_ws, size_t ws_size, hipStream_t stream) {
    static int grid = 0;
    if (grid == 0) {
        if (n_in != 35 || out_size != MLAT * D || ws_size < WS_END) { fprintf(stderr, "kernel_launch: unexpected shapes (n_in %d out %d ws %zu need %zu)\n", n_in, out_size, ws_size, (size_t)WS_END); grid = -1; return; }
        int dev = 0, cus = 0, per_cu = 0;
        if (hipGetDevice(&dev) != hipSuccess || hipDeviceGetAttribute(&cus, hipDeviceAttributeMultiprocessorCount, dev) != hipSuccess) { grid = -1; return; }
        if (hipFuncSetAttribute((const void*)fwd_kernel, hipFuncAttributeMaxDynamicSharedMemorySize, LDS_BYTES) != hipSuccess) { fprintf(stderr, "kernel_launch: hipFuncSetAttribute failed\n"); grid = -1; return; }
        if (hipOccupancyMaxActiveBlocksPerMultiprocessor(&per_cu, (const void*)fwd_kernel, NTHR, LDS_BYTES) != hipSuccess || per_cu < 1) { fprintf(stderr, "kernel_launch: occupancy query says %d\n", per_cu); }
        (void)hipGetLastError();
        grid = cus;
    }
    if (grid < 0) return;
    (void)hipMemsetAsync((char*)d_ws + WS_CTL, 0, CTL_ZERO_BYTES, stream);
    Args a{};
    for (int i = 0; i < 35; ++i) a.in[i] = (const float*)d_in[i];
    a.out = (float*)d_out; a.ws = (unsigned char*)d_ws; a.rep = UNIT_REP;
#if ONE_LAUNCH
    a.ph_lo = 0; a.ph_hi = 64;
    hipLaunchKernelGGL(fwd_kernel, dim3(grid), dim3(NTHR), LDS_BYTES, stream, a);
#else
    static const int phases[] = {0, 1, 2, 3, 4, 5, 6, 7, 8, 9, 11, 12, 17, 18, 19, 20, 21, 22, 23, 24, 25, 27, 28, 29, 30};
    for (int k = 0; k < (int)(sizeof(phases) / sizeof(phases[0])); ++k) {
        a.ph_lo = phases[k]; a.ph_hi = phases[k] + 1;
        for (int rp = 0; rp < NREP(phases[k]); ++rp) hipLaunchKernelGGL(fwd_kernel, dim3(grid), dim3(NTHR), LDS_BYTES, stream, a);
    }
#endif
}
```
